# Optimizing an MI355X kernel written in HIP

```python
import math
import jax, jax.numpy as jnp
from jax import lax
import numpy as np

D_MODEL = 1024
BATCH = 8
SEQ = 2048
DEPTH = 2

N_A_LAYERS = max(1, DEPTH // 2)
N_B_LAYERS = DEPTH - N_A_LAYERS
CONV_WIDTH = 3
N_HEADS = 8
HEAD_DIM = D_MODEL // (2 * N_HEADS)
N_GROUPS = 4
EXPERTS_PER_GROUP = 8
N_EXPERTS = N_GROUPS * EXPERTS_PER_GROUP
TOP_K = 2
D_EXPERT = D_MODEL // 2
Q_BLOCK = 128
ROW_BLOCK = 128
ALPHA = (2.0 * DEPTH) ** 0.25
BETA = (8.0 * DEPTH) ** -0.25
LN_EPS = 1e-5
RMS_EPS = 1e-5

kernel_name = "yoco_shortconv_diffattn_hmoe"


def layer_norm(x, g, b):
    xf = x.astype(jnp.float32)
    mu = jnp.mean(xf, axis=-1, keepdims=True)
    var = jnp.mean(jnp.square(xf - mu), axis=-1, keepdims=True)
    return ((xf - mu) * lax.rsqrt(var + LN_EPS) * g.astype(jnp.float32) + b.astype(jnp.float32)).astype(x.dtype)


def rms_norm(x, g):
    xf = x.astype(jnp.float32)
    return xf * lax.rsqrt(jnp.mean(jnp.square(xf), axis=-1, keepdims=True) + RMS_EPS) * g.astype(jnp.float32)


def short_conv_mixer(x, w_in, conv_w, w_out):
    h = jnp.einsum('bsd,de->bse', x, w_in)
    gate_b, gate_c, v = jnp.split(h, 3, axis=-1)
    u = gate_c * v
    u_conv = lax.conv_general_dilated(
        u, conv_w[:, None, :], window_strides=(1,), padding=[(CONV_WIDTH - 1, 0)],
        dimension_numbers=('NWC', 'WIO', 'NWC'), feature_group_count=D_MODEL)
    return jnp.einsum('bsd,de->bse', gate_b * u_conv, w_out)


def shared_kv(x, kv_w):
    b, s, _ = x.shape
    kv = jnp.einsum('bsd,de->bse', x, kv_w)
    k, v = jnp.split(kv, 2, axis=-1)
    return k.reshape(b, s, N_HEADS, 2, HEAD_DIM), v.reshape(b, s, N_HEADS, 2 * HEAD_DIM)


def diff_attention(x, w_q, lam, subln_g, w_o, k, v, layer_idx):
    b, s, _ = x.shape
    q = jnp.einsum('bsd,de->bse', x, w_q).reshape(b, s, N_HEADS, 2, HEAD_DIM)
    lam_init = 0.8 - 0.6 * math.exp(-0.3 * layer_idx)
    lamf = lam.astype(jnp.float32)
    lam_full = jnp.exp(jnp.sum(lamf[0] * lamf[1])) - jnp.exp(jnp.sum(lamf[2] * lamf[3])) + lam_init
    scale = HEAD_DIM ** -0.5
    outs = []
    for i in range(s // Q_BLOCK):
        kv_len = (i + 1) * Q_BLOCK
        q_blk = q[:, i * Q_BLOCK:kv_len]
        k_pre = k[:, :kv_len]
        v_pre = v[:, :kv_len]
        sc = jnp.einsum('bqhcd,bkhcd->bhcqk', q_blk, k_pre,
                        preferred_element_type=jnp.float32) * scale
        q_pos = i * Q_BLOCK + jnp.arange(Q_BLOCK)
        k_pos = jnp.arange(kv_len)
        sc = jnp.where(k_pos[None, :] <= q_pos[:, None], sc, -jnp.inf)
        p = jax.nn.softmax(sc, axis=-1)
        attn = p[:, :, 0] - lam_full * p[:, :, 1]
        outs.append(jnp.einsum('bhqk,bkhe->bqhe', attn, v_pre.astype(jnp.float32)))
    o = jnp.concatenate(outs, axis=1)
    o = rms_norm(o, subln_g) * (1.0 - lam_init)
    o = o.reshape(b, s, N_HEADS * 2 * HEAD_DIM).astype(x.dtype)
    return jnp.einsum('bse,ed->bsd', o, w_o)


def routed_experts(xf, expert_idx, gates, w_in, w_down):
    t, d = xf.shape
    a = t * TOP_K
    flat_e = expert_idx.reshape(a)
    order = jnp.argsort(flat_e)
    sorted_e = flat_e[order]
    counts = jnp.zeros((N_EXPERTS,), jnp.int32).at[flat_e].add(1)
    padded = (counts + ROW_BLOCK - 1) // ROW_BLOCK * ROW_BLOCK
    pad_end = jnp.cumsum(padded)
    pad_start = pad_end - padded
    start = jnp.cumsum(counts) - counts
    dest = pad_start[sorted_e] + jnp.arange(a, dtype=jnp.int32) - start[sorted_e]
    n_rows = -(-a // ROW_BLOCK) * ROW_BLOCK + N_EXPERTS * ROW_BLOCK
    n_blocks = n_rows // ROW_BLOCK
    tok = (order // TOP_K).astype(jnp.int32)
    row_token = jnp.full((n_rows,), t, jnp.int32).at[dest].set(tok)
    x_pad = jnp.concatenate([xf, jnp.zeros((1, d), xf.dtype)], axis=0)
    rows = x_pad[row_token].reshape(n_blocks, ROW_BLOCK, d)
    block_expert = jnp.minimum(
        jnp.searchsorted(pad_end, jnp.arange(n_blocks) * ROW_BLOCK, side='right'), N_EXPERTS - 1)

    def expert_block(args):
        xb, e = args
        g, u = jnp.split(xb @ w_in[e], 2, axis=-1)
        return (jax.nn.silu(g) * u) @ w_down[e]

    y_rows = lax.map(expert_block, (rows, block_expert)).reshape(n_rows, d)
    contrib = y_rows[dest] * gates.reshape(a)[order][:, None].astype(y_rows.dtype)
    return jax.ops.segment_sum(contrib, tok, num_segments=t)


def hierarchical_moe(x, rg_w, rg_b, re_w, re_b, w_in, w_down):
    b, s, d = x.shape
    xf = x.reshape(b * s, d)
    t = xf.shape[0]
    g_prob = jax.nn.softmax((xf @ rg_w).astype(jnp.float32) + rg_b.astype(jnp.float32), axis=-1)
    g_top, g_idx = lax.top_k(g_prob, 1)
    e_logits = ((xf @ re_w).astype(jnp.float32) + re_b.astype(jnp.float32)).reshape(t, N_GROUPS, EXPERTS_PER_GROUP)
    e_sel = jnp.take_along_axis(e_logits, g_idx[:, :, None], axis=1)[:, 0]
    w_top, local_idx = lax.top_k(jax.nn.softmax(e_sel, axis=-1), TOP_K)
    gates = g_top * (w_top / jnp.sum(w_top, axis=-1, keepdims=True))
    expert_idx = g_idx * EXPERTS_PER_GROUP + local_idx
    return routed_experts(xf, expert_idx, gates, w_in, w_down).reshape(b, s, d)


def setup_inputs(seed: int = 0) -> dict:
    key = jax.random.key(seed)
    ks = jax.random.split(key, 24)
    n = jax.random.normal
    f32 = jnp.float32
    s_d = D_MODEL ** -0.5
    kv_scale = jnp.concatenate([jnp.full((D_MODEL,), s_d, f32), jnp.full((D_MODEL,), s_d * BETA, f32)])
    return {
        "x": n(ks[0], (BATCH, SEQ, D_MODEL), f32),
        "a_w_in": n(ks[1], (N_A_LAYERS, D_MODEL, 3 * D_MODEL), f32) * s_d,
        "a_conv_w": n(ks[2], (N_A_LAYERS, CONV_WIDTH, D_MODEL), f32) * CONV_WIDTH ** -0.5,
        "a_w_out": n(ks[3], (N_A_LAYERS, D_MODEL, D_MODEL), f32) * s_d * BETA,
        "kv_w": n(ks[4], (D_MODEL, 2 * D_MODEL), f32) * kv_scale,
        "b_w_q": n(ks[5], (N_B_LAYERS, D_MODEL, 2 * N_HEADS * HEAD_DIM), f32) * s_d,
        "b_lambda": n(ks[6], (N_B_LAYERS, 4, HEAD_DIM), f32) * 0.1,
        "b_subln_g": 1.0 + 0.01 * n(ks[7], (N_B_LAYERS, 2 * HEAD_DIM), f32),
        "b_w_o": n(ks[8], (N_B_LAYERS, 2 * N_HEADS * HEAD_DIM, D_MODEL), f32) * s_d * BETA,
        "ln1_g": 1.0 + 0.01 * n(ks[9], (DEPTH, D_MODEL), f32),
        "ln1_b": 0.01 * n(ks[10], (DEPTH, D_MODEL), f32),
        "ln2_g": 1.0 + 0.01 * n(ks[11], (DEPTH, D_MODEL), f32),
        "ln2_b": 0.01 * n(ks[12], (DEPTH, D_MODEL), f32),
        "rg_w": n(ks[13], (DEPTH, D_MODEL, N_GROUPS), f32) * s_d,
        "rg_b": 0.01 * n(ks[14], (DEPTH, N_GROUPS), f32),
        "re_w": n(ks[15], (DEPTH, D_MODEL, N_EXPERTS), f32) * s_d,
        "re_b": 0.01 * n(ks[16], (DEPTH, N_EXPERTS), f32),
        "e_w_in": n(ks[17], (DEPTH, N_EXPERTS, D_MODEL, 2 * D_EXPERT), f32) * s_d,
        "e_w_down": n(ks[18], (DEPTH, N_EXPERTS, D_EXPERT, D_MODEL), f32) * D_EXPERT ** -0.5 * BETA,
    }


def reference(x, a_w_in, a_conv_w, a_w_out, kv_w, b_w_q, b_lambda, b_subln_g, b_w_o,
              ln1_g, ln1_b, ln2_g, ln2_b, rg_w, rg_b, re_w, re_b, e_w_in, e_w_down):
    k_shared = None
    v_shared = None
    for layer in range(DEPTH):
        if layer < N_A_LAYERS:
            mix = short_conv_mixer(x, a_w_in[layer], a_conv_w[layer], a_w_out[layer])
        else:
            j = layer - N_A_LAYERS
            mix = diff_attention(x, b_w_q[j], b_lambda[j], b_subln_g[j], b_w_o[j],
                                 k_shared, v_shared, layer)
        x = layer_norm(ALPHA * x + mix, ln1_g[layer], ln1_b[layer])
        ffn = hierarchical_moe(x, rg_w[layer], rg_b[layer], re_w[layer], re_b[layer],
                               e_w_in[layer], e_w_down[layer])
        x = layer_norm(ALPHA * x + ffn, ln2_g[layer], ln2_b[layer])
        if layer == N_A_LAYERS - 1:
            k_shared, v_shared = shared_kv(x, kv_w)
    return x
```

```cpp
#include <hip/hip_runtime.h>
#include <hip/hip_bf16.h>
#include <cstdio>
#include <cstdint>
#include <cmath>

namespace ref {
constexpr int D = 1024, BATCH = 8, SEQ = 2048, T = BATCH * SEQ;
constexpr int NH = 8, HD = 64, NG = 4, EPG = 8, NE = 32, DE = 512;
constexpr float ALPHA = 1.4142135623730951f;
constexpr float LN_EPS = 1e-5f, RMS_EPS = 1e-5f;
constexpr int RB = 64;
constexpr int NR = T * 2 + NE * RB;
constexpr int NRT = NR / RB;

typedef short bf16x8 __attribute__((ext_vector_type(8)));
typedef float f32x4 __attribute__((ext_vector_type(4)));

__device__ __forceinline__ unsigned short f2bf(float f) {
    unsigned u = __builtin_bit_cast(unsigned, f);
    return (unsigned short)((u + 0x7fffu + ((u >> 16) & 1u)) >> 16);
}

__global__ __launch_bounds__(256) void gemm_ref(const float* __restrict__ A, int lda, const int* __restrict__ arow,
                                                const float* __restrict__ B, int ldb, const int* __restrict__ tile_expert, long expert_stride,
                                                const int* __restrict__ ntiles_ptr,
                                                float* __restrict__ C, int ldc, int M, int N, int K) {
    __shared__ __attribute__((aligned(16))) unsigned short As[64][40];
    __shared__ __attribute__((aligned(16))) unsigned short Bs[64][40];
    const int tm = blockIdx.y, tn = blockIdx.x;
    if (ntiles_ptr && tm >= *ntiles_ptr) return;
    const float* Bp = B;
    if (tile_expert) Bp += (long)tile_expert[tm] * expert_stride;
    const int tid = threadIdx.x, lane = tid & 63, wave = tid >> 6, wm = wave >> 1, wn = wave & 1;
    const int m0 = tm * 64, n0 = tn * 64;
    const int ar = tid >> 2, ac = (tid & 3) * 8;
    long arow_idx = m0 + ar;
    bool avalid = true;
    if (arow) { int g = arow[m0 + ar]; avalid = g >= 0; arow_idx = avalid ? g : 0; }
    const float* Ap = A + arow_idx * lda + ac;
    const int bk = tid >> 3, bn = (tid & 7) * 8;
    f32x4 acc[2][2];
    for (int i = 0; i < 2; ++i) for (int j = 0; j < 2; ++j) acc[i][j] = (f32x4){0.f, 0.f, 0.f, 0.f};
    for (int k0 = 0; k0 < K; k0 += 32) {
        f32x4 a0 = (f32x4){0.f, 0.f, 0.f, 0.f}, a1 = a0;
        if (avalid) { a0 = *(const f32x4*)(Ap + k0); a1 = *(const f32x4*)(Ap + k0 + 4); }
        const float* bp = Bp + (long)(k0 + bk) * ldb + n0 + bn;
        f32x4 b0 = *(const f32x4*)bp, b1 = *(const f32x4*)(bp + 4);
        __syncthreads();
        bf16x8 av;
        av[0] = (short)f2bf(a0[0]); av[1] = (short)f2bf(a0[1]); av[2] = (short)f2bf(a0[2]); av[3] = (short)f2bf(a0[3]);
        av[4] = (short)f2bf(a1[0]); av[5] = (short)f2bf(a1[1]); av[6] = (short)f2bf(a1[2]); av[7] = (short)f2bf(a1[3]);
        *(bf16x8*)&As[ar][ac] = av;
        for (int i = 0; i < 4; ++i) { Bs[bn + i][bk] = f2bf(b0[i]); Bs[bn + 4 + i][bk] = f2bf(b1[i]); }
        __syncthreads();
        bf16x8 af[2], bfr[2];
        for (int i = 0; i < 2; ++i) {
            af[i] = *(const bf16x8*)&As[wm * 32 + i * 16 + (lane & 15)][8 * (lane >> 4)];
            bfr[i] = *(const bf16x8*)&Bs[wn * 32 + i * 16 + (lane & 15)][8 * (lane >> 4)];
        }
        for (int i = 0; i < 2; ++i) for (int j = 0; j < 2; ++j)
            acc[i][j] = __builtin_amdgcn_mfma_f32_16x16x32_bf16(af[i], bfr[j], acc[i][j], 0, 0, 0);
    }
    for (int i = 0; i < 2; ++i) for (int j = 0; j < 2; ++j) for (int r = 0; r < 4; ++r) {
        const int row = m0 + wm * 32 + i * 16 + (lane >> 4) * 4 + r, col = n0 + wn * 32 + j * 16 + (lane & 15);
        C[(long)row * ldc + col] = acc[i][j][r];
    }
}

__global__ void conv_gate(const float* __restrict__ h, const float* __restrict__ cw, float* __restrict__ a2) {
    const long i = (long)blockIdx.x * blockDim.x + threadIdx.x;
    if (i >= (long)T * D) return;
    const int d = (int)(i % D); const long t = i / D; const int s = (int)(t % SEQ);
    const float* hr = h + t * 3 * D;
    float u0 = hr[D + d] * hr[2 * D + d];
    float u1 = 0.f, u2 = 0.f;
    if (s >= 1) u1 = (hr - 3 * D)[D + d] * (hr - 3 * D)[2 * D + d];
    if (s >= 2) u2 = (hr - 6 * D)[D + d] * (hr - 6 * D)[2 * D + d];
    const float c = cw[0 * D + d] * u2 + cw[1 * D + d] * u1 + cw[2 * D + d] * u0;
    a2[i] = hr[d] * c;
}

__device__ __forceinline__ float wave_sum(float v) {
    for (int o = 1; o < 64; o <<= 1) v += __shfl_xor(v, o);
    return v;
}
__device__ __forceinline__ float wave_max(float v) {
    for (int o = 1; o < 64; o <<= 1) v = fmaxf(v, __shfl_xor(v, o));
    return v;
}

__global__ __launch_bounds__(256) void ln_kernel(const float* __restrict__ x, const float* __restrict__ mix,
                                                 const float* __restrict__ Y, const int* __restrict__ dest, const float* __restrict__ gate,
                                                 const float* __restrict__ g, const float* __restrict__ b, float* __restrict__ out) {
    const int t = blockIdx.x * 4 + (threadIdx.x >> 6), lane = threadIdx.x & 63;
    float v[16]; float s = 0.f;
    for (int j = 0; j < 16; ++j) {
        const int c = j * 64 + lane;
        float z = ALPHA * x[(long)t * D + c];
        if (mix) z += mix[(long)t * D + c];
        if (Y) z += gate[t * 2] * Y[(long)dest[t * 2] * D + c] + gate[t * 2 + 1] * Y[(long)dest[t * 2 + 1] * D + c];
        v[j] = z; s += z;
    }
    const float mu = wave_sum(s) * (1.f / D);
    float q = 0.f;
    for (int j = 0; j < 16; ++j) { v[j] -= mu; q += v[j] * v[j]; }
    const float rstd = 1.0f / sqrtf(wave_sum(q) * (1.f / D) + LN_EPS);
    for (int j = 0; j < 16; ++j) { const int c = j * 64 + lane; out[(long)t * D + c] = v[j] * rstd * g[c] + b[c]; }
}

__global__ __launch_bounds__(256) void router(const float* __restrict__ x, const float* __restrict__ rgw, const float* __restrict__ rgb,
                                              const float* __restrict__ rew, const float* __restrict__ reb,
                                              int* __restrict__ eidx, float* __restrict__ gate, int* __restrict__ slot, int* __restrict__ cnt) {
    const int t = blockIdx.x * 4 + (threadIdx.x >> 6), lane = threadIdx.x & 63;
    float xv[16];
    for (int j = 0; j < 16; ++j) xv[j] = x[(long)t * D + j * 64 + lane];
    float gl[NG];
    for (int n = 0; n < NG; ++n) { float a = 0.f; for (int j = 0; j < 16; ++j) a += xv[j] * rgw[(long)(j * 64 + lane) * NG + n]; gl[n] = wave_sum(a) + rgb[n]; }
    int gi = 0; float gm = gl[0];
    for (int n = 1; n < NG; ++n) if (gl[n] > gm) { gm = gl[n]; gi = n; }
    float gs = 0.f; for (int n = 0; n < NG; ++n) gs += expf(gl[n] - gm);
    const float gtop = 1.0f / gs;
    float el[EPG];
    for (int n = 0; n < EPG; ++n) { float a = 0.f; const int col = gi * EPG + n; for (int j = 0; j < 16; ++j) a += xv[j] * rew[(long)(j * 64 + lane) * NE + col]; el[n] = wave_sum(a) + reb[col]; }
    int i0 = 0; float m0 = el[0];
    for (int n = 1; n < EPG; ++n) if (el[n] > m0) { m0 = el[n]; i0 = n; }
    int i1 = -1; float m1 = -INFINITY;
    for (int n = 0; n < EPG; ++n) if (n != i0 && el[n] > m1) { m1 = el[n]; i1 = n; }
    const float e1 = expf(m1 - m0); const float w0 = 1.0f / (1.0f + e1), w1 = e1 / (1.0f + e1);
    if (lane == 0) {
        const int ea = gi * EPG + i0, eb = gi * EPG + i1;
        eidx[t * 2] = ea; eidx[t * 2 + 1] = eb; gate[t * 2] = gtop * w0; gate[t * 2 + 1] = gtop * w1;
        slot[t * 2] = atomicAdd(&cnt[ea], 1); slot[t * 2 + 1] = atomicAdd(&cnt[eb], 1);
    }
}
__global__ void moe_plan(const int* __restrict__ cnt, int* __restrict__ pad_start, int* __restrict__ tile_expert, int* __restrict__ ntiles, int* __restrict__ row_token) {
    __shared__ int ps[NE + 1];
    if (threadIdx.x == 0) { int a = 0; for (int e = 0; e < NE; ++e) { ps[e] = a; a += (cnt[e] + RB - 1) / RB * RB; } ps[NE] = a; *ntiles = a / RB; }
    __syncthreads();
    if (threadIdx.x < NE) pad_start[threadIdx.x] = ps[threadIdx.x];
    for (int i = threadIdx.x; i < NRT; i += blockDim.x) { int e = NE - 1; for (int k = 0; k < NE; ++k) if (i * RB < ps[k + 1]) { e = k; break; } tile_expert[i] = e; }
    for (int i = threadIdx.x; i < NR; i += blockDim.x) row_token[i] = -1;
}
__global__ void moe_scatter(const int* __restrict__ eidx, const int* __restrict__ slot, const int* __restrict__ pad_start, int* __restrict__ dest, int* __restrict__ row_token) {
    const int p = blockIdx.x * blockDim.x + threadIdx.x;
    if (p >= T * 2) return;
    const int d = pad_start[eidx[p]] + slot[p]; dest[p] = d; row_token[d] = p >> 1;
}
__global__ void swiglu(const float* __restrict__ h, float* __restrict__ act, const int* __restrict__ ntiles) {
    const long i = (long)blockIdx.x * blockDim.x + threadIdx.x;
    const long r = i / DE; const int j = (int)(i % DE);
    if (r >= (long)(*ntiles) * RB) return;
    const float g = h[r * D + j], u = h[r * D + DE + j];
    act[i] = g / (1.0f + expf(-g)) * u;
}

__global__ __launch_bounds__(128) void attn_ref(const float* __restrict__ q, const float* __restrict__ kv, const float* __restrict__ lam,
                                                const float* __restrict__ subg, float lam_init, float* __restrict__ out) {
    __shared__ float Ks[2][64][65];
    const int wave = threadIdx.x >> 6, lane = threadIdx.x & 63;
    const int gw = blockIdx.x * 2 + wave;
    const int h = gw % NH, s = (gw / NH) % SEQ, b = gw / (NH * SEQ);
    float l01 = wave_sum(lam[lane] * lam[64 + lane]), l23 = wave_sum(lam[128 + lane] * lam[192 + lane]);
    const float lam_full = expf(l01) - expf(l23) + lam_init;
    const long t = (long)b * SEQ + s;
    float oc[2][2];
    for (int c = 0; c < 2; ++c) {
        const float qv = q[t * D + h * 128 + c * 64 + lane] * 0.125f;
        float m = -INFINITY, l = 0.f, a0 = 0.f, a1 = 0.f;
        for (int j0 = 0; j0 <= s; j0 += 64) {
            const int nk = min(64, s - j0 + 1);
            for (int r = 0; r < nk; ++r) Ks[wave][r][lane] = kv[((long)b * SEQ + j0 + r) * 2 * D + h * 128 + c * 64 + lane];
            __builtin_amdgcn_wave_barrier();
            float sc = 0.f;
            for (int d = 0; d < 64; ++d) sc += __shfl(qv, d) * Ks[wave][lane][d];
            if (lane >= nk) sc = -INFINITY;
            const float mn = fmaxf(m, wave_max(sc));
            const float f = expf(m - mn);
            const float p = (lane < nk) ? expf(sc - mn) : 0.f;
            l = l * f + wave_sum(p); a0 *= f; a1 *= f; m = mn;
            for (int r = 0; r < nk; ++r) {
                const float pr = __shfl(p, r);
                const float* vr = kv + ((long)b * SEQ + j0 + r) * 2 * D + D + h * 128;
                a0 += pr * vr[lane]; a1 += pr * vr[64 + lane];
            }
        }
        oc[c][0] = a0 / l; oc[c][1] = a1 / l;
    }
    const float o0 = oc[0][0] - lam_full * oc[1][0], o1 = oc[0][1] - lam_full * oc[1][1];
    const float ss = wave_sum(o0 * o0 + o1 * o1) * (1.f / 128.f);
    const float r = 1.0f / sqrtf(ss + RMS_EPS) * (1.0f - lam_init);
    out[t * D + h * 128 + lane] = o0 * r * subg[lane];
    out[t * D + h * 128 + 64 + lane] = o1 * r * subg[64 + lane];
}
}

extern "C" void kernel_launch(void* const* d_in, const int* in_sizes, int n_in, void* d_out, int out_size, void* d_ws, size_t ws_size, hipStream_t stream) {
    using namespace ref;
    const float* x = (const float*)d_in[0];
    const float* a_w_in = (const float*)d_in[1];
    const float* a_conv_w = (const float*)d_in[2];
    const float* a_w_out = (const float*)d_in[3];
    const float* kv_w = (const float*)d_in[4];
    const float* b_w_q = (const float*)d_in[5];
    const float* b_lambda = (const float*)d_in[6];
    const float* b_subln_g = (const float*)d_in[7];
    const float* b_w_o = (const float*)d_in[8];
    const float* ln1_g = (const float*)d_in[9];
    const float* ln1_b = (const float*)d_in[10];
    const float* ln2_g = (const float*)d_in[11];
    const float* ln2_b = (const float*)d_in[12];
    const float* rg_w = (const float*)d_in[13];
    const float* rg_b = (const float*)d_in[14];
    const float* re_w = (const float*)d_in[15];
    const float* re_b = (const float*)d_in[16];
    const float* e_w_in = (const float*)d_in[17];
    const float* e_w_down = (const float*)d_in[18];
    float* out = (float*)d_out;

    char* ws = (char*)d_ws; size_t off = 0;
    auto alloc = [&](size_t bytes) { void* p = ws + off; off += (bytes + 255) & ~(size_t)255; return p; };
    float* R0 = (float*)alloc((size_t)T * 3 * D * 4);
    float* A2 = (float*)alloc((size_t)T * D * 4);
    float* MIX = (float*)alloc((size_t)T * D * 4);
    float* X1 = (float*)alloc((size_t)T * D * 4);
    float* ACT = (float*)alloc((size_t)NR * DE * 4);
    float* Y = (float*)alloc((size_t)NR * D * 4);
    float* X2 = (float*)alloc((size_t)T * D * 4);
    float* Q = (float*)alloc((size_t)T * D * 4);
    int* eidx = (int*)alloc((size_t)T * 2 * 4);
    float* gate = (float*)alloc((size_t)T * 2 * 4);
    int* slot = (int*)alloc((size_t)T * 2 * 4);
    int* dest = (int*)alloc((size_t)T * 2 * 4);
    int* row_token = (int*)alloc((size_t)NR * 4);
    int* tile_expert = (int*)alloc((size_t)NRT * 4);
    int* cnt = (int*)alloc(256);
    int* pad_start = (int*)alloc(256);
    int* ntiles = (int*)alloc(256);
    if (off > ws_size) { fprintf(stderr, "kernel_launch: workspace too small: need %zu have %zu\n", off, ws_size); return; }
    static_assert((size_t)NR * D * 4 <= (size_t)T * 3 * D * 4, "HE fits in R0");

    const float lam_init = 0.8f - 0.6f * expf(-0.3f * 1.0f);

    auto moe = [&](int layer, const float* xin, float* xout) {
        (void)hipMemsetAsync(cnt, 0, 256, stream);
        router<<<T / 4, 256, 0, stream>>>(xin, rg_w + (size_t)layer * D * NG, rg_b + layer * NG, re_w + (size_t)layer * D * NE, re_b + layer * NE, eidx, gate, slot, cnt);
        moe_plan<<<1, 1024, 0, stream>>>(cnt, pad_start, tile_expert, ntiles, row_token);
        moe_scatter<<<T * 2 / 256, 256, 0, stream>>>(eidx, slot, pad_start, dest, row_token);
        float* HE = R0;
        gemm_ref<<<dim3(D / 64, NRT), 256, 0, stream>>>(xin, D, row_token, e_w_in + (size_t)layer * NE * D * D, D, tile_expert, (long)D * D, ntiles, HE, D, NR, D, D);
        swiglu<<<(unsigned)(((size_t)NR * DE + 255) / 256), 256, 0, stream>>>(HE, ACT, ntiles);
        gemm_ref<<<dim3(D / 64, NRT), 256, 0, stream>>>(ACT, DE, nullptr, e_w_down + (size_t)layer * NE * DE * D, D, tile_expert, (long)DE * D, ntiles, Y, D, NR, D, DE);
        ln_kernel<<<T / 4, 256, 0, stream>>>(xin, nullptr, Y, dest, gate, ln2_g + layer * D, ln2_b + layer * D, xout);
    };

    gemm_ref<<<dim3(3 * D / 64, T / 64), 256, 0, stream>>>(x, D, nullptr, a_w_in, 3 * D, nullptr, 0, nullptr, R0, 3 * D, T, 3 * D, D);
    conv_gate<<<(unsigned)((size_t)T * D / 256), 256, 0, stream>>>(R0, a_conv_w, A2);
    gemm_ref<<<dim3(D / 64, T / 64), 256, 0, stream>>>(A2, D, nullptr, a_w_out, D, nullptr, 0, nullptr, MIX, D, T, D, D);
    ln_kernel<<<T / 4, 256, 0, stream>>>(x, MIX, nullptr, nullptr, nullptr, ln1_g, ln1_b, X1);
    moe(0, X1, X2);
    float* KV = R0;
    gemm_ref<<<dim3(2 * D / 64, T / 64), 256, 0, stream>>>(X2, D, nullptr, kv_w, 2 * D, nullptr, 0, nullptr, KV, 2 * D, T, 2 * D, D);
    gemm_ref<<<dim3(D / 64, T / 64), 256, 0, stream>>>(X2, D, nullptr, b_w_q, D, nullptr, 0, nullptr, Q, D, T, D, D);
    float* O3 = A2;
    attn_ref<<<T * NH / 2, 128, 0, stream>>>(Q, KV, b_lambda, b_subln_g, lam_init, O3);
    gemm_ref<<<dim3(D / 64, T / 64), 256, 0, stream>>>(O3, D, nullptr, b_w_o, D, nullptr, 0, nullptr, MIX, D, T, D, D);
    float* X3 = X1;
    ln_kernel<<<T / 4, 256, 0, stream>>>(X2, MIX, nullptr, nullptr, nullptr, ln1_g + D, ln1_b + D, X3);
    moe(1, X3, out);
}
```

```cpp
#include <hip/hip_runtime.h>
#include <hip/hip_cooperative_groups.h>
#include <cstdio>
#include <cstdint>
namespace cg = cooperative_groups;

namespace pg8 {
#define PG8_LAS __attribute__((address_space(3)))
typedef unsigned short bf16_t;
typedef short bf16x8 __attribute__((ext_vector_type(8)));
typedef float f32x4 __attribute__((ext_vector_type(4)));
typedef unsigned u32x4 __attribute__((ext_vector_type(4)));
typedef unsigned u32x2 __attribute__((ext_vector_type(2)));
constexpr int BM = 256, BK = 64, HALF = 128, HTB = HALF * BK * 2  , STAGE_BYTES = 8 * HTB, NXCD = 8, WGM = 8;

__host__ __device__ __forceinline__ int lds_byte(int r, int c) { const int st = (r >> 4) * 2 + (c >> 5), rr = r & 15, cc = c & 31, ob = rr * 64 + cc * 2; return st * 1024 + (ob ^ (((ob >> 9) & 1) << 5)); }
__host__ __device__ __forceinline__ void stage_rc(int b, int& R, int& C) { const int st = b / 1024, sb = b % 1024, swz = sb ^ (((sb >> 9) & 1) << 5); R = (st >> 1) * 16 + swz / 64; C = (st & 1) * 32 + (swz % 64) / 2; }
__host__ __device__ __forceinline__ int perm32(int rho) { const int n = rho >> 4, i = rho & 15; return 8 * (i >> 2) + 4 * n + (i & 3); }

struct Unit { const char* b0; const char* b1; int arow; int p0, p1, p2; };

__device__ __forceinline__ bool static_tile(int i, int G, int c, int nM, int nN, int& pm, int& pn) {
    const int nwg = nM * nN; const long L = (long)i * G + c; if (L >= nwg) return false;
    int wgid = (int)L; { const int q = nwg / NXCD, r = nwg % NXCD, xcd = wgid % NXCD, off = wgid / NXCD; wgid = (xcd < r ? xcd * (q + 1) : r * (q + 1) + (xcd - r) * q) + off; }
    const int nig = WGM * nN, gid = wgid / nig, fm = gid * WGM, gsz = (nM - fm) < WGM ? (nM - fm) : WGM;
    pm = fm + ((wgid % nig) % gsz); pn = (wgid % nig) / gsz; return true;
}

__device__ __forceinline__ unsigned cvt_pk_bf16(float lo, float hi) { unsigned r; asm volatile("v_cvt_pk_bf16_f32 %0, %1, %2" : "=v"(r) : "v"(lo), "v"(hi)); return r; }

template <class Epi, class Sched>
__device__ __forceinline__ void gemm_phase(PG8_LAS unsigned char* lds, const char* Abase, const int K, const Sched& S, const Epi& E) {
    int tid_ = threadIdx.x; asm volatile("" : "+v"(tid_));
    const int tid = tid_, wid = __builtin_amdgcn_readfirstlane(tid >> 6), lane = tid & 63, wr = wid >> 2, wc = wid & 3, fr = lane & 15, fq = lane >> 4;
    const int nt = K / BK;
    int R[2], C[2]; unsigned voffB[2];
#pragma unroll
    for (int i = 0; i < 2; ++i) { stage_rc(tid * 16 + i * 8192, R[i], C[i]); const int Rb = Epi::PERM ? ((R[i] & ~31) + perm32(R[i] & 31)) : R[i]; voffB[i] = (unsigned)(Rb * K + C[i]) * 2u; }
    const size_t kstep = (size_t)(BK * 2);
    const unsigned ldsw = (unsigned)wid * 1024u;
    const int aoff = lds_byte(wr * 64 + fr, fq * 8), boff = lds_byte(wc * 32 + fr, fq * 8);
#define PG8_SA(b, h) (((b) * 2 + (h)) * HTB)
#define PG8_SB(b, h) ((4 + (b) * 2 + (h)) * HTB)
#define PG8_STAGE(bufoff, gbase, v0, v1) do { \
        __builtin_amdgcn_global_load_lds((const unsigned*)((const char*)(gbase) + (v0)), (PG8_LAS unsigned*)(lds + (bufoff) + ldsw), 16, 0, 0); \
        __builtin_amdgcn_global_load_lds((const unsigned*)((const char*)(gbase) + (v1)), (PG8_LAS unsigned*)(lds + (bufoff) + ldsw + 8192), 16, 0, 0); } while (0)
#define PG8_STAGEB(bufoff, gbase) PG8_STAGE(bufoff, gbase, voffB[0], voffB[1])
#define PG8_LDA(dst, b, h) do { _Pragma("unroll") for (int m = 0; m < 4; ++m) _Pragma("unroll") for (int k = 0; k < 2; ++k) dst[m][k] = *(const PG8_LAS bf16x8*)(lds + PG8_SA(b, h) + aoff + m * 2048 + k * 1024); } while (0)
#define PG8_LDB(dst, b, h) do { _Pragma("unroll") for (int n = 0; n < 2; ++n) _Pragma("unroll") for (int k = 0; k < 2; ++k) dst[n][k] = *(const PG8_LAS bf16x8*)(lds + PG8_SB(b, h) + boff + n * 2048 + k * 1024); } while (0)
#define PG8_MMA(ai, bj, At, Bt) do { __builtin_amdgcn_s_setprio(1); _Pragma("unroll") for (int m = 0; m < 4; ++m) _Pragma("unroll") for (int n = 0; n < 2; ++n) _Pragma("unroll") for (int k = 0; k < 2; ++k) \
        acc[ai][bj][m][n] = __builtin_amdgcn_mfma_f32_16x16x32_bf16(Bt[n][k], At[m][k], acc[ai][bj][m][n], 0, 0, 0); __builtin_amdgcn_s_setprio(0); } while (0)
#define PG8_WAIT_V(n) asm volatile("s_waitcnt vmcnt(" #n ")" ::: "memory")
#define PG8_WAIT_L(n) asm volatile("s_waitcnt lgkmcnt(" #n ")" ::: "memory")
#define PG8_BAR __builtin_amdgcn_s_barrier()
#define PG8_SCHED __builtin_amdgcn_sched_barrier(0)
    Unit cur, nxt; int ui = 0;
    if (!S.next(0, cur)) return;
    f32x4 acc[2][2][4][2];
#pragma unroll
    for (int a = 0; a < 2; ++a)
#pragma unroll
        for (int b = 0; b < 2; ++b)
#pragma unroll
            for (int m = 0; m < 4; ++m)
#pragma unroll
                for (int n = 0; n < 2; ++n) acc[a][b][m][n] = (f32x4){0.f, 0.f, 0.f, 0.f};
    bf16x8 At[4][2], B0[2][2], B1[2][2];
    unsigned vA00, vA01, vA10, vA11, vN00, vN01, vN10, vN11;
    S.a_offs(cur, R, C, vA00, vA01, vA10, vA11);
    const char* cB0 = cur.b0; const char* cB1 = cur.b1;
    PG8_STAGEB(PG8_SB(0, 0), cB0); PG8_STAGEB(PG8_SB(0, 1), cB1); PG8_STAGE(PG8_SA(0, 0), Abase, vA00, vA01); PG8_STAGE(PG8_SA(0, 1), Abase, vA10, vA11);
    if (wr == 1) PG8_BAR;
    PG8_WAIT_V(2); PG8_BAR;
    PG8_STAGEB(PG8_SB(1, 0), cB0 + kstep); PG8_STAGE(PG8_SA(1, 0), Abase + kstep, vA00, vA01); PG8_STAGEB(PG8_SB(1, 1), cB1 + kstep);
    PG8_WAIT_V(6); PG8_BAR;
    for (;;) {
        const bool has_next = S.next(ui + 1, nxt);
        if (has_next) S.a_offs(nxt, R, C, vN00, vN01, vN10, vN11); else { vN00 = vA00; vN01 = vA01; vN10 = vA10; vN11 = vA11; }
        const char* nB0 = has_next ? nxt.b0 : cB0; const char* nB1 = has_next ? nxt.b1 : cB1;
        for (int t = 0; t < nt; t += 2) {
            const bool last = (t == nt - 2);
            const char* a1 = Abase + (size_t)(t + 1) * kstep;
            PG8_LDB(B0, 0, 0); PG8_LDB(B1, 0, 1); PG8_SCHED; PG8_LDA(At, 0, 0); PG8_STAGE(PG8_SA(1, 1), a1, vA10, vA11);
            PG8_WAIT_V(8); PG8_WAIT_L(0); PG8_BAR; PG8_MMA(0, 0, At, B0); PG8_MMA(0, 1, At, B1); PG8_BAR; PG8_SCHED;
            if (last) { vA00 = vN00; vA01 = vN01; vA10 = vN10; vA11 = vN11; }
            const char* a2 = last ? Abase : Abase + (size_t)(t + 2) * kstep;
            const char* b20 = last ? nB0 : cB0 + (size_t)(t + 2) * kstep; const char* b21 = last ? nB1 : cB1 + (size_t)(t + 2) * kstep;
            const char* a3 = a2 + kstep; const char* b30 = b20 + kstep; const char* b31 = b21 + kstep;
            PG8_LDA(At, 0, 1); PG8_STAGEB(PG8_SB(0, 0), b20); PG8_STAGEB(PG8_SB(0, 1), b21); PG8_STAGE(PG8_SA(0, 0), a2, vA00, vA01);
            PG8_WAIT_V(8); PG8_WAIT_L(0); PG8_BAR; PG8_MMA(1, 0, At, B0); PG8_MMA(1, 1, At, B1); PG8_BAR; PG8_SCHED;
            PG8_LDB(B0, 1, 0); PG8_LDB(B1, 1, 1); PG8_SCHED; PG8_LDA(At, 1, 0); PG8_STAGE(PG8_SA(0, 1), a2, vA10, vA11);
            PG8_WAIT_V(8); PG8_WAIT_L(0); PG8_BAR; PG8_MMA(0, 0, At, B0); PG8_MMA(0, 1, At, B1); PG8_BAR; PG8_SCHED;
            PG8_LDA(At, 1, 1); PG8_STAGEB(PG8_SB(1, 0), b30); PG8_STAGEB(PG8_SB(1, 1), b31); PG8_STAGE(PG8_SA(1, 0), a3, vA00, vA01);
            PG8_WAIT_V(8); PG8_WAIT_L(0); PG8_BAR; PG8_MMA(1, 0, At, B0); PG8_MMA(1, 1, At, B1); PG8_BAR; PG8_SCHED;
        }
        if (wr == 0) PG8_BAR;
        E(acc, cur, wr, wc, fr, fq);
        if (!has_next) break;
#pragma unroll
        for (int a = 0; a < 2; ++a)
#pragma unroll
            for (int b = 0; b < 2; ++b)
#pragma unroll
                for (int m = 0; m < 4; ++m)
#pragma unroll
                    for (int n = 0; n < 2; ++n) acc[a][b][m][n] = (f32x4){0.f, 0.f, 0.f, 0.f};
        cur = nxt; cB0 = nB0; cB1 = nB1; ++ui;
        if (wr == 1) PG8_BAR;
    }
    PG8_WAIT_V(0);
    PG8_BAR;
#undef PG8_SA
#undef PG8_SB
#undef PG8_STAGE
#undef PG8_STAGEB
#undef PG8_LDA
#undef PG8_LDB
#undef PG8_MMA
#undef PG8_WAIT_V
#undef PG8_WAIT_L
#undef PG8_BAR
#undef PG8_SCHED
}
}
#include <hip/hip_bf16.h>
#include <cmath>
namespace attn_body {
using bf16=__hip_bfloat16;
using bf16x8=__attribute__((ext_vector_type(8)))short;
using s16x4=__attribute__((ext_vector_type(4)))short;
using f32x16=__attribute__((ext_vector_type(16)))float;
using u32x4=__attribute__((ext_vector_type(4)))unsigned;
constexpr int D=64,DM=1024;
constexpr int NW=8,QBLK=32,QB=QBLK*NW,KVBLK=64;
constexpr int ATTN_PITCH=DM, ATTN_UNIT_ROWS=QB;
__device__ __forceinline__ int crow(int r,int hi){return (r&3)+8*(r>>2)+4*hi;}
#define SBAR() __builtin_amdgcn_sched_barrier(0)
__device__ __forceinline__ void cmask(f32x16&p0,f32x16&p1,int jb,int qrel,int hi){
  const float NEG=-INFINITY; int kb=64*jb+4*hi;
  #pragma unroll
  for(int r=0;r<16;++r){int kv=kb+(r&3)+8*(r>>2); if(kv>qrel)p0[r]=NEG; if(kv+32>qrel)p1[r]=NEG;}
}

constexpr int NSLOT=3, SLOTB=8192;
constexpr int LDS_K=0, LDS_V=NSLOT*SLOTB, LDS_WS=2*NSLOT*SLOTB, LDS_OST=LDS_WS+NW*64*4, LDS_BYTES=LDS_OST+NW*4096;
constexpr float C2=0.125f*1.4426950408889634f;
__device__ __forceinline__ void glds16(const void*gsrc,unsigned lds_dst){unsigned keep;
  asm volatile("s_mov_b32 %0, m0\n\ts_mov_b32 m0, %2\n\ts_nop 0\n\tglobal_load_lds_dwordx4 %1, off\n\ts_mov_b32 m0, %0":"=&s"(keep):"v"(gsrc),"s"(lds_dst):"memory");}
__device__ __forceinline__ void glds16s(const void*sbase,unsigned voff,unsigned lds_dst){unsigned keep;
  asm volatile("s_mov_b32 %0, m0\n\ts_mov_b32 m0, %3\n\ts_nop 4\n\tglobal_load_lds_dwordx4 %1, %2\n\ts_mov_b32 m0, %0":"=&s"(keep):"v"(voff),"s"(sbase),"s"(lds_dst):"memory");}
__device__ __forceinline__ float max3f(float a,float b,float c){float r;asm("v_max3_f32 %0, %1, %2, %3":"=v"(r):"v"(a),"v"(b),"v"(c));return r;}
__device__ __forceinline__ float max2f(float a,float b){float r;asm("v_max_f32_e32 %0, %1, %2":"=v"(r):"v"(a),"v"(b));return r;}
__device__ __forceinline__ float fadd_s(float a,float b){float r;asm("v_add_f32_e32 %0, %1, %2":"=v"(r):"v"(a),"v"(b));return r;}
__device__ __forceinline__ float fsub_s(float a,float b){float r;asm("v_sub_f32_e32 %0, %1, %2":"=v"(r):"v"(a),"v"(b));return r;}
typedef float f32x2_t __attribute__((ext_vector_type(2))); typedef __bf16 bf16x2_t __attribute__((ext_vector_type(2)));
__device__ __forceinline__ unsigned cvtpk_s(float lo,float hi){f32x2_t v={lo,hi};bf16x2_t b=__builtin_convertvector(v,bf16x2_t);return __builtin_bit_cast(unsigned,b);}
#define WAIT_BAR(N) asm volatile("s_waitcnt vmcnt(" #N ") lgkmcnt(0)\n\ts_barrier":::"memory")

__device__ __forceinline__ void qkt(f32x16&p0,f32x16&p1,const char*Kslot,const bf16x8*qr,const f32x16&negm,int r32,int hi){
  const char*kb=Kslot+hi*1024+r32*16;
  #pragma unroll
  for(int d0=0;d0<4;++d0){
    const bf16x8 b0=*reinterpret_cast<const bf16x8*>(kb+d0*2048);
    const bf16x8 b1=*reinterpret_cast<const bf16x8*>(kb+d0*2048+512);
    if(d0==0){p0=__builtin_amdgcn_mfma_f32_32x32x16_bf16(b0,qr[0],negm,0,0,0);p1=__builtin_amdgcn_mfma_f32_32x32x16_bf16(b1,qr[0],negm,0,0,0);}
    else{p0=__builtin_amdgcn_mfma_f32_32x32x16_bf16(b0,qr[d0],p0,0,0,0);p1=__builtin_amdgcn_mfma_f32_32x32x16_bf16(b1,qr[d0],p1,0,0,0);}}
}
typedef __attribute__((address_space(3))) const char* lds_cptr;
typedef short v4i16_t __attribute__((ext_vector_type(4)));
__device__ __forceinline__ void kload8(bf16x8*kf,lds_cptr kp){
  kf[0]=*(const __attribute__((address_space(3))) bf16x8*)(kp);      kf[1]=*(const __attribute__((address_space(3))) bf16x8*)(kp+512);
  kf[2]=*(const __attribute__((address_space(3))) bf16x8*)(kp+2048); kf[3]=*(const __attribute__((address_space(3))) bf16x8*)(kp+2560);
  kf[4]=*(const __attribute__((address_space(3))) bf16x8*)(kp+4096); kf[5]=*(const __attribute__((address_space(3))) bf16x8*)(kp+4608);
  kf[6]=*(const __attribute__((address_space(3))) bf16x8*)(kp+6144); kf[7]=*(const __attribute__((address_space(3))) bf16x8*)(kp+6656);
}
__device__ __forceinline__ void kload2(bf16x8*kf,lds_cptr kp,int j){ kf[2*j]=*(const __attribute__((address_space(3))) bf16x8*)(kp+j*2048); kf[2*j+1]=*(const __attribute__((address_space(3))) bf16x8*)(kp+j*2048+512); }
__device__ __forceinline__ s16x4 vtr(lds_cptr p){ return __builtin_bit_cast(s16x4,__builtin_amdgcn_ds_read_tr16_b64_v4i16((__attribute__((address_space(3))) v4i16_t*)p)); }
__device__ __forceinline__ float rowmax(const f32x16&p0,const f32x16&p1){
  float a=max3f(p0[0],p0[1],p1[0]),b=max3f(p0[2],p0[3],p1[1]);a=max3f(a,p1[2],p1[3]);
  #pragma unroll
  for(int r=4;r<16;r+=4){a=max3f(a,p0[r],p0[r+1]);b=max3f(b,p0[r+2],p0[r+3]);a=max3f(a,p1[r],p1[r+1]);b=max3f(b,p1[r+2],p1[r+3]);}
  const float m=max2f(a,b);
  auto rr=__builtin_amdgcn_permlane32_swap(__float_as_uint(m),__float_as_uint(m),false,false);
  return max2f(__uint_as_float(rr[0]),__uint_as_float(rr[1]));
}
__device__ __forceinline__ void pv(f32x16*o,int vb,bf16x8 pa0,bf16x8 pa1,bf16x8 pa2,bf16x8 pa3){
  #pragma unroll
  for(int d0=0;d0<2;++d0){s16x4 lo[4],hi[4];
    #pragma unroll
    for(int ks=0;ks<4;++ks){
      asm volatile("ds_read_b64_tr_b16 %0,%1 offset:%c2":"=&v"(lo[ks]):"v"(vb),"i"(d0*4096+ks*1024):"memory");
      asm volatile("ds_read_b64_tr_b16 %0,%1 offset:%c2":"=&v"(hi[ks]):"v"(vb),"i"(d0*4096+ks*1024+512):"memory");}
    asm volatile("s_waitcnt lgkmcnt(0)":::"memory");SBAR();
    #define PK(k) (bf16x8){lo[k][0],lo[k][1],lo[k][2],lo[k][3],hi[k][0],hi[k][1],hi[k][2],hi[k][3]}
    o[d0]=__builtin_amdgcn_mfma_f32_32x32x16_bf16(pa0,PK(0),o[d0],0,0,0);
    o[d0]=__builtin_amdgcn_mfma_f32_32x32x16_bf16(pa1,PK(1),o[d0],0,0,0);
    o[d0]=__builtin_amdgcn_mfma_f32_32x32x16_bf16(pa2,PK(2),o[d0],0,0,0);
    o[d0]=__builtin_amdgcn_mfma_f32_32x32x16_bf16(pa3,PK(3),o[d0],0,0,0);
    #undef PK
  }
}

#ifndef ATTN_STORE16
#define ATTN_STORE16(p,v) (*(u32x4*)(p)=(v))
#endif
template<int THRL> __device__ __forceinline__ void attn_unit(long rowbase,int qb,const bf16*Qc,const bf16*__restrict__ Kc,const bf16*__restrict__ Vc,bf16*Oc,char*shm){
  int tid_=threadIdx.x; asm volatile("":"+v"(tid_)); const int tid=tid_,lane=tid&63,r32=lane&31,hi=lane>>5; const int wid=__builtin_amdgcn_readfirstlane(tid>>6);
  const int q0=qb*QB;
  const bf16*Qw=Qc+(rowbase+q0+wid*QBLK)*DM;
  const bf16*Kh=Kc+rowbase*DM,*Vh=Vc+rowbase*DM;
  const unsigned lds0=(unsigned)(uintptr_t)shm;
  float*wsf=(float*)(shm+LDS_WS)+wid*64;
  const unsigned koff=(unsigned)(lane*DM+wid*8)*2u;
  const unsigned voffv=(unsigned)((16*(wid&3)+(lane>>2))*DM+(wid>>2)*32+(lane&3)*8)*2u;
  const unsigned kdst=lds0+LDS_K+wid*1024, vdst=lds0+LDS_V+wid*1024;
  #define DMA_K(t,slot) glds16s(Kh+(long)(t)*KVBLK*DM,koff,(unsigned)__builtin_amdgcn_readfirstlane(kdst+(slot)))
  #define DMA_V(t,slot) glds16s(Vh+(long)(t)*KVBLK*DM,voffv,(unsigned)__builtin_amdgcn_readfirstlane(vdst+(slot)))
  const int vb0=(int)(lds0+LDS_V)+((lane>>4)&1)*32+(lane&3)*8+(4*hi+((lane&15)>>2))*64;
  const char*Kbase=shm+LDS_K; bf16x8 kf[8];
  const lds_cptr shm3=(lds_cptr)shm; const lds_cptr kp0=shm3+LDS_K+hi*1024+r32*16; const lds_cptr vp0=shm3+LDS_V+((lane>>4)&1)*32+(lane&3)*8+(4*hi+((lane&15)>>2))*64;
  const int NT=(q0+QB)/KVBLK;
  DMA_K(0,0);DMA_V(0,0);DMA_K(1,SLOTB);
  bf16x8 qr[4];
  #pragma unroll
  for(int d0=0;d0<4;++d0)qr[d0]=*reinterpret_cast<const bf16x8*>(&Qw[(long)r32*DM+d0*16+hi*8]);
  float mhat=0.f,l_reg=0.f;f32x16 o[2];o[0]=f32x16{};o[1]=f32x16{};f32x16 negm=f32x16{};asm volatile("":"+v"(negm));
  const int qrel=wid*QBLK+r32;
  #define CMASK(P0,P1,t) do{int jb_=(t)-(NT-4); if(jb_>=0)cmask(P0,P1,jb_,qrel,hi);}while(0)
  bool resc=false;
  #define START(P0,P1) do{ const float rm=rowmax(P0,P1); resc=false; \
    { const float dl=rm; mhat=fadd_s(mhat,dl); \
      _Pragma("unroll") for(int r=0;r<16;++r){P0[r]=fsub_s(P0[r],dl);P1[r]=fsub_s(P1[r],dl);} \
      _Pragma("unroll") for(int r=0;r<16;++r)negm[r]=-mhat; asm volatile("":"+v"(negm)); } \
    _Pragma("unroll") for(int r=0;r<16;++r)P0[r]=__builtin_amdgcn_exp2f(P0[r]); }while(0)
  #define RESC() do{ if(resc){ asm volatile("s_waitcnt lgkmcnt(0)":::"memory"); \
      _Pragma("unroll") for(int d_=0;d_<2;++d_) _Pragma("unroll") for(int r=0;r<16;++r)o[d_][r]*=wsf[crow(r,hi)]; } }while(0)
  f32x16 pA0,pA1,pB0,pB1;
  int sl_prev=0,sl_cur=0,sl_next=SLOTB;
  #define ROT() do{sl_prev=sl_cur;sl_cur=sl_next;sl_next=(sl_next==(NSLOT-1)*SLOTB)?0:sl_next+SLOTB;}while(0)
  DMA_K(2,2*SLOTB);
  WAIT_BAR(3);
  qkt(pA0,pA1,Kbase,qr,negm,r32,hi);asm volatile("s_nop 15\n\ts_nop 7":"+v"(pA0),"+v"(pA1));CMASK(pA0,pA1,0);
  START(pA0,pA1);
  _Pragma("unroll") for(int r=0;r<16;++r)pA1[r]=__builtin_amdgcn_exp2f(pA1[r]);
  WAIT_BAR(0);
  DMA_K(3,0);DMA_V(1,SLOTB);
  ROT();
  kload8(kf,kp0+sl_cur);
  WAIT_BAR(2);
  s16x4 vlo[8],vhi[8]; u32x4 pw0,pw1,pw2,pw3;
  #define PKW(P,B) cvtpk_s(P[B],P[B+1])
  #define PAF(k) __builtin_bit_cast(bf16x8,pw##k)
  #define VFR(i) (bf16x8){vlo[i][0],vlo[i][1],vlo[i][2],vlo[i][3],vhi[i][0],vhi[i][1],vhi[i][2],vhi[i][3]}
  #define PIN(x) asm volatile("":"+v"(x))
  #define MX3(a,b,c) __builtin_fmaxf(__builtin_fmaxf((a),(b)),(c))
  #define GAPA(MF,A0,A1,A2,A3,W0,W1,PW) do{ MF; sacc+=A0; sacc+=A1; sacc+=A2; sacc+=A3; PIN(sacc); W0; W1; PIN(PW); SBAR(); }while(0)
  #define EX(v) __builtin_amdgcn_exp2f(v)
  #define GAPB(MF,X,B) do{ MF; X[B]=EX(X[B]); X[B+1]=EX(X[B+1]); X[B+2]=EX(X[B+2]); X[B+3]=EX(X[B+3]); PIN(X); SBAR(); }while(0)
  #define VRD(i) do{ vlo[i]=vtr(vp_+(((i)>>2)*4096+((i)&3)*1024)); vhi[i]=vtr(vp_+(((i)>>2)*4096+((i)&3)*1024+512)); }while(0)
  #define KRD(G,j) do{ if(G){ kload2(kf,kp0+sl_next,j); SBAR(); } }while(0)
  #define STEP(C0,C1,P0,P1,t,GK,GV,GL) do{ SBAR(); \
    const lds_cptr vp_=vp0+sl_prev; \
    VRD(0); SBAR(); float sacc=(P0[0]+P0[1]); \
    GAPA(C0=__builtin_amdgcn_mfma_f32_32x32x16_bf16(kf[0],qr[0],negm,0,0,0), P0[2],P0[3],P0[4],P0[5],     pw0[0]=PKW(P0,0), pw0[1]=PKW(P0,2), pw0); \
    VRD(4); SBAR(); GAPA(C1=__builtin_amdgcn_mfma_f32_32x32x16_bf16(kf[1],qr[0],negm,0,0,0), P0[6],P0[7],P0[8],P0[9],     pw0[2]=PKW(P0,4), pw0[3]=PKW(P0,6), pw0); \
    VRD(1); SBAR(); GAPA(C0=__builtin_amdgcn_mfma_f32_32x32x16_bf16(kf[2],qr[1],C0,0,0,0),   P0[10],P0[11],P0[12],P0[13], pw1[0]=PKW(P0,8), pw1[1]=PKW(P0,10), pw1); \
    VRD(5); SBAR(); GAPA(C1=__builtin_amdgcn_mfma_f32_32x32x16_bf16(kf[3],qr[1],C1,0,0,0),   P0[14],P0[15],P1[0],P1[1],   pw1[2]=PKW(P0,12),pw1[3]=PKW(P0,14), pw1); \
    VRD(2); SBAR(); GAPA(C0=__builtin_amdgcn_mfma_f32_32x32x16_bf16(kf[4],qr[2],C0,0,0,0),   P1[2],P1[3],P1[4],P1[5],     pw2[0]=PKW(P1,0), pw2[1]=PKW(P1,2), pw2); \
    VRD(6); SBAR(); GAPA(C1=__builtin_amdgcn_mfma_f32_32x32x16_bf16(kf[5],qr[2],C1,0,0,0),   P1[6],P1[7],P1[8],P1[9],     pw2[2]=PKW(P1,4), pw2[3]=PKW(P1,6), pw2); \
    VRD(3); SBAR(); GAPA(C0=__builtin_amdgcn_mfma_f32_32x32x16_bf16(kf[6],qr[3],C0,0,0,0),   P1[10],P1[11],P1[12],P1[13], pw3[0]=PKW(P1,8), pw3[1]=PKW(P1,10), pw3); \
    VRD(7); SBAR(); GAPA(C1=__builtin_amdgcn_mfma_f32_32x32x16_bf16(kf[7],qr[3],C1,0,0,0),   P1[14],P1[15],0.f,0.f,       pw3[2]=PKW(P1,12),pw3[3]=PKW(P1,14), pw3); \
    l_reg+=sacc; \
    if(GK){DMA_K((t)+3,sl_cur);} if(GV){DMA_V((t)+1,sl_next);} \
    CMASK(C0,C1,t); \
    { float a=MX3(C0[0],C0[1],C1[0]),b=MX3(C0[2],C0[3],C1[1]); a=MX3(a,C1[2],C1[3]); \
      _Pragma("unroll") for(int r=4;r<16;r+=4){a=MX3(a,C0[r],C0[r+1]);b=MX3(b,C0[r+2],C0[r+3]);a=MX3(a,C1[r],C1[r+1]);b=MX3(b,C1[r+2],C1[r+3]);} \
      float rm=__builtin_fmaxf(a,b); { auto rr=__builtin_amdgcn_permlane32_swap(__float_as_uint(rm),__float_as_uint(rm),false,false); rm=__builtin_fmaxf(__uint_as_float(rr[0]),__uint_as_float(rr[1])); } \
      resc=false; \
      if(__builtin_expect(__any(rm>(float)THRL),0)){ const float dl=__builtin_fmaxf(rm,0.f); mhat+=dl; \
        _Pragma("unroll") for(int r=0;r<16;++r){C0[r]-=dl;C1[r]-=dl;} \
        _Pragma("unroll") for(int r=0;r<16;++r)negm[r]=-mhat; asm volatile("":"+v"(negm)); \
        const float f=__builtin_amdgcn_exp2f(-dl); l_reg*=f; if(hi==0)wsf[r32]=f; resc=true; } } \
    SBAR(); \
    GAPB(o[0]=__builtin_amdgcn_mfma_f32_32x32x16_bf16(PAF(0),VFR(0),o[0],0,0,0), C0,0); \
    GAPB(o[1]=__builtin_amdgcn_mfma_f32_32x32x16_bf16(PAF(0),VFR(4),o[1],0,0,0), C0,4); \
    KRD(GL,0); GAPB(o[0]=__builtin_amdgcn_mfma_f32_32x32x16_bf16(PAF(1),VFR(1),o[0],0,0,0), C0,8); \
    KRD(GL,1); GAPB(o[1]=__builtin_amdgcn_mfma_f32_32x32x16_bf16(PAF(1),VFR(5),o[1],0,0,0), C0,12); \
    KRD(GL,2); GAPB(o[0]=__builtin_amdgcn_mfma_f32_32x32x16_bf16(PAF(2),VFR(2),o[0],0,0,0), C1,0); \
    KRD(GL,3); GAPB(o[1]=__builtin_amdgcn_mfma_f32_32x32x16_bf16(PAF(2),VFR(6),o[1],0,0,0), C1,4); \
    GAPB(o[0]=__builtin_amdgcn_mfma_f32_32x32x16_bf16(PAF(3),VFR(3),o[0],0,0,0), C1,8); \
    GAPB(o[1]=__builtin_amdgcn_mfma_f32_32x32x16_bf16(PAF(3),VFR(7),o[1],0,0,0), C1,12); \
    }while(0)
  int t=1;
  #undef CMASK
  #define CMASK(P0,P1,t) do{}while(0)
  for(;t+5<NT;t+=2){
    STEP(pB0,pB1,pA0,pA1,t,true,true,true);     WAIT_BAR(2); RESC(); ROT();
    STEP(pA0,pA1,pB0,pB1,t+1,true,true,true);   WAIT_BAR(2); RESC(); ROT();
  }
  #undef CMASK
  #define CMASK(P0,P1,t) do{int jb_=(t)-(NT-4); if(jb_>=0)cmask(P0,P1,jb_,qrel,hi);}while(0)
  #define ENDW(tt) do{ if((tt)+3<NT){WAIT_BAR(2);} else if((tt)+2<NT){WAIT_BAR(1);} else {WAIT_BAR(0);} }while(0)
  for(;t+1<NT;t+=2){
    STEP(pB0,pB1,pA0,pA1,t,(t+3<NT),(t+1<NT),(t+1<NT));       ENDW(t);   RESC(); ROT();
    STEP(pA0,pA1,pB0,pB1,t+1,(t+4<NT),(t+2<NT),(t+2<NT));     ENDW(t+1); RESC(); ROT();
  }
  STEP(pB0,pB1,pA0,pA1,NT-1,false,false,false); RESC();
  { float sacc=pB0[0]+pB0[1]; _Pragma("unroll") for(int r=2;r<16;++r)sacc+=pB0[r]; _Pragma("unroll") for(int r=0;r<16;++r)sacc+=pB1[r]; l_reg+=sacc;
    pw0=(u32x4){PKW(pB0,0),PKW(pB0,2),PKW(pB0,4),PKW(pB0,6)};pw1=(u32x4){PKW(pB0,8),PKW(pB0,10),PKW(pB0,12),PKW(pB0,14)};pw2=(u32x4){PKW(pB1,0),PKW(pB1,2),PKW(pB1,4),PKW(pB1,6)};pw3=(u32x4){PKW(pB1,8),PKW(pB1,10),PKW(pB1,12),PKW(pB1,14)};
    SBAR(); pv(o,vb0+sl_cur,PAF(0),PAF(1),PAF(2),PAF(3)); }
  #undef PKW
  #undef PAF
  #undef VFR
  #undef PIN
  #undef MX3
  #undef GAPA
  #undef GAPB
  #undef EX
  #undef VRD
  #undef KRD
  #undef STEP
  #undef ENDW
  {auto rr=__builtin_amdgcn_permlane32_swap(__float_as_uint(l_reg),__float_as_uint(l_reg),false,false);l_reg=__uint_as_float(rr[0])+__uint_as_float(rr[1]);}
  if(hi==0)wsf[32+r32]=l_reg;asm volatile("s_waitcnt lgkmcnt(0)":::"memory");
  float rli[16];
  #pragma unroll
  for(int r=0;r<16;++r)rli[r]=__builtin_amdgcn_rcpf(wsf[32+crow(r,hi)]);
  bf16*Ow=Oc+(rowbase+q0+wid*QBLK)*DM;
  { bf16*stg=(bf16*)(shm+LDS_OST)+wid*2048;
    #pragma unroll
    for(int r=0;r<16;++r){const int orow=crow(r,hi);
      #pragma unroll
      for(int d0=0;d0<2;++d0)stg[orow*64+d0*32+r32]=__float2bfloat16(o[d0][r]*rli[r]);}
    asm volatile("s_waitcnt lgkmcnt(0)":::"memory");
    #pragma unroll
    for(int i=0;i<4;++i){const int row=i*8+(lane>>3),ch=lane&7; const u32x4 v=*(const u32x4*)(stg+row*64+ch*8); ATTN_STORE16(Ow+(long)row*DM+ch*8,v);} }
  asm volatile("s_waitcnt lgkmcnt(0)\n\ts_barrier":::"memory");
  #undef DMA_K
  #undef DMA_V
  #undef CMASK
  #undef START
  #undef RESC
  #undef ROT
}
constexpr int ATTN_LDS_BYTES=LDS_BYTES;
#undef SBAR
#undef WAIT_BAR
}
namespace mk {
#define GAS __attribute__((address_space(1)))
#define LAS __attribute__((address_space(3)))
typedef unsigned short bf16;
typedef unsigned v4u __attribute__((ext_vector_type(4)));
typedef unsigned v2u __attribute__((ext_vector_type(2)));
typedef float f32x4 __attribute__((ext_vector_type(4)));
using pg8::Unit;
using pg8::cvt_pk_bf16;

constexpr int D = 1024, BATCH = 8, SEQ = 2048, T = BATCH * SEQ, NH = 8, NG = 4, EPG = 8, NE = 32, DE = 512, NRW = NG + NE;
constexpr float ALPHA = 1.4142135623730951f, LN_EPS = 1e-5f, RMS_EPS = 1e-5f;
constexpr float LAM_INIT = 0.35550906f;
constexpr float QSCALE = 0.125f * 1.4426950408889634f;
constexpr int CAP = 2 * T;
constexpr int NWAVES = 8, NTHREADS = 512;

constexpr size_t MiB = 1u << 20;
constexpr size_t WS_CTL = 0, WS_W1T = 1 * MiB, WS_W2T = 7 * MiB, WS_WKVQ = 9 * MiB, WS_WOT = 15 * MiB, WS_RWT = 17 * MiB, WS_PERM = 18 * MiB, WS_GATE = 22 * MiB;
constexpr size_t WS_WUT = 24 * MiB, WS_WDT = 152 * MiB, WS_XB = 216 * MiB, WS_GB = 248 * MiB, WS_U = 280 * MiB, WS_A2 = 312 * MiB, WS_Z = 344 * MiB, WS_X1B = 408 * MiB;
constexpr size_t WS_ACT = 440 * MiB, WS_YP = 480 * MiB, WS_X2B = 544 * MiB, WS_K = 576 * MiB, WS_V = 608 * MiB, WS_Q = 640 * MiB, WS_O0 = 672 * MiB, WS_O1 = 704 * MiB;
constexpr size_t WS_A3 = 736 * MiB, WS_X3B = 768 * MiB, WS_END = 800 * MiB;
constexpr int RING_BYTES = 131072, MISC_OFF = RING_BYTES, LDS_BYTES = 147456;

struct Args {
    const float *x, *a_w_in, *a_conv_w, *a_w_out, *kv_w, *b_w_q, *b_lambda, *b_subln_g, *b_w_o, *ln1_g, *ln1_b, *ln2_g, *ln2_b, *rg_w, *rg_b, *re_w, *re_b, *e_w_in, *e_w_down;
    float* out; unsigned char* ws;
};

typedef const __attribute__((address_space(4))) Args* ArgsP;
__device__ __forceinline__ ArgsP kargs() { ArgsP p = (ArgsP)__builtin_amdgcn_kernarg_segment_ptr(); asm volatile("" : "+s"(p)); return p; }
struct Ctx { int tid, lane, wave, G, bx, gw, NGW; unsigned char* ws; };
__device__ __forceinline__ Ctx mkctx(ArgsP ap) { Ctx c; int t = threadIdx.x; asm volatile("" : "+v"(t)); c.tid = t; c.lane = t & 63; c.wave = __builtin_amdgcn_readfirstlane(t >> 6);
    c.G = gridDim.x; c.bx = blockIdx.x; c.gw = c.bx * 8 + c.wave; c.NGW = c.G * 8; c.ws = ap->ws; return c; }
__device__ __forceinline__ unsigned f2bf(float f) { unsigned u = __builtin_bit_cast(unsigned, f); return (u + 0x7fffu + ((u >> 16) & 1u)) >> 16; }
__device__ __forceinline__ unsigned pk2(float lo, float hi) { return f2bf(lo) | (f2bf(hi) << 16); }
__device__ __forceinline__ float bflo(unsigned w) { return __builtin_bit_cast(float, w << 16); }
__device__ __forceinline__ float bfhi(unsigned w) { return __builtin_bit_cast(float, w & 0xffff0000u); }
__device__ __forceinline__ float wave_sum(float v) {
#pragma unroll
    for (int o = 1; o < 64; o <<= 1) v += __shfl_xor(v, o);
    return v;
}

__device__ __forceinline__ void p0_transpose_item(const float* W, int K, int N, bf16* WT, int row_off, LAS float* scr, int item, int lane) {
    const int nblk = N / 32, kb = item / nblk, nb = item % nblk, k0 = 64 * kb, n0 = 32 * nb;
#pragma unroll 8
    for (int i = 0; i < 32; ++i) { const int kk = 2 * i + (lane >> 5); scr[kk * 33 + (lane & 31)] = W[(size_t)(k0 + kk) * N + n0 + (lane & 31)]; }
    asm volatile("s_waitcnt lgkmcnt(0)" ::: "memory");
    const int c = lane & 7;
#pragma unroll
    for (int j = 0; j < 4; ++j) { const int n = (lane >> 3) + 8 * j; const LAS float* s = scr + (8 * c) * 33 + n;
        v4u o; o.x = pk2(s[0 * 33], s[1 * 33]); o.y = pk2(s[2 * 33], s[3 * 33]); o.z = pk2(s[4 * 33], s[5 * 33]); o.w = pk2(s[6 * 33], s[7 * 33]);
        *(GAS v4u*)(WT + (size_t)(row_off + n0 + n) * K + k0 + 8 * c) = o; }
    asm volatile("s_waitcnt lgkmcnt(0)" ::: "memory");
}

__device__ __forceinline__ void p0_prologue(LAS unsigned char* lds) {
    const ArgsP a = kargs(); const Ctx cx = mkctx(a); const int gw = cx.gw, NGW = cx.NGW, wave = cx.wave, lane = cx.lane;
    unsigned char* ws = cx.ws;
    LAS float* scr = (LAS float*)(lds + wave * 16384);
    constexpr int I_IN = 16 * 96, I_SQ = 16 * 32, I_KV = 16 * 64, I_DN = 8 * 32;
    constexpr int S1 = I_IN, S2 = S1 + I_SQ, S3 = S2 + I_KV, S4 = S3 + I_SQ, S5 = S4 + I_SQ, S6 = S5 + 64 * I_SQ, NITEMS = S6 + 64 * I_DN;
    for (int it = gw; it < NITEMS; it += NGW) {
        if (it < S1) p0_transpose_item(a->a_w_in, D, 3 * D, (bf16*)(ws + WS_W1T), 0, scr, it, lane);
        else if (it < S2) p0_transpose_item(a->a_w_out, D, D, (bf16*)(ws + WS_W2T), 0, scr, it - S1, lane);
        else if (it < S3) p0_transpose_item(a->kv_w, D, 2 * D, (bf16*)(ws + WS_WKVQ), 0, scr, it - S2, lane);
        else if (it < S4) p0_transpose_item(a->b_w_q, D, D, (bf16*)(ws + WS_WKVQ), 2 * D, scr, it - S3, lane);
        else if (it < S5) p0_transpose_item(a->b_w_o, D, D, (bf16*)(ws + WS_WOT), 0, scr, it - S4, lane);
        else if (it < S6) { const int r = it - S5, mtx = r / I_SQ; p0_transpose_item(a->e_w_in + (size_t)mtx * D * D, D, D, (bf16*)(ws + WS_WUT) + (size_t)mtx * D * D, 0, scr, r % I_SQ, lane); }
        else { const int r = it - S6, mtx = r / I_DN; p0_transpose_item(a->e_w_down + (size_t)mtx * DE * D, DE, D, (bf16*)(ws + WS_WDT) + (size_t)mtx * D * DE, 0, scr, r % I_DN, lane); }
    }
    for (int m = gw; m < T; m += NGW) {
        const GAS f32x4* xr = (const GAS f32x4*)(a->x + (size_t)m * D) + lane;
        GAS v2u* o = (GAS v2u*)((bf16*)(ws + WS_XB) + (size_t)m * D) + lane;
#pragma unroll
        for (int j = 0; j < 4; ++j) { const f32x4 v = xr[64 * j]; v2u w; w.x = pk2(v.x, v.y); w.y = pk2(v.z, v.w); o[64 * j] = w; }
    }
    { float* rwt = (float*)(ws + WS_RWT);
      for (int idx = gw * 64 + lane; idx < 2 * NRW * D; idx += NGW * 64) { const int l = idx / (NRW * D), n = (idx / D) % NRW, k = idx % D;
          rwt[idx] = n < NG ? a->rg_w[((size_t)l * D + k) * NG + n] : a->re_w[((size_t)l * D + k) * NE + (n - NG)]; } }
    if (gw == 0) { ((int*)(ws + WS_CTL))[lane] = 0; }
}

struct SchedDense {
    int G, c, nN, mode, K; const char* W;
    __device__ __forceinline__ bool next(int i, Unit& u) const {
        int pm, pn; if (!pg8::static_tile(i, G, c, T / 256, nN, pm, pn)) return false;
        u.arow = pm * 256; u.p0 = pm; u.p1 = pn; u.p2 = 0;
        const size_t rb = (size_t)K * 2;
        if (mode == 0 && pn >= 4) { const int jj = pn - 4; u.b0 = W + (size_t)(D + 128 * jj) * rb; u.b1 = W + (size_t)(2 * D + 128 * jj) * rb; }
        else { u.b0 = W + (size_t)(256 * pn) * rb; u.b1 = u.b0 + 128 * rb; }
        return true;
    }
    __device__ __forceinline__ void a_offs(const Unit& u, const int (&R)[2], const int (&C)[2], unsigned& v00, unsigned& v01, unsigned& v10, unsigned& v11) const {
        v00 = (unsigned)((u.arow + R[0]) * K + C[0]) * 2u; v01 = (unsigned)((u.arow + R[1]) * K + C[1]) * 2u;
        v10 = (unsigned)((u.arow + 128 + R[0]) * K + C[0]) * 2u; v11 = (unsigned)((u.arow + 128 + R[1]) * K + C[1]) * 2u;
    }
};
struct MoeTab { const LAS int* ub; const LAS int* ps; const LAS int* cn; };
struct SchedMoe {
    int G, c, K; bool up; const char* W; const int* perm; MoeTab tb;
    __device__ __forceinline__ bool next(int i, Unit& u) const {
        const int idx = i * G + c; if (idx >= tb.ub[NE]) return false;
        int e = 0;
#pragma unroll 1
        for (int k = 1; k < NE; ++k) if (idx >= tb.ub[k]) e = k;
        const int local = idx - tb.ub[e], rtn = (tb.ub[e + 1] - tb.ub[e]) >> 2, ct = local / rtn, rti = local - ct * rtn;
        const size_t rb = (size_t)K * 2; const char* We = W + (size_t)e * D * rb;
        if (up) { u.b0 = We + (size_t)(128 * ct) * rb; u.b1 = We + (size_t)(DE + 128 * ct) * rb; u.arow = e * CAP + rti * 256; u.p0 = tb.ps[e] + rti * 256; }
        else { u.b0 = We + (size_t)(256 * ct) * rb; u.b1 = u.b0 + 128 * rb; u.arow = tb.ps[e] + rti * 256; u.p0 = e * CAP + rti * 256; }
        u.p1 = ct; u.p2 = tb.cn[e] - rti * 256;
        return true;
    }
    __device__ __forceinline__ void a_offs(const Unit& u, const int (&R)[2], const int (&C)[2], unsigned& v00, unsigned& v01, unsigned& v10, unsigned& v11) const {
        if (up) {
            const int r00 = R[0] < u.p2 ? R[0] : 0, r01 = R[1] < u.p2 ? R[1] : 0, r10 = 128 + R[0] < u.p2 ? 128 + R[0] : 0, r11 = 128 + R[1] < u.p2 ? 128 + R[1] : 0;
            const int t00 = perm[u.arow + r00] >> 1, t01 = perm[u.arow + r01] >> 1, t10 = perm[u.arow + r10] >> 1, t11 = perm[u.arow + r11] >> 1;
            v00 = (unsigned)(t00 * K + C[0]) * 2u; v01 = (unsigned)(t01 * K + C[1]) * 2u; v10 = (unsigned)(t10 * K + C[0]) * 2u; v11 = (unsigned)(t11 * K + C[1]) * 2u;
        } else {
            v00 = (unsigned)((u.arow + R[0]) * K + C[0]) * 2u; v01 = (unsigned)((u.arow + R[1]) * K + C[1]) * 2u;
            v10 = (unsigned)((u.arow + 128 + R[0]) * K + C[0]) * 2u; v11 = (unsigned)((u.arow + 128 + R[1]) * K + C[1]) * 2u;
        }
    }
};

struct EpiConvIn {
    static constexpr bool PERM = true; bf16* GB; bf16* U;
    __device__ __forceinline__ void operator()(const f32x4 (&acc)[2][2][4][2], const Unit& u, int wr, int wc, int fr, int fq) const {
        const int row0 = u.p0 * 256 + wr * 64 + fr;
        if (u.p1 < 4) {
            const int col0 = u.p1 * 256 + wc * 32 + 8 * fq;
#pragma unroll
            for (int ai = 0; ai < 2; ++ai)
#pragma unroll
                for (int m = 0; m < 4; ++m) { bf16* rowp = GB + (size_t)(row0 + ai * 128 + m * 16) * D + col0;
#pragma unroll
                    for (int bj = 0; bj < 2; ++bj) { const f32x4 v0 = acc[ai][bj][m][0], v1 = acc[ai][bj][m][1];
                        v4u w; w.x = cvt_pk_bf16(v0[0], v0[1]); w.y = cvt_pk_bf16(v0[2], v0[3]); w.z = cvt_pk_bf16(v1[0], v1[1]); w.w = cvt_pk_bf16(v1[2], v1[3]);
                        *(v4u*)(rowp + bj * 128) = w; } }
        } else {
            const int col0 = (u.p1 - 4) * 128 + wc * 32 + 8 * fq;
#pragma unroll
            for (int ai = 0; ai < 2; ++ai)
#pragma unroll
                for (int m = 0; m < 4; ++m) { const f32x4 v0 = acc[ai][0][m][0] * acc[ai][1][m][0], v1 = acc[ai][0][m][1] * acc[ai][1][m][1];
                    v4u w; w.x = cvt_pk_bf16(v0[0], v0[1]); w.y = cvt_pk_bf16(v0[2], v0[3]); w.z = cvt_pk_bf16(v1[0], v1[1]); w.w = cvt_pk_bf16(v1[2], v1[3]);
                    *(v4u*)(U + (size_t)(row0 + ai * 128 + m * 16) * D + col0) = w; }
        }
    }
};
template <bool RES_BF16> struct EpiResZ {
    static constexpr bool PERM = false; const void* res; float* Z;
    __device__ __forceinline__ void operator()(const f32x4 (&acc)[2][2][4][2], const Unit& u, int wr, int wc, int fr, int fq) const {
        const int row0 = u.p0 * 256 + wr * 64 + fr, col0 = u.p1 * 256 + wc * 32 + 4 * fq;
#pragma unroll
        for (int ai = 0; ai < 2; ++ai)
#pragma unroll
            for (int m = 0; m < 4; ++m) { const size_t off = (size_t)(row0 + ai * 128 + m * 16) * D + col0;
#pragma unroll
                for (int bj = 0; bj < 2; ++bj)
#pragma unroll
                    for (int n = 0; n < 2; ++n) { const size_t o = off + bj * 128 + n * 16; f32x4 r;
                        if (RES_BF16) { const v2u w = *(const v2u*)((const bf16*)res + o); r = (f32x4){bflo(w.x), bfhi(w.x), bflo(w.y), bfhi(w.y)}; }
                        else r = *(const f32x4*)((const float*)res + o);
                        *(f32x4*)(Z + o) = r * ALPHA + acc[ai][bj][m][n]; } }
    }
};
struct EpiUp {
    static constexpr bool PERM = true; bf16* ACT;
    __device__ __forceinline__ void operator()(const f32x4 (&acc)[2][2][4][2], const Unit& u, int wr, int wc, int fr, int fq) const {
        const int row0 = u.p0 + wr * 64 + fr, col0 = u.p1 * 128 + wc * 32 + 8 * fq;
#pragma unroll
        for (int ai = 0; ai < 2; ++ai)
#pragma unroll
            for (int m = 0; m < 4; ++m) { f32x4 v[2];
#pragma unroll
                for (int n = 0; n < 2; ++n) { const f32x4 g = acc[ai][0][m][n], uu = acc[ai][1][m][n];
#pragma unroll
                    for (int j = 0; j < 4; ++j) { const float e = __builtin_amdgcn_exp2f(g[j] * -1.4426950408889634f); v[n][j] = g[j] * __builtin_amdgcn_rcpf(1.0f + e) * uu[j]; } }
                v4u w; w.x = cvt_pk_bf16(v[0][0], v[0][1]); w.y = cvt_pk_bf16(v[0][2], v[0][3]); w.z = cvt_pk_bf16(v[1][0], v[1][1]); w.w = cvt_pk_bf16(v[1][2], v[1][3]);
                *(v4u*)(ACT + (size_t)(row0 + ai * 128 + m * 16) * DE + col0) = w; }
    }
};
struct EpiDown {
    static constexpr bool PERM = true; bf16* YP; const int* perm; const float* gate;
    __device__ __forceinline__ void operator()(const f32x4 (&acc)[2][2][4][2], const Unit& u, int wr, int wc, int fr, int fq) const {
        const int col0 = u.p1 * 256 + wc * 32 + 8 * fq;
#pragma unroll
        for (int ai = 0; ai < 2; ++ai)
#pragma unroll
            for (int m = 0; m < 4; ++m) { const int r = ai * 128 + wr * 64 + m * 16 + fr;
                if (r < u.p2) { const int pair = perm[u.p0 + r]; const float g = gate[pair]; bf16* rowp = YP + (size_t)pair * D + col0;
#pragma unroll
                    for (int bj = 0; bj < 2; ++bj) { const f32x4 v0 = acc[ai][bj][m][0] * g, v1 = acc[ai][bj][m][1] * g;
                        v4u w; w.x = cvt_pk_bf16(v0[0], v0[1]); w.y = cvt_pk_bf16(v0[2], v0[3]); w.z = cvt_pk_bf16(v1[0], v1[1]); w.w = cvt_pk_bf16(v1[2], v1[3]);
                        *(v4u*)(rowp + bj * 128) = w; } } }
    }
};
struct EpiKVQ {
    static constexpr bool PERM = true; bf16* KB;
    __device__ __forceinline__ void operator()(const f32x4 (&acc)[2][2][4][2], const Unit& u, int wr, int wc, int fr, int fq) const {
        const int t = u.p1 >> 2; const float sc = t == 2 ? QSCALE : 1.0f;
        bf16* base = KB + (size_t)t * (32 * MiB / 2);
        const int row0 = u.p0 * 256 + wr * 64 + fr, col0 = (u.p1 & 3) * 256 + wc * 32 + 8 * fq;
#pragma unroll
        for (int ai = 0; ai < 2; ++ai)
#pragma unroll
            for (int m = 0; m < 4; ++m) { bf16* rowp = base + (size_t)(row0 + ai * 128 + m * 16) * D + col0;
#pragma unroll
                for (int bj = 0; bj < 2; ++bj) { const f32x4 v0 = acc[ai][bj][m][0] * sc, v1 = acc[ai][bj][m][1] * sc;
                    v4u w; w.x = cvt_pk_bf16(v0[0], v0[1]); w.y = cvt_pk_bf16(v0[2], v0[3]); w.z = cvt_pk_bf16(v1[0], v1[1]); w.w = cvt_pk_bf16(v1[2], v1[3]);
                    *(v4u*)(rowp + bj * 128) = w; } }
    }
};

__device__ __forceinline__ void ln_rows(f32x4 (&v)[4], const float* g, const float* b, int lane) {
    float s = 0.f;
#pragma unroll
    for (int j = 0; j < 4; ++j) s += (v[j].x + v[j].y) + (v[j].z + v[j].w);
    const float mean = wave_sum(s) * (1.f / D); float s2 = 0.f;
#pragma unroll
    for (int j = 0; j < 4; ++j) { v[j] = v[j] - mean; s2 += (v[j].x * v[j].x + v[j].y * v[j].y) + (v[j].z * v[j].z + v[j].w * v[j].w); }
    const float rstd = 1.f / sqrtf(wave_sum(s2) * (1.f / D) + LN_EPS);
#pragma unroll
    for (int j = 0; j < 4; ++j) { const f32x4 gg = *(const f32x4*)(g + 256 * j + 4 * lane), bb = *(const f32x4*)(b + 256 * j + 4 * lane); v[j] = v[j] * rstd * gg + bb; }
}
__device__ __forceinline__ float dot_row(const f32x4 (&v)[4], const float* w, int lane) {
    float a = 0.f;
#pragma unroll
    for (int j = 0; j < 4; ++j) { const f32x4 ww = *(const f32x4*)(w + 256 * j + 4 * lane); a += (v[j].x * ww.x + v[j].y * ww.y) + (v[j].z * ww.z + v[j].w * ww.w); }
    return wave_sum(a);
}
__device__ __forceinline__ void ln_router_phase(int layer) {
    const ArgsP a = kargs(); const Ctx cx = mkctx(a); const int gw = cx.gw, NGW = cx.NGW, lane = cx.lane;
    unsigned char* ws = cx.ws;
    const float* Z = (const float*)(ws + WS_Z); bf16* Xb = (bf16*)(ws + (layer == 0 ? WS_X1B : WS_X3B));
    const float* g = a->ln1_g + layer * D; const float* b = a->ln1_b + layer * D;
    const float* rwt = (const float*)(ws + WS_RWT) + (size_t)layer * NRW * D;
    const float* rgb = a->rg_b + layer * NG; const float* reb = a->re_b + layer * NE;
    int* cnt = (int*)(ws + WS_CTL) + layer * NE; int* perm = (int*)(ws + WS_PERM); float* gate = (float*)(ws + WS_GATE);
    for (int row = gw; row < T; row += NGW) {
        f32x4 v[4];
#pragma unroll
        for (int j = 0; j < 4; ++j) v[j] = *(const f32x4*)(Z + (size_t)row * D + 256 * j + 4 * lane);
        ln_rows(v, g, b, lane);
#pragma unroll
        for (int j = 0; j < 4; ++j) { v2u w; w.x = pk2(v[j].x, v[j].y); w.y = pk2(v[j].z, v[j].w); *(v2u*)(Xb + (size_t)row * D + 256 * j + 4 * lane) = w; }
        float gl[NG];
#pragma unroll
        for (int n = 0; n < NG; ++n) gl[n] = dot_row(v, rwt + n * D, lane) + rgb[n];
        int gi = 0; float gm = gl[0];
#pragma unroll
        for (int n = 1; n < NG; ++n) if (gl[n] > gm) { gm = gl[n]; gi = n; }
        float gs = 0.f;
#pragma unroll
        for (int n = 0; n < NG; ++n) gs += __expf(gl[n] - gm);
        const float gtop = 1.0f / gs;
        gi = __builtin_amdgcn_readfirstlane(gi);
        float m0 = -INFINITY, m1 = -INFINITY; int i0 = 0, i1 = 0;
#pragma unroll
        for (int n = 0; n < EPG; ++n) { const float el = dot_row(v, rwt + (NG + gi * EPG + n) * D, lane) + reb[gi * EPG + n];
            if (el > m0) { m1 = m0; i1 = i0; m0 = el; i0 = n; } else if (el > m1) { m1 = el; i1 = n; } }
        const float e1 = __expf(m1 - m0), w0 = 1.0f / (1.0f + e1), w1 = e1 * w0;
        if (lane == 0) {
            const int ea = gi * EPG + i0, eb = gi * EPG + i1;
            const int sa = atomicAdd(&cnt[ea], 1), sb = atomicAdd(&cnt[eb], 1);
            perm[ea * CAP + sa] = 2 * row; perm[eb * CAP + sb] = 2 * row + 1;
            gate[2 * row] = gtop * w0; gate[2 * row + 1] = gtop * w1;
        }
    }
}
__device__ __forceinline__ void ln2_phase(int layer) {
    const ArgsP a = kargs(); const Ctx cx = mkctx(a); const int gw = cx.gw, NGW = cx.NGW, lane = cx.lane;
    unsigned char* ws = cx.ws;
    const bf16* Xin = (const bf16*)(ws + (layer == 0 ? WS_X1B : WS_X3B)); const bf16* YP = (const bf16*)(ws + WS_YP);
    const float* g = a->ln2_g + layer * D; const float* b = a->ln2_b + layer * D;
    for (int row = gw; row < T; row += NGW) {
        f32x4 v[4];
#pragma unroll
        for (int j = 0; j < 4; ++j) { const size_t c = 256 * j + 4 * lane;
            const v2u xw = *(const v2u*)(Xin + (size_t)row * D + c), y0 = *(const v2u*)(YP + (size_t)(2 * row) * D + c), y1 = *(const v2u*)(YP + (size_t)(2 * row + 1) * D + c);
            v[j].x = ALPHA * bflo(xw.x) + (bflo(y0.x) + bflo(y1.x)); v[j].y = ALPHA * bfhi(xw.x) + (bfhi(y0.x) + bfhi(y1.x));
            v[j].z = ALPHA * bflo(xw.y) + (bflo(y0.y) + bflo(y1.y)); v[j].w = ALPHA * bfhi(xw.y) + (bfhi(y0.y) + bfhi(y1.y)); }
        ln_rows(v, g, b, lane);
        if (layer == 0) {
#pragma unroll
            for (int j = 0; j < 4; ++j) { v2u w; w.x = pk2(v[j].x, v[j].y); w.y = pk2(v[j].z, v[j].w); *(v2u*)((bf16*)(ws + WS_X2B) + (size_t)row * D + 256 * j + 4 * lane) = w; }
        } else {
#pragma unroll
            for (int j = 0; j < 4; ++j) *(f32x4*)(a->out + (size_t)row * D + 256 * j + 4 * lane) = v[j];
        }
    }
}
__device__ __forceinline__ void conv_phase() {
    const ArgsP a = kargs(); const Ctx cx = mkctx(a); const int gtid = cx.bx * NTHREADS + cx.tid, NGT = cx.G * NTHREADS;
    unsigned char* ws = cx.ws;
    const bf16* GB = (const bf16*)(ws + WS_GB); const bf16* U = (const bf16*)(ws + WS_U); bf16* A2 = (bf16*)(ws + WS_A2);
    for (int it = gtid; it < T * (D / 8); it += NGT) {
        const int t = it >> 7, d0 = (it & 127) * 8, s = t & (SEQ - 1);
        const size_t o = (size_t)t * D + d0;
        const v4u g = *(const v4u*)(GB + o), u0 = *(const v4u*)(U + o);
        v4u u1 = (v4u){0u, 0u, 0u, 0u}, u2 = u1;
        if (s >= 1) u1 = *(const v4u*)(U + o - D);
        if (s >= 2) u2 = *(const v4u*)(U + o - 2 * D);
        v4u r;
#pragma unroll
        for (int q = 0; q < 4; ++q) {
            const int d = d0 + 2 * q;
            const float c0 = a->a_conv_w[d] * bflo(u2[q]) + a->a_conv_w[D + d] * bflo(u1[q]) + a->a_conv_w[2 * D + d] * bflo(u0[q]);
            const float c1 = a->a_conv_w[d + 1] * bfhi(u2[q]) + a->a_conv_w[D + d + 1] * bfhi(u1[q]) + a->a_conv_w[2 * D + d + 1] * bfhi(u0[q]);
            r[q] = pk2(bflo(g[q]) * c0, bfhi(g[q]) * c1);
        }
        *(v4u*)(A2 + o) = r;
    }
}
__device__ __forceinline__ void combine_phase() {
    const ArgsP a = kargs(); const Ctx cx = mkctx(a); const int gw = cx.gw, NGW = cx.NGW, lane = cx.lane;
    unsigned char* ws = cx.ws;
    const bf16* O0 = (const bf16*)(ws + WS_O0); const bf16* O1 = (const bf16*)(ws + WS_O1); bf16* A3 = (bf16*)(ws + WS_A3);
    const float l01 = wave_sum(a->b_lambda[lane] * a->b_lambda[64 + lane]), l23 = wave_sum(a->b_lambda[128 + lane] * a->b_lambda[192 + lane]);
    const float lam = __expf(l01) - __expf(l23) + LAM_INIT;
    float gsc[16];
#pragma unroll
    for (int i = 0; i < 16; ++i) gsc[i] = a->b_subln_g[(lane & 7) * 16 + i] * (1.0f - LAM_INIT);
    for (int row = gw; row < T; row += NGW) {
        const size_t o = (size_t)row * D + lane * 16;
        const v4u p0 = *(const v4u*)(O0 + o), p1 = *(const v4u*)(O0 + o + 8), q0 = *(const v4u*)(O1 + o), q1 = *(const v4u*)(O1 + o + 8);
        float d[16]; float ss = 0.f;
#pragma unroll
        for (int i = 0; i < 4; ++i) { d[2 * i] = bflo(p0[i]) - lam * bflo(q0[i]); d[2 * i + 1] = bfhi(p0[i]) - lam * bfhi(q0[i]);
            d[8 + 2 * i] = bflo(p1[i]) - lam * bflo(q1[i]); d[8 + 2 * i + 1] = bfhi(p1[i]) - lam * bfhi(q1[i]); }
#pragma unroll
        for (int i = 0; i < 16; ++i) ss += d[i] * d[i];
        ss += __shfl_xor(ss, 1); ss += __shfl_xor(ss, 2); ss += __shfl_xor(ss, 4);
        const float r = 1.0f / sqrtf(ss * (1.0f / 128.0f) + RMS_EPS);
        v4u w0, w1;
#pragma unroll
        for (int i = 0; i < 4; ++i) { w0[i] = pk2(d[2 * i] * r * gsc[2 * i], d[2 * i + 1] * r * gsc[2 * i + 1]); w1[i] = pk2(d[8 + 2 * i] * r * gsc[8 + 2 * i], d[8 + 2 * i + 1] * r * gsc[8 + 2 * i + 1]); }
        *(v4u*)(A3 + o) = w0; *(v4u*)(A3 + o + 8) = w1;
    }
}

#ifndef MKMASK
#define MKMASK 0xffff
#endif
#define PH(k) if constexpr ((MKMASK >> (k)) & 1)
__device__ __forceinline__ void gemm1_phase(LAS unsigned char* lds) { const ArgsP a = kargs(); const Ctx cx = mkctx(a); unsigned char* ws = cx.ws;
    SchedDense S{cx.G, cx.bx, 12, 0, D, (const char*)(ws + WS_W1T)}; EpiConvIn E{(bf16*)(ws + WS_GB), (bf16*)(ws + WS_U)};
    pg8::gemm_phase(lds, (const char*)(ws + WS_XB), D, S, E); }
__device__ __forceinline__ void gemm2_phase(LAS unsigned char* lds) { const ArgsP a = kargs(); const Ctx cx = mkctx(a); unsigned char* ws = cx.ws;
    SchedDense S{cx.G, cx.bx, 4, 1, D, (const char*)(ws + WS_W2T)}; EpiResZ<false> E{(const void*)a->x, (float*)(ws + WS_Z)};
    pg8::gemm_phase(lds, (const char*)(ws + WS_A2), D, S, E); }
__device__ __forceinline__ void kvq_phase(LAS unsigned char* lds) { const ArgsP a = kargs(); const Ctx cx = mkctx(a); unsigned char* ws = cx.ws;
    SchedDense S{cx.G, cx.bx, 12, 1, D, (const char*)(ws + WS_WKVQ)}; EpiKVQ E{(bf16*)(ws + WS_K)};
    pg8::gemm_phase(lds, (const char*)(ws + WS_X2B), D, S, E); }
__device__ __forceinline__ void wo_phase(LAS unsigned char* lds) { const ArgsP a = kargs(); const Ctx cx = mkctx(a); unsigned char* ws = cx.ws;
    SchedDense S{cx.G, cx.bx, 4, 1, D, (const char*)(ws + WS_WOT)}; EpiResZ<true> E{(const void*)(ws + WS_X2B), (float*)(ws + WS_Z)};
    pg8::gemm_phase(lds, (const char*)(ws + WS_A3), D, S, E); }
__device__ __forceinline__ void attn_phase(char* lds_generic) { const ArgsP a = kargs(); const Ctx cx = mkctx(a); unsigned char* ws = cx.ws;
#pragma unroll 1
    for (int uix = cx.bx; uix < BATCH * NH * 4 * (SEQ / 256); uix += cx.G) {
        const int combo = uix & 255, qi = uix >> 8;
        const int b = combo >> 5, h = (combo >> 2) & 7, c = (combo >> 1) & 1, vh = combo & 1;
        const int qb = (qi & 1) ? (SEQ / 256 - 1 - (qi >> 1)) : (qi >> 1);
        const attn_body::bf16* QK = (const attn_body::bf16*)(ws + WS_K) + h * 128 + c * 64;
        const attn_body::bf16* Vc = (const attn_body::bf16*)(ws + WS_V) + h * 128 + vh * 64;
        attn_body::bf16* Oc = (attn_body::bf16*)(ws + (c ? WS_O1 : WS_O0)) + h * 128 + vh * 64;
        attn_body::attn_unit<8>((long)b * SEQ, qb, QK + (WS_Q - WS_K) / 2, QK, Vc, Oc, lds_generic);
    }
}
__device__ __forceinline__ void moe_tables(LAS unsigned char* lds, int layer) { const ArgsP a = kargs(); const Ctx cx = mkctx(a); LAS int* misc = (LAS int*)(lds + MISC_OFF);
    const int* cnt = (const int*)(cx.ws + WS_CTL) + layer * NE;
    if (cx.tid < NE) misc[128 + cx.tid] = __hip_atomic_load(cnt + cx.tid, __ATOMIC_RELAXED, __HIP_MEMORY_SCOPE_AGENT);
    __syncthreads();
    if (cx.tid == 0) { int ub = 0, ps = 0; for (int e = 0; e < NE; ++e) { misc[e] = ub; misc[64 + e] = ps; const int rt = (misc[128 + e] + 255) >> 8; ub += 4 * rt; ps += 256 * rt; } misc[NE] = ub; misc[64 + NE] = ps; }
    __syncthreads(); }
__device__ __forceinline__ void moe_up_phase(LAS unsigned char* lds, int layer) { const ArgsP a = kargs(); const Ctx cx = mkctx(a); unsigned char* ws = cx.ws; LAS int* misc = (LAS int*)(lds + MISC_OFF);
    const MoeTab tb{misc, misc + 64, misc + 128};
    SchedMoe S{cx.G, cx.bx, D, true, (const char*)(ws + WS_WUT) + (size_t)layer * NE * D * D * 2, (const int*)(ws + WS_PERM), tb}; EpiUp E{(bf16*)(ws + WS_ACT)};
    pg8::gemm_phase(lds, (const char*)(ws + (layer == 0 ? WS_X1B : WS_X3B)), D, S, E); }
__device__ __forceinline__ void moe_down_phase(LAS unsigned char* lds, int layer) { const ArgsP a = kargs(); const Ctx cx = mkctx(a); unsigned char* ws = cx.ws; LAS int* misc = (LAS int*)(lds + MISC_OFF);
    const MoeTab tb{misc, misc + 64, misc + 128};
    SchedMoe S{cx.G, cx.bx, DE, false, (const char*)(ws + WS_WDT) + (size_t)layer * NE * D * DE * 2, (const int*)(ws + WS_PERM), tb};
    EpiDown E{(bf16*)(ws + WS_YP), (const int*)(ws + WS_PERM), (const float*)(ws + WS_GATE)};
    pg8::gemm_phase(lds, (const char*)(ws + WS_ACT), DE, S, E); }

__global__ void __launch_bounds__(NTHREADS, 2) fwd_megakernel(Args args_unused) {
    extern __shared__ __attribute__((aligned(16))) unsigned char lds_raw[];
#ifdef NOSYNC
    struct { __device__ void sync() const {} } grid;
#else
    cg::grid_group grid = cg::this_grid();
#endif
    LAS unsigned char* lds = (LAS unsigned char*)lds_raw;
    PH(0) p0_prologue(lds);
    grid.sync();
    PH(1) gemm1_phase(lds);
    grid.sync();
    PH(2) conv_phase();
    grid.sync();
    PH(3) gemm2_phase(lds);
    grid.sync();
    PH(8) ln_router_phase(0);
    grid.sync();
    moe_tables(lds, 0);
    PH(9) moe_up_phase(lds, 0);
    grid.sync();
    PH(10) moe_down_phase(lds, 0);
    grid.sync();
    PH(11) ln2_phase(0);
    grid.sync();
    PH(4) kvq_phase(lds);
    grid.sync();
    PH(5) attn_phase((char*)lds_raw);
    grid.sync();
    PH(6) combine_phase();
    grid.sync();
    PH(7) wo_phase(lds);
    grid.sync();
    PH(8) ln_router_phase(1);
    grid.sync();
    moe_tables(lds, 1);
    PH(9) moe_up_phase(lds, 1);
    grid.sync();
    PH(10) moe_down_phase(lds, 1);
    grid.sync();
    PH(11) ln2_phase(1);
}
}

extern "C" void kernel_launch(void* const* d_in, const int* in_sizes, int n_in, void* d_out, int out_size, void* d_ws, size_t ws_size, hipStream_t stream) {
    using namespace mk;
    static int grid = 0;
    if (grid == 0) {
        if (n_in != 19 || out_size != T * D || ws_size < WS_END) { fprintf(stderr, "kernel_launch: unexpected shapes / workspace (n_in %d out %d ws %zu, need %zu)\n", n_in, out_size, ws_size, (size_t)WS_END); grid = -1; return; }
        int dev = 0, cus = 0, per_cu = 0;
        (void)hipGetDevice(&dev); (void)hipDeviceGetAttribute(&cus, hipDeviceAttributeMultiprocessorCount, dev);
        if (hipFuncSetAttribute((const void*)fwd_megakernel, hipFuncAttributeMaxDynamicSharedMemorySize, LDS_BYTES) != hipSuccess) { fprintf(stderr, "kernel_launch: hipFuncSetAttribute failed\n"); grid = -1; return; }
        if (hipOccupancyMaxActiveBlocksPerMultiprocessor(&per_cu, (const void*)fwd_megakernel, NTHREADS, LDS_BYTES) != hipSuccess || per_cu < 1) { fprintf(stderr, "kernel_launch: occupancy query says %d blocks per CU\n", per_cu); grid = -1; return; }
        grid = cus * 1;
        (void)hipGetLastError();
    }
    if (grid < 0) return;
    Args a{};
    a.x = (const float*)d_in[0]; a.a_w_in = (const float*)d_in[1]; a.a_conv_w = (const float*)d_in[2]; a.a_w_out = (const float*)d_in[3]; a.kv_w = (const float*)d_in[4];
    a.b_w_q = (const float*)d_in[5]; a.b_lambda = (const float*)d_in[6]; a.b_subln_g = (const float*)d_in[7]; a.b_w_o = (const float*)d_in[8];
    a.ln1_g = (const float*)d_in[9]; a.ln1_b = (const float*)d_in[10]; a.ln2_g = (const float*)d_in[11]; a.ln2_b = (const float*)d_in[12];
    a.rg_w = (const float*)d_in[13]; a.rg_b = (const float*)d_in[14]; a.re_w = (const float*)d_in[15]; a.re_b = (const float*)d_in[16];
    a.e_w_in = (const float*)d_in[17]; a.e_w_down = (const float*)d_in[18];
    a.out = (float*)d_out; a.ws = (unsigned char*)d_ws;
    void* kargs[] = {&a};
    const hipError_t e = hipLaunchCooperativeKernel((const void*)fwd_megakernel, dim3(grid), dim3(NTHREADS), kargs, LDS_BYTES, stream);
    if (e != hipSuccess) fprintf(stderr, "kernel_launch: cooperative launch failed: %s (grid %d)\n", hipGetErrorString(e), grid);
}
```

```cpp
#include <hip/hip_runtime.h>
#include <hip/hip_cooperative_groups.h>
#include <cstdio>
#include <cstdint>
namespace cg = cooperative_groups;

namespace pg8 {
#define PG8_LAS __attribute__((address_space(3)))
typedef unsigned short bf16_t;
typedef short bf16x8 __attribute__((ext_vector_type(8)));
typedef float f32x4 __attribute__((ext_vector_type(4)));
typedef unsigned u32x4 __attribute__((ext_vector_type(4)));
typedef unsigned u32x2 __attribute__((ext_vector_type(2)));
constexpr int BM = 256, BK = 64, HALF = 128, HTB = HALF * BK * 2  , STAGE_BYTES = 8 * HTB, NXCD = 8, WGM = 8;

__host__ __device__ __forceinline__ int lds_byte(int r, int c) { const int st = (r >> 4) * 2 + (c >> 5), rr = r & 15, cc = c & 31, ob = rr * 64 + cc * 2; return st * 1024 + (ob ^ (((ob >> 9) & 1) << 5)); }
__host__ __device__ __forceinline__ void stage_rc(int b, int& R, int& C) { const int st = b / 1024, sb = b % 1024, swz = sb ^ (((sb >> 9) & 1) << 5); R = (st >> 1) * 16 + swz / 64; C = (st & 1) * 32 + (swz % 64) / 2; }
__host__ __device__ __forceinline__ int perm32(int rho) { const int n = rho >> 4, i = rho & 15; return 8 * (i >> 2) + 4 * n + (i & 3); }

struct Unit { const char* b0; const char* b1; int arow; int p0, p1, p2; };

__device__ __forceinline__ bool static_tile(int i, int G, int c, int nM, int nN, int& pm, int& pn) {
    const int nwg = nM * nN; const long L = (long)i * G + c; if (L >= nwg) return false;
    int wgid = (int)L; { const int q = nwg / NXCD, r = nwg % NXCD, xcd = wgid % NXCD, off = wgid / NXCD; wgid = (xcd < r ? xcd * (q + 1) : r * (q + 1) + (xcd - r) * q) + off; }
    const int nig = WGM * nN, gid = wgid / nig, fm = gid * WGM, gsz = (nM - fm) < WGM ? (nM - fm) : WGM;
    pm = fm + ((wgid % nig) % gsz); pn = (wgid % nig) / gsz; return true;
}

__device__ __forceinline__ unsigned cvt_pk_bf16(float lo, float hi) { unsigned r; asm volatile("v_cvt_pk_bf16_f32 %0, %1, %2" : "=v"(r) : "v"(lo), "v"(hi)); return r; }

template <class Epi, class Sched>
__device__ __forceinline__ void gemm_phase(PG8_LAS unsigned char* lds, const char* Abase, const int K, const Sched& S, const Epi& E) {
    int tid_ = threadIdx.x; asm volatile("" : "+v"(tid_));
    const int tid = tid_, wid = __builtin_amdgcn_readfirstlane(tid >> 6), lane = tid & 63, wr = wid >> 2, wc = wid & 3, fr = lane & 15, fq = lane >> 4;
    const int nt = K / BK;
    int R[2], C[2]; unsigned voffB[2];
#pragma unroll
    for (int i = 0; i < 2; ++i) { stage_rc(tid * 16 + i * 8192, R[i], C[i]); const int Rb = Epi::PERM ? ((R[i] & ~31) + perm32(R[i] & 31)) : R[i]; voffB[i] = (unsigned)(Rb * K + C[i]) * 2u; }
    const size_t kstep = (size_t)(BK * 2);
    const unsigned ldsw = (unsigned)wid * 1024u;
    const int aoff = lds_byte(wr * 64 + fr, fq * 8), boff = lds_byte(wc * 32 + fr, fq * 8);
#define PG8_SA(b, h) (((b) * 2 + (h)) * HTB)
#define PG8_SB(b, h) ((4 + (b) * 2 + (h)) * HTB)
#define PG8_STAGE(bufoff, gbase, v0, v1) do { \
        __builtin_amdgcn_global_load_lds((const unsigned*)((const char*)(gbase) + (v0)), (PG8_LAS unsigned*)(lds + (bufoff) + ldsw), 16, 0, 0); \
        __builtin_amdgcn_global_load_lds((const unsigned*)((const char*)(gbase) + (v1)), (PG8_LAS unsigned*)(lds + (bufoff) + ldsw + 8192), 16, 0, 0); } while (0)
#define PG8_STAGEB(bufoff, gbase) PG8_STAGE(bufoff, gbase, voffB[0], voffB[1])
#define PG8_LDA(dst, b, h) do { _Pragma("unroll") for (int m = 0; m < 4; ++m) _Pragma("unroll") for (int k = 0; k < 2; ++k) dst[m][k] = *(const PG8_LAS bf16x8*)(lds + PG8_SA(b, h) + aoff + m * 2048 + k * 1024); } while (0)
#define PG8_LDB(dst, b, h) do { _Pragma("unroll") for (int n = 0; n < 2; ++n) _Pragma("unroll") for (int k = 0; k < 2; ++k) dst[n][k] = *(const PG8_LAS bf16x8*)(lds + PG8_SB(b, h) + boff + n * 2048 + k * 1024); } while (0)
#define PG8_MMA(ai, bj, At, Bt) do { __builtin_amdgcn_s_setprio(1); _Pragma("unroll") for (int m = 0; m < 4; ++m) _Pragma("unroll") for (int n = 0; n < 2; ++n) _Pragma("unroll") for (int k = 0; k < 2; ++k) \
        acc[ai][bj][m][n] = __builtin_amdgcn_mfma_f32_16x16x32_bf16(Bt[n][k], At[m][k], acc[ai][bj][m][n], 0, 0, 0); __builtin_amdgcn_s_setprio(0); } while (0)
#define PG8_WAIT_V(n) asm volatile("s_waitcnt vmcnt(" #n ")" ::: "memory")
#define PG8_WAIT_L(n) asm volatile("s_waitcnt lgkmcnt(" #n ")" ::: "memory")
#define PG8_BAR __builtin_amdgcn_s_barrier()
#define PG8_SCHED __builtin_amdgcn_sched_barrier(0)
    Unit cur, nxt; int ui = 0;
    if (!S.next(0, cur)) return;
    f32x4 acc[2][2][4][2];
#pragma unroll
    for (int a = 0; a < 2; ++a)
#pragma unroll
        for (int b = 0; b < 2; ++b)
#pragma unroll
            for (int m = 0; m < 4; ++m)
#pragma unroll
                for (int n = 0; n < 2; ++n) acc[a][b][m][n] = (f32x4){0.f, 0.f, 0.f, 0.f};
    bf16x8 At[4][2], B0[2][2], B1[2][2];
    unsigned vA00, vA01, vA10, vA11, vN00, vN01, vN10, vN11;
    S.a_offs(cur, R, C, vA00, vA01, vA10, vA11);
    const char* cB0 = cur.b0; const char* cB1 = cur.b1;
    PG8_STAGEB(PG8_SB(0, 0), cB0); PG8_STAGEB(PG8_SB(0, 1), cB1); PG8_STAGE(PG8_SA(0, 0), Abase, vA00, vA01); PG8_STAGE(PG8_SA(0, 1), Abase, vA10, vA11);
    if (wr == 1) PG8_BAR;
    PG8_WAIT_V(2); PG8_BAR;
    PG8_STAGEB(PG8_SB(1, 0), cB0 + kstep); PG8_STAGE(PG8_SA(1, 0), Abase + kstep, vA00, vA01); PG8_STAGEB(PG8_SB(1, 1), cB1 + kstep);
    PG8_WAIT_V(6); PG8_BAR;
    for (;;) {
        const bool has_next = S.next(ui + 1, nxt);
        if (has_next) S.a_offs(nxt, R, C, vN00, vN01, vN10, vN11); else { vN00 = vA00; vN01 = vA01; vN10 = vA10; vN11 = vA11; }
        const char* nB0 = has_next ? nxt.b0 : cB0; const char* nB1 = has_next ? nxt.b1 : cB1;
        for (int t = 0; t < nt; t += 2) {
            const bool last = (t == nt - 2);
            const char* a1 = Abase + (size_t)(t + 1) * kstep;
            PG8_LDB(B0, 0, 0); PG8_LDB(B1, 0, 1); PG8_SCHED; PG8_LDA(At, 0, 0); PG8_STAGE(PG8_SA(1, 1), a1, vA10, vA11);
            PG8_WAIT_V(8); PG8_WAIT_L(0); PG8_BAR; PG8_MMA(0, 0, At, B0); PG8_MMA(0, 1, At, B1); PG8_BAR; PG8_SCHED;
            if (last) { vA00 = vN00; vA01 = vN01; vA10 = vN10; vA11 = vN11; }
            const char* a2 = last ? Abase : Abase + (size_t)(t + 2) * kstep;
            const char* b20 = last ? nB0 : cB0 + (size_t)(t + 2) * kstep; const char* b21 = last ? nB1 : cB1 + (size_t)(t + 2) * kstep;
            const char* a3 = a2 + kstep; const char* b30 = b20 + kstep; const char* b31 = b21 + kstep;
            PG8_LDA(At, 0, 1); PG8_STAGEB(PG8_SB(0, 0), b20); PG8_STAGEB(PG8_SB(0, 1), b21); PG8_STAGE(PG8_SA(0, 0), a2, vA00, vA01);
            PG8_WAIT_V(8); PG8_WAIT_L(0); PG8_BAR; PG8_MMA(1, 0, At, B0); PG8_MMA(1, 1, At, B1); PG8_BAR; PG8_SCHED;
            PG8_LDB(B0, 1, 0); PG8_LDB(B1, 1, 1); PG8_SCHED; PG8_LDA(At, 1, 0); PG8_STAGE(PG8_SA(0, 1), a2, vA10, vA11);
            PG8_WAIT_V(8); PG8_WAIT_L(0); PG8_BAR; PG8_MMA(0, 0, At, B0); PG8_MMA(0, 1, At, B1); PG8_BAR; PG8_SCHED;
            PG8_LDA(At, 1, 1); PG8_STAGEB(PG8_SB(1, 0), b30); PG8_STAGEB(PG8_SB(1, 1), b31); PG8_STAGE(PG8_SA(1, 0), a3, vA00, vA01);
            PG8_WAIT_V(8); PG8_WAIT_L(0); PG8_BAR; PG8_MMA(1, 0, At, B0); PG8_MMA(1, 1, At, B1); PG8_BAR; PG8_SCHED;
        }
        if (wr == 0) PG8_BAR;
        E(acc, cur, wr, wc, fr, fq);
        if (!has_next) break;
#pragma unroll
        for (int a = 0; a < 2; ++a)
#pragma unroll
            for (int b = 0; b < 2; ++b)
#pragma unroll
                for (int m = 0; m < 4; ++m)
#pragma unroll
                    for (int n = 0; n < 2; ++n) acc[a][b][m][n] = (f32x4){0.f, 0.f, 0.f, 0.f};
        cur = nxt; cB0 = nB0; cB1 = nB1; ++ui;
        if (wr == 1) PG8_BAR;
    }
    PG8_WAIT_V(0);
    PG8_BAR;
#undef PG8_SA
#undef PG8_SB
#undef PG8_STAGE
#undef PG8_STAGEB
#undef PG8_LDA
#undef PG8_LDB
#undef PG8_MMA
#undef PG8_WAIT_V
#undef PG8_WAIT_L
#undef PG8_BAR
#undef PG8_SCHED
}
}
#include <hip/hip_bf16.h>
#include <cmath>
namespace attn_body {
using bf16=__hip_bfloat16;
using bf16x8=__attribute__((ext_vector_type(8)))short;
using s16x4=__attribute__((ext_vector_type(4)))short;
using f32x16=__attribute__((ext_vector_type(16)))float;
using u32x4=__attribute__((ext_vector_type(4)))unsigned;
constexpr int D=64,DM=1024;
constexpr int NW=8,QBLK=32,QB=QBLK*NW,KVBLK=64;
constexpr int ATTN_PITCH=DM, ATTN_UNIT_ROWS=QB;
__device__ __forceinline__ int crow(int r,int hi){return (r&3)+8*(r>>2)+4*hi;}
#define SBAR() __builtin_amdgcn_sched_barrier(0)
__device__ __forceinline__ void cmask(f32x16&p0,f32x16&p1,int jb,int qrel,int hi){
  const float NEG=-INFINITY; int kb=64*jb+4*hi;
  #pragma unroll
  for(int r=0;r<16;++r){int kv=kb+(r&3)+8*(r>>2); if(kv>qrel)p0[r]=NEG; if(kv+32>qrel)p1[r]=NEG;}
}

constexpr int NSLOT=3, SLOTB=8192;
constexpr int LDS_K=0, LDS_V=NSLOT*SLOTB, LDS_WS=2*NSLOT*SLOTB, LDS_OST=LDS_WS+NW*64*4, LDS_BYTES=LDS_OST+NW*4096;
constexpr float C2=0.125f*1.4426950408889634f;
__device__ __forceinline__ void glds16(const void*gsrc,unsigned lds_dst){unsigned keep;
  asm volatile("s_mov_b32 %0, m0\n\ts_mov_b32 m0, %2\n\ts_nop 0\n\tglobal_load_lds_dwordx4 %1, off\n\ts_mov_b32 m0, %0":"=&s"(keep):"v"(gsrc),"s"(lds_dst):"memory");}
__device__ __forceinline__ void glds16s(const void*sbase,unsigned voff,unsigned lds_dst){unsigned keep;
  asm volatile("s_mov_b32 %0, m0\n\ts_mov_b32 m0, %3\n\ts_nop 4\n\tglobal_load_lds_dwordx4 %1, %2\n\ts_mov_b32 m0, %0":"=&s"(keep):"v"(voff),"s"(sbase),"s"(lds_dst):"memory");}
__device__ __forceinline__ float max3f(float a,float b,float c){float r;asm("v_max3_f32 %0, %1, %2, %3":"=v"(r):"v"(a),"v"(b),"v"(c));return r;}
__device__ __forceinline__ float max2f(float a,float b){float r;asm("v_max_f32_e32 %0, %1, %2":"=v"(r):"v"(a),"v"(b));return r;}
__device__ __forceinline__ float fadd_s(float a,float b){float r;asm("v_add_f32_e32 %0, %1, %2":"=v"(r):"v"(a),"v"(b));return r;}
__device__ __forceinline__ float fsub_s(float a,float b){float r;asm("v_sub_f32_e32 %0, %1, %2":"=v"(r):"v"(a),"v"(b));return r;}
typedef float f32x2_t __attribute__((ext_vector_type(2))); typedef __bf16 bf16x2_t __attribute__((ext_vector_type(2)));
__device__ __forceinline__ unsigned cvtpk_s(float lo,float hi){f32x2_t v={lo,hi};bf16x2_t b=__builtin_convertvector(v,bf16x2_t);return __builtin_bit_cast(unsigned,b);}
#define WAIT_BAR(N) asm volatile("s_waitcnt vmcnt(" #N ") lgkmcnt(0)\n\ts_barrier":::"memory")

__device__ __forceinline__ void qkt(f32x16&p0,f32x16&p1,const char*Kslot,const bf16x8*qr,const f32x16&negm,int r32,int hi){
  const char*kb=Kslot+hi*1024+r32*16;
  #pragma unroll
  for(int d0=0;d0<4;++d0){
    const bf16x8 b0=*reinterpret_cast<const bf16x8*>(kb+d0*2048);
    const bf16x8 b1=*reinterpret_cast<const bf16x8*>(kb+d0*2048+512);
    if(d0==0){p0=__builtin_amdgcn_mfma_f32_32x32x16_bf16(b0,qr[0],negm,0,0,0);p1=__builtin_amdgcn_mfma_f32_32x32x16_bf16(b1,qr[0],negm,0,0,0);}
    else{p0=__builtin_amdgcn_mfma_f32_32x32x16_bf16(b0,qr[d0],p0,0,0,0);p1=__builtin_amdgcn_mfma_f32_32x32x16_bf16(b1,qr[d0],p1,0,0,0);}}
}
typedef __attribute__((address_space(3))) const char* lds_cptr;
typedef short v4i16_t __attribute__((ext_vector_type(4)));
__device__ __forceinline__ void kload8(bf16x8*kf,lds_cptr kp){
  kf[0]=*(const __attribute__((address_space(3))) bf16x8*)(kp);      kf[1]=*(const __attribute__((address_space(3))) bf16x8*)(kp+512);
  kf[2]=*(const __attribute__((address_space(3))) bf16x8*)(kp+2048); kf[3]=*(const __attribute__((address_space(3))) bf16x8*)(kp+2560);
  kf[4]=*(const __attribute__((address_space(3))) bf16x8*)(kp+4096); kf[5]=*(const __attribute__((address_space(3))) bf16x8*)(kp+4608);
  kf[6]=*(const __attribute__((address_space(3))) bf16x8*)(kp+6144); kf[7]=*(const __attribute__((address_space(3))) bf16x8*)(kp+6656);
}
__device__ __forceinline__ void kload2(bf16x8*kf,lds_cptr kp,int j){ kf[2*j]=*(const __attribute__((address_space(3))) bf16x8*)(kp+j*2048); kf[2*j+1]=*(const __attribute__((address_space(3))) bf16x8*)(kp+j*2048+512); }
__device__ __forceinline__ s16x4 vtr(lds_cptr p){ return __builtin_bit_cast(s16x4,__builtin_amdgcn_ds_read_tr16_b64_v4i16((__attribute__((address_space(3))) v4i16_t*)p)); }
__device__ __forceinline__ float rowmax(const f32x16&p0,const f32x16&p1){
  float a=max3f(p0[0],p0[1],p1[0]),b=max3f(p0[2],p0[3],p1[1]);a=max3f(a,p1[2],p1[3]);
  #pragma unroll
  for(int r=4;r<16;r+=4){a=max3f(a,p0[r],p0[r+1]);b=max3f(b,p0[r+2],p0[r+3]);a=max3f(a,p1[r],p1[r+1]);b=max3f(b,p1[r+2],p1[r+3]);}
  const float m=max2f(a,b);
  auto rr=__builtin_amdgcn_permlane32_swap(__float_as_uint(m),__float_as_uint(m),false,false);
  return max2f(__uint_as_float(rr[0]),__uint_as_float(rr[1]));
}
__device__ __forceinline__ void pv(f32x16*o,int vb,bf16x8 pa0,bf16x8 pa1,bf16x8 pa2,bf16x8 pa3){
  #pragma unroll
  for(int d0=0;d0<2;++d0){s16x4 lo[4],hi[4];
    #pragma unroll
    for(int ks=0;ks<4;++ks){
      asm volatile("ds_read_b64_tr_b16 %0,%1 offset:%c2":"=&v"(lo[ks]):"v"(vb),"i"(d0*4096+ks*1024):"memory");
      asm volatile("ds_read_b64_tr_b16 %0,%1 offset:%c2":"=&v"(hi[ks]):"v"(vb),"i"(d0*4096+ks*1024+512):"memory");}
    asm volatile("s_waitcnt lgkmcnt(0)":::"memory");SBAR();
    #define PK(k) (bf16x8){lo[k][0],lo[k][1],lo[k][2],lo[k][3],hi[k][0],hi[k][1],hi[k][2],hi[k][3]}
    o[d0]=__builtin_amdgcn_mfma_f32_32x32x16_bf16(pa0,PK(0),o[d0],0,0,0);
    o[d0]=__builtin_amdgcn_mfma_f32_32x32x16_bf16(pa1,PK(1),o[d0],0,0,0);
    o[d0]=__builtin_amdgcn_mfma_f32_32x32x16_bf16(pa2,PK(2),o[d0],0,0,0);
    o[d0]=__builtin_amdgcn_mfma_f32_32x32x16_bf16(pa3,PK(3),o[d0],0,0,0);
    #undef PK
  }
}

#ifndef ATTN_STORE16
#define ATTN_STORE16(p,v) (*(u32x4*)(p)=(v))
#endif
template<int THRL> __device__ __forceinline__ void attn_unit(long rowbase,int qb,const bf16*Qc,const bf16*__restrict__ Kc,const bf16*__restrict__ Vc,bf16*Oc,char*shm){
  int tid_=threadIdx.x; asm volatile("":"+v"(tid_)); const int tid=tid_,lane=tid&63,r32=lane&31,hi=lane>>5; const int wid=__builtin_amdgcn_readfirstlane(tid>>6);
  const int q0=qb*QB;
  const bf16*Qw=Qc+(rowbase+q0+wid*QBLK)*DM;
  const bf16*Kh=Kc+rowbase*DM,*Vh=Vc+rowbase*DM;
  const unsigned lds0=(unsigned)(uintptr_t)shm;
  float*wsf=(float*)(shm+LDS_WS)+wid*64;
  const unsigned koff=(unsigned)(lane*DM+wid*8)*2u;
  const unsigned voffv=(unsigned)((16*(wid&3)+(lane>>2))*DM+(wid>>2)*32+(lane&3)*8)*2u;
  const unsigned kdst=lds0+LDS_K+wid*1024, vdst=lds0+LDS_V+wid*1024;
  #define DMA_K(t,slot) glds16s(Kh+(long)(t)*KVBLK*DM,koff,(unsigned)__builtin_amdgcn_readfirstlane(kdst+(slot)))
  #define DMA_V(t,slot) glds16s(Vh+(long)(t)*KVBLK*DM,voffv,(unsigned)__builtin_amdgcn_readfirstlane(vdst+(slot)))
  const int vb0=(int)(lds0+LDS_V)+((lane>>4)&1)*32+(lane&3)*8+(4*hi+((lane&15)>>2))*64;
  const char*Kbase=shm+LDS_K; bf16x8 kf[8];
  const lds_cptr shm3=(lds_cptr)shm; const lds_cptr kp0=shm3+LDS_K+hi*1024+r32*16; const lds_cptr vp0=shm3+LDS_V+((lane>>4)&1)*32+(lane&3)*8+(4*hi+((lane&15)>>2))*64;
  const int NT=(q0+QB)/KVBLK;
  DMA_K(0,0);DMA_V(0,0);DMA_K(1,SLOTB);
  bf16x8 qr[4];
  #pragma unroll
  for(int d0=0;d0<4;++d0)qr[d0]=*reinterpret_cast<const bf16x8*>(&Qw[(long)r32*DM+d0*16+hi*8]);
  float mhat=0.f,l_reg=0.f;f32x16 o[2];o[0]=f32x16{};o[1]=f32x16{};f32x16 negm=f32x16{};asm volatile("":"+v"(negm));
  const int qrel=wid*QBLK+r32;
  #define CMASK(P0,P1,t) do{int jb_=(t)-(NT-4); if(jb_>=0)cmask(P0,P1,jb_,qrel,hi);}while(0)
  bool resc=false;
  #define START(P0,P1) do{ const float rm=rowmax(P0,P1); resc=false; \
    { const float dl=rm; mhat=fadd_s(mhat,dl); \
      _Pragma("unroll") for(int r=0;r<16;++r){P0[r]=fsub_s(P0[r],dl);P1[r]=fsub_s(P1[r],dl);} \
      _Pragma("unroll") for(int r=0;r<16;++r)negm[r]=-mhat; asm volatile("":"+v"(negm)); } \
    _Pragma("unroll") for(int r=0;r<16;++r)P0[r]=__builtin_amdgcn_exp2f(P0[r]); }while(0)
  #define RESC() do{ if(resc){ asm volatile("s_waitcnt lgkmcnt(0)":::"memory"); \
      _Pragma("unroll") for(int d_=0;d_<2;++d_) _Pragma("unroll") for(int r=0;r<16;++r)o[d_][r]*=wsf[crow(r,hi)]; } }while(0)
  f32x16 pA0,pA1,pB0,pB1;
  int sl_prev=0,sl_cur=0,sl_next=SLOTB;
  #define ROT() do{sl_prev=sl_cur;sl_cur=sl_next;sl_next=(sl_next==(NSLOT-1)*SLOTB)?0:sl_next+SLOTB;}while(0)
  DMA_K(2,2*SLOTB);
  WAIT_BAR(3);
  qkt(pA0,pA1,Kbase,qr,negm,r32,hi);asm volatile("s_nop 15\n\ts_nop 7":"+v"(pA0),"+v"(pA1));CMASK(pA0,pA1,0);
  START(pA0,pA1);
  _Pragma("unroll") for(int r=0;r<16;++r)pA1[r]=__builtin_amdgcn_exp2f(pA1[r]);
  WAIT_BAR(0);
  DMA_K(3,0);DMA_V(1,SLOTB);
  ROT();
  kload8(kf,kp0+sl_cur);
  WAIT_BAR(2);
  s16x4 vlo[8],vhi[8]; u32x4 pw0,pw1,pw2,pw3;
  #define PKW(P,B) cvtpk_s(P[B],P[B+1])
  #define PAF(k) __builtin_bit_cast(bf16x8,pw##k)
  #define VFR(i) (bf16x8){vlo[i][0],vlo[i][1],vlo[i][2],vlo[i][3],vhi[i][0],vhi[i][1],vhi[i][2],vhi[i][3]}
  #define PIN(x) asm volatile("":"+v"(x))
  #define MX3(a,b,c) __builtin_fmaxf(__builtin_fmaxf((a),(b)),(c))
  #define GAPA(MF,A0,A1,A2,A3,W0,W1,PW) do{ MF; sacc+=A0; sacc+=A1; sacc+=A2; sacc+=A3; PIN(sacc); W0; W1; PIN(PW); SBAR(); }while(0)
  #define EX(v) __builtin_amdgcn_exp2f(v)
  #define GAPB(MF,X,B) do{ MF; X[B]=EX(X[B]); X[B+1]=EX(X[B+1]); X[B+2]=EX(X[B+2]); X[B+3]=EX(X[B+3]); PIN(X); SBAR(); }while(0)
  #define VRD(i) do{ vlo[i]=vtr(vp_+(((i)>>2)*4096+((i)&3)*1024)); vhi[i]=vtr(vp_+(((i)>>2)*4096+((i)&3)*1024+512)); }while(0)
  #define KRD(G,j) do{ if(G){ kload2(kf,kp0+sl_next,j); SBAR(); } }while(0)
  #define STEP(C0,C1,P0,P1,t,GK,GV,GL) do{ SBAR(); \
    const lds_cptr vp_=vp0+sl_prev; \
    VRD(0); SBAR(); float sacc=(P0[0]+P0[1]); \
    GAPA(C0=__builtin_amdgcn_mfma_f32_32x32x16_bf16(kf[0],qr[0],negm,0,0,0), P0[2],P0[3],P0[4],P0[5],     pw0[0]=PKW(P0,0), pw0[1]=PKW(P0,2), pw0); \
    VRD(4); SBAR(); GAPA(C1=__builtin_amdgcn_mfma_f32_32x32x16_bf16(kf[1],qr[0],negm,0,0,0), P0[6],P0[7],P0[8],P0[9],     pw0[2]=PKW(P0,4), pw0[3]=PKW(P0,6), pw0); \
    VRD(1); SBAR(); GAPA(C0=__builtin_amdgcn_mfma_f32_32x32x16_bf16(kf[2],qr[1],C0,0,0,0),   P0[10],P0[11],P0[12],P0[13], pw1[0]=PKW(P0,8), pw1[1]=PKW(P0,10), pw1); \
    VRD(5); SBAR(); GAPA(C1=__builtin_amdgcn_mfma_f32_32x32x16_bf16(kf[3],qr[1],C1,0,0,0),   P0[14],P0[15],P1[0],P1[1],   pw1[2]=PKW(P0,12),pw1[3]=PKW(P0,14), pw1); \
    VRD(2); SBAR(); GAPA(C0=__builtin_amdgcn_mfma_f32_32x32x16_bf16(kf[4],qr[2],C0,0,0,0),   P1[2],P1[3],P1[4],P1[5],     pw2[0]=PKW(P1,0), pw2[1]=PKW(P1,2), pw2); \
    VRD(6); SBAR(); GAPA(C1=__builtin_amdgcn_mfma_f32_32x32x16_bf16(kf[5],qr[2],C1,0,0,0),   P1[6],P1[7],P1[8],P1[9],     pw2[2]=PKW(P1,4), pw2[3]=PKW(P1,6), pw2); \
    VRD(3); SBAR(); GAPA(C0=__builtin_amdgcn_mfma_f32_32x32x16_bf16(kf[6],qr[3],C0,0,0,0),   P1[10],P1[11],P1[12],P1[13], pw3[0]=PKW(P1,8), pw3[1]=PKW(P1,10), pw3); \
    VRD(7); SBAR(); GAPA(C1=__builtin_amdgcn_mfma_f32_32x32x16_bf16(kf[7],qr[3],C1,0,0,0),   P1[14],P1[15],0.f,0.f,       pw3[2]=PKW(P1,12),pw3[3]=PKW(P1,14), pw3); \
    l_reg+=sacc; \
    if(GK){DMA_K((t)+3,sl_cur);} if(GV){DMA_V((t)+1,sl_next);} \
    CMASK(C0,C1,t); \
    { float a=MX3(C0[0],C0[1],C1[0]),b=MX3(C0[2],C0[3],C1[1]); a=MX3(a,C1[2],C1[3]); \
      _Pragma("unroll") for(int r=4;r<16;r+=4){a=MX3(a,C0[r],C0[r+1]);b=MX3(b,C0[r+2],C0[r+3]);a=MX3(a,C1[r],C1[r+1]);b=MX3(b,C1[r+2],C1[r+3]);} \
      float rm=__builtin_fmaxf(a,b); { auto rr=__builtin_amdgcn_permlane32_swap(__float_as_uint(rm),__float_as_uint(rm),false,false); rm=__builtin_fmaxf(__uint_as_float(rr[0]),__uint_as_float(rr[1])); } \
      resc=false; \
      if(__builtin_expect(__any(rm>(float)THRL),0)){ const float dl=__builtin_fmaxf(rm,0.f); mhat+=dl; \
        _Pragma("unroll") for(int r=0;r<16;++r){C0[r]-=dl;C1[r]-=dl;} \
        _Pragma("unroll") for(int r=0;r<16;++r)negm[r]=-mhat; asm volatile("":"+v"(negm)); \
        const float f=__builtin_amdgcn_exp2f(-dl); l_reg*=f; if(hi==0)wsf[r32]=f; resc=true; } } \
    SBAR(); \
    GAPB(o[0]=__builtin_amdgcn_mfma_f32_32x32x16_bf16(PAF(0),VFR(0),o[0],0,0,0), C0,0); \
    GAPB(o[1]=__builtin_amdgcn_mfma_f32_32x32x16_bf16(PAF(0),VFR(4),o[1],0,0,0), C0,4); \
    KRD(GL,0); GAPB(o[0]=__builtin_amdgcn_mfma_f32_32x32x16_bf16(PAF(1),VFR(1),o[0],0,0,0), C0,8); \
    KRD(GL,1); GAPB(o[1]=__builtin_amdgcn_mfma_f32_32x32x16_bf16(PAF(1),VFR(5),o[1],0,0,0), C0,12); \
    KRD(GL,2); GAPB(o[0]=__builtin_amdgcn_mfma_f32_32x32x16_bf16(PAF(2),VFR(2),o[0],0,0,0), C1,0); \
    KRD(GL,3); GAPB(o[1]=__builtin_amdgcn_mfma_f32_32x32x16_bf16(PAF(2),VFR(6),o[1],0,0,0), C1,4); \
    GAPB(o[0]=__builtin_amdgcn_mfma_f32_32x32x16_bf16(PAF(3),VFR(3),o[0],0,0,0), C1,8); \
    GAPB(o[1]=__builtin_amdgcn_mfma_f32_32x32x16_bf16(PAF(3),VFR(7),o[1],0,0,0), C1,12); \
    }while(0)
  int t=1;
  #undef CMASK
  #define CMASK(P0,P1,t) do{}while(0)
  for(;t+5<NT;t+=2){
    STEP(pB0,pB1,pA0,pA1,t,true,true,true);     WAIT_BAR(2); RESC(); ROT();
    STEP(pA0,pA1,pB0,pB1,t+1,true,true,true);   WAIT_BAR(2); RESC(); ROT();
  }
  #undef CMASK
  #define CMASK(P0,P1,t) do{int jb_=(t)-(NT-4); if(jb_>=0)cmask(P0,P1,jb_,qrel,hi);}while(0)
  #define ENDW(tt) do{ if((tt)+3<NT){WAIT_BAR(2);} else if((tt)+2<NT){WAIT_BAR(1);} else {WAIT_BAR(0);} }while(0)
  for(;t+1<NT;t+=2){
    STEP(pB0,pB1,pA0,pA1,t,(t+3<NT),(t+1<NT),(t+1<NT));       ENDW(t);   RESC(); ROT();
    STEP(pA0,pA1,pB0,pB1,t+1,(t+4<NT),(t+2<NT),(t+2<NT));     ENDW(t+1); RESC(); ROT();
  }
  STEP(pB0,pB1,pA0,pA1,NT-1,false,false,false); RESC();
  { float sacc=pB0[0]+pB0[1]; _Pragma("unroll") for(int r=2;r<16;++r)sacc+=pB0[r]; _Pragma("unroll") for(int r=0;r<16;++r)sacc+=pB1[r]; l_reg+=sacc;
    pw0=(u32x4){PKW(pB0,0),PKW(pB0,2),PKW(pB0,4),PKW(pB0,6)};pw1=(u32x4){PKW(pB0,8),PKW(pB0,10),PKW(pB0,12),PKW(pB0,14)};pw2=(u32x4){PKW(pB1,0),PKW(pB1,2),PKW(pB1,4),PKW(pB1,6)};pw3=(u32x4){PKW(pB1,8),PKW(pB1,10),PKW(pB1,12),PKW(pB1,14)};
    SBAR(); pv(o,vb0+sl_cur,PAF(0),PAF(1),PAF(2),PAF(3)); }
  #undef PKW
  #undef PAF
  #undef VFR
  #undef PIN
  #undef MX3
  #undef GAPA
  #undef GAPB
  #undef EX
  #undef VRD
  #undef KRD
  #undef STEP
  #undef ENDW
  {auto rr=__builtin_amdgcn_permlane32_swap(__float_as_uint(l_reg),__float_as_uint(l_reg),false,false);l_reg=__uint_as_float(rr[0])+__uint_as_float(rr[1]);}
  if(hi==0)wsf[32+r32]=l_reg;asm volatile("s_waitcnt lgkmcnt(0)":::"memory");
  float rli[16];
  #pragma unroll
  for(int r=0;r<16;++r)rli[r]=__builtin_amdgcn_rcpf(wsf[32+crow(r,hi)]);
  bf16*Ow=Oc+(rowbase+q0+wid*QBLK)*DM;
  { bf16*stg=(bf16*)(shm+LDS_OST)+wid*2048;
    #pragma unroll
    for(int r=0;r<16;++r){const int orow=crow(r,hi);
      #pragma unroll
      for(int d0=0;d0<2;++d0)stg[orow*64+d0*32+r32]=__float2bfloat16(o[d0][r]*rli[r]);}
    asm volatile("s_waitcnt lgkmcnt(0)":::"memory");
    #pragma unroll
    for(int i=0;i<4;++i){const int row=i*8+(lane>>3),ch=lane&7; const u32x4 v=*(const u32x4*)(stg+row*64+ch*8); ATTN_STORE16(Ow+(long)row*DM+ch*8,v);} }
  asm volatile("s_waitcnt lgkmcnt(0)\n\ts_barrier":::"memory");
  #undef DMA_K
  #undef DMA_V
  #undef CMASK
  #undef START
  #undef RESC
  #undef ROT
}
constexpr int ATTN_LDS_BYTES=LDS_BYTES;
#undef SBAR
#undef WAIT_BAR
}
namespace mk {
#define GAS __attribute__((address_space(1)))
#define LAS __attribute__((address_space(3)))
typedef unsigned short bf16;
typedef unsigned v4u __attribute__((ext_vector_type(4)));
typedef unsigned v2u __attribute__((ext_vector_type(2)));
typedef float f32x4 __attribute__((ext_vector_type(4)));
using pg8::Unit;
using pg8::cvt_pk_bf16;

constexpr int D = 1024, BATCH = 8, SEQ = 2048, T = BATCH * SEQ, NH = 8, NG = 4, EPG = 8, NE = 32, DE = 512, NRW = NG + NE;
constexpr float ALPHA = 1.4142135623730951f, LN_EPS = 1e-5f, RMS_EPS = 1e-5f;
constexpr float LAM_INIT = 0.35550906f;
constexpr float QSCALE = 0.125f * 1.4426950408889634f;
constexpr int CAP = 2 * T;
constexpr int NWAVES = 8, NTHREADS = 512;

constexpr size_t MiB = 1u << 20;
constexpr size_t WS_CTL = 0, WS_W1T = 1 * MiB, WS_W2T = 7 * MiB, WS_WKVQ = 9 * MiB, WS_WOT = 15 * MiB, WS_RWT = 17 * MiB, WS_PERM = 18 * MiB, WS_GATE = 22 * MiB;
constexpr size_t WS_WUT = 24 * MiB, WS_WDT = 152 * MiB, WS_XB = 216 * MiB, WS_GB = 248 * MiB, WS_U = 280 * MiB, WS_A2 = 312 * MiB, WS_Z = 344 * MiB, WS_X1B = 408 * MiB;
constexpr size_t WS_ACT = 440 * MiB, WS_YP = 480 * MiB, WS_X2B = 544 * MiB, WS_K = 576 * MiB, WS_V = 608 * MiB, WS_Q = 640 * MiB, WS_O0 = 672 * MiB, WS_O1 = 704 * MiB;
constexpr size_t WS_A3 = 736 * MiB, WS_X3B = 768 * MiB, WS_END = 800 * MiB;
constexpr int RING_BYTES = 131072, MISC_OFF = RING_BYTES, LDS_BYTES = 147456;

struct Args {
    const float *x, *a_w_in, *a_conv_w, *a_w_out, *kv_w, *b_w_q, *b_lambda, *b_subln_g, *b_w_o, *ln1_g, *ln1_b, *ln2_g, *ln2_b, *rg_w, *rg_b, *re_w, *re_b, *e_w_in, *e_w_down;
    float* out; unsigned char* ws;
};

typedef const __attribute__((address_space(4))) Args* ArgsP;
__device__ __forceinline__ ArgsP kargs() { ArgsP p = (ArgsP)__builtin_amdgcn_kernarg_segment_ptr(); asm volatile("" : "+s"(p)); return p; }
struct Ctx { int tid, lane, wave, G, bx, gw, NGW; unsigned char* ws; };
__device__ __forceinline__ Ctx mkctx(ArgsP ap) { Ctx c; int t = threadIdx.x; asm volatile("" : "+v"(t)); c.tid = t; c.lane = t & 63; c.wave = __builtin_amdgcn_readfirstlane(t >> 6);
    c.G = gridDim.x; c.bx = blockIdx.x; c.gw = c.bx * 8 + c.wave; c.NGW = c.G * 8; c.ws = ap->ws; return c; }
__device__ __forceinline__ unsigned f2bf(float f) { unsigned u = __builtin_bit_cast(unsigned, f); return (u + 0x7fffu + ((u >> 16) & 1u)) >> 16; }
__device__ __forceinline__ unsigned pk2(float lo, float hi) { return f2bf(lo) | (f2bf(hi) << 16); }
__device__ __forceinline__ float bflo(unsigned w) { return __builtin_bit_cast(float, w << 16); }
__device__ __forceinline__ float bfhi(unsigned w) { return __builtin_bit_cast(float, w & 0xffff0000u); }
__device__ __forceinline__ float wave_sum(float v) {
#pragma unroll
    for (int o = 1; o < 64; o <<= 1) v += __shfl_xor(v, o);
    return v;
}

__device__ __forceinline__ void p0_transpose_item(const float* W, int K, int N, bf16* WT, int row_off, LAS float* scr, int item, int lane) {
    const int nblk = N / 32, kb = item / nblk, nb = item % nblk, k0 = 64 * kb, n0 = 32 * nb;
#pragma unroll 8
    for (int i = 0; i < 32; ++i) { const int kk = 2 * i + (lane >> 5); scr[kk * 33 + (lane & 31)] = W[(size_t)(k0 + kk) * N + n0 + (lane & 31)]; }
    asm volatile("s_waitcnt lgkmcnt(0)" ::: "memory");
    const int c = lane & 7;
#pragma unroll
    for (int j = 0; j < 4; ++j) { const int n = (lane >> 3) + 8 * j; const LAS float* s = scr + (8 * c) * 33 + n;
        v4u o; o.x = pk2(s[0 * 33], s[1 * 33]); o.y = pk2(s[2 * 33], s[3 * 33]); o.z = pk2(s[4 * 33], s[5 * 33]); o.w = pk2(s[6 * 33], s[7 * 33]);
        *(GAS v4u*)(WT + (size_t)(row_off + n0 + n) * K + k0 + 8 * c) = o; }
    asm volatile("s_waitcnt lgkmcnt(0)" ::: "memory");
}

__device__ __forceinline__ void p0_prologue(LAS unsigned char* lds) {
    const ArgsP a = kargs(); const Ctx cx = mkctx(a); const int gw = cx.gw, NGW = cx.NGW, wave = cx.wave, lane = cx.lane;
    unsigned char* ws = cx.ws;
    LAS float* scr = (LAS float*)(lds + wave * 16384);
    constexpr int I_IN = 16 * 96, I_SQ = 16 * 32, I_KV = 16 * 64, I_DN = 8 * 32;
    constexpr int S1 = I_IN, S2 = S1 + I_SQ, S3 = S2 + I_KV, S4 = S3 + I_SQ, S5 = S4 + I_SQ, S6 = S5 + 64 * I_SQ, NITEMS = S6 + 64 * I_DN;
    for (int it = gw; it < NITEMS; it += NGW) {
        if (it < S1) p0_transpose_item(a->a_w_in, D, 3 * D, (bf16*)(ws + WS_W1T), 0, scr, it, lane);
        else if (it < S2) p0_transpose_item(a->a_w_out, D, D, (bf16*)(ws + WS_W2T), 0, scr, it - S1, lane);
        else if (it < S3) p0_transpose_item(a->kv_w, D, 2 * D, (bf16*)(ws + WS_WKVQ), 0, scr, it - S2, lane);
        else if (it < S4) p0_transpose_item(a->b_w_q, D, D, (bf16*)(ws + WS_WKVQ), 2 * D, scr, it - S3, lane);
        else if (it < S5) p0_transpose_item(a->b_w_o, D, D, (bf16*)(ws + WS_WOT), 0, scr, it - S4, lane);
        else if (it < S6) { const int r = it - S5, mtx = r / I_SQ; p0_transpose_item(a->e_w_in + (size_t)mtx * D * D, D, D, (bf16*)(ws + WS_WUT) + (size_t)mtx * D * D, 0, scr, r % I_SQ, lane); }
        else { const int r = it - S6, mtx = r / I_DN; p0_transpose_item(a->e_w_down + (size_t)mtx * DE * D, DE, D, (bf16*)(ws + WS_WDT) + (size_t)mtx * D * DE, 0, scr, r % I_DN, lane); }
    }
    for (int m = gw; m < T; m += NGW) {
        const GAS f32x4* xr = (const GAS f32x4*)(a->x + (size_t)m * D) + lane;
        GAS v2u* o = (GAS v2u*)((bf16*)(ws + WS_XB) + (size_t)m * D) + lane;
#pragma unroll
        for (int j = 0; j < 4; ++j) { const f32x4 v = xr[64 * j]; v2u w; w.x = pk2(v.x, v.y); w.y = pk2(v.z, v.w); o[64 * j] = w; }
    }
    { float* rwt = (float*)(ws + WS_RWT);
      for (int idx = gw * 64 + lane; idx < 2 * NRW * D; idx += NGW * 64) { const int l = idx / (NRW * D), n = (idx / D) % NRW, k = idx % D;
          rwt[idx] = n < NG ? a->rg_w[((size_t)l * D + k) * NG + n] : a->re_w[((size_t)l * D + k) * NE + (n - NG)]; } }
}

struct SchedDense {
    int G, c, nN, mode, K; const char* W;
    __device__ __forceinline__ bool next(int i, Unit& u) const {
        int pm, pn; if (!pg8::static_tile(i, G, c, T / 256, nN, pm, pn)) return false;
        u.arow = pm * 256; u.p0 = pm; u.p1 = pn; u.p2 = 0;
        const size_t rb = (size_t)K * 2;
        if (mode == 0 && pn >= 4) { const int jj = pn - 4; u.b0 = W + (size_t)(D + 128 * jj) * rb; u.b1 = W + (size_t)(2 * D + 128 * jj) * rb; }
        else { u.b0 = W + (size_t)(256 * pn) * rb; u.b1 = u.b0 + 128 * rb; }
        return true;
    }
    __device__ __forceinline__ void a_offs(const Unit& u, const int (&R)[2], const int (&C)[2], unsigned& v00, unsigned& v01, unsigned& v10, unsigned& v11) const {
        v00 = (unsigned)((u.arow + R[0]) * K + C[0]) * 2u; v01 = (unsigned)((u.arow + R[1]) * K + C[1]) * 2u;
        v10 = (unsigned)((u.arow + 128 + R[0]) * K + C[0]) * 2u; v11 = (unsigned)((u.arow + 128 + R[1]) * K + C[1]) * 2u;
    }
};
struct MoeTab { const LAS int* ub; const LAS int* ps; const LAS int* cn; };
struct SchedMoe {
    int G, c, K; bool up; const char* W; const int* perm; MoeTab tb;
    __device__ __forceinline__ bool next(int i, Unit& u) const {
        const int idx = i * G + c; if (idx >= tb.ub[NE]) return false;
        int e = 0;
#pragma unroll 1
        for (int k = 1; k < NE; ++k) if (idx >= tb.ub[k]) e = k;
        const int local = idx - tb.ub[e], rtn = (tb.ub[e + 1] - tb.ub[e]) >> 2, ct = local / rtn, rti = local - ct * rtn;
        const size_t rb = (size_t)K * 2; const char* We = W + (size_t)e * D * rb;
        if (up) { u.b0 = We + (size_t)(128 * ct) * rb; u.b1 = We + (size_t)(DE + 128 * ct) * rb; u.arow = e * CAP + rti * 256; u.p0 = tb.ps[e] + rti * 256; }
        else { u.b0 = We + (size_t)(256 * ct) * rb; u.b1 = u.b0 + 128 * rb; u.arow = tb.ps[e] + rti * 256; u.p0 = e * CAP + rti * 256; }
        u.p1 = ct; u.p2 = tb.cn[e] - rti * 256;
        return true;
    }
    __device__ __forceinline__ void a_offs(const Unit& u, const int (&R)[2], const int (&C)[2], unsigned& v00, unsigned& v01, unsigned& v10, unsigned& v11) const {
        if (up) {
            const int r00 = R[0] < u.p2 ? R[0] : 0, r01 = R[1] < u.p2 ? R[1] : 0, r10 = 128 + R[0] < u.p2 ? 128 + R[0] : 0, r11 = 128 + R[1] < u.p2 ? 128 + R[1] : 0;
            const int t00 = perm[u.arow + r00] >> 1, t01 = perm[u.arow + r01] >> 1, t10 = perm[u.arow + r10] >> 1, t11 = perm[u.arow + r11] >> 1;
            v00 = (unsigned)(t00 * K + C[0]) * 2u; v01 = (unsigned)(t01 * K + C[1]) * 2u; v10 = (unsigned)(t10 * K + C[0]) * 2u; v11 = (unsigned)(t11 * K + C[1]) * 2u;
        } else {
            v00 = (unsigned)((u.arow + R[0]) * K + C[0]) * 2u; v01 = (unsigned)((u.arow + R[1]) * K + C[1]) * 2u;
            v10 = (unsigned)((u.arow + 128 + R[0]) * K + C[0]) * 2u; v11 = (unsigned)((u.arow + 128 + R[1]) * K + C[1]) * 2u;
        }
    }
};

struct EpiConvIn {
    static constexpr bool PERM = true; bf16* GB; bf16* U;
    __device__ __forceinline__ void operator()(const f32x4 (&acc)[2][2][4][2], const Unit& u, int wr, int wc, int fr, int fq) const {
        const int row0 = u.p0 * 256 + wr * 64 + fr;
        if (u.p1 < 4) {
            const int col0 = u.p1 * 256 + wc * 32 + 8 * fq;
#pragma unroll
            for (int ai = 0; ai < 2; ++ai)
#pragma unroll
                for (int m = 0; m < 4; ++m) { bf16* rowp = GB + (size_t)(row0 + ai * 128 + m * 16) * D + col0;
#pragma unroll
                    for (int bj = 0; bj < 2; ++bj) { const f32x4 v0 = acc[ai][bj][m][0], v1 = acc[ai][bj][m][1];
                        v4u w; w.x = cvt_pk_bf16(v0[0], v0[1]); w.y = cvt_pk_bf16(v0[2], v0[3]); w.z = cvt_pk_bf16(v1[0], v1[1]); w.w = cvt_pk_bf16(v1[2], v1[3]);
                        *(v4u*)(rowp + bj * 128) = w; } }
        } else {
            const int col0 = (u.p1 - 4) * 128 + wc * 32 + 8 * fq;
#pragma unroll
            for (int ai = 0; ai < 2; ++ai)
#pragma unroll
                for (int m = 0; m < 4; ++m) { const f32x4 v0 = acc[ai][0][m][0] * acc[ai][1][m][0], v1 = acc[ai][0][m][1] * acc[ai][1][m][1];
                    v4u w; w.x = cvt_pk_bf16(v0[0], v0[1]); w.y = cvt_pk_bf16(v0[2], v0[3]); w.z = cvt_pk_bf16(v1[0], v1[1]); w.w = cvt_pk_bf16(v1[2], v1[3]);
                    *(v4u*)(U + (size_t)(row0 + ai * 128 + m * 16) * D + col0) = w; }
        }
    }
};
template <bool RES_BF16> struct EpiResZ {
    static constexpr bool PERM = false; const void* res; float* Z;
    __device__ __forceinline__ void operator()(const f32x4 (&acc)[2][2][4][2], const Unit& u, int wr, int wc, int fr, int fq) const {
        const int row0 = u.p0 * 256 + wr * 64 + fr, col0 = u.p1 * 256 + wc * 32 + 4 * fq;
#pragma unroll
        for (int ai = 0; ai < 2; ++ai)
#pragma unroll
            for (int m = 0; m < 4; ++m) { const size_t off = (size_t)(row0 + ai * 128 + m * 16) * D + col0;
#pragma unroll
                for (int bj = 0; bj < 2; ++bj)
#pragma unroll
                    for (int n = 0; n < 2; ++n) { const size_t o = off + bj * 128 + n * 16; f32x4 r;
                        if (RES_BF16) { const v2u w = *(const v2u*)((const bf16*)res + o); r = (f32x4){bflo(w.x), bfhi(w.x), bflo(w.y), bfhi(w.y)}; }
                        else r = *(const f32x4*)((const float*)res + o);
                        *(f32x4*)(Z + o) = r * ALPHA + acc[ai][bj][m][n]; } }
    }
};
struct EpiUp {
    static constexpr bool PERM = true; bf16* ACT;
    __device__ __forceinline__ void operator()(const f32x4 (&acc)[2][2][4][2], const Unit& u, int wr, int wc, int fr, int fq) const {
        const int row0 = u.p0 + wr * 64 + fr, col0 = u.p1 * 128 + wc * 32 + 8 * fq;
#pragma unroll
        for (int ai = 0; ai < 2; ++ai)
#pragma unroll
            for (int m = 0; m < 4; ++m) { f32x4 v[2];
#pragma unroll
                for (int n = 0; n < 2; ++n) { const f32x4 g = acc[ai][0][m][n], uu = acc[ai][1][m][n];
#pragma unroll
                    for (int j = 0; j < 4; ++j) { const float e = __builtin_amdgcn_exp2f(g[j] * -1.4426950408889634f); v[n][j] = g[j] * __builtin_amdgcn_rcpf(1.0f + e) * uu[j]; } }
                v4u w; w.x = cvt_pk_bf16(v[0][0], v[0][1]); w.y = cvt_pk_bf16(v[0][2], v[0][3]); w.z = cvt_pk_bf16(v[1][0], v[1][1]); w.w = cvt_pk_bf16(v[1][2], v[1][3]);
                *(v4u*)(ACT + (size_t)(row0 + ai * 128 + m * 16) * DE + col0) = w; }
    }
};
struct EpiDown {
    static constexpr bool PERM = true; bf16* YP; const int* perm; const float* gate;
    __device__ __forceinline__ void operator()(const f32x4 (&acc)[2][2][4][2], const Unit& u, int wr, int wc, int fr, int fq) const {
        const int col0 = u.p1 * 256 + wc * 32 + 8 * fq;
#pragma unroll
        for (int ai = 0; ai < 2; ++ai)
#pragma unroll
            for (int m = 0; m < 4; ++m) { const int r = ai * 128 + wr * 64 + m * 16 + fr;
                if (r < u.p2) { const int pair = perm[u.p0 + r]; const float g = gate[pair]; bf16* rowp = YP + (size_t)pair * D + col0;
#pragma unroll
                    for (int bj = 0; bj < 2; ++bj) { const f32x4 v0 = acc[ai][bj][m][0] * g, v1 = acc[ai][bj][m][1] * g;
                        v4u w; w.x = cvt_pk_bf16(v0[0], v0[1]); w.y = cvt_pk_bf16(v0[2], v0[3]); w.z = cvt_pk_bf16(v1[0], v1[1]); w.w = cvt_pk_bf16(v1[2], v1[3]);
                        *(v4u*)(rowp + bj * 128) = w; } } }
    }
};
struct EpiKVQ {
    static constexpr bool PERM = true; bf16* KB;
    __device__ __forceinline__ void operator()(const f32x4 (&acc)[2][2][4][2], const Unit& u, int wr, int wc, int fr, int fq) const {
        const int t = u.p1 >> 2; const float sc = t == 2 ? QSCALE : 1.0f;
        bf16* base = KB + (size_t)t * (32 * MiB / 2);
        const int row0 = u.p0 * 256 + wr * 64 + fr, col0 = (u.p1 & 3) * 256 + wc * 32 + 8 * fq;
#pragma unroll
        for (int ai = 0; ai < 2; ++ai)
#pragma unroll
            for (int m = 0; m < 4; ++m) { bf16* rowp = base + (size_t)(row0 + ai * 128 + m * 16) * D + col0;
#pragma unroll
                for (int bj = 0; bj < 2; ++bj) { const f32x4 v0 = acc[ai][bj][m][0] * sc, v1 = acc[ai][bj][m][1] * sc;
                    v4u w; w.x = cvt_pk_bf16(v0[0], v0[1]); w.y = cvt_pk_bf16(v0[2], v0[3]); w.z = cvt_pk_bf16(v1[0], v1[1]); w.w = cvt_pk_bf16(v1[2], v1[3]);
                    *(v4u*)(rowp + bj * 128) = w; } }
    }
};

__device__ __forceinline__ void ln_rows(f32x4 (&v)[4], const float* g, const float* b, int lane) {
    float s = 0.f;
#pragma unroll
    for (int j = 0; j < 4; ++j) s += (v[j].x + v[j].y) + (v[j].z + v[j].w);
    const float mean = wave_sum(s) * (1.f / D); float s2 = 0.f;
#pragma unroll
    for (int j = 0; j < 4; ++j) { v[j] = v[j] - mean; s2 += (v[j].x * v[j].x + v[j].y * v[j].y) + (v[j].z * v[j].z + v[j].w * v[j].w); }
    const float rstd = 1.f / sqrtf(wave_sum(s2) * (1.f / D) + LN_EPS);
#pragma unroll
    for (int j = 0; j < 4; ++j) { const f32x4 gg = *(const f32x4*)(g + 256 * j + 4 * lane), bb = *(const f32x4*)(b + 256 * j + 4 * lane); v[j] = v[j] * rstd * gg + bb; }
}
__device__ __forceinline__ float dot_row(const f32x4 (&v)[4], const float* w, int lane) {
    float a = 0.f;
#pragma unroll
    for (int j = 0; j < 4; ++j) { const f32x4 ww = *(const f32x4*)(w + 256 * j + 4 * lane); a += (v[j].x * ww.x + v[j].y * ww.y) + (v[j].z * ww.z + v[j].w * ww.w); }
    return wave_sum(a);
}
__device__ __forceinline__ void ln_router_phase(int layer, int rep = 0) {
    const ArgsP a = kargs(); const Ctx cx = mkctx(a); const int gw = cx.gw, NGW = cx.NGW, lane = cx.lane;
    unsigned char* ws = cx.ws;
    const float* Z = (const float*)(ws + WS_Z); bf16* Xb = (bf16*)(ws + (layer == 0 ? WS_X1B : WS_X3B));
    const float* g = a->ln1_g + layer * D; const float* b = a->ln1_b + layer * D;
    const float* rwt = (const float*)(ws + WS_RWT) + (size_t)layer * NRW * D;
    const float* rgb = a->rg_b + layer * NG; const float* reb = a->re_b + layer * NE;
    int* cnt = (int*)(ws + WS_CTL) + layer * NE; int* perm = (int*)(ws + WS_PERM); float* gate = (float*)(ws + WS_GATE);
    for (int row = gw; row < T; row += NGW) {
        f32x4 v[4];
#pragma unroll
        for (int j = 0; j < 4; ++j) v[j] = *(const f32x4*)(Z + (size_t)row * D + 256 * j + 4 * lane);
        ln_rows(v, g, b, lane);
#pragma unroll
        for (int j = 0; j < 4; ++j) { v2u w; w.x = pk2(v[j].x, v[j].y); w.y = pk2(v[j].z, v[j].w); *(v2u*)(Xb + (size_t)row * D + 256 * j + 4 * lane) = w; }
        float gl[NG];
#pragma unroll
        for (int n = 0; n < NG; ++n) gl[n] = dot_row(v, rwt + n * D, lane) + rgb[n];
        int gi = 0; float gm = gl[0];
#pragma unroll
        for (int n = 1; n < NG; ++n) if (gl[n] > gm) { gm = gl[n]; gi = n; }
        float gs = 0.f;
#pragma unroll
        for (int n = 0; n < NG; ++n) gs += __expf(gl[n] - gm);
        const float gtop = 1.0f / gs;
        gi = __builtin_amdgcn_readfirstlane(gi);
        float m0 = -INFINITY, m1 = -INFINITY; int i0 = 0, i1 = 0;
#pragma unroll
        for (int n = 0; n < EPG; ++n) { const float el = dot_row(v, rwt + (NG + gi * EPG + n) * D, lane) + reb[gi * EPG + n];
            if (el > m0) { m1 = m0; i1 = i0; m0 = el; i0 = n; } else if (el > m1) { m1 = el; i1 = n; } }
        const float e1 = __expf(m1 - m0), w0 = 1.0f / (1.0f + e1), w1 = e1 * w0;
        if (lane == 0 && rep == 0) {
            const int ea = gi * EPG + i0, eb = gi * EPG + i1;
            const int sa = atomicAdd(&cnt[ea], 1), sb = atomicAdd(&cnt[eb], 1);
            perm[ea * CAP + sa] = 2 * row; perm[eb * CAP + sb] = 2 * row + 1;
            gate[2 * row] = gtop * w0; gate[2 * row + 1] = gtop * w1;
        }
    }
}
__device__ __forceinline__ void ln2_phase(int layer) {
    const ArgsP a = kargs(); const Ctx cx = mkctx(a); const int gw = cx.gw, NGW = cx.NGW, lane = cx.lane;
    unsigned char* ws = cx.ws;
    const bf16* Xin = (const bf16*)(ws + (layer == 0 ? WS_X1B : WS_X3B)); const bf16* YP = (const bf16*)(ws + WS_YP);
    const float* g = a->ln2_g + layer * D; const float* b = a->ln2_b + layer * D;
    for (int row = gw; row < T; row += NGW) {
        f32x4 v[4];
#pragma unroll
        for (int j = 0; j < 4; ++j) { const size_t c = 256 * j + 4 * lane;
            const v2u xw = *(const v2u*)(Xin + (size_t)row * D + c), y0 = *(const v2u*)(YP + (size_t)(2 * row) * D + c), y1 = *(const v2u*)(YP + (size_t)(2 * row + 1) * D + c);
            v[j].x = ALPHA * bflo(xw.x) + (bflo(y0.x) + bflo(y1.x)); v[j].y = ALPHA * bfhi(xw.x) + (bfhi(y0.x) + bfhi(y1.x));
            v[j].z = ALPHA * bflo(xw.y) + (bflo(y0.y) + bflo(y1.y)); v[j].w = ALPHA * bfhi(xw.y) + (bfhi(y0.y) + bfhi(y1.y)); }
        ln_rows(v, g, b, lane);
        if (layer == 0) {
#pragma unroll
            for (int j = 0; j < 4; ++j) { v2u w; w.x = pk2(v[j].x, v[j].y); w.y = pk2(v[j].z, v[j].w); *(v2u*)((bf16*)(ws + WS_X2B) + (size_t)row * D + 256 * j + 4 * lane) = w; }
        } else {
#pragma unroll
            for (int j = 0; j < 4; ++j) *(f32x4*)(a->out + (size_t)row * D + 256 * j + 4 * lane) = v[j];
        }
    }
}
__device__ __forceinline__ void conv_phase() {
    const ArgsP a = kargs(); const Ctx cx = mkctx(a); const int gtid = cx.bx * NTHREADS + cx.tid, NGT = cx.G * NTHREADS;
    unsigned char* ws = cx.ws;
    const bf16* GB = (const bf16*)(ws + WS_GB); const bf16* U = (const bf16*)(ws + WS_U); bf16* A2 = (bf16*)(ws + WS_A2);
    for (int it = gtid; it < T * (D / 8); it += NGT) {
        const int t = it >> 7, d0 = (it & 127) * 8, s = t & (SEQ - 1);
        const size_t o = (size_t)t * D + d0;
        const v4u g = *(const v4u*)(GB + o), u0 = *(const v4u*)(U + o);
        v4u u1 = (v4u){0u, 0u, 0u, 0u}, u2 = u1;
        if (s >= 1) u1 = *(const v4u*)(U + o - D);
        if (s >= 2) u2 = *(const v4u*)(U + o - 2 * D);
        v4u r;
#pragma unroll
        for (int q = 0; q < 4; ++q) {
            const int d = d0 + 2 * q;
            const float c0 = a->a_conv_w[d] * bflo(u2[q]) + a->a_conv_w[D + d] * bflo(u1[q]) + a->a_conv_w[2 * D + d] * bflo(u0[q]);
            const float c1 = a->a_conv_w[d + 1] * bfhi(u2[q]) + a->a_conv_w[D + d + 1] * bfhi(u1[q]) + a->a_conv_w[2 * D + d + 1] * bfhi(u0[q]);
            r[q] = pk2(bflo(g[q]) * c0, bfhi(g[q]) * c1);
        }
        *(v4u*)(A2 + o) = r;
    }
}
__device__ __forceinline__ void combine_phase() {
    const ArgsP a = kargs(); const Ctx cx = mkctx(a); const int gw = cx.gw, NGW = cx.NGW, lane = cx.lane;
    unsigned char* ws = cx.ws;
    const bf16* O0 = (const bf16*)(ws + WS_O0); const bf16* O1 = (const bf16*)(ws + WS_O1); bf16* A3 = (bf16*)(ws + WS_A3);
    const float l01 = wave_sum(a->b_lambda[lane] * a->b_lambda[64 + lane]), l23 = wave_sum(a->b_lambda[128 + lane] * a->b_lambda[192 + lane]);
    const float lam = __expf(l01) - __expf(l23) + LAM_INIT;
    float gsc[16];
#pragma unroll
    for (int i = 0; i < 16; ++i) gsc[i] = a->b_subln_g[(lane & 7) * 16 + i] * (1.0f - LAM_INIT);
    for (int row = gw; row < T; row += NGW) {
        const size_t o = (size_t)row * D + lane * 16;
        const v4u p0 = *(const v4u*)(O0 + o), p1 = *(const v4u*)(O0 + o + 8), q0 = *(const v4u*)(O1 + o), q1 = *(const v4u*)(O1 + o + 8);
        float d[16]; float ss = 0.f;
#pragma unroll
        for (int i = 0; i < 4; ++i) { d[2 * i] = bflo(p0[i]) - lam * bflo(q0[i]); d[2 * i + 1] = bfhi(p0[i]) - lam * bfhi(q0[i]);
            d[8 + 2 * i] = bflo(p1[i]) - lam * bflo(q1[i]); d[8 + 2 * i + 1] = bfhi(p1[i]) - lam * bfhi(q1[i]); }
#pragma unroll
        for (int i = 0; i < 16; ++i) ss += d[i] * d[i];
        ss += __shfl_xor(ss, 1); ss += __shfl_xor(ss, 2); ss += __shfl_xor(ss, 4);
        const float r = 1.0f / sqrtf(ss * (1.0f / 128.0f) + RMS_EPS);
        v4u w0, w1;
#pragma unroll
        for (int i = 0; i < 4; ++i) { w0[i] = pk2(d[2 * i] * r * gsc[2 * i], d[2 * i + 1] * r * gsc[2 * i + 1]); w1[i] = pk2(d[8 + 2 * i] * r * gsc[8 + 2 * i], d[8 + 2 * i + 1] * r * gsc[8 + 2 * i + 1]); }
        *(v4u*)(A3 + o) = w0; *(v4u*)(A3 + o + 8) = w1;
    }
}

#ifndef MKMASK
#define MKMASK 0xffff
#endif
#ifndef MKREP
#define MKREP 0
#endif
#ifndef MKSYNC
#define MKSYNC 0
#endif
#ifndef MKMASK2
#define MKMASK2 MKMASK
#endif
#define PH(k) _Pragma("unroll 1") for (int rep_ = 0; rep_ < (int)(((pass_ ? MKMASK2 : MKMASK) >> (k)) & 1) + (int)((MKREP >> (k)) & 1); ++rep_)
#define XB_TMO      128
#define XB_XCNT(j)  (256  + 64 * (j))
#define XB_XSUB(j)  (1280 + 64 * (j))
#define XB_XGEN(j)  (2304 + 64 * (j))
#define XB_TOP      3328
#define XB_TOPGEN   3392
#define XCD_BAR_WORDS 3456
#define XB_SPIN_CAP (1u << 18)

__device__ __forceinline__ unsigned xb_ld(unsigned* p)              { return __hip_atomic_load(p, __ATOMIC_RELAXED, __HIP_MEMORY_SCOPE_AGENT); }
__device__ __forceinline__ unsigned xb_add(unsigned* p, unsigned v) { return __hip_atomic_fetch_add(p, v, __ATOMIC_RELAXED, __HIP_MEMORY_SCOPE_AGENT); }
__device__ __forceinline__ unsigned xb_xcc_id() { return (unsigned)__builtin_amdgcn_s_getreg((3 << 11) | 20) & 0xFu; }
#define XB_SPIN(cond, bar) do { unsigned _sp = 0; while (cond) { __builtin_amdgcn_s_sleep(1); \
    if ((++_sp & 255u) == 0u) { if (xb_ld(&(bar)[XB_TMO])) break; if (_sp > XB_SPIN_CAP) { atomicAdd(&(bar)[XB_TMO], 1u); break; } } } } while (0)

struct XcdBarrier {
    unsigned* bar; unsigned x;
    volatile LAS unsigned* st;
};

__device__ __forceinline__ XcdBarrier xcd_barrier_post(unsigned* bar, volatile LAS unsigned* st) {
    XcdBarrier b; b.bar = bar; b.x = xb_xcc_id(); b.st = st;
    if (threadIdx.x == 0) (void)xb_add(&bar[XB_XCNT(b.x)], 1u);
    return b;
}
__device__ __forceinline__ void xcd_barrier_complete(unsigned* bar, unsigned x, unsigned& nloc, unsigned& nx) {
    const unsigned G = gridDim.x * gridDim.y * gridDim.z;
    unsigned sum, cnt, mine, sp = 0u;
    for (;;) {
        sum = 0u; cnt = 0u; mine = 0u;
#pragma unroll
        for (unsigned j = 0; j < 16; ++j) { const unsigned c = xb_ld(&bar[XB_XCNT(j)]); sum += c; cnt += (c > 0u) ? 1u : 0u; mine = (j == x) ? c : mine; }
        if (sum == G) break;
        __builtin_amdgcn_s_sleep(1);
        if ((++sp & 255u) == 0u) { if (xb_ld(&bar[XB_TMO])) break; if (sp > XB_SPIN_CAP) { atomicAdd(&bar[XB_TMO], 1u); break; } }
    }
    nloc = mine > 0u ? mine : 1u; nx = cnt > 0u ? cnt : 1u;
}

__device__ __forceinline__ void xcd_barrier(const XcdBarrier& b) {
    asm volatile("s_waitcnt vmcnt(0)" ::: "memory");
    __syncthreads();
    if (threadIdx.x == 0) {
        unsigned* bar = b.bar;
        __builtin_amdgcn_s_waitcnt(0);
        unsigned nloc = b.st[0], nx = b.st[1];
        if (nloc == 0u) { xcd_barrier_complete(bar, b.x, nloc, nx); b.st[0] = nloc; b.st[1] = nx; }
        const unsigned old = xb_add(&bar[XB_XSUB(b.x)], 1u);
        const unsigned gen = old / nloc;
        if (old + 1u == (gen + 1u) * nloc) {
            __builtin_amdgcn_fence(__ATOMIC_RELEASE, "agent");
            asm volatile("s_waitcnt vmcnt(0)" ::: "memory");
            const unsigned og = xb_add(&bar[XB_TOP], 1u);
            const unsigned tg = og / nx;
            if (og + 1u == (tg + 1u) * nx) xb_add(&bar[XB_TOPGEN], 1u);
            else XB_SPIN(xb_ld(&bar[XB_TOPGEN]) == tg, bar);
            __builtin_amdgcn_fence(__ATOMIC_ACQUIRE, "agent");
            xb_add(&bar[XB_XGEN(b.x)], 1u);
            asm volatile("s_waitcnt vmcnt(0)" ::: "memory");
        } else {
            XB_SPIN(xb_ld(&bar[XB_XGEN(b.x)]) == gen, bar);
            __builtin_amdgcn_fence(__ATOMIC_ACQUIRE, "agent");
            asm volatile("s_waitcnt vmcnt(0)" ::: "memory");
        }
    }
    __syncthreads();
}

constexpr int CW_BAR = 1024;
constexpr int ST_OFF = MISC_OFF + 1024;
__device__ __forceinline__ void seam(LAS unsigned char* lds) { const ArgsP a = kargs(); XcdBarrier b; b.bar = (unsigned*)(a->ws + WS_CTL) + CW_BAR; b.x = xb_xcc_id(); b.st = (volatile LAS unsigned*)(lds + ST_OFF); xcd_barrier(b); }
__device__ __forceinline__ void gemm1_phase(LAS unsigned char* lds) { const ArgsP a = kargs(); const Ctx cx = mkctx(a); unsigned char* ws = cx.ws;
    SchedDense S{cx.G, cx.bx, 12, 0, D, (const char*)(ws + WS_W1T)}; EpiConvIn E{(bf16*)(ws + WS_GB), (bf16*)(ws + WS_U)};
    pg8::gemm_phase(lds, (const char*)(ws + WS_XB), D, S, E); }
__device__ __forceinline__ void gemm2_phase(LAS unsigned char* lds) { const ArgsP a = kargs(); const Ctx cx = mkctx(a); unsigned char* ws = cx.ws;
    SchedDense S{cx.G, cx.bx, 4, 1, D, (const char*)(ws + WS_W2T)}; EpiResZ<false> E{(const void*)a->x, (float*)(ws + WS_Z)};
    pg8::gemm_phase(lds, (const char*)(ws + WS_A2), D, S, E); }
__device__ __forceinline__ void kvq_phase(LAS unsigned char* lds) { const ArgsP a = kargs(); const Ctx cx = mkctx(a); unsigned char* ws = cx.ws;
    SchedDense S{cx.G, cx.bx, 12, 1, D, (const char*)(ws + WS_WKVQ)}; EpiKVQ E{(bf16*)(ws + WS_K)};
    pg8::gemm_phase(lds, (const char*)(ws + WS_X2B), D, S, E); }
__device__ __forceinline__ void wo_phase(LAS unsigned char* lds) { const ArgsP a = kargs(); const Ctx cx = mkctx(a); unsigned char* ws = cx.ws;
    SchedDense S{cx.G, cx.bx, 4, 1, D, (const char*)(ws + WS_WOT)}; EpiResZ<true> E{(const void*)(ws + WS_X2B), (float*)(ws + WS_Z)};
    pg8::gemm_phase(lds, (const char*)(ws + WS_A3), D, S, E); }
__device__ __forceinline__ void attn_phase(char* lds_generic) { const ArgsP a = kargs(); const Ctx cx = mkctx(a); unsigned char* ws = cx.ws;
#pragma unroll 1
    for (int uix = cx.bx; uix < BATCH * NH * 4 * (SEQ / 256); uix += cx.G) {
        const int combo = uix & 255, qi = uix >> 8;
        const int b = combo >> 5, h = (combo >> 2) & 7, c = (combo >> 1) & 1, vh = combo & 1;
        const int qb = (qi & 1) ? (SEQ / 256 - 1 - (qi >> 1)) : (qi >> 1);
        const attn_body::bf16* QK = (const attn_body::bf16*)(ws + WS_K) + h * 128 + c * 64;
        const attn_body::bf16* Vc = (const attn_body::bf16*)(ws + WS_V) + h * 128 + vh * 64;
        attn_body::bf16* Oc = (attn_body::bf16*)(ws + (c ? WS_O1 : WS_O0)) + h * 128 + vh * 64;
        attn_body::attn_unit<8>((long)b * SEQ, qb, QK + (WS_Q - WS_K) / 2, QK, Vc, Oc, lds_generic);
    }
}
__device__ __forceinline__ void moe_tables(LAS unsigned char* lds, int layer) { const ArgsP a = kargs(); const Ctx cx = mkctx(a); LAS int* misc = (LAS int*)(lds + MISC_OFF);
    const int* cnt = (const int*)(cx.ws + WS_CTL) + layer * NE;
    if (cx.tid < NE) misc[128 + cx.tid] = __hip_atomic_load(cnt + cx.tid, __ATOMIC_RELAXED, __HIP_MEMORY_SCOPE_AGENT);
    __syncthreads();
    if (cx.tid == 0) { int ub = 0, ps = 0; for (int e = 0; e < NE; ++e) { misc[e] = ub; misc[64 + e] = ps; const int rt = (misc[128 + e] + 255) >> 8; ub += 4 * rt; ps += 256 * rt; } misc[NE] = ub; misc[64 + NE] = ps; }
    __syncthreads(); }
__device__ __forceinline__ void moe_up_phase(LAS unsigned char* lds, int layer) { const ArgsP a = kargs(); const Ctx cx = mkctx(a); unsigned char* ws = cx.ws; LAS int* misc = (LAS int*)(lds + MISC_OFF);
    const MoeTab tb{misc, misc + 64, misc + 128};
    SchedMoe S{cx.G, cx.bx, D, true, (const char*)(ws + WS_WUT) + (size_t)layer * NE * D * D * 2, (const int*)(ws + WS_PERM), tb}; EpiUp E{(bf16*)(ws + WS_ACT)};
    pg8::gemm_phase(lds, (const char*)(ws + (layer == 0 ? WS_X1B : WS_X3B)), D, S, E); }
__device__ __forceinline__ void moe_down_phase(LAS unsigned char* lds, int layer) { const ArgsP a = kargs(); const Ctx cx = mkctx(a); unsigned char* ws = cx.ws; LAS int* misc = (LAS int*)(lds + MISC_OFF);
    const MoeTab tb{misc, misc + 64, misc + 128};
    SchedMoe S{cx.G, cx.bx, DE, false, (const char*)(ws + WS_WDT) + (size_t)layer * NE * D * DE * 2, (const int*)(ws + WS_PERM), tb};
    EpiDown E{(bf16*)(ws + WS_YP), (const int*)(ws + WS_PERM), (const float*)(ws + WS_GATE)};
    pg8::gemm_phase(lds, (const char*)(ws + WS_ACT), DE, S, E); }

__global__ void __launch_bounds__(NTHREADS, 2) fwd_megakernel(Args args_unused) {
    extern __shared__ __attribute__((aligned(16))) unsigned char lds_raw[];
#ifdef NOSYNC
    struct { __device__ void sync() const {} } grid;
#else
    cg::grid_group grid = cg::this_grid();
#endif
#define SEAM() seam(lds)
    LAS unsigned char* lds = (LAS unsigned char*)lds_raw;
#ifndef MKPASS
#define MKPASS 1
#endif
    { const ArgsP a = kargs(); int t = threadIdx.x; asm volatile("" : "+v"(t));
      if (t < 2) ((volatile LAS unsigned*)(lds + ST_OFF))[t] = 0u;
      if (blockIdx.x == 0) { unsigned* ctl = (unsigned*)(a->ws + WS_CTL); for (int i = t; i < CW_BAR + XCD_BAR_WORDS; i += NTHREADS) ctl[i] = 0u; } }
    __syncthreads();
#pragma unroll 1
    for (int pass_ = 0; pass_ < MKPASS; ++pass_) {
    if (pass_) SEAM();
    PH(0) p0_prologue(lds);
    if (pass_ == 0) { grid.sync();
      const ArgsP a = kargs(); (void)xcd_barrier_post((unsigned*)(a->ws + WS_CTL) + CW_BAR, (volatile LAS unsigned*)(lds + ST_OFF)); }
    else SEAM();
    PH(1) gemm1_phase(lds);
    SEAM();
    PH(2) conv_phase();
    SEAM();
    PH(3) gemm2_phase(lds);
    SEAM();
    PH(8) ln_router_phase(0, rep_ + pass_);
    SEAM();
    moe_tables(lds, 0);
    PH(9) moe_up_phase(lds, 0);
    SEAM();
    PH(10) moe_down_phase(lds, 0);
    SEAM();
    PH(11) ln2_phase(0);
    SEAM();
    PH(4) kvq_phase(lds);
    SEAM();
    PH(5) attn_phase((char*)lds_raw);
    SEAM();
    PH(6) combine_phase();
    SEAM();
    PH(7) wo_phase(lds);
    SEAM();
    PH(8) ln_router_phase(1, rep_ + pass_);
    SEAM();
    moe_tables(lds, 1);
    PH(9) moe_up_phase(lds, 1);
    SEAM();
    PH(10) moe_down_phase(lds, 1);
    SEAM();
    PH(11) ln2_phase(1);
    }
#pragma unroll 1
    for (int i = 0; i < MKSYNC; ++i) SEAM();
}
}

extern "C" void kernel_launch(void* const* d_in, const int* in_sizes, int n_in, void* d_out, int out_size, void* d_ws, size_t ws_size, hipStream_t stream) {
    using namespace mk;
    static int grid = 0;
    if (grid == 0) {
        if (n_in != 19 || out_size != T * D || ws_size < WS_END) { fprintf(stderr, "kernel_launch: unexpected shapes / workspace (n_in %d out %d ws %zu, need %zu)\n", n_in, out_size, ws_size, (size_t)WS_END); grid = -1; return; }
        int dev = 0, cus = 0, per_cu = 0;
        (void)hipGetDevice(&dev); (void)hipDeviceGetAttribute(&cus, hipDeviceAttributeMultiprocessorCount, dev);
        if (hipFuncSetAttribute((const void*)fwd_megakernel, hipFuncAttributeMaxDynamicSharedMemorySize, LDS_BYTES) != hipSuccess) { fprintf(stderr, "kernel_launch: hipFuncSetAttribute failed\n"); grid = -1; return; }
        if (hipOccupancyMaxActiveBlocksPerMultiprocessor(&per_cu, (const void*)fwd_megakernel, NTHREADS, LDS_BYTES) != hipSuccess || per_cu < 1) { fprintf(stderr, "kernel_launch: occupancy query says %d blocks per CU\n", per_cu); grid = -1; return; }
        grid = cus * 1;
        (void)hipGetLastError();
    }
    if (grid < 0) return;
    Args a{};
    a.x = (const float*)d_in[0]; a.a_w_in = (const float*)d_in[1]; a.a_conv_w = (const float*)d_in[2]; a.a_w_out = (const float*)d_in[3]; a.kv_w = (const float*)d_in[4];
    a.b_w_q = (const float*)d_in[5]; a.b_lambda = (const float*)d_in[6]; a.b_subln_g = (const float*)d_in[7]; a.b_w_o = (const float*)d_in[8];
    a.ln1_g = (const float*)d_in[9]; a.ln1_b = (const float*)d_in[10]; a.ln2_g = (const float*)d_in[11]; a.ln2_b = (const float*)d_in[12];
    a.rg_w = (const float*)d_in[13]; a.rg_b = (const float*)d_in[14]; a.re_w = (const float*)d_in[15]; a.re_b = (const float*)d_in[16];
    a.e_w_in = (const float*)d_in[17]; a.e_w_down = (const float*)d_in[18];
    a.out = (float*)d_out; a.ws = (unsigned char*)d_ws;
    void* kargs[] = {&a};
    const hipError_t e = hipLaunchCooperativeKernel((const void*)fwd_megakernel, dim3(grid), dim3(NTHREADS), kargs, LDS_BYTES, stream);
    if (e != hipSuccess) fprintf(stderr, "kernel_launch: cooperative launch failed: %s (grid %d)\n", hipGetErrorString(e), grid);
}
```

```cpp
#include <hip/hip_runtime.h>
#include <hip/hip_cooperative_groups.h>
#include <cstdio>
#include <cstdint>
namespace cg = cooperative_groups;

namespace pg8 {
#define PG8_LAS __attribute__((address_space(3)))
typedef unsigned short bf16_t;
typedef short bf16x8 __attribute__((ext_vector_type(8)));
typedef float f32x4 __attribute__((ext_vector_type(4)));
typedef unsigned u32x4 __attribute__((ext_vector_type(4)));
typedef unsigned u32x2 __attribute__((ext_vector_type(2)));
constexpr int BM = 256, BK = 64, HALF = 128, HTB = HALF * BK * 2  , STAGE_BYTES = 8 * HTB, NXCD = 8, WGM = 8;

__host__ __device__ __forceinline__ int lds_byte(int r, int c) { const int st = (r >> 4) * 2 + (c >> 5), rr = r & 15, cc = c & 31, ob = rr * 64 + cc * 2; return st * 1024 + (ob ^ (((ob >> 9) & 1) << 5)); }
__host__ __device__ __forceinline__ void stage_rc(int b, int& R, int& C) { const int st = b / 1024, sb = b % 1024, swz = sb ^ (((sb >> 9) & 1) << 5); R = (st >> 1) * 16 + swz / 64; C = (st & 1) * 32 + (swz % 64) / 2; }
__host__ __device__ __forceinline__ int perm32(int rho) { const int n = rho >> 4, i = rho & 15; return 8 * (i >> 2) + 4 * n + (i & 3); }

struct Unit { const char* b0; const char* b1; int arow; int p0, p1, p2; };

__device__ __forceinline__ bool static_tile(int i, int G, int c, int nM, int nN, int& pm, int& pn) {
    const int nwg = nM * nN; const long L = (long)i * G + c; if (L >= nwg) return false;
    int wgid = (int)L; { const int q = nwg / NXCD, r = nwg % NXCD, xcd = wgid % NXCD, off = wgid / NXCD; wgid = (xcd < r ? xcd * (q + 1) : r * (q + 1) + (xcd - r) * q) + off; }
    const int nig = WGM * nN, gid = wgid / nig, fm = gid * WGM, gsz = (nM - fm) < WGM ? (nM - fm) : WGM;
    pm = fm + ((wgid % nig) % gsz); pn = (wgid % nig) / gsz; return true;
}

__device__ __forceinline__ unsigned cvt_pk_bf16(float lo, float hi) { unsigned r; asm volatile("v_cvt_pk_bf16_f32 %0, %1, %2" : "=v"(r) : "v"(lo), "v"(hi)); return r; }

template <class Epi, class Sched>
__device__ __forceinline__ void gemm_phase(PG8_LAS unsigned char* lds, const char* Abase, const int K, const Sched& S, const Epi& E) {
    int tid_ = threadIdx.x; asm volatile("" : "+v"(tid_));
    const int tid = tid_, wid = __builtin_amdgcn_readfirstlane(tid >> 6), lane = tid & 63, wr = wid >> 2, wc = wid & 3, fr = lane & 15, fq = lane >> 4;
    const int nt = K / BK;
    int R[2], C[2]; unsigned voffB[2];
#pragma unroll
    for (int i = 0; i < 2; ++i) { stage_rc(tid * 16 + i * 8192, R[i], C[i]); const int Rb = Epi::PERM ? ((R[i] & ~31) + perm32(R[i] & 31)) : R[i]; voffB[i] = (unsigned)(Rb * K + C[i]) * 2u; }
    const size_t kstep = (size_t)(BK * 2);
    const unsigned ldsw = (unsigned)wid * 1024u;
    const int aoff = lds_byte(wr * 64 + fr, fq * 8), boff = lds_byte(wc * 32 + fr, fq * 8);
#define PG8_SA(b, h) (((b) * 2 + (h)) * HTB)
#define PG8_SB(b, h) ((4 + (b) * 2 + (h)) * HTB)
#define PG8_STAGE(bufoff, gbase, v0, v1) do { \
        __builtin_amdgcn_global_load_lds((const unsigned*)((const char*)(gbase) + (v0)), (PG8_LAS unsigned*)(lds + (bufoff) + ldsw), 16, 0, 0); \
        __builtin_amdgcn_global_load_lds((const unsigned*)((const char*)(gbase) + (v1)), (PG8_LAS unsigned*)(lds + (bufoff) + ldsw + 8192), 16, 0, 0); } while (0)
#define PG8_STAGEB(bufoff, gbase) PG8_STAGE(bufoff, gbase, voffB[0], voffB[1])
#define PG8_LDA(dst, b, h) do { _Pragma("unroll") for (int m = 0; m < 4; ++m) _Pragma("unroll") for (int k = 0; k < 2; ++k) dst[m][k] = *(const PG8_LAS bf16x8*)(lds + PG8_SA(b, h) + aoff + m * 2048 + k * 1024); } while (0)
#define PG8_LDB(dst, b, h) do { _Pragma("unroll") for (int n = 0; n < 2; ++n) _Pragma("unroll") for (int k = 0; k < 2; ++k) dst[n][k] = *(const PG8_LAS bf16x8*)(lds + PG8_SB(b, h) + boff + n * 2048 + k * 1024); } while (0)
#define PG8_MMA(ai, bj, At, Bt) do { __builtin_amdgcn_s_setprio(1); _Pragma("unroll") for (int m = 0; m < 4; ++m) _Pragma("unroll") for (int n = 0; n < 2; ++n) _Pragma("unroll") for (int k = 0; k < 2; ++k) \
        acc[ai][bj][m][n] = __builtin_amdgcn_mfma_f32_16x16x32_bf16(Bt[n][k], At[m][k], acc[ai][bj][m][n], 0, 0, 0); __builtin_amdgcn_s_setprio(0); } while (0)
#define PG8_WAIT_V(n) asm volatile("s_waitcnt vmcnt(" #n ")" ::: "memory")
#define PG8_WAIT_L(n) asm volatile("s_waitcnt lgkmcnt(" #n ")" ::: "memory")
#define PG8_BAR __builtin_amdgcn_s_barrier()
#define PG8_SCHED __builtin_amdgcn_sched_barrier(0)
    Unit cur, nxt; int ui = 0;
    if (!S.next(0, cur)) return;
    f32x4 acc[2][2][4][2];
#pragma unroll
    for (int a = 0; a < 2; ++a)
#pragma unroll
        for (int b = 0; b < 2; ++b)
#pragma unroll
            for (int m = 0; m < 4; ++m)
#pragma unroll
                for (int n = 0; n < 2; ++n) acc[a][b][m][n] = (f32x4){0.f, 0.f, 0.f, 0.f};
    bf16x8 At[4][2], B0[2][2], B1[2][2];
    unsigned vA00, vA01, vA10, vA11, vN00, vN01, vN10, vN11;
    S.a_offs(cur, R, C, vA00, vA01, vA10, vA11);
    const char* cB0 = cur.b0; const char* cB1 = cur.b1;
    PG8_STAGEB(PG8_SB(0, 0), cB0); PG8_STAGEB(PG8_SB(0, 1), cB1); PG8_STAGE(PG8_SA(0, 0), Abase, vA00, vA01); PG8_STAGE(PG8_SA(0, 1), Abase, vA10, vA11);
    if (wr == 1) PG8_BAR;
    PG8_WAIT_V(2); PG8_BAR;
    PG8_STAGEB(PG8_SB(1, 0), cB0 + kstep); PG8_STAGE(PG8_SA(1, 0), Abase + kstep, vA00, vA01); PG8_STAGEB(PG8_SB(1, 1), cB1 + kstep);
    PG8_WAIT_V(6); PG8_BAR;
    for (;;) {
        const bool has_next = S.next(ui + 1, nxt);
        if (has_next) S.a_offs(nxt, R, C, vN00, vN01, vN10, vN11); else { vN00 = vA00; vN01 = vA01; vN10 = vA10; vN11 = vA11; }
        const char* nB0 = has_next ? nxt.b0 : cB0; const char* nB1 = has_next ? nxt.b1 : cB1;
        for (int t = 0; t < nt; t += 2) {
            const bool last = (t == nt - 2);
            const char* a1 = Abase + (size_t)(t + 1) * kstep;
            PG8_LDB(B0, 0, 0); PG8_LDB(B1, 0, 1); PG8_SCHED; PG8_LDA(At, 0, 0); PG8_STAGE(PG8_SA(1, 1), a1, vA10, vA11);
            PG8_WAIT_V(8); PG8_WAIT_L(0); PG8_BAR; PG8_MMA(0, 0, At, B0); PG8_MMA(0, 1, At, B1); PG8_BAR; PG8_SCHED;
            if (last) { vA00 = vN00; vA01 = vN01; vA10 = vN10; vA11 = vN11; }
            const char* a2 = last ? Abase : Abase + (size_t)(t + 2) * kstep;
            const char* b20 = last ? nB0 : cB0 + (size_t)(t + 2) * kstep; const char* b21 = last ? nB1 : cB1 + (size_t)(t + 2) * kstep;
            const char* a3 = a2 + kstep; const char* b30 = b20 + kstep; const char* b31 = b21 + kstep;
            PG8_LDA(At, 0, 1); PG8_STAGEB(PG8_SB(0, 0), b20); PG8_STAGEB(PG8_SB(0, 1), b21); PG8_STAGE(PG8_SA(0, 0), a2, vA00, vA01);
            PG8_WAIT_V(8); PG8_WAIT_L(0); PG8_BAR; PG8_MMA(1, 0, At, B0); PG8_MMA(1, 1, At, B1); PG8_BAR; PG8_SCHED;
            PG8_LDB(B0, 1, 0); PG8_LDB(B1, 1, 1); PG8_SCHED; PG8_LDA(At, 1, 0); PG8_STAGE(PG8_SA(0, 1), a2, vA10, vA11);
            PG8_WAIT_V(8); PG8_WAIT_L(0); PG8_BAR; PG8_MMA(0, 0, At, B0); PG8_MMA(0, 1, At, B1); PG8_BAR; PG8_SCHED;
            PG8_LDA(At, 1, 1); PG8_STAGEB(PG8_SB(1, 0), b30); PG8_STAGEB(PG8_SB(1, 1), b31); PG8_STAGE(PG8_SA(1, 0), a3, vA00, vA01);
            PG8_WAIT_V(8); PG8_WAIT_L(0); PG8_BAR; PG8_MMA(1, 0, At, B0); PG8_MMA(1, 1, At, B1); PG8_BAR; PG8_SCHED;
        }
        if (wr == 0) PG8_BAR;
        E(acc, cur, wr, wc, fr, fq);
        if (!has_next) break;
#pragma unroll
        for (int a = 0; a < 2; ++a)
#pragma unroll
            for (int b = 0; b < 2; ++b)
#pragma unroll
                for (int m = 0; m < 4; ++m)
#pragma unroll
                    for (int n = 0; n < 2; ++n) acc[a][b][m][n] = (f32x4){0.f, 0.f, 0.f, 0.f};
        cur = nxt; cB0 = nB0; cB1 = nB1; ++ui;
        if (wr == 1) PG8_BAR;
    }
    PG8_WAIT_V(0);
    PG8_BAR;
#undef PG8_SA
#undef PG8_SB
#undef PG8_STAGE
#undef PG8_STAGEB
#undef PG8_LDA
#undef PG8_LDB
#undef PG8_MMA
#undef PG8_WAIT_V
#undef PG8_WAIT_L
#undef PG8_BAR
#undef PG8_SCHED
}
}
#include <hip/hip_bf16.h>
#include <cmath>
namespace attn_body {
using bf16=__hip_bfloat16;
using bf16x8=__attribute__((ext_vector_type(8)))short;
using s16x4=__attribute__((ext_vector_type(4)))short;
using f32x16=__attribute__((ext_vector_type(16)))float;
using u32x4=__attribute__((ext_vector_type(4)))unsigned;
constexpr int D=64,DM=1024;
constexpr int NW=8,QBLK=32,QB=QBLK*NW,KVBLK=64;
constexpr int ATTN_PITCH=DM, ATTN_UNIT_ROWS=QB;
__device__ __forceinline__ int crow(int r,int hi){return (r&3)+8*(r>>2)+4*hi;}
#define SBAR() __builtin_amdgcn_sched_barrier(0)
__device__ __forceinline__ void cmask(f32x16&p0,f32x16&p1,int jb,int qrel,int hi){
  const float NEG=-INFINITY; int kb=64*jb+4*hi;
  #pragma unroll
  for(int r=0;r<16;++r){int kv=kb+(r&3)+8*(r>>2); if(kv>qrel)p0[r]=NEG; if(kv+32>qrel)p1[r]=NEG;}
}

constexpr int NSLOT=3, SLOTB=8192;
constexpr int LDS_K=0, LDS_V=NSLOT*SLOTB, LDS_WS=2*NSLOT*SLOTB, LDS_OST=LDS_WS+NW*64*4, LDS_BYTES=LDS_OST+NW*4096;
constexpr float C2=0.125f*1.4426950408889634f;
__device__ __forceinline__ void glds16(const void*gsrc,unsigned lds_dst){unsigned keep;
  asm volatile("s_mov_b32 %0, m0\n\ts_mov_b32 m0, %2\n\ts_nop 0\n\tglobal_load_lds_dwordx4 %1, off\n\ts_mov_b32 m0, %0":"=&s"(keep):"v"(gsrc),"s"(lds_dst):"memory");}
__device__ __forceinline__ void glds16s(const void*sbase,unsigned voff,unsigned lds_dst){unsigned keep;
  asm volatile("s_mov_b32 %0, m0\n\ts_mov_b32 m0, %3\n\ts_nop 4\n\tglobal_load_lds_dwordx4 %1, %2\n\ts_mov_b32 m0, %0":"=&s"(keep):"v"(voff),"s"(sbase),"s"(lds_dst):"memory");}
__device__ __forceinline__ float max3f(float a,float b,float c){float r;asm("v_max3_f32 %0, %1, %2, %3":"=v"(r):"v"(a),"v"(b),"v"(c));return r;}
__device__ __forceinline__ float max2f(float a,float b){float r;asm("v_max_f32_e32 %0, %1, %2":"=v"(r):"v"(a),"v"(b));return r;}
__device__ __forceinline__ float fadd_s(float a,float b){float r;asm("v_add_f32_e32 %0, %1, %2":"=v"(r):"v"(a),"v"(b));return r;}
__device__ __forceinline__ float fsub_s(float a,float b){float r;asm("v_sub_f32_e32 %0, %1, %2":"=v"(r):"v"(a),"v"(b));return r;}
typedef float f32x2_t __attribute__((ext_vector_type(2))); typedef __bf16 bf16x2_t __attribute__((ext_vector_type(2)));
__device__ __forceinline__ unsigned cvtpk_s(float lo,float hi){f32x2_t v={lo,hi};bf16x2_t b=__builtin_convertvector(v,bf16x2_t);return __builtin_bit_cast(unsigned,b);}
#define WAIT_BAR(N) asm volatile("s_waitcnt vmcnt(" #N ") lgkmcnt(0)\n\ts_barrier":::"memory")

__device__ __forceinline__ void qkt(f32x16&p0,f32x16&p1,const char*Kslot,const bf16x8*qr,const f32x16&negm,int r32,int hi){
  const char*kb=Kslot+hi*1024+r32*16;
  #pragma unroll
  for(int d0=0;d0<4;++d0){
    const bf16x8 b0=*reinterpret_cast<const bf16x8*>(kb+d0*2048);
    const bf16x8 b1=*reinterpret_cast<const bf16x8*>(kb+d0*2048+512);
    if(d0==0){p0=__builtin_amdgcn_mfma_f32_32x32x16_bf16(b0,qr[0],negm,0,0,0);p1=__builtin_amdgcn_mfma_f32_32x32x16_bf16(b1,qr[0],negm,0,0,0);}
    else{p0=__builtin_amdgcn_mfma_f32_32x32x16_bf16(b0,qr[d0],p0,0,0,0);p1=__builtin_amdgcn_mfma_f32_32x32x16_bf16(b1,qr[d0],p1,0,0,0);}}
}
typedef __attribute__((address_space(3))) const char* lds_cptr;
typedef short v4i16_t __attribute__((ext_vector_type(4)));
__device__ __forceinline__ void kload8(bf16x8*kf,lds_cptr kp){
  kf[0]=*(const __attribute__((address_space(3))) bf16x8*)(kp);      kf[1]=*(const __attribute__((address_space(3))) bf16x8*)(kp+512);
  kf[2]=*(const __attribute__((address_space(3))) bf16x8*)(kp+2048); kf[3]=*(const __attribute__((address_space(3))) bf16x8*)(kp+2560);
  kf[4]=*(const __attribute__((address_space(3))) bf16x8*)(kp+4096); kf[5]=*(const __attribute__((address_space(3))) bf16x8*)(kp+4608);
  kf[6]=*(const __attribute__((address_space(3))) bf16x8*)(kp+6144); kf[7]=*(const __attribute__((address_space(3))) bf16x8*)(kp+6656);
}
__device__ __forceinline__ void kload2(bf16x8*kf,lds_cptr kp,int j){ kf[2*j]=*(const __attribute__((address_space(3))) bf16x8*)(kp+j*2048); kf[2*j+1]=*(const __attribute__((address_space(3))) bf16x8*)(kp+j*2048+512); }
__device__ __forceinline__ s16x4 vtr(lds_cptr p){ return __builtin_bit_cast(s16x4,__builtin_amdgcn_ds_read_tr16_b64_v4i16((__attribute__((address_space(3))) v4i16_t*)p)); }
__device__ __forceinline__ float rowmax(const f32x16&p0,const f32x16&p1){
  float a=max3f(p0[0],p0[1],p1[0]),b=max3f(p0[2],p0[3],p1[1]);a=max3f(a,p1[2],p1[3]);
  #pragma unroll
  for(int r=4;r<16;r+=4){a=max3f(a,p0[r],p0[r+1]);b=max3f(b,p0[r+2],p0[r+3]);a=max3f(a,p1[r],p1[r+1]);b=max3f(b,p1[r+2],p1[r+3]);}
  const float m=max2f(a,b);
  auto rr=__builtin_amdgcn_permlane32_swap(__float_as_uint(m),__float_as_uint(m),false,false);
  return max2f(__uint_as_float(rr[0]),__uint_as_float(rr[1]));
}
__device__ __forceinline__ void pv(f32x16*o,int vb,bf16x8 pa0,bf16x8 pa1,bf16x8 pa2,bf16x8 pa3){
  #pragma unroll
  for(int d0=0;d0<2;++d0){s16x4 lo[4],hi[4];
    #pragma unroll
    for(int ks=0;ks<4;++ks){
      asm volatile("ds_read_b64_tr_b16 %0,%1 offset:%c2":"=&v"(lo[ks]):"v"(vb),"i"(d0*4096+ks*1024):"memory");
      asm volatile("ds_read_b64_tr_b16 %0,%1 offset:%c2":"=&v"(hi[ks]):"v"(vb),"i"(d0*4096+ks*1024+512):"memory");}
    asm volatile("s_waitcnt lgkmcnt(0)":::"memory");SBAR();
    #define PK(k) (bf16x8){lo[k][0],lo[k][1],lo[k][2],lo[k][3],hi[k][0],hi[k][1],hi[k][2],hi[k][3]}
    o[d0]=__builtin_amdgcn_mfma_f32_32x32x16_bf16(pa0,PK(0),o[d0],0,0,0);
    o[d0]=__builtin_amdgcn_mfma_f32_32x32x16_bf16(pa1,PK(1),o[d0],0,0,0);
    o[d0]=__builtin_amdgcn_mfma_f32_32x32x16_bf16(pa2,PK(2),o[d0],0,0,0);
    o[d0]=__builtin_amdgcn_mfma_f32_32x32x16_bf16(pa3,PK(3),o[d0],0,0,0);
    #undef PK
  }
}

#ifndef ATTN_STORE16
#define ATTN_STORE16(p,v) (*(u32x4*)(p)=(v))
#endif
template<int THRL> __device__ __forceinline__ void attn_unit(long rowbase,int qb,const bf16*Qc,const bf16*__restrict__ Kc,const bf16*__restrict__ Vc,bf16*Oc,char*shm){
  int tid_=threadIdx.x; asm volatile("":"+v"(tid_)); const int tid=tid_,lane=tid&63,r32=lane&31,hi=lane>>5; const int wid=__builtin_amdgcn_readfirstlane(tid>>6);
  const int q0=qb*QB;
  const bf16*Qw=Qc+(rowbase+q0+wid*QBLK)*DM;
  const bf16*Kh=Kc+rowbase*DM,*Vh=Vc+rowbase*DM;
  const unsigned lds0=(unsigned)(uintptr_t)shm;
  float*wsf=(float*)(shm+LDS_WS)+wid*64;
  const unsigned koff=(unsigned)(lane*DM+wid*8)*2u;
  const unsigned voffv=(unsigned)((16*(wid&3)+(lane>>2))*DM+(wid>>2)*32+(lane&3)*8)*2u;
  const unsigned kdst=lds0+LDS_K+wid*1024, vdst=lds0+LDS_V+wid*1024;
  #define DMA_K(t,slot) glds16s(Kh+(long)(t)*KVBLK*DM,koff,(unsigned)__builtin_amdgcn_readfirstlane(kdst+(slot)))
  #define DMA_V(t,slot) glds16s(Vh+(long)(t)*KVBLK*DM,voffv,(unsigned)__builtin_amdgcn_readfirstlane(vdst+(slot)))
  const int vb0=(int)(lds0+LDS_V)+((lane>>4)&1)*32+(lane&3)*8+(4*hi+((lane&15)>>2))*64;
  const char*Kbase=shm+LDS_K; bf16x8 kf[8];
  const lds_cptr shm3=(lds_cptr)shm; const lds_cptr kp0=shm3+LDS_K+hi*1024+r32*16; const lds_cptr vp0=shm3+LDS_V+((lane>>4)&1)*32+(lane&3)*8+(4*hi+((lane&15)>>2))*64;
  const int NT=(q0+QB)/KVBLK;
  DMA_K(0,0);DMA_V(0,0);DMA_K(1,SLOTB);
  bf16x8 qr[4];
  #pragma unroll
  for(int d0=0;d0<4;++d0)qr[d0]=*reinterpret_cast<const bf16x8*>(&Qw[(long)r32*DM+d0*16+hi*8]);
  float mhat=0.f,l_reg=0.f;f32x16 o[2];o[0]=f32x16{};o[1]=f32x16{};f32x16 negm=f32x16{};asm volatile("":"+v"(negm));
  const int qrel=wid*QBLK+r32;
  #define CMASK(P0,P1,t) do{int jb_=(t)-(NT-4); if(jb_>=0)cmask(P0,P1,jb_,qrel,hi);}while(0)
  bool resc=false;
  #define START(P0,P1) do{ const float rm=rowmax(P0,P1); resc=false; \
    { const float dl=rm; mhat=fadd_s(mhat,dl); \
      _Pragma("unroll") for(int r=0;r<16;++r){P0[r]=fsub_s(P0[r],dl);P1[r]=fsub_s(P1[r],dl);} \
      _Pragma("unroll") for(int r=0;r<16;++r)negm[r]=-mhat; asm volatile("":"+v"(negm)); } \
    _Pragma("unroll") for(int r=0;r<16;++r)P0[r]=__builtin_amdgcn_exp2f(P0[r]); }while(0)
  #define RESC() do{ if(resc){ asm volatile("s_waitcnt lgkmcnt(0)":::"memory"); \
      _Pragma("unroll") for(int d_=0;d_<2;++d_) _Pragma("unroll") for(int r=0;r<16;++r)o[d_][r]*=wsf[crow(r,hi)]; } }while(0)
  f32x16 pA0,pA1,pB0,pB1;
  int sl_prev=0,sl_cur=0,sl_next=SLOTB;
  #define ROT() do{sl_prev=sl_cur;sl_cur=sl_next;sl_next=(sl_next==(NSLOT-1)*SLOTB)?0:sl_next+SLOTB;}while(0)
  DMA_K(2,2*SLOTB);
  WAIT_BAR(3);
  qkt(pA0,pA1,Kbase,qr,negm,r32,hi);asm volatile("s_nop 15\n\ts_nop 7":"+v"(pA0),"+v"(pA1));CMASK(pA0,pA1,0);
  START(pA0,pA1);
  _Pragma("unroll") for(int r=0;r<16;++r)pA1[r]=__builtin_amdgcn_exp2f(pA1[r]);
  WAIT_BAR(0);
  DMA_K(3,0);DMA_V(1,SLOTB);
  ROT();
  kload8(kf,kp0+sl_cur);
  WAIT_BAR(2);
  s16x4 vlo[8],vhi[8]; u32x4 pw0,pw1,pw2,pw3;
  #define PKW(P,B) cvtpk_s(P[B],P[B+1])
  #define PAF(k) __builtin_bit_cast(bf16x8,pw##k)
  #define VFR(i) (bf16x8){vlo[i][0],vlo[i][1],vlo[i][2],vlo[i][3],vhi[i][0],vhi[i][1],vhi[i][2],vhi[i][3]}
  #define PIN(x) asm volatile("":"+v"(x))
  #define MX3(a,b,c) __builtin_fmaxf(__builtin_fmaxf((a),(b)),(c))
  #define GAPA(MF,A0,A1,A2,A3,W0,W1,PW) do{ MF; sacc+=A0; sacc+=A1; sacc+=A2; sacc+=A3; PIN(sacc); W0; W1; PIN(PW); SBAR(); }while(0)
  #define EX(v) __builtin_amdgcn_exp2f(v)
  #define GAPB(MF,X,B) do{ MF; X[B]=EX(X[B]); X[B+1]=EX(X[B+1]); X[B+2]=EX(X[B+2]); X[B+3]=EX(X[B+3]); PIN(X); SBAR(); }while(0)
  #define VRD(i) do{ vlo[i]=vtr(vp_+(((i)>>2)*4096+((i)&3)*1024)); vhi[i]=vtr(vp_+(((i)>>2)*4096+((i)&3)*1024+512)); }while(0)
  #define KRD(G,j) do{ if(G){ kload2(kf,kp0+sl_next,j); SBAR(); } }while(0)
  #define STEP(C0,C1,P0,P1,t,GK,GV,GL) do{ SBAR(); \
    const lds_cptr vp_=vp0+sl_prev; \
    VRD(0); SBAR(); float sacc=(P0[0]+P0[1]); \
    GAPA(C0=__builtin_amdgcn_mfma_f32_32x32x16_bf16(kf[0],qr[0],negm,0,0,0), P0[2],P0[3],P0[4],P0[5],     pw0[0]=PKW(P0,0), pw0[1]=PKW(P0,2), pw0); \
    VRD(4); SBAR(); GAPA(C1=__builtin_amdgcn_mfma_f32_32x32x16_bf16(kf[1],qr[0],negm,0,0,0), P0[6],P0[7],P0[8],P0[9],     pw0[2]=PKW(P0,4), pw0[3]=PKW(P0,6), pw0); \
    VRD(1); SBAR(); GAPA(C0=__builtin_amdgcn_mfma_f32_32x32x16_bf16(kf[2],qr[1],C0,0,0,0),   P0[10],P0[11],P0[12],P0[13], pw1[0]=PKW(P0,8), pw1[1]=PKW(P0,10), pw1); \
    VRD(5); SBAR(); GAPA(C1=__builtin_amdgcn_mfma_f32_32x32x16_bf16(kf[3],qr[1],C1,0,0,0),   P0[14],P0[15],P1[0],P1[1],   pw1[2]=PKW(P0,12),pw1[3]=PKW(P0,14), pw1); \
    VRD(2); SBAR(); GAPA(C0=__builtin_amdgcn_mfma_f32_32x32x16_bf16(kf[4],qr[2],C0,0,0,0),   P1[2],P1[3],P1[4],P1[5],     pw2[0]=PKW(P1,0), pw2[1]=PKW(P1,2), pw2); \
    VRD(6); SBAR(); GAPA(C1=__builtin_amdgcn_mfma_f32_32x32x16_bf16(kf[5],qr[2],C1,0,0,0),   P1[6],P1[7],P1[8],P1[9],     pw2[2]=PKW(P1,4), pw2[3]=PKW(P1,6), pw2); \
    VRD(3); SBAR(); GAPA(C0=__builtin_amdgcn_mfma_f32_32x32x16_bf16(kf[6],qr[3],C0,0,0,0),   P1[10],P1[11],P1[12],P1[13], pw3[0]=PKW(P1,8), pw3[1]=PKW(P1,10), pw3); \
    VRD(7); SBAR(); GAPA(C1=__builtin_amdgcn_mfma_f32_32x32x16_bf16(kf[7],qr[3],C1,0,0,0),   P1[14],P1[15],0.f,0.f,       pw3[2]=PKW(P1,12),pw3[3]=PKW(P1,14), pw3); \
    l_reg+=sacc; \
    if(GK){DMA_K((t)+3,sl_cur);} if(GV){DMA_V((t)+1,sl_next);} \
    CMASK(C0,C1,t); \
    { float a=MX3(C0[0],C0[1],C1[0]),b=MX3(C0[2],C0[3],C1[1]); a=MX3(a,C1[2],C1[3]); \
      _Pragma("unroll") for(int r=4;r<16;r+=4){a=MX3(a,C0[r],C0[r+1]);b=MX3(b,C0[r+2],C0[r+3]);a=MX3(a,C1[r],C1[r+1]);b=MX3(b,C1[r+2],C1[r+3]);} \
      float rm=__builtin_fmaxf(a,b); { auto rr=__builtin_amdgcn_permlane32_swap(__float_as_uint(rm),__float_as_uint(rm),false,false); rm=__builtin_fmaxf(__uint_as_float(rr[0]),__uint_as_float(rr[1])); } \
      resc=false; \
      if(__builtin_expect(__any(rm>(float)THRL),0)){ const float dl=__builtin_fmaxf(rm,0.f); mhat+=dl; \
        _Pragma("unroll") for(int r=0;r<16;++r){C0[r]-=dl;C1[r]-=dl;} \
        _Pragma("unroll") for(int r=0;r<16;++r)negm[r]=-mhat; asm volatile("":"+v"(negm)); \
        const float f=__builtin_amdgcn_exp2f(-dl); l_reg*=f; if(hi==0)wsf[r32]=f; resc=true; } } \
    SBAR(); \
    GAPB(o[0]=__builtin_amdgcn_mfma_f32_32x32x16_bf16(PAF(0),VFR(0),o[0],0,0,0), C0,0); \
    GAPB(o[1]=__builtin_amdgcn_mfma_f32_32x32x16_bf16(PAF(0),VFR(4),o[1],0,0,0), C0,4); \
    KRD(GL,0); GAPB(o[0]=__builtin_amdgcn_mfma_f32_32x32x16_bf16(PAF(1),VFR(1),o[0],0,0,0), C0,8); \
    KRD(GL,1); GAPB(o[1]=__builtin_amdgcn_mfma_f32_32x32x16_bf16(PAF(1),VFR(5),o[1],0,0,0), C0,12); \
    KRD(GL,2); GAPB(o[0]=__builtin_amdgcn_mfma_f32_32x32x16_bf16(PAF(2),VFR(2),o[0],0,0,0), C1,0); \
    KRD(GL,3); GAPB(o[1]=__builtin_amdgcn_mfma_f32_32x32x16_bf16(PAF(2),VFR(6),o[1],0,0,0), C1,4); \
    GAPB(o[0]=__builtin_amdgcn_mfma_f32_32x32x16_bf16(PAF(3),VFR(3),o[0],0,0,0), C1,8); \
    GAPB(o[1]=__builtin_amdgcn_mfma_f32_32x32x16_bf16(PAF(3),VFR(7),o[1],0,0,0), C1,12); \
    }while(0)
  int t=1;
  #undef CMASK
  #define CMASK(P0,P1,t) do{}while(0)
  for(;t+5<NT;t+=2){
    STEP(pB0,pB1,pA0,pA1,t,true,true,true);     WAIT_BAR(2); RESC(); ROT();
    STEP(pA0,pA1,pB0,pB1,t+1,true,true,true);   WAIT_BAR(2); RESC(); ROT();
  }
  #undef CMASK
  #define CMASK(P0,P1,t) do{int jb_=(t)-(NT-4); if(jb_>=0)cmask(P0,P1,jb_,qrel,hi);}while(0)
  #define ENDW(tt) do{ if((tt)+3<NT){WAIT_BAR(2);} else if((tt)+2<NT){WAIT_BAR(1);} else {WAIT_BAR(0);} }while(0)
  for(;t+1<NT;t+=2){
    STEP(pB0,pB1,pA0,pA1,t,(t+3<NT),(t+1<NT),(t+1<NT));       ENDW(t);   RESC(); ROT();
    STEP(pA0,pA1,pB0,pB1,t+1,(t+4<NT),(t+2<NT),(t+2<NT));     ENDW(t+1); RESC(); ROT();
  }
  STEP(pB0,pB1,pA0,pA1,NT-1,false,false,false); RESC();
  { float sacc=pB0[0]+pB0[1]; _Pragma("unroll") for(int r=2;r<16;++r)sacc+=pB0[r]; _Pragma("unroll") for(int r=0;r<16;++r)sacc+=pB1[r]; l_reg+=sacc;
    pw0=(u32x4){PKW(pB0,0),PKW(pB0,2),PKW(pB0,4),PKW(pB0,6)};pw1=(u32x4){PKW(pB0,8),PKW(pB0,10),PKW(pB0,12),PKW(pB0,14)};pw2=(u32x4){PKW(pB1,0),PKW(pB1,2),PKW(pB1,4),PKW(pB1,6)};pw3=(u32x4){PKW(pB1,8),PKW(pB1,10),PKW(pB1,12),PKW(pB1,14)};
    SBAR(); pv(o,vb0+sl_cur,PAF(0),PAF(1),PAF(2),PAF(3)); }
  #undef PKW
  #undef PAF
  #undef VFR
  #undef PIN
  #undef MX3
  #undef GAPA
  #undef GAPB
  #undef EX
  #undef VRD
  #undef KRD
  #undef STEP
  #undef ENDW
  {auto rr=__builtin_amdgcn_permlane32_swap(__float_as_uint(l_reg),__float_as_uint(l_reg),false,false);l_reg=__uint_as_float(rr[0])+__uint_as_float(rr[1]);}
  if(hi==0)wsf[32+r32]=l_reg;asm volatile("s_waitcnt lgkmcnt(0)":::"memory");
  float rli[16];
  #pragma unroll
  for(int r=0;r<16;++r)rli[r]=__builtin_amdgcn_rcpf(wsf[32+crow(r,hi)]);
  bf16*Ow=Oc+(rowbase+q0+wid*QBLK)*DM;
  { bf16*stg=(bf16*)(shm+LDS_OST)+wid*2048;
    #pragma unroll
    for(int r=0;r<16;++r){const int orow=crow(r,hi);
      #pragma unroll
      for(int d0=0;d0<2;++d0)stg[orow*64+d0*32+r32]=__float2bfloat16(o[d0][r]*rli[r]);}
    asm volatile("s_waitcnt lgkmcnt(0)":::"memory");
    #pragma unroll
    for(int i=0;i<4;++i){const int row=i*8+(lane>>3),ch=lane&7; const u32x4 v=*(const u32x4*)(stg+row*64+ch*8); ATTN_STORE16(Ow+(long)row*DM+ch*8,v);} }
  asm volatile("s_waitcnt lgkmcnt(0)\n\ts_barrier":::"memory");
  #undef DMA_K
  #undef DMA_V
  #undef CMASK
  #undef START
  #undef RESC
  #undef ROT
}
constexpr int ATTN_LDS_BYTES=LDS_BYTES;
#undef SBAR
#undef WAIT_BAR
}
namespace mk {
#define GAS __attribute__((address_space(1)))
#define LAS __attribute__((address_space(3)))
typedef unsigned short bf16;
typedef unsigned v4u __attribute__((ext_vector_type(4)));
typedef unsigned v2u __attribute__((ext_vector_type(2)));
typedef float f32x4 __attribute__((ext_vector_type(4)));
using pg8::Unit;
using pg8::cvt_pk_bf16;

constexpr int D = 1024, BATCH = 8, SEQ = 2048, T = BATCH * SEQ, NH = 8, NG = 4, EPG = 8, NE = 32, DE = 512, NRW = NG + NE;
constexpr float ALPHA = 1.4142135623730951f, LN_EPS = 1e-5f, RMS_EPS = 1e-5f;
constexpr float LAM_INIT = 0.35550906f;
constexpr float QSCALE = 0.125f * 1.4426950408889634f;
constexpr int CNT_STRIDE = 64;
constexpr int CAP = 2 * T;
constexpr int NWAVES = 8, NTHREADS = 512;

constexpr size_t MiB = 1u << 20;
constexpr size_t WS_CTL = 0, WS_W1T = 1 * MiB, WS_W2T = 7 * MiB, WS_WKVQ = 9 * MiB, WS_WOT = 15 * MiB, WS_RWT = 17 * MiB, WS_PERM = 18 * MiB, WS_GATE = 22 * MiB;
constexpr size_t WS_WUT = 24 * MiB, WS_WDT = 152 * MiB, WS_XB = 216 * MiB, WS_GB = 248 * MiB, WS_U = 280 * MiB, WS_A2 = 312 * MiB, WS_Z = 344 * MiB, WS_X1B = 408 * MiB;
constexpr size_t WS_ACT = 440 * MiB, WS_YP = 480 * MiB, WS_X2B = 544 * MiB, WS_K = 576 * MiB, WS_V = 608 * MiB, WS_Q = 640 * MiB, WS_O0 = 672 * MiB, WS_O1 = 704 * MiB;
constexpr size_t WS_A3 = 736 * MiB, WS_X3B = 768 * MiB;
#ifdef MKPROBE
constexpr size_t WS_Z1 = 800 * MiB, WS_ACT1 = 864 * MiB, WS_YP1 = 904 * MiB, WS_PERM1 = 968 * MiB, WS_GATE1 = 972 * MiB, WS_END = 973 * MiB;
#else
constexpr size_t WS_Z1 = WS_Z, WS_ACT1 = WS_ACT, WS_YP1 = WS_YP, WS_PERM1 = WS_PERM, WS_GATE1 = WS_GATE, WS_END = 800 * MiB;
#endif
#define LZ(l) ((l) ? WS_Z1 : WS_Z)
#define LACT(l) ((l) ? WS_ACT1 : WS_ACT)
#define LYP(l) ((l) ? WS_YP1 : WS_YP)
#define LPERM(l) ((l) ? WS_PERM1 : WS_PERM)
#define LGATE(l) ((l) ? WS_GATE1 : WS_GATE)
constexpr int RING_BYTES = 131072, RW_BYTES = 147456  , MISC_OFF = RW_BYTES, LDS_BYTES = 163840;

struct Args {
    const float *x, *a_w_in, *a_conv_w, *a_w_out, *kv_w, *b_w_q, *b_lambda, *b_subln_g, *b_w_o, *ln1_g, *ln1_b, *ln2_g, *ln2_b, *rg_w, *rg_b, *re_w, *re_b, *e_w_in, *e_w_down;
    float* out; unsigned char* ws;
};

typedef const __attribute__((address_space(4))) Args* ArgsP;
__device__ __forceinline__ ArgsP kargs() { ArgsP p = (ArgsP)__builtin_amdgcn_kernarg_segment_ptr(); asm volatile("" : "+s"(p)); return p; }
struct Ctx { int tid, lane, wave, G, bx, gw, NGW; unsigned char* ws; };
__device__ __forceinline__ Ctx mkctx(ArgsP ap) { Ctx c; int t = threadIdx.x; asm volatile("" : "+v"(t)); c.tid = t; c.lane = t & 63; c.wave = __builtin_amdgcn_readfirstlane(t >> 6);
    c.G = gridDim.x; c.bx = blockIdx.x; c.gw = c.bx * 8 + c.wave; c.NGW = c.G * 8; c.ws = ap->ws; return c; }
__device__ __forceinline__ unsigned f2bf(float f) { unsigned u = __builtin_bit_cast(unsigned, f); return (u + 0x7fffu + ((u >> 16) & 1u)) >> 16; }
__device__ __forceinline__ unsigned pk2(float lo, float hi) { return f2bf(lo) | (f2bf(hi) << 16); }
__device__ __forceinline__ float bflo(unsigned w) { return __builtin_bit_cast(float, w << 16); }
__device__ __forceinline__ float bfhi(unsigned w) { return __builtin_bit_cast(float, w & 0xffff0000u); }
__device__ __forceinline__ float wave_sum(float v) {
#pragma unroll
    for (int o = 1; o < 64; o <<= 1) v += __shfl_xor(v, o);
    return v;
}

__device__ __forceinline__ float dpp_add(float v, const int ctrl_sel) {
    const int iv = __builtin_bit_cast(int, v); int t;
    if (ctrl_sel == 0) t = __builtin_amdgcn_update_dpp(0, iv, 0xB1, 0xF, 0xF, true);
    else if (ctrl_sel == 1) t = __builtin_amdgcn_update_dpp(0, iv, 0x4E, 0xF, 0xF, true);
    else if (ctrl_sel == 2) t = __builtin_amdgcn_update_dpp(0, iv, 0x141, 0xF, 0xF, true);
    else if (ctrl_sel == 3) t = __builtin_amdgcn_update_dpp(0, iv, 0x140, 0xF, 0xF, true);
    else if (ctrl_sel == 4) t = __builtin_amdgcn_update_dpp(0, iv, 0x142, 0xA, 0xF, false);
    else t = __builtin_amdgcn_update_dpp(0, iv, 0x143, 0xC, 0xF, false);
    return v + __builtin_bit_cast(float, t);
}
template <int N> __device__ __forceinline__ void dpp_sum(float (&v)[N]) {
#pragma unroll
    for (int st = 0; st < 6; ++st) {
#pragma unroll
        for (int i = 0; i < N; ++i) v[i] = dpp_add(v[i], st);
    }
#pragma unroll
    for (int i = 0; i < N; ++i) v[i] = __builtin_bit_cast(float, __builtin_amdgcn_readlane(__builtin_bit_cast(int, v[i]), 63));
}
__device__ __forceinline__ float dpp_sum1(float v) { float a[1] = {v}; dpp_sum(a); return a[0]; }

__device__ __forceinline__ void p0_transpose_item(const float* W, int K, int N, bf16* WT, int row_off, LAS float* scr, int item, int lane) {
    const int nblk = N / 32, kb = item / nblk, nb = item % nblk, k0 = 64 * kb, n0 = 32 * nb;
#pragma unroll 8
    for (int i = 0; i < 32; ++i) { const int kk = 2 * i + (lane >> 5); scr[kk * 33 + (lane & 31)] = W[(size_t)(k0 + kk) * N + n0 + (lane & 31)]; }
    asm volatile("s_waitcnt lgkmcnt(0)" ::: "memory");
    const int c = lane & 7;
#pragma unroll
    for (int j = 0; j < 4; ++j) { const int n = (lane >> 3) + 8 * j; const LAS float* s = scr + (8 * c) * 33 + n;
        v4u o; o.x = pk2(s[0 * 33], s[1 * 33]); o.y = pk2(s[2 * 33], s[3 * 33]); o.z = pk2(s[4 * 33], s[5 * 33]); o.w = pk2(s[6 * 33], s[7 * 33]);
        *(GAS v4u*)(WT + (size_t)(row_off + n0 + n) * K + k0 + 8 * c) = o; }
    asm volatile("s_waitcnt lgkmcnt(0)" ::: "memory");
}

__device__ __forceinline__ void p0_prologue(LAS unsigned char* lds) {
    const ArgsP a = kargs(); const Ctx cx = mkctx(a); const int gw = cx.gw, NGW = cx.NGW, wave = cx.wave, lane = cx.lane;
    unsigned char* ws = cx.ws;
    LAS float* scr = (LAS float*)(lds + wave * 16384);
    constexpr int I_IN = 16 * 96, I_SQ = 16 * 32, I_KV = 16 * 64, I_DN = 8 * 32;
    constexpr int S1 = I_IN, S2 = S1 + I_SQ, S3 = S2 + I_KV, S4 = S3 + I_SQ, S5 = S4 + I_SQ, S6 = S5 + 64 * I_SQ, NITEMS = S6 + 64 * I_DN;
    for (int it = gw; it < NITEMS; it += NGW) {
        if (it < S1) p0_transpose_item(a->a_w_in, D, 3 * D, (bf16*)(ws + WS_W1T), 0, scr, it, lane);
        else if (it < S2) p0_transpose_item(a->a_w_out, D, D, (bf16*)(ws + WS_W2T), 0, scr, it - S1, lane);
        else if (it < S3) p0_transpose_item(a->kv_w, D, 2 * D, (bf16*)(ws + WS_WKVQ), 0, scr, it - S2, lane);
        else if (it < S4) p0_transpose_item(a->b_w_q, D, D, (bf16*)(ws + WS_WKVQ), 2 * D, scr, it - S3, lane);
        else if (it < S5) p0_transpose_item(a->b_w_o, D, D, (bf16*)(ws + WS_WOT), 0, scr, it - S4, lane);
        else if (it < S6) { const int r = it - S5, mtx = r / I_SQ; p0_transpose_item(a->e_w_in + (size_t)mtx * D * D, D, D, (bf16*)(ws + WS_WUT) + (size_t)mtx * D * D, 0, scr, r % I_SQ, lane); }
        else { const int r = it - S6, mtx = r / I_DN; p0_transpose_item(a->e_w_down + (size_t)mtx * DE * D, DE, D, (bf16*)(ws + WS_WDT) + (size_t)mtx * D * DE, 0, scr, r % I_DN, lane); }
    }
    for (int m = gw; m < T; m += NGW) {
        const GAS f32x4* xr = (const GAS f32x4*)(a->x + (size_t)m * D) + lane;
        GAS v2u* o = (GAS v2u*)((bf16*)(ws + WS_XB) + (size_t)m * D) + lane;
#pragma unroll
        for (int j = 0; j < 4; ++j) { const f32x4 v = xr[64 * j]; v2u w; w.x = pk2(v.x, v.y); w.y = pk2(v.z, v.w); o[64 * j] = w; }
    }
    { float* rwt = (float*)(ws + WS_RWT);
      for (int idx = gw * 64 + lane; idx < 2 * NRW * D; idx += NGW * 64) { const int l = idx / (NRW * D), n = (idx / D) % NRW, k = idx % D;
          rwt[idx] = n < NG ? a->rg_w[((size_t)l * D + k) * NG + n] : a->re_w[((size_t)l * D + k) * NE + (n - NG)]; } }
}

struct SchedDense {
    int G, c, nN, mode, K; const char* W;
    __device__ __forceinline__ bool next(int i, Unit& u) const {
        int pm, pn; if (!pg8::static_tile(i, G, c, T / 256, nN, pm, pn)) return false;
        u.arow = pm * 256; u.p0 = pm; u.p1 = pn; u.p2 = 0;
        const size_t rb = (size_t)K * 2;
        if (mode == 0 && pn >= 4) { const int jj = pn - 4; u.b0 = W + (size_t)(D + 128 * jj) * rb; u.b1 = W + (size_t)(2 * D + 128 * jj) * rb; }
        else { u.b0 = W + (size_t)(256 * pn) * rb; u.b1 = u.b0 + 128 * rb; }
        return true;
    }
    __device__ __forceinline__ void a_offs(const Unit& u, const int (&R)[2], const int (&C)[2], unsigned& v00, unsigned& v01, unsigned& v10, unsigned& v11) const {
        v00 = (unsigned)((u.arow + R[0]) * K + C[0]) * 2u; v01 = (unsigned)((u.arow + R[1]) * K + C[1]) * 2u;
        v10 = (unsigned)((u.arow + 128 + R[0]) * K + C[0]) * 2u; v11 = (unsigned)((u.arow + 128 + R[1]) * K + C[1]) * 2u;
    }
};
struct MoeTab { const LAS int* ub; const LAS int* ps; const LAS int* cn; };
struct SchedMoe {
    int G, c, K; bool up; const char* W; const int* perm; MoeTab tb;
    __device__ __forceinline__ bool next(int i, Unit& u) const {
        const int idx = i * G + c; if (idx >= tb.ub[NE]) return false;
        int e = 0;
#pragma unroll 1
        for (int k = 1; k < NE; ++k) if (idx >= tb.ub[k]) e = k;
        const int local = idx - tb.ub[e], rtn = (tb.ub[e + 1] - tb.ub[e]) >> 2, ct = local / rtn, rti = local - ct * rtn;
        const size_t rb = (size_t)K * 2; const char* We = W + (size_t)e * D * rb;
        if (up) { u.b0 = We + (size_t)(128 * ct) * rb; u.b1 = We + (size_t)(DE + 128 * ct) * rb; u.arow = e * CAP + rti * 256; u.p0 = tb.ps[e] + rti * 256; }
        else { u.b0 = We + (size_t)(256 * ct) * rb; u.b1 = u.b0 + 128 * rb; u.arow = tb.ps[e] + rti * 256; u.p0 = e * CAP + rti * 256; }
        u.p1 = ct; u.p2 = tb.cn[e] - rti * 256;
        return true;
    }
    __device__ __forceinline__ void a_offs(const Unit& u, const int (&R)[2], const int (&C)[2], unsigned& v00, unsigned& v01, unsigned& v10, unsigned& v11) const {
        if (up) {
            const int r00 = R[0] < u.p2 ? R[0] : 0, r01 = R[1] < u.p2 ? R[1] : 0, r10 = 128 + R[0] < u.p2 ? 128 + R[0] : 0, r11 = 128 + R[1] < u.p2 ? 128 + R[1] : 0;
            const int t00 = perm[u.arow + r00] >> 1, t01 = perm[u.arow + r01] >> 1, t10 = perm[u.arow + r10] >> 1, t11 = perm[u.arow + r11] >> 1;
            v00 = (unsigned)(t00 * K + C[0]) * 2u; v01 = (unsigned)(t01 * K + C[1]) * 2u; v10 = (unsigned)(t10 * K + C[0]) * 2u; v11 = (unsigned)(t11 * K + C[1]) * 2u;
        } else {
            v00 = (unsigned)((u.arow + R[0]) * K + C[0]) * 2u; v01 = (unsigned)((u.arow + R[1]) * K + C[1]) * 2u;
            v10 = (unsigned)((u.arow + 128 + R[0]) * K + C[0]) * 2u; v11 = (unsigned)((u.arow + 128 + R[1]) * K + C[1]) * 2u;
        }
    }
};

struct EpiConvIn {
    static constexpr bool PERM = true; bf16* GB; bf16* U;
    __device__ __forceinline__ void operator()(const f32x4 (&acc)[2][2][4][2], const Unit& u, int wr, int wc, int fr, int fq) const {
        const int row0 = u.p0 * 256 + wr * 64 + fr;
        if (u.p1 < 4) {
            const int col0 = u.p1 * 256 + wc * 32 + 8 * fq;
#pragma unroll
            for (int ai = 0; ai < 2; ++ai)
#pragma unroll
                for (int m = 0; m < 4; ++m) { bf16* rowp = GB + (size_t)(row0 + ai * 128 + m * 16) * D + col0;
#pragma unroll
                    for (int bj = 0; bj < 2; ++bj) { const f32x4 v0 = acc[ai][bj][m][0], v1 = acc[ai][bj][m][1];
                        v4u w; w.x = cvt_pk_bf16(v0[0], v0[1]); w.y = cvt_pk_bf16(v0[2], v0[3]); w.z = cvt_pk_bf16(v1[0], v1[1]); w.w = cvt_pk_bf16(v1[2], v1[3]);
                        *(v4u*)(rowp + bj * 128) = w; } }
        } else {
            const int col0 = (u.p1 - 4) * 128 + wc * 32 + 8 * fq;
#pragma unroll
            for (int ai = 0; ai < 2; ++ai)
#pragma unroll
                for (int m = 0; m < 4; ++m) { const f32x4 v0 = acc[ai][0][m][0] * acc[ai][1][m][0], v1 = acc[ai][0][m][1] * acc[ai][1][m][1];
                    v4u w; w.x = cvt_pk_bf16(v0[0], v0[1]); w.y = cvt_pk_bf16(v0[2], v0[3]); w.z = cvt_pk_bf16(v1[0], v1[1]); w.w = cvt_pk_bf16(v1[2], v1[3]);
                    *(v4u*)(U + (size_t)(row0 + ai * 128 + m * 16) * D + col0) = w; }
        }
    }
};
template <bool RES_BF16> struct EpiResZ {
    static constexpr bool PERM = false; const void* res; float* Z;
    __device__ __forceinline__ void operator()(const f32x4 (&acc)[2][2][4][2], const Unit& u, int wr, int wc, int fr, int fq) const {
        const int row0 = u.p0 * 256 + wr * 64 + fr, col0 = u.p1 * 256 + wc * 32 + 4 * fq;
#pragma unroll
        for (int ai = 0; ai < 2; ++ai)
#pragma unroll
            for (int m = 0; m < 4; ++m) { const size_t off = (size_t)(row0 + ai * 128 + m * 16) * D + col0;
#pragma unroll
                for (int bj = 0; bj < 2; ++bj)
#pragma unroll
                    for (int n = 0; n < 2; ++n) { const size_t o = off + bj * 128 + n * 16; f32x4 r;
                        if (RES_BF16) { const v2u w = *(const v2u*)((const bf16*)res + o); r = (f32x4){bflo(w.x), bfhi(w.x), bflo(w.y), bfhi(w.y)}; }
                        else r = *(const f32x4*)((const float*)res + o);
                        *(f32x4*)(Z + o) = r * ALPHA + acc[ai][bj][m][n]; } }
    }
};
struct EpiUp {
    static constexpr bool PERM = true; bf16* ACT;
    __device__ __forceinline__ void operator()(const f32x4 (&acc)[2][2][4][2], const Unit& u, int wr, int wc, int fr, int fq) const {
        const int row0 = u.p0 + wr * 64 + fr, col0 = u.p1 * 128 + wc * 32 + 8 * fq;
#pragma unroll
        for (int ai = 0; ai < 2; ++ai)
#pragma unroll
            for (int m = 0; m < 4; ++m) { f32x4 v[2];
#pragma unroll
                for (int n = 0; n < 2; ++n) { const f32x4 g = acc[ai][0][m][n], uu = acc[ai][1][m][n];
#pragma unroll
                    for (int j = 0; j < 4; ++j) { const float e = __builtin_amdgcn_exp2f(g[j] * -1.4426950408889634f); v[n][j] = g[j] * __builtin_amdgcn_rcpf(1.0f + e) * uu[j]; } }
                v4u w; w.x = cvt_pk_bf16(v[0][0], v[0][1]); w.y = cvt_pk_bf16(v[0][2], v[0][3]); w.z = cvt_pk_bf16(v[1][0], v[1][1]); w.w = cvt_pk_bf16(v[1][2], v[1][3]);
                *(v4u*)(ACT + (size_t)(row0 + ai * 128 + m * 16) * DE + col0) = w; }
    }
};
struct EpiDown {
    static constexpr bool PERM = true; bf16* YP; const int* perm; const float* gate;
    __device__ __forceinline__ void operator()(const f32x4 (&acc)[2][2][4][2], const Unit& u, int wr, int wc, int fr, int fq) const {
        const int col0 = u.p1 * 256 + wc * 32 + 8 * fq;
#pragma unroll
        for (int ai = 0; ai < 2; ++ai)
#pragma unroll
            for (int m = 0; m < 4; ++m) { const int r = ai * 128 + wr * 64 + m * 16 + fr;
                if (r < u.p2) { const int pair = perm[u.p0 + r]; const float g = gate[pair]; bf16* rowp = YP + (size_t)pair * D + col0;
#pragma unroll
                    for (int bj = 0; bj < 2; ++bj) { const f32x4 v0 = acc[ai][bj][m][0] * g, v1 = acc[ai][bj][m][1] * g;
                        v4u w; w.x = cvt_pk_bf16(v0[0], v0[1]); w.y = cvt_pk_bf16(v0[2], v0[3]); w.z = cvt_pk_bf16(v1[0], v1[1]); w.w = cvt_pk_bf16(v1[2], v1[3]);
                        *(v4u*)(rowp + bj * 128) = w; } } }
    }
};
struct EpiKVQ {
    static constexpr bool PERM = true; bf16* KB;
    __device__ __forceinline__ void operator()(const f32x4 (&acc)[2][2][4][2], const Unit& u, int wr, int wc, int fr, int fq) const {
        const int t = u.p1 >> 2; const float sc = t == 2 ? QSCALE : 1.0f;
        bf16* base = KB + (size_t)t * (32 * MiB / 2);
        const int row0 = u.p0 * 256 + wr * 64 + fr, col0 = (u.p1 & 3) * 256 + wc * 32 + 8 * fq;
#pragma unroll
        for (int ai = 0; ai < 2; ++ai)
#pragma unroll
            for (int m = 0; m < 4; ++m) { bf16* rowp = base + (size_t)(row0 + ai * 128 + m * 16) * D + col0;
#pragma unroll
                for (int bj = 0; bj < 2; ++bj) { const f32x4 v0 = acc[ai][bj][m][0] * sc, v1 = acc[ai][bj][m][1] * sc;
                    v4u w; w.x = cvt_pk_bf16(v0[0], v0[1]); w.y = cvt_pk_bf16(v0[2], v0[3]); w.z = cvt_pk_bf16(v1[0], v1[1]); w.w = cvt_pk_bf16(v1[2], v1[3]);
                    *(v4u*)(rowp + bj * 128) = w; } }
    }
};

__device__ __forceinline__ void ln_rows(f32x4 (&v)[4], const f32x4 (&gg)[4], const f32x4 (&bb)[4]) {
    float s = 0.f;
#pragma unroll
    for (int j = 0; j < 4; ++j) s += (v[j].x + v[j].y) + (v[j].z + v[j].w);
    const float mean = dpp_sum1(s) * (1.f / D); float s2 = 0.f;
#pragma unroll
    for (int j = 0; j < 4; ++j) { v[j] = v[j] - mean; s2 += (v[j].x * v[j].x + v[j].y * v[j].y) + (v[j].z * v[j].z + v[j].w * v[j].w); }
    const float rstd = 1.f / sqrtf(dpp_sum1(s2) * (1.f / D) + LN_EPS);
#pragma unroll
    for (int j = 0; j < 4; ++j) v[j] = v[j] * rstd * gg[j] + bb[j];
}
__device__ __forceinline__ float dot_lds(const f32x4 (&v)[4], const LAS f32x4* w, int lane) {
    float a = 0.f;
#pragma unroll
    for (int j = 0; j < 4; ++j) { const f32x4 ww = w[64 * j + lane]; a += (v[j].x * ww.x + v[j].y * ww.y) + (v[j].z * ww.z + v[j].w * ww.w); }
    return a;
}
__device__ __forceinline__ void ln_router_phase(LAS unsigned char* lds, int layer, int rep = 0) {
    const ArgsP a = kargs(); const Ctx cx = mkctx(a); const int gw = cx.gw, NGW = cx.NGW, lane = cx.lane;
    unsigned char* ws = cx.ws;
    const float* Z = (const float*)(ws + LZ(layer)); bf16* Xb = (bf16*)(ws + (layer == 0 ? WS_X1B : WS_X3B));
    const float* g = a->ln1_g + layer * D; const float* b = a->ln1_b + layer * D;
    const float* rgb = a->rg_b + layer * NG; const float* reb = a->re_b + layer * NE;
    int* cnt = (int*)(ws + WS_CTL) + layer * NE * CNT_STRIDE; int* perm = (int*)(ws + LPERM(layer)); float* gate = (float*)(ws + LGATE(layer));
    LAS f32x4* wl = (LAS f32x4*)lds;
    { const f32x4* wg = (const f32x4*)((const float*)(ws + WS_RWT) + (size_t)layer * NRW * D);
      for (int i = cx.tid; i < NRW * D / 4; i += NTHREADS) wl[i] = wg[i]; }
    f32x4 gg[4], bb[4];
#pragma unroll
    for (int j = 0; j < 4; ++j) { gg[j] = *(const f32x4*)(g + 256 * j + 4 * lane); bb[j] = *(const f32x4*)(b + 256 * j + 4 * lane); }
    f32x4 nv[4];
    if (gw < T) {
#pragma unroll
        for (int j = 0; j < 4; ++j) nv[j] = *(const f32x4*)(Z + (size_t)gw * D + 256 * j + 4 * lane);
    }
    constexpr int RPW = 16;
    LAS int* rt_row = (LAS int*)(lds + MISC_OFF + 2048);
    LAS int* rt_e = rt_row + NWAVES * RPW;
    LAS float* rt_g = (LAS float*)(rt_e + 2 * NWAVES * RPW);
    LAS int* rt_base = (LAS int*)(rt_g + 2 * NWAVES * RPW);
    LAS int* wave_rows = rt_base + NE;
    __syncthreads();
    int it = 0;
#pragma unroll 1
    for (int row = gw; row < T && it < RPW; row += NGW, ++it) {
        f32x4 v[4];
#pragma unroll
        for (int j = 0; j < 4; ++j) v[j] = nv[j];
        if (row + NGW < T) {
#pragma unroll
            for (int j = 0; j < 4; ++j) nv[j] = *(const f32x4*)(Z + (size_t)(row + NGW) * D + 256 * j + 4 * lane);
        }
        ln_rows(v, gg, bb);
#pragma unroll
        for (int j = 0; j < 4; ++j) { v2u w; w.x = pk2(v[j].x, v[j].y); w.y = pk2(v[j].z, v[j].w); *(v2u*)(Xb + (size_t)row * D + 256 * j + 4 * lane) = w; }
        float gl[NG];
#pragma unroll
        for (int n = 0; n < NG; ++n) gl[n] = dot_lds(v, wl + n * (D / 4), lane);
        dpp_sum(gl);
        int gi = 0; float gm = -INFINITY;
#pragma unroll
        for (int n = 0; n < NG; ++n) { gl[n] += rgb[n]; if (gl[n] > gm) { gm = gl[n]; gi = n; } }
        float gs = 0.f;
#pragma unroll
        for (int n = 0; n < NG; ++n) gs += __expf(gl[n] - gm);
        const float gtop = 1.0f / gs;
        float el[EPG];
#pragma unroll
        for (int n = 0; n < EPG; ++n) el[n] = dot_lds(v, wl + (NG + gi * EPG + n) * (D / 4), lane);
        dpp_sum(el);
        float m0 = -INFINITY, m1 = -INFINITY; int i0 = 0, i1 = 0;
#pragma unroll
        for (int n = 0; n < EPG; ++n) { const float e = el[n] + reb[gi * EPG + n];
            if (e > m0) { m1 = m0; i1 = i0; m0 = e; i0 = n; } else if (e > m1) { m1 = e; i1 = n; } }
        const float e1 = __expf(m1 - m0), w0 = 1.0f / (1.0f + e1), w1 = e1 * w0;
        if (lane == 0) {
            const int li = cx.wave * RPW + it;
            rt_row[li] = row; rt_e[2 * li] = gi * EPG + i0; rt_e[2 * li + 1] = gi * EPG + i1; rt_g[2 * li] = gtop * w0; rt_g[2 * li + 1] = gtop * w1;
        }
    }
    if (lane == 0) wave_rows[cx.wave] = it;
    __syncthreads();
    if (rep == 0) {
        if (cx.tid < NE) { int c = 0;
            for (int w = 0; w < NWAVES; ++w) { const int n = wave_rows[w]; for (int i = 0; i < 2 * n; ++i) c += (rt_e[2 * (w * RPW) + i] == cx.tid) ? 1 : 0; }
            rt_base[cx.tid] = c ? atomicAdd(&cnt[cx.tid * CNT_STRIDE], c) : 0; }
        __syncthreads();
        if (cx.tid < 2 * NWAVES * RPW) { const int w = cx.tid / (2 * RPW), i = cx.tid % (2 * RPW);
            if (i < 2 * wave_rows[w]) { const int e = rt_e[cx.tid]; int rank = 0;
                for (int w2 = 0; w2 <= w; ++w2) { const int lim = (w2 < w) ? 2 * wave_rows[w2] : i; for (int q = 0; q < lim; ++q) rank += (rt_e[2 * (w2 * RPW) + q] == e) ? 1 : 0; }
                const int pair = 2 * rt_row[cx.tid >> 1] + (cx.tid & 1);
                perm[e * CAP + rt_base[e] + rank] = pair; gate[pair] = rt_g[cx.tid]; } }
    }
}
__device__ __forceinline__ void ln2_phase(int layer) {
    const ArgsP a = kargs(); const Ctx cx = mkctx(a); const int gw = cx.gw, NGW = cx.NGW, lane = cx.lane;
    unsigned char* ws = cx.ws;
    const bf16* Xin = (const bf16*)(ws + (layer == 0 ? WS_X1B : WS_X3B)); const bf16* YP = (const bf16*)(ws + LYP(layer));
    const float* g = a->ln2_g + layer * D; const float* b = a->ln2_b + layer * D;
    f32x4 gg[4], bb[4];
#pragma unroll
    for (int j = 0; j < 4; ++j) { gg[j] = *(const f32x4*)(g + 256 * j + 4 * lane); bb[j] = *(const f32x4*)(b + 256 * j + 4 * lane); }
    v2u nx[4], ny0[4], ny1[4];
    if (gw < T) {
#pragma unroll
        for (int j = 0; j < 4; ++j) { const size_t c = 256 * j + 4 * lane;
            nx[j] = *(const v2u*)(Xin + (size_t)gw * D + c); ny0[j] = *(const v2u*)(YP + (size_t)(2 * gw) * D + c); ny1[j] = *(const v2u*)(YP + (size_t)(2 * gw + 1) * D + c); }
    }
#pragma unroll 1
    for (int row = gw; row < T; row += NGW) {
        f32x4 v[4];
#pragma unroll
        for (int j = 0; j < 4; ++j) { const v2u xw = nx[j], y0 = ny0[j], y1 = ny1[j];
            v[j].x = ALPHA * bflo(xw.x) + (bflo(y0.x) + bflo(y1.x)); v[j].y = ALPHA * bfhi(xw.x) + (bfhi(y0.x) + bfhi(y1.x));
            v[j].z = ALPHA * bflo(xw.y) + (bflo(y0.y) + bflo(y1.y)); v[j].w = ALPHA * bfhi(xw.y) + (bfhi(y0.y) + bfhi(y1.y)); }
        if (row + NGW < T) { const int r2 = row + NGW;
#pragma unroll
            for (int j = 0; j < 4; ++j) { const size_t c = 256 * j + 4 * lane;
                nx[j] = *(const v2u*)(Xin + (size_t)r2 * D + c); ny0[j] = *(const v2u*)(YP + (size_t)(2 * r2) * D + c); ny1[j] = *(const v2u*)(YP + (size_t)(2 * r2 + 1) * D + c); }
        }
        ln_rows(v, gg, bb);
        if (layer == 0) {
#pragma unroll
            for (int j = 0; j < 4; ++j) { v2u w; w.x = pk2(v[j].x, v[j].y); w.y = pk2(v[j].z, v[j].w); *(v2u*)((bf16*)(ws + WS_X2B) + (size_t)row * D + 256 * j + 4 * lane) = w; }
        } else {
#pragma unroll
            for (int j = 0; j < 4; ++j) *(f32x4*)(a->out + (size_t)row * D + 256 * j + 4 * lane) = v[j];
        }
    }
}
__device__ __forceinline__ void conv_phase() {
    const ArgsP a = kargs(); const Ctx cx = mkctx(a); const int gtid = cx.bx * NTHREADS + cx.tid, NGT = cx.G * NTHREADS;
    unsigned char* ws = cx.ws;
    const bf16* GB = (const bf16*)(ws + WS_GB); const bf16* U = (const bf16*)(ws + WS_U); bf16* A2 = (bf16*)(ws + WS_A2);
    for (int it = gtid; it < T * (D / 8); it += NGT) {
        const int t = it >> 7, d0 = (it & 127) * 8, s = t & (SEQ - 1);
        const size_t o = (size_t)t * D + d0;
        const v4u g = *(const v4u*)(GB + o), u0 = *(const v4u*)(U + o);
        v4u u1 = (v4u){0u, 0u, 0u, 0u}, u2 = u1;
        if (s >= 1) u1 = *(const v4u*)(U + o - D);
        if (s >= 2) u2 = *(const v4u*)(U + o - 2 * D);
        v4u r;
#pragma unroll
        for (int q = 0; q < 4; ++q) {
            const int d = d0 + 2 * q;
            const float c0 = a->a_conv_w[d] * bflo(u2[q]) + a->a_conv_w[D + d] * bflo(u1[q]) + a->a_conv_w[2 * D + d] * bflo(u0[q]);
            const float c1 = a->a_conv_w[d + 1] * bfhi(u2[q]) + a->a_conv_w[D + d + 1] * bfhi(u1[q]) + a->a_conv_w[2 * D + d + 1] * bfhi(u0[q]);
            r[q] = pk2(bflo(g[q]) * c0, bfhi(g[q]) * c1);
        }
        *(v4u*)(A2 + o) = r;
    }
}
__device__ __forceinline__ void combine_phase() {
    const ArgsP a = kargs(); const Ctx cx = mkctx(a); const int gw = cx.gw, NGW = cx.NGW, lane = cx.lane;
    unsigned char* ws = cx.ws;
    const bf16* O0 = (const bf16*)(ws + WS_O0); const bf16* O1 = (const bf16*)(ws + WS_O1); bf16* A3 = (bf16*)(ws + WS_A3);
    const float l01 = wave_sum(a->b_lambda[lane] * a->b_lambda[64 + lane]), l23 = wave_sum(a->b_lambda[128 + lane] * a->b_lambda[192 + lane]);
    const float lam = __expf(l01) - __expf(l23) + LAM_INIT;
    float gsc[16];
#pragma unroll
    for (int i = 0; i < 16; ++i) gsc[i] = a->b_subln_g[(lane & 7) * 16 + i] * (1.0f - LAM_INIT);
    for (int row = gw; row < T; row += NGW) {
        const size_t o = (size_t)row * D + lane * 16;
        const v4u p0 = *(const v4u*)(O0 + o), p1 = *(const v4u*)(O0 + o + 8), q0 = *(const v4u*)(O1 + o), q1 = *(const v4u*)(O1 + o + 8);
        float d[16]; float ss = 0.f;
#pragma unroll
        for (int i = 0; i < 4; ++i) { d[2 * i] = bflo(p0[i]) - lam * bflo(q0[i]); d[2 * i + 1] = bfhi(p0[i]) - lam * bfhi(q0[i]);
            d[8 + 2 * i] = bflo(p1[i]) - lam * bflo(q1[i]); d[8 + 2 * i + 1] = bfhi(p1[i]) - lam * bfhi(q1[i]); }
#pragma unroll
        for (int i = 0; i < 16; ++i) ss += d[i] * d[i];
        ss += __shfl_xor(ss, 1); ss += __shfl_xor(ss, 2); ss += __shfl_xor(ss, 4);
        const float r = 1.0f / sqrtf(ss * (1.0f / 128.0f) + RMS_EPS);
        v4u w0, w1;
#pragma unroll
        for (int i = 0; i < 4; ++i) { w0[i] = pk2(d[2 * i] * r * gsc[2 * i], d[2 * i + 1] * r * gsc[2 * i + 1]); w1[i] = pk2(d[8 + 2 * i] * r * gsc[8 + 2 * i], d[8 + 2 * i + 1] * r * gsc[8 + 2 * i + 1]); }
        *(v4u*)(A3 + o) = w0; *(v4u*)(A3 + o + 8) = w1;
    }
}

#ifndef MKMASK
#define MKMASK 0xffff
#endif
#ifndef MKREP
#define MKREP 0
#endif
#ifndef MKSYNC
#define MKSYNC 0
#endif
#ifndef MKMASK2
#define MKMASK2 MKMASK
#endif
#define PH(k) _Pragma("unroll 1") for (int rep_ = 0; rep_ < (int)(((pass_ ? MKMASK2 : MKMASK) >> (k)) & 1) + (int)((MKREP >> (k)) & 1); ++rep_)
#define XB_TMO      128
#define XB_XCNT(j)  (256  + 64 * (j))
#define XB_XSUB(j)  (1280 + 64 * (j))
#define XB_XGEN(j)  (2304 + 64 * (j))
#define XB_TOP      3328
#define XB_TOPGEN   3392
#define XCD_BAR_WORDS 3456
#define XB_SPIN_CAP (1u << 18)

__device__ __forceinline__ unsigned xb_ld(unsigned* p)              { return __hip_atomic_load(p, __ATOMIC_RELAXED, __HIP_MEMORY_SCOPE_AGENT); }
__device__ __forceinline__ unsigned xb_add(unsigned* p, unsigned v) { return __hip_atomic_fetch_add(p, v, __ATOMIC_RELAXED, __HIP_MEMORY_SCOPE_AGENT); }
__device__ __forceinline__ unsigned xb_xcc_id() { return (unsigned)__builtin_amdgcn_s_getreg((3 << 11) | 20) & 0xFu; }
#define XB_SPIN(cond, bar) do { unsigned _sp = 0; while (cond) { __builtin_amdgcn_s_sleep(1); \
    if ((++_sp & 255u) == 0u) { if (xb_ld(&(bar)[XB_TMO])) break; if (_sp > XB_SPIN_CAP) { atomicAdd(&(bar)[XB_TMO], 1u); break; } } } } while (0)

struct XcdBarrier {
    unsigned* bar; unsigned x;
    volatile LAS unsigned* st;
};

__device__ __forceinline__ XcdBarrier xcd_barrier_post(unsigned* bar, volatile LAS unsigned* st) {
    XcdBarrier b; b.bar = bar; b.x = xb_xcc_id(); b.st = st;
    if (threadIdx.x == 0) (void)xb_add(&bar[XB_XCNT(b.x)], 1u);
    return b;
}
__device__ __forceinline__ void xcd_barrier_complete(unsigned* bar, unsigned x, unsigned& nloc, unsigned& nx) {
    const unsigned G = gridDim.x * gridDim.y * gridDim.z;
    unsigned sum, cnt, mine, sp = 0u;
    for (;;) {
        sum = 0u; cnt = 0u; mine = 0u;
#pragma unroll
        for (unsigned j = 0; j < 16; ++j) { const unsigned c = xb_ld(&bar[XB_XCNT(j)]); sum += c; cnt += (c > 0u) ? 1u : 0u; mine = (j == x) ? c : mine; }
        if (sum == G) break;
        __builtin_amdgcn_s_sleep(1);
        if ((++sp & 255u) == 0u) { if (xb_ld(&bar[XB_TMO])) break; if (sp > XB_SPIN_CAP) { atomicAdd(&bar[XB_TMO], 1u); break; } }
    }
    nloc = mine > 0u ? mine : 1u; nx = cnt > 0u ? cnt : 1u;
}

__device__ __forceinline__ void xcd_barrier(const XcdBarrier& b) {
    asm volatile("s_waitcnt vmcnt(0)" ::: "memory");
    __syncthreads();
    if (threadIdx.x == 0) {
        unsigned* bar = b.bar;
        __builtin_amdgcn_s_waitcnt(0);
        unsigned nloc = b.st[0], nx = b.st[1];
        if (nloc == 0u) { xcd_barrier_complete(bar, b.x, nloc, nx); b.st[0] = nloc; b.st[1] = nx; }
        const unsigned old = xb_add(&bar[XB_XSUB(b.x)], 1u);
        const unsigned gen = old / nloc;
        if (old + 1u == (gen + 1u) * nloc) {
            __builtin_amdgcn_fence(__ATOMIC_RELEASE, "agent");
            asm volatile("s_waitcnt vmcnt(0)" ::: "memory");
            const unsigned og = xb_add(&bar[XB_TOP], 1u);
            const unsigned tg = og / nx;
            if (og + 1u == (tg + 1u) * nx) xb_add(&bar[XB_TOPGEN], 1u);
            else XB_SPIN(xb_ld(&bar[XB_TOPGEN]) == tg, bar);
            __builtin_amdgcn_fence(__ATOMIC_ACQUIRE, "agent");
            xb_add(&bar[XB_XGEN(b.x)], 1u);
            asm volatile("s_waitcnt vmcnt(0)" ::: "memory");
        } else {
            XB_SPIN(xb_ld(&bar[XB_XGEN(b.x)]) == gen, bar);
            __builtin_amdgcn_fence(__ATOMIC_ACQUIRE, "agent");
            asm volatile("s_waitcnt vmcnt(0)" ::: "memory");
        }
    }
    __syncthreads();
}

constexpr int CW_BAR = 8192;
constexpr int ST_OFF = MISC_OFF + 1024;
__device__ __forceinline__ void seam(LAS unsigned char* lds) { const ArgsP a = kargs(); XcdBarrier b; b.bar = (unsigned*)(a->ws + WS_CTL) + CW_BAR; b.x = xb_xcc_id(); b.st = (volatile LAS unsigned*)(lds + ST_OFF); xcd_barrier(b); }
__device__ __forceinline__ void gemm1_phase(LAS unsigned char* lds) { const ArgsP a = kargs(); const Ctx cx = mkctx(a); unsigned char* ws = cx.ws;
    SchedDense S{cx.G, cx.bx, 12, 0, D, (const char*)(ws + WS_W1T)}; EpiConvIn E{(bf16*)(ws + WS_GB), (bf16*)(ws + WS_U)};
    pg8::gemm_phase(lds, (const char*)(ws + WS_XB), D, S, E); }
__device__ __forceinline__ void gemm2_phase(LAS unsigned char* lds) { const ArgsP a = kargs(); const Ctx cx = mkctx(a); unsigned char* ws = cx.ws;
    SchedDense S{cx.G, cx.bx, 4, 1, D, (const char*)(ws + WS_W2T)}; EpiResZ<false> E{(const void*)a->x, (float*)(ws + LZ(0))};
    pg8::gemm_phase(lds, (const char*)(ws + WS_A2), D, S, E); }
__device__ __forceinline__ void kvq_phase(LAS unsigned char* lds) { const ArgsP a = kargs(); const Ctx cx = mkctx(a); unsigned char* ws = cx.ws;
    SchedDense S{cx.G, cx.bx, 12, 1, D, (const char*)(ws + WS_WKVQ)}; EpiKVQ E{(bf16*)(ws + WS_K)};
    pg8::gemm_phase(lds, (const char*)(ws + WS_X2B), D, S, E); }
__device__ __forceinline__ void wo_phase(LAS unsigned char* lds) { const ArgsP a = kargs(); const Ctx cx = mkctx(a); unsigned char* ws = cx.ws;
    SchedDense S{cx.G, cx.bx, 4, 1, D, (const char*)(ws + WS_WOT)}; EpiResZ<true> E{(const void*)(ws + WS_X2B), (float*)(ws + LZ(1))};
    pg8::gemm_phase(lds, (const char*)(ws + WS_A3), D, S, E); }
__device__ __forceinline__ void attn_phase(char* lds_generic) { const ArgsP a = kargs(); const Ctx cx = mkctx(a); unsigned char* ws = cx.ws;
#pragma unroll 1
    for (int uix = cx.bx; uix < BATCH * NH * 4 * (SEQ / 256); uix += cx.G) {
        const int combo = uix & 255, qi = uix >> 8;
        const int b = combo >> 5, h = (combo >> 2) & 7, c = (combo >> 1) & 1, vh = combo & 1;
        const int qb = (qi & 1) ? (SEQ / 256 - 1 - (qi >> 1)) : (qi >> 1);
        const attn_body::bf16* QK = (const attn_body::bf16*)(ws + WS_K) + h * 128 + c * 64;
        const attn_body::bf16* Vc = (const attn_body::bf16*)(ws + WS_V) + h * 128 + vh * 64;
        attn_body::bf16* Oc = (attn_body::bf16*)(ws + (c ? WS_O1 : WS_O0)) + h * 128 + vh * 64;
        attn_body::attn_unit<8>((long)b * SEQ, qb, QK + (WS_Q - WS_K) / 2, QK, Vc, Oc, lds_generic);
    }
}
__device__ __forceinline__ void moe_tables(LAS unsigned char* lds, int layer) { const ArgsP a = kargs(); const Ctx cx = mkctx(a); LAS int* misc = (LAS int*)(lds + MISC_OFF);
    const int* cnt = (const int*)(cx.ws + WS_CTL) + layer * NE * CNT_STRIDE;
    if (cx.tid < NE) misc[128 + cx.tid] = __hip_atomic_load(cnt + cx.tid * CNT_STRIDE, __ATOMIC_RELAXED, __HIP_MEMORY_SCOPE_AGENT);
    __syncthreads();
    if (cx.tid == 0) { int ub = 0, ps = 0; for (int e = 0; e < NE; ++e) { misc[e] = ub; misc[64 + e] = ps; const int rt = (misc[128 + e] + 255) >> 8; ub += 4 * rt; ps += 256 * rt; } misc[NE] = ub; misc[64 + NE] = ps; }
    __syncthreads(); }
__device__ __forceinline__ void moe_up_phase(LAS unsigned char* lds, int layer) { const ArgsP a = kargs(); const Ctx cx = mkctx(a); unsigned char* ws = cx.ws; LAS int* misc = (LAS int*)(lds + MISC_OFF);
    const MoeTab tb{misc, misc + 64, misc + 128};
    SchedMoe S{cx.G, cx.bx, D, true, (const char*)(ws + WS_WUT) + (size_t)layer * NE * D * D * 2, (const int*)(ws + LPERM(layer)), tb}; EpiUp E{(bf16*)(ws + LACT(layer))};
    pg8::gemm_phase(lds, (const char*)(ws + (layer == 0 ? WS_X1B : WS_X3B)), D, S, E); }
__device__ __forceinline__ void moe_down_phase(LAS unsigned char* lds, int layer) { const ArgsP a = kargs(); const Ctx cx = mkctx(a); unsigned char* ws = cx.ws; LAS int* misc = (LAS int*)(lds + MISC_OFF);
    const MoeTab tb{misc, misc + 64, misc + 128};
    SchedMoe S{cx.G, cx.bx, DE, false, (const char*)(ws + WS_WDT) + (size_t)layer * NE * D * DE * 2, (const int*)(ws + LPERM(layer)), tb};
    EpiDown E{(bf16*)(ws + LYP(layer)), (const int*)(ws + LPERM(layer)), (const float*)(ws + LGATE(layer))};
    pg8::gemm_phase(lds, (const char*)(ws + LACT(layer)), DE, S, E); }

__global__ void __launch_bounds__(NTHREADS, 2) fwd_megakernel(Args args_unused) {
    extern __shared__ __attribute__((aligned(16))) unsigned char lds_raw[];
#ifdef NOSYNC
    struct { __device__ void sync() const {} } grid;
#else
    cg::grid_group grid = cg::this_grid();
#endif
#define SEAM() seam(lds)
    LAS unsigned char* lds = (LAS unsigned char*)lds_raw;
#ifndef MKPASS
#define MKPASS 1
#endif
    { const ArgsP a = kargs(); int t = threadIdx.x; asm volatile("" : "+v"(t));
      if (t < 2) ((volatile LAS unsigned*)(lds + ST_OFF))[t] = 0u;
      if (blockIdx.x == 0) { unsigned* ctl = (unsigned*)(a->ws + WS_CTL); for (int i = t; i < CW_BAR + XCD_BAR_WORDS; i += NTHREADS) ctl[i] = 0u; } }
    __syncthreads();
#pragma unroll 1
    for (int pass_ = 0; pass_ < MKPASS; ++pass_) {
    if (pass_) SEAM();
    PH(0) p0_prologue(lds);
    if (pass_ == 0) { grid.sync();
      const ArgsP a = kargs(); (void)xcd_barrier_post((unsigned*)(a->ws + WS_CTL) + CW_BAR, (volatile LAS unsigned*)(lds + ST_OFF)); }
    else SEAM();
    PH(1) gemm1_phase(lds);
    SEAM();
    PH(2) conv_phase();
    SEAM();
    PH(3) gemm2_phase(lds);
    SEAM();
    PH(8) ln_router_phase(lds, 0, rep_ + pass_);
    SEAM();
    moe_tables(lds, 0);
    PH(9) moe_up_phase(lds, 0);
    SEAM();
    PH(10) moe_down_phase(lds, 0);
    SEAM();
    PH(11) ln2_phase(0);
    SEAM();
    PH(4) kvq_phase(lds);
    SEAM();
    PH(5) attn_phase((char*)lds_raw);
    SEAM();
    PH(6) combine_phase();
    SEAM();
    PH(7) wo_phase(lds);
    SEAM();
    PH(8) ln_router_phase(lds, 1, rep_ + pass_);
    SEAM();
    moe_tables(lds, 1);
    PH(9) moe_up_phase(lds, 1);
    SEAM();
    PH(10) moe_down_phase(lds, 1);
    SEAM();
    PH(11) ln2_phase(1);
    }
#pragma unroll 1
    for (int i = 0; i < MKSYNC; ++i) SEAM();
}
}

extern "C" void kernel_launch(void* const* d_in, const int* in_sizes, int n_in, void* d_out, int out_size, void* d_ws, size_t ws_size, hipStream_t stream) {
    using namespace mk;
    static int grid = 0;
    if (grid == 0) {
        if (n_in != 19 || out_size != T * D || ws_size < WS_END) { fprintf(stderr, "kernel_launch: unexpected shapes / workspace (n_in %d out %d ws %zu, need %zu)\n", n_in, out_size, ws_size, (size_t)WS_END); grid = -1; return; }
        int dev = 0, cus = 0, per_cu = 0;
        (void)hipGetDevice(&dev); (void)hipDeviceGetAttribute(&cus, hipDeviceAttributeMultiprocessorCount, dev);
        if (hipFuncSetAttribute((const void*)fwd_megakernel, hipFuncAttributeMaxDynamicSharedMemorySize, LDS_BYTES) != hipSuccess) { fprintf(stderr, "kernel_launch: hipFuncSetAttribute failed\n"); grid = -1; return; }
        if (hipOccupancyMaxActiveBlocksPerMultiprocessor(&per_cu, (const void*)fwd_megakernel, NTHREADS, LDS_BYTES) != hipSuccess || per_cu < 1) { fprintf(stderr, "kernel_launch: occupancy query says %d blocks per CU\n", per_cu); grid = -1; return; }
        grid = cus * 1;
        (void)hipGetLastError();
    }
    if (grid < 0) return;
    Args a{};
    a.x = (const float*)d_in[0]; a.a_w_in = (const float*)d_in[1]; a.a_conv_w = (const float*)d_in[2]; a.a_w_out = (const float*)d_in[3]; a.kv_w = (const float*)d_in[4];
    a.b_w_q = (const float*)d_in[5]; a.b_lambda = (const float*)d_in[6]; a.b_subln_g = (const float*)d_in[7]; a.b_w_o = (const float*)d_in[8];
    a.ln1_g = (const float*)d_in[9]; a.ln1_b = (const float*)d_in[10]; a.ln2_g = (const float*)d_in[11]; a.ln2_b = (const float*)d_in[12];
    a.rg_w = (const float*)d_in[13]; a.rg_b = (const float*)d_in[14]; a.re_w = (const float*)d_in[15]; a.re_b = (const float*)d_in[16];
    a.e_w_in = (const float*)d_in[17]; a.e_w_down = (const float*)d_in[18];
    a.out = (float*)d_out; a.ws = (unsigned char*)d_ws;
    void* kargs[] = {&a};
    const hipError_t e = hipLaunchCooperativeKernel((const void*)fwd_megakernel, dim3(grid), dim3(NTHREADS), kargs, LDS_BYTES, stream);
    if (e != hipSuccess) fprintf(stderr, "kernel_launch: cooperative launch failed: %s (grid %d)\n", hipGetErrorString(e), grid);
}
```

```cpp
#define P0B_SPLIT 18432
#include <hip/hip_runtime.h>
#include <hip/hip_cooperative_groups.h>
#include <cstdio>
#include <cstdint>
namespace cg = cooperative_groups;

namespace pg8 {
#define PG8_LAS __attribute__((address_space(3)))
typedef unsigned short bf16_t;
typedef short bf16x8 __attribute__((ext_vector_type(8)));
typedef float f32x4 __attribute__((ext_vector_type(4)));
typedef unsigned u32x4 __attribute__((ext_vector_type(4)));
typedef unsigned u32x2 __attribute__((ext_vector_type(2)));
constexpr int BM = 256, BK = 64, HALF = 128, HTB = HALF * BK * 2  , STAGE_BYTES = 8 * HTB, NXCD = 8, WGM = 8;

__host__ __device__ __forceinline__ int lds_byte(int r, int c) { const int st = (r >> 4) * 2 + (c >> 5), rr = r & 15, cc = c & 31, ob = rr * 64 + cc * 2; return st * 1024 + (ob ^ (((ob >> 9) & 1) << 5)); }
__host__ __device__ __forceinline__ void stage_rc(int b, int& R, int& C) { const int st = b / 1024, sb = b % 1024, swz = sb ^ (((sb >> 9) & 1) << 5); R = (st >> 1) * 16 + swz / 64; C = (st & 1) * 32 + (swz % 64) / 2; }
__host__ __device__ __forceinline__ int perm32(int rho) { const int n = rho >> 4, i = rho & 15; return 8 * (i >> 2) + 4 * n + (i & 3); }

struct Unit { const char* b0; const char* b1; int arow; int p0, p1, p2; };

__device__ __forceinline__ bool static_tile(int i, int G, int c, int nM, int nN, int& pm, int& pn) {
    const int nwg = nM * nN; const long L = (long)i * G + c; if (L >= nwg) return false;
    int wgid = (int)L; { const int q = nwg / NXCD, r = nwg % NXCD, xcd = wgid % NXCD, off = wgid / NXCD; wgid = (xcd < r ? xcd * (q + 1) : r * (q + 1) + (xcd - r) * q) + off; }
    const int nig = WGM * nN, gid = wgid / nig, fm = gid * WGM, gsz = (nM - fm) < WGM ? (nM - fm) : WGM;
    pm = fm + ((wgid % nig) % gsz); pn = (wgid % nig) / gsz; return true;
}

__device__ __forceinline__ unsigned cvt_pk_bf16(float lo, float hi) { unsigned r; asm volatile("v_cvt_pk_bf16_f32 %0, %1, %2" : "=v"(r) : "v"(lo), "v"(hi)); return r; }

template <class Epi, class Sched>
__device__ __forceinline__ void gemm_phase(PG8_LAS unsigned char* lds, const char* Abase, const int K, const Sched& S, const Epi& E) {
    int tid_ = threadIdx.x; asm volatile("" : "+v"(tid_));
    const int tid = tid_, wid = __builtin_amdgcn_readfirstlane(tid >> 6), lane = tid & 63, wr = wid >> 2, wc = wid & 3, fr = lane & 15, fq = lane >> 4;
    const int nt = K / BK;
    int R[2], C[2]; unsigned voffB[2];
#pragma unroll
    for (int i = 0; i < 2; ++i) { stage_rc(tid * 16 + i * 8192, R[i], C[i]); const int Rb = Epi::PERM ? ((R[i] & ~31) + perm32(R[i] & 31)) : R[i]; voffB[i] = (unsigned)(Rb * K + C[i]) * 2u; }
    const size_t kstep = (size_t)(BK * 2);
    const unsigned ldsw = (unsigned)wid * 1024u;
    const int aoff = lds_byte(wr * 64 + fr, fq * 8), boff = lds_byte(wc * 32 + fr, fq * 8);
#define PG8_SA(b, h) (((b) * 2 + (h)) * HTB)
#define PG8_SB(b, h) ((4 + (b) * 2 + (h)) * HTB)
#define PG8_STAGE(bufoff, gbase, v0, v1) do { \
        __builtin_amdgcn_global_load_lds((const unsigned*)((const char*)(gbase) + (v0)), (PG8_LAS unsigned*)(lds + (bufoff) + ldsw), 16, 0, 0); \
        __builtin_amdgcn_global_load_lds((const unsigned*)((const char*)(gbase) + (v1)), (PG8_LAS unsigned*)(lds + (bufoff) + ldsw + 8192), 16, 0, 0); } while (0)
#define PG8_STAGEB(bufoff, gbase) PG8_STAGE(bufoff, gbase, voffB[0], voffB[1])
#define PG8_LDA(dst, b, h) do { _Pragma("unroll") for (int m = 0; m < 4; ++m) _Pragma("unroll") for (int k = 0; k < 2; ++k) dst[m][k] = *(const PG8_LAS bf16x8*)(lds + PG8_SA(b, h) + aoff + m * 2048 + k * 1024); } while (0)
#define PG8_LDB(dst, b, h) do { _Pragma("unroll") for (int n = 0; n < 2; ++n) _Pragma("unroll") for (int k = 0; k < 2; ++k) dst[n][k] = *(const PG8_LAS bf16x8*)(lds + PG8_SB(b, h) + boff + n * 2048 + k * 1024); } while (0)
#define PG8_MMA(ai, bj, At, Bt) do { __builtin_amdgcn_s_setprio(1); _Pragma("unroll") for (int m = 0; m < 4; ++m) _Pragma("unroll") for (int n = 0; n < 2; ++n) _Pragma("unroll") for (int k = 0; k < 2; ++k) \
        acc[ai][bj][m][n] = __builtin_amdgcn_mfma_f32_16x16x32_bf16(Bt[n][k], At[m][k], acc[ai][bj][m][n], 0, 0, 0); __builtin_amdgcn_s_setprio(0); } while (0)
#define PG8_WAIT_V(n) asm volatile("s_waitcnt vmcnt(" #n ")" ::: "memory")
#define PG8_WAIT_L(n) asm volatile("s_waitcnt lgkmcnt(" #n ")" ::: "memory")
#define PG8_BAR __builtin_amdgcn_s_barrier()
#define PG8_SCHED __builtin_amdgcn_sched_barrier(0)
    Unit cur, nxt; int ui = 0;
    if (!S.next(0, cur)) return;
    f32x4 acc[2][2][4][2];
#pragma unroll
    for (int a = 0; a < 2; ++a)
#pragma unroll
        for (int b = 0; b < 2; ++b)
#pragma unroll
            for (int m = 0; m < 4; ++m)
#pragma unroll
                for (int n = 0; n < 2; ++n) acc[a][b][m][n] = (f32x4){0.f, 0.f, 0.f, 0.f};
    bf16x8 At[4][2], B0[2][2], B1[2][2];
    unsigned vA00, vA01, vA10, vA11, vN00, vN01, vN10, vN11;
    S.a_offs(cur, R, C, vA00, vA01, vA10, vA11);
    const char* cB0 = cur.b0; const char* cB1 = cur.b1;
    PG8_STAGEB(PG8_SB(0, 0), cB0); PG8_STAGEB(PG8_SB(0, 1), cB1); PG8_STAGE(PG8_SA(0, 0), Abase, vA00, vA01); PG8_STAGE(PG8_SA(0, 1), Abase, vA10, vA11);
    if (wr == 1) PG8_BAR;
    PG8_WAIT_V(2); PG8_BAR;
    PG8_STAGEB(PG8_SB(1, 0), cB0 + kstep); PG8_STAGE(PG8_SA(1, 0), Abase + kstep, vA00, vA01); PG8_STAGEB(PG8_SB(1, 1), cB1 + kstep);
    PG8_WAIT_V(6); PG8_BAR;
    for (;;) {
        const bool has_next = S.next(ui + 1, nxt);
        if (has_next) S.a_offs(nxt, R, C, vN00, vN01, vN10, vN11); else { vN00 = vA00; vN01 = vA01; vN10 = vA10; vN11 = vA11; }
        const char* nB0 = has_next ? nxt.b0 : cB0; const char* nB1 = has_next ? nxt.b1 : cB1;
        for (int t = 0; t < nt; t += 2) {
            const bool last = (t == nt - 2);
            const char* a1 = Abase + (size_t)(t + 1) * kstep;
            PG8_LDB(B0, 0, 0); PG8_LDB(B1, 0, 1); PG8_SCHED; PG8_LDA(At, 0, 0); PG8_STAGE(PG8_SA(1, 1), a1, vA10, vA11);
            PG8_WAIT_V(8); PG8_WAIT_L(0); PG8_BAR; PG8_MMA(0, 0, At, B0); PG8_MMA(0, 1, At, B1); PG8_BAR; PG8_SCHED;
            if (last) { vA00 = vN00; vA01 = vN01; vA10 = vN10; vA11 = vN11; }
            const char* a2 = last ? Abase : Abase + (size_t)(t + 2) * kstep;
            const char* b20 = last ? nB0 : cB0 + (size_t)(t + 2) * kstep; const char* b21 = last ? nB1 : cB1 + (size_t)(t + 2) * kstep;
            const char* a3 = a2 + kstep; const char* b30 = b20 + kstep; const char* b31 = b21 + kstep;
            PG8_LDA(At, 0, 1); PG8_STAGEB(PG8_SB(0, 0), b20); PG8_STAGEB(PG8_SB(0, 1), b21); PG8_STAGE(PG8_SA(0, 0), a2, vA00, vA01);
            PG8_WAIT_V(8); PG8_WAIT_L(0); PG8_BAR; PG8_MMA(1, 0, At, B0); PG8_MMA(1, 1, At, B1); PG8_BAR; PG8_SCHED;
            PG8_LDB(B0, 1, 0); PG8_LDB(B1, 1, 1); PG8_SCHED; PG8_LDA(At, 1, 0); PG8_STAGE(PG8_SA(0, 1), a2, vA10, vA11);
            PG8_WAIT_V(8); PG8_WAIT_L(0); PG8_BAR; PG8_MMA(0, 0, At, B0); PG8_MMA(0, 1, At, B1); PG8_BAR; PG8_SCHED;
            PG8_LDA(At, 1, 1); PG8_STAGEB(PG8_SB(1, 0), b30); PG8_STAGEB(PG8_SB(1, 1), b31); PG8_STAGE(PG8_SA(1, 0), a3, vA00, vA01);
            PG8_WAIT_V(8); PG8_WAIT_L(0); PG8_BAR; PG8_MMA(1, 0, At, B0); PG8_MMA(1, 1, At, B1); PG8_BAR; PG8_SCHED;
        }
        if (wr == 0) PG8_BAR;
        E(acc, cur, wr, wc, fr, fq);
        if (!has_next) break;
#pragma unroll
        for (int a = 0; a < 2; ++a)
#pragma unroll
            for (int b = 0; b < 2; ++b)
#pragma unroll
                for (int m = 0; m < 4; ++m)
#pragma unroll
                    for (int n = 0; n < 2; ++n) acc[a][b][m][n] = (f32x4){0.f, 0.f, 0.f, 0.f};
        cur = nxt; cB0 = nB0; cB1 = nB1; ++ui;
        if (wr == 1) PG8_BAR;
    }
    PG8_WAIT_V(0);
    PG8_BAR;
#undef PG8_SA
#undef PG8_SB
#undef PG8_STAGE
#undef PG8_STAGEB
#undef PG8_LDA
#undef PG8_LDB
#undef PG8_MMA
#undef PG8_WAIT_V
#undef PG8_WAIT_L
#undef PG8_BAR
#undef PG8_SCHED
}
}
#include <hip/hip_bf16.h>
#include <cmath>
namespace attn_body {
using bf16=__hip_bfloat16;
using bf16x8=__attribute__((ext_vector_type(8)))short;
using s16x4=__attribute__((ext_vector_type(4)))short;
using f32x16=__attribute__((ext_vector_type(16)))float;
using u32x4=__attribute__((ext_vector_type(4)))unsigned;
constexpr int D=64,DM=1024;
constexpr int NW=8,QBLK=32,QB=QBLK*NW,KVBLK=64;
constexpr int ATTN_PITCH=DM, ATTN_UNIT_ROWS=QB;
__device__ __forceinline__ int crow(int r,int hi){return (r&3)+8*(r>>2)+4*hi;}
#define SBAR() __builtin_amdgcn_sched_barrier(0)
__device__ __forceinline__ void cmask(f32x16&p0,f32x16&p1,int jb,int qrel,int hi){
  const float NEG=-INFINITY; int kb=64*jb+4*hi;
  #pragma unroll
  for(int r=0;r<16;++r){int kv=kb+(r&3)+8*(r>>2); if(kv>qrel)p0[r]=NEG; if(kv+32>qrel)p1[r]=NEG;}
}

constexpr int NSLOT=3, SLOTB=8192;
constexpr int LDS_K=0, LDS_V=NSLOT*SLOTB, LDS_WS=2*NSLOT*SLOTB, LDS_OST=LDS_WS+NW*64*4, LDS_BYTES=LDS_OST+NW*4096;
constexpr float C2=0.125f*1.4426950408889634f;
__device__ __forceinline__ void glds16(const void*gsrc,unsigned lds_dst){unsigned keep;
  asm volatile("s_mov_b32 %0, m0\n\ts_mov_b32 m0, %2\n\ts_nop 0\n\tglobal_load_lds_dwordx4 %1, off\n\ts_mov_b32 m0, %0":"=&s"(keep):"v"(gsrc),"s"(lds_dst):"memory");}
__device__ __forceinline__ void glds16s(const void*sbase,unsigned voff,unsigned lds_dst){unsigned keep;
  asm volatile("s_mov_b32 %0, m0\n\ts_mov_b32 m0, %3\n\ts_nop 4\n\tglobal_load_lds_dwordx4 %1, %2\n\ts_mov_b32 m0, %0":"=&s"(keep):"v"(voff),"s"(sbase),"s"(lds_dst):"memory");}
__device__ __forceinline__ float max3f(float a,float b,float c){float r;asm("v_max3_f32 %0, %1, %2, %3":"=v"(r):"v"(a),"v"(b),"v"(c));return r;}
__device__ __forceinline__ float max2f(float a,float b){float r;asm("v_max_f32_e32 %0, %1, %2":"=v"(r):"v"(a),"v"(b));return r;}
__device__ __forceinline__ float fadd_s(float a,float b){float r;asm("v_add_f32_e32 %0, %1, %2":"=v"(r):"v"(a),"v"(b));return r;}
__device__ __forceinline__ float fsub_s(float a,float b){float r;asm("v_sub_f32_e32 %0, %1, %2":"=v"(r):"v"(a),"v"(b));return r;}
typedef float f32x2_t __attribute__((ext_vector_type(2))); typedef __bf16 bf16x2_t __attribute__((ext_vector_type(2)));
__device__ __forceinline__ unsigned cvtpk_s(float lo,float hi){f32x2_t v={lo,hi};bf16x2_t b=__builtin_convertvector(v,bf16x2_t);return __builtin_bit_cast(unsigned,b);}
#define WAIT_BAR(N) asm volatile("s_waitcnt vmcnt(" #N ") lgkmcnt(0)\n\ts_barrier":::"memory")

__device__ __forceinline__ void qkt(f32x16&p0,f32x16&p1,const char*Kslot,const bf16x8*qr,const f32x16&negm,int r32,int hi){
  const char*kb=Kslot+hi*1024+r32*16;
  #pragma unroll
  for(int d0=0;d0<4;++d0){
    const bf16x8 b0=*reinterpret_cast<const bf16x8*>(kb+d0*2048);
    const bf16x8 b1=*reinterpret_cast<const bf16x8*>(kb+d0*2048+512);
    if(d0==0){p0=__builtin_amdgcn_mfma_f32_32x32x16_bf16(b0,qr[0],negm,0,0,0);p1=__builtin_amdgcn_mfma_f32_32x32x16_bf16(b1,qr[0],negm,0,0,0);}
    else{p0=__builtin_amdgcn_mfma_f32_32x32x16_bf16(b0,qr[d0],p0,0,0,0);p1=__builtin_amdgcn_mfma_f32_32x32x16_bf16(b1,qr[d0],p1,0,0,0);}}
}
typedef __attribute__((address_space(3))) const char* lds_cptr;
typedef short v4i16_t __attribute__((ext_vector_type(4)));
__device__ __forceinline__ void kload8(bf16x8*kf,lds_cptr kp){
  kf[0]=*(const __attribute__((address_space(3))) bf16x8*)(kp);      kf[1]=*(const __attribute__((address_space(3))) bf16x8*)(kp+512);
  kf[2]=*(const __attribute__((address_space(3))) bf16x8*)(kp+2048); kf[3]=*(const __attribute__((address_space(3))) bf16x8*)(kp+2560);
  kf[4]=*(const __attribute__((address_space(3))) bf16x8*)(kp+4096); kf[5]=*(const __attribute__((address_space(3))) bf16x8*)(kp+4608);
  kf[6]=*(const __attribute__((address_space(3))) bf16x8*)(kp+6144); kf[7]=*(const __attribute__((address_space(3))) bf16x8*)(kp+6656);
}
__device__ __forceinline__ void kload2(bf16x8*kf,lds_cptr kp,int j){ kf[2*j]=*(const __attribute__((address_space(3))) bf16x8*)(kp+j*2048); kf[2*j+1]=*(const __attribute__((address_space(3))) bf16x8*)(kp+j*2048+512); }
__device__ __forceinline__ s16x4 vtr(lds_cptr p){ return __builtin_bit_cast(s16x4,__builtin_amdgcn_ds_read_tr16_b64_v4i16((__attribute__((address_space(3))) v4i16_t*)p)); }
__device__ __forceinline__ float rowmax(const f32x16&p0,const f32x16&p1){
  float a=max3f(p0[0],p0[1],p1[0]),b=max3f(p0[2],p0[3],p1[1]);a=max3f(a,p1[2],p1[3]);
  #pragma unroll
  for(int r=4;r<16;r+=4){a=max3f(a,p0[r],p0[r+1]);b=max3f(b,p0[r+2],p0[r+3]);a=max3f(a,p1[r],p1[r+1]);b=max3f(b,p1[r+2],p1[r+3]);}
  const float m=max2f(a,b);
  auto rr=__builtin_amdgcn_permlane32_swap(__float_as_uint(m),__float_as_uint(m),false,false);
  return max2f(__uint_as_float(rr[0]),__uint_as_float(rr[1]));
}
__device__ __forceinline__ void pv(f32x16*o,int vb,bf16x8 pa0,bf16x8 pa1,bf16x8 pa2,bf16x8 pa3){
  #pragma unroll
  for(int d0=0;d0<2;++d0){s16x4 lo[4],hi[4];
    #pragma unroll
    for(int ks=0;ks<4;++ks){
      asm volatile("ds_read_b64_tr_b16 %0,%1 offset:%c2":"=&v"(lo[ks]):"v"(vb),"i"(d0*4096+ks*1024):"memory");
      asm volatile("ds_read_b64_tr_b16 %0,%1 offset:%c2":"=&v"(hi[ks]):"v"(vb),"i"(d0*4096+ks*1024+512):"memory");}
    asm volatile("s_waitcnt lgkmcnt(0)":::"memory");SBAR();
    #define PK(k) (bf16x8){lo[k][0],lo[k][1],lo[k][2],lo[k][3],hi[k][0],hi[k][1],hi[k][2],hi[k][3]}
    o[d0]=__builtin_amdgcn_mfma_f32_32x32x16_bf16(pa0,PK(0),o[d0],0,0,0);
    o[d0]=__builtin_amdgcn_mfma_f32_32x32x16_bf16(pa1,PK(1),o[d0],0,0,0);
    o[d0]=__builtin_amdgcn_mfma_f32_32x32x16_bf16(pa2,PK(2),o[d0],0,0,0);
    o[d0]=__builtin_amdgcn_mfma_f32_32x32x16_bf16(pa3,PK(3),o[d0],0,0,0);
    #undef PK
  }
}

#ifndef ATTN_STORE16
#define ATTN_STORE16(p,v) (*(u32x4*)(p)=(v))
#endif
template<int THRL> __device__ __forceinline__ void attn_unit(long rowbase,int qb,const bf16*Qc,const bf16*__restrict__ Kc,const bf16*__restrict__ Vc,bf16*Oc,char*shm){
  int tid_=threadIdx.x; asm volatile("":"+v"(tid_)); const int tid=tid_,lane=tid&63,r32=lane&31,hi=lane>>5; const int wid=__builtin_amdgcn_readfirstlane(tid>>6);
  const int q0=qb*QB;
  const bf16*Qw=Qc+(rowbase+q0+wid*QBLK)*DM;
  const bf16*Kh=Kc+rowbase*DM,*Vh=Vc+rowbase*DM;
  const unsigned lds0=(unsigned)(uintptr_t)shm;
  float*wsf=(float*)(shm+LDS_WS)+wid*64;
  const unsigned koff=(unsigned)(lane*DM+wid*8)*2u;
  const unsigned voffv=(unsigned)((16*(wid&3)+(lane>>2))*DM+(wid>>2)*32+(lane&3)*8)*2u;
  const unsigned kdst=lds0+LDS_K+wid*1024, vdst=lds0+LDS_V+wid*1024;
  #define DMA_K(t,slot) glds16s(Kh+(long)(t)*KVBLK*DM,koff,(unsigned)__builtin_amdgcn_readfirstlane(kdst+(slot)))
  #define DMA_V(t,slot) glds16s(Vh+(long)(t)*KVBLK*DM,voffv,(unsigned)__builtin_amdgcn_readfirstlane(vdst+(slot)))
  const int vb0=(int)(lds0+LDS_V)+((lane>>4)&1)*32+(lane&3)*8+(4*hi+((lane&15)>>2))*64;
  const char*Kbase=shm+LDS_K; bf16x8 kf[8];
  const lds_cptr shm3=(lds_cptr)shm; const lds_cptr kp0=shm3+LDS_K+hi*1024+r32*16; const lds_cptr vp0=shm3+LDS_V+((lane>>4)&1)*32+(lane&3)*8+(4*hi+((lane&15)>>2))*64;
  const int NT=(q0+QB)/KVBLK;
  DMA_K(0,0);DMA_V(0,0);DMA_K(1,SLOTB);
  bf16x8 qr[4];
  #pragma unroll
  for(int d0=0;d0<4;++d0)qr[d0]=*reinterpret_cast<const bf16x8*>(&Qw[(long)r32*DM+d0*16+hi*8]);
  float mhat=0.f,l_reg=0.f;f32x16 o[2];o[0]=f32x16{};o[1]=f32x16{};f32x16 negm=f32x16{};asm volatile("":"+v"(negm));
  const int qrel=wid*QBLK+r32;
  #define CMASK(P0,P1,t) do{int jb_=(t)-(NT-4); if(jb_>=0)cmask(P0,P1,jb_,qrel,hi);}while(0)
  bool resc=false;
  #define START(P0,P1) do{ const float rm=rowmax(P0,P1); resc=false; \
    { const float dl=rm; mhat=fadd_s(mhat,dl); \
      _Pragma("unroll") for(int r=0;r<16;++r){P0[r]=fsub_s(P0[r],dl);P1[r]=fsub_s(P1[r],dl);} \
      _Pragma("unroll") for(int r=0;r<16;++r)negm[r]=-mhat; asm volatile("":"+v"(negm)); } \
    _Pragma("unroll") for(int r=0;r<16;++r)P0[r]=__builtin_amdgcn_exp2f(P0[r]); }while(0)
  #define RESC() do{ if(resc){ asm volatile("s_waitcnt lgkmcnt(0)":::"memory"); \
      _Pragma("unroll") for(int d_=0;d_<2;++d_) _Pragma("unroll") for(int r=0;r<16;++r)o[d_][r]*=wsf[crow(r,hi)]; } }while(0)
  f32x16 pA0,pA1,pB0,pB1;
  int sl_prev=0,sl_cur=0,sl_next=SLOTB;
  #define ROT() do{sl_prev=sl_cur;sl_cur=sl_next;sl_next=(sl_next==(NSLOT-1)*SLOTB)?0:sl_next+SLOTB;}while(0)
  DMA_K(2,2*SLOTB);
  WAIT_BAR(3);
  qkt(pA0,pA1,Kbase,qr,negm,r32,hi);asm volatile("s_nop 15\n\ts_nop 7":"+v"(pA0),"+v"(pA1));CMASK(pA0,pA1,0);
  START(pA0,pA1);
  _Pragma("unroll") for(int r=0;r<16;++r)pA1[r]=__builtin_amdgcn_exp2f(pA1[r]);
  WAIT_BAR(0);
  DMA_K(3,0);DMA_V(1,SLOTB);
  ROT();
  kload8(kf,kp0+sl_cur);
  WAIT_BAR(2);
  s16x4 vlo[8],vhi[8]; u32x4 pw0,pw1,pw2,pw3;
  #define PKW(P,B) cvtpk_s(P[B],P[B+1])
  #define PAF(k) __builtin_bit_cast(bf16x8,pw##k)
  #define VFR(i) (bf16x8){vlo[i][0],vlo[i][1],vlo[i][2],vlo[i][3],vhi[i][0],vhi[i][1],vhi[i][2],vhi[i][3]}
  #define PIN(x) asm volatile("":"+v"(x))
  #define MX3(a,b,c) __builtin_fmaxf(__builtin_fmaxf((a),(b)),(c))
  #define GAPA(MF,A0,A1,A2,A3,W0,W1,PW) do{ MF; sacc+=A0; sacc+=A1; sacc+=A2; sacc+=A3; PIN(sacc); W0; W1; PIN(PW); SBAR(); }while(0)
  #define EX(v) __builtin_amdgcn_exp2f(v)
  #define GAPB(MF,X,B) do{ MF; X[B]=EX(X[B]); X[B+1]=EX(X[B+1]); X[B+2]=EX(X[B+2]); X[B+3]=EX(X[B+3]); PIN(X); SBAR(); }while(0)
  #define VRD(i) do{ vlo[i]=vtr(vp_+(((i)>>2)*4096+((i)&3)*1024)); vhi[i]=vtr(vp_+(((i)>>2)*4096+((i)&3)*1024+512)); }while(0)
  #define KRD(G,j) do{ if(G){ kload2(kf,kp0+sl_next,j); SBAR(); } }while(0)
  #define STEP(C0,C1,P0,P1,t,GK,GV,GL) do{ SBAR(); \
    const lds_cptr vp_=vp0+sl_prev; \
    VRD(0); SBAR(); float sacc=(P0[0]+P0[1]); \
    GAPA(C0=__builtin_amdgcn_mfma_f32_32x32x16_bf16(kf[0],qr[0],negm,0,0,0), P0[2],P0[3],P0[4],P0[5],     pw0[0]=PKW(P0,0), pw0[1]=PKW(P0,2), pw0); \
    VRD(4); SBAR(); GAPA(C1=__builtin_amdgcn_mfma_f32_32x32x16_bf16(kf[1],qr[0],negm,0,0,0), P0[6],P0[7],P0[8],P0[9],     pw0[2]=PKW(P0,4), pw0[3]=PKW(P0,6), pw0); \
    VRD(1); SBAR(); GAPA(C0=__builtin_amdgcn_mfma_f32_32x32x16_bf16(kf[2],qr[1],C0,0,0,0),   P0[10],P0[11],P0[12],P0[13], pw1[0]=PKW(P0,8), pw1[1]=PKW(P0,10), pw1); \
    VRD(5); SBAR(); GAPA(C1=__builtin_amdgcn_mfma_f32_32x32x16_bf16(kf[3],qr[1],C1,0,0,0),   P0[14],P0[15],P1[0],P1[1],   pw1[2]=PKW(P0,12),pw1[3]=PKW(P0,14), pw1); \
    VRD(2); SBAR(); GAPA(C0=__builtin_amdgcn_mfma_f32_32x32x16_bf16(kf[4],qr[2],C0,0,0,0),   P1[2],P1[3],P1[4],P1[5],     pw2[0]=PKW(P1,0), pw2[1]=PKW(P1,2), pw2); \
    VRD(6); SBAR(); GAPA(C1=__builtin_amdgcn_mfma_f32_32x32x16_bf16(kf[5],qr[2],C1,0,0,0),   P1[6],P1[7],P1[8],P1[9],     pw2[2]=PKW(P1,4), pw2[3]=PKW(P1,6), pw2); \
    VRD(3); SBAR(); GAPA(C0=__builtin_amdgcn_mfma_f32_32x32x16_bf16(kf[6],qr[3],C0,0,0,0),   P1[10],P1[11],P1[12],P1[13], pw3[0]=PKW(P1,8), pw3[1]=PKW(P1,10), pw3); \
    VRD(7); SBAR(); GAPA(C1=__builtin_amdgcn_mfma_f32_32x32x16_bf16(kf[7],qr[3],C1,0,0,0),   P1[14],P1[15],0.f,0.f,       pw3[2]=PKW(P1,12),pw3[3]=PKW(P1,14), pw3); \
    l_reg+=sacc; \
    if(GK){DMA_K((t)+3,sl_cur);} if(GV){DMA_V((t)+1,sl_next);} \
    CMASK(C0,C1,t); \
    { float a=MX3(C0[0],C0[1],C1[0]),b=MX3(C0[2],C0[3],C1[1]); a=MX3(a,C1[2],C1[3]); \
      _Pragma("unroll") for(int r=4;r<16;r+=4){a=MX3(a,C0[r],C0[r+1]);b=MX3(b,C0[r+2],C0[r+3]);a=MX3(a,C1[r],C1[r+1]);b=MX3(b,C1[r+2],C1[r+3]);} \
      float rm=__builtin_fmaxf(a,b); { auto rr=__builtin_amdgcn_permlane32_swap(__float_as_uint(rm),__float_as_uint(rm),false,false); rm=__builtin_fmaxf(__uint_as_float(rr[0]),__uint_as_float(rr[1])); } \
      resc=false; \
      if(__builtin_expect(__any(rm>(float)THRL),0)){ const float dl=__builtin_fmaxf(rm,0.f); mhat+=dl; \
        _Pragma("unroll") for(int r=0;r<16;++r){C0[r]-=dl;C1[r]-=dl;} \
        _Pragma("unroll") for(int r=0;r<16;++r)negm[r]=-mhat; asm volatile("":"+v"(negm)); \
        const float f=__builtin_amdgcn_exp2f(-dl); l_reg*=f; if(hi==0)wsf[r32]=f; resc=true; } } \
    SBAR(); \
    GAPB(o[0]=__builtin_amdgcn_mfma_f32_32x32x16_bf16(PAF(0),VFR(0),o[0],0,0,0), C0,0); \
    GAPB(o[1]=__builtin_amdgcn_mfma_f32_32x32x16_bf16(PAF(0),VFR(4),o[1],0,0,0), C0,4); \
    KRD(GL,0); GAPB(o[0]=__builtin_amdgcn_mfma_f32_32x32x16_bf16(PAF(1),VFR(1),o[0],0,0,0), C0,8); \
    KRD(GL,1); GAPB(o[1]=__builtin_amdgcn_mfma_f32_32x32x16_bf16(PAF(1),VFR(5),o[1],0,0,0), C0,12); \
    KRD(GL,2); GAPB(o[0]=__builtin_amdgcn_mfma_f32_32x32x16_bf16(PAF(2),VFR(2),o[0],0,0,0), C1,0); \
    KRD(GL,3); GAPB(o[1]=__builtin_amdgcn_mfma_f32_32x32x16_bf16(PAF(2),VFR(6),o[1],0,0,0), C1,4); \
    GAPB(o[0]=__builtin_amdgcn_mfma_f32_32x32x16_bf16(PAF(3),VFR(3),o[0],0,0,0), C1,8); \
    GAPB(o[1]=__builtin_amdgcn_mfma_f32_32x32x16_bf16(PAF(3),VFR(7),o[1],0,0,0), C1,12); \
    }while(0)
  int t=1;
  #undef CMASK
  #define CMASK(P0,P1,t) do{}while(0)
  for(;t+5<NT;t+=2){
    STEP(pB0,pB1,pA0,pA1,t,true,true,true);     WAIT_BAR(2); RESC(); ROT();
    STEP(pA0,pA1,pB0,pB1,t+1,true,true,true);   WAIT_BAR(2); RESC(); ROT();
  }
  #undef CMASK
  #define CMASK(P0,P1,t) do{int jb_=(t)-(NT-4); if(jb_>=0)cmask(P0,P1,jb_,qrel,hi);}while(0)
  #define ENDW(tt) do{ if((tt)+3<NT){WAIT_BAR(2);} else if((tt)+2<NT){WAIT_BAR(1);} else {WAIT_BAR(0);} }while(0)
  for(;t+1<NT;t+=2){
    STEP(pB0,pB1,pA0,pA1,t,(t+3<NT),(t+1<NT),(t+1<NT));       ENDW(t);   RESC(); ROT();
    STEP(pA0,pA1,pB0,pB1,t+1,(t+4<NT),(t+2<NT),(t+2<NT));     ENDW(t+1); RESC(); ROT();
  }
  STEP(pB0,pB1,pA0,pA1,NT-1,false,false,false); RESC();
  { float sacc=pB0[0]+pB0[1]; _Pragma("unroll") for(int r=2;r<16;++r)sacc+=pB0[r]; _Pragma("unroll") for(int r=0;r<16;++r)sacc+=pB1[r]; l_reg+=sacc;
    pw0=(u32x4){PKW(pB0,0),PKW(pB0,2),PKW(pB0,4),PKW(pB0,6)};pw1=(u32x4){PKW(pB0,8),PKW(pB0,10),PKW(pB0,12),PKW(pB0,14)};pw2=(u32x4){PKW(pB1,0),PKW(pB1,2),PKW(pB1,4),PKW(pB1,6)};pw3=(u32x4){PKW(pB1,8),PKW(pB1,10),PKW(pB1,12),PKW(pB1,14)};
    SBAR(); pv(o,vb0+sl_cur,PAF(0),PAF(1),PAF(2),PAF(3)); }
  #undef PKW
  #undef PAF
  #undef VFR
  #undef PIN
  #undef MX3
  #undef GAPA
  #undef GAPB
  #undef EX
  #undef VRD
  #undef KRD
  #undef STEP
  #undef ENDW
  {auto rr=__builtin_amdgcn_permlane32_swap(__float_as_uint(l_reg),__float_as_uint(l_reg),false,false);l_reg=__uint_as_float(rr[0])+__uint_as_float(rr[1]);}
  if(hi==0)wsf[32+r32]=l_reg;asm volatile("s_waitcnt lgkmcnt(0)":::"memory");
  float rli[16];
  #pragma unroll
  for(int r=0;r<16;++r)rli[r]=__builtin_amdgcn_rcpf(wsf[32+crow(r,hi)]);
  bf16*Ow=Oc+(rowbase+q0+wid*QBLK)*DM;
  { bf16*stg=(bf16*)(shm+LDS_OST)+wid*2048;
    #pragma unroll
    for(int r=0;r<16;++r){const int orow=crow(r,hi);
      #pragma unroll
      for(int d0=0;d0<2;++d0)stg[orow*64+d0*32+r32]=__float2bfloat16(o[d0][r]*rli[r]);}
    asm volatile("s_waitcnt lgkmcnt(0)":::"memory");
    #pragma unroll
    for(int i=0;i<4;++i){const int row=i*8+(lane>>3),ch=lane&7; const u32x4 v=*(const u32x4*)(stg+row*64+ch*8); ATTN_STORE16(Ow+(long)row*DM+ch*8,v);} }
  asm volatile("s_waitcnt lgkmcnt(0)\n\ts_barrier":::"memory");
  #undef DMA_K
  #undef DMA_V
  #undef CMASK
  #undef START
  #undef RESC
  #undef ROT
}
constexpr int ATTN_LDS_BYTES=LDS_BYTES;
#undef SBAR
#undef WAIT_BAR
}
namespace mk {
#define GAS __attribute__((address_space(1)))
#define LAS __attribute__((address_space(3)))
typedef unsigned short bf16;
typedef unsigned v4u __attribute__((ext_vector_type(4)));
typedef unsigned v2u __attribute__((ext_vector_type(2)));
typedef float f32x4 __attribute__((ext_vector_type(4)));
using pg8::Unit;
using pg8::cvt_pk_bf16;

constexpr int D = 1024, BATCH = 8, SEQ = 2048, T = BATCH * SEQ, NH = 8, NG = 4, EPG = 8, NE = 32, DE = 512, NRW = NG + NE;
constexpr float ALPHA = 1.4142135623730951f, LN_EPS = 1e-5f, RMS_EPS = 1e-5f;
constexpr float LAM_INIT = 0.35550906f;
constexpr float QSCALE = 0.125f * 1.4426950408889634f;
constexpr int CNT_STRIDE = 64;
constexpr int CAP = 2 * T;
constexpr int NWAVES = 8, NTHREADS = 512;
#ifndef P0B_FILL
#define P0B_FILL 1
#endif
#ifndef P0B_SPLIT
#define P0B_SPLIT 15360
#endif

constexpr size_t MiB = 1u << 20;
constexpr size_t WS_CTL = 0, WS_W1T = 1 * MiB, WS_W2T = 7 * MiB, WS_WKVQ = 9 * MiB, WS_WOT = 15 * MiB, WS_RWT = 17 * MiB, WS_PERM = 18 * MiB, WS_GATE = 22 * MiB;
constexpr size_t WS_WUT = 24 * MiB, WS_WDT = 152 * MiB, WS_XB = 216 * MiB, WS_GB = 248 * MiB, WS_U = 280 * MiB, WS_A2 = 312 * MiB, WS_Z = 344 * MiB, WS_X1B = 408 * MiB;
constexpr size_t WS_ACT = 440 * MiB, WS_YP = 480 * MiB, WS_X2B = 544 * MiB, WS_K = 576 * MiB, WS_V = 608 * MiB, WS_Q = 640 * MiB, WS_O0 = 672 * MiB, WS_O1 = 704 * MiB;
constexpr size_t WS_A3 = 736 * MiB, WS_X3B = 768 * MiB;
#ifdef MKPROBE
constexpr size_t WS_Z1 = 800 * MiB, WS_ACT1 = 864 * MiB, WS_YP1 = 904 * MiB, WS_PERM1 = 968 * MiB, WS_GATE1 = 972 * MiB, WS_END = 973 * MiB;
#else
constexpr size_t WS_Z1 = WS_Z, WS_ACT1 = WS_ACT, WS_YP1 = WS_YP, WS_PERM1 = WS_PERM, WS_GATE1 = WS_GATE, WS_END = 800 * MiB;
#endif
#define LZ(l) ((l) ? WS_Z1 : WS_Z)
#define LACT(l) ((l) ? WS_ACT1 : WS_ACT)
#define LYP(l) ((l) ? WS_YP1 : WS_YP)
#define LPERM(l) ((l) ? WS_PERM1 : WS_PERM)
#define LGATE(l) ((l) ? WS_GATE1 : WS_GATE)
constexpr int RING_BYTES = 131072, RW_BYTES = 147456  , MISC_OFF = RW_BYTES, LDS_BYTES = 163840;

struct Args {
    const float *x, *a_w_in, *a_conv_w, *a_w_out, *kv_w, *b_w_q, *b_lambda, *b_subln_g, *b_w_o, *ln1_g, *ln1_b, *ln2_g, *ln2_b, *rg_w, *rg_b, *re_w, *re_b, *e_w_in, *e_w_down;
    float* out; unsigned char* ws;
};

typedef const __attribute__((address_space(4))) Args* ArgsP;
__device__ __forceinline__ ArgsP kargs() { ArgsP p = (ArgsP)__builtin_amdgcn_kernarg_segment_ptr(); asm volatile("" : "+s"(p)); return p; }
struct Ctx { int tid, lane, wave, G, bx, gw, NGW; unsigned char* ws; };
__device__ __forceinline__ Ctx mkctx(ArgsP ap) { Ctx c; int t = threadIdx.x; asm volatile("" : "+v"(t)); c.tid = t; c.lane = t & 63; c.wave = __builtin_amdgcn_readfirstlane(t >> 6);
    c.G = gridDim.x; c.bx = blockIdx.x; c.gw = c.bx * 8 + c.wave; c.NGW = c.G * 8; c.ws = ap->ws; return c; }
__device__ __forceinline__ unsigned f2bf(float f) { unsigned u = __builtin_bit_cast(unsigned, f); return (u + 0x7fffu + ((u >> 16) & 1u)) >> 16; }
__device__ __forceinline__ unsigned pk2(float lo, float hi) { return f2bf(lo) | (f2bf(hi) << 16); }
__device__ __forceinline__ float bflo(unsigned w) { return __builtin_bit_cast(float, w << 16); }
__device__ __forceinline__ float bfhi(unsigned w) { return __builtin_bit_cast(float, w & 0xffff0000u); }
__device__ __forceinline__ float wave_sum(float v) {
#pragma unroll
    for (int o = 1; o < 64; o <<= 1) v += __shfl_xor(v, o);
    return v;
}

__device__ __forceinline__ float dpp_add(float v, const int ctrl_sel) {
    const int iv = __builtin_bit_cast(int, v); int t;
    if (ctrl_sel == 0) t = __builtin_amdgcn_update_dpp(0, iv, 0xB1, 0xF, 0xF, true);
    else if (ctrl_sel == 1) t = __builtin_amdgcn_update_dpp(0, iv, 0x4E, 0xF, 0xF, true);
    else if (ctrl_sel == 2) t = __builtin_amdgcn_update_dpp(0, iv, 0x141, 0xF, 0xF, true);
    else if (ctrl_sel == 3) t = __builtin_amdgcn_update_dpp(0, iv, 0x140, 0xF, 0xF, true);
    else if (ctrl_sel == 4) t = __builtin_amdgcn_update_dpp(0, iv, 0x142, 0xA, 0xF, false);
    else t = __builtin_amdgcn_update_dpp(0, iv, 0x143, 0xC, 0xF, false);
    return v + __builtin_bit_cast(float, t);
}
template <int N> __device__ __forceinline__ void dpp_sum(float (&v)[N]) {
#pragma unroll
    for (int st = 0; st < 6; ++st) {
#pragma unroll
        for (int i = 0; i < N; ++i) v[i] = dpp_add(v[i], st);
    }
#pragma unroll
    for (int i = 0; i < N; ++i) v[i] = __builtin_bit_cast(float, __builtin_amdgcn_readlane(__builtin_bit_cast(int, v[i]), 63));
}
__device__ __forceinline__ float dpp_sum1(float v) { float a[1] = {v}; dpp_sum(a); return a[0]; }

__device__ __forceinline__ void p0_transpose_item(const float* W, int K, int N, bf16* WT, int row_off, LAS float* scr, int item, int lane) {
    const int nblk = N / 32, kb = item / nblk, nb = item % nblk, k0 = 64 * kb, n0 = 32 * nb;
#pragma unroll 8
    for (int i = 0; i < 32; ++i) { const int kk = 2 * i + (lane >> 5); scr[kk * 33 + (lane & 31)] = W[(size_t)(k0 + kk) * N + n0 + (lane & 31)]; }
    asm volatile("s_waitcnt lgkmcnt(0)" ::: "memory");
    const int c = lane & 7;
#pragma unroll
    for (int j = 0; j < 4; ++j) { const int n = (lane >> 3) + 8 * j; const LAS float* s = scr + (8 * c) * 33 + n;
        v4u o; o.x = pk2(s[0 * 33], s[1 * 33]); o.y = pk2(s[2 * 33], s[3 * 33]); o.z = pk2(s[4 * 33], s[5 * 33]); o.w = pk2(s[6 * 33], s[7 * 33]);
        *(GAS v4u*)(WT + (size_t)(row_off + n0 + n) * K + k0 + 8 * c) = o; }
    asm volatile("s_waitcnt lgkmcnt(0)" ::: "memory");
}

__device__ __forceinline__ void p0_prologue(LAS unsigned char* lds) {
    const ArgsP a = kargs(); const Ctx cx = mkctx(a); const int gw = cx.gw, NGW = cx.NGW, wave = cx.wave, lane = cx.lane;
    unsigned char* ws = cx.ws;
    LAS float* scr = (LAS float*)(lds + wave * 16384);
    constexpr int I_IN = 16 * 96, I_SQ = 16 * 32, I_KV = 16 * 64, I_DN = 8 * 32;
    constexpr int NEM = P0B_FILL ? NE : 2 * NE;
    constexpr int S1 = I_IN, S2 = S1 + I_SQ, S3 = S2 + I_KV, S4 = S3 + I_SQ, S5 = S4 + I_SQ, S6 = S5 + NEM * I_SQ, NITEMS = S6 + NEM * I_DN;
    for (int it = gw; it < NITEMS; it += NGW) {
        if (it < S1) p0_transpose_item(a->a_w_in, D, 3 * D, (bf16*)(ws + WS_W1T), 0, scr, it, lane);
        else if (it < S2) p0_transpose_item(a->a_w_out, D, D, (bf16*)(ws + WS_W2T), 0, scr, it - S1, lane);
        else if (it < S3) p0_transpose_item(a->kv_w, D, 2 * D, (bf16*)(ws + WS_WKVQ), 0, scr, it - S2, lane);
        else if (it < S4) p0_transpose_item(a->b_w_q, D, D, (bf16*)(ws + WS_WKVQ), 2 * D, scr, it - S3, lane);
        else if (it < S5) p0_transpose_item(a->b_w_o, D, D, (bf16*)(ws + WS_WOT), 0, scr, it - S4, lane);
        else if (it < S6) { const int r = it - S5, mtx = r / I_SQ; p0_transpose_item(a->e_w_in + (size_t)mtx * D * D, D, D, (bf16*)(ws + WS_WUT) + (size_t)mtx * D * D, 0, scr, r % I_SQ, lane); }
        else { const int r = it - S6, mtx = r / I_DN; p0_transpose_item(a->e_w_down + (size_t)mtx * DE * D, DE, D, (bf16*)(ws + WS_WDT) + (size_t)mtx * D * DE, 0, scr, r % I_DN, lane); }
    }
    for (int m = gw; m < T; m += NGW) {
        const GAS f32x4* xr = (const GAS f32x4*)(a->x + (size_t)m * D) + lane;
        GAS v2u* o = (GAS v2u*)((bf16*)(ws + WS_XB) + (size_t)m * D) + lane;
#pragma unroll
        for (int j = 0; j < 4; ++j) { const f32x4 v = xr[64 * j]; v2u w; w.x = pk2(v.x, v.y); w.y = pk2(v.z, v.w); o[64 * j] = w; }
    }
    { float* rwt = (float*)(ws + WS_RWT);
      for (int idx = gw * 64 + lane; idx < 2 * NRW * D; idx += NGW * 64) { const int l = idx / (NRW * D), n = (idx / D) % NRW, k = idx % D;
          rwt[idx] = n < NG ? a->rg_w[((size_t)l * D + k) * NG + n] : a->re_w[((size_t)l * D + k) * NE + (n - NG)]; } }
}

__device__ __forceinline__ void p0b_fill(LAS unsigned char* lds, int lo, int hi, int r, int nidle) {
    const ArgsP a = kargs(); const Ctx cx = mkctx(a); unsigned char* ws = cx.ws;
    LAS float* scr = (LAS float*)(lds + cx.wave * 16384);
    for (int it = lo + r * NWAVES + cx.wave; it < hi; it += nidle * NWAVES) {
        if (it < NE * 512) { const int mtx = NE + it / 512; p0_transpose_item(a->e_w_in + (size_t)mtx * D * D, D, D, (bf16*)(ws + WS_WUT) + (size_t)mtx * D * D, 0, scr, it % 512, cx.lane); }
        else { const int r2 = it - NE * 512, mtx = NE + r2 / 256; p0_transpose_item(a->e_w_down + (size_t)mtx * DE * D, DE, D, (bf16*)(ws + WS_WDT) + (size_t)mtx * D * DE, 0, scr, r2 % 256, cx.lane); }
    }
}
constexpr int P0B_ITEMS = NE * 512 + NE * 256;
__device__ __forceinline__ void p0b_idle_fill(LAS unsigned char* lds, int lo, int hi) {
    const ArgsP a = kargs(); const Ctx cx = mkctx(a); const LAS int* misc = (const LAS int*)(lds + MISC_OFF);
    const int U = misc[NE], rem = U % cx.G;
    if (rem == 0) p0b_fill(lds, lo, hi, cx.bx, cx.G);
    else if (cx.bx >= rem) p0b_fill(lds, lo, hi, cx.bx - rem, cx.G - rem);
}
struct SchedDense {
    int G, c, nN, mode, K; const char* W;
    __device__ __forceinline__ bool next(int i, Unit& u) const {
        int pm, pn; if (!pg8::static_tile(i, G, c, T / 256, nN, pm, pn)) return false;
        u.arow = pm * 256; u.p0 = pm; u.p1 = pn; u.p2 = 0;
        const size_t rb = (size_t)K * 2;
        if (mode == 0 && pn >= 4) { const int jj = pn - 4; u.b0 = W + (size_t)(D + 128 * jj) * rb; u.b1 = W + (size_t)(2 * D + 128 * jj) * rb; }
        else { u.b0 = W + (size_t)(256 * pn) * rb; u.b1 = u.b0 + 128 * rb; }
        return true;
    }
    __device__ __forceinline__ void a_offs(const Unit& u, const int (&R)[2], const int (&C)[2], unsigned& v00, unsigned& v01, unsigned& v10, unsigned& v11) const {
        v00 = (unsigned)((u.arow + R[0]) * K + C[0]) * 2u; v01 = (unsigned)((u.arow + R[1]) * K + C[1]) * 2u;
        v10 = (unsigned)((u.arow + 128 + R[0]) * K + C[0]) * 2u; v11 = (unsigned)((u.arow + 128 + R[1]) * K + C[1]) * 2u;
    }
};
struct MoeTab { const LAS int* ub; const LAS int* ps; const LAS int* cn; };
struct SchedMoe {
    int G, c, K; bool up; const char* W; const int* perm; MoeTab tb;
    __device__ __forceinline__ bool next(int i, Unit& u) const {
        const int idx = i * G + c; if (idx >= tb.ub[NE]) return false;
        int e = 0;
#pragma unroll 1
        for (int k = 1; k < NE; ++k) if (idx >= tb.ub[k]) e = k;
        const int local = idx - tb.ub[e], rtn = (tb.ub[e + 1] - tb.ub[e]) >> 2, ct = local / rtn, rti = local - ct * rtn;
        const size_t rb = (size_t)K * 2; const char* We = W + (size_t)e * D * rb;
        if (up) { u.b0 = We + (size_t)(128 * ct) * rb; u.b1 = We + (size_t)(DE + 128 * ct) * rb; u.arow = e * CAP + rti * 256; u.p0 = tb.ps[e] + rti * 256; }
        else { u.b0 = We + (size_t)(256 * ct) * rb; u.b1 = u.b0 + 128 * rb; u.arow = tb.ps[e] + rti * 256; u.p0 = e * CAP + rti * 256; }
        u.p1 = ct; u.p2 = tb.cn[e] - rti * 256;
        return true;
    }
    __device__ __forceinline__ void a_offs(const Unit& u, const int (&R)[2], const int (&C)[2], unsigned& v00, unsigned& v01, unsigned& v10, unsigned& v11) const {
        if (up) {
            const int r00 = R[0] < u.p2 ? R[0] : 0, r01 = R[1] < u.p2 ? R[1] : 0, r10 = 128 + R[0] < u.p2 ? 128 + R[0] : 0, r11 = 128 + R[1] < u.p2 ? 128 + R[1] : 0;
            const int t00 = perm[u.arow + r00] >> 1, t01 = perm[u.arow + r01] >> 1, t10 = perm[u.arow + r10] >> 1, t11 = perm[u.arow + r11] >> 1;
            v00 = (unsigned)(t00 * K + C[0]) * 2u; v01 = (unsigned)(t01 * K + C[1]) * 2u; v10 = (unsigned)(t10 * K + C[0]) * 2u; v11 = (unsigned)(t11 * K + C[1]) * 2u;
        } else {
            v00 = (unsigned)((u.arow + R[0]) * K + C[0]) * 2u; v01 = (unsigned)((u.arow + R[1]) * K + C[1]) * 2u;
            v10 = (unsigned)((u.arow + 128 + R[0]) * K + C[0]) * 2u; v11 = (unsigned)((u.arow + 128 + R[1]) * K + C[1]) * 2u;
        }
    }
};

struct EpiConvIn {
    static constexpr bool PERM = true; bf16* GB; bf16* U;
    __device__ __forceinline__ void operator()(const f32x4 (&acc)[2][2][4][2], const Unit& u, int wr, int wc, int fr, int fq) const {
        const int row0 = u.p0 * 256 + wr * 64 + fr;
        if (u.p1 < 4) {
            const int col0 = u.p1 * 256 + wc * 32 + 8 * fq;
#pragma unroll
            for (int ai = 0; ai < 2; ++ai)
#pragma unroll
                for (int m = 0; m < 4; ++m) { bf16* rowp = GB + (size_t)(row0 + ai * 128 + m * 16) * D + col0;
#pragma unroll
                    for (int bj = 0; bj < 2; ++bj) { const f32x4 v0 = acc[ai][bj][m][0], v1 = acc[ai][bj][m][1];
                        v4u w; w.x = cvt_pk_bf16(v0[0], v0[1]); w.y = cvt_pk_bf16(v0[2], v0[3]); w.z = cvt_pk_bf16(v1[0], v1[1]); w.w = cvt_pk_bf16(v1[2], v1[3]);
                        *(v4u*)(rowp + bj * 128) = w; } }
        } else {
            const int col0 = (u.p1 - 4) * 128 + wc * 32 + 8 * fq;
#pragma unroll
            for (int ai = 0; ai < 2; ++ai)
#pragma unroll
                for (int m = 0; m < 4; ++m) { const f32x4 v0 = acc[ai][0][m][0] * acc[ai][1][m][0], v1 = acc[ai][0][m][1] * acc[ai][1][m][1];
                    v4u w; w.x = cvt_pk_bf16(v0[0], v0[1]); w.y = cvt_pk_bf16(v0[2], v0[3]); w.z = cvt_pk_bf16(v1[0], v1[1]); w.w = cvt_pk_bf16(v1[2], v1[3]);
                    *(v4u*)(U + (size_t)(row0 + ai * 128 + m * 16) * D + col0) = w; }
        }
    }
};
template <bool RES_BF16> struct EpiResZ {
    static constexpr bool PERM = false; const void* res; float* Z;
    __device__ __forceinline__ void operator()(const f32x4 (&acc)[2][2][4][2], const Unit& u, int wr, int wc, int fr, int fq) const {
        const int row0 = u.p0 * 256 + wr * 64 + fr, col0 = u.p1 * 256 + wc * 32 + 4 * fq;
#pragma unroll
        for (int ai = 0; ai < 2; ++ai)
#pragma unroll
            for (int m = 0; m < 4; ++m) { const size_t off = (size_t)(row0 + ai * 128 + m * 16) * D + col0;
#pragma unroll
                for (int bj = 0; bj < 2; ++bj)
#pragma unroll
                    for (int n = 0; n < 2; ++n) { const size_t o = off + bj * 128 + n * 16; f32x4 r;
                        if (RES_BF16) { const v2u w = *(const v2u*)((const bf16*)res + o); r = (f32x4){bflo(w.x), bfhi(w.x), bflo(w.y), bfhi(w.y)}; }
                        else r = *(const f32x4*)((const float*)res + o);
                        *(f32x4*)(Z + o) = r * ALPHA + acc[ai][bj][m][n]; } }
    }
};
struct EpiUp {
    static constexpr bool PERM = true; bf16* ACT;
    __device__ __forceinline__ void operator()(const f32x4 (&acc)[2][2][4][2], const Unit& u, int wr, int wc, int fr, int fq) const {
        const int row0 = u.p0 + wr * 64 + fr, col0 = u.p1 * 128 + wc * 32 + 8 * fq;
#pragma unroll
        for (int ai = 0; ai < 2; ++ai)
#pragma unroll
            for (int m = 0; m < 4; ++m) { f32x4 v[2];
#pragma unroll
                for (int n = 0; n < 2; ++n) { const f32x4 g = acc[ai][0][m][n], uu = acc[ai][1][m][n];
#pragma unroll
                    for (int j = 0; j < 4; ++j) { const float e = __builtin_amdgcn_exp2f(g[j] * -1.4426950408889634f); v[n][j] = g[j] * __builtin_amdgcn_rcpf(1.0f + e) * uu[j]; } }
                v4u w; w.x = cvt_pk_bf16(v[0][0], v[0][1]); w.y = cvt_pk_bf16(v[0][2], v[0][3]); w.z = cvt_pk_bf16(v[1][0], v[1][1]); w.w = cvt_pk_bf16(v[1][2], v[1][3]);
                *(v4u*)(ACT + (size_t)(row0 + ai * 128 + m * 16) * DE + col0) = w; }
    }
};
struct EpiDown {
    static constexpr bool PERM = true; bf16* YP; const int* perm; const float* gate;
    __device__ __forceinline__ void operator()(const f32x4 (&acc)[2][2][4][2], const Unit& u, int wr, int wc, int fr, int fq) const {
        const int col0 = u.p1 * 256 + wc * 32 + 8 * fq;
#pragma unroll
        for (int ai = 0; ai < 2; ++ai)
#pragma unroll
            for (int m = 0; m < 4; ++m) { const int r = ai * 128 + wr * 64 + m * 16 + fr;
                if (r < u.p2) { const int pair = perm[u.p0 + r]; const float g = gate[pair]; bf16* rowp = YP + (size_t)pair * D + col0;
#pragma unroll
                    for (int bj = 0; bj < 2; ++bj) { const f32x4 v0 = acc[ai][bj][m][0] * g, v1 = acc[ai][bj][m][1] * g;
                        v4u w; w.x = cvt_pk_bf16(v0[0], v0[1]); w.y = cvt_pk_bf16(v0[2], v0[3]); w.z = cvt_pk_bf16(v1[0], v1[1]); w.w = cvt_pk_bf16(v1[2], v1[3]);
                        *(v4u*)(rowp + bj * 128) = w; } } }
    }
};
struct EpiKVQ {
    static constexpr bool PERM = true; bf16* KB;
    __device__ __forceinline__ void operator()(const f32x4 (&acc)[2][2][4][2], const Unit& u, int wr, int wc, int fr, int fq) const {
        const int t = u.p1 >> 2; const float sc = t == 2 ? QSCALE : 1.0f;
        bf16* base = KB + (size_t)t * (32 * MiB / 2);
        const int row0 = u.p0 * 256 + wr * 64 + fr, col0 = (u.p1 & 3) * 256 + wc * 32 + 8 * fq;
#pragma unroll
        for (int ai = 0; ai < 2; ++ai)
#pragma unroll
            for (int m = 0; m < 4; ++m) { bf16* rowp = base + (size_t)(row0 + ai * 128 + m * 16) * D + col0;
#pragma unroll
                for (int bj = 0; bj < 2; ++bj) { const f32x4 v0 = acc[ai][bj][m][0] * sc, v1 = acc[ai][bj][m][1] * sc;
                    v4u w; w.x = cvt_pk_bf16(v0[0], v0[1]); w.y = cvt_pk_bf16(v0[2], v0[3]); w.z = cvt_pk_bf16(v1[0], v1[1]); w.w = cvt_pk_bf16(v1[2], v1[3]);
                    *(v4u*)(rowp + bj * 128) = w; } }
    }
};

__device__ __forceinline__ void ln_rows(f32x4 (&v)[4], const f32x4 (&gg)[4], const f32x4 (&bb)[4]) {
    float s = 0.f;
#pragma unroll
    for (int j = 0; j < 4; ++j) s += (v[j].x + v[j].y) + (v[j].z + v[j].w);
    const float mean = dpp_sum1(s) * (1.f / D); float s2 = 0.f;
#pragma unroll
    for (int j = 0; j < 4; ++j) { v[j] = v[j] - mean; s2 += (v[j].x * v[j].x + v[j].y * v[j].y) + (v[j].z * v[j].z + v[j].w * v[j].w); }
    const float rstd = 1.f / sqrtf(dpp_sum1(s2) * (1.f / D) + LN_EPS);
#pragma unroll
    for (int j = 0; j < 4; ++j) v[j] = v[j] * rstd * gg[j] + bb[j];
}
__device__ __forceinline__ float dot_lds(const f32x4 (&v)[4], const LAS f32x4* w, int lane) {
    float a = 0.f;
#pragma unroll
    for (int j = 0; j < 4; ++j) { const f32x4 ww = w[64 * j + lane]; a += (v[j].x * ww.x + v[j].y * ww.y) + (v[j].z * ww.z + v[j].w * ww.w); }
    return a;
}
__device__ __forceinline__ void ln_router_phase(LAS unsigned char* lds, int layer, int rep = 0) {
    const ArgsP a = kargs(); const Ctx cx = mkctx(a); const int gw = cx.gw, NGW = cx.NGW, lane = cx.lane;
    unsigned char* ws = cx.ws;
    const float* Z = (const float*)(ws + LZ(layer)); bf16* Xb = (bf16*)(ws + (layer == 0 ? WS_X1B : WS_X3B));
    const float* g = a->ln1_g + layer * D; const float* b = a->ln1_b + layer * D;
    const float* rgb = a->rg_b + layer * NG; const float* reb = a->re_b + layer * NE;
    int* cnt = (int*)(ws + WS_CTL) + layer * NE * CNT_STRIDE; int* perm = (int*)(ws + LPERM(layer)); float* gate = (float*)(ws + LGATE(layer));
    LAS f32x4* wl = (LAS f32x4*)lds;
    { const f32x4* wg = (const f32x4*)((const float*)(ws + WS_RWT) + (size_t)layer * NRW * D);
      for (int i = cx.tid; i < NRW * D / 4; i += NTHREADS) wl[i] = wg[i]; }
    f32x4 gg[4], bb[4];
#pragma unroll
    for (int j = 0; j < 4; ++j) { gg[j] = *(const f32x4*)(g + 256 * j + 4 * lane); bb[j] = *(const f32x4*)(b + 256 * j + 4 * lane); }
    f32x4 nv[4];
    if (gw < T) {
#pragma unroll
        for (int j = 0; j < 4; ++j) nv[j] = *(const f32x4*)(Z + (size_t)gw * D + 256 * j + 4 * lane);
    }
    constexpr int RPW = 16;
    LAS int* rt_row = (LAS int*)(lds + MISC_OFF + 2048);
    LAS int* rt_e = rt_row + NWAVES * RPW;
    LAS float* rt_g = (LAS float*)(rt_e + 2 * NWAVES * RPW);
    LAS int* rt_base = (LAS int*)(rt_g + 2 * NWAVES * RPW);
    LAS int* wave_rows = rt_base + NE;
    __syncthreads();
    int it = 0;
#pragma unroll 1
    for (int row = gw; row < T && it < RPW; row += NGW, ++it) {
        f32x4 v[4];
#pragma unroll
        for (int j = 0; j < 4; ++j) v[j] = nv[j];
        if (row + NGW < T) {
#pragma unroll
            for (int j = 0; j < 4; ++j) nv[j] = *(const f32x4*)(Z + (size_t)(row + NGW) * D + 256 * j + 4 * lane);
        }
        ln_rows(v, gg, bb);
#pragma unroll
        for (int j = 0; j < 4; ++j) { v2u w; w.x = pk2(v[j].x, v[j].y); w.y = pk2(v[j].z, v[j].w); *(v2u*)(Xb + (size_t)row * D + 256 * j + 4 * lane) = w; }
        float gl[NG];
#pragma unroll
        for (int n = 0; n < NG; ++n) gl[n] = dot_lds(v, wl + n * (D / 4), lane);
        dpp_sum(gl);
        int gi = 0; float gm = -INFINITY;
#pragma unroll
        for (int n = 0; n < NG; ++n) { gl[n] += rgb[n]; if (gl[n] > gm) { gm = gl[n]; gi = n; } }
        float gs = 0.f;
#pragma unroll
        for (int n = 0; n < NG; ++n) gs += __expf(gl[n] - gm);
        const float gtop = 1.0f / gs;
        float el[EPG];
#pragma unroll
        for (int n = 0; n < EPG; ++n) el[n] = dot_lds(v, wl + (NG + gi * EPG + n) * (D / 4), lane);
        dpp_sum(el);
        float m0 = -INFINITY, m1 = -INFINITY; int i0 = 0, i1 = 0;
#pragma unroll
        for (int n = 0; n < EPG; ++n) { const float e = el[n] + reb[gi * EPG + n];
            if (e > m0) { m1 = m0; i1 = i0; m0 = e; i0 = n; } else if (e > m1) { m1 = e; i1 = n; } }
        const float e1 = __expf(m1 - m0), w0 = 1.0f / (1.0f + e1), w1 = e1 * w0;
        if (lane == 0) {
            const int li = cx.wave * RPW + it;
            rt_row[li] = row; rt_e[2 * li] = gi * EPG + i0; rt_e[2 * li + 1] = gi * EPG + i1; rt_g[2 * li] = gtop * w0; rt_g[2 * li + 1] = gtop * w1;
        }
    }
    if (lane == 0) wave_rows[cx.wave] = it;
    __syncthreads();
    if (rep == 0) {
        if (cx.tid < NE) { int c = 0;
            for (int w = 0; w < NWAVES; ++w) { const int n = wave_rows[w]; for (int i = 0; i < 2 * n; ++i) c += (rt_e[2 * (w * RPW) + i] == cx.tid) ? 1 : 0; }
            rt_base[cx.tid] = c ? atomicAdd(&cnt[cx.tid * CNT_STRIDE], c) : 0; }
        __syncthreads();
        if (cx.tid < 2 * NWAVES * RPW) { const int w = cx.tid / (2 * RPW), i = cx.tid % (2 * RPW);
            if (i < 2 * wave_rows[w]) { const int e = rt_e[cx.tid]; int rank = 0;
                for (int w2 = 0; w2 <= w; ++w2) { const int lim = (w2 < w) ? 2 * wave_rows[w2] : i; for (int q = 0; q < lim; ++q) rank += (rt_e[2 * (w2 * RPW) + q] == e) ? 1 : 0; }
                const int pair = 2 * rt_row[cx.tid >> 1] + (cx.tid & 1);
                perm[e * CAP + rt_base[e] + rank] = pair; gate[pair] = rt_g[cx.tid]; } }
    }
}
__device__ __forceinline__ void ln2_phase(int layer) {
    const ArgsP a = kargs(); const Ctx cx = mkctx(a); const int gw = cx.gw, NGW = cx.NGW, lane = cx.lane;
    unsigned char* ws = cx.ws;
    const bf16* Xin = (const bf16*)(ws + (layer == 0 ? WS_X1B : WS_X3B)); const bf16* YP = (const bf16*)(ws + LYP(layer));
    const float* g = a->ln2_g + layer * D; const float* b = a->ln2_b + layer * D;
    f32x4 gg[4], bb[4];
#pragma unroll
    for (int j = 0; j < 4; ++j) { gg[j] = *(const f32x4*)(g + 256 * j + 4 * lane); bb[j] = *(const f32x4*)(b + 256 * j + 4 * lane); }
    v2u nx[4], ny0[4], ny1[4];
    if (gw < T) {
#pragma unroll
        for (int j = 0; j < 4; ++j) { const size_t c = 256 * j + 4 * lane;
            nx[j] = *(const v2u*)(Xin + (size_t)gw * D + c); ny0[j] = *(const v2u*)(YP + (size_t)(2 * gw) * D + c); ny1[j] = *(const v2u*)(YP + (size_t)(2 * gw + 1) * D + c); }
    }
#pragma unroll 1
    for (int row = gw; row < T; row += NGW) {
        f32x4 v[4];
#pragma unroll
        for (int j = 0; j < 4; ++j) { const v2u xw = nx[j], y0 = ny0[j], y1 = ny1[j];
            v[j].x = ALPHA * bflo(xw.x) + (bflo(y0.x) + bflo(y1.x)); v[j].y = ALPHA * bfhi(xw.x) + (bfhi(y0.x) + bfhi(y1.x));
            v[j].z = ALPHA * bflo(xw.y) + (bflo(y0.y) + bflo(y1.y)); v[j].w = ALPHA * bfhi(xw.y) + (bfhi(y0.y) + bfhi(y1.y)); }
        if (row + NGW < T) { const int r2 = row + NGW;
#pragma unroll
            for (int j = 0; j < 4; ++j) { const size_t c = 256 * j + 4 * lane;
                nx[j] = *(const v2u*)(Xin + (size_t)r2 * D + c); ny0[j] = *(const v2u*)(YP + (size_t)(2 * r2) * D + c); ny1[j] = *(const v2u*)(YP + (size_t)(2 * r2 + 1) * D + c); }
        }
        ln_rows(v, gg, bb);
        if (layer == 0) {
#pragma unroll
            for (int j = 0; j < 4; ++j) { v2u w; w.x = pk2(v[j].x, v[j].y); w.y = pk2(v[j].z, v[j].w); *(v2u*)((bf16*)(ws + WS_X2B) + (size_t)row * D + 256 * j + 4 * lane) = w; }
        } else {
#pragma unroll
            for (int j = 0; j < 4; ++j) *(f32x4*)(a->out + (size_t)row * D + 256 * j + 4 * lane) = v[j];
        }
    }
}
__device__ __forceinline__ void conv_phase() {
    const ArgsP a = kargs(); const Ctx cx = mkctx(a); const int gtid = cx.bx * NTHREADS + cx.tid, NGT = cx.G * NTHREADS;
    unsigned char* ws = cx.ws;
    const bf16* GB = (const bf16*)(ws + WS_GB); const bf16* U = (const bf16*)(ws + WS_U); bf16* A2 = (bf16*)(ws + WS_A2);
    for (int it = gtid; it < T * (D / 8); it += NGT) {
        const int t = it >> 7, d0 = (it & 127) * 8, s = t & (SEQ - 1);
        const size_t o = (size_t)t * D + d0;
        const v4u g = *(const v4u*)(GB + o), u0 = *(const v4u*)(U + o);
        v4u u1 = (v4u){0u, 0u, 0u, 0u}, u2 = u1;
        if (s >= 1) u1 = *(const v4u*)(U + o - D);
        if (s >= 2) u2 = *(const v4u*)(U + o - 2 * D);
        v4u r;
#pragma unroll
        for (int q = 0; q < 4; ++q) {
            const int d = d0 + 2 * q;
            const float c0 = a->a_conv_w[d] * bflo(u2[q]) + a->a_conv_w[D + d] * bflo(u1[q]) + a->a_conv_w[2 * D + d] * bflo(u0[q]);
            const float c1 = a->a_conv_w[d + 1] * bfhi(u2[q]) + a->a_conv_w[D + d + 1] * bfhi(u1[q]) + a->a_conv_w[2 * D + d + 1] * bfhi(u0[q]);
            r[q] = pk2(bflo(g[q]) * c0, bfhi(g[q]) * c1);
        }
        *(v4u*)(A2 + o) = r;
    }
}
__device__ __forceinline__ void combine_phase() {
    const ArgsP a = kargs(); const Ctx cx = mkctx(a); const int gw = cx.gw, NGW = cx.NGW, lane = cx.lane;
    unsigned char* ws = cx.ws;
    const bf16* O0 = (const bf16*)(ws + WS_O0); const bf16* O1 = (const bf16*)(ws + WS_O1); bf16* A3 = (bf16*)(ws + WS_A3);
    const float l01 = wave_sum(a->b_lambda[lane] * a->b_lambda[64 + lane]), l23 = wave_sum(a->b_lambda[128 + lane] * a->b_lambda[192 + lane]);
    const float lam = __expf(l01) - __expf(l23) + LAM_INIT;
    float gsc[16];
#pragma unroll
    for (int i = 0; i < 16; ++i) gsc[i] = a->b_subln_g[(lane & 7) * 16 + i] * (1.0f - LAM_INIT);
    for (int row = gw; row < T; row += NGW) {
        const size_t o = (size_t)row * D + lane * 16;
        const v4u p0 = *(const v4u*)(O0 + o), p1 = *(const v4u*)(O0 + o + 8), q0 = *(const v4u*)(O1 + o), q1 = *(const v4u*)(O1 + o + 8);
        float d[16]; float ss = 0.f;
#pragma unroll
        for (int i = 0; i < 4; ++i) { d[2 * i] = bflo(p0[i]) - lam * bflo(q0[i]); d[2 * i + 1] = bfhi(p0[i]) - lam * bfhi(q0[i]);
            d[8 + 2 * i] = bflo(p1[i]) - lam * bflo(q1[i]); d[8 + 2 * i + 1] = bfhi(p1[i]) - lam * bfhi(q1[i]); }
#pragma unroll
        for (int i = 0; i < 16; ++i) ss += d[i] * d[i];
        ss += __shfl_xor(ss, 1); ss += __shfl_xor(ss, 2); ss += __shfl_xor(ss, 4);
        const float r = 1.0f / sqrtf(ss * (1.0f / 128.0f) + RMS_EPS);
        v4u w0, w1;
#pragma unroll
        for (int i = 0; i < 4; ++i) { w0[i] = pk2(d[2 * i] * r * gsc[2 * i], d[2 * i + 1] * r * gsc[2 * i + 1]); w1[i] = pk2(d[8 + 2 * i] * r * gsc[8 + 2 * i], d[8 + 2 * i + 1] * r * gsc[8 + 2 * i + 1]); }
        *(v4u*)(A3 + o) = w0; *(v4u*)(A3 + o + 8) = w1;
    }
}

#ifndef MKMASK
#define MKMASK 0xffff
#endif
#ifndef MKREP
#define MKREP 0
#endif
#ifndef MKSYNC
#define MKSYNC 0
#endif
#ifndef MKMASK2
#define MKMASK2 MKMASK
#endif
#define PH(k) _Pragma("unroll 1") for (int rep_ = 0; rep_ < (int)(((pass_ ? MKMASK2 : MKMASK) >> (k)) & 1) + (int)((MKREP >> (k)) & 1); ++rep_)
#define XB_TMO      128
#define XB_XCNT(j)  (256  + 64 * (j))
#define XB_XSUB(j)  (1280 + 64 * (j))
#define XB_XGEN(j)  (2304 + 64 * (j))
#define XB_TOP      3328
#define XB_TOPGEN   3392
#define XCD_BAR_WORDS 3456
#define XB_SPIN_CAP (1u << 18)

__device__ __forceinline__ unsigned xb_ld(unsigned* p)              { return __hip_atomic_load(p, __ATOMIC_RELAXED, __HIP_MEMORY_SCOPE_AGENT); }
__device__ __forceinline__ unsigned xb_add(unsigned* p, unsigned v) { return __hip_atomic_fetch_add(p, v, __ATOMIC_RELAXED, __HIP_MEMORY_SCOPE_AGENT); }
__device__ __forceinline__ unsigned xb_xcc_id() { return (unsigned)__builtin_amdgcn_s_getreg((3 << 11) | 20) & 0xFu; }
#define XB_SPIN(cond, bar) do { unsigned _sp = 0; while (cond) { __builtin_amdgcn_s_sleep(1); \
    if ((++_sp & 255u) == 0u) { if (xb_ld(&(bar)[XB_TMO])) break; if (_sp > XB_SPIN_CAP) { atomicAdd(&(bar)[XB_TMO], 1u); break; } } } } while (0)

struct XcdBarrier {
    unsigned* bar; unsigned x;
    volatile LAS unsigned* st;
};

__device__ __forceinline__ XcdBarrier xcd_barrier_post(unsigned* bar, volatile LAS unsigned* st) {
    XcdBarrier b; b.bar = bar; b.x = xb_xcc_id(); b.st = st;
    if (threadIdx.x == 0) (void)xb_add(&bar[XB_XCNT(b.x)], 1u);
    return b;
}
__device__ __forceinline__ void xcd_barrier_complete(unsigned* bar, unsigned x, unsigned& nloc, unsigned& nx) {
    const unsigned G = gridDim.x * gridDim.y * gridDim.z;
    unsigned sum, cnt, mine, sp = 0u;
    for (;;) {
        sum = 0u; cnt = 0u; mine = 0u;
#pragma unroll
        for (unsigned j = 0; j < 16; ++j) { const unsigned c = xb_ld(&bar[XB_XCNT(j)]); sum += c; cnt += (c > 0u) ? 1u : 0u; mine = (j == x) ? c : mine; }
        if (sum == G) break;
        __builtin_amdgcn_s_sleep(1);
        if ((++sp & 255u) == 0u) { if (xb_ld(&bar[XB_TMO])) break; if (sp > XB_SPIN_CAP) { atomicAdd(&bar[XB_TMO], 1u); break; } }
    }
    nloc = mine > 0u ? mine : 1u; nx = cnt > 0u ? cnt : 1u;
}

__device__ __forceinline__ void xcd_barrier(const XcdBarrier& b) {
    asm volatile("s_waitcnt vmcnt(0)" ::: "memory");
    __syncthreads();
    if (threadIdx.x == 0) {
        unsigned* bar = b.bar;
        __builtin_amdgcn_s_waitcnt(0);
        unsigned nloc = b.st[0], nx = b.st[1];
        if (nloc == 0u) { xcd_barrier_complete(bar, b.x, nloc, nx); b.st[0] = nloc; b.st[1] = nx; }
        const unsigned old = xb_add(&bar[XB_XSUB(b.x)], 1u);
        const unsigned gen = old / nloc;
        if (old + 1u == (gen + 1u) * nloc) {
            __builtin_amdgcn_fence(__ATOMIC_RELEASE, "agent");
            asm volatile("s_waitcnt vmcnt(0)" ::: "memory");
            const unsigned og = xb_add(&bar[XB_TOP], 1u);
            const unsigned tg = og / nx;
            if (og + 1u == (tg + 1u) * nx) xb_add(&bar[XB_TOPGEN], 1u);
            else XB_SPIN(xb_ld(&bar[XB_TOPGEN]) == tg, bar);
            __builtin_amdgcn_fence(__ATOMIC_ACQUIRE, "agent");
            xb_add(&bar[XB_XGEN(b.x)], 1u);
            asm volatile("s_waitcnt vmcnt(0)" ::: "memory");
        } else {
            XB_SPIN(xb_ld(&bar[XB_XGEN(b.x)]) == gen, bar);
            __builtin_amdgcn_fence(__ATOMIC_ACQUIRE, "agent");
            asm volatile("s_waitcnt vmcnt(0)" ::: "memory");
        }
    }
    __syncthreads();
}

constexpr int CW_BAR = 8192;
constexpr int ST_OFF = MISC_OFF + 1024;
__device__ __forceinline__ void seam(LAS unsigned char* lds) { const ArgsP a = kargs(); XcdBarrier b; b.bar = (unsigned*)(a->ws + WS_CTL) + CW_BAR; b.x = xb_xcc_id(); b.st = (volatile LAS unsigned*)(lds + ST_OFF); xcd_barrier(b); }
__device__ __forceinline__ void gemm1_phase(LAS unsigned char* lds) { const ArgsP a = kargs(); const Ctx cx = mkctx(a); unsigned char* ws = cx.ws;
    SchedDense S{cx.G, cx.bx, 12, 0, D, (const char*)(ws + WS_W1T)}; EpiConvIn E{(bf16*)(ws + WS_GB), (bf16*)(ws + WS_U)};
    pg8::gemm_phase(lds, (const char*)(ws + WS_XB), D, S, E); }
__device__ __forceinline__ void gemm2_phase(LAS unsigned char* lds) { const ArgsP a = kargs(); const Ctx cx = mkctx(a); unsigned char* ws = cx.ws;
    SchedDense S{cx.G, cx.bx, 4, 1, D, (const char*)(ws + WS_W2T)}; EpiResZ<false> E{(const void*)a->x, (float*)(ws + LZ(0))};
    pg8::gemm_phase(lds, (const char*)(ws + WS_A2), D, S, E); }
__device__ __forceinline__ void kvq_phase(LAS unsigned char* lds) { const ArgsP a = kargs(); const Ctx cx = mkctx(a); unsigned char* ws = cx.ws;
    SchedDense S{cx.G, cx.bx, 12, 1, D, (const char*)(ws + WS_WKVQ)}; EpiKVQ E{(bf16*)(ws + WS_K)};
    pg8::gemm_phase(lds, (const char*)(ws + WS_X2B), D, S, E); }
__device__ __forceinline__ void wo_phase(LAS unsigned char* lds) { const ArgsP a = kargs(); const Ctx cx = mkctx(a); unsigned char* ws = cx.ws;
    SchedDense S{cx.G, cx.bx, 4, 1, D, (const char*)(ws + WS_WOT)}; EpiResZ<true> E{(const void*)(ws + WS_X2B), (float*)(ws + LZ(1))};
    pg8::gemm_phase(lds, (const char*)(ws + WS_A3), D, S, E); }
__device__ __forceinline__ void attn_phase(char* lds_generic) { const ArgsP a = kargs(); const Ctx cx = mkctx(a); unsigned char* ws = cx.ws;
#pragma unroll 1
    for (int uix = cx.bx; uix < BATCH * NH * 4 * (SEQ / 256); uix += cx.G) {
        const int combo = uix & 255, qi = uix >> 8;
        const int b = combo >> 5, h = (combo >> 2) & 7, c = (combo >> 1) & 1, vh = combo & 1;
        const int qb = (qi & 1) ? (SEQ / 256 - 1 - (qi >> 1)) : (qi >> 1);
        const attn_body::bf16* QK = (const attn_body::bf16*)(ws + WS_K) + h * 128 + c * 64;
        const attn_body::bf16* Vc = (const attn_body::bf16*)(ws + WS_V) + h * 128 + vh * 64;
        attn_body::bf16* Oc = (attn_body::bf16*)(ws + (c ? WS_O1 : WS_O0)) + h * 128 + vh * 64;
        attn_body::attn_unit<8>((long)b * SEQ, qb, QK + (WS_Q - WS_K) / 2, QK, Vc, Oc, lds_generic);
    }
}
__device__ __forceinline__ void moe_tables(LAS unsigned char* lds, int layer) { const ArgsP a = kargs(); const Ctx cx = mkctx(a); LAS int* misc = (LAS int*)(lds + MISC_OFF);
    const int* cnt = (const int*)(cx.ws + WS_CTL) + layer * NE * CNT_STRIDE;
    if (cx.tid < NE) misc[128 + cx.tid] = __hip_atomic_load(cnt + cx.tid * CNT_STRIDE, __ATOMIC_RELAXED, __HIP_MEMORY_SCOPE_AGENT);
    __syncthreads();
    if (cx.tid == 0) { int ub = 0, ps = 0; for (int e = 0; e < NE; ++e) { misc[e] = ub; misc[64 + e] = ps; const int rt = (misc[128 + e] + 255) >> 8; ub += 4 * rt; ps += 256 * rt; } misc[NE] = ub; misc[64 + NE] = ps; }
    __syncthreads(); }
__device__ __forceinline__ void moe_up_phase(LAS unsigned char* lds, int layer) { const ArgsP a = kargs(); const Ctx cx = mkctx(a); unsigned char* ws = cx.ws; LAS int* misc = (LAS int*)(lds + MISC_OFF);
    const MoeTab tb{misc, misc + 64, misc + 128};
    SchedMoe S{cx.G, cx.bx, D, true, (const char*)(ws + WS_WUT) + (size_t)layer * NE * D * D * 2, (const int*)(ws + LPERM(layer)), tb}; EpiUp E{(bf16*)(ws + LACT(layer))};
    pg8::gemm_phase(lds, (const char*)(ws + (layer == 0 ? WS_X1B : WS_X3B)), D, S, E); }
__device__ __forceinline__ void moe_down_phase(LAS unsigned char* lds, int layer) { const ArgsP a = kargs(); const Ctx cx = mkctx(a); unsigned char* ws = cx.ws; LAS int* misc = (LAS int*)(lds + MISC_OFF);
    const MoeTab tb{misc, misc + 64, misc + 128};
    SchedMoe S{cx.G, cx.bx, DE, false, (const char*)(ws + WS_WDT) + (size_t)layer * NE * D * DE * 2, (const int*)(ws + LPERM(layer)), tb};
    EpiDown E{(bf16*)(ws + LYP(layer)), (const int*)(ws + LPERM(layer)), (const float*)(ws + LGATE(layer))};
    pg8::gemm_phase(lds, (const char*)(ws + LACT(layer)), DE, S, E); }

__global__ void __launch_bounds__(NTHREADS, 2) fwd_megakernel(Args args_unused) {
    extern __shared__ __attribute__((aligned(16))) unsigned char lds_raw[];
#ifdef NOSYNC
    struct { __device__ void sync() const {} } grid;
#else
    cg::grid_group grid = cg::this_grid();
#endif
#define SEAM() seam(lds)
    LAS unsigned char* lds = (LAS unsigned char*)lds_raw;
#ifndef MKPASS
#define MKPASS 1
#endif
    { const ArgsP a = kargs(); int t = threadIdx.x; asm volatile("" : "+v"(t));
      if (t < 2) ((volatile LAS unsigned*)(lds + ST_OFF))[t] = 0u;
      if (blockIdx.x == 0) { unsigned* ctl = (unsigned*)(a->ws + WS_CTL); for (int i = t; i < CW_BAR + XCD_BAR_WORDS; i += NTHREADS) ctl[i] = 0u; } }
    __syncthreads();
#pragma unroll 1
    for (int pass_ = 0; pass_ < MKPASS; ++pass_) {
    if (pass_) SEAM();
    PH(0) p0_prologue(lds);
    if (pass_ == 0) { grid.sync();
      const ArgsP a = kargs(); (void)xcd_barrier_post((unsigned*)(a->ws + WS_CTL) + CW_BAR, (volatile LAS unsigned*)(lds + ST_OFF)); }
    else SEAM();
    PH(1) gemm1_phase(lds);
    SEAM();
    PH(2) conv_phase();
    SEAM();
    PH(3) gemm2_phase(lds);
    SEAM();
    PH(8) ln_router_phase(lds, 0, rep_ + pass_);
    SEAM();
    moe_tables(lds, 0);
    PH(9) { moe_up_phase(lds, 0); if (P0B_FILL && pass_ == 0) p0b_idle_fill(lds, 0, P0B_SPLIT); }
    SEAM();
    PH(10) { moe_down_phase(lds, 0); if (P0B_FILL && pass_ == 0) p0b_idle_fill(lds, P0B_SPLIT, P0B_ITEMS); }
    SEAM();
    PH(11) ln2_phase(0);
    SEAM();
    PH(4) kvq_phase(lds);
    SEAM();
    PH(5) attn_phase((char*)lds_raw);
    SEAM();
    PH(6) combine_phase();
    SEAM();
    PH(7) wo_phase(lds);
    SEAM();
    PH(8) ln_router_phase(lds, 1, rep_ + pass_);
    SEAM();
    moe_tables(lds, 1);
    PH(9) moe_up_phase(lds, 1);
    SEAM();
    PH(10) moe_down_phase(lds, 1);
    SEAM();
    PH(11) ln2_phase(1);
    }
#pragma unroll 1
    for (int i = 0; i < MKSYNC; ++i) SEAM();
}
}

extern "C" void kernel_launch(void* const* d_in, const int* in_sizes, int n_in, void* d_out, int out_size, void* d_ws, size_t ws_size, hipStream_t stream) {
    using namespace mk;
    static int grid = 0;
    if (grid == 0) {
        if (n_in != 19 || out_size != T * D || ws_size < WS_END) { fprintf(stderr, "kernel_launch: unexpected shapes / workspace (n_in %d out %d ws %zu, need %zu)\n", n_in, out_size, ws_size, (size_t)WS_END); grid = -1; return; }
        int dev = 0, cus = 0, per_cu = 0;
        (void)hipGetDevice(&dev); (void)hipDeviceGetAttribute(&cus, hipDeviceAttributeMultiprocessorCount, dev);
        if (hipFuncSetAttribute((const void*)fwd_megakernel, hipFuncAttributeMaxDynamicSharedMemorySize, LDS_BYTES) != hipSuccess) { fprintf(stderr, "kernel_launch: hipFuncSetAttribute failed\n"); grid = -1; return; }
        if (hipOccupancyMaxActiveBlocksPerMultiprocessor(&per_cu, (const void*)fwd_megakernel, NTHREADS, LDS_BYTES) != hipSuccess || per_cu < 1) { fprintf(stderr, "kernel_launch: occupancy query says %d blocks per CU\n", per_cu); grid = -1; return; }
        grid = cus * 1;
        (void)hipGetLastError();
    }
    if (grid < 0) return;
    Args a{};
    a.x = (const float*)d_in[0]; a.a_w_in = (const float*)d_in[1]; a.a_conv_w = (const float*)d_in[2]; a.a_w_out = (const float*)d_in[3]; a.kv_w = (const float*)d_in[4];
    a.b_w_q = (const float*)d_in[5]; a.b_lambda = (const float*)d_in[6]; a.b_subln_g = (const float*)d_in[7]; a.b_w_o = (const float*)d_in[8];
    a.ln1_g = (const float*)d_in[9]; a.ln1_b = (const float*)d_in[10]; a.ln2_g = (const float*)d_in[11]; a.ln2_b = (const float*)d_in[12];
    a.rg_w = (const float*)d_in[13]; a.rg_b = (const float*)d_in[14]; a.re_w = (const float*)d_in[15]; a.re_b = (const float*)d_in[16];
    a.e_w_in = (const float*)d_in[17]; a.e_w_down = (const float*)d_in[18];
    a.out = (float*)d_out; a.ws = (unsigned char*)d_ws;
    void* kargs[] = {&a};
    const hipError_t e = hipLaunchCooperativeKernel((const void*)fwd_megakernel, dim3(grid), dim3(NTHREADS), kargs, LDS_BYTES, stream);
    if (e != hipSuccess) fprintf(stderr, "kernel_launch: cooperative launch failed: %s (grid %d)\n", hipGetErrorString(e), grid);
}
```

```cpp
#include <hip/hip_runtime.h>
#include <hip/hip_cooperative_groups.h>
#include <cstdio>
#include <cstdint>
namespace cg = cooperative_groups;

namespace pg8 {
#define PG8_LAS __attribute__((address_space(3)))
typedef unsigned short bf16_t;
typedef short bf16x8 __attribute__((ext_vector_type(8)));
typedef float f32x4 __attribute__((ext_vector_type(4)));
typedef unsigned u32x4 __attribute__((ext_vector_type(4)));
typedef unsigned u32x2 __attribute__((ext_vector_type(2)));
constexpr int BM = 256, BK = 64, HALF = 128, HTB = HALF * BK * 2  , STAGE_BYTES = 8 * HTB, NXCD = 8, WGM = 8;

__host__ __device__ __forceinline__ int lds_byte(int r, int c) { const int st = (r >> 4) * 2 + (c >> 5), rr = r & 15, cc = c & 31, ob = rr * 64 + cc * 2; return st * 1024 + (ob ^ (((ob >> 9) & 1) << 5)); }
__host__ __device__ __forceinline__ void stage_rc(int b, int& R, int& C) { const int st = b / 1024, sb = b % 1024, swz = sb ^ (((sb >> 9) & 1) << 5); R = (st >> 1) * 16 + swz / 64; C = (st & 1) * 32 + (swz % 64) / 2; }
__host__ __device__ __forceinline__ int perm32(int rho) { const int n = rho >> 4, i = rho & 15; return 8 * (i >> 2) + 4 * n + (i & 3); }

struct Unit { const char* b0; const char* b1; int arow; int p0, p1, p2; };

__device__ __forceinline__ bool static_tile(int i, int G, int c, int nM, int nN, int& pm, int& pn) {
    const int nwg = nM * nN; const long L = (long)i * G + c; if (L >= nwg) return false;
    int wgid = (int)L; { const int q = nwg / NXCD, r = nwg % NXCD, xcd = wgid % NXCD, off = wgid / NXCD; wgid = (xcd < r ? xcd * (q + 1) : r * (q + 1) + (xcd - r) * q) + off; }
    const int nig = WGM * nN, gid = wgid / nig, fm = gid * WGM, gsz = (nM - fm) < WGM ? (nM - fm) : WGM;
    pm = fm + ((wgid % nig) % gsz); pn = (wgid % nig) / gsz; return true;
}

__device__ __forceinline__ unsigned cvt_pk_bf16(float lo, float hi) { unsigned r; asm volatile("v_cvt_pk_bf16_f32 %0, %1, %2" : "=v"(r) : "v"(lo), "v"(hi)); return r; }

template <class Epi, class Sched>
__device__ __forceinline__ void gemm_phase(PG8_LAS unsigned char* lds, const char* Abase, const int K, const Sched& S, const Epi& E) {
    int tid_ = threadIdx.x; asm volatile("" : "+v"(tid_));
    const int tid = tid_, wid = __builtin_amdgcn_readfirstlane(tid >> 6), lane = tid & 63, wr = wid >> 2, wc = wid & 3, fr = lane & 15, fq = lane >> 4;
    const int nt = K / BK;
    int R[2], C[2]; unsigned voffB[2];
#pragma unroll
    for (int i = 0; i < 2; ++i) { stage_rc(tid * 16 + i * 8192, R[i], C[i]); const int Rb = Epi::PERM ? ((R[i] & ~31) + perm32(R[i] & 31)) : R[i]; voffB[i] = (unsigned)(Rb * K + C[i]) * 2u; }
    const size_t kstep = (size_t)(BK * 2);
    const unsigned ldsw = (unsigned)wid * 1024u;
    const int aoff = lds_byte(wr * 64 + fr, fq * 8), boff = lds_byte(wc * 32 + fr, fq * 8);
#define PG8_SA(b, h) (((b) * 2 + (h)) * HTB)
#define PG8_SB(b, h) ((4 + (b) * 2 + (h)) * HTB)
#define PG8_STAGE(bufoff, gbase, v0, v1) do { \
        __builtin_amdgcn_global_load_lds((const unsigned*)((const char*)(gbase) + (v0)), (PG8_LAS unsigned*)(lds + (bufoff) + ldsw), 16, 0, 0); \
        __builtin_amdgcn_global_load_lds((const unsigned*)((const char*)(gbase) + (v1)), (PG8_LAS unsigned*)(lds + (bufoff) + ldsw + 8192), 16, 0, 0); } while (0)
#define PG8_STAGEB(bufoff, gbase) PG8_STAGE(bufoff, gbase, voffB[0], voffB[1])
#define PG8_LDA(dst, b, h) do { _Pragma("unroll") for (int m = 0; m < 4; ++m) _Pragma("unroll") for (int k = 0; k < 2; ++k) dst[m][k] = *(const PG8_LAS bf16x8*)(lds + PG8_SA(b, h) + aoff + m * 2048 + k * 1024); } while (0)
#define PG8_LDB(dst, b, h) do { _Pragma("unroll") for (int n = 0; n < 2; ++n) _Pragma("unroll") for (int k = 0; k < 2; ++k) dst[n][k] = *(const PG8_LAS bf16x8*)(lds + PG8_SB(b, h) + boff + n * 2048 + k * 1024); } while (0)
#define PG8_MMA(ai, bj, At, Bt) do { __builtin_amdgcn_s_setprio(1); _Pragma("unroll") for (int m = 0; m < 4; ++m) _Pragma("unroll") for (int n = 0; n < 2; ++n) _Pragma("unroll") for (int k = 0; k < 2; ++k) \
        acc[ai][bj][m][n] = __builtin_amdgcn_mfma_f32_16x16x32_bf16(Bt[n][k], At[m][k], acc[ai][bj][m][n], 0, 0, 0); __builtin_amdgcn_s_setprio(0); } while (0)
#define PG8_WAIT_V(n) asm volatile("s_waitcnt vmcnt(" #n ")" ::: "memory")
#define PG8_WAIT_L(n) asm volatile("s_waitcnt lgkmcnt(" #n ")" ::: "memory")
#define PG8_BAR __builtin_amdgcn_s_barrier()
#define PG8_SCHED __builtin_amdgcn_sched_barrier(0)
    Unit cur, nxt; int ui = 0;
    if (!S.next(0, cur)) return;
    f32x4 acc[2][2][4][2];
#pragma unroll
    for (int a = 0; a < 2; ++a)
#pragma unroll
        for (int b = 0; b < 2; ++b)
#pragma unroll
            for (int m = 0; m < 4; ++m)
#pragma unroll
                for (int n = 0; n < 2; ++n) acc[a][b][m][n] = (f32x4){0.f, 0.f, 0.f, 0.f};
    bf16x8 At[4][2], B0[2][2], B1[2][2];
    unsigned vA00, vA01, vA10, vA11, vN00, vN01, vN10, vN11;
    S.a_offs(cur, R, C, vA00, vA01, vA10, vA11);
    const char* cB0 = cur.b0; const char* cB1 = cur.b1;
    PG8_STAGEB(PG8_SB(0, 0), cB0); PG8_STAGEB(PG8_SB(0, 1), cB1); PG8_STAGE(PG8_SA(0, 0), Abase, vA00, vA01); PG8_STAGE(PG8_SA(0, 1), Abase, vA10, vA11);
    if (wr == 1) PG8_BAR;
    PG8_WAIT_V(2); PG8_BAR;
    PG8_STAGEB(PG8_SB(1, 0), cB0 + kstep); PG8_STAGE(PG8_SA(1, 0), Abase + kstep, vA00, vA01); PG8_STAGEB(PG8_SB(1, 1), cB1 + kstep);
    PG8_WAIT_V(6); PG8_BAR;
    for (;;) {
        const bool has_next = S.next(ui + 1, nxt);
        if (has_next) S.a_offs(nxt, R, C, vN00, vN01, vN10, vN11); else { vN00 = vA00; vN01 = vA01; vN10 = vA10; vN11 = vA11; }
        const char* nB0 = has_next ? nxt.b0 : cB0; const char* nB1 = has_next ? nxt.b1 : cB1;
        for (int t = 0; t < nt; t += 2) {
            const bool last = (t == nt - 2);
            const char* a1 = Abase + (size_t)(t + 1) * kstep;
            PG8_LDB(B0, 0, 0); PG8_LDB(B1, 0, 1); PG8_SCHED; PG8_LDA(At, 0, 0); PG8_STAGE(PG8_SA(1, 1), a1, vA10, vA11);
            PG8_WAIT_V(8); PG8_WAIT_L(0); PG8_BAR; PG8_MMA(0, 0, At, B0); PG8_MMA(0, 1, At, B1); PG8_BAR; PG8_SCHED;
            if (last) { vA00 = vN00; vA01 = vN01; vA10 = vN10; vA11 = vN11; }
            const char* a2 = last ? Abase : Abase + (size_t)(t + 2) * kstep;
            const char* b20 = last ? nB0 : cB0 + (size_t)(t + 2) * kstep; const char* b21 = last ? nB1 : cB1 + (size_t)(t + 2) * kstep;
            const char* a3 = a2 + kstep; const char* b30 = b20 + kstep; const char* b31 = b21 + kstep;
            PG8_LDA(At, 0, 1); PG8_STAGEB(PG8_SB(0, 0), b20); PG8_STAGEB(PG8_SB(0, 1), b21); PG8_STAGE(PG8_SA(0, 0), a2, vA00, vA01);
            PG8_WAIT_V(8); PG8_WAIT_L(0); PG8_BAR; PG8_MMA(1, 0, At, B0); PG8_MMA(1, 1, At, B1); PG8_BAR; PG8_SCHED;
            PG8_LDB(B0, 1, 0); PG8_LDB(B1, 1, 1); PG8_SCHED; PG8_LDA(At, 1, 0); PG8_STAGE(PG8_SA(0, 1), a2, vA10, vA11);
            PG8_WAIT_V(8); PG8_WAIT_L(0); PG8_BAR; PG8_MMA(0, 0, At, B0); PG8_MMA(0, 1, At, B1); PG8_BAR; PG8_SCHED;
            PG8_LDA(At, 1, 1); PG8_STAGEB(PG8_SB(1, 0), b30); PG8_STAGEB(PG8_SB(1, 1), b31); PG8_STAGE(PG8_SA(1, 0), a3, vA00, vA01);
            PG8_WAIT_V(8); PG8_WAIT_L(0); PG8_BAR; PG8_MMA(1, 0, At, B0); PG8_MMA(1, 1, At, B1); PG8_BAR; PG8_SCHED;
        }
        if (wr == 0) PG8_BAR;
        E(acc, cur, wr, wc, fr, fq);
        if (!has_next) break;
#pragma unroll
        for (int a = 0; a < 2; ++a)
#pragma unroll
            for (int b = 0; b < 2; ++b)
#pragma unroll
                for (int m = 0; m < 4; ++m)
#pragma unroll
                    for (int n = 0; n < 2; ++n) acc[a][b][m][n] = (f32x4){0.f, 0.f, 0.f, 0.f};
        cur = nxt; cB0 = nB0; cB1 = nB1; ++ui;
        if (wr == 1) PG8_BAR;
    }
    PG8_WAIT_V(0);
    PG8_BAR;
#undef PG8_SA
#undef PG8_SB
#undef PG8_STAGE
#undef PG8_STAGEB
#undef PG8_LDA
#undef PG8_LDB
#undef PG8_MMA
#undef PG8_WAIT_V
#undef PG8_WAIT_L
#undef PG8_BAR
#undef PG8_SCHED
}
}
#include <hip/hip_bf16.h>
#include <cmath>
namespace attn_body {
using bf16=__hip_bfloat16;
using bf16x8=__attribute__((ext_vector_type(8)))short;
using s16x4=__attribute__((ext_vector_type(4)))short;
using f32x16=__attribute__((ext_vector_type(16)))float;
using u32x4=__attribute__((ext_vector_type(4)))unsigned;
constexpr int D=64,DM=1024;
constexpr int NW=8,QBLK=32,QB=QBLK*NW,KVBLK=64;
constexpr int ATTN_PITCH=DM, ATTN_UNIT_ROWS=QB;
__device__ __forceinline__ int crow(int r,int hi){return (r&3)+8*(r>>2)+4*hi;}
#define SBAR() __builtin_amdgcn_sched_barrier(0)
__device__ __forceinline__ void cmask(f32x16&p0,f32x16&p1,int jb,int qrel,int hi){
  const float NEG=-INFINITY; int kb=64*jb+4*hi;
  #pragma unroll
  for(int r=0;r<16;++r){int kv=kb+(r&3)+8*(r>>2); if(kv>qrel)p0[r]=NEG; if(kv+32>qrel)p1[r]=NEG;}
}

constexpr int NSLOT=3, SLOTB=8192;
constexpr int LDS_K=0, LDS_V=NSLOT*SLOTB, LDS_WS=2*NSLOT*SLOTB, LDS_OST=LDS_WS+NW*64*4, LDS_BYTES=LDS_OST+NW*4096;
constexpr float C2=0.125f*1.4426950408889634f;
__device__ __forceinline__ void glds16(const void*gsrc,unsigned lds_dst){unsigned keep;
  asm volatile("s_mov_b32 %0, m0\n\ts_mov_b32 m0, %2\n\ts_nop 0\n\tglobal_load_lds_dwordx4 %1, off\n\ts_mov_b32 m0, %0":"=&s"(keep):"v"(gsrc),"s"(lds_dst):"memory");}
__device__ __forceinline__ void glds16s(const void*sbase,unsigned voff,unsigned lds_dst){unsigned keep;
  asm volatile("s_mov_b32 %0, m0\n\ts_mov_b32 m0, %3\n\ts_nop 4\n\tglobal_load_lds_dwordx4 %1, %2\n\ts_mov_b32 m0, %0":"=&s"(keep):"v"(voff),"s"(sbase),"s"(lds_dst):"memory");}
__device__ __forceinline__ float max3f(float a,float b,float c){float r;asm("v_max3_f32 %0, %1, %2, %3":"=v"(r):"v"(a),"v"(b),"v"(c));return r;}
__device__ __forceinline__ float max2f(float a,float b){float r;asm("v_max_f32_e32 %0, %1, %2":"=v"(r):"v"(a),"v"(b));return r;}
__device__ __forceinline__ float fadd_s(float a,float b){float r;asm("v_add_f32_e32 %0, %1, %2":"=v"(r):"v"(a),"v"(b));return r;}
__device__ __forceinline__ float fsub_s(float a,float b){float r;asm("v_sub_f32_e32 %0, %1, %2":"=v"(r):"v"(a),"v"(b));return r;}
typedef float f32x2_t __attribute__((ext_vector_type(2))); typedef __bf16 bf16x2_t __attribute__((ext_vector_type(2)));
__device__ __forceinline__ unsigned cvtpk_s(float lo,float hi){f32x2_t v={lo,hi};bf16x2_t b=__builtin_convertvector(v,bf16x2_t);return __builtin_bit_cast(unsigned,b);}
#define WAIT_BAR(N) asm volatile("s_waitcnt vmcnt(" #N ") lgkmcnt(0)\n\ts_barrier":::"memory")

__device__ __forceinline__ void qkt(f32x16&p0,f32x16&p1,const char*Kslot,const bf16x8*qr,const f32x16&negm,int r32,int hi){
  const char*kb=Kslot+hi*1024+r32*16;
  #pragma unroll
  for(int d0=0;d0<4;++d0){
    const bf16x8 b0=*reinterpret_cast<const bf16x8*>(kb+d0*2048);
    const bf16x8 b1=*reinterpret_cast<const bf16x8*>(kb+d0*2048+512);
    if(d0==0){p0=__builtin_amdgcn_mfma_f32_32x32x16_bf16(b0,qr[0],negm,0,0,0);p1=__builtin_amdgcn_mfma_f32_32x32x16_bf16(b1,qr[0],negm,0,0,0);}
    else{p0=__builtin_amdgcn_mfma_f32_32x32x16_bf16(b0,qr[d0],p0,0,0,0);p1=__builtin_amdgcn_mfma_f32_32x32x16_bf16(b1,qr[d0],p1,0,0,0);}}
}
typedef __attribute__((address_space(3))) const char* lds_cptr;
typedef short v4i16_t __attribute__((ext_vector_type(4)));
__device__ __forceinline__ void kload8(bf16x8*kf,lds_cptr kp){
  kf[0]=*(const __attribute__((address_space(3))) bf16x8*)(kp);      kf[1]=*(const __attribute__((address_space(3))) bf16x8*)(kp+512);
  kf[2]=*(const __attribute__((address_space(3))) bf16x8*)(kp+2048); kf[3]=*(const __attribute__((address_space(3))) bf16x8*)(kp+2560);
  kf[4]=*(const __attribute__((address_space(3))) bf16x8*)(kp+4096); kf[5]=*(const __attribute__((address_space(3))) bf16x8*)(kp+4608);
  kf[6]=*(const __attribute__((address_space(3))) bf16x8*)(kp+6144); kf[7]=*(const __attribute__((address_space(3))) bf16x8*)(kp+6656);
}
__device__ __forceinline__ void kload2(bf16x8*kf,lds_cptr kp,int j){ kf[2*j]=*(const __attribute__((address_space(3))) bf16x8*)(kp+j*2048); kf[2*j+1]=*(const __attribute__((address_space(3))) bf16x8*)(kp+j*2048+512); }
__device__ __forceinline__ s16x4 vtr(lds_cptr p){ return __builtin_bit_cast(s16x4,__builtin_amdgcn_ds_read_tr16_b64_v4i16((__attribute__((address_space(3))) v4i16_t*)p)); }
__device__ __forceinline__ float rowmax(const f32x16&p0,const f32x16&p1){
  float a=max3f(p0[0],p0[1],p1[0]),b=max3f(p0[2],p0[3],p1[1]);a=max3f(a,p1[2],p1[3]);
  #pragma unroll
  for(int r=4;r<16;r+=4){a=max3f(a,p0[r],p0[r+1]);b=max3f(b,p0[r+2],p0[r+3]);a=max3f(a,p1[r],p1[r+1]);b=max3f(b,p1[r+2],p1[r+3]);}
  const float m=max2f(a,b);
  auto rr=__builtin_amdgcn_permlane32_swap(__float_as_uint(m),__float_as_uint(m),false,false);
  return max2f(__uint_as_float(rr[0]),__uint_as_float(rr[1]));
}
__device__ __forceinline__ void pv(f32x16*o,int vb,bf16x8 pa0,bf16x8 pa1,bf16x8 pa2,bf16x8 pa3){
  #pragma unroll
  for(int d0=0;d0<2;++d0){s16x4 lo[4],hi[4];
    #pragma unroll
    for(int ks=0;ks<4;++ks){
      asm volatile("ds_read_b64_tr_b16 %0,%1 offset:%c2":"=&v"(lo[ks]):"v"(vb),"i"(d0*4096+ks*1024):"memory");
      asm volatile("ds_read_b64_tr_b16 %0,%1 offset:%c2":"=&v"(hi[ks]):"v"(vb),"i"(d0*4096+ks*1024+512):"memory");}
    asm volatile("s_waitcnt lgkmcnt(0)":::"memory");SBAR();
    #define PK(k) (bf16x8){lo[k][0],lo[k][1],lo[k][2],lo[k][3],hi[k][0],hi[k][1],hi[k][2],hi[k][3]}
    o[d0]=__builtin_amdgcn_mfma_f32_32x32x16_bf16(pa0,PK(0),o[d0],0,0,0);
    o[d0]=__builtin_amdgcn_mfma_f32_32x32x16_bf16(pa1,PK(1),o[d0],0,0,0);
    o[d0]=__builtin_amdgcn_mfma_f32_32x32x16_bf16(pa2,PK(2),o[d0],0,0,0);
    o[d0]=__builtin_amdgcn_mfma_f32_32x32x16_bf16(pa3,PK(3),o[d0],0,0,0);
    #undef PK
  }
}

#ifndef ATTN_STORE16
#define ATTN_STORE16(p,v) (*(u32x4*)(p)=(v))
#endif
template<int THRL> __device__ __forceinline__ void attn_unit(long rowbase,int qb,const bf16*Qc,const bf16*__restrict__ Kc,const bf16*__restrict__ Vc,bf16*Oc,char*shm){
  int tid_=threadIdx.x; asm volatile("":"+v"(tid_)); const int tid=tid_,lane=tid&63,r32=lane&31,hi=lane>>5; const int wid=__builtin_amdgcn_readfirstlane(tid>>6);
  const int q0=qb*QB;
  const bf16*Qw=Qc+(rowbase+q0+wid*QBLK)*DM;
  const bf16*Kh=Kc+rowbase*DM,*Vh=Vc+rowbase*DM;
  const unsigned lds0=(unsigned)(uintptr_t)shm;
  float*wsf=(float*)(shm+LDS_WS)+wid*64;
  const unsigned koff=(unsigned)(lane*DM+wid*8)*2u;
  const unsigned voffv=(unsigned)((16*(wid&3)+(lane>>2))*DM+(wid>>2)*32+(lane&3)*8)*2u;
  const unsigned kdst=lds0+LDS_K+wid*1024, vdst=lds0+LDS_V+wid*1024;
  #define DMA_K(t,slot) glds16s(Kh+(long)(t)*KVBLK*DM,koff,(unsigned)__builtin_amdgcn_readfirstlane(kdst+(slot)))
  #define DMA_V(t,slot) glds16s(Vh+(long)(t)*KVBLK*DM,voffv,(unsigned)__builtin_amdgcn_readfirstlane(vdst+(slot)))
  const int vb0=(int)(lds0+LDS_V)+((lane>>4)&1)*32+(lane&3)*8+(4*hi+((lane&15)>>2))*64;
  const char*Kbase=shm+LDS_K; bf16x8 kf[8];
  const lds_cptr shm3=(lds_cptr)shm; const lds_cptr kp0=shm3+LDS_K+hi*1024+r32*16; const lds_cptr vp0=shm3+LDS_V+((lane>>4)&1)*32+(lane&3)*8+(4*hi+((lane&15)>>2))*64;
  const int NT=(q0+QB)/KVBLK;
  DMA_K(0,0);DMA_V(0,0);DMA_K(1,SLOTB);
  bf16x8 qr[4];
  #pragma unroll
  for(int d0=0;d0<4;++d0)qr[d0]=*reinterpret_cast<const bf16x8*>(&Qw[(long)r32*DM+d0*16+hi*8]);
  float mhat=0.f,l_reg=0.f;f32x16 o[2];o[0]=f32x16{};o[1]=f32x16{};f32x16 negm=f32x16{};asm volatile("":"+v"(negm));
  const int qrel=wid*QBLK+r32;
  #define CMASK(P0,P1,t) do{int jb_=(t)-(NT-4); if(jb_>=0)cmask(P0,P1,jb_,qrel,hi);}while(0)
  bool resc=false;
  #define START(P0,P1) do{ const float rm=rowmax(P0,P1); resc=false; \
    { const float dl=rm; mhat=fadd_s(mhat,dl); \
      _Pragma("unroll") for(int r=0;r<16;++r){P0[r]=fsub_s(P0[r],dl);P1[r]=fsub_s(P1[r],dl);} \
      _Pragma("unroll") for(int r=0;r<16;++r)negm[r]=-mhat; asm volatile("":"+v"(negm)); } \
    _Pragma("unroll") for(int r=0;r<16;++r)P0[r]=__builtin_amdgcn_exp2f(P0[r]); }while(0)
  #define RESC() do{ if(resc){ asm volatile("s_waitcnt lgkmcnt(0)":::"memory"); \
      _Pragma("unroll") for(int d_=0;d_<2;++d_) _Pragma("unroll") for(int r=0;r<16;++r)o[d_][r]*=wsf[crow(r,hi)]; } }while(0)
  f32x16 pA0,pA1,pB0,pB1;
  int sl_prev=0,sl_cur=0,sl_next=SLOTB;
  #define ROT() do{sl_prev=sl_cur;sl_cur=sl_next;sl_next=(sl_next==(NSLOT-1)*SLOTB)?0:sl_next+SLOTB;}while(0)
  DMA_K(2,2*SLOTB);
  WAIT_BAR(3);
  qkt(pA0,pA1,Kbase,qr,negm,r32,hi);asm volatile("s_nop 15\n\ts_nop 7":"+v"(pA0),"+v"(pA1));CMASK(pA0,pA1,0);
  START(pA0,pA1);
  _Pragma("unroll") for(int r=0;r<16;++r)pA1[r]=__builtin_amdgcn_exp2f(pA1[r]);
  WAIT_BAR(0);
  DMA_K(3,0);DMA_V(1,SLOTB);
  ROT();
  kload8(kf,kp0+sl_cur);
  WAIT_BAR(2);
  s16x4 vlo[8],vhi[8]; u32x4 pw0,pw1,pw2,pw3;
  #define PKW(P,B) cvtpk_s(P[B],P[B+1])
  #define PAF(k) __builtin_bit_cast(bf16x8,pw##k)
  #define VFR(i) (bf16x8){vlo[i][0],vlo[i][1],vlo[i][2],vlo[i][3],vhi[i][0],vhi[i][1],vhi[i][2],vhi[i][3]}
  #define PIN(x) asm volatile("":"+v"(x))
  #define MX3(a,b,c) __builtin_fmaxf(__builtin_fmaxf((a),(b)),(c))
  #define GAPA(MF,A0,A1,A2,A3,W0,W1,PW) do{ MF; sacc+=A0; sacc+=A1; sacc+=A2; sacc+=A3; PIN(sacc); W0; W1; PIN(PW); SBAR(); }while(0)
  #define EX(v) __builtin_amdgcn_exp2f(v)
  #define GAPB(MF,X,B) do{ MF; X[B]=EX(X[B]); X[B+1]=EX(X[B+1]); X[B+2]=EX(X[B+2]); X[B+3]=EX(X[B+3]); PIN(X); SBAR(); }while(0)
  #define VRD(i) do{ vlo[i]=vtr(vp_+(((i)>>2)*4096+((i)&3)*1024)); vhi[i]=vtr(vp_+(((i)>>2)*4096+((i)&3)*1024+512)); }while(0)
  #define KRD(G,j) do{ if(G){ kload2(kf,kp0+sl_next,j); SBAR(); } }while(0)
  #define STEP(C0,C1,P0,P1,t,GK,GV,GL) do{ SBAR(); \
    const lds_cptr vp_=vp0+sl_prev; \
    VRD(0); SBAR(); float sacc=(P0[0]+P0[1]); \
    GAPA(C0=__builtin_amdgcn_mfma_f32_32x32x16_bf16(kf[0],qr[0],negm,0,0,0), P0[2],P0[3],P0[4],P0[5],     pw0[0]=PKW(P0,0), pw0[1]=PKW(P0,2), pw0); \
    VRD(4); SBAR(); GAPA(C1=__builtin_amdgcn_mfma_f32_32x32x16_bf16(kf[1],qr[0],negm,0,0,0), P0[6],P0[7],P0[8],P0[9],     pw0[2]=PKW(P0,4), pw0[3]=PKW(P0,6), pw0); \
    VRD(1); SBAR(); GAPA(C0=__builtin_amdgcn_mfma_f32_32x32x16_bf16(kf[2],qr[1],C0,0,0,0),   P0[10],P0[11],P0[12],P0[13], pw1[0]=PKW(P0,8), pw1[1]=PKW(P0,10), pw1); \
    VRD(5); SBAR(); GAPA(C1=__builtin_amdgcn_mfma_f32_32x32x16_bf16(kf[3],qr[1],C1,0,0,0),   P0[14],P0[15],P1[0],P1[1],   pw1[2]=PKW(P0,12),pw1[3]=PKW(P0,14), pw1); \
    VRD(2); SBAR(); GAPA(C0=__builtin_amdgcn_mfma_f32_32x32x16_bf16(kf[4],qr[2],C0,0,0,0),   P1[2],P1[3],P1[4],P1[5],     pw2[0]=PKW(P1,0), pw2[1]=PKW(P1,2), pw2); \
    VRD(6); SBAR(); GAPA(C1=__builtin_amdgcn_mfma_f32_32x32x16_bf16(kf[5],qr[2],C1,0,0,0),   P1[6],P1[7],P1[8],P1[9],     pw2[2]=PKW(P1,4), pw2[3]=PKW(P1,6), pw2); \
    VRD(3); SBAR(); GAPA(C0=__builtin_amdgcn_mfma_f32_32x32x16_bf16(kf[6],qr[3],C0,0,0,0),   P1[10],P1[11],P1[12],P1[13], pw3[0]=PKW(P1,8), pw3[1]=PKW(P1,10), pw3); \
    VRD(7); SBAR(); GAPA(C1=__builtin_amdgcn_mfma_f32_32x32x16_bf16(kf[7],qr[3],C1,0,0,0),   P1[14],P1[15],0.f,0.f,       pw3[2]=PKW(P1,12),pw3[3]=PKW(P1,14), pw3); \
    l_reg+=sacc; \
    if(GK){DMA_K((t)+3,sl_cur);} if(GV){DMA_V((t)+1,sl_next);} \
    CMASK(C0,C1,t); \
    { float a=MX3(C0[0],C0[1],C1[0]),b=MX3(C0[2],C0[3],C1[1]); a=MX3(a,C1[2],C1[3]); \
      _Pragma("unroll") for(int r=4;r<16;r+=4){a=MX3(a,C0[r],C0[r+1]);b=MX3(b,C0[r+2],C0[r+3]);a=MX3(a,C1[r],C1[r+1]);b=MX3(b,C1[r+2],C1[r+3]);} \
      float rm=__builtin_fmaxf(a,b); { auto rr=__builtin_amdgcn_permlane32_swap(__float_as_uint(rm),__float_as_uint(rm),false,false); rm=__builtin_fmaxf(__uint_as_float(rr[0]),__uint_as_float(rr[1])); } \
      resc=false; \
      if(__builtin_expect(__any(rm>(float)THRL),0)){ const float dl=__builtin_fmaxf(rm,0.f); mhat+=dl; \
        _Pragma("unroll") for(int r=0;r<16;++r){C0[r]-=dl;C1[r]-=dl;} \
        _Pragma("unroll") for(int r=0;r<16;++r)negm[r]=-mhat; asm volatile("":"+v"(negm)); \
        const float f=__builtin_amdgcn_exp2f(-dl); l_reg*=f; if(hi==0)wsf[r32]=f; resc=true; } } \
    SBAR(); \
    GAPB(o[0]=__builtin_amdgcn_mfma_f32_32x32x16_bf16(PAF(0),VFR(0),o[0],0,0,0), C0,0); \
    GAPB(o[1]=__builtin_amdgcn_mfma_f32_32x32x16_bf16(PAF(0),VFR(4),o[1],0,0,0), C0,4); \
    KRD(GL,0); GAPB(o[0]=__builtin_amdgcn_mfma_f32_32x32x16_bf16(PAF(1),VFR(1),o[0],0,0,0), C0,8); \
    KRD(GL,1); GAPB(o[1]=__builtin_amdgcn_mfma_f32_32x32x16_bf16(PAF(1),VFR(5),o[1],0,0,0), C0,12); \
    KRD(GL,2); GAPB(o[0]=__builtin_amdgcn_mfma_f32_32x32x16_bf16(PAF(2),VFR(2),o[0],0,0,0), C1,0); \
    KRD(GL,3); GAPB(o[1]=__builtin_amdgcn_mfma_f32_32x32x16_bf16(PAF(2),VFR(6),o[1],0,0,0), C1,4); \
    GAPB(o[0]=__builtin_amdgcn_mfma_f32_32x32x16_bf16(PAF(3),VFR(3),o[0],0,0,0), C1,8); \
    GAPB(o[1]=__builtin_amdgcn_mfma_f32_32x32x16_bf16(PAF(3),VFR(7),o[1],0,0,0), C1,12); \
    }while(0)
  int t=1;
  #undef CMASK
  #define CMASK(P0,P1,t) do{}while(0)
  for(;t+5<NT;t+=2){
    STEP(pB0,pB1,pA0,pA1,t,true,true,true);     WAIT_BAR(2); RESC(); ROT();
    STEP(pA0,pA1,pB0,pB1,t+1,true,true,true);   WAIT_BAR(2); RESC(); ROT();
  }
  #undef CMASK
  #define CMASK(P0,P1,t) do{int jb_=(t)-(NT-4); if(jb_>=0)cmask(P0,P1,jb_,qrel,hi);}while(0)
  #define ENDW(tt) do{ if((tt)+3<NT){WAIT_BAR(2);} else if((tt)+2<NT){WAIT_BAR(1);} else {WAIT_BAR(0);} }while(0)
  for(;t+1<NT;t+=2){
    STEP(pB0,pB1,pA0,pA1,t,(t+3<NT),(t+1<NT),(t+1<NT));       ENDW(t);   RESC(); ROT();
    STEP(pA0,pA1,pB0,pB1,t+1,(t+4<NT),(t+2<NT),(t+2<NT));     ENDW(t+1); RESC(); ROT();
  }
  STEP(pB0,pB1,pA0,pA1,NT-1,false,false,false); RESC();
  { float sacc=pB0[0]+pB0[1]; _Pragma("unroll") for(int r=2;r<16;++r)sacc+=pB0[r]; _Pragma("unroll") for(int r=0;r<16;++r)sacc+=pB1[r]; l_reg+=sacc;
    pw0=(u32x4){PKW(pB0,0),PKW(pB0,2),PKW(pB0,4),PKW(pB0,6)};pw1=(u32x4){PKW(pB0,8),PKW(pB0,10),PKW(pB0,12),PKW(pB0,14)};pw2=(u32x4){PKW(pB1,0),PKW(pB1,2),PKW(pB1,4),PKW(pB1,6)};pw3=(u32x4){PKW(pB1,8),PKW(pB1,10),PKW(pB1,12),PKW(pB1,14)};
    SBAR(); pv(o,vb0+sl_cur,PAF(0),PAF(1),PAF(2),PAF(3)); }
  #undef PKW
  #undef PAF
  #undef VFR
  #undef PIN
  #undef MX3
  #undef GAPA
  #undef GAPB
  #undef EX
  #undef VRD
  #undef KRD
  #undef STEP
  #undef ENDW
  {auto rr=__builtin_amdgcn_permlane32_swap(__float_as_uint(l_reg),__float_as_uint(l_reg),false,false);l_reg=__uint_as_float(rr[0])+__uint_as_float(rr[1]);}
  if(hi==0)wsf[32+r32]=l_reg;asm volatile("s_waitcnt lgkmcnt(0)":::"memory");
  float rli[16];
  #pragma unroll
  for(int r=0;r<16;++r)rli[r]=__builtin_amdgcn_rcpf(wsf[32+crow(r,hi)]);
  bf16*Ow=Oc+(rowbase+q0+wid*QBLK)*DM;
  { bf16*stg=(bf16*)(shm+LDS_OST)+wid*2048;
    #pragma unroll
    for(int r=0;r<16;++r){const int orow=crow(r,hi);
      #pragma unroll
      for(int d0=0;d0<2;++d0)stg[orow*64+d0*32+r32]=__float2bfloat16(o[d0][r]*rli[r]);}
    asm volatile("s_waitcnt lgkmcnt(0)":::"memory");
    #pragma unroll
    for(int i=0;i<4;++i){const int row=i*8+(lane>>3),ch=lane&7; const u32x4 v=*(const u32x4*)(stg+row*64+ch*8); ATTN_STORE16(Ow+(long)row*DM+ch*8,v);} }
  asm volatile("s_waitcnt lgkmcnt(0)\n\ts_barrier":::"memory");
  #undef DMA_K
  #undef DMA_V
  #undef CMASK
  #undef START
  #undef RESC
  #undef ROT
}
constexpr int ATTN_LDS_BYTES=LDS_BYTES;
#undef SBAR
#undef WAIT_BAR
}
namespace mk {
#define GAS __attribute__((address_space(1)))
#define LAS __attribute__((address_space(3)))
typedef unsigned short bf16;
typedef unsigned v4u __attribute__((ext_vector_type(4)));
typedef unsigned v2u __attribute__((ext_vector_type(2)));
typedef float f32x4 __attribute__((ext_vector_type(4)));
using pg8::Unit;
using pg8::cvt_pk_bf16;

constexpr int D = 1024, BATCH = 8, SEQ = 2048, T = BATCH * SEQ, NH = 8, NG = 4, EPG = 8, NE = 32, DE = 512, NRW = NG + NE;
constexpr float ALPHA = 1.4142135623730951f, LN_EPS = 1e-5f, RMS_EPS = 1e-5f;
constexpr float LAM_INIT = 0.35550906f;
constexpr float QSCALE = 0.125f * 1.4426950408889634f;
constexpr int CNT_STRIDE = 64;
constexpr int CAP = 2 * T;
constexpr int NWAVES = 8, NTHREADS = 512;
#ifndef P0B_FILL
#define P0B_FILL 1
#endif
#ifndef P0B_SPLIT
#define P0B_SPLIT 9216
#endif

constexpr size_t MiB = 1u << 20;
constexpr size_t WS_CTL = 0, WS_W1T = 1 * MiB, WS_W2T = 7 * MiB, WS_WKVQ = 9 * MiB, WS_WOT = 15 * MiB, WS_RWT = 17 * MiB, WS_PERM = 18 * MiB, WS_GATE = 22 * MiB;
constexpr size_t WS_WUT = 24 * MiB, WS_WDT = 152 * MiB, WS_XB = 216 * MiB, WS_GB = 248 * MiB, WS_U = 280 * MiB, WS_A2 = 312 * MiB, WS_Z = 344 * MiB, WS_X1B = 408 * MiB;
constexpr size_t WS_ACT = 440 * MiB, WS_YP = 480 * MiB, WS_X2B = 544 * MiB, WS_K = 576 * MiB, WS_V = 608 * MiB, WS_Q = 640 * MiB, WS_O0 = 672 * MiB, WS_O1 = 704 * MiB;
constexpr size_t WS_A3 = 736 * MiB, WS_X3B = 768 * MiB;
#ifdef MKPROBE
constexpr size_t WS_Z1 = 800 * MiB, WS_ACT1 = 864 * MiB, WS_YP1 = 904 * MiB, WS_PERM1 = 968 * MiB, WS_GATE1 = 972 * MiB, WS_END = 973 * MiB;
#else
constexpr size_t WS_Z1 = WS_Z, WS_ACT1 = WS_ACT, WS_YP1 = WS_YP, WS_PERM1 = WS_PERM, WS_GATE1 = WS_GATE, WS_END = 800 * MiB;
#endif
#define LZ(l) ((l) ? WS_Z1 : WS_Z)
#define LACT(l) ((l) ? WS_ACT1 : WS_ACT)
#define LYP(l) ((l) ? WS_YP1 : WS_YP)
#define LPERM(l) ((l) ? WS_PERM1 : WS_PERM)
#define LGATE(l) ((l) ? WS_GATE1 : WS_GATE)
constexpr int RING_BYTES = 131072, RW_BYTES = 147456  , MISC_OFF = RW_BYTES, LDS_BYTES = 163840;

struct Args {
    const float *x, *a_w_in, *a_conv_w, *a_w_out, *kv_w, *b_w_q, *b_lambda, *b_subln_g, *b_w_o, *ln1_g, *ln1_b, *ln2_g, *ln2_b, *rg_w, *rg_b, *re_w, *re_b, *e_w_in, *e_w_down;
    float* out; unsigned char* ws;
};

typedef const __attribute__((address_space(4))) Args* ArgsP;
__device__ __forceinline__ ArgsP kargs() { ArgsP p = (ArgsP)__builtin_amdgcn_kernarg_segment_ptr(); asm volatile("" : "+s"(p)); return p; }
struct Ctx { int tid, lane, wave, G, bx, gw, NGW; unsigned char* ws; };
__device__ __forceinline__ Ctx mkctx(ArgsP ap) { Ctx c; int t = threadIdx.x; asm volatile("" : "+v"(t)); c.tid = t; c.lane = t & 63; c.wave = __builtin_amdgcn_readfirstlane(t >> 6);
    c.G = gridDim.x; c.bx = blockIdx.x; c.gw = c.bx * 8 + c.wave; c.NGW = c.G * 8; c.ws = ap->ws; return c; }
__device__ __forceinline__ unsigned f2bf(float f) { unsigned u = __builtin_bit_cast(unsigned, f); return (u + 0x7fffu + ((u >> 16) & 1u)) >> 16; }
__device__ __forceinline__ unsigned pk2(float lo, float hi) { return f2bf(lo) | (f2bf(hi) << 16); }
__device__ __forceinline__ float bflo(unsigned w) { return __builtin_bit_cast(float, w << 16); }
__device__ __forceinline__ float bfhi(unsigned w) { return __builtin_bit_cast(float, w & 0xffff0000u); }
__device__ __forceinline__ float wave_sum(float v) {
#pragma unroll
    for (int o = 1; o < 64; o <<= 1) v += __shfl_xor(v, o);
    return v;
}

__device__ __forceinline__ float dpp_add(float v, const int ctrl_sel) {
    const int iv = __builtin_bit_cast(int, v); int t;
    if (ctrl_sel == 0) t = __builtin_amdgcn_update_dpp(0, iv, 0xB1, 0xF, 0xF, true);
    else if (ctrl_sel == 1) t = __builtin_amdgcn_update_dpp(0, iv, 0x4E, 0xF, 0xF, true);
    else if (ctrl_sel == 2) t = __builtin_amdgcn_update_dpp(0, iv, 0x141, 0xF, 0xF, true);
    else if (ctrl_sel == 3) t = __builtin_amdgcn_update_dpp(0, iv, 0x140, 0xF, 0xF, true);
    else if (ctrl_sel == 4) t = __builtin_amdgcn_update_dpp(0, iv, 0x142, 0xA, 0xF, false);
    else t = __builtin_amdgcn_update_dpp(0, iv, 0x143, 0xC, 0xF, false);
    return v + __builtin_bit_cast(float, t);
}
template <int N> __device__ __forceinline__ void dpp_sum(float (&v)[N]) {
#pragma unroll
    for (int st = 0; st < 6; ++st) {
#pragma unroll
        for (int i = 0; i < N; ++i) v[i] = dpp_add(v[i], st);
    }
#pragma unroll
    for (int i = 0; i < N; ++i) v[i] = __builtin_bit_cast(float, __builtin_amdgcn_readlane(__builtin_bit_cast(int, v[i]), 63));
}
__device__ __forceinline__ float dpp_sum1(float v) { float a[1] = {v}; dpp_sum(a); return a[0]; }

__device__ __forceinline__ void p0_transpose_item(const float* W, int K, int N, bf16* WT, int row_off, LAS float* scr, int item, int lane) {
    const int nblk = N / 64, kb = item / nblk, nb = item % nblk, k0 = 64 * kb, n0 = 64 * nb;
    const float* src = W + (size_t)(k0 + (lane >> 4)) * N + n0 + (lane & 15) * 4;
    f32x4 v[16];
#pragma unroll
    for (int i = 0; i < 16; ++i) v[i] = __builtin_nontemporal_load((const f32x4*)(src + (size_t)(4 * i) * N));
#pragma unroll
    for (int i = 0; i < 16; ++i) { LAS float* d = scr + (4 * i + (lane >> 4)) * 65 + (lane & 15) * 4; d[0] = v[i].x; d[1] = v[i].y; d[2] = v[i].z; d[3] = v[i].w; }
    asm volatile("s_waitcnt lgkmcnt(0)" ::: "memory");
    const int c = lane & 7;
#pragma unroll
    for (int j = 0; j < 8; ++j) { const int n = (lane >> 3) + 8 * j; const LAS float* s = scr + (8 * c) * 65 + n;
        v4u o; o.x = pk2(s[0 * 65], s[1 * 65]); o.y = pk2(s[2 * 65], s[3 * 65]); o.z = pk2(s[4 * 65], s[5 * 65]); o.w = pk2(s[6 * 65], s[7 * 65]);
        *(GAS v4u*)(WT + (size_t)(row_off + n0 + n) * K + k0 + 8 * c) = o; }
    asm volatile("s_waitcnt lgkmcnt(0)" ::: "memory");
}

constexpr int I_IN = 16 * 48, I_SQ = 16 * 16, I_KV = 16 * 32, I_DN = 8 * 16;
constexpr int NEM = P0B_FILL ? NE : 2 * NE;
constexpr int PS1 = I_IN, PS2 = PS1 + I_SQ, PS3 = PS2 + I_KV, PS4 = PS3 + I_SQ, PS5 = PS4 + I_SQ, PS6 = PS5 + NEM * I_SQ, P0_NITEMS = PS6 + NEM * I_DN;
__device__ __forceinline__ void p0_items(LAS unsigned char* lds, int lo, int hi, int w, int nw) {
    const ArgsP a = kargs(); const Ctx cx = mkctx(a); const int lane = cx.lane; unsigned char* ws = cx.ws;
    LAS float* scr = (LAS float*)(lds + cx.wave * 16640);
    for (int it = lo + w; it < hi; it += nw) {
        if (it < PS1) p0_transpose_item(a->a_w_in, D, 3 * D, (bf16*)(ws + WS_W1T), 0, scr, it, lane);
        else if (it < PS2) p0_transpose_item(a->a_w_out, D, D, (bf16*)(ws + WS_W2T), 0, scr, it - PS1, lane);
        else if (it < PS3) p0_transpose_item(a->kv_w, D, 2 * D, (bf16*)(ws + WS_WKVQ), 0, scr, it - PS2, lane);
        else if (it < PS4) p0_transpose_item(a->b_w_q, D, D, (bf16*)(ws + WS_WKVQ), 2 * D, scr, it - PS3, lane);
        else if (it < PS5) p0_transpose_item(a->b_w_o, D, D, (bf16*)(ws + WS_WOT), 0, scr, it - PS4, lane);
        else if (it < PS6) { const int r = it - PS5, mtx = r / I_SQ; p0_transpose_item(a->e_w_in + (size_t)mtx * D * D, D, D, (bf16*)(ws + WS_WUT) + (size_t)mtx * D * D, 0, scr, r % I_SQ, lane); }
        else { const int r = it - PS6, mtx = r / I_DN; p0_transpose_item(a->e_w_down + (size_t)mtx * DE * D, DE, D, (bf16*)(ws + WS_WDT) + (size_t)mtx * D * DE, 0, scr, r % I_DN, lane); }
    }
}
#ifndef ROLE_SPLIT
#define ROLE_SPLIT 1
#endif
#ifndef P0A_EXTRA
#define P0A_EXTRA 6656
#endif
__device__ __forceinline__ void p0_prologue(LAS unsigned char* lds) {
    const ArgsP a = kargs(); const Ctx cx = mkctx(a); const int gw = cx.gw, NGW = cx.NGW, lane = cx.lane;
    unsigned char* ws = cx.ws;
    p0_items(lds, 0, ROLE_SPLIT ? PS1 + P0A_EXTRA : P0_NITEMS, gw, NGW);
    for (int m = gw; m < T; m += NGW) {
        const GAS f32x4* xr = (const GAS f32x4*)(a->x + (size_t)m * D) + lane;
        GAS v2u* o = (GAS v2u*)((bf16*)(ws + WS_XB) + (size_t)m * D) + lane;
#pragma unroll
        for (int j = 0; j < 4; ++j) { const f32x4 v = xr[64 * j]; v2u w; w.x = pk2(v.x, v.y); w.y = pk2(v.z, v.w); o[64 * j] = w; }
    }
    { float* rwt = (float*)(ws + WS_RWT);
      for (int idx = gw * 64 + lane; idx < 2 * NRW * D; idx += NGW * 64) { const int l = idx / (NRW * D), n = (idx / D) % NRW, k = idx % D;
          rwt[idx] = n < NG ? a->rg_w[((size_t)l * D + k) * NG + n] : a->re_w[((size_t)l * D + k) * NE + (n - NG)]; } }
}
__device__ __forceinline__ void p0b_fill(LAS unsigned char* lds, int lo, int hi, int r, int nidle) {
    const ArgsP a = kargs(); const Ctx cx = mkctx(a); unsigned char* ws = cx.ws;
    LAS float* scr = (LAS float*)(lds + cx.wave * 16640);
    for (int it = lo + r * NWAVES + cx.wave; it < hi; it += nidle * NWAVES) {
        if (it < NE * 256) { const int mtx = NE + it / 256; p0_transpose_item(a->e_w_in + (size_t)mtx * D * D, D, D, (bf16*)(ws + WS_WUT) + (size_t)mtx * D * D, 0, scr, it % 256, cx.lane); }
        else { const int r2 = it - NE * 256, mtx = NE + r2 / 128; p0_transpose_item(a->e_w_down + (size_t)mtx * DE * D, DE, D, (bf16*)(ws + WS_WDT) + (size_t)mtx * D * DE, 0, scr, r2 % 128, cx.lane); }
    }
}
constexpr int P0B_ITEMS = NE * 256 + NE * 128;
__device__ __forceinline__ void p0b_idle_fill(LAS unsigned char* lds, int lo, int hi) {
    const ArgsP a = kargs(); const Ctx cx = mkctx(a); const LAS int* misc = (const LAS int*)(lds + MISC_OFF);
    const int U = misc[NE], rem = U % cx.G;
    if (rem == 0) p0b_fill(lds, lo, hi, cx.bx, cx.G);
    else if (cx.bx >= rem) p0b_fill(lds, lo, hi, cx.bx - rem, cx.G - rem);
}
struct SchedDense {
    int G, c, nN, mode, K; const char* W;
    __device__ __forceinline__ bool next(int i, Unit& u) const {
        int pm, pn; if (!pg8::static_tile(i, G, c, T / 256, nN, pm, pn)) return false;
        u.arow = pm * 256; u.p0 = pm; u.p1 = pn; u.p2 = 0;
        const size_t rb = (size_t)K * 2;
        if (mode == 0 && pn >= 4) { const int jj = pn - 4; u.b0 = W + (size_t)(D + 128 * jj) * rb; u.b1 = W + (size_t)(2 * D + 128 * jj) * rb; }
        else { u.b0 = W + (size_t)(256 * pn) * rb; u.b1 = u.b0 + 128 * rb; }
        return true;
    }
    __device__ __forceinline__ void a_offs(const Unit& u, const int (&R)[2], const int (&C)[2], unsigned& v00, unsigned& v01, unsigned& v10, unsigned& v11) const {
        v00 = (unsigned)((u.arow + R[0]) * K + C[0]) * 2u; v01 = (unsigned)((u.arow + R[1]) * K + C[1]) * 2u;
        v10 = (unsigned)((u.arow + 128 + R[0]) * K + C[0]) * 2u; v11 = (unsigned)((u.arow + 128 + R[1]) * K + C[1]) * 2u;
    }
};
struct MoeTab { const LAS int* ub; const LAS int* ps; const LAS int* cn; };
struct SchedMoe {
    int G, c, K; bool up; const char* W; const int* perm; MoeTab tb;
    __device__ __forceinline__ bool next(int i, Unit& u) const {
        const int idx = i * G + c; if (idx >= tb.ub[NE]) return false;
        int e = 0;
#pragma unroll 1
        for (int k = 1; k < NE; ++k) if (idx >= tb.ub[k]) e = k;
        const int local = idx - tb.ub[e], rtn = (tb.ub[e + 1] - tb.ub[e]) >> 2, ct = local / rtn, rti = local - ct * rtn;
        const size_t rb = (size_t)K * 2; const char* We = W + (size_t)e * D * rb;
        if (up) { u.b0 = We + (size_t)(128 * ct) * rb; u.b1 = We + (size_t)(DE + 128 * ct) * rb; u.arow = e * CAP + rti * 256; u.p0 = tb.ps[e] + rti * 256; }
        else { u.b0 = We + (size_t)(256 * ct) * rb; u.b1 = u.b0 + 128 * rb; u.arow = tb.ps[e] + rti * 256; u.p0 = e * CAP + rti * 256; }
        u.p1 = ct; u.p2 = tb.cn[e] - rti * 256;
        return true;
    }
    __device__ __forceinline__ void a_offs(const Unit& u, const int (&R)[2], const int (&C)[2], unsigned& v00, unsigned& v01, unsigned& v10, unsigned& v11) const {
        if (up) {
            const int r00 = R[0] < u.p2 ? R[0] : 0, r01 = R[1] < u.p2 ? R[1] : 0, r10 = 128 + R[0] < u.p2 ? 128 + R[0] : 0, r11 = 128 + R[1] < u.p2 ? 128 + R[1] : 0;
            const int t00 = perm[u.arow + r00] >> 1, t01 = perm[u.arow + r01] >> 1, t10 = perm[u.arow + r10] >> 1, t11 = perm[u.arow + r11] >> 1;
            v00 = (unsigned)(t00 * K + C[0]) * 2u; v01 = (unsigned)(t01 * K + C[1]) * 2u; v10 = (unsigned)(t10 * K + C[0]) * 2u; v11 = (unsigned)(t11 * K + C[1]) * 2u;
        } else {
            v00 = (unsigned)((u.arow + R[0]) * K + C[0]) * 2u; v01 = (unsigned)((u.arow + R[1]) * K + C[1]) * 2u;
            v10 = (unsigned)((u.arow + 128 + R[0]) * K + C[0]) * 2u; v11 = (unsigned)((u.arow + 128 + R[1]) * K + C[1]) * 2u;
        }
    }
};

struct EpiConvIn {
    static constexpr bool PERM = true; bf16* GB; bf16* U;
    __device__ __forceinline__ void operator()(const f32x4 (&acc)[2][2][4][2], const Unit& u, int wr, int wc, int fr, int fq) const {
        const int row0 = u.p0 * 256 + wr * 64 + fr;
        if (u.p1 < 4) {
            const int col0 = u.p1 * 256 + wc * 32 + 8 * fq;
#pragma unroll
            for (int ai = 0; ai < 2; ++ai)
#pragma unroll
                for (int m = 0; m < 4; ++m) { bf16* rowp = GB + (size_t)(row0 + ai * 128 + m * 16) * D + col0;
#pragma unroll
                    for (int bj = 0; bj < 2; ++bj) { const f32x4 v0 = acc[ai][bj][m][0], v1 = acc[ai][bj][m][1];
                        v4u w; w.x = cvt_pk_bf16(v0[0], v0[1]); w.y = cvt_pk_bf16(v0[2], v0[3]); w.z = cvt_pk_bf16(v1[0], v1[1]); w.w = cvt_pk_bf16(v1[2], v1[3]);
                        *(v4u*)(rowp + bj * 128) = w; } }
        } else {
            const int col0 = (u.p1 - 4) * 128 + wc * 32 + 8 * fq;
#pragma unroll
            for (int ai = 0; ai < 2; ++ai)
#pragma unroll
                for (int m = 0; m < 4; ++m) { const f32x4 v0 = acc[ai][0][m][0] * acc[ai][1][m][0], v1 = acc[ai][0][m][1] * acc[ai][1][m][1];
                    v4u w; w.x = cvt_pk_bf16(v0[0], v0[1]); w.y = cvt_pk_bf16(v0[2], v0[3]); w.z = cvt_pk_bf16(v1[0], v1[1]); w.w = cvt_pk_bf16(v1[2], v1[3]);
                    *(v4u*)(U + (size_t)(row0 + ai * 128 + m * 16) * D + col0) = w; }
        }
    }
};
template <bool RES_BF16> struct EpiResZ {
    static constexpr bool PERM = false; const void* res; float* Z;
    __device__ __forceinline__ void operator()(const f32x4 (&acc)[2][2][4][2], const Unit& u, int wr, int wc, int fr, int fq) const {
        const int row0 = u.p0 * 256 + wr * 64 + fr, col0 = u.p1 * 256 + wc * 32 + 4 * fq;
#pragma unroll
        for (int ai = 0; ai < 2; ++ai)
#pragma unroll
            for (int m = 0; m < 4; ++m) { const size_t off = (size_t)(row0 + ai * 128 + m * 16) * D + col0;
#pragma unroll
                for (int bj = 0; bj < 2; ++bj)
#pragma unroll
                    for (int n = 0; n < 2; ++n) { const size_t o = off + bj * 128 + n * 16; f32x4 r;
                        if (RES_BF16) { const v2u w = *(const v2u*)((const bf16*)res + o); r = (f32x4){bflo(w.x), bfhi(w.x), bflo(w.y), bfhi(w.y)}; }
                        else r = *(const f32x4*)((const float*)res + o);
                        *(f32x4*)(Z + o) = r * ALPHA + acc[ai][bj][m][n]; } }
    }
};
struct EpiUp {
    static constexpr bool PERM = true; bf16* ACT;
    __device__ __forceinline__ void operator()(const f32x4 (&acc)[2][2][4][2], const Unit& u, int wr, int wc, int fr, int fq) const {
        const int row0 = u.p0 + wr * 64 + fr, col0 = u.p1 * 128 + wc * 32 + 8 * fq;
#pragma unroll
        for (int ai = 0; ai < 2; ++ai)
#pragma unroll
            for (int m = 0; m < 4; ++m) { f32x4 v[2];
#pragma unroll
                for (int n = 0; n < 2; ++n) { const f32x4 g = acc[ai][0][m][n], uu = acc[ai][1][m][n];
#pragma unroll
                    for (int j = 0; j < 4; ++j) { const float e = __builtin_amdgcn_exp2f(g[j] * -1.4426950408889634f); v[n][j] = g[j] * __builtin_amdgcn_rcpf(1.0f + e) * uu[j]; } }
                v4u w; w.x = cvt_pk_bf16(v[0][0], v[0][1]); w.y = cvt_pk_bf16(v[0][2], v[0][3]); w.z = cvt_pk_bf16(v[1][0], v[1][1]); w.w = cvt_pk_bf16(v[1][2], v[1][3]);
                *(v4u*)(ACT + (size_t)(row0 + ai * 128 + m * 16) * DE + col0) = w; }
    }
};
struct EpiDown {
    static constexpr bool PERM = true; bf16* YP; const int* perm; const float* gate;
    __device__ __forceinline__ void operator()(const f32x4 (&acc)[2][2][4][2], const Unit& u, int wr, int wc, int fr, int fq) const {
        const int col0 = u.p1 * 256 + wc * 32 + 8 * fq;
#pragma unroll
        for (int ai = 0; ai < 2; ++ai)
#pragma unroll
            for (int m = 0; m < 4; ++m) { const int r = ai * 128 + wr * 64 + m * 16 + fr;
                if (r < u.p2) { const int pair = perm[u.p0 + r]; const float g = gate[pair]; bf16* rowp = YP + (size_t)pair * D + col0;
#pragma unroll
                    for (int bj = 0; bj < 2; ++bj) { const f32x4 v0 = acc[ai][bj][m][0] * g, v1 = acc[ai][bj][m][1] * g;
                        v4u w; w.x = cvt_pk_bf16(v0[0], v0[1]); w.y = cvt_pk_bf16(v0[2], v0[3]); w.z = cvt_pk_bf16(v1[0], v1[1]); w.w = cvt_pk_bf16(v1[2], v1[3]);
                        *(v4u*)(rowp + bj * 128) = w; } } }
    }
};
struct EpiKVQ {
    static constexpr bool PERM = true; bf16* KB;
    __device__ __forceinline__ void operator()(const f32x4 (&acc)[2][2][4][2], const Unit& u, int wr, int wc, int fr, int fq) const {
        const int t = u.p1 >> 2; const float sc = t == 2 ? QSCALE : 1.0f;
        bf16* base = KB + (size_t)t * (32 * MiB / 2);
        const int row0 = u.p0 * 256 + wr * 64 + fr, col0 = (u.p1 & 3) * 256 + wc * 32 + 8 * fq;
#pragma unroll
        for (int ai = 0; ai < 2; ++ai)
#pragma unroll
            for (int m = 0; m < 4; ++m) { bf16* rowp = base + (size_t)(row0 + ai * 128 + m * 16) * D + col0;
#pragma unroll
                for (int bj = 0; bj < 2; ++bj) { const f32x4 v0 = acc[ai][bj][m][0] * sc, v1 = acc[ai][bj][m][1] * sc;
                    v4u w; w.x = cvt_pk_bf16(v0[0], v0[1]); w.y = cvt_pk_bf16(v0[2], v0[3]); w.z = cvt_pk_bf16(v1[0], v1[1]); w.w = cvt_pk_bf16(v1[2], v1[3]);
                    *(v4u*)(rowp + bj * 128) = w; } }
    }
};

__device__ __forceinline__ void ln_rows(f32x4 (&v)[4], const f32x4 (&gg)[4], const f32x4 (&bb)[4]) {
    float s = 0.f;
#pragma unroll
    for (int j = 0; j < 4; ++j) s += (v[j].x + v[j].y) + (v[j].z + v[j].w);
    const float mean = dpp_sum1(s) * (1.f / D); float s2 = 0.f;
#pragma unroll
    for (int j = 0; j < 4; ++j) { v[j] = v[j] - mean; s2 += (v[j].x * v[j].x + v[j].y * v[j].y) + (v[j].z * v[j].z + v[j].w * v[j].w); }
    const float rstd = 1.f / sqrtf(dpp_sum1(s2) * (1.f / D) + LN_EPS);
#pragma unroll
    for (int j = 0; j < 4; ++j) v[j] = v[j] * rstd * gg[j] + bb[j];
}
__device__ __forceinline__ float dot_lds(const f32x4 (&v)[4], const LAS f32x4* w, int lane) {
    float a = 0.f;
#pragma unroll
    for (int j = 0; j < 4; ++j) { const f32x4 ww = w[64 * j + lane]; a += (v[j].x * ww.x + v[j].y * ww.y) + (v[j].z * ww.z + v[j].w * ww.w); }
    return a;
}
__device__ __forceinline__ void ln_router_phase(LAS unsigned char* lds, int layer, int rep = 0) {
    const ArgsP a = kargs(); const Ctx cx = mkctx(a); const int gw = cx.gw, NGW = cx.NGW, lane = cx.lane;
    unsigned char* ws = cx.ws;
    const float* Z = (const float*)(ws + LZ(layer)); bf16* Xb = (bf16*)(ws + (layer == 0 ? WS_X1B : WS_X3B));
    const float* g = a->ln1_g + layer * D; const float* b = a->ln1_b + layer * D;
    const float* rgb = a->rg_b + layer * NG; const float* reb = a->re_b + layer * NE;
    int* cnt = (int*)(ws + WS_CTL) + layer * NE * CNT_STRIDE; int* perm = (int*)(ws + LPERM(layer)); float* gate = (float*)(ws + LGATE(layer));
    LAS f32x4* wl = (LAS f32x4*)lds;
    { const f32x4* wg = (const f32x4*)((const float*)(ws + WS_RWT) + (size_t)layer * NRW * D);
      for (int i = cx.tid; i < NRW * D / 4; i += NTHREADS) wl[i] = wg[i]; }
    f32x4 gg[4], bb[4];
#pragma unroll
    for (int j = 0; j < 4; ++j) { gg[j] = *(const f32x4*)(g + 256 * j + 4 * lane); bb[j] = *(const f32x4*)(b + 256 * j + 4 * lane); }
    constexpr int RPW = 16;
    LAS int* rt_row = (LAS int*)(lds + MISC_OFF + 2048);
    LAS int* rt_e = rt_row + NWAVES * RPW;
    LAS float* rt_g = (LAS float*)(rt_e + 2 * NWAVES * RPW);
    LAS int* rt_base = (LAS int*)(rt_g + 2 * NWAVES * RPW);
    LAS int* wave_rows = rt_base + NE;
    f32x4 nv[2][4];
#pragma unroll
    for (int r = 0; r < 2; ++r) { const int row = gw + r * NGW;
        if (row < T) {
#pragma unroll
            for (int j = 0; j < 4; ++j) nv[r][j] = *(const f32x4*)(Z + (size_t)row * D + 256 * j + 4 * lane);
        } }
    __syncthreads();
    int it = 0;
#pragma unroll 1
    for (int row0 = gw; row0 < T && it < RPW; row0 += 2 * NGW, it += 2) {
        const bool two = row0 + NGW < T;
        f32x4 v[2][4];
#pragma unroll
        for (int r = 0; r < 2; ++r)
#pragma unroll
            for (int j = 0; j < 4; ++j) v[r][j] = nv[r][j];
#pragma unroll
        for (int r = 0; r < 2; ++r) { const int row = row0 + (2 + r) * NGW;
            if (row < T) {
#pragma unroll
                for (int j = 0; j < 4; ++j) nv[r][j] = *(const f32x4*)(Z + (size_t)row * D + 256 * j + 4 * lane);
            } }
        if (!two) {
#pragma unroll
            for (int j = 0; j < 4; ++j) v[1][j] = v[0][j];
        }
        float s1[2];
#pragma unroll
        for (int r = 0; r < 2; ++r) { float s = 0.f;
#pragma unroll
            for (int j = 0; j < 4; ++j) s += (v[r][j].x + v[r][j].y) + (v[r][j].z + v[r][j].w);
            s1[r] = s; }
        dpp_sum(s1);
        float s2[2];
#pragma unroll
        for (int r = 0; r < 2; ++r) { const float mean = s1[r] * (1.f / D); float q = 0.f;
#pragma unroll
            for (int j = 0; j < 4; ++j) { v[r][j] = v[r][j] - mean; q += (v[r][j].x * v[r][j].x + v[r][j].y * v[r][j].y) + (v[r][j].z * v[r][j].z + v[r][j].w * v[r][j].w); }
            s2[r] = q; }
        dpp_sum(s2);
#pragma unroll
        for (int r = 0; r < 2; ++r) { const float rstd = 1.f / sqrtf(s2[r] * (1.f / D) + LN_EPS);
#pragma unroll
            for (int j = 0; j < 4; ++j) v[r][j] = v[r][j] * rstd * gg[j] + bb[j]; }
#pragma unroll
        for (int r = 0; r < 2; ++r) { const int row = row0 + r * NGW;
            if (r == 0 || two) {
#pragma unroll
                for (int j = 0; j < 4; ++j) { v2u w; w.x = pk2(v[r][j].x, v[r][j].y); w.y = pk2(v[r][j].z, v[r][j].w); *(v2u*)(Xb + (size_t)row * D + 256 * j + 4 * lane) = w; }
            } }
        float gl[2 * NG];
#pragma unroll
        for (int r = 0; r < 2; ++r)
#pragma unroll
            for (int n = 0; n < NG; ++n) gl[r * NG + n] = dot_lds(v[r], wl + n * (D / 4), lane);
        dpp_sum(gl);
        int gi[2]; float gtop[2];
#pragma unroll
        for (int r = 0; r < 2; ++r) { int g_ = 0; float gm = -INFINITY;
#pragma unroll
            for (int n = 0; n < NG; ++n) { gl[r * NG + n] += rgb[n]; if (gl[r * NG + n] > gm) { gm = gl[r * NG + n]; g_ = n; } }
            float gs = 0.f;
#pragma unroll
            for (int n = 0; n < NG; ++n) gs += __expf(gl[r * NG + n] - gm);
            gi[r] = g_; gtop[r] = 1.0f / gs; }
        float el[2 * EPG];
#pragma unroll
        for (int r = 0; r < 2; ++r)
#pragma unroll
            for (int n = 0; n < EPG; ++n) el[r * EPG + n] = dot_lds(v[r], wl + (NG + gi[r] * EPG + n) * (D / 4), lane);
        dpp_sum(el);
#pragma unroll
        for (int r = 0; r < 2; ++r) {
            float m0 = -INFINITY, m1 = -INFINITY; int i0 = 0, i1 = 0;
#pragma unroll
            for (int n = 0; n < EPG; ++n) { const float e = el[r * EPG + n] + reb[gi[r] * EPG + n];
                if (e > m0) { m1 = m0; i1 = i0; m0 = e; i0 = n; } else if (e > m1) { m1 = e; i1 = n; } }
            const float e1 = __expf(m1 - m0), w0 = 1.0f / (1.0f + e1), w1 = e1 * w0;
            if (lane == 0 && (r == 0 || two)) {
                const int li = cx.wave * RPW + it + r;
                rt_row[li] = row0 + r * NGW; rt_e[2 * li] = gi[r] * EPG + i0; rt_e[2 * li + 1] = gi[r] * EPG + i1; rt_g[2 * li] = gtop[r] * w0; rt_g[2 * li + 1] = gtop[r] * w1;
            }
        }
        if (!two) { it += 1; break; }
    }
    if (lane == 0) wave_rows[cx.wave] = it;
    __syncthreads();
    if (rep == 0) {
        if (cx.tid < NE) { int c = 0;
            for (int w = 0; w < NWAVES; ++w) { const int n = wave_rows[w]; for (int i = 0; i < 2 * n; ++i) c += (rt_e[2 * (w * RPW) + i] == cx.tid) ? 1 : 0; }
            rt_base[cx.tid] = c ? atomicAdd(&cnt[cx.tid * CNT_STRIDE], c) : 0; }
        __syncthreads();
        if (cx.tid < 2 * NWAVES * RPW) { const int w = cx.tid / (2 * RPW), i = cx.tid % (2 * RPW);
            if (i < 2 * wave_rows[w]) { const int e = rt_e[cx.tid]; int rank = 0;
                for (int w2 = 0; w2 <= w; ++w2) { const int lim = (w2 < w) ? 2 * wave_rows[w2] : i; for (int q = 0; q < lim; ++q) rank += (rt_e[2 * (w2 * RPW) + q] == e) ? 1 : 0; }
                const int pair = 2 * rt_row[cx.tid >> 1] + (cx.tid & 1);
                perm[e * CAP + rt_base[e] + rank] = pair; gate[pair] = rt_g[cx.tid]; } }
    }
}
__device__ __forceinline__ void ln2_phase(int layer) {
    const ArgsP a = kargs(); const Ctx cx = mkctx(a); const int gw = cx.gw, NGW = cx.NGW, lane = cx.lane;
    unsigned char* ws = cx.ws;
    const bf16* Xin = (const bf16*)(ws + (layer == 0 ? WS_X1B : WS_X3B)); const bf16* YP = (const bf16*)(ws + LYP(layer));
    const float* g = a->ln2_g + layer * D; const float* b = a->ln2_b + layer * D;
    f32x4 gg[4], bb[4];
#pragma unroll
    for (int j = 0; j < 4; ++j) { gg[j] = *(const f32x4*)(g + 256 * j + 4 * lane); bb[j] = *(const f32x4*)(b + 256 * j + 4 * lane); }
    v2u nx[4], ny0[4], ny1[4];
    if (gw < T) {
#pragma unroll
        for (int j = 0; j < 4; ++j) { const size_t c = 256 * j + 4 * lane;
            nx[j] = *(const v2u*)(Xin + (size_t)gw * D + c); ny0[j] = *(const v2u*)(YP + (size_t)(2 * gw) * D + c); ny1[j] = *(const v2u*)(YP + (size_t)(2 * gw + 1) * D + c); }
    }
#pragma unroll 1
    for (int row = gw; row < T; row += NGW) {
        f32x4 v[4];
#pragma unroll
        for (int j = 0; j < 4; ++j) { const v2u xw = nx[j], y0 = ny0[j], y1 = ny1[j];
            v[j].x = ALPHA * bflo(xw.x) + (bflo(y0.x) + bflo(y1.x)); v[j].y = ALPHA * bfhi(xw.x) + (bfhi(y0.x) + bfhi(y1.x));
            v[j].z = ALPHA * bflo(xw.y) + (bflo(y0.y) + bflo(y1.y)); v[j].w = ALPHA * bfhi(xw.y) + (bfhi(y0.y) + bfhi(y1.y)); }
        if (row + NGW < T) { const int r2 = row + NGW;
#pragma unroll
            for (int j = 0; j < 4; ++j) { const size_t c = 256 * j + 4 * lane;
                nx[j] = *(const v2u*)(Xin + (size_t)r2 * D + c); ny0[j] = *(const v2u*)(YP + (size_t)(2 * r2) * D + c); ny1[j] = *(const v2u*)(YP + (size_t)(2 * r2 + 1) * D + c); }
        }
        ln_rows(v, gg, bb);
        if (layer == 0) {
#pragma unroll
            for (int j = 0; j < 4; ++j) { v2u w; w.x = pk2(v[j].x, v[j].y); w.y = pk2(v[j].z, v[j].w); *(v2u*)((bf16*)(ws + WS_X2B) + (size_t)row * D + 256 * j + 4 * lane) = w; }
        } else {
#pragma unroll
            for (int j = 0; j < 4; ++j) *(f32x4*)(a->out + (size_t)row * D + 256 * j + 4 * lane) = v[j];
        }
    }
}
__device__ __forceinline__ void conv_phase() {
    const ArgsP a = kargs(); const Ctx cx = mkctx(a); const int gtid = cx.bx * NTHREADS + cx.tid, NGT = cx.G * NTHREADS;
    unsigned char* ws = cx.ws;
    const bf16* GB = (const bf16*)(ws + WS_GB); const bf16* U = (const bf16*)(ws + WS_U); bf16* A2 = (bf16*)(ws + WS_A2);
    for (int it = gtid; it < T * (D / 8); it += NGT) {
        const int t = it >> 7, d0 = (it & 127) * 8, s = t & (SEQ - 1);
        const size_t o = (size_t)t * D + d0;
        const v4u g = *(const v4u*)(GB + o), u0 = *(const v4u*)(U + o);
        v4u u1 = (v4u){0u, 0u, 0u, 0u}, u2 = u1;
        if (s >= 1) u1 = *(const v4u*)(U + o - D);
        if (s >= 2) u2 = *(const v4u*)(U + o - 2 * D);
        v4u r;
#pragma unroll
        for (int q = 0; q < 4; ++q) {
            const int d = d0 + 2 * q;
            const float c0 = a->a_conv_w[d] * bflo(u2[q]) + a->a_conv_w[D + d] * bflo(u1[q]) + a->a_conv_w[2 * D + d] * bflo(u0[q]);
            const float c1 = a->a_conv_w[d + 1] * bfhi(u2[q]) + a->a_conv_w[D + d + 1] * bfhi(u1[q]) + a->a_conv_w[2 * D + d + 1] * bfhi(u0[q]);
            r[q] = pk2(bflo(g[q]) * c0, bfhi(g[q]) * c1);
        }
        *(v4u*)(A2 + o) = r;
    }
}
__device__ __forceinline__ void combine_phase() {
    const ArgsP a = kargs(); const Ctx cx = mkctx(a); const int gw = cx.gw, NGW = cx.NGW, lane = cx.lane;
    unsigned char* ws = cx.ws;
    const bf16* O0 = (const bf16*)(ws + WS_O0); const bf16* O1 = (const bf16*)(ws + WS_O1); bf16* A3 = (bf16*)(ws + WS_A3);
    const float l01 = wave_sum(a->b_lambda[lane] * a->b_lambda[64 + lane]), l23 = wave_sum(a->b_lambda[128 + lane] * a->b_lambda[192 + lane]);
    const float lam = __expf(l01) - __expf(l23) + LAM_INIT;
    float gsc[16];
#pragma unroll
    for (int i = 0; i < 16; ++i) gsc[i] = a->b_subln_g[(lane & 7) * 16 + i] * (1.0f - LAM_INIT);
    for (int row = gw; row < T; row += NGW) {
        const size_t o = (size_t)row * D + lane * 16;
        const v4u p0 = *(const v4u*)(O0 + o), p1 = *(const v4u*)(O0 + o + 8), q0 = *(const v4u*)(O1 + o), q1 = *(const v4u*)(O1 + o + 8);
        float d[16]; float ss = 0.f;
#pragma unroll
        for (int i = 0; i < 4; ++i) { d[2 * i] = bflo(p0[i]) - lam * bflo(q0[i]); d[2 * i + 1] = bfhi(p0[i]) - lam * bfhi(q0[i]);
            d[8 + 2 * i] = bflo(p1[i]) - lam * bflo(q1[i]); d[8 + 2 * i + 1] = bfhi(p1[i]) - lam * bfhi(q1[i]); }
#pragma unroll
        for (int i = 0; i < 16; ++i) ss += d[i] * d[i];
        ss += __shfl_xor(ss, 1); ss += __shfl_xor(ss, 2); ss += __shfl_xor(ss, 4);
        const float r = 1.0f / sqrtf(ss * (1.0f / 128.0f) + RMS_EPS);
        v4u w0, w1;
#pragma unroll
        for (int i = 0; i < 4; ++i) { w0[i] = pk2(d[2 * i] * r * gsc[2 * i], d[2 * i + 1] * r * gsc[2 * i + 1]); w1[i] = pk2(d[8 + 2 * i] * r * gsc[8 + 2 * i], d[8 + 2 * i + 1] * r * gsc[8 + 2 * i + 1]); }
        *(v4u*)(A3 + o) = w0; *(v4u*)(A3 + o + 8) = w1;
    }
}

#ifndef MKMASK
#define MKMASK 0xffff
#endif
#ifndef MKREP
#define MKREP 0
#endif
#ifndef MKSYNC
#define MKSYNC 0
#endif
#ifndef MKMASK2
#define MKMASK2 MKMASK
#endif
#define PH(k) _Pragma("unroll 1") for (int rep_ = 0; rep_ < (int)(((pass_ ? MKMASK2 : MKMASK) >> (k)) & 1) + (int)((MKREP >> (k)) & 1); ++rep_)
#define XB_TMO      128
#define XB_XCNT(j)  (256  + 64 * (j))
#define XB_XSUB(j)  (1280 + 64 * (j))
#define XB_XGEN(j)  (2304 + 64 * (j))
#define XB_TOP      3328
#define XB_TOPGEN   3392
#define XCD_BAR_WORDS 3456
#define XB_SPIN_CAP (1u << 18)

__device__ __forceinline__ unsigned xb_ld(unsigned* p)              { return __hip_atomic_load(p, __ATOMIC_RELAXED, __HIP_MEMORY_SCOPE_AGENT); }
__device__ __forceinline__ unsigned xb_add(unsigned* p, unsigned v) { return __hip_atomic_fetch_add(p, v, __ATOMIC_RELAXED, __HIP_MEMORY_SCOPE_AGENT); }
__device__ __forceinline__ unsigned xb_xcc_id() { return (unsigned)__builtin_amdgcn_s_getreg((3 << 11) | 20) & 0xFu; }
#define XB_SPIN(cond, bar) do { unsigned _sp = 0; while (cond) { __builtin_amdgcn_s_sleep(1); \
    if ((++_sp & 255u) == 0u) { if (xb_ld(&(bar)[XB_TMO])) break; if (_sp > XB_SPIN_CAP) { atomicAdd(&(bar)[XB_TMO], 1u); break; } } } } while (0)

struct XcdBarrier {
    unsigned* bar; unsigned x;
    volatile LAS unsigned* st;
};

__device__ __forceinline__ XcdBarrier xcd_barrier_post(unsigned* bar, volatile LAS unsigned* st) {
    XcdBarrier b; b.bar = bar; b.x = xb_xcc_id(); b.st = st;
    if (threadIdx.x == 0) (void)xb_add(&bar[XB_XCNT(b.x)], 1u);
    return b;
}
__device__ __forceinline__ void xcd_barrier_complete(unsigned* bar, unsigned x, unsigned& nloc, unsigned& nx) {
    const unsigned G = gridDim.x * gridDim.y * gridDim.z;
    unsigned sum, cnt, mine, sp = 0u;
    for (;;) {
        sum = 0u; cnt = 0u; mine = 0u;
#pragma unroll
        for (unsigned j = 0; j < 16; ++j) { const unsigned c = xb_ld(&bar[XB_XCNT(j)]); sum += c; cnt += (c > 0u) ? 1u : 0u; mine = (j == x) ? c : mine; }
        if (sum == G) break;
        __builtin_amdgcn_s_sleep(1);
        if ((++sp & 255u) == 0u) { if (xb_ld(&bar[XB_TMO])) break; if (sp > XB_SPIN_CAP) { atomicAdd(&bar[XB_TMO], 1u); break; } }
    }
    nloc = mine > 0u ? mine : 1u; nx = cnt > 0u ? cnt : 1u;
}

__device__ __forceinline__ void xcd_barrier(const XcdBarrier& b) {
    asm volatile("s_waitcnt vmcnt(0)" ::: "memory");
    __syncthreads();
    if (threadIdx.x == 0) {
        unsigned* bar = b.bar;
        __builtin_amdgcn_s_waitcnt(0);
        unsigned nloc = b.st[0], nx = b.st[1];
        if (nloc == 0u) { xcd_barrier_complete(bar, b.x, nloc, nx); b.st[0] = nloc; b.st[1] = nx; }
        const unsigned old = xb_add(&bar[XB_XSUB(b.x)], 1u);
        const unsigned gen = old / nloc;
        if (old + 1u == (gen + 1u) * nloc) {
            __builtin_amdgcn_fence(__ATOMIC_RELEASE, "agent");
            asm volatile("s_waitcnt vmcnt(0)" ::: "memory");
            const unsigned og = xb_add(&bar[XB_TOP], 1u);
            const unsigned tg = og / nx;
            if (og + 1u == (tg + 1u) * nx) xb_add(&bar[XB_TOPGEN], 1u);
            else XB_SPIN(xb_ld(&bar[XB_TOPGEN]) == tg, bar);
            __builtin_amdgcn_fence(__ATOMIC_ACQUIRE, "agent");
            xb_add(&bar[XB_XGEN(b.x)], 1u);
            asm volatile("s_waitcnt vmcnt(0)" ::: "memory");
        } else {
            XB_SPIN(xb_ld(&bar[XB_XGEN(b.x)]) == gen, bar);
            __builtin_amdgcn_fence(__ATOMIC_ACQUIRE, "agent");
            asm volatile("s_waitcnt vmcnt(0)" ::: "memory");
        }
    }
    __syncthreads();
}

constexpr int CW_BAR = 8192;
constexpr int ST_OFF = MISC_OFF + 1024;
__device__ __forceinline__ void seam(LAS unsigned char* lds) { const ArgsP a = kargs(); XcdBarrier b; b.bar = (unsigned*)(a->ws + WS_CTL) + CW_BAR; b.x = xb_xcc_id(); b.st = (volatile LAS unsigned*)(lds + ST_OFF); xcd_barrier(b); }
__device__ __forceinline__ void gemm1_phase(LAS unsigned char* lds) { const ArgsP a = kargs(); const Ctx cx = mkctx(a); unsigned char* ws = cx.ws;
    const int ng = ROLE_SPLIT ? cx.G - cx.G / 4 : cx.G;
    if (cx.bx < ng) { SchedDense S{ng, cx.bx, 12, 0, D, (const char*)(ws + WS_W1T)}; EpiConvIn E{(bf16*)(ws + WS_GB), (bf16*)(ws + WS_U)};
        pg8::gemm_phase(lds, (const char*)(ws + WS_XB), D, S, E); }
    else p0_items(lds, PS1 + P0A_EXTRA, P0_NITEMS, (cx.bx - ng) * NWAVES + cx.wave, (cx.G - ng) * NWAVES); }
__device__ __forceinline__ void gemm2_phase(LAS unsigned char* lds) { const ArgsP a = kargs(); const Ctx cx = mkctx(a); unsigned char* ws = cx.ws;
    SchedDense S{cx.G, cx.bx, 4, 1, D, (const char*)(ws + WS_W2T)}; EpiResZ<false> E{(const void*)a->x, (float*)(ws + LZ(0))};
    pg8::gemm_phase(lds, (const char*)(ws + WS_A2), D, S, E); }
__device__ __forceinline__ void kvq_phase(LAS unsigned char* lds) { const ArgsP a = kargs(); const Ctx cx = mkctx(a); unsigned char* ws = cx.ws;
    SchedDense S{cx.G, cx.bx, 12, 1, D, (const char*)(ws + WS_WKVQ)}; EpiKVQ E{(bf16*)(ws + WS_K)};
    pg8::gemm_phase(lds, (const char*)(ws + WS_X2B), D, S, E); }
__device__ __forceinline__ void wo_phase(LAS unsigned char* lds) { const ArgsP a = kargs(); const Ctx cx = mkctx(a); unsigned char* ws = cx.ws;
    SchedDense S{cx.G, cx.bx, 4, 1, D, (const char*)(ws + WS_WOT)}; EpiResZ<true> E{(const void*)(ws + WS_X2B), (float*)(ws + LZ(1))};
    pg8::gemm_phase(lds, (const char*)(ws + WS_A3), D, S, E); }
__device__ __forceinline__ void attn_phase(char* lds_generic) { const ArgsP a = kargs(); const Ctx cx = mkctx(a); unsigned char* ws = cx.ws;
#pragma unroll 1
    for (int uix = cx.bx; uix < BATCH * NH * 4 * (SEQ / 256); uix += cx.G) {
        const int combo = uix & 255, qi = uix >> 8;
        const int b = combo >> 5, h = (combo >> 2) & 7, c = (combo >> 1) & 1, vh = combo & 1;
        const int qb = (qi & 1) ? (SEQ / 256 - 1 - (qi >> 1)) : (qi >> 1);
        const attn_body::bf16* QK = (const attn_body::bf16*)(ws + WS_K) + h * 128 + c * 64;
        const attn_body::bf16* Vc = (const attn_body::bf16*)(ws + WS_V) + h * 128 + vh * 64;
        attn_body::bf16* Oc = (attn_body::bf16*)(ws + (c ? WS_O1 : WS_O0)) + h * 128 + vh * 64;
        attn_body::attn_unit<8>((long)b * SEQ, qb, QK + (WS_Q - WS_K) / 2, QK, Vc, Oc, lds_generic);
    }
}
__device__ __forceinline__ void moe_tables(LAS unsigned char* lds, int layer) { const ArgsP a = kargs(); const Ctx cx = mkctx(a); LAS int* misc = (LAS int*)(lds + MISC_OFF);
    const int* cnt = (const int*)(cx.ws + WS_CTL) + layer * NE * CNT_STRIDE;
    if (cx.tid < NE) misc[128 + cx.tid] = __hip_atomic_load(cnt + cx.tid * CNT_STRIDE, __ATOMIC_RELAXED, __HIP_MEMORY_SCOPE_AGENT);
    __syncthreads();
    if (cx.tid == 0) { int ub = 0, ps = 0; for (int e = 0; e < NE; ++e) { misc[e] = ub; misc[64 + e] = ps; const int rt = (misc[128 + e] + 255) >> 8; ub += 4 * rt; ps += 256 * rt; } misc[NE] = ub; misc[64 + NE] = ps; }
    __syncthreads(); }
__device__ __forceinline__ void moe_up_phase(LAS unsigned char* lds, int layer) { const ArgsP a = kargs(); const Ctx cx = mkctx(a); unsigned char* ws = cx.ws; LAS int* misc = (LAS int*)(lds + MISC_OFF);
    const MoeTab tb{misc, misc + 64, misc + 128};
    SchedMoe S{cx.G, cx.bx, D, true, (const char*)(ws + WS_WUT) + (size_t)layer * NE * D * D * 2, (const int*)(ws + LPERM(layer)), tb}; EpiUp E{(bf16*)(ws + LACT(layer))};
    pg8::gemm_phase(lds, (const char*)(ws + (layer == 0 ? WS_X1B : WS_X3B)), D, S, E); }
__device__ __forceinline__ void moe_down_phase(LAS unsigned char* lds, int layer) { const ArgsP a = kargs(); const Ctx cx = mkctx(a); unsigned char* ws = cx.ws; LAS int* misc = (LAS int*)(lds + MISC_OFF);
    const MoeTab tb{misc, misc + 64, misc + 128};
    SchedMoe S{cx.G, cx.bx, DE, false, (const char*)(ws + WS_WDT) + (size_t)layer * NE * D * DE * 2, (const int*)(ws + LPERM(layer)), tb};
    EpiDown E{(bf16*)(ws + LYP(layer)), (const int*)(ws + LPERM(layer)), (const float*)(ws + LGATE(layer))};
    pg8::gemm_phase(lds, (const char*)(ws + LACT(layer)), DE, S, E); }

__global__ void __launch_bounds__(NTHREADS, 2) fwd_megakernel(Args args_unused) {
    extern __shared__ __attribute__((aligned(16))) unsigned char lds_raw[];
#ifdef NOSYNC
    struct { __device__ void sync() const {} } grid;
#else
    cg::grid_group grid = cg::this_grid();
#endif
#define SEAM() seam(lds)
    LAS unsigned char* lds = (LAS unsigned char*)lds_raw;
#ifndef MKPASS
#define MKPASS 1
#endif
    { const ArgsP a = kargs(); int t = threadIdx.x; asm volatile("" : "+v"(t));
      if (t < 2) ((volatile LAS unsigned*)(lds + ST_OFF))[t] = 0u;
      if (blockIdx.x == 0) { unsigned* ctl = (unsigned*)(a->ws + WS_CTL); for (int i = t; i < CW_BAR + XCD_BAR_WORDS; i += NTHREADS) ctl[i] = 0u; } }
    __syncthreads();
#pragma unroll 1
    for (int pass_ = 0; pass_ < MKPASS; ++pass_) {
    if (pass_) SEAM();
    PH(0) p0_prologue(lds);
    if (pass_ == 0) { grid.sync();
      const ArgsP a = kargs(); (void)xcd_barrier_post((unsigned*)(a->ws + WS_CTL) + CW_BAR, (volatile LAS unsigned*)(lds + ST_OFF)); }
    else SEAM();
    PH(1) gemm1_phase(lds);
    SEAM();
    PH(2) conv_phase();
    SEAM();
    PH(3) gemm2_phase(lds);
    SEAM();
    PH(8) ln_router_phase(lds, 0, rep_ + pass_);
    SEAM();
    moe_tables(lds, 0);
    PH(9) { moe_up_phase(lds, 0); if (P0B_FILL && pass_ == 0) p0b_idle_fill(lds, 0, P0B_SPLIT); }
    SEAM();
    PH(10) { moe_down_phase(lds, 0); if (P0B_FILL && pass_ == 0) p0b_idle_fill(lds, P0B_SPLIT, P0B_ITEMS); }
    SEAM();
    PH(11) ln2_phase(0);
    SEAM();
    PH(4) kvq_phase(lds);
    SEAM();
    PH(5) attn_phase((char*)lds_raw);
    SEAM();
    PH(6) combine_phase();
    SEAM();
    PH(7) wo_phase(lds);
    SEAM();
    PH(8) ln_router_phase(lds, 1, rep_ + pass_);
    SEAM();
    moe_tables(lds, 1);
    PH(9) moe_up_phase(lds, 1);
    SEAM();
    PH(10) moe_down_phase(lds, 1);
    SEAM();
    PH(11) ln2_phase(1);
    }
#pragma unroll 1
    for (int i = 0; i < MKSYNC; ++i) SEAM();
}
}

extern "C" void kernel_launch(void* const* d_in, const int* in_sizes, int n_in, void* d_out, int out_size, void* d_ws, size_t ws_size, hipStream_t stream) {
    using namespace mk;
    static int grid = 0;
    if (grid == 0) {
        if (n_in != 19 || out_size != T * D || ws_size < WS_END) { fprintf(stderr, "kernel_launch: unexpected shapes / workspace (n_in %d out %d ws %zu, need %zu)\n", n_in, out_size, ws_size, (size_t)WS_END); grid = -1; return; }
        int dev = 0, cus = 0, per_cu = 0;
        (void)hipGetDevice(&dev); (void)hipDeviceGetAttribute(&cus, hipDeviceAttributeMultiprocessorCount, dev);
        if (hipFuncSetAttribute((const void*)fwd_megakernel, hipFuncAttributeMaxDynamicSharedMemorySize, LDS_BYTES) != hipSuccess) { fprintf(stderr, "kernel_launch: hipFuncSetAttribute failed\n"); grid = -1; return; }
        if (hipOccupancyMaxActiveBlocksPerMultiprocessor(&per_cu, (const void*)fwd_megakernel, NTHREADS, LDS_BYTES) != hipSuccess || per_cu < 1) { fprintf(stderr, "kernel_launch: occupancy query says %d blocks per CU\n", per_cu); grid = -1; return; }
        grid = cus * 1;
        (void)hipGetLastError();
    }
    if (grid < 0) return;
    Args a{};
    a.x = (const float*)d_in[0]; a.a_w_in = (const float*)d_in[1]; a.a_conv_w = (const float*)d_in[2]; a.a_w_out = (const float*)d_in[3]; a.kv_w = (const float*)d_in[4];
    a.b_w_q = (const float*)d_in[5]; a.b_lambda = (const float*)d_in[6]; a.b_subln_g = (const float*)d_in[7]; a.b_w_o = (const float*)d_in[8];
    a.ln1_g = (const float*)d_in[9]; a.ln1_b = (const float*)d_in[10]; a.ln2_g = (const float*)d_in[11]; a.ln2_b = (const float*)d_in[12];
    a.rg_w = (const float*)d_in[13]; a.rg_b = (const float*)d_in[14]; a.re_w = (const float*)d_in[15]; a.re_b = (const float*)d_in[16];
    a.e_w_in = (const float*)d_in[17]; a.e_w_down = (const float*)d_in[18];
    a.out = (float*)d_out; a.ws = (unsigned char*)d_ws;
    void* kargs[] = {&a};
    const hipError_t e = hipLaunchCooperativeKernel((const void*)fwd_megakernel, dim3(grid), dim3(NTHREADS), kargs, LDS_BYTES, stream);
    if (e != hipSuccess) fprintf(stderr, "kernel_launch: cooperative launch failed: %s (grid %d)\n", hipGetErrorString(e), grid);
}
```

```cpp
#include <hip/hip_runtime.h>
#include <hip/hip_cooperative_groups.h>
#include <cstdio>
#include <cstdint>
namespace cg = cooperative_groups;

namespace pg8 {
#define PG8_LAS __attribute__((address_space(3)))
typedef unsigned short bf16_t;
typedef short bf16x8 __attribute__((ext_vector_type(8)));
typedef float f32x4 __attribute__((ext_vector_type(4)));
typedef unsigned u32x4 __attribute__((ext_vector_type(4)));
typedef unsigned u32x2 __attribute__((ext_vector_type(2)));
constexpr int BM = 256, BK = 64, HALF = 128, HTB = HALF * BK * 2  , STAGE_BYTES = 8 * HTB, NXCD = 8, WGM = 8;

__host__ __device__ __forceinline__ int lds_byte(int r, int c) { const int st = (r >> 4) * 2 + (c >> 5), rr = r & 15, cc = c & 31, ob = rr * 64 + cc * 2; return st * 1024 + (ob ^ (((ob >> 9) & 1) << 5)); }
__host__ __device__ __forceinline__ void stage_rc(int b, int& R, int& C) { const int st = b / 1024, sb = b % 1024, swz = sb ^ (((sb >> 9) & 1) << 5); R = (st >> 1) * 16 + swz / 64; C = (st & 1) * 32 + (swz % 64) / 2; }
__host__ __device__ __forceinline__ int perm32(int rho) { const int n = rho >> 4, i = rho & 15; return 8 * (i >> 2) + 4 * n + (i & 3); }

struct Unit { const char* b0; const char* b1; int arow; int p0, p1, p2, p3; };

__device__ __forceinline__ bool static_tile(int i, int G, int c, int nM, int nN, int& pm, int& pn) {
    const int nwg = nM * nN; const long L = (long)i * G + c; if (L >= nwg) return false;
    int wgid = (int)L; { const int q = nwg / NXCD, r = nwg % NXCD, xcd = wgid % NXCD, off = wgid / NXCD; wgid = (xcd < r ? xcd * (q + 1) : r * (q + 1) + (xcd - r) * q) + off; }
    const int nig = WGM * nN, gid = wgid / nig, fm = gid * WGM, gsz = (nM - fm) < WGM ? (nM - fm) : WGM;
    pm = fm + ((wgid % nig) % gsz); pn = (wgid % nig) / gsz; return true;
}

__device__ __forceinline__ unsigned cvt_pk_bf16(float lo, float hi) { unsigned r; asm volatile("v_cvt_pk_bf16_f32 %0, %1, %2" : "=v"(r) : "v"(lo), "v"(hi)); return r; }

template <class Epi, class Sched>
__device__ __forceinline__ void gemm_phase(PG8_LAS unsigned char* lds, const char* Abase, const int K, const Sched& S, const Epi& E) {
    int tid_ = threadIdx.x; asm volatile("" : "+v"(tid_));
    const int tid = tid_, wid = __builtin_amdgcn_readfirstlane(tid >> 6), lane = tid & 63, wr = wid >> 2, wc = wid & 3, fr = lane & 15, fq = lane >> 4;
    const int nt = K / BK;
    int R[2], C[2]; unsigned voffB[2];
#pragma unroll
    for (int i = 0; i < 2; ++i) { stage_rc(tid * 16 + i * 8192, R[i], C[i]); const int Rb = Epi::PERM ? ((R[i] & ~31) + perm32(R[i] & 31)) : R[i]; voffB[i] = (unsigned)(Rb * K + C[i]) * 2u; }
    const size_t kstep = (size_t)(BK * 2);
    const unsigned ldsw = (unsigned)wid * 1024u;
    const int aoff = lds_byte(wr * 64 + fr, fq * 8), boff = lds_byte(wc * 32 + fr, fq * 8);
#define PG8_SA(b, h) (((b) * 2 + (h)) * HTB)
#define PG8_SB(b, h) ((4 + (b) * 2 + (h)) * HTB)
#define PG8_STAGE(bufoff, gbase, v0, v1) do { \
        __builtin_amdgcn_global_load_lds((const unsigned*)((const char*)(gbase) + (v0)), (PG8_LAS unsigned*)(lds + (bufoff) + ldsw), 16, 0, 0); \
        __builtin_amdgcn_global_load_lds((const unsigned*)((const char*)(gbase) + (v1)), (PG8_LAS unsigned*)(lds + (bufoff) + ldsw + 8192), 16, 0, 0); } while (0)
#define PG8_STAGEB(bufoff, gbase) PG8_STAGE(bufoff, gbase, voffB[0], voffB[1])
#define PG8_LDA(dst, b, h) do { _Pragma("unroll") for (int m = 0; m < 4; ++m) _Pragma("unroll") for (int k = 0; k < 2; ++k) dst[m][k] = *(const PG8_LAS bf16x8*)(lds + PG8_SA(b, h) + aoff + m * 2048 + k * 1024); } while (0)
#define PG8_LDB(dst, b, h) do { _Pragma("unroll") for (int n = 0; n < 2; ++n) _Pragma("unroll") for (int k = 0; k < 2; ++k) dst[n][k] = *(const PG8_LAS bf16x8*)(lds + PG8_SB(b, h) + boff + n * 2048 + k * 1024); } while (0)
#define PG8_MMA(ai, bj, At, Bt) do { __builtin_amdgcn_s_setprio(1); _Pragma("unroll") for (int m = 0; m < 4; ++m) _Pragma("unroll") for (int n = 0; n < 2; ++n) _Pragma("unroll") for (int k = 0; k < 2; ++k) \
        acc[ai][bj][m][n] = __builtin_amdgcn_mfma_f32_16x16x32_bf16(Bt[n][k], At[m][k], acc[ai][bj][m][n], 0, 0, 0); __builtin_amdgcn_s_setprio(0); } while (0)
#define PG8_WAIT_V(n) asm volatile("s_waitcnt vmcnt(" #n ")" ::: "memory")
#define PG8_WAIT_L(n) asm volatile("s_waitcnt lgkmcnt(" #n ")" ::: "memory")
#define PG8_BAR __builtin_amdgcn_s_barrier()
#define PG8_SCHED __builtin_amdgcn_sched_barrier(0)
    Unit cur, nxt; int ui = 0;
    if (!S.next(0, cur)) return;
    f32x4 acc[2][2][4][2];
#pragma unroll
    for (int a = 0; a < 2; ++a)
#pragma unroll
        for (int b = 0; b < 2; ++b)
#pragma unroll
            for (int m = 0; m < 4; ++m)
#pragma unroll
                for (int n = 0; n < 2; ++n) acc[a][b][m][n] = (f32x4){0.f, 0.f, 0.f, 0.f};
    bf16x8 At[4][2], B0[2][2], B1[2][2];
    unsigned vA00, vA01, vA10, vA11, vN00, vN01, vN10, vN11;
    S.a_ready(cur, S.peek(cur));
    S.a_offs(cur, R, C, vA00, vA01, vA10, vA11);
    const char* cB0 = cur.b0; const char* cB1 = cur.b1;
    PG8_STAGEB(PG8_SB(0, 0), cB0); PG8_STAGEB(PG8_SB(0, 1), cB1); PG8_STAGE(PG8_SA(0, 0), Abase, vA00, vA01); PG8_STAGE(PG8_SA(0, 1), Abase, vA10, vA11);
    if (wr == 1) PG8_BAR;
    PG8_WAIT_V(2); PG8_BAR;
    PG8_STAGEB(PG8_SB(1, 0), cB0 + kstep); PG8_STAGE(PG8_SA(1, 0), Abase + kstep, vA00, vA01); PG8_STAGEB(PG8_SB(1, 1), cB1 + kstep);
    PG8_WAIT_V(6); PG8_BAR;
    for (;;) {
        const bool has_next = S.next(ui + 1, nxt);
        if (has_next) S.a_offs(nxt, R, C, vN00, vN01, vN10, vN11); else { vN00 = vA00; vN01 = vA01; vN10 = vA10; vN11 = vA11; }
        const char* nB0 = has_next ? nxt.b0 : cB0; const char* nB1 = has_next ? nxt.b1 : cB1;
        const unsigned pk = has_next ? S.peek(nxt) : 0u;
        const bool skip1 = S.half_only(cur);
        for (int t = 0; t < nt; t += 2) {
            const bool last = (t == nt - 2);
            if (last && has_next) S.a_ready(nxt, pk);
            const char* a1 = Abase + (size_t)(t + 1) * kstep;
            PG8_LDB(B0, 0, 0); PG8_LDB(B1, 0, 1); PG8_SCHED; PG8_LDA(At, 0, 0); PG8_STAGE(PG8_SA(1, 1), a1, vA10, vA11);
            PG8_WAIT_V(8); PG8_WAIT_L(0); PG8_BAR; PG8_MMA(0, 0, At, B0); PG8_MMA(0, 1, At, B1); PG8_BAR; PG8_SCHED;
            if (last) { vA00 = vN00; vA01 = vN01; vA10 = vN10; vA11 = vN11; }
            const char* a2 = last ? Abase : Abase + (size_t)(t + 2) * kstep;
            const char* b20 = last ? nB0 : cB0 + (size_t)(t + 2) * kstep; const char* b21 = last ? nB1 : cB1 + (size_t)(t + 2) * kstep;
            const char* a3 = a2 + kstep; const char* b30 = b20 + kstep; const char* b31 = b21 + kstep;
            PG8_LDA(At, 0, 1); PG8_STAGEB(PG8_SB(0, 0), b20); PG8_STAGEB(PG8_SB(0, 1), b21); PG8_STAGE(PG8_SA(0, 0), a2, vA00, vA01);
            PG8_WAIT_V(8); PG8_WAIT_L(0); PG8_BAR; if (!skip1) { PG8_MMA(1, 0, At, B0); PG8_MMA(1, 1, At, B1); } PG8_BAR; PG8_SCHED;
            PG8_LDB(B0, 1, 0); PG8_LDB(B1, 1, 1); PG8_SCHED; PG8_LDA(At, 1, 0); PG8_STAGE(PG8_SA(0, 1), a2, vA10, vA11);
            PG8_WAIT_V(8); PG8_WAIT_L(0); PG8_BAR; PG8_MMA(0, 0, At, B0); PG8_MMA(0, 1, At, B1); PG8_BAR; PG8_SCHED;
            PG8_LDA(At, 1, 1); PG8_STAGEB(PG8_SB(1, 0), b30); PG8_STAGEB(PG8_SB(1, 1), b31); PG8_STAGE(PG8_SA(1, 0), a3, vA00, vA01);
            PG8_WAIT_V(8); PG8_WAIT_L(0); PG8_BAR; if (!skip1) { PG8_MMA(1, 0, At, B0); PG8_MMA(1, 1, At, B1); } PG8_BAR; PG8_SCHED;
        }
        if (wr == 0) PG8_BAR;
        E(acc, cur, wr, wc, fr, fq);
        S.done(cur);
        if (!has_next) break;
#pragma unroll
        for (int a = 0; a < 2; ++a)
#pragma unroll
            for (int b = 0; b < 2; ++b)
#pragma unroll
                for (int m = 0; m < 4; ++m)
#pragma unroll
                    for (int n = 0; n < 2; ++n) acc[a][b][m][n] = (f32x4){0.f, 0.f, 0.f, 0.f};
        cur = nxt; cB0 = nB0; cB1 = nB1; ++ui;
        if (wr == 1) PG8_BAR;
    }
    PG8_WAIT_V(0);
    PG8_BAR;
#undef PG8_SA
#undef PG8_SB
#undef PG8_STAGE
#undef PG8_STAGEB
#undef PG8_LDA
#undef PG8_LDB
#undef PG8_MMA
#undef PG8_WAIT_V
#undef PG8_WAIT_L
#undef PG8_BAR
#undef PG8_SCHED
}
}
#include <hip/hip_bf16.h>
#include <cmath>
namespace attn_body {
using bf16=__hip_bfloat16;
using bf16x8=__attribute__((ext_vector_type(8)))short;
using s16x4=__attribute__((ext_vector_type(4)))short;
using f32x16=__attribute__((ext_vector_type(16)))float;
using u32x4=__attribute__((ext_vector_type(4)))unsigned;
constexpr int D=64,DM=1024;
constexpr int NW=8,QBLK=32,QB=QBLK*NW,KVBLK=64;
constexpr int ATTN_PITCH=DM, ATTN_UNIT_ROWS=QB;
__device__ __forceinline__ int crow(int r,int hi){return (r&3)+8*(r>>2)+4*hi;}
#define SBAR() __builtin_amdgcn_sched_barrier(0)
__device__ __forceinline__ void cmask(f32x16&p0,f32x16&p1,int jb,int qrel,int hi){
  const float NEG=-INFINITY; int kb=64*jb+4*hi;
  #pragma unroll
  for(int r=0;r<16;++r){int kv=kb+(r&3)+8*(r>>2); if(kv>qrel)p0[r]=NEG; if(kv+32>qrel)p1[r]=NEG;}
}

constexpr int NSLOT=3, SLOTB=8192;
constexpr int LDS_K=0, LDS_V=NSLOT*SLOTB, LDS_WS=2*NSLOT*SLOTB, LDS_OST=LDS_WS+NW*64*4, LDS_BYTES=LDS_OST+NW*4096;
constexpr float C2=0.125f*1.4426950408889634f;
__device__ __forceinline__ void glds16(const void*gsrc,unsigned lds_dst){unsigned keep;
  asm volatile("s_mov_b32 %0, m0\n\ts_mov_b32 m0, %2\n\ts_nop 0\n\tglobal_load_lds_dwordx4 %1, off\n\ts_mov_b32 m0, %0":"=&s"(keep):"v"(gsrc),"s"(lds_dst):"memory");}
__device__ __forceinline__ void glds16s(const void*sbase,unsigned voff,unsigned lds_dst){unsigned keep;
  asm volatile("s_mov_b32 %0, m0\n\ts_mov_b32 m0, %3\n\ts_nop 4\n\tglobal_load_lds_dwordx4 %1, %2\n\ts_mov_b32 m0, %0":"=&s"(keep):"v"(voff),"s"(sbase),"s"(lds_dst):"memory");}
__device__ __forceinline__ float max3f(float a,float b,float c){float r;asm("v_max3_f32 %0, %1, %2, %3":"=v"(r):"v"(a),"v"(b),"v"(c));return r;}
__device__ __forceinline__ float max2f(float a,float b){float r;asm("v_max_f32_e32 %0, %1, %2":"=v"(r):"v"(a),"v"(b));return r;}
__device__ __forceinline__ float fadd_s(float a,float b){float r;asm("v_add_f32_e32 %0, %1, %2":"=v"(r):"v"(a),"v"(b));return r;}
__device__ __forceinline__ float fsub_s(float a,float b){float r;asm("v_sub_f32_e32 %0, %1, %2":"=v"(r):"v"(a),"v"(b));return r;}
typedef float f32x2_t __attribute__((ext_vector_type(2))); typedef __bf16 bf16x2_t __attribute__((ext_vector_type(2)));
__device__ __forceinline__ unsigned cvtpk_s(float lo,float hi){f32x2_t v={lo,hi};bf16x2_t b=__builtin_convertvector(v,bf16x2_t);return __builtin_bit_cast(unsigned,b);}
#define WAIT_BAR(N) asm volatile("s_waitcnt vmcnt(" #N ") lgkmcnt(0)\n\ts_barrier":::"memory")

__device__ __forceinline__ void qkt(f32x16&p0,f32x16&p1,const char*Kslot,const bf16x8*qr,const f32x16&negm,int r32,int hi){
  const char*kb=Kslot+hi*1024+r32*16;
  #pragma unroll
  for(int d0=0;d0<4;++d0){
    const bf16x8 b0=*reinterpret_cast<const bf16x8*>(kb+d0*2048);
    const bf16x8 b1=*reinterpret_cast<const bf16x8*>(kb+d0*2048+512);
    if(d0==0){p0=__builtin_amdgcn_mfma_f32_32x32x16_bf16(b0,qr[0],negm,0,0,0);p1=__builtin_amdgcn_mfma_f32_32x32x16_bf16(b1,qr[0],negm,0,0,0);}
    else{p0=__builtin_amdgcn_mfma_f32_32x32x16_bf16(b0,qr[d0],p0,0,0,0);p1=__builtin_amdgcn_mfma_f32_32x32x16_bf16(b1,qr[d0],p1,0,0,0);}}
}
typedef __attribute__((address_space(3))) const char* lds_cptr;
typedef short v4i16_t __attribute__((ext_vector_type(4)));
__device__ __forceinline__ void kload8(bf16x8*kf,lds_cptr kp){
  kf[0]=*(const __attribute__((address_space(3))) bf16x8*)(kp);      kf[1]=*(const __attribute__((address_space(3))) bf16x8*)(kp+512);
  kf[2]=*(const __attribute__((address_space(3))) bf16x8*)(kp+2048); kf[3]=*(const __attribute__((address_space(3))) bf16x8*)(kp+2560);
  kf[4]=*(const __attribute__((address_space(3))) bf16x8*)(kp+4096); kf[5]=*(const __attribute__((address_space(3))) bf16x8*)(kp+4608);
  kf[6]=*(const __attribute__((address_space(3))) bf16x8*)(kp+6144); kf[7]=*(const __attribute__((address_space(3))) bf16x8*)(kp+6656);
}
__device__ __forceinline__ void kload2(bf16x8*kf,lds_cptr kp,int j){ kf[2*j]=*(const __attribute__((address_space(3))) bf16x8*)(kp+j*2048); kf[2*j+1]=*(const __attribute__((address_space(3))) bf16x8*)(kp+j*2048+512); }
__device__ __forceinline__ s16x4 vtr(lds_cptr p){ return __builtin_bit_cast(s16x4,__builtin_amdgcn_ds_read_tr16_b64_v4i16((__attribute__((address_space(3))) v4i16_t*)p)); }
__device__ __forceinline__ float rowmax(const f32x16&p0,const f32x16&p1){
  float a=max3f(p0[0],p0[1],p1[0]),b=max3f(p0[2],p0[3],p1[1]);a=max3f(a,p1[2],p1[3]);
  #pragma unroll
  for(int r=4;r<16;r+=4){a=max3f(a,p0[r],p0[r+1]);b=max3f(b,p0[r+2],p0[r+3]);a=max3f(a,p1[r],p1[r+1]);b=max3f(b,p1[r+2],p1[r+3]);}
  const float m=max2f(a,b);
  auto rr=__builtin_amdgcn_permlane32_swap(__float_as_uint(m),__float_as_uint(m),false,false);
  return max2f(__uint_as_float(rr[0]),__uint_as_float(rr[1]));
}
__device__ __forceinline__ void pv(f32x16*o,int vb,bf16x8 pa0,bf16x8 pa1,bf16x8 pa2,bf16x8 pa3){
  #pragma unroll
  for(int d0=0;d0<2;++d0){s16x4 lo[4],hi[4];
    #pragma unroll
    for(int ks=0;ks<4;++ks){
      asm volatile("ds_read_b64_tr_b16 %0,%1 offset:%c2":"=&v"(lo[ks]):"v"(vb),"i"(d0*4096+ks*1024):"memory");
      asm volatile("ds_read_b64_tr_b16 %0,%1 offset:%c2":"=&v"(hi[ks]):"v"(vb),"i"(d0*4096+ks*1024+512):"memory");}
    asm volatile("s_waitcnt lgkmcnt(0)":::"memory");SBAR();
    #define PK(k) (bf16x8){lo[k][0],lo[k][1],lo[k][2],lo[k][3],hi[k][0],hi[k][1],hi[k][2],hi[k][3]}
    o[d0]=__builtin_amdgcn_mfma_f32_32x32x16_bf16(pa0,PK(0),o[d0],0,0,0);
    o[d0]=__builtin_amdgcn_mfma_f32_32x32x16_bf16(pa1,PK(1),o[d0],0,0,0);
    o[d0]=__builtin_amdgcn_mfma_f32_32x32x16_bf16(pa2,PK(2),o[d0],0,0,0);
    o[d0]=__builtin_amdgcn_mfma_f32_32x32x16_bf16(pa3,PK(3),o[d0],0,0,0);
    #undef PK
  }
}

#ifndef ATTN_STORE16
#define ATTN_STORE16(p,v) (*(u32x4*)(p)=(v))
#endif
template<int THRL> __device__ __forceinline__ void attn_unit(long rowbase,int qb,const bf16*Qc,const bf16*__restrict__ Kc,const bf16*__restrict__ Vc,bf16*Oc,char*shm){
  int tid_=threadIdx.x; asm volatile("":"+v"(tid_)); const int tid=tid_,lane=tid&63,r32=lane&31,hi=lane>>5; const int wid=__builtin_amdgcn_readfirstlane(tid>>6);
  const int q0=qb*QB;
  const bf16*Qw=Qc+(rowbase+q0+wid*QBLK)*DM;
  const bf16*Kh=Kc+rowbase*DM,*Vh=Vc+rowbase*DM;
  const unsigned lds0=(unsigned)(uintptr_t)shm;
  float*wsf=(float*)(shm+LDS_WS)+wid*64;
  const unsigned koff=(unsigned)(lane*DM+wid*8)*2u;
  const unsigned voffv=(unsigned)((16*(wid&3)+(lane>>2))*DM+(wid>>2)*32+(lane&3)*8)*2u;
  const unsigned kdst=lds0+LDS_K+wid*1024, vdst=lds0+LDS_V+wid*1024;
  #define DMA_K(t,slot) glds16s(Kh+(long)(t)*KVBLK*DM,koff,(unsigned)__builtin_amdgcn_readfirstlane(kdst+(slot)))
  #define DMA_V(t,slot) glds16s(Vh+(long)(t)*KVBLK*DM,voffv,(unsigned)__builtin_amdgcn_readfirstlane(vdst+(slot)))
  const int vb0=(int)(lds0+LDS_V)+((lane>>4)&1)*32+(lane&3)*8+(4*hi+((lane&15)>>2))*64;
  const char*Kbase=shm+LDS_K; bf16x8 kf[8];
  const lds_cptr shm3=(lds_cptr)shm; const lds_cptr kp0=shm3+LDS_K+hi*1024+r32*16; const lds_cptr vp0=shm3+LDS_V+((lane>>4)&1)*32+(lane&3)*8+(4*hi+((lane&15)>>2))*64;
  const int NT=(q0+QB)/KVBLK;
  DMA_K(0,0);DMA_V(0,0);DMA_K(1,SLOTB);
  bf16x8 qr[4];
  #pragma unroll
  for(int d0=0;d0<4;++d0)qr[d0]=*reinterpret_cast<const bf16x8*>(&Qw[(long)r32*DM+d0*16+hi*8]);
  float mhat=0.f,l_reg=0.f;f32x16 o[2];o[0]=f32x16{};o[1]=f32x16{};f32x16 negm=f32x16{};asm volatile("":"+v"(negm));
  const int qrel=wid*QBLK+r32;
  #define CMASK(P0,P1,t) do{int jb_=(t)-(NT-4); if(jb_>=0)cmask(P0,P1,jb_,qrel,hi);}while(0)
  bool resc=false;
  #define START(P0,P1) do{ const float rm=rowmax(P0,P1); resc=false; \
    { const float dl=rm; mhat=fadd_s(mhat,dl); \
      _Pragma("unroll") for(int r=0;r<16;++r){P0[r]=fsub_s(P0[r],dl);P1[r]=fsub_s(P1[r],dl);} \
      _Pragma("unroll") for(int r=0;r<16;++r)negm[r]=-mhat; asm volatile("":"+v"(negm)); } \
    _Pragma("unroll") for(int r=0;r<16;++r)P0[r]=__builtin_amdgcn_exp2f(P0[r]); }while(0)
  #define RESC() do{ if(resc){ asm volatile("s_waitcnt lgkmcnt(0)":::"memory"); \
      _Pragma("unroll") for(int d_=0;d_<2;++d_) _Pragma("unroll") for(int r=0;r<16;++r)o[d_][r]*=wsf[crow(r,hi)]; } }while(0)
  f32x16 pA0,pA1,pB0,pB1;
  int sl_prev=0,sl_cur=0,sl_next=SLOTB;
  #define ROT() do{sl_prev=sl_cur;sl_cur=sl_next;sl_next=(sl_next==(NSLOT-1)*SLOTB)?0:sl_next+SLOTB;}while(0)
  DMA_K(2,2*SLOTB);
  WAIT_BAR(3);
  qkt(pA0,pA1,Kbase,qr,negm,r32,hi);asm volatile("s_nop 15\n\ts_nop 7":"+v"(pA0),"+v"(pA1));CMASK(pA0,pA1,0);
  START(pA0,pA1);
  _Pragma("unroll") for(int r=0;r<16;++r)pA1[r]=__builtin_amdgcn_exp2f(pA1[r]);
  WAIT_BAR(0);
  DMA_K(3,0);DMA_V(1,SLOTB);
  ROT();
  kload8(kf,kp0+sl_cur);
  WAIT_BAR(2);
  s16x4 vlo[8],vhi[8]; u32x4 pw0,pw1,pw2,pw3;
  #define PKW(P,B) cvtpk_s(P[B],P[B+1])
  #define PAF(k) __builtin_bit_cast(bf16x8,pw##k)
  #define VFR(i) (bf16x8){vlo[i][0],vlo[i][1],vlo[i][2],vlo[i][3],vhi[i][0],vhi[i][1],vhi[i][2],vhi[i][3]}
  #define PIN(x) asm volatile("":"+v"(x))
  #define MX3(a,b,c) __builtin_fmaxf(__builtin_fmaxf((a),(b)),(c))
  #define GAPA(MF,A0,A1,A2,A3,W0,W1,PW) do{ MF; sacc+=A0; sacc+=A1; sacc+=A2; sacc+=A3; PIN(sacc); W0; W1; PIN(PW); SBAR(); }while(0)
  #define EX(v) __builtin_amdgcn_exp2f(v)
  #define GAPB(MF,X,B) do{ MF; X[B]=EX(X[B]); X[B+1]=EX(X[B+1]); X[B+2]=EX(X[B+2]); X[B+3]=EX(X[B+3]); PIN(X); SBAR(); }while(0)
  #define VRD(i) do{ vlo[i]=vtr(vp_+(((i)>>2)*4096+((i)&3)*1024)); vhi[i]=vtr(vp_+(((i)>>2)*4096+((i)&3)*1024+512)); }while(0)
  #define KRD(G,j) do{ if(G){ kload2(kf,kp0+sl_next,j); SBAR(); } }while(0)
  #define STEP(C0,C1,P0,P1,t,GK,GV,GL) do{ SBAR(); \
    const lds_cptr vp_=vp0+sl_prev; \
    VRD(0); SBAR(); float sacc=(P0[0]+P0[1]); \
    GAPA(C0=__builtin_amdgcn_mfma_f32_32x32x16_bf16(kf[0],qr[0],negm,0,0,0), P0[2],P0[3],P0[4],P0[5],     pw0[0]=PKW(P0,0), pw0[1]=PKW(P0,2), pw0); \
    VRD(4); SBAR(); GAPA(C1=__builtin_amdgcn_mfma_f32_32x32x16_bf16(kf[1],qr[0],negm,0,0,0), P0[6],P0[7],P0[8],P0[9],     pw0[2]=PKW(P0,4), pw0[3]=PKW(P0,6), pw0); \
    VRD(1); SBAR(); GAPA(C0=__builtin_amdgcn_mfma_f32_32x32x16_bf16(kf[2],qr[1],C0,0,0,0),   P0[10],P0[11],P0[12],P0[13], pw1[0]=PKW(P0,8), pw1[1]=PKW(P0,10), pw1); \
    VRD(5); SBAR(); GAPA(C1=__builtin_amdgcn_mfma_f32_32x32x16_bf16(kf[3],qr[1],C1,0,0,0),   P0[14],P0[15],P1[0],P1[1],   pw1[2]=PKW(P0,12),pw1[3]=PKW(P0,14), pw1); \
    VRD(2); SBAR(); GAPA(C0=__builtin_amdgcn_mfma_f32_32x32x16_bf16(kf[4],qr[2],C0,0,0,0),   P1[2],P1[3],P1[4],P1[5],     pw2[0]=PKW(P1,0), pw2[1]=PKW(P1,2), pw2); \
    VRD(6); SBAR(); GAPA(C1=__builtin_amdgcn_mfma_f32_32x32x16_bf16(kf[5],qr[2],C1,0,0,0),   P1[6],P1[7],P1[8],P1[9],     pw2[2]=PKW(P1,4), pw2[3]=PKW(P1,6), pw2); \
    VRD(3); SBAR(); GAPA(C0=__builtin_amdgcn_mfma_f32_32x32x16_bf16(kf[6],qr[3],C0,0,0,0),   P1[10],P1[11],P1[12],P1[13], pw3[0]=PKW(P1,8), pw3[1]=PKW(P1,10), pw3); \
    VRD(7); SBAR(); GAPA(C1=__builtin_amdgcn_mfma_f32_32x32x16_bf16(kf[7],qr[3],C1,0,0,0),   P1[14],P1[15],0.f,0.f,       pw3[2]=PKW(P1,12),pw3[3]=PKW(P1,14), pw3); \
    l_reg+=sacc; \
    if(GK){DMA_K((t)+3,sl_cur);} if(GV){DMA_V((t)+1,sl_next);} \
    CMASK(C0,C1,t); \
    { float a=MX3(C0[0],C0[1],C1[0]),b=MX3(C0[2],C0[3],C1[1]); a=MX3(a,C1[2],C1[3]); \
      _Pragma("unroll") for(int r=4;r<16;r+=4){a=MX3(a,C0[r],C0[r+1]);b=MX3(b,C0[r+2],C0[r+3]);a=MX3(a,C1[r],C1[r+1]);b=MX3(b,C1[r+2],C1[r+3]);} \
      float rm=__builtin_fmaxf(a,b); { auto rr=__builtin_amdgcn_permlane32_swap(__float_as_uint(rm),__float_as_uint(rm),false,false); rm=__builtin_fmaxf(__uint_as_float(rr[0]),__uint_as_float(rr[1])); } \
      resc=false; \
      if(__builtin_expect(__any(rm>(float)THRL),0)){ const float dl=__builtin_fmaxf(rm,0.f); mhat+=dl; \
        _Pragma("unroll") for(int r=0;r<16;++r){C0[r]-=dl;C1[r]-=dl;} \
        _Pragma("unroll") for(int r=0;r<16;++r)negm[r]=-mhat; asm volatile("":"+v"(negm)); \
        const float f=__builtin_amdgcn_exp2f(-dl); l_reg*=f; if(hi==0)wsf[r32]=f; resc=true; } } \
    SBAR(); \
    GAPB(o[0]=__builtin_amdgcn_mfma_f32_32x32x16_bf16(PAF(0),VFR(0),o[0],0,0,0), C0,0); \
    GAPB(o[1]=__builtin_amdgcn_mfma_f32_32x32x16_bf16(PAF(0),VFR(4),o[1],0,0,0), C0,4); \
    KRD(GL,0); GAPB(o[0]=__builtin_amdgcn_mfma_f32_32x32x16_bf16(PAF(1),VFR(1),o[0],0,0,0), C0,8); \
    KRD(GL,1); GAPB(o[1]=__builtin_amdgcn_mfma_f32_32x32x16_bf16(PAF(1),VFR(5),o[1],0,0,0), C0,12); \
    KRD(GL,2); GAPB(o[0]=__builtin_amdgcn_mfma_f32_32x32x16_bf16(PAF(2),VFR(2),o[0],0,0,0), C1,0); \
    KRD(GL,3); GAPB(o[1]=__builtin_amdgcn_mfma_f32_32x32x16_bf16(PAF(2),VFR(6),o[1],0,0,0), C1,4); \
    GAPB(o[0]=__builtin_amdgcn_mfma_f32_32x32x16_bf16(PAF(3),VFR(3),o[0],0,0,0), C1,8); \
    GAPB(o[1]=__builtin_amdgcn_mfma_f32_32x32x16_bf16(PAF(3),VFR(7),o[1],0,0,0), C1,12); \
    }while(0)
  int t=1;
  #undef CMASK
  #define CMASK(P0,P1,t) do{}while(0)
  for(;t+5<NT;t+=2){
    STEP(pB0,pB1,pA0,pA1,t,true,true,true);     WAIT_BAR(2); RESC(); ROT();
    STEP(pA0,pA1,pB0,pB1,t+1,true,true,true);   WAIT_BAR(2); RESC(); ROT();
  }
  #undef CMASK
  #define CMASK(P0,P1,t) do{int jb_=(t)-(NT-4); if(jb_>=0)cmask(P0,P1,jb_,qrel,hi);}while(0)
  #define ENDW(tt) do{ if((tt)+3<NT){WAIT_BAR(2);} else if((tt)+2<NT){WAIT_BAR(1);} else {WAIT_BAR(0);} }while(0)
  for(;t+1<NT;t+=2){
    STEP(pB0,pB1,pA0,pA1,t,(t+3<NT),(t+1<NT),(t+1<NT));       ENDW(t);   RESC(); ROT();
    STEP(pA0,pA1,pB0,pB1,t+1,(t+4<NT),(t+2<NT),(t+2<NT));     ENDW(t+1); RESC(); ROT();
  }
  STEP(pB0,pB1,pA0,pA1,NT-1,false,false,false); RESC();
  { float sacc=pB0[0]+pB0[1]; _Pragma("unroll") for(int r=2;r<16;++r)sacc+=pB0[r]; _Pragma("unroll") for(int r=0;r<16;++r)sacc+=pB1[r]; l_reg+=sacc;
    pw0=(u32x4){PKW(pB0,0),PKW(pB0,2),PKW(pB0,4),PKW(pB0,6)};pw1=(u32x4){PKW(pB0,8),PKW(pB0,10),PKW(pB0,12),PKW(pB0,14)};pw2=(u32x4){PKW(pB1,0),PKW(pB1,2),PKW(pB1,4),PKW(pB1,6)};pw3=(u32x4){PKW(pB1,8),PKW(pB1,10),PKW(pB1,12),PKW(pB1,14)};
    SBAR(); pv(o,vb0+sl_cur,PAF(0),PAF(1),PAF(2),PAF(3)); }
  #undef PKW
  #undef PAF
  #undef VFR
  #undef PIN
  #undef MX3
  #undef GAPA
  #undef GAPB
  #undef EX
  #undef VRD
  #undef KRD
  #undef STEP
  #undef ENDW
  {auto rr=__builtin_amdgcn_permlane32_swap(__float_as_uint(l_reg),__float_as_uint(l_reg),false,false);l_reg=__uint_as_float(rr[0])+__uint_as_float(rr[1]);}
  if(hi==0)wsf[32+r32]=l_reg;asm volatile("s_waitcnt lgkmcnt(0)":::"memory");
  float rli[16];
  #pragma unroll
  for(int r=0;r<16;++r)rli[r]=__builtin_amdgcn_rcpf(wsf[32+crow(r,hi)]);
  bf16*Ow=Oc+(rowbase+q0+wid*QBLK)*DM;
  { bf16*stg=(bf16*)(shm+LDS_OST)+wid*2048;
    #pragma unroll
    for(int r=0;r<16;++r){const int orow=crow(r,hi);
      #pragma unroll
      for(int d0=0;d0<2;++d0)stg[orow*64+d0*32+r32]=__float2bfloat16(o[d0][r]*rli[r]);}
    asm volatile("s_waitcnt lgkmcnt(0)":::"memory");
    #pragma unroll
    for(int i=0;i<4;++i){const int row=i*8+(lane>>3),ch=lane&7; const u32x4 v=*(const u32x4*)(stg+row*64+ch*8); ATTN_STORE16(Ow+(long)row*DM+ch*8,v);} }
  asm volatile("s_waitcnt lgkmcnt(0)\n\ts_barrier":::"memory");
  #undef DMA_K
  #undef DMA_V
  #undef CMASK
  #undef START
  #undef RESC
  #undef ROT
}
constexpr int ATTN_LDS_BYTES=LDS_BYTES;
#undef SBAR
#undef WAIT_BAR
}
namespace mk {
#define GAS __attribute__((address_space(1)))
#define LAS __attribute__((address_space(3)))
typedef unsigned short bf16;
typedef unsigned v4u __attribute__((ext_vector_type(4)));
typedef unsigned v2u __attribute__((ext_vector_type(2)));
typedef float f32x4 __attribute__((ext_vector_type(4)));
using pg8::Unit;
using pg8::cvt_pk_bf16;

constexpr int D = 1024, BATCH = 8, SEQ = 2048, T = BATCH * SEQ, NH = 8, NG = 4, EPG = 8, NE = 32, DE = 512, NRW = NG + NE;
constexpr float ALPHA = 1.4142135623730951f, LN_EPS = 1e-5f, RMS_EPS = 1e-5f;
constexpr float LAM_INIT = 0.35550906f;
constexpr float QSCALE = 0.125f * 1.4426950408889634f;
constexpr int CNT_STRIDE = 64;
constexpr int CAP = T;
constexpr int NWAVES = 8, NTHREADS = 512;
#ifndef P0B_FILL
#define P0B_FILL 1
#endif
#ifndef MOE_MERGE
#define MOE_MERGE 0
#endif
#ifndef P0B_SPLIT
#define P0B_SPLIT 9216
#endif

constexpr size_t MiB = 1u << 20;
constexpr size_t WS_CTL = 0, WS_W1T = 1 * MiB, WS_W2T = 7 * MiB, WS_WKVQ = 9 * MiB, WS_WOT = 15 * MiB, WS_RWT = 17 * MiB;
constexpr size_t WS_RWH = 17 * MiB + 512 * 1024;
constexpr size_t WS_WUT = 24 * MiB, WS_WDT = 152 * MiB, WS_XB = 216 * MiB, WS_GB = 248 * MiB, WS_U = 280 * MiB, WS_A2 = 312 * MiB, WS_Z = 344 * MiB, WS_X1B = 408 * MiB;
constexpr size_t WS_ACT = 440 * MiB, WS_YP = 480 * MiB, WS_X2B = 544 * MiB, WS_K = 576 * MiB, WS_V = 608 * MiB, WS_Q = 640 * MiB, WS_O0 = 672 * MiB, WS_O1 = 704 * MiB;
constexpr size_t WS_A3 = 736 * MiB, WS_X3B = 768 * MiB;
#ifdef MKPROBE
constexpr size_t WS_PERM = 18 * MiB;
constexpr size_t WS_Z1 = 800 * MiB, WS_ACT1 = 864 * MiB, WS_YP1 = 904 * MiB, WS_PERM1 = 968 * MiB, WS_END = 972 * MiB;
#else
constexpr size_t WS_PERM = 18 * MiB;
constexpr size_t WS_Z1 = WS_Z, WS_ACT1 = WS_ACT, WS_YP1 = WS_YP, WS_PERM1 = WS_PERM, WS_END = 800 * MiB;
#endif
#define LZ(l) ((l) ? WS_Z1 : WS_Z)
#define LACT(l) ((l) ? WS_ACT1 : WS_ACT)
#define LYP(l) ((l) ? WS_YP1 : WS_YP)
#define LPERM(l) ((l) ? WS_PERM1 : WS_PERM)
constexpr int RWH_PITCH = 2064  , RWH_BYTES = 2 * 36 * RWH_PITCH  ;
constexpr int RWH_PAD = 149504;
constexpr int RING_BYTES = 131072, RW_BYTES = RWH_PAD  , MISC_OFF = RW_BYTES, LDS_BYTES = 163840;

struct Args {
    const float *x, *a_w_in, *a_conv_w, *a_w_out, *kv_w, *b_w_q, *b_lambda, *b_subln_g, *b_w_o, *ln1_g, *ln1_b, *ln2_g, *ln2_b, *rg_w, *rg_b, *re_w, *re_b, *e_w_in, *e_w_down;
    float* out; unsigned char* ws;
};

typedef const __attribute__((address_space(4))) Args* ArgsP;
__device__ __forceinline__ ArgsP kargs() { ArgsP p = (ArgsP)__builtin_amdgcn_kernarg_segment_ptr(); asm volatile("" : "+s"(p)); return p; }
struct Ctx { int tid, lane, wave, G, bx, gw, NGW; unsigned char* ws; };
__device__ __forceinline__ Ctx mkctx(ArgsP ap) { Ctx c; int t = threadIdx.x; asm volatile("" : "+v"(t)); c.tid = t; c.lane = t & 63; c.wave = __builtin_amdgcn_readfirstlane(t >> 6);
    c.G = gridDim.x; c.bx = blockIdx.x; c.gw = c.bx * 8 + c.wave; c.NGW = c.G * 8; c.ws = ap->ws; return c; }
__device__ __forceinline__ unsigned f2bf(float f) { unsigned u = __builtin_bit_cast(unsigned, f); return (u + 0x7fffu + ((u >> 16) & 1u)) >> 16; }
__device__ __forceinline__ unsigned pk2(float lo, float hi) { return f2bf(lo) | (f2bf(hi) << 16); }
__device__ __forceinline__ float bflo(unsigned w) { return __builtin_bit_cast(float, w << 16); }
__device__ __forceinline__ float bfhi(unsigned w) { return __builtin_bit_cast(float, w & 0xffff0000u); }
__device__ __forceinline__ float wave_sum(float v) {
#pragma unroll
    for (int o = 1; o < 64; o <<= 1) v += __shfl_xor(v, o);
    return v;
}

__device__ __forceinline__ float dpp_add(float v, const int ctrl_sel) {
    const int iv = __builtin_bit_cast(int, v); int t;
    if (ctrl_sel == 0) t = __builtin_amdgcn_update_dpp(0, iv, 0xB1, 0xF, 0xF, true);
    else if (ctrl_sel == 1) t = __builtin_amdgcn_update_dpp(0, iv, 0x4E, 0xF, 0xF, true);
    else if (ctrl_sel == 2) t = __builtin_amdgcn_update_dpp(0, iv, 0x141, 0xF, 0xF, true);
    else if (ctrl_sel == 3) t = __builtin_amdgcn_update_dpp(0, iv, 0x140, 0xF, 0xF, true);
    else if (ctrl_sel == 4) t = __builtin_amdgcn_update_dpp(0, iv, 0x142, 0xA, 0xF, false);
    else t = __builtin_amdgcn_update_dpp(0, iv, 0x143, 0xC, 0xF, false);
    return v + __builtin_bit_cast(float, t);
}
template <int N> __device__ __forceinline__ void dpp_sum(float (&v)[N]) {
#pragma unroll
    for (int st = 0; st < 6; ++st) {
#pragma unroll
        for (int i = 0; i < N; ++i) v[i] = dpp_add(v[i], st);
    }
#pragma unroll
    for (int i = 0; i < N; ++i) v[i] = __builtin_bit_cast(float, __builtin_amdgcn_readlane(__builtin_bit_cast(int, v[i]), 63));
}
__device__ __forceinline__ float dpp_sum1(float v) { float a[1] = {v}; dpp_sum(a); return a[0]; }

__device__ __forceinline__ void p0_transpose_item(const float* W, int K, int N, bf16* WT, int row_off, LAS float* scr, int item, int lane) {
    const int nblk = N / 64, kb = item / nblk, nb = item % nblk, k0 = 64 * kb, n0 = 64 * nb;
    const float* src = W + (size_t)(k0 + (lane >> 4)) * N + n0 + (lane & 15) * 4;
    f32x4 v[16];
#pragma unroll
    for (int i = 0; i < 16; ++i) v[i] = __builtin_nontemporal_load((const f32x4*)(src + (size_t)(4 * i) * N));
#pragma unroll
    for (int i = 0; i < 16; ++i) { LAS float* d = scr + (4 * i + (lane >> 4)) * 65 + (lane & 15) * 4; d[0] = v[i].x; d[1] = v[i].y; d[2] = v[i].z; d[3] = v[i].w; }
    asm volatile("s_waitcnt lgkmcnt(0)" ::: "memory");
    const int c = lane & 7;
#pragma unroll
    for (int j = 0; j < 8; ++j) { const int n = (lane >> 3) + 8 * j; const LAS float* s = scr + (8 * c) * 65 + n;
        v4u o; o.x = pk2(s[0 * 65], s[1 * 65]); o.y = pk2(s[2 * 65], s[3 * 65]); o.z = pk2(s[4 * 65], s[5 * 65]); o.w = pk2(s[6 * 65], s[7 * 65]);
        *(GAS v4u*)(WT + (size_t)(row_off + n0 + n) * K + k0 + 8 * c) = o; }
    asm volatile("s_waitcnt lgkmcnt(0)" ::: "memory");
}

constexpr int I_IN = 16 * 48, I_SQ = 16 * 16, I_KV = 16 * 32, I_DN = 8 * 16;
constexpr int NEM = P0B_FILL ? NE : 2 * NE;
constexpr int PS1 = I_IN, PS2 = PS1 + I_SQ, PS3 = PS2 + I_KV, PS4 = PS3 + I_SQ, PS5 = PS4 + I_SQ, PS6 = PS5 + NEM * I_SQ, P0_NITEMS = PS6 + NEM * I_DN;
__device__ __forceinline__ void p0_items(LAS unsigned char* lds, int lo, int hi, int w, int nw) {
    const ArgsP a = kargs(); const Ctx cx = mkctx(a); const int lane = cx.lane; unsigned char* ws = cx.ws;
    LAS float* scr = (LAS float*)(lds + cx.wave * 16640);
    for (int it = lo + w; it < hi; it += nw) {
        if (it < PS1) p0_transpose_item(a->a_w_in, D, 3 * D, (bf16*)(ws + WS_W1T), 0, scr, it, lane);
        else if (it < PS2) p0_transpose_item(a->a_w_out, D, D, (bf16*)(ws + WS_W2T), 0, scr, it - PS1, lane);
        else if (it < PS3) p0_transpose_item(a->kv_w, D, 2 * D, (bf16*)(ws + WS_WKVQ), 0, scr, it - PS2, lane);
        else if (it < PS4) p0_transpose_item(a->b_w_q, D, D, (bf16*)(ws + WS_WKVQ), 2 * D, scr, it - PS3, lane);
        else if (it < PS5) p0_transpose_item(a->b_w_o, D, D, (bf16*)(ws + WS_WOT), 0, scr, it - PS4, lane);
        else if (it < PS6) { const int r = it - PS5, mtx = r / I_SQ; p0_transpose_item(a->e_w_in + (size_t)mtx * D * D, D, D, (bf16*)(ws + WS_WUT) + (size_t)mtx * D * D, 0, scr, r % I_SQ, lane); }
        else { const int r = it - PS6, mtx = r / I_DN; p0_transpose_item(a->e_w_down + (size_t)mtx * DE * D, DE, D, (bf16*)(ws + WS_WDT) + (size_t)mtx * D * DE, 0, scr, r % I_DN, lane); }
    }
}
#ifndef ROLE_SPLIT
#define ROLE_SPLIT 1
#endif
#ifndef P0A_EXTRA
#define P0A_EXTRA 6656
#endif
__device__ __forceinline__ void p0_prologue(LAS unsigned char* lds) {
    const ArgsP a = kargs(); const Ctx cx = mkctx(a); const int gw = cx.gw, NGW = cx.NGW, lane = cx.lane;
    unsigned char* ws = cx.ws;
    p0_items(lds, 0, ROLE_SPLIT ? PS1 + P0A_EXTRA : P0_NITEMS, gw, NGW);
    for (int m = gw; m < T; m += NGW) {
        const GAS f32x4* xr = (const GAS f32x4*)(a->x + (size_t)m * D) + lane;
        GAS v2u* o = (GAS v2u*)((bf16*)(ws + WS_XB) + (size_t)m * D) + lane;
#pragma unroll
        for (int j = 0; j < 4; ++j) { const f32x4 v = xr[64 * j]; v2u w; w.x = pk2(v.x, v.y); w.y = pk2(v.z, v.w); o[64 * j] = w; }
    }
    { float* rwt = (float*)(ws + WS_RWT);
      for (int idx = gw * 64 + lane; idx < 2 * NRW * D; idx += NGW * 64) { const int l = idx / (NRW * D), n = (idx / D) % NRW, k = idx % D;
          const float w = n < NG ? a->rg_w[((size_t)l * D + k) * NG + n] : a->re_w[((size_t)l * D + k) * NE + (n - NG)];
          rwt[idx] = w;
          const unsigned hi = f2bf(w), lo = f2bf(w - __builtin_bit_cast(float, hi << 16));
          bf16* img = (bf16*)(ws + WS_RWH) + (size_t)l * (RWH_PAD / 2);
          img[(size_t)n * (RWH_PITCH / 2) + k] = (bf16)hi; img[(size_t)(NRW + n) * (RWH_PITCH / 2) + k] = (bf16)lo; } }
}
__device__ __forceinline__ void p0b_fill(LAS unsigned char* lds, int lo, int hi, int r, int nidle) {
    const ArgsP a = kargs(); const Ctx cx = mkctx(a); unsigned char* ws = cx.ws;
    LAS float* scr = (LAS float*)(lds + cx.wave * 16640);
    for (int it = lo + r * NWAVES + cx.wave; it < hi; it += nidle * NWAVES) {
        if (it < NE * 256) { const int mtx = NE + it / 256; p0_transpose_item(a->e_w_in + (size_t)mtx * D * D, D, D, (bf16*)(ws + WS_WUT) + (size_t)mtx * D * D, 0, scr, it % 256, cx.lane); }
        else { const int r2 = it - NE * 256, mtx = NE + r2 / 128; p0_transpose_item(a->e_w_down + (size_t)mtx * DE * D, DE, D, (bf16*)(ws + WS_WDT) + (size_t)mtx * D * DE, 0, scr, r2 % 128, cx.lane); }
    }
}
constexpr int P0B_ITEMS = NE * 256 + NE * 128;
__device__ __forceinline__ void p0b_idle_fill(LAS unsigned char* lds, int lo, int hi) {
    const ArgsP a = kargs(); const Ctx cx = mkctx(a); const LAS int* misc = (const LAS int*)(lds + MISC_OFF);
    const int U = misc[2 * NE], rem = U % cx.G;
    if (rem == 0) p0b_fill(lds, lo, hi, cx.bx, cx.G);
    else if (cx.bx >= rem) p0b_fill(lds, lo, hi, cx.bx - rem, cx.G - rem);
}
struct SchedDense {
    int G, c, nN, mode, K; const char* W;
    __device__ __forceinline__ bool next(int i, Unit& u) const {
        int pm, pn; if (!pg8::static_tile(i, G, c, T / 256, nN, pm, pn)) return false;
        u.arow = pm * 256; u.p0 = pm; u.p1 = pn; u.p2 = 0; u.p3 = 0;
        const size_t rb = (size_t)K * 2;
        if (mode == 0 && pn >= 4) { const int jj = pn - 4; u.b0 = W + (size_t)(D + 128 * jj) * rb; u.b1 = W + (size_t)(2 * D + 128 * jj) * rb; }
        else { u.b0 = W + (size_t)(256 * pn) * rb; u.b1 = u.b0 + 128 * rb; }
        return true;
    }
    __device__ __forceinline__ void a_offs(const Unit& u, const int (&R)[2], const int (&C)[2], unsigned& v00, unsigned& v01, unsigned& v10, unsigned& v11) const {
        v00 = (unsigned)((u.arow + R[0]) * K + C[0]) * 2u; v01 = (unsigned)((u.arow + R[1]) * K + C[1]) * 2u;
        v10 = (unsigned)((u.arow + 128 + R[0]) * K + C[0]) * 2u; v11 = (unsigned)((u.arow + 128 + R[1]) * K + C[1]) * 2u;
    }
    __device__ __forceinline__ bool half_only(const Unit&) const { return false; }
    __device__ __forceinline__ unsigned peek(const Unit&) const { return 0u; }
    __device__ __forceinline__ void a_ready(const Unit&, unsigned) const {}
    __device__ __forceinline__ void done(const Unit&) const {}
};
struct MoeTab { const LAS int* ub; const LAS int* ps; const LAS int* cn; };
struct SchedMoe {
    int G, c, K; bool up; const char* W; const v2u* perm; MoeTab tb;
    unsigned* ready; int hook; int off, nb;
    __device__ __forceinline__ bool half_only(const Unit& u) const { return u.p2 <= 128; }
    __device__ __forceinline__ unsigned peek(const Unit& u) const {
        return hook == 2 ? __hip_atomic_load(ready + 64 * u.p3, __ATOMIC_RELAXED, __HIP_MEMORY_SCOPE_AGENT) : 0u;
    }
    __device__ __forceinline__ void a_ready(const Unit& u, unsigned pk) const {
        if (hook != 2) return;
        if ((unsigned)__builtin_amdgcn_readfirstlane(pk) >= 32u) return;
        const unsigned long long t0 = __builtin_amdgcn_s_memrealtime();
        while ((unsigned)__builtin_amdgcn_readfirstlane(__hip_atomic_load(ready + 64 * u.p3, __ATOMIC_RELAXED, __HIP_MEMORY_SCOPE_AGENT)) < 32u) {
            if (__builtin_amdgcn_s_memrealtime() - t0 > 2000000ull) break;
            __builtin_amdgcn_s_sleep(2); }
        __builtin_amdgcn_fence(__ATOMIC_ACQUIRE, "agent");
        asm volatile("s_waitcnt vmcnt(0)" ::: "memory");
    }
    __device__ __forceinline__ void done(const Unit& u) const {
        if (hook != 1) return;
        asm volatile("s_waitcnt vmcnt(0)" ::: "memory");
        if ((threadIdx.x & 63) == 0) __hip_atomic_fetch_add(ready + 64 * u.p3, 1u, __ATOMIC_RELAXED, __HIP_MEMORY_SCOPE_AGENT);
    }
    __device__ __forceinline__ bool next(int i, Unit& u) const {
        int idx = i * G + c;
        if (nb > 0) {
            const int v = c - (G - nb);
            if (v >= 0) idx = i == 0 ? v : i == 1 ? v + nb : 2 * nb + v + (i - 2) * G;
            else idx = 3 * nb + c + i * G;
        }
        if (idx >= tb.ub[2 * NE]) return false;
        int k = 0;
#pragma unroll 1
        for (int q = 1; q < 2 * NE; ++q) if (idx >= tb.ub[q]) k = q;
        const int e = k & (NE - 1), local = idx - tb.ub[k];
        int ct, rti;
        if (k < NE) { const int rtn = (tb.ub[k + 1] - tb.ub[k]) >> 2; ct = local / rtn; rti = local - ct * rtn; }
        else { ct = local; rti = (tb.cn[e] - 1) >> 8; }
        const size_t rb = (size_t)K * 2; const char* We = W + (size_t)e * D * rb;
        if (up) { u.b0 = We + (size_t)(128 * ct) * rb; u.b1 = We + (size_t)(DE + 128 * ct) * rb; u.arow = e * CAP + rti * 256; u.p0 = tb.ps[e] + rti * 256; }
        else { u.b0 = We + (size_t)(256 * ct) * rb; u.b1 = u.b0 + 128 * rb; u.arow = tb.ps[e] + rti * 256; u.p0 = e * CAP + rti * 256; }
        u.p1 = ct; u.p2 = tb.cn[e] - rti * 256; u.p3 = (tb.ps[e] >> 8) + rti;
        return true;
    }
    __device__ __forceinline__ void a_offs(const Unit& u, const int (&R)[2], const int (&C)[2], unsigned& v00, unsigned& v01, unsigned& v10, unsigned& v11) const {
        if (up) {
            const int r00 = R[0] < u.p2 ? R[0] : 0, r01 = R[1] < u.p2 ? R[1] : 0, r10 = 128 + R[0] < u.p2 ? 128 + R[0] : 0, r11 = 128 + R[1] < u.p2 ? 128 + R[1] : 0;
            const int t00 = (int)(perm[u.arow + r00].y >> 1), t01 = (int)(perm[u.arow + r01].y >> 1), t10 = (int)(perm[u.arow + r10].y >> 1), t11 = (int)(perm[u.arow + r11].y >> 1);
            v00 = (unsigned)(t00 * K + C[0]) * 2u; v01 = (unsigned)(t01 * K + C[1]) * 2u; v10 = (unsigned)(t10 * K + C[0]) * 2u; v11 = (unsigned)(t11 * K + C[1]) * 2u;
        } else {
            v00 = (unsigned)((u.arow + R[0]) * K + C[0]) * 2u; v01 = (unsigned)((u.arow + R[1]) * K + C[1]) * 2u;
            v10 = (unsigned)((u.arow + 128 + R[0]) * K + C[0]) * 2u; v11 = (unsigned)((u.arow + 128 + R[1]) * K + C[1]) * 2u;
        }
    }
};

struct EpiConvIn {
    static constexpr bool PERM = true; bf16* GB; bf16* U;
    __device__ __forceinline__ void operator()(const f32x4 (&acc)[2][2][4][2], const Unit& u, int wr, int wc, int fr, int fq) const {
        const int row0 = u.p0 * 256 + wr * 64 + fr;
        if (u.p1 < 4) {
            const int col0 = u.p1 * 256 + wc * 32 + 8 * fq;
#pragma unroll
            for (int ai = 0; ai < 2; ++ai)
#pragma unroll
                for (int m = 0; m < 4; ++m) { bf16* rowp = GB + (size_t)(row0 + ai * 128 + m * 16) * D + col0;
#pragma unroll
                    for (int bj = 0; bj < 2; ++bj) { const f32x4 v0 = acc[ai][bj][m][0], v1 = acc[ai][bj][m][1];
                        v4u w; w.x = cvt_pk_bf16(v0[0], v0[1]); w.y = cvt_pk_bf16(v0[2], v0[3]); w.z = cvt_pk_bf16(v1[0], v1[1]); w.w = cvt_pk_bf16(v1[2], v1[3]);
                        *(v4u*)(rowp + bj * 128) = w; } }
        } else {
            const int col0 = (u.p1 - 4) * 128 + wc * 32 + 8 * fq;
#pragma unroll
            for (int ai = 0; ai < 2; ++ai)
#pragma unroll
                for (int m = 0; m < 4; ++m) { const f32x4 v0 = acc[ai][0][m][0] * acc[ai][1][m][0], v1 = acc[ai][0][m][1] * acc[ai][1][m][1];
                    v4u w; w.x = cvt_pk_bf16(v0[0], v0[1]); w.y = cvt_pk_bf16(v0[2], v0[3]); w.z = cvt_pk_bf16(v1[0], v1[1]); w.w = cvt_pk_bf16(v1[2], v1[3]);
                    *(v4u*)(U + (size_t)(row0 + ai * 128 + m * 16) * D + col0) = w; }
        }
    }
};
template <bool RES_BF16> struct EpiResZ {
    static constexpr bool PERM = false; const void* res; float* Z;
    __device__ __forceinline__ void operator()(const f32x4 (&acc)[2][2][4][2], const Unit& u, int wr, int wc, int fr, int fq) const {
        const int row0 = u.p0 * 256 + wr * 64 + fr, col0 = u.p1 * 256 + wc * 32 + 4 * fq;
#pragma unroll
        for (int ai = 0; ai < 2; ++ai)
#pragma unroll
            for (int m = 0; m < 4; ++m) { const size_t off = (size_t)(row0 + ai * 128 + m * 16) * D + col0;
#pragma unroll
                for (int bj = 0; bj < 2; ++bj)
#pragma unroll
                    for (int n = 0; n < 2; ++n) { const size_t o = off + bj * 128 + n * 16; f32x4 r;
                        if (RES_BF16) { const v2u w = *(const v2u*)((const bf16*)res + o); r = (f32x4){bflo(w.x), bfhi(w.x), bflo(w.y), bfhi(w.y)}; }
                        else r = *(const f32x4*)((const float*)res + o);
                        *(f32x4*)(Z + o) = r * ALPHA + acc[ai][bj][m][n]; } }
    }
};
template <bool WT> struct EpiUp {
    static constexpr bool PERM = true; bf16* ACT;
    __device__ __forceinline__ void operator()(const f32x4 (&acc)[2][2][4][2], const Unit& u, int wr, int wc, int fr, int fq) const {
        const int row0 = u.p0 + wr * 64 + fr, col0 = u.p1 * 128 + wc * 32 + 8 * fq;
#pragma unroll
        for (int ai = 0; ai < 2; ++ai)
#pragma unroll
            for (int m = 0; m < 4; ++m) { f32x4 v[2];
#pragma unroll
                for (int n = 0; n < 2; ++n) { const f32x4 g = acc[ai][0][m][n], uu = acc[ai][1][m][n];
#pragma unroll
                    for (int j = 0; j < 4; ++j) { const float e = __builtin_amdgcn_exp2f(g[j] * -1.4426950408889634f); v[n][j] = g[j] * __builtin_amdgcn_rcpf(1.0f + e) * uu[j]; } }
                v4u w; w.x = cvt_pk_bf16(v[0][0], v[0][1]); w.y = cvt_pk_bf16(v[0][2], v[0][3]); w.z = cvt_pk_bf16(v[1][0], v[1][1]); w.w = cvt_pk_bf16(v[1][2], v[1][3]);
                bf16* dst = ACT + (size_t)(row0 + ai * 128 + m * 16) * DE + col0;
                if (WT) { __hip_atomic_store((unsigned long long*)dst, ((unsigned long long)w.y << 32) | w.x, __ATOMIC_RELAXED, __HIP_MEMORY_SCOPE_AGENT);
                          __hip_atomic_store((unsigned long long*)dst + 1, ((unsigned long long)w.w << 32) | w.z, __ATOMIC_RELAXED, __HIP_MEMORY_SCOPE_AGENT); }
                else *(v4u*)dst = w; }
    }
};
struct EpiDown {
    static constexpr bool PERM = true; bf16* YP; const v2u* perm;
    __device__ __forceinline__ void operator()(const f32x4 (&acc)[2][2][4][2], const Unit& u, int wr, int wc, int fr, int fq) const {
        const int col0 = u.p1 * 256 + wc * 32 + 8 * fq;
        v2u rec[2][4];
#pragma unroll
        for (int ai = 0; ai < 2; ++ai)
#pragma unroll
            for (int m = 0; m < 4; ++m) { const int r = ai * 128 + wr * 64 + m * 16 + fr; rec[ai][m] = perm[u.p0 + (r < u.p2 ? r : 0)]; }
#pragma unroll
        for (int ai = 0; ai < 2; ++ai)
#pragma unroll
            for (int m = 0; m < 4; ++m) { const int r = ai * 128 + wr * 64 + m * 16 + fr;
                if (r < u.p2) { const int pair = (int)rec[ai][m].y; float g = __builtin_bit_cast(float, rec[ai][m].x); asm volatile("" : "+v"(g)); bf16* rowp = YP + (size_t)pair * D + col0;
#pragma unroll
                    for (int bj = 0; bj < 2; ++bj) { const f32x4 v0 = acc[ai][bj][m][0] * g, v1 = acc[ai][bj][m][1] * g;
                        v4u w; w.x = cvt_pk_bf16(v0[0], v0[1]); w.y = cvt_pk_bf16(v0[2], v0[3]); w.z = cvt_pk_bf16(v1[0], v1[1]); w.w = cvt_pk_bf16(v1[2], v1[3]);
                        *(v4u*)(rowp + bj * 128) = w; } } }
    }
};
struct EpiKVQ {
    static constexpr bool PERM = true; bf16* KB;
    __device__ __forceinline__ void operator()(const f32x4 (&acc)[2][2][4][2], const Unit& u, int wr, int wc, int fr, int fq) const {
        const int t = u.p1 >> 2; const float sc = t == 2 ? QSCALE : 1.0f;
        bf16* base = KB + (size_t)t * (32 * MiB / 2);
        const int row0 = u.p0 * 256 + wr * 64 + fr, col0 = (u.p1 & 3) * 256 + wc * 32 + 8 * fq;
#pragma unroll
        for (int ai = 0; ai < 2; ++ai)
#pragma unroll
            for (int m = 0; m < 4; ++m) { bf16* rowp = base + (size_t)(row0 + ai * 128 + m * 16) * D + col0;
#pragma unroll
                for (int bj = 0; bj < 2; ++bj) { const f32x4 v0 = acc[ai][bj][m][0] * sc, v1 = acc[ai][bj][m][1] * sc;
                    v4u w; w.x = cvt_pk_bf16(v0[0], v0[1]); w.y = cvt_pk_bf16(v0[2], v0[3]); w.z = cvt_pk_bf16(v1[0], v1[1]); w.w = cvt_pk_bf16(v1[2], v1[3]);
                    *(v4u*)(rowp + bj * 128) = w; } }
    }
};

__device__ __forceinline__ void ln_rows(f32x4 (&v)[4], const f32x4 (&gg)[4], const f32x4 (&bb)[4]) {
    float s = 0.f;
#pragma unroll
    for (int j = 0; j < 4; ++j) s += (v[j].x + v[j].y) + (v[j].z + v[j].w);
    const float mean = dpp_sum1(s) * (1.f / D); float s2 = 0.f;
#pragma unroll
    for (int j = 0; j < 4; ++j) { v[j] = v[j] - mean; s2 += (v[j].x * v[j].x + v[j].y * v[j].y) + (v[j].z * v[j].z + v[j].w * v[j].w); }
    const float rstd = 1.f / sqrtf(dpp_sum1(s2) * (1.f / D) + LN_EPS);
#pragma unroll
    for (int j = 0; j < 4; ++j) v[j] = v[j] * rstd * gg[j] + bb[j];
}
__device__ __forceinline__ float dot_lds(const f32x4 (&v)[4], const LAS f32x4* w, int lane) {
    float a = 0.f;
#pragma unroll
    for (int j = 0; j < 4; ++j) { const f32x4 ww = w[64 * j + lane]; a += (v[j].x * ww.x + v[j].y * ww.y) + (v[j].z * ww.z + v[j].w * ww.w); }
    return a;
}
typedef short bf16x8v __attribute__((ext_vector_type(8)));
__device__ __forceinline__ void ln_router_mfma(LAS unsigned char* lds, int layer, int rep) {
    const ArgsP a = kargs(); const Ctx cx = mkctx(a); const int lane = cx.lane, wave = cx.wave, tid = cx.tid;
    unsigned char* ws = cx.ws;
    const float* Z = (const float*)(ws + LZ(layer)); bf16* Xb = (bf16*)(ws + (layer == 0 ? WS_X1B : WS_X3B));
    const float* g = a->ln1_g + layer * D; const float* b = a->ln1_b + layer * D;
    const float* rgb = a->rg_b + layer * NG; const float* reb = a->re_b + layer * NE;
    int* cnt = (int*)(ws + WS_CTL) + layer * NE * CNT_STRIDE; v2u* perm = (v2u*)(ws + LPERM(layer));
    const int i = lane & 15, kq = lane >> 4, grp = wave >> 1, half = wave & 1;
    const int row = cx.bx * 64 + grp * 16 + i, col0 = 512 * half + 8 * kq;
    { const unsigned char* wg = ws + WS_RWH + (size_t)layer * RWH_PAD;
      for (int q = wave; q < RWH_PAD / 1024; q += NWAVES)
          __builtin_amdgcn_global_load_lds((const unsigned*)(wg + (size_t)q * 1024 + lane * 16), (LAS unsigned*)(lds + q * 1024), 16, 0, 0); }
    f32x4 x[16][2];
#pragma unroll
    for (int s = 0; s < 16; ++s) { const float* p = Z + (size_t)row * D + col0 + 32 * s; x[s][0] = *(const f32x4*)p; x[s][1] = *(const f32x4*)(p + 4); }
    LAS float* xs = (LAS float*)(lds + MISC_OFF + 4096);
    LAS float* part = (LAS float*)lds;
    float s1 = 0.f, s2 = 0.f;
#pragma unroll
    for (int s = 0; s < 16; ++s)
#pragma unroll
        for (int h2 = 0; h2 < 2; ++h2) { const f32x4 v = x[s][h2]; s1 += (v.x + v.y) + (v.z + v.w); s2 += (v.x * v.x + v.y * v.y) + (v.z * v.z + v.w * v.w); }
    s1 += __shfl_xor(s1, 16); s2 += __shfl_xor(s2, 16); s1 += __shfl_xor(s1, 32); s2 += __shfl_xor(s2, 32);
    if (kq == 0) { xs[(wave * 16 + i) * 2] = s1; xs[(wave * 16 + i) * 2 + 1] = s2; }
    __syncthreads();
    const float t1 = xs[((wave ^ 1) * 16 + i) * 2] + s1, t2 = xs[((wave ^ 1) * 16 + i) * 2 + 1] + s2;
    const float mean = t1 * (1.f / D), rstd = 1.f / sqrtf(fmaxf(t2 * (1.f / D) - mean * mean, 0.f) + LN_EPS);
    typedef float f32x4a __attribute__((ext_vector_type(4)));
    f32x4a acc0 = {0.f, 0.f, 0.f, 0.f}, acc1 = acc0, acc2 = acc0;
    const LAS unsigned char* wb = (const LAS unsigned char*)lds + (size_t)(lane & 15) * RWH_PITCH + (size_t)col0 * 2;
    const int n2 = (32 + (lane & 15)) < NRW ? 32 + (lane & 15) : NRW - 1;
    const LAS unsigned char* wb2 = (const LAS unsigned char*)lds + (size_t)n2 * RWH_PITCH + (size_t)col0 * 2;
    constexpr int LO = NRW * RWH_PITCH;
#pragma unroll
    for (int s = 0; s < 16; ++s) {
        const float* gp = g + col0 + 32 * s; const float* bp = b + col0 + 32 * s;
        const f32x4 g0 = *(const f32x4*)gp, g1 = *(const f32x4*)(gp + 4), b0 = *(const f32x4*)bp, b1 = *(const f32x4*)(bp + 4);
        const f32x4 v0 = (x[s][0] - mean) * rstd * g0 + b0, v1 = (x[s][1] - mean) * rstd * g1 + b1;
        const float vv[8] = {v0.x, v0.y, v0.z, v0.w, v1.x, v1.y, v1.z, v1.w};
        unsigned hi[8], lo[8];
#pragma unroll
        for (int j = 0; j < 8; ++j) { hi[j] = f2bf(vv[j]); lo[j] = f2bf(vv[j] - __builtin_bit_cast(float, hi[j] << 16)); }
        v4u hw, lw;
#pragma unroll
        for (int j = 0; j < 4; ++j) { hw[j] = hi[2 * j] | (hi[2 * j + 1] << 16); lw[j] = lo[2 * j] | (lo[2 * j + 1] << 16); }
        *(v4u*)(Xb + (size_t)row * D + col0 + 32 * s) = hw;
        const bf16x8v ah = __builtin_bit_cast(bf16x8v, hw), al = __builtin_bit_cast(bf16x8v, lw);
        const bf16x8v w0h = *(const LAS bf16x8v*)(wb + 64 * s), w0l = *(const LAS bf16x8v*)(wb + LO + 64 * s);
        const bf16x8v w1h = *(const LAS bf16x8v*)(wb + 16 * RWH_PITCH + 64 * s), w1l = *(const LAS bf16x8v*)(wb + 16 * RWH_PITCH + LO + 64 * s);
        const bf16x8v w2h = *(const LAS bf16x8v*)(wb2 + 64 * s), w2l = *(const LAS bf16x8v*)(wb2 + LO + 64 * s);
        acc0 = __builtin_amdgcn_mfma_f32_16x16x32_bf16(ah, w0h, acc0, 0, 0, 0); acc0 = __builtin_amdgcn_mfma_f32_16x16x32_bf16(al, w0h, acc0, 0, 0, 0); acc0 = __builtin_amdgcn_mfma_f32_16x16x32_bf16(ah, w0l, acc0, 0, 0, 0);
        acc1 = __builtin_amdgcn_mfma_f32_16x16x32_bf16(ah, w1h, acc1, 0, 0, 0); acc1 = __builtin_amdgcn_mfma_f32_16x16x32_bf16(al, w1h, acc1, 0, 0, 0); acc1 = __builtin_amdgcn_mfma_f32_16x16x32_bf16(ah, w1l, acc1, 0, 0, 0);
        acc2 = __builtin_amdgcn_mfma_f32_16x16x32_bf16(ah, w2h, acc2, 0, 0, 0); acc2 = __builtin_amdgcn_mfma_f32_16x16x32_bf16(al, w2h, acc2, 0, 0, 0); acc2 = __builtin_amdgcn_mfma_f32_16x16x32_bf16(ah, w2l, acc2, 0, 0, 0);
    }
    __syncthreads();
#pragma unroll
    for (int r = 0; r < 4; ++r) { LAS float* pr = part + (size_t)(wave * 16 + 4 * kq + r) * 48 + (lane & 15); pr[0] = acc0[r]; pr[16] = acc1[r]; pr[32] = acc2[r]; }
    LAS int* rt_e = (LAS int*)(part + 8 * 16 * 48);
    LAS float* rt_g = (LAS float*)(rt_e + 128);
    LAS int* rt_base = (LAS int*)(rt_g + 128);
    __syncthreads();
    if (tid < 64) {
        const int gq = tid >> 4, ii = tid & 15; const LAS float* p0 = part + (size_t)((2 * gq) * 16 + ii) * 48; const LAS float* p1 = p0 + 16 * 48;
        int gi = 0; float gm = -INFINITY, gl[NG];
#pragma unroll
        for (int n = 0; n < NG; ++n) { gl[n] = p0[n] + p1[n] + rgb[n]; if (gl[n] > gm) { gm = gl[n]; gi = n; } }
        float gs = 0.f;
#pragma unroll
        for (int n = 0; n < NG; ++n) gs += __expf(gl[n] - gm);
        const float gtop = 1.0f / gs;
        float m0 = -INFINITY, m1 = -INFINITY; int i0 = 0, i1 = 0;
        for (int n = 0; n < EPG; ++n) { const int c = NG + gi * EPG + n; const float e = p0[c] + p1[c] + reb[gi * EPG + n];
            if (e > m0) { m1 = m0; i1 = i0; m0 = e; i0 = n; } else if (e > m1) { m1 = e; i1 = n; } }
        const float e1 = __expf(m1 - m0), w0 = 1.0f / (1.0f + e1), w1 = e1 * w0;
        rt_e[2 * tid] = gi * EPG + i0; rt_e[2 * tid + 1] = gi * EPG + i1; rt_g[2 * tid] = gtop * w0; rt_g[2 * tid + 1] = gtop * w1;
    }
    __syncthreads();
    if (rep == 0) {
        if (tid < NE) { int c = 0; for (int q = 0; q < 128; ++q) c += (rt_e[q] == tid) ? 1 : 0; rt_base[tid] = c ? atomicAdd(&cnt[tid * CNT_STRIDE], c) : 0; }
        __syncthreads();
        if (tid < 128) { const int e = rt_e[tid]; int rank = 0; for (int q = 0; q < tid; ++q) rank += (rt_e[q] == e) ? 1 : 0;
            const int pair = 2 * (cx.bx * 64 + (tid >> 1)) + (tid & 1);
            perm[e * CAP + rt_base[e] + rank] = (v2u){__builtin_bit_cast(unsigned, rt_g[tid]), (unsigned)pair}; }
    }
}
__device__ __forceinline__ void ln_router_phase(LAS unsigned char* lds, int layer, int rep = 0) {
    const ArgsP a = kargs(); const Ctx cx = mkctx(a); const int gw = cx.gw, NGW = cx.NGW, lane = cx.lane;
    unsigned char* ws = cx.ws;
    const float* Z = (const float*)(ws + LZ(layer)); bf16* Xb = (bf16*)(ws + (layer == 0 ? WS_X1B : WS_X3B));
    const float* g = a->ln1_g + layer * D; const float* b = a->ln1_b + layer * D;
    const float* rgb = a->rg_b + layer * NG; const float* reb = a->re_b + layer * NE;
    int* cnt = (int*)(ws + WS_CTL) + layer * NE * CNT_STRIDE; v2u* perm = (v2u*)(ws + LPERM(layer));
    LAS f32x4* wl = (LAS f32x4*)lds;
    { const f32x4* wg = (const f32x4*)((const float*)(ws + WS_RWT) + (size_t)layer * NRW * D);
      for (int i = cx.tid; i < NRW * D / 4; i += NTHREADS) wl[i] = wg[i]; }
    f32x4 gg[4], bb[4];
#pragma unroll
    for (int j = 0; j < 4; ++j) { gg[j] = *(const f32x4*)(g + 256 * j + 4 * lane); bb[j] = *(const f32x4*)(b + 256 * j + 4 * lane); }
    constexpr int RPW = 16;
    LAS int* rt_row = (LAS int*)(lds + MISC_OFF + 2048);
    LAS int* rt_e = rt_row + NWAVES * RPW;
    LAS float* rt_g = (LAS float*)(rt_e + 2 * NWAVES * RPW);
    LAS int* rt_base = (LAS int*)(rt_g + 2 * NWAVES * RPW);
    LAS int* wave_rows = rt_base + NE;
    f32x4 nv[2][4];
#pragma unroll
    for (int r = 0; r < 2; ++r) { const int row = gw + r * NGW;
        if (row < T) {
#pragma unroll
            for (int j = 0; j < 4; ++j) nv[r][j] = *(const f32x4*)(Z + (size_t)row * D + 256 * j + 4 * lane);
        } }
    __syncthreads();
    int it = 0;
#pragma unroll 1
    for (int row0 = gw; row0 < T && it < RPW; row0 += 2 * NGW, it += 2) {
        const bool two = row0 + NGW < T;
        f32x4 v[2][4];
#pragma unroll
        for (int r = 0; r < 2; ++r)
#pragma unroll
            for (int j = 0; j < 4; ++j) v[r][j] = nv[r][j];
#pragma unroll
        for (int r = 0; r < 2; ++r) { const int row = row0 + (2 + r) * NGW;
            if (row < T) {
#pragma unroll
                for (int j = 0; j < 4; ++j) nv[r][j] = *(const f32x4*)(Z + (size_t)row * D + 256 * j + 4 * lane);
            } }
        if (!two) {
#pragma unroll
            for (int j = 0; j < 4; ++j) v[1][j] = v[0][j];
        }
        float s1[2];
#pragma unroll
        for (int r = 0; r < 2; ++r) { float s = 0.f;
#pragma unroll
            for (int j = 0; j < 4; ++j) s += (v[r][j].x + v[r][j].y) + (v[r][j].z + v[r][j].w);
            s1[r] = s; }
        dpp_sum(s1);
        float s2[2];
#pragma unroll
        for (int r = 0; r < 2; ++r) { const float mean = s1[r] * (1.f / D); float q = 0.f;
#pragma unroll
            for (int j = 0; j < 4; ++j) { v[r][j] = v[r][j] - mean; q += (v[r][j].x * v[r][j].x + v[r][j].y * v[r][j].y) + (v[r][j].z * v[r][j].z + v[r][j].w * v[r][j].w); }
            s2[r] = q; }
        dpp_sum(s2);
#pragma unroll
        for (int r = 0; r < 2; ++r) { const float rstd = 1.f / sqrtf(s2[r] * (1.f / D) + LN_EPS);
#pragma unroll
            for (int j = 0; j < 4; ++j) v[r][j] = v[r][j] * rstd * gg[j] + bb[j]; }
#pragma unroll
        for (int r = 0; r < 2; ++r) { const int row = row0 + r * NGW;
            if (r == 0 || two) {
#pragma unroll
                for (int j = 0; j < 4; ++j) { v2u w; w.x = pk2(v[r][j].x, v[r][j].y); w.y = pk2(v[r][j].z, v[r][j].w); *(v2u*)(Xb + (size_t)row * D + 256 * j + 4 * lane) = w; }
            } }
        float gl[2 * NG];
#pragma unroll
        for (int r = 0; r < 2; ++r)
#pragma unroll
            for (int n = 0; n < NG; ++n) gl[r * NG + n] = dot_lds(v[r], wl + n * (D / 4), lane);
        dpp_sum(gl);
        int gi[2]; float gtop[2];
#pragma unroll
        for (int r = 0; r < 2; ++r) { int g_ = 0; float gm = -INFINITY;
#pragma unroll
            for (int n = 0; n < NG; ++n) { gl[r * NG + n] += rgb[n]; if (gl[r * NG + n] > gm) { gm = gl[r * NG + n]; g_ = n; } }
            float gs = 0.f;
#pragma unroll
            for (int n = 0; n < NG; ++n) gs += __expf(gl[r * NG + n] - gm);
            gi[r] = g_; gtop[r] = 1.0f / gs; }
        float el[2 * EPG];
#pragma unroll
        for (int r = 0; r < 2; ++r)
#pragma unroll
            for (int n = 0; n < EPG; ++n) el[r * EPG + n] = dot_lds(v[r], wl + (NG + gi[r] * EPG + n) * (D / 4), lane);
        dpp_sum(el);
#pragma unroll
        for (int r = 0; r < 2; ++r) {
            float m0 = -INFINITY, m1 = -INFINITY; int i0 = 0, i1 = 0;
#pragma unroll
            for (int n = 0; n < EPG; ++n) { const float e = el[r * EPG + n] + reb[gi[r] * EPG + n];
                if (e > m0) { m1 = m0; i1 = i0; m0 = e; i0 = n; } else if (e > m1) { m1 = e; i1 = n; } }
            const float e1 = __expf(m1 - m0), w0 = 1.0f / (1.0f + e1), w1 = e1 * w0;
            if (lane == 0 && (r == 0 || two)) {
                const int li = cx.wave * RPW + it + r;
                rt_row[li] = row0 + r * NGW; rt_e[2 * li] = gi[r] * EPG + i0; rt_e[2 * li + 1] = gi[r] * EPG + i1; rt_g[2 * li] = gtop[r] * w0; rt_g[2 * li + 1] = gtop[r] * w1;
            }
        }
        if (!two) { it += 1; break; }
    }
    if (lane == 0) wave_rows[cx.wave] = it;
    __syncthreads();
    if (rep == 0) {
        if (cx.tid < NE) { int c = 0;
            for (int w = 0; w < NWAVES; ++w) { const int n = wave_rows[w]; for (int i = 0; i < 2 * n; ++i) c += (rt_e[2 * (w * RPW) + i] == cx.tid) ? 1 : 0; }
            rt_base[cx.tid] = c ? atomicAdd(&cnt[cx.tid * CNT_STRIDE], c) : 0; }
        __syncthreads();
        if (cx.tid < 2 * NWAVES * RPW) { const int w = cx.tid / (2 * RPW), i = cx.tid % (2 * RPW);
            if (i < 2 * wave_rows[w]) { const int e = rt_e[cx.tid]; int rank = 0;
                for (int w2 = 0; w2 <= w; ++w2) { const int lim = (w2 < w) ? 2 * wave_rows[w2] : i; for (int q = 0; q < lim; ++q) rank += (rt_e[2 * (w2 * RPW) + q] == e) ? 1 : 0; }
                const int pair = 2 * rt_row[cx.tid >> 1] + (cx.tid & 1);
                perm[e * CAP + rt_base[e] + rank] = (v2u){__builtin_bit_cast(unsigned, rt_g[cx.tid]), (unsigned)pair}; } }
    }
}
__device__ __forceinline__ void ln2_phase(int layer) {
    const ArgsP a = kargs(); const Ctx cx = mkctx(a); const int gw = cx.gw, NGW = cx.NGW, lane = cx.lane;
    unsigned char* ws = cx.ws;
    const bf16* Xin = (const bf16*)(ws + (layer == 0 ? WS_X1B : WS_X3B)); const bf16* YP = (const bf16*)(ws + LYP(layer));
    const float* g = a->ln2_g + layer * D; const float* b = a->ln2_b + layer * D;
    f32x4 gg[4], bb[4];
#pragma unroll
    for (int j = 0; j < 4; ++j) { gg[j] = *(const f32x4*)(g + 256 * j + 4 * lane); bb[j] = *(const f32x4*)(b + 256 * j + 4 * lane); }
    v2u nx[4], ny0[4], ny1[4];
    if (gw < T) {
#pragma unroll
        for (int j = 0; j < 4; ++j) { const size_t c = 256 * j + 4 * lane;
            nx[j] = *(const v2u*)(Xin + (size_t)gw * D + c); ny0[j] = *(const v2u*)(YP + (size_t)(2 * gw) * D + c); ny1[j] = *(const v2u*)(YP + (size_t)(2 * gw + 1) * D + c); }
    }
#pragma unroll 1
    for (int row = gw; row < T; row += NGW) {
        f32x4 v[4];
#pragma unroll
        for (int j = 0; j < 4; ++j) { const v2u xw = nx[j], y0 = ny0[j], y1 = ny1[j];
            v[j].x = ALPHA * bflo(xw.x) + (bflo(y0.x) + bflo(y1.x)); v[j].y = ALPHA * bfhi(xw.x) + (bfhi(y0.x) + bfhi(y1.x));
            v[j].z = ALPHA * bflo(xw.y) + (bflo(y0.y) + bflo(y1.y)); v[j].w = ALPHA * bfhi(xw.y) + (bfhi(y0.y) + bfhi(y1.y)); }
        if (row + NGW < T) { const int r2 = row + NGW;
#pragma unroll
            for (int j = 0; j < 4; ++j) { const size_t c = 256 * j + 4 * lane;
                nx[j] = *(const v2u*)(Xin + (size_t)r2 * D + c); ny0[j] = *(const v2u*)(YP + (size_t)(2 * r2) * D + c); ny1[j] = *(const v2u*)(YP + (size_t)(2 * r2 + 1) * D + c); }
        }
        ln_rows(v, gg, bb);
        if (layer == 0) {
#pragma unroll
            for (int j = 0; j < 4; ++j) { v2u w; w.x = pk2(v[j].x, v[j].y); w.y = pk2(v[j].z, v[j].w); *(v2u*)((bf16*)(ws + WS_X2B) + (size_t)row * D + 256 * j + 4 * lane) = w; }
        } else {
#pragma unroll
            for (int j = 0; j < 4; ++j) *(f32x4*)(a->out + (size_t)row * D + 256 * j + 4 * lane) = v[j];
        }
    }
}
__device__ __forceinline__ void conv_phase() {
    const ArgsP a = kargs(); const Ctx cx = mkctx(a); const int gtid = cx.bx * NTHREADS + cx.tid, NGT = cx.G * NTHREADS;
    unsigned char* ws = cx.ws;
    const bf16* GB = (const bf16*)(ws + WS_GB); const bf16* U = (const bf16*)(ws + WS_U); bf16* A2 = (bf16*)(ws + WS_A2);
    for (int it = gtid; it < T * (D / 8); it += NGT) {
        const int t = it >> 7, d0 = (it & 127) * 8, s = t & (SEQ - 1);
        const size_t o = (size_t)t * D + d0;
        const v4u g = *(const v4u*)(GB + o), u0 = *(const v4u*)(U + o);
        v4u u1 = (v4u){0u, 0u, 0u, 0u}, u2 = u1;
        if (s >= 1) u1 = *(const v4u*)(U + o - D);
        if (s >= 2) u2 = *(const v4u*)(U + o - 2 * D);
        v4u r;
#pragma unroll
        for (int q = 0; q < 4; ++q) {
            const int d = d0 + 2 * q;
            const float c0 = a->a_conv_w[d] * bflo(u2[q]) + a->a_conv_w[D + d] * bflo(u1[q]) + a->a_conv_w[2 * D + d] * bflo(u0[q]);
            const float c1 = a->a_conv_w[d + 1] * bfhi(u2[q]) + a->a_conv_w[D + d + 1] * bfhi(u1[q]) + a->a_conv_w[2 * D + d + 1] * bfhi(u0[q]);
            r[q] = pk2(bflo(g[q]) * c0, bfhi(g[q]) * c1);
        }
        *(v4u*)(A2 + o) = r;
    }
}
__device__ __forceinline__ void combine_phase() {
    const ArgsP a = kargs(); const Ctx cx = mkctx(a); const int gw = cx.gw, NGW = cx.NGW, lane = cx.lane;
    unsigned char* ws = cx.ws;
    const bf16* O0 = (const bf16*)(ws + WS_O0); const bf16* O1 = (const bf16*)(ws + WS_O1); bf16* A3 = (bf16*)(ws + WS_A3);
    const float l01 = wave_sum(a->b_lambda[lane] * a->b_lambda[64 + lane]), l23 = wave_sum(a->b_lambda[128 + lane] * a->b_lambda[192 + lane]);
    const float lam = __expf(l01) - __expf(l23) + LAM_INIT;
    float gsc[16];
#pragma unroll
    for (int i = 0; i < 16; ++i) gsc[i] = a->b_subln_g[(lane & 7) * 16 + i] * (1.0f - LAM_INIT);
    for (int row = gw; row < T; row += NGW) {
        const size_t o = (size_t)row * D + lane * 16;
        const v4u p0 = *(const v4u*)(O0 + o), p1 = *(const v4u*)(O0 + o + 8), q0 = *(const v4u*)(O1 + o), q1 = *(const v4u*)(O1 + o + 8);
        float d[16]; float ss = 0.f;
#pragma unroll
        for (int i = 0; i < 4; ++i) { d[2 * i] = bflo(p0[i]) - lam * bflo(q0[i]); d[2 * i + 1] = bfhi(p0[i]) - lam * bfhi(q0[i]);
            d[8 + 2 * i] = bflo(p1[i]) - lam * bflo(q1[i]); d[8 + 2 * i + 1] = bfhi(p1[i]) - lam * bfhi(q1[i]); }
#pragma unroll
        for (int i = 0; i < 16; ++i) ss += d[i] * d[i];
        ss += __shfl_xor(ss, 1); ss += __shfl_xor(ss, 2); ss += __shfl_xor(ss, 4);
        const float r = 1.0f / sqrtf(ss * (1.0f / 128.0f) + RMS_EPS);
        v4u w0, w1;
#pragma unroll
        for (int i = 0; i < 4; ++i) { w0[i] = pk2(d[2 * i] * r * gsc[2 * i], d[2 * i + 1] * r * gsc[2 * i + 1]); w1[i] = pk2(d[8 + 2 * i] * r * gsc[8 + 2 * i], d[8 + 2 * i + 1] * r * gsc[8 + 2 * i + 1]); }
        *(v4u*)(A3 + o) = w0; *(v4u*)(A3 + o + 8) = w1;
    }
}

#ifndef MKMASK
#define MKMASK 0xffff
#endif
#ifndef MKREP
#define MKREP 0
#endif
#ifndef MKSYNC
#define MKSYNC 0
#endif
#ifndef MKMASK2
#define MKMASK2 MKMASK
#endif
#define PH(k) _Pragma("unroll 1") for (int rep_ = 0; rep_ < (int)(((pass_ ? MKMASK2 : MKMASK) >> (k)) & 1) + (int)((MKREP >> (k)) & 1); ++rep_)
#define XB_TMO      128
#define XB_XCNT(j)  (256  + 64 * (j))
#define XB_XSUB(j)  (1280 + 64 * (j))
#define XB_XGEN(j)  (2304 + 64 * (j))
#define XB_TOP      3328
#define XB_TOPGEN   3392
#define XCD_BAR_WORDS 3456
#define XB_SPIN_CAP (1u << 18)

__device__ __forceinline__ unsigned xb_ld(unsigned* p)              { return __hip_atomic_load(p, __ATOMIC_RELAXED, __HIP_MEMORY_SCOPE_AGENT); }
__device__ __forceinline__ unsigned xb_add(unsigned* p, unsigned v) { return __hip_atomic_fetch_add(p, v, __ATOMIC_RELAXED, __HIP_MEMORY_SCOPE_AGENT); }
__device__ __forceinline__ unsigned xb_xcc_id() { return (unsigned)__builtin_amdgcn_s_getreg((3 << 11) | 20) & 0xFu; }
#define XB_SPIN(cond, bar) do { unsigned _sp = 0; while (cond) { __builtin_amdgcn_s_sleep(1); \
    if ((++_sp & 255u) == 0u) { if (xb_ld(&(bar)[XB_TMO])) break; if (_sp > XB_SPIN_CAP) { atomicAdd(&(bar)[XB_TMO], 1u); break; } } } } while (0)

struct XcdBarrier {
    unsigned* bar; unsigned x;
    volatile LAS unsigned* st;
};

__device__ __forceinline__ XcdBarrier xcd_barrier_post(unsigned* bar, volatile LAS unsigned* st) {
    XcdBarrier b; b.bar = bar; b.x = xb_xcc_id(); b.st = st;
    if (threadIdx.x == 0) (void)xb_add(&bar[XB_XCNT(b.x)], 1u);
    return b;
}
__device__ __forceinline__ void xcd_barrier_complete(unsigned* bar, unsigned x, unsigned& nloc, unsigned& nx) {
    const unsigned G = gridDim.x * gridDim.y * gridDim.z;
    unsigned sum, cnt, mine, sp = 0u;
    for (;;) {
        sum = 0u; cnt = 0u; mine = 0u;
#pragma unroll
        for (unsigned j = 0; j < 16; ++j) { const unsigned c = xb_ld(&bar[XB_XCNT(j)]); sum += c; cnt += (c > 0u) ? 1u : 0u; mine = (j == x) ? c : mine; }
        if (sum == G) break;
        __builtin_amdgcn_s_sleep(1);
        if ((++sp & 255u) == 0u) { if (xb_ld(&bar[XB_TMO])) break; if (sp > XB_SPIN_CAP) { atomicAdd(&bar[XB_TMO], 1u); break; } }
    }
    nloc = mine > 0u ? mine : 1u; nx = cnt > 0u ? cnt : 1u;
}

__device__ __forceinline__ void xcd_barrier(const XcdBarrier& b) {
    asm volatile("s_waitcnt vmcnt(0)" ::: "memory");
    __syncthreads();
    if (threadIdx.x == 0) {
        unsigned* bar = b.bar;
        __builtin_amdgcn_s_waitcnt(0);
        unsigned nloc = b.st[0], nx = b.st[1];
        if (nloc == 0u) { xcd_barrier_complete(bar, b.x, nloc, nx); b.st[0] = nloc; b.st[1] = nx; }
        const unsigned old = xb_add(&bar[XB_XSUB(b.x)], 1u);
        const unsigned gen = old / nloc;
        if (old + 1u == (gen + 1u) * nloc) {
            __builtin_amdgcn_fence(__ATOMIC_RELEASE, "agent");
            asm volatile("s_waitcnt vmcnt(0)" ::: "memory");
            const unsigned og = xb_add(&bar[XB_TOP], 1u);
            const unsigned tg = og / nx;
            if (og + 1u == (tg + 1u) * nx) xb_add(&bar[XB_TOPGEN], 1u);
            else XB_SPIN(xb_ld(&bar[XB_TOPGEN]) == tg, bar);
            __builtin_amdgcn_fence(__ATOMIC_ACQUIRE, "agent");
            xb_add(&bar[XB_XGEN(b.x)], 1u);
            asm volatile("s_waitcnt vmcnt(0)" ::: "memory");
        } else {
            XB_SPIN(xb_ld(&bar[XB_XGEN(b.x)]) == gen, bar);
            __builtin_amdgcn_fence(__ATOMIC_ACQUIRE, "agent");
            asm volatile("s_waitcnt vmcnt(0)" ::: "memory");
        }
    }
    __syncthreads();
}

constexpr int CW_BAR = 16384;
constexpr int ST_OFF = MISC_OFF + 1024;
__device__ __forceinline__ void seam(LAS unsigned char* lds) { const ArgsP a = kargs(); XcdBarrier b; b.bar = (unsigned*)(a->ws + WS_CTL) + CW_BAR; b.x = xb_xcc_id(); b.st = (volatile LAS unsigned*)(lds + ST_OFF); xcd_barrier(b); }
__device__ __forceinline__ void gemm1_phase(LAS unsigned char* lds) { const ArgsP a = kargs(); const Ctx cx = mkctx(a); unsigned char* ws = cx.ws;
    const int ng = ROLE_SPLIT ? cx.G - cx.G / 4 : cx.G;
    if (cx.bx < ng) { SchedDense S{ng, cx.bx, 12, 0, D, (const char*)(ws + WS_W1T)}; EpiConvIn E{(bf16*)(ws + WS_GB), (bf16*)(ws + WS_U)};
        pg8::gemm_phase(lds, (const char*)(ws + WS_XB), D, S, E); }
    else p0_items(lds, PS1 + P0A_EXTRA, P0_NITEMS, (cx.bx - ng) * NWAVES + cx.wave, (cx.G - ng) * NWAVES); }
__device__ __forceinline__ void gemm2_phase(LAS unsigned char* lds) { const ArgsP a = kargs(); const Ctx cx = mkctx(a); unsigned char* ws = cx.ws;
    SchedDense S{cx.G, cx.bx, 4, 1, D, (const char*)(ws + WS_W2T)}; EpiResZ<false> E{(const void*)a->x, (float*)(ws + LZ(0))};
    pg8::gemm_phase(lds, (const char*)(ws + WS_A2), D, S, E); }
__device__ __forceinline__ void kvq_phase(LAS unsigned char* lds) { const ArgsP a = kargs(); const Ctx cx = mkctx(a); unsigned char* ws = cx.ws;
    SchedDense S{cx.G, cx.bx, 12, 1, D, (const char*)(ws + WS_WKVQ)}; EpiKVQ E{(bf16*)(ws + WS_K)};
    pg8::gemm_phase(lds, (const char*)(ws + WS_X2B), D, S, E); }
__device__ __forceinline__ void wo_phase(LAS unsigned char* lds) { const ArgsP a = kargs(); const Ctx cx = mkctx(a); unsigned char* ws = cx.ws;
    SchedDense S{cx.G, cx.bx, 4, 1, D, (const char*)(ws + WS_WOT)}; EpiResZ<true> E{(const void*)(ws + WS_X2B), (float*)(ws + LZ(1))};
    pg8::gemm_phase(lds, (const char*)(ws + WS_A3), D, S, E); }
__device__ __forceinline__ void attn_phase(char* lds_generic) { const ArgsP a = kargs(); const Ctx cx = mkctx(a); unsigned char* ws = cx.ws;
#pragma unroll 1
    for (int uix = cx.bx; uix < BATCH * NH * 4 * (SEQ / 256); uix += cx.G) {
        const int combo = uix & 255, qi = uix >> 8;
        const int b = combo >> 5, h = (combo >> 2) & 7, c = (combo >> 1) & 1, vh = combo & 1;
        const int qb = (qi & 1) ? (SEQ / 256 - 1 - (qi >> 1)) : (qi >> 1);
        const attn_body::bf16* QK = (const attn_body::bf16*)(ws + WS_K) + h * 128 + c * 64;
        const attn_body::bf16* Vc = (const attn_body::bf16*)(ws + WS_V) + h * 128 + vh * 64;
        attn_body::bf16* Oc = (attn_body::bf16*)(ws + (c ? WS_O1 : WS_O0)) + h * 128 + vh * 64;
        attn_body::attn_unit<8>((long)b * SEQ, qb, QK + (WS_Q - WS_K) / 2, QK, Vc, Oc, lds_generic);
    }
}
__device__ __forceinline__ void moe_tables(LAS unsigned char* lds, int layer) { const ArgsP a = kargs(); const Ctx cx = mkctx(a); LAS int* misc = (LAS int*)(lds + MISC_OFF);
    const int* cnt = (const int*)(cx.ws + WS_CTL) + layer * NE * CNT_STRIDE;
    if (cx.tid < NE) misc[128 + cx.tid] = __hip_atomic_load(cnt + cx.tid * CNT_STRIDE, __ATOMIC_RELAXED, __HIP_MEMORY_SCOPE_AGENT);
    __syncthreads();
    if (cx.tid == 0) { int ub = 0, ps = 0; for (int e = 0; e < NE; ++e) { misc[e] = ub; misc[192 + e] = ps; const int cn = misc[128 + e], rt = (cn + 255) >> 8, half = (cn > 0 && ((cn - 1) & 255) < 128) ? 1 : 0; ub += 4 * (rt - half); ps += 256 * rt; }
        misc[192 + NE] = ps;
        for (int e = 0; e < NE; ++e) { misc[NE + e] = ub; const int cn = misc[128 + e]; ub += (cn > 0 && ((cn - 1) & 255) < 128) ? 4 : 0; } misc[2 * NE] = ub; }
    __syncthreads(); }
constexpr int CW_READY = 4096;
__device__ __forceinline__ void moe_up_phase(LAS unsigned char* lds, int layer, bool merged) { const ArgsP a = kargs(); const Ctx cx = mkctx(a); unsigned char* ws = cx.ws; LAS int* misc = (LAS int*)(lds + MISC_OFF);
    const MoeTab tb{misc, misc + 192, misc + 128};
    SchedMoe S{cx.G, cx.bx, D, true, (const char*)(ws + WS_WUT) + (size_t)layer * NE * D * D * 2, (const v2u*)(ws + LPERM(layer)), tb, (unsigned*)(ws + WS_CTL) + CW_READY, merged ? 1 : 0, 0, 0};
    if (merged) { EpiUp<true> E{(bf16*)(ws + LACT(layer))}; pg8::gemm_phase(lds, (const char*)(ws + (layer == 0 ? WS_X1B : WS_X3B)), D, S, E); }
    else { EpiUp<false> E{(bf16*)(ws + LACT(layer))}; pg8::gemm_phase(lds, (const char*)(ws + (layer == 0 ? WS_X1B : WS_X3B)), D, S, E); } }
__device__ __forceinline__ void moe_down_phase(LAS unsigned char* lds, int layer, bool merged) { const ArgsP a = kargs(); const Ctx cx = mkctx(a); unsigned char* ws = cx.ws; LAS int* misc = (LAS int*)(lds + MISC_OFF);
    const MoeTab tb{misc, misc + 192, misc + 128};
    int nb = 0;
    if (merged) { const int U = misc[2 * NE], rem = U % cx.G; nb = rem ? cx.G - rem : 0; }
    SchedMoe S{cx.G, cx.bx, DE, false, (const char*)(ws + WS_WDT) + (size_t)layer * NE * D * DE * 2, (const v2u*)(ws + LPERM(layer)), tb, (unsigned*)(ws + WS_CTL) + CW_READY, merged ? 2 : 0, 0, nb};
    EpiDown E{(bf16*)(ws + LYP(layer)), (const v2u*)(ws + LPERM(layer))};
    pg8::gemm_phase(lds, (const char*)(ws + LACT(layer)), DE, S, E); }

__global__ void __launch_bounds__(NTHREADS, 2) fwd_megakernel(Args args_unused) {
    extern __shared__ __attribute__((aligned(16))) unsigned char lds_raw[];
#ifdef NOSYNC
    struct { __device__ void sync() const {} } grid;
#else
    cg::grid_group grid = cg::this_grid();
#endif
#define SEAM() seam(lds)
    LAS unsigned char* lds = (LAS unsigned char*)lds_raw;
#ifndef MKPASS
#define MKPASS 1
#endif
    { const ArgsP a = kargs(); int t = threadIdx.x; asm volatile("" : "+v"(t));
      if (t < 2) ((volatile LAS unsigned*)(lds + ST_OFF))[t] = 0u;
      if (blockIdx.x == 0) { unsigned* ctl = (unsigned*)(a->ws + WS_CTL); for (int i = t; i < CW_BAR + XCD_BAR_WORDS; i += NTHREADS) ctl[i] = 0u; } }
    __syncthreads();
#pragma unroll 1
    for (int pass_ = 0; pass_ < MKPASS; ++pass_) {
    if (pass_) SEAM();
    PH(0) p0_prologue(lds);
    if (pass_ == 0) { grid.sync();
      const ArgsP a = kargs(); (void)xcd_barrier_post((unsigned*)(a->ws + WS_CTL) + CW_BAR, (volatile LAS unsigned*)(lds + ST_OFF)); }
    else SEAM();
    PH(1) gemm1_phase(lds);
    SEAM();
    PH(2) conv_phase();
    SEAM();
    PH(3) gemm2_phase(lds);
    SEAM();
    PH(8) { if (gridDim.x == 256) ln_router_mfma(lds, 0, rep_ + pass_); else ln_router_phase(lds, 0, rep_ + pass_); }
    SEAM();
    moe_tables(lds, 0);
    PH(9) { moe_up_phase(lds, 0, false); if (P0B_FILL && pass_ == 0) p0b_idle_fill(lds, 0, P0B_SPLIT); }
    SEAM();
    PH(10) { moe_down_phase(lds, 0, false); if (P0B_FILL && pass_ == 0) p0b_idle_fill(lds, P0B_SPLIT, P0B_ITEMS); }
    SEAM();
    PH(11) ln2_phase(0);
    SEAM();
    PH(4) kvq_phase(lds);
    SEAM();
    PH(5) attn_phase((char*)lds_raw);
    SEAM();
    PH(6) combine_phase();
    SEAM();
    PH(7) wo_phase(lds);
    SEAM();
    PH(8) { if (gridDim.x == 256) ln_router_mfma(lds, 1, rep_ + pass_); else ln_router_phase(lds, 1, rep_ + pass_); }
    SEAM();
    moe_tables(lds, 1);
#if MOE_MERGE
    PH(9) moe_up_phase(lds, 1, pass_ == 0);
    if (pass_) SEAM();
    PH(10) moe_down_phase(lds, 1, pass_ == 0);
#else
    PH(9) moe_up_phase(lds, 1, false);
    SEAM();
    PH(10) moe_down_phase(lds, 1, false);
#endif
    SEAM();
    PH(11) ln2_phase(1);
    }
#pragma unroll 1
    for (int i = 0; i < MKSYNC; ++i) SEAM();
}
}

extern "C" void kernel_launch(void* const* d_in, const int* in_sizes, int n_in, void* d_out, int out_size, void* d_ws, size_t ws_size, hipStream_t stream) {
    using namespace mk;
    static int grid = 0;
    if (grid == 0) {
        if (n_in != 19 || out_size != T * D || ws_size < WS_END) { fprintf(stderr, "kernel_launch: unexpected shapes / workspace (n_in %d out %d ws %zu, need %zu)\n", n_in, out_size, ws_size, (size_t)WS_END); grid = -1; return; }
        int dev = 0, cus = 0, per_cu = 0;
        (void)hipGetDevice(&dev); (void)hipDeviceGetAttribute(&cus, hipDeviceAttributeMultiprocessorCount, dev);
        if (hipFuncSetAttribute((const void*)fwd_megakernel, hipFuncAttributeMaxDynamicSharedMemorySize, LDS_BYTES) != hipSuccess) { fprintf(stderr, "kernel_launch: hipFuncSetAttribute failed\n"); grid = -1; return; }
        if (hipOccupancyMaxActiveBlocksPerMultiprocessor(&per_cu, (const void*)fwd_megakernel, NTHREADS, LDS_BYTES) != hipSuccess || per_cu < 1) { fprintf(stderr, "kernel_launch: occupancy query says %d blocks per CU\n", per_cu); grid = -1; return; }
        grid = cus * 1;
        (void)hipGetLastError();
    }
    if (grid < 0) return;
    Args a{};
    a.x = (const float*)d_in[0]; a.a_w_in = (const float*)d_in[1]; a.a_conv_w = (const float*)d_in[2]; a.a_w_out = (const float*)d_in[3]; a.kv_w = (const float*)d_in[4];
    a.b_w_q = (const float*)d_in[5]; a.b_lambda = (const float*)d_in[6]; a.b_subln_g = (const float*)d_in[7]; a.b_w_o = (const float*)d_in[8];
    a.ln1_g = (const float*)d_in[9]; a.ln1_b = (const float*)d_in[10]; a.ln2_g = (const float*)d_in[11]; a.ln2_b = (const float*)d_in[12];
    a.rg_w = (const float*)d_in[13]; a.rg_b = (const float*)d_in[14]; a.re_w = (const float*)d_in[15]; a.re_b = (const float*)d_in[16];
    a.e_w_in = (const float*)d_in[17]; a.e_w_down = (const float*)d_in[18];
    a.out = (float*)d_out; a.ws = (unsigned char*)d_ws;
    void* kargs[] = {&a};
    const hipError_t e = hipLaunchCooperativeKernel((const void*)fwd_megakernel, dim3(grid), dim3(NTHREADS), kargs, LDS_BYTES, stream);
    if (e != hipSuccess) fprintf(stderr, "kernel_launch: cooperative launch failed: %s (grid %d)\n", hipGetErrorString(e), grid);
}
```

```cpp
#include <hip/hip_runtime.h>
#include <hip/hip_cooperative_groups.h>
#include <cstdio>
#include <cstdint>
namespace cg = cooperative_groups;

namespace pg8 {
#define PG8_LAS __attribute__((address_space(3)))
typedef unsigned short bf16_t;
typedef short bf16x8 __attribute__((ext_vector_type(8)));
typedef float f32x4 __attribute__((ext_vector_type(4)));
typedef unsigned u32x4 __attribute__((ext_vector_type(4)));
typedef unsigned u32x2 __attribute__((ext_vector_type(2)));
constexpr int BM = 256, BK = 64, HALF = 128, HTB = HALF * BK * 2  , STAGE_BYTES = 8 * HTB, NXCD = 8, WGM = 8;

__host__ __device__ __forceinline__ int lds_byte(int r, int c) { const int st = (r >> 4) * 2 + (c >> 5), rr = r & 15, cc = c & 31, ob = rr * 64 + cc * 2; return st * 1024 + (ob ^ (((ob >> 9) & 1) << 5)); }
__host__ __device__ __forceinline__ void stage_rc(int b, int& R, int& C) { const int st = b / 1024, sb = b % 1024, swz = sb ^ (((sb >> 9) & 1) << 5); R = (st >> 1) * 16 + swz / 64; C = (st & 1) * 32 + (swz % 64) / 2; }
__host__ __device__ __forceinline__ int perm32(int rho) { const int n = rho >> 4, i = rho & 15; return 8 * (i >> 2) + 4 * n + (i & 3); }

struct Unit { const char* b0; const char* b1; int arow; int p0, p1, p2, p3; };

__device__ __forceinline__ bool static_tile(int i, int G, int c, int nM, int nN, int& pm, int& pn) {
    const int nwg = nM * nN; const long L = (long)i * G + c; if (L >= nwg) return false;
    int wgid = (int)L; { const int q = nwg / NXCD, r = nwg % NXCD, xcd = wgid % NXCD, off = wgid / NXCD; wgid = (xcd < r ? xcd * (q + 1) : r * (q + 1) + (xcd - r) * q) + off; }
    const int nig = WGM * nN, gid = wgid / nig, fm = gid * WGM, gsz = (nM - fm) < WGM ? (nM - fm) : WGM;
    pm = fm + ((wgid % nig) % gsz); pn = (wgid % nig) / gsz; return true;
}

__device__ __forceinline__ unsigned cvt_pk_bf16(float lo, float hi) { unsigned r; asm volatile("v_cvt_pk_bf16_f32 %0, %1, %2" : "=v"(r) : "v"(lo), "v"(hi)); return r; }

template <class Epi, class Sched>
__device__ __forceinline__ void gemm_phase(PG8_LAS unsigned char* lds, const char* Abase, const int K, const Sched& S, const Epi& E) {
    int tid_ = threadIdx.x; asm volatile("" : "+v"(tid_));
    const int tid = tid_, wid = __builtin_amdgcn_readfirstlane(tid >> 6), lane = tid & 63, wr = wid >> 2, wc = wid & 3, fr = lane & 15, fq = lane >> 4;
    const int nt = K / BK;
    int R[2], C[2]; unsigned voffB[2];
#pragma unroll
    for (int i = 0; i < 2; ++i) { stage_rc(tid * 16 + i * 8192, R[i], C[i]); const int Rb = Epi::PERM ? ((R[i] & ~31) + perm32(R[i] & 31)) : R[i]; voffB[i] = (unsigned)(Rb * K + C[i]) * 2u; }
    const size_t kstep = (size_t)(BK * 2);
    const unsigned ldsw = (unsigned)wid * 1024u;
    const int aoff = lds_byte(wr * 64 + fr, fq * 8), boff = lds_byte(wc * 32 + fr, fq * 8);
#define PG8_SA(b, h) (((b) * 2 + (h)) * HTB)
#define PG8_SB(b, h) ((4 + (b) * 2 + (h)) * HTB)
#define PG8_STAGE(bufoff, gbase, v0, v1) do { \
        __builtin_amdgcn_global_load_lds((const unsigned*)((const char*)(gbase) + (v0)), (PG8_LAS unsigned*)(lds + (bufoff) + ldsw), 16, 0, 0); \
        __builtin_amdgcn_global_load_lds((const unsigned*)((const char*)(gbase) + (v1)), (PG8_LAS unsigned*)(lds + (bufoff) + ldsw + 8192), 16, 0, 0); } while (0)
#define PG8_STAGEB(bufoff, gbase) PG8_STAGE(bufoff, gbase, voffB[0], voffB[1])
#define PG8_LDA(dst, b, h) do { _Pragma("unroll") for (int m = 0; m < 4; ++m) _Pragma("unroll") for (int k = 0; k < 2; ++k) dst[m][k] = *(const PG8_LAS bf16x8*)(lds + PG8_SA(b, h) + aoff + m * 2048 + k * 1024); } while (0)
#define PG8_LDB(dst, b, h) do { _Pragma("unroll") for (int n = 0; n < 2; ++n) _Pragma("unroll") for (int k = 0; k < 2; ++k) dst[n][k] = *(const PG8_LAS bf16x8*)(lds + PG8_SB(b, h) + boff + n * 2048 + k * 1024); } while (0)
#define PG8_MMA(ai, bj, At, Bt) do { __builtin_amdgcn_s_setprio(1); _Pragma("unroll") for (int m = 0; m < 4; ++m) _Pragma("unroll") for (int n = 0; n < 2; ++n) _Pragma("unroll") for (int k = 0; k < 2; ++k) \
        acc[ai][bj][m][n] = __builtin_amdgcn_mfma_f32_16x16x32_bf16(Bt[n][k], At[m][k], acc[ai][bj][m][n], 0, 0, 0); __builtin_amdgcn_s_setprio(0); } while (0)
#define PG8_WAIT_V(n) asm volatile("s_waitcnt vmcnt(" #n ")" ::: "memory")
#define PG8_WAIT_L(n) asm volatile("s_waitcnt lgkmcnt(" #n ")" ::: "memory")
#define PG8_BAR __builtin_amdgcn_s_barrier()
#define PG8_SCHED __builtin_amdgcn_sched_barrier(0)
    Unit cur, nxt; int ui = 0;
    if (!S.next(0, cur)) return;
    f32x4 acc[2][2][4][2];
#pragma unroll
    for (int a = 0; a < 2; ++a)
#pragma unroll
        for (int b = 0; b < 2; ++b)
#pragma unroll
            for (int m = 0; m < 4; ++m)
#pragma unroll
                for (int n = 0; n < 2; ++n) acc[a][b][m][n] = (f32x4){0.f, 0.f, 0.f, 0.f};
    bf16x8 At[4][2], B0[2][2], B1[2][2];
    unsigned vA00, vA01, vA10, vA11, vN00, vN01, vN10, vN11;
    S.a_ready(cur, S.peek(cur));
    S.a_offs(cur, R, C, vA00, vA01, vA10, vA11);
    const char* cB0 = cur.b0; const char* cB1 = cur.b1;
    PG8_STAGEB(PG8_SB(0, 0), cB0); PG8_STAGEB(PG8_SB(0, 1), cB1); PG8_STAGE(PG8_SA(0, 0), Abase, vA00, vA01); PG8_STAGE(PG8_SA(0, 1), Abase, vA10, vA11);
    if (wr == 1) PG8_BAR;
    PG8_WAIT_V(2); PG8_BAR;
    PG8_STAGEB(PG8_SB(1, 0), cB0 + kstep); PG8_STAGE(PG8_SA(1, 0), Abase + kstep, vA00, vA01); PG8_STAGEB(PG8_SB(1, 1), cB1 + kstep);
    PG8_WAIT_V(6); PG8_BAR;
    for (;;) {
        const bool has_next = S.next(ui + 1, nxt);
        if (has_next) S.a_offs(nxt, R, C, vN00, vN01, vN10, vN11); else { vN00 = vA00; vN01 = vA01; vN10 = vA10; vN11 = vA11; }
        const char* nB0 = has_next ? nxt.b0 : cB0; const char* nB1 = has_next ? nxt.b1 : cB1;
        const unsigned pk = has_next ? S.peek(nxt) : 0u;
        const bool skip1 = S.half_only(cur);
        for (int t = 0; t < nt; t += 2) {
            const bool last = (t == nt - 2);
            if (last && has_next) S.a_ready(nxt, pk);
            const char* a1 = Abase + (size_t)(t + 1) * kstep;
            PG8_LDB(B0, 0, 0); PG8_LDB(B1, 0, 1); PG8_SCHED; PG8_LDA(At, 0, 0); PG8_STAGE(PG8_SA(1, 1), a1, vA10, vA11);
            PG8_WAIT_V(8); PG8_WAIT_L(0); PG8_BAR; PG8_MMA(0, 0, At, B0); PG8_MMA(0, 1, At, B1); PG8_BAR; PG8_SCHED;
            if (last) { vA00 = vN00; vA01 = vN01; vA10 = vN10; vA11 = vN11; }
            const char* a2 = last ? Abase : Abase + (size_t)(t + 2) * kstep;
            const char* b20 = last ? nB0 : cB0 + (size_t)(t + 2) * kstep; const char* b21 = last ? nB1 : cB1 + (size_t)(t + 2) * kstep;
            const char* a3 = a2 + kstep; const char* b30 = b20 + kstep; const char* b31 = b21 + kstep;
            PG8_LDA(At, 0, 1); PG8_STAGEB(PG8_SB(0, 0), b20); PG8_STAGEB(PG8_SB(0, 1), b21); PG8_STAGE(PG8_SA(0, 0), a2, vA00, vA01);
            PG8_WAIT_V(8); PG8_WAIT_L(0); PG8_BAR; if (!skip1) { PG8_MMA(1, 0, At, B0); PG8_MMA(1, 1, At, B1); } PG8_BAR; PG8_SCHED;
            PG8_LDB(B0, 1, 0); PG8_LDB(B1, 1, 1); PG8_SCHED; PG8_LDA(At, 1, 0); PG8_STAGE(PG8_SA(0, 1), a2, vA10, vA11);
            PG8_WAIT_V(8); PG8_WAIT_L(0); PG8_BAR; PG8_MMA(0, 0, At, B0); PG8_MMA(0, 1, At, B1); PG8_BAR; PG8_SCHED;
            PG8_LDA(At, 1, 1); PG8_STAGEB(PG8_SB(1, 0), b30); PG8_STAGEB(PG8_SB(1, 1), b31); PG8_STAGE(PG8_SA(1, 0), a3, vA00, vA01);
            PG8_WAIT_V(8); PG8_WAIT_L(0); PG8_BAR; if (!skip1) { PG8_MMA(1, 0, At, B0); PG8_MMA(1, 1, At, B1); } PG8_BAR; PG8_SCHED;
        }
        if (wr == 0) PG8_BAR;
        E(acc, cur, wr, wc, fr, fq);
        S.done(cur);
        if (!has_next) break;
#pragma unroll
        for (int a = 0; a < 2; ++a)
#pragma unroll
            for (int b = 0; b < 2; ++b)
#pragma unroll
                for (int m = 0; m < 4; ++m)
#pragma unroll
                    for (int n = 0; n < 2; ++n) acc[a][b][m][n] = (f32x4){0.f, 0.f, 0.f, 0.f};
        cur = nxt; cB0 = nB0; cB1 = nB1; ++ui;
        if (wr == 1) PG8_BAR;
    }
    PG8_WAIT_V(0);
    PG8_BAR;
#undef PG8_SA
#undef PG8_SB
#undef PG8_STAGE
#undef PG8_STAGEB
#undef PG8_LDA
#undef PG8_LDB
#undef PG8_MMA
#undef PG8_WAIT_V
#undef PG8_WAIT_L
#undef PG8_BAR
#undef PG8_SCHED
}
}
#include <hip/hip_bf16.h>
#include <cmath>
namespace attn_body {
using bf16=__hip_bfloat16;
using bf16x8=__attribute__((ext_vector_type(8)))short;
using s16x4=__attribute__((ext_vector_type(4)))short;
using f32x16=__attribute__((ext_vector_type(16)))float;
using u32x4=__attribute__((ext_vector_type(4)))unsigned;
constexpr int D=64,DM=1024;
constexpr int NW=8,QBLK=32,QB=QBLK*NW,KVBLK=64;
constexpr int ATTN_PITCH=DM, ATTN_UNIT_ROWS=QB;
__device__ __forceinline__ int crow(int r,int hi){return (r&3)+8*(r>>2)+4*hi;}
#define SBAR() __builtin_amdgcn_sched_barrier(0)
__device__ __forceinline__ void cmask(f32x16&p0,f32x16&p1,int jb,int qrel,int hi){
  const float NEG=-INFINITY; int kb=64*jb+4*hi;
  #pragma unroll
  for(int r=0;r<16;++r){int kv=kb+(r&3)+8*(r>>2); if(kv>qrel)p0[r]=NEG; if(kv+32>qrel)p1[r]=NEG;}
}

constexpr int NSLOT=3, SLOTB=8192;
constexpr int LDS_K=0, LDS_V=NSLOT*SLOTB, LDS_WS=2*NSLOT*SLOTB, LDS_OST=LDS_WS+NW*64*4, LDS_BYTES=LDS_OST+NW*4096;
constexpr float C2=0.125f*1.4426950408889634f;
__device__ __forceinline__ void glds16(const void*gsrc,unsigned lds_dst){unsigned keep;
  asm volatile("s_mov_b32 %0, m0\n\ts_mov_b32 m0, %2\n\ts_nop 0\n\tglobal_load_lds_dwordx4 %1, off\n\ts_mov_b32 m0, %0":"=&s"(keep):"v"(gsrc),"s"(lds_dst):"memory");}
__device__ __forceinline__ void glds16s(const void*sbase,unsigned voff,unsigned lds_dst){unsigned keep;
  asm volatile("s_mov_b32 %0, m0\n\ts_mov_b32 m0, %3\n\ts_nop 4\n\tglobal_load_lds_dwordx4 %1, %2\n\ts_mov_b32 m0, %0":"=&s"(keep):"v"(voff),"s"(sbase),"s"(lds_dst):"memory");}
__device__ __forceinline__ float max3f(float a,float b,float c){float r;asm("v_max3_f32 %0, %1, %2, %3":"=v"(r):"v"(a),"v"(b),"v"(c));return r;}
__device__ __forceinline__ float max2f(float a,float b){float r;asm("v_max_f32_e32 %0, %1, %2":"=v"(r):"v"(a),"v"(b));return r;}
__device__ __forceinline__ float fadd_s(float a,float b){float r;asm("v_add_f32_e32 %0, %1, %2":"=v"(r):"v"(a),"v"(b));return r;}
__device__ __forceinline__ float fsub_s(float a,float b){float r;asm("v_sub_f32_e32 %0, %1, %2":"=v"(r):"v"(a),"v"(b));return r;}
typedef float f32x2_t __attribute__((ext_vector_type(2))); typedef __bf16 bf16x2_t __attribute__((ext_vector_type(2)));
__device__ __forceinline__ unsigned cvtpk_s(float lo,float hi){f32x2_t v={lo,hi};bf16x2_t b=__builtin_convertvector(v,bf16x2_t);return __builtin_bit_cast(unsigned,b);}
#define WAIT_BAR(N) asm volatile("s_waitcnt vmcnt(" #N ") lgkmcnt(0)\n\ts_barrier":::"memory")

__device__ __forceinline__ void qkt(f32x16&p0,f32x16&p1,const char*Kslot,const bf16x8*qr,const f32x16&negm,int r32,int hi){
  const char*kb=Kslot+hi*1024+r32*16;
  #pragma unroll
  for(int d0=0;d0<4;++d0){
    const bf16x8 b0=*reinterpret_cast<const bf16x8*>(kb+d0*2048);
    const bf16x8 b1=*reinterpret_cast<const bf16x8*>(kb+d0*2048+512);
    if(d0==0){p0=__builtin_amdgcn_mfma_f32_32x32x16_bf16(b0,qr[0],negm,0,0,0);p1=__builtin_amdgcn_mfma_f32_32x32x16_bf16(b1,qr[0],negm,0,0,0);}
    else{p0=__builtin_amdgcn_mfma_f32_32x32x16_bf16(b0,qr[d0],p0,0,0,0);p1=__builtin_amdgcn_mfma_f32_32x32x16_bf16(b1,qr[d0],p1,0,0,0);}}
}
typedef __attribute__((address_space(3))) const char* lds_cptr;
typedef short v4i16_t __attribute__((ext_vector_type(4)));
__device__ __forceinline__ void kload8(bf16x8*kf,lds_cptr kp){
  kf[0]=*(const __attribute__((address_space(3))) bf16x8*)(kp);      kf[1]=*(const __attribute__((address_space(3))) bf16x8*)(kp+512);
  kf[2]=*(const __attribute__((address_space(3))) bf16x8*)(kp+2048); kf[3]=*(const __attribute__((address_space(3))) bf16x8*)(kp+2560);
  kf[4]=*(const __attribute__((address_space(3))) bf16x8*)(kp+4096); kf[5]=*(const __attribute__((address_space(3))) bf16x8*)(kp+4608);
  kf[6]=*(const __attribute__((address_space(3))) bf16x8*)(kp+6144); kf[7]=*(const __attribute__((address_space(3))) bf16x8*)(kp+6656);
}
__device__ __forceinline__ void kload2(bf16x8*kf,lds_cptr kp,int j){ kf[2*j]=*(const __attribute__((address_space(3))) bf16x8*)(kp+j*2048); kf[2*j+1]=*(const __attribute__((address_space(3))) bf16x8*)(kp+j*2048+512); }
__device__ __forceinline__ s16x4 vtr(lds_cptr p){ return __builtin_bit_cast(s16x4,__builtin_amdgcn_ds_read_tr16_b64_v4i16((__attribute__((address_space(3))) v4i16_t*)p)); }
__device__ __forceinline__ float rowmax(const f32x16&p0,const f32x16&p1){
  float a=max3f(p0[0],p0[1],p1[0]),b=max3f(p0[2],p0[3],p1[1]);a=max3f(a,p1[2],p1[3]);
  #pragma unroll
  for(int r=4;r<16;r+=4){a=max3f(a,p0[r],p0[r+1]);b=max3f(b,p0[r+2],p0[r+3]);a=max3f(a,p1[r],p1[r+1]);b=max3f(b,p1[r+2],p1[r+3]);}
  const float m=max2f(a,b);
  auto rr=__builtin_amdgcn_permlane32_swap(__float_as_uint(m),__float_as_uint(m),false,false);
  return max2f(__uint_as_float(rr[0]),__uint_as_float(rr[1]));
}
__device__ __forceinline__ void pv(f32x16*o,int vb,bf16x8 pa0,bf16x8 pa1,bf16x8 pa2,bf16x8 pa3){
  #pragma unroll
  for(int d0=0;d0<2;++d0){s16x4 lo[4],hi[4];
    #pragma unroll
    for(int ks=0;ks<4;++ks){
      asm volatile("ds_read_b64_tr_b16 %0,%1 offset:%c2":"=&v"(lo[ks]):"v"(vb),"i"(d0*4096+ks*1024):"memory");
      asm volatile("ds_read_b64_tr_b16 %0,%1 offset:%c2":"=&v"(hi[ks]):"v"(vb),"i"(d0*4096+ks*1024+512):"memory");}
    asm volatile("s_waitcnt lgkmcnt(0)":::"memory");SBAR();
    #define PK(k) (bf16x8){lo[k][0],lo[k][1],lo[k][2],lo[k][3],hi[k][0],hi[k][1],hi[k][2],hi[k][3]}
    o[d0]=__builtin_amdgcn_mfma_f32_32x32x16_bf16(pa0,PK(0),o[d0],0,0,0);
    o[d0]=__builtin_amdgcn_mfma_f32_32x32x16_bf16(pa1,PK(1),o[d0],0,0,0);
    o[d0]=__builtin_amdgcn_mfma_f32_32x32x16_bf16(pa2,PK(2),o[d0],0,0,0);
    o[d0]=__builtin_amdgcn_mfma_f32_32x32x16_bf16(pa3,PK(3),o[d0],0,0,0);
    #undef PK
  }
}

#ifndef ATTN_STORE16
#define ATTN_STORE16(p,v) (*(u32x4*)(p)=(v))
#endif
template<int THRL> __device__ __forceinline__ void attn_unit(long rowbase,int qb,const bf16*Qc,const bf16*__restrict__ Kc,const bf16*__restrict__ Vc,bf16*Oc,char*shm){
  int tid_=threadIdx.x; asm volatile("":"+v"(tid_)); const int tid=tid_,lane=tid&63,r32=lane&31,hi=lane>>5; const int wid=__builtin_amdgcn_readfirstlane(tid>>6);
  const int q0=qb*QB;
  const bf16*Qw=Qc+(rowbase+q0+wid*QBLK)*DM;
  const bf16*Kh=Kc+rowbase*DM,*Vh=Vc+rowbase*DM;
  const unsigned lds0=(unsigned)(uintptr_t)shm;
  float*wsf=(float*)(shm+LDS_WS)+wid*64;
  const unsigned koff=(unsigned)(lane*DM+wid*8)*2u;
  const unsigned voffv=(unsigned)((16*(wid&3)+(lane>>2))*DM+(wid>>2)*32+(lane&3)*8)*2u;
  const unsigned kdst=lds0+LDS_K+wid*1024, vdst=lds0+LDS_V+wid*1024;
  #define DMA_K(t,slot) glds16s(Kh+(long)(t)*KVBLK*DM,koff,(unsigned)__builtin_amdgcn_readfirstlane(kdst+(slot)))
  #define DMA_V(t,slot) glds16s(Vh+(long)(t)*KVBLK*DM,voffv,(unsigned)__builtin_amdgcn_readfirstlane(vdst+(slot)))
  const int vb0=(int)(lds0+LDS_V)+((lane>>4)&1)*32+(lane&3)*8+(4*hi+((lane&15)>>2))*64;
  const char*Kbase=shm+LDS_K; bf16x8 kf[8];
  const lds_cptr shm3=(lds_cptr)shm; const lds_cptr kp0=shm3+LDS_K+hi*1024+r32*16; const lds_cptr vp0=shm3+LDS_V+((lane>>4)&1)*32+(lane&3)*8+(4*hi+((lane&15)>>2))*64;
  const int NT=(q0+QB)/KVBLK;
  DMA_K(0,0);DMA_V(0,0);DMA_K(1,SLOTB);
  bf16x8 qr[4];
  #pragma unroll
  for(int d0=0;d0<4;++d0)qr[d0]=*reinterpret_cast<const bf16x8*>(&Qw[(long)r32*DM+d0*16+hi*8]);
  float mhat=0.f,l_reg=0.f;f32x16 o[2];o[0]=f32x16{};o[1]=f32x16{};f32x16 negm=f32x16{};asm volatile("":"+v"(negm));
  const int qrel=wid*QBLK+r32;
  #define CMASK(P0,P1,t) do{int jb_=(t)-(NT-4); if(jb_>=0)cmask(P0,P1,jb_,qrel,hi);}while(0)
  bool resc=false;
  #define START(P0,P1) do{ const float rm=rowmax(P0,P1); resc=false; \
    { const float dl=rm; mhat=fadd_s(mhat,dl); \
      _Pragma("unroll") for(int r=0;r<16;++r){P0[r]=fsub_s(P0[r],dl);P1[r]=fsub_s(P1[r],dl);} \
      _Pragma("unroll") for(int r=0;r<16;++r)negm[r]=-mhat; asm volatile("":"+v"(negm)); } \
    _Pragma("unroll") for(int r=0;r<16;++r)P0[r]=__builtin_amdgcn_exp2f(P0[r]); }while(0)
  #define RESC() do{ if(resc){ asm volatile("s_waitcnt lgkmcnt(0)":::"memory"); \
      _Pragma("unroll") for(int d_=0;d_<2;++d_) _Pragma("unroll") for(int r=0;r<16;++r)o[d_][r]*=wsf[crow(r,hi)]; } }while(0)
  f32x16 pA0,pA1,pB0,pB1;
  int sl_prev=0,sl_cur=0,sl_next=SLOTB;
  #define ROT() do{sl_prev=sl_cur;sl_cur=sl_next;sl_next=(sl_next==(NSLOT-1)*SLOTB)?0:sl_next+SLOTB;}while(0)
  DMA_K(2,2*SLOTB);
  WAIT_BAR(3);
  qkt(pA0,pA1,Kbase,qr,negm,r32,hi);asm volatile("s_nop 15\n\ts_nop 7":"+v"(pA0),"+v"(pA1));CMASK(pA0,pA1,0);
  START(pA0,pA1);
  _Pragma("unroll") for(int r=0;r<16;++r)pA1[r]=__builtin_amdgcn_exp2f(pA1[r]);
  WAIT_BAR(0);
  DMA_K(3,0);DMA_V(1,SLOTB);
  ROT();
  kload8(kf,kp0+sl_cur);
  WAIT_BAR(2);
  s16x4 vlo[8],vhi[8]; u32x4 pw0,pw1,pw2,pw3;
  #define PKW(P,B) cvtpk_s(P[B],P[B+1])
  #define PAF(k) __builtin_bit_cast(bf16x8,pw##k)
  #define VFR(i) (bf16x8){vlo[i][0],vlo[i][1],vlo[i][2],vlo[i][3],vhi[i][0],vhi[i][1],vhi[i][2],vhi[i][3]}
  #define PIN(x) asm volatile("":"+v"(x))
  #define MX3(a,b,c) __builtin_fmaxf(__builtin_fmaxf((a),(b)),(c))
  #define GAPA(MF,A0,A1,A2,A3,W0,W1,PW) do{ MF; sacc+=A0; sacc+=A1; sacc+=A2; sacc+=A3; PIN(sacc); W0; W1; PIN(PW); SBAR(); }while(0)
  #define EX(v) __builtin_amdgcn_exp2f(v)
  #define GAPB(MF,X,B) do{ MF; X[B]=EX(X[B]); X[B+1]=EX(X[B+1]); X[B+2]=EX(X[B+2]); X[B+3]=EX(X[B+3]); PIN(X); SBAR(); }while(0)
  #define VRD(i) do{ vlo[i]=vtr(vp_+(((i)>>2)*4096+((i)&3)*1024)); vhi[i]=vtr(vp_+(((i)>>2)*4096+((i)&3)*1024+512)); }while(0)
  #define KRD(G,j) do{ if(G){ kload2(kf,kp0+sl_next,j); SBAR(); } }while(0)
  #define STEP(C0,C1,P0,P1,t,GK,GV,GL) do{ SBAR(); \
    const lds_cptr vp_=vp0+sl_prev; \
    VRD(0); SBAR(); float sacc=(P0[0]+P0[1]); \
    GAPA(C0=__builtin_amdgcn_mfma_f32_32x32x16_bf16(kf[0],qr[0],negm,0,0,0), P0[2],P0[3],P0[4],P0[5],     pw0[0]=PKW(P0,0), pw0[1]=PKW(P0,2), pw0); \
    VRD(4); SBAR(); GAPA(C1=__builtin_amdgcn_mfma_f32_32x32x16_bf16(kf[1],qr[0],negm,0,0,0), P0[6],P0[7],P0[8],P0[9],     pw0[2]=PKW(P0,4), pw0[3]=PKW(P0,6), pw0); \
    VRD(1); SBAR(); GAPA(C0=__builtin_amdgcn_mfma_f32_32x32x16_bf16(kf[2],qr[1],C0,0,0,0),   P0[10],P0[11],P0[12],P0[13], pw1[0]=PKW(P0,8), pw1[1]=PKW(P0,10), pw1); \
    VRD(5); SBAR(); GAPA(C1=__builtin_amdgcn_mfma_f32_32x32x16_bf16(kf[3],qr[1],C1,0,0,0),   P0[14],P0[15],P1[0],P1[1],   pw1[2]=PKW(P0,12),pw1[3]=PKW(P0,14), pw1); \
    VRD(2); SBAR(); GAPA(C0=__builtin_amdgcn_mfma_f32_32x32x16_bf16(kf[4],qr[2],C0,0,0,0),   P1[2],P1[3],P1[4],P1[5],     pw2[0]=PKW(P1,0), pw2[1]=PKW(P1,2), pw2); \
    VRD(6); SBAR(); GAPA(C1=__builtin_amdgcn_mfma_f32_32x32x16_bf16(kf[5],qr[2],C1,0,0,0),   P1[6],P1[7],P1[8],P1[9],     pw2[2]=PKW(P1,4), pw2[3]=PKW(P1,6), pw2); \
    VRD(3); SBAR(); GAPA(C0=__builtin_amdgcn_mfma_f32_32x32x16_bf16(kf[6],qr[3],C0,0,0,0),   P1[10],P1[11],P1[12],P1[13], pw3[0]=PKW(P1,8), pw3[1]=PKW(P1,10), pw3); \
    VRD(7); SBAR(); GAPA(C1=__builtin_amdgcn_mfma_f32_32x32x16_bf16(kf[7],qr[3],C1,0,0,0),   P1[14],P1[15],0.f,0.f,       pw3[2]=PKW(P1,12),pw3[3]=PKW(P1,14), pw3); \
    l_reg+=sacc; \
    if(GK){DMA_K((t)+3,sl_cur);} if(GV){DMA_V((t)+1,sl_next);} \
    CMASK(C0,C1,t); \
    { float a=MX3(C0[0],C0[1],C1[0]),b=MX3(C0[2],C0[3],C1[1]); a=MX3(a,C1[2],C1[3]); \
      _Pragma("unroll") for(int r=4;r<16;r+=4){a=MX3(a,C0[r],C0[r+1]);b=MX3(b,C0[r+2],C0[r+3]);a=MX3(a,C1[r],C1[r+1]);b=MX3(b,C1[r+2],C1[r+3]);} \
      float rm=__builtin_fmaxf(a,b); { auto rr=__builtin_amdgcn_permlane32_swap(__float_as_uint(rm),__float_as_uint(rm),false,false); rm=__builtin_fmaxf(__uint_as_float(rr[0]),__uint_as_float(rr[1])); } \
      resc=false; \
      if(__builtin_expect(__any(rm>(float)THRL),0)){ const float dl=__builtin_fmaxf(rm,0.f); mhat+=dl; \
        _Pragma("unroll") for(int r=0;r<16;++r){C0[r]-=dl;C1[r]-=dl;} \
        _Pragma("unroll") for(int r=0;r<16;++r)negm[r]=-mhat; asm volatile("":"+v"(negm)); \
        const float f=__builtin_amdgcn_exp2f(-dl); l_reg*=f; if(hi==0)wsf[r32]=f; resc=true; } } \
    SBAR(); \
    GAPB(o[0]=__builtin_amdgcn_mfma_f32_32x32x16_bf16(PAF(0),VFR(0),o[0],0,0,0), C0,0); \
    GAPB(o[1]=__builtin_amdgcn_mfma_f32_32x32x16_bf16(PAF(0),VFR(4),o[1],0,0,0), C0,4); \
    KRD(GL,0); GAPB(o[0]=__builtin_amdgcn_mfma_f32_32x32x16_bf16(PAF(1),VFR(1),o[0],0,0,0), C0,8); \
    KRD(GL,1); GAPB(o[1]=__builtin_amdgcn_mfma_f32_32x32x16_bf16(PAF(1),VFR(5),o[1],0,0,0), C0,12); \
    KRD(GL,2); GAPB(o[0]=__builtin_amdgcn_mfma_f32_32x32x16_bf16(PAF(2),VFR(2),o[0],0,0,0), C1,0); \
    KRD(GL,3); GAPB(o[1]=__builtin_amdgcn_mfma_f32_32x32x16_bf16(PAF(2),VFR(6),o[1],0,0,0), C1,4); \
    GAPB(o[0]=__builtin_amdgcn_mfma_f32_32x32x16_bf16(PAF(3),VFR(3),o[0],0,0,0), C1,8); \
    GAPB(o[1]=__builtin_amdgcn_mfma_f32_32x32x16_bf16(PAF(3),VFR(7),o[1],0,0,0), C1,12); \
    }while(0)
  int t=1;
  #undef CMASK
  #define CMASK(P0,P1,t) do{}while(0)
  for(;t+5<NT;t+=2){
    STEP(pB0,pB1,pA0,pA1,t,true,true,true);     WAIT_BAR(2); RESC(); ROT();
    STEP(pA0,pA1,pB0,pB1,t+1,true,true,true);   WAIT_BAR(2); RESC(); ROT();
  }
  #undef CMASK
  #define CMASK(P0,P1,t) do{int jb_=(t)-(NT-4); if(jb_>=0)cmask(P0,P1,jb_,qrel,hi);}while(0)
  #define ENDW(tt) do{ if((tt)+3<NT){WAIT_BAR(2);} else if((tt)+2<NT){WAIT_BAR(1);} else {WAIT_BAR(0);} }while(0)
  for(;t+1<NT;t+=2){
    STEP(pB0,pB1,pA0,pA1,t,(t+3<NT),(t+1<NT),(t+1<NT));       ENDW(t);   RESC(); ROT();
    STEP(pA0,pA1,pB0,pB1,t+1,(t+4<NT),(t+2<NT),(t+2<NT));     ENDW(t+1); RESC(); ROT();
  }
  STEP(pB0,pB1,pA0,pA1,NT-1,false,false,false); RESC();
  { float sacc=pB0[0]+pB0[1]; _Pragma("unroll") for(int r=2;r<16;++r)sacc+=pB0[r]; _Pragma("unroll") for(int r=0;r<16;++r)sacc+=pB1[r]; l_reg+=sacc;
    pw0=(u32x4){PKW(pB0,0),PKW(pB0,2),PKW(pB0,4),PKW(pB0,6)};pw1=(u32x4){PKW(pB0,8),PKW(pB0,10),PKW(pB0,12),PKW(pB0,14)};pw2=(u32x4){PKW(pB1,0),PKW(pB1,2),PKW(pB1,4),PKW(pB1,6)};pw3=(u32x4){PKW(pB1,8),PKW(pB1,10),PKW(pB1,12),PKW(pB1,14)};
    SBAR(); pv(o,vb0+sl_cur,PAF(0),PAF(1),PAF(2),PAF(3)); }
  #undef PKW
  #undef PAF
  #undef VFR
  #undef PIN
  #undef MX3
  #undef GAPA
  #undef GAPB
  #undef EX
  #undef VRD
  #undef KRD
  #undef STEP
  #undef ENDW
  {auto rr=__builtin_amdgcn_permlane32_swap(__float_as_uint(l_reg),__float_as_uint(l_reg),false,false);l_reg=__uint_as_float(rr[0])+__uint_as_float(rr[1]);}
  if(hi==0)wsf[32+r32]=l_reg;asm volatile("s_waitcnt lgkmcnt(0)":::"memory");
  float rli[16];
  #pragma unroll
  for(int r=0;r<16;++r)rli[r]=__builtin_amdgcn_rcpf(wsf[32+crow(r,hi)]);
  bf16*Ow=Oc+(rowbase+q0+wid*QBLK)*DM;
  { bf16*stg=(bf16*)(shm+LDS_OST)+wid*2048;
    #pragma unroll
    for(int r=0;r<16;++r){const int orow=crow(r,hi);
      #pragma unroll
      for(int d0=0;d0<2;++d0)stg[orow*64+d0*32+r32]=__float2bfloat16(o[d0][r]*rli[r]);}
    asm volatile("s_waitcnt lgkmcnt(0)":::"memory");
    #pragma unroll
    for(int i=0;i<4;++i){const int row=i*8+(lane>>3),ch=lane&7; const u32x4 v=*(const u32x4*)(stg+row*64+ch*8); ATTN_STORE16(Ow+(long)row*DM+ch*8,v);} }
  asm volatile("s_waitcnt lgkmcnt(0)\n\ts_barrier":::"memory");
  #undef DMA_K
  #undef DMA_V
  #undef CMASK
  #undef START
  #undef RESC
  #undef ROT
}
constexpr int ATTN_LDS_BYTES=LDS_BYTES;
#undef SBAR
#undef WAIT_BAR
}
namespace mk {
#define GAS __attribute__((address_space(1)))
#define LAS __attribute__((address_space(3)))
typedef unsigned short bf16;
typedef unsigned v4u __attribute__((ext_vector_type(4)));
typedef unsigned v2u __attribute__((ext_vector_type(2)));
typedef float f32x4 __attribute__((ext_vector_type(4)));
using pg8::Unit;
using pg8::cvt_pk_bf16;

constexpr int D = 1024, BATCH = 8, SEQ = 2048, T = BATCH * SEQ, NH = 8, NG = 4, EPG = 8, NE = 32, DE = 512, NRW = NG + NE;
constexpr float ALPHA = 1.4142135623730951f, LN_EPS = 1e-5f, RMS_EPS = 1e-5f;
constexpr float LAM_INIT = 0.35550906f;
constexpr float QSCALE = 0.125f * 1.4426950408889634f;
constexpr int CNT_STRIDE = 64;
constexpr int CAP = T;
constexpr int NWAVES = 8, NTHREADS = 512;
#ifndef P0B_FILL
#define P0B_FILL 1
#endif
#ifndef MOE_MERGE
#define MOE_MERGE 0
#endif
#ifndef P0B_SPLIT
#define P0B_SPLIT 9216
#endif

constexpr size_t MiB = 1u << 20;
constexpr size_t WS_CTL = 0, WS_W1T = 1 * MiB, WS_W2T = 7 * MiB, WS_WKVQ = 9 * MiB, WS_WOT = 15 * MiB, WS_RWT = 17 * MiB;
constexpr size_t WS_RWH = 17 * MiB + 512 * 1024;
constexpr size_t WS_WUT = 24 * MiB, WS_WDT = 152 * MiB, WS_XB = 216 * MiB, WS_GB = 248 * MiB, WS_U = 280 * MiB, WS_A2 = 312 * MiB, WS_Z = 344 * MiB, WS_X1B = 408 * MiB;
constexpr size_t WS_ACT = 440 * MiB, WS_YP = 480 * MiB, WS_X2B = 544 * MiB, WS_K = 576 * MiB, WS_V = 608 * MiB, WS_Q = 640 * MiB, WS_O0 = 672 * MiB, WS_O1 = 704 * MiB;
constexpr size_t WS_A3 = 736 * MiB, WS_X3B = 768 * MiB;
#ifdef MKPROBE
constexpr size_t WS_PERM = 18 * MiB;
constexpr size_t WS_Z1 = 800 * MiB, WS_ACT1 = 864 * MiB, WS_YP1 = 904 * MiB, WS_PERM1 = 968 * MiB, WS_END = 972 * MiB;
#else
constexpr size_t WS_PERM = 18 * MiB;
constexpr size_t WS_Z1 = WS_Z, WS_ACT1 = WS_ACT, WS_YP1 = WS_YP, WS_PERM1 = WS_PERM, WS_END = 800 * MiB;
#endif
#define LZ(l) ((l) ? WS_Z1 : WS_Z)
#define LACT(l) ((l) ? WS_ACT1 : WS_ACT)
#define LYP(l) ((l) ? WS_YP1 : WS_YP)
#define LPERM(l) ((l) ? WS_PERM1 : WS_PERM)
constexpr int RWH_PITCH = 2064  , RWH_BYTES = 2 * 36 * RWH_PITCH  ;
constexpr int RWH_PAD = 149504;
constexpr int RING_BYTES = 131072, RW_BYTES = RWH_PAD  , MISC_OFF = RW_BYTES, LDS_BYTES = 163840;

struct Args {
    const float *x, *a_w_in, *a_conv_w, *a_w_out, *kv_w, *b_w_q, *b_lambda, *b_subln_g, *b_w_o, *ln1_g, *ln1_b, *ln2_g, *ln2_b, *rg_w, *rg_b, *re_w, *re_b, *e_w_in, *e_w_down;
    float* out; unsigned char* ws;
};

typedef const __attribute__((address_space(4))) Args* ArgsP;
__device__ __forceinline__ ArgsP kargs() { ArgsP p = (ArgsP)__builtin_amdgcn_kernarg_segment_ptr(); asm volatile("" : "+s"(p)); return p; }
struct Ctx { int tid, lane, wave, G, bx, gw, NGW; unsigned char* ws; };
__device__ __forceinline__ Ctx mkctx(ArgsP ap) { Ctx c; int t = threadIdx.x; asm volatile("" : "+v"(t)); c.tid = t; c.lane = t & 63; c.wave = __builtin_amdgcn_readfirstlane(t >> 6);
    c.G = gridDim.x; c.bx = blockIdx.x; c.gw = c.bx * 8 + c.wave; c.NGW = c.G * 8; c.ws = ap->ws; return c; }
__device__ __forceinline__ unsigned f2bf(float f) { unsigned u = __builtin_bit_cast(unsigned, f); return (u + 0x7fffu + ((u >> 16) & 1u)) >> 16; }
__device__ __forceinline__ unsigned pk2(float lo, float hi) { return f2bf(lo) | (f2bf(hi) << 16); }
__device__ __forceinline__ float bflo(unsigned w) { return __builtin_bit_cast(float, w << 16); }
__device__ __forceinline__ float bfhi(unsigned w) { return __builtin_bit_cast(float, w & 0xffff0000u); }
__device__ __forceinline__ float wave_sum(float v) {
#pragma unroll
    for (int o = 1; o < 64; o <<= 1) v += __shfl_xor(v, o);
    return v;
}

__device__ __forceinline__ float dpp_add(float v, const int ctrl_sel) {
    const int iv = __builtin_bit_cast(int, v); int t;
    if (ctrl_sel == 0) t = __builtin_amdgcn_update_dpp(0, iv, 0xB1, 0xF, 0xF, true);
    else if (ctrl_sel == 1) t = __builtin_amdgcn_update_dpp(0, iv, 0x4E, 0xF, 0xF, true);
    else if (ctrl_sel == 2) t = __builtin_amdgcn_update_dpp(0, iv, 0x141, 0xF, 0xF, true);
    else if (ctrl_sel == 3) t = __builtin_amdgcn_update_dpp(0, iv, 0x140, 0xF, 0xF, true);
    else if (ctrl_sel == 4) t = __builtin_amdgcn_update_dpp(0, iv, 0x142, 0xA, 0xF, false);
    else t = __builtin_amdgcn_update_dpp(0, iv, 0x143, 0xC, 0xF, false);
    return v + __builtin_bit_cast(float, t);
}
template <int N> __device__ __forceinline__ void dpp_sum(float (&v)[N]) {
#pragma unroll
    for (int st = 0; st < 6; ++st) {
#pragma unroll
        for (int i = 0; i < N; ++i) v[i] = dpp_add(v[i], st);
    }
#pragma unroll
    for (int i = 0; i < N; ++i) v[i] = __builtin_bit_cast(float, __builtin_amdgcn_readlane(__builtin_bit_cast(int, v[i]), 63));
}
__device__ __forceinline__ float dpp_sum1(float v) { float a[1] = {v}; dpp_sum(a); return a[0]; }

__device__ __forceinline__ void p0_transpose_item(const float* W, int K, int N, bf16* WT, int row_off, LAS float* scr, int item, int lane) {
    const int nblk = N / 64, kb = item / nblk, nb = item % nblk, k0 = 64 * kb, n0 = 64 * nb;
    const float* src = W + (size_t)(k0 + (lane >> 4)) * N + n0 + (lane & 15) * 4;
    f32x4 v[16];
#pragma unroll
    for (int i = 0; i < 16; ++i) v[i] = __builtin_nontemporal_load((const f32x4*)(src + (size_t)(4 * i) * N));
#pragma unroll
    for (int i = 0; i < 16; ++i) { LAS float* d = scr + (4 * i + (lane >> 4)) * 65 + (lane & 15) * 4; d[0] = v[i].x; d[1] = v[i].y; d[2] = v[i].z; d[3] = v[i].w; }
    asm volatile("s_waitcnt lgkmcnt(0)" ::: "memory");
    const int c = lane & 7;
#pragma unroll
    for (int j = 0; j < 8; ++j) { const int n = (lane >> 3) + 8 * j; const LAS float* s = scr + (8 * c) * 65 + n;
        v4u o; o.x = pk2(s[0 * 65], s[1 * 65]); o.y = pk2(s[2 * 65], s[3 * 65]); o.z = pk2(s[4 * 65], s[5 * 65]); o.w = pk2(s[6 * 65], s[7 * 65]);
        *(GAS v4u*)(WT + (size_t)(row_off + n0 + n) * K + k0 + 8 * c) = o; }
    asm volatile("s_waitcnt lgkmcnt(0)" ::: "memory");
}

constexpr int I_IN = 16 * 48, I_SQ = 16 * 16, I_KV = 16 * 32, I_DN = 8 * 16;
constexpr int NEM = P0B_FILL ? NE : 2 * NE;
constexpr int PS1 = I_IN, PS2 = PS1 + I_SQ, PS3 = PS2 + I_KV, PS4 = PS3 + I_SQ, PS5 = PS4 + I_SQ, PS6 = PS5 + NEM * I_SQ, P0_NITEMS = PS6 + NEM * I_DN;
__device__ __forceinline__ void p0_items(LAS unsigned char* lds, int lo, int hi, int w, int nw) {
    const ArgsP a = kargs(); const Ctx cx = mkctx(a); const int lane = cx.lane; unsigned char* ws = cx.ws;
    LAS float* scr = (LAS float*)(lds + cx.wave * 16640);
    for (int it = lo + w; it < hi; it += nw) {
        if (it < PS1) p0_transpose_item(a->a_w_in, D, 3 * D, (bf16*)(ws + WS_W1T), 0, scr, it, lane);
        else if (it < PS2) p0_transpose_item(a->a_w_out, D, D, (bf16*)(ws + WS_W2T), 0, scr, it - PS1, lane);
        else if (it < PS3) p0_transpose_item(a->kv_w, D, 2 * D, (bf16*)(ws + WS_WKVQ), 0, scr, it - PS2, lane);
        else if (it < PS4) p0_transpose_item(a->b_w_q, D, D, (bf16*)(ws + WS_WKVQ), 2 * D, scr, it - PS3, lane);
        else if (it < PS5) p0_transpose_item(a->b_w_o, D, D, (bf16*)(ws + WS_WOT), 0, scr, it - PS4, lane);
        else if (it < PS6) { const int r = it - PS5, mtx = r / I_SQ; p0_transpose_item(a->e_w_in + (size_t)mtx * D * D, D, D, (bf16*)(ws + WS_WUT) + (size_t)mtx * D * D, 0, scr, r % I_SQ, lane); }
        else { const int r = it - PS6, mtx = r / I_DN; p0_transpose_item(a->e_w_down + (size_t)mtx * DE * D, DE, D, (bf16*)(ws + WS_WDT) + (size_t)mtx * D * DE, 0, scr, r % I_DN, lane); }
    }
}
#ifndef ROLE_SPLIT
#define ROLE_SPLIT 1
#endif
#ifndef P0A_EXTRA
#define P0A_EXTRA 6656
#endif
__device__ __forceinline__ void p0_prologue(LAS unsigned char* lds) {
    const ArgsP a = kargs(); const Ctx cx = mkctx(a); const int gw = cx.gw, NGW = cx.NGW, lane = cx.lane;
    unsigned char* ws = cx.ws;
    p0_items(lds, 0, ROLE_SPLIT ? PS1 + P0A_EXTRA : P0_NITEMS, gw, NGW);
    for (int m = gw; m < T; m += NGW) {
        const GAS f32x4* xr = (const GAS f32x4*)(a->x + (size_t)m * D) + lane;
        GAS v2u* o = (GAS v2u*)((bf16*)(ws + WS_XB) + (size_t)m * D) + lane;
#pragma unroll
        for (int j = 0; j < 4; ++j) { const f32x4 v = xr[64 * j]; v2u w; w.x = pk2(v.x, v.y); w.y = pk2(v.z, v.w); o[64 * j] = w; }
    }
    { float* rwt = (float*)(ws + WS_RWT);
      for (int idx = gw * 64 + lane; idx < 2 * NRW * D; idx += NGW * 64) { const int l = idx / (NRW * D), n = (idx / D) % NRW, k = idx % D;
          const float w = n < NG ? a->rg_w[((size_t)l * D + k) * NG + n] : a->re_w[((size_t)l * D + k) * NE + (n - NG)];
          rwt[idx] = w;
          const unsigned hi = f2bf(w), lo = f2bf(w - __builtin_bit_cast(float, hi << 16));
          bf16* img = (bf16*)(ws + WS_RWH) + (size_t)l * (RWH_PAD / 2);
          img[(size_t)n * (RWH_PITCH / 2) + k] = (bf16)hi; img[(size_t)(NRW + n) * (RWH_PITCH / 2) + k] = (bf16)lo; } }
}
__device__ __forceinline__ void p0b_fill(LAS unsigned char* lds, int lo, int hi, int r, int nidle) {
    const ArgsP a = kargs(); const Ctx cx = mkctx(a); unsigned char* ws = cx.ws;
    LAS float* scr = (LAS float*)(lds + cx.wave * 16640);
    for (int it = lo + r * NWAVES + cx.wave; it < hi; it += nidle * NWAVES) {
        if (it < NE * 256) { const int mtx = NE + it / 256; p0_transpose_item(a->e_w_in + (size_t)mtx * D * D, D, D, (bf16*)(ws + WS_WUT) + (size_t)mtx * D * D, 0, scr, it % 256, cx.lane); }
        else { const int r2 = it - NE * 256, mtx = NE + r2 / 128; p0_transpose_item(a->e_w_down + (size_t)mtx * DE * D, DE, D, (bf16*)(ws + WS_WDT) + (size_t)mtx * D * DE, 0, scr, r2 % 128, cx.lane); }
    }
}
constexpr int P0B_ITEMS = NE * 256 + NE * 128;
__device__ __forceinline__ void p0b_idle_fill(LAS unsigned char* lds, int lo, int hi) {
    const ArgsP a = kargs(); const Ctx cx = mkctx(a); const LAS int* misc = (const LAS int*)(lds + MISC_OFF);
    const int U = misc[2 * NE], rem = U % cx.G;
    if (rem == 0) p0b_fill(lds, lo, hi, cx.bx, cx.G);
    else if (cx.bx >= rem) p0b_fill(lds, lo, hi, cx.bx - rem, cx.G - rem);
}
struct SchedDense {
    int G, c, nN, mode, K; const char* W;
    __device__ __forceinline__ bool next(int i, Unit& u) const {
        int pm, pn; if (!pg8::static_tile(i, G, c, T / 256, nN, pm, pn)) return false;
        u.arow = pm * 256; u.p0 = pm; u.p1 = pn; u.p2 = 0; u.p3 = 0;
        const size_t rb = (size_t)K * 2;
        if (mode == 0 && pn >= 4) { const int jj = pn - 4; u.b0 = W + (size_t)(D + 128 * jj) * rb; u.b1 = W + (size_t)(2 * D + 128 * jj) * rb; }
        else { u.b0 = W + (size_t)(256 * pn) * rb; u.b1 = u.b0 + 128 * rb; }
        return true;
    }
    __device__ __forceinline__ void a_offs(const Unit& u, const int (&R)[2], const int (&C)[2], unsigned& v00, unsigned& v01, unsigned& v10, unsigned& v11) const {
        v00 = (unsigned)((u.arow + R[0]) * K + C[0]) * 2u; v01 = (unsigned)((u.arow + R[1]) * K + C[1]) * 2u;
        v10 = (unsigned)((u.arow + 128 + R[0]) * K + C[0]) * 2u; v11 = (unsigned)((u.arow + 128 + R[1]) * K + C[1]) * 2u;
    }
    __device__ __forceinline__ bool half_only(const Unit&) const { return false; }
    __device__ __forceinline__ unsigned peek(const Unit&) const { return 0u; }
    __device__ __forceinline__ void a_ready(const Unit&, unsigned) const {}
    __device__ __forceinline__ void done(const Unit&) const {}
};
struct MoeTab { const LAS int* ub; const LAS int* ps; const LAS int* cn; };
struct SchedMoe {
    int G, c, K; bool up; const char* W; const v2u* perm; MoeTab tb;
    unsigned* ready; int hook; int off, nb;
    __device__ __forceinline__ bool half_only(const Unit& u) const { return u.p2 <= 128; }
    __device__ __forceinline__ unsigned peek(const Unit& u) const {
        return hook == 2 ? __hip_atomic_load(ready + 64 * u.p3, __ATOMIC_RELAXED, __HIP_MEMORY_SCOPE_AGENT) : 0u;
    }
    __device__ __forceinline__ void a_ready(const Unit& u, unsigned pk) const {
        if (hook != 2) return;
        if ((unsigned)__builtin_amdgcn_readfirstlane(pk) >= 32u) return;
        const unsigned long long t0 = __builtin_amdgcn_s_memrealtime();
        while ((unsigned)__builtin_amdgcn_readfirstlane(__hip_atomic_load(ready + 64 * u.p3, __ATOMIC_RELAXED, __HIP_MEMORY_SCOPE_AGENT)) < 32u) {
            if (__builtin_amdgcn_s_memrealtime() - t0 > 2000000ull) break;
            __builtin_amdgcn_s_sleep(2); }
        __builtin_amdgcn_fence(__ATOMIC_ACQUIRE, "agent");
        asm volatile("s_waitcnt vmcnt(0)" ::: "memory");
    }
    __device__ __forceinline__ void done(const Unit& u) const {
        if (hook != 1) return;
        asm volatile("s_waitcnt vmcnt(0)" ::: "memory");
        if ((threadIdx.x & 63) == 0) __hip_atomic_fetch_add(ready + 64 * u.p3, 1u, __ATOMIC_RELAXED, __HIP_MEMORY_SCOPE_AGENT);
    }
    __device__ __forceinline__ bool next(int i, Unit& u) const {
        int idx = i * G + c;
        if (nb > 0) {
            const int v = c - (G - nb);
            if (v >= 0) idx = i == 0 ? v : i == 1 ? v + nb : 2 * nb + v + (i - 2) * G;
            else idx = 3 * nb + c + i * G;
        }
        if (idx >= tb.ub[2 * NE]) return false;
        int k = 0;
#pragma unroll 1
        for (int q = 1; q < 2 * NE; ++q) if (idx >= tb.ub[q]) k = q;
        const int e = k & (NE - 1), local = idx - tb.ub[k];
        int ct, rti;
        if (k < NE) { const int rtn = (tb.ub[k + 1] - tb.ub[k]) >> 2; ct = local / rtn; rti = local - ct * rtn; }
        else { ct = local; rti = (tb.cn[e] - 1) >> 8; }
        const size_t rb = (size_t)K * 2; const char* We = W + (size_t)e * D * rb;
        if (up) { u.b0 = We + (size_t)(128 * ct) * rb; u.b1 = We + (size_t)(DE + 128 * ct) * rb; u.arow = e * CAP + rti * 256; u.p0 = tb.ps[e] + rti * 256; }
        else { u.b0 = We + (size_t)(256 * ct) * rb; u.b1 = u.b0 + 128 * rb; u.arow = tb.ps[e] + rti * 256; u.p0 = e * CAP + rti * 256; }
        u.p1 = ct; u.p2 = tb.cn[e] - rti * 256; u.p3 = (tb.ps[e] >> 8) + rti;
        return true;
    }
    __device__ __forceinline__ void a_offs(const Unit& u, const int (&R)[2], const int (&C)[2], unsigned& v00, unsigned& v01, unsigned& v10, unsigned& v11) const {
        if (up) {
            const int r00 = R[0] < u.p2 ? R[0] : 0, r01 = R[1] < u.p2 ? R[1] : 0, r10 = 128 + R[0] < u.p2 ? 128 + R[0] : 0, r11 = 128 + R[1] < u.p2 ? 128 + R[1] : 0;
            const int t00 = (int)(perm[u.arow + r00].y >> 1), t01 = (int)(perm[u.arow + r01].y >> 1), t10 = (int)(perm[u.arow + r10].y >> 1), t11 = (int)(perm[u.arow + r11].y >> 1);
            v00 = (unsigned)(t00 * K + C[0]) * 2u; v01 = (unsigned)(t01 * K + C[1]) * 2u; v10 = (unsigned)(t10 * K + C[0]) * 2u; v11 = (unsigned)(t11 * K + C[1]) * 2u;
        } else {
            v00 = (unsigned)((u.arow + R[0]) * K + C[0]) * 2u; v01 = (unsigned)((u.arow + R[1]) * K + C[1]) * 2u;
            v10 = (unsigned)((u.arow + 128 + R[0]) * K + C[0]) * 2u; v11 = (unsigned)((u.arow + 128 + R[1]) * K + C[1]) * 2u;
        }
    }
};

struct EpiConvIn {
    static constexpr bool PERM = true; bf16* GB; bf16* U;
    __device__ __forceinline__ void operator()(const f32x4 (&acc)[2][2][4][2], const Unit& u, int wr, int wc, int fr, int fq) const {
        const int row0 = u.p0 * 256 + wr * 64 + fr;
        if (u.p1 < 4) {
            const int col0 = u.p1 * 256 + wc * 32 + 8 * fq;
#pragma unroll
            for (int ai = 0; ai < 2; ++ai)
#pragma unroll
                for (int m = 0; m < 4; ++m) { bf16* rowp = GB + (size_t)(row0 + ai * 128 + m * 16) * D + col0;
#pragma unroll
                    for (int bj = 0; bj < 2; ++bj) { const f32x4 v0 = acc[ai][bj][m][0], v1 = acc[ai][bj][m][1];
                        v4u w; w.x = cvt_pk_bf16(v0[0], v0[1]); w.y = cvt_pk_bf16(v0[2], v0[3]); w.z = cvt_pk_bf16(v1[0], v1[1]); w.w = cvt_pk_bf16(v1[2], v1[3]);
                        *(v4u*)(rowp + bj * 128) = w; } }
        } else {
            const int col0 = (u.p1 - 4) * 128 + wc * 32 + 8 * fq;
#pragma unroll
            for (int ai = 0; ai < 2; ++ai)
#pragma unroll
                for (int m = 0; m < 4; ++m) { const f32x4 v0 = acc[ai][0][m][0] * acc[ai][1][m][0], v1 = acc[ai][0][m][1] * acc[ai][1][m][1];
                    v4u w; w.x = cvt_pk_bf16(v0[0], v0[1]); w.y = cvt_pk_bf16(v0[2], v0[3]); w.z = cvt_pk_bf16(v1[0], v1[1]); w.w = cvt_pk_bf16(v1[2], v1[3]);
                    *(v4u*)(U + (size_t)(row0 + ai * 128 + m * 16) * D + col0) = w; }
        }
    }
};
template <bool RES_BF16> struct EpiResZ {
    static constexpr bool PERM = false; const void* res; float* Z;
    __device__ __forceinline__ void operator()(const f32x4 (&acc)[2][2][4][2], const Unit& u, int wr, int wc, int fr, int fq) const {
        const int row0 = u.p0 * 256 + wr * 64 + fr, col0 = u.p1 * 256 + wc * 32 + 4 * fq;
#pragma unroll
        for (int ai = 0; ai < 2; ++ai)
#pragma unroll
            for (int m = 0; m < 4; ++m) { const size_t off = (size_t)(row0 + ai * 128 + m * 16) * D + col0;
#pragma unroll
                for (int bj = 0; bj < 2; ++bj)
#pragma unroll
                    for (int n = 0; n < 2; ++n) { const size_t o = off + bj * 128 + n * 16; f32x4 r;
                        if (RES_BF16) { const v2u w = *(const v2u*)((const bf16*)res + o); r = (f32x4){bflo(w.x), bfhi(w.x), bflo(w.y), bfhi(w.y)}; }
                        else r = *(const f32x4*)((const float*)res + o);
                        *(f32x4*)(Z + o) = r * ALPHA + acc[ai][bj][m][n]; } }
    }
};
template <bool WT> struct EpiUp {
    static constexpr bool PERM = true; bf16* ACT;
    __device__ __forceinline__ void operator()(const f32x4 (&acc)[2][2][4][2], const Unit& u, int wr, int wc, int fr, int fq) const {
        const int row0 = u.p0 + wr * 64 + fr, col0 = u.p1 * 128 + wc * 32 + 8 * fq;
#pragma unroll
        for (int ai = 0; ai < 2; ++ai)
#pragma unroll
            for (int m = 0; m < 4; ++m) { f32x4 v[2];
#pragma unroll
                for (int n = 0; n < 2; ++n) { const f32x4 g = acc[ai][0][m][n], uu = acc[ai][1][m][n];
#pragma unroll
                    for (int j = 0; j < 4; ++j) { const float e = __builtin_amdgcn_exp2f(g[j] * -1.4426950408889634f); v[n][j] = g[j] * __builtin_amdgcn_rcpf(1.0f + e) * uu[j]; } }
                v4u w; w.x = cvt_pk_bf16(v[0][0], v[0][1]); w.y = cvt_pk_bf16(v[0][2], v[0][3]); w.z = cvt_pk_bf16(v[1][0], v[1][1]); w.w = cvt_pk_bf16(v[1][2], v[1][3]);
                bf16* dst = ACT + (size_t)(row0 + ai * 128 + m * 16) * DE + col0;
                if (WT) { __hip_atomic_store((unsigned long long*)dst, ((unsigned long long)w.y << 32) | w.x, __ATOMIC_RELAXED, __HIP_MEMORY_SCOPE_AGENT);
                          __hip_atomic_store((unsigned long long*)dst + 1, ((unsigned long long)w.w << 32) | w.z, __ATOMIC_RELAXED, __HIP_MEMORY_SCOPE_AGENT); }
                else *(v4u*)dst = w; }
    }
};
struct EpiDown {
    static constexpr bool PERM = true; bf16* YP; const v2u* perm;
    __device__ __forceinline__ void operator()(const f32x4 (&acc)[2][2][4][2], const Unit& u, int wr, int wc, int fr, int fq) const {
        const int col0 = u.p1 * 256 + wc * 32 + 8 * fq;
        v2u rec[2][4];
#pragma unroll
        for (int ai = 0; ai < 2; ++ai)
#pragma unroll
            for (int m = 0; m < 4; ++m) { const int r = ai * 128 + wr * 64 + m * 16 + fr; rec[ai][m] = perm[u.p0 + (r < u.p2 ? r : 0)]; }
#pragma unroll
        for (int ai = 0; ai < 2; ++ai)
#pragma unroll
            for (int m = 0; m < 4; ++m) { const int r = ai * 128 + wr * 64 + m * 16 + fr;
                if (r < u.p2) { const int pair = (int)rec[ai][m].y; float g = __builtin_bit_cast(float, rec[ai][m].x); asm volatile("" : "+v"(g)); bf16* rowp = YP + (size_t)pair * D + col0;
#pragma unroll
                    for (int bj = 0; bj < 2; ++bj) { const f32x4 v0 = acc[ai][bj][m][0] * g, v1 = acc[ai][bj][m][1] * g;
                        v4u w; w.x = cvt_pk_bf16(v0[0], v0[1]); w.y = cvt_pk_bf16(v0[2], v0[3]); w.z = cvt_pk_bf16(v1[0], v1[1]); w.w = cvt_pk_bf16(v1[2], v1[3]);
                        *(v4u*)(rowp + bj * 128) = w; } } }
    }
};
struct EpiKVQ {
    static constexpr bool PERM = true; bf16* KB;
    __device__ __forceinline__ void operator()(const f32x4 (&acc)[2][2][4][2], const Unit& u, int wr, int wc, int fr, int fq) const {
        const int t = u.p1 >> 2; const float sc = t == 2 ? QSCALE : 1.0f;
        bf16* base = KB + (size_t)t * (32 * MiB / 2);
        const int row0 = u.p0 * 256 + wr * 64 + fr, col0 = (u.p1 & 3) * 256 + wc * 32 + 8 * fq;
#pragma unroll
        for (int ai = 0; ai < 2; ++ai)
#pragma unroll
            for (int m = 0; m < 4; ++m) { bf16* rowp = base + (size_t)(row0 + ai * 128 + m * 16) * D + col0;
#pragma unroll
                for (int bj = 0; bj < 2; ++bj) { const f32x4 v0 = acc[ai][bj][m][0] * sc, v1 = acc[ai][bj][m][1] * sc;
                    v4u w; w.x = cvt_pk_bf16(v0[0], v0[1]); w.y = cvt_pk_bf16(v0[2], v0[3]); w.z = cvt_pk_bf16(v1[0], v1[1]); w.w = cvt_pk_bf16(v1[2], v1[3]);
                    *(v4u*)(rowp + bj * 128) = w; } }
    }
};

__device__ __forceinline__ void ln_rows(f32x4 (&v)[4], const f32x4 (&gg)[4], const f32x4 (&bb)[4]) {
    float s = 0.f;
#pragma unroll
    for (int j = 0; j < 4; ++j) s += (v[j].x + v[j].y) + (v[j].z + v[j].w);
    const float mean = dpp_sum1(s) * (1.f / D); float s2 = 0.f;
#pragma unroll
    for (int j = 0; j < 4; ++j) { v[j] = v[j] - mean; s2 += (v[j].x * v[j].x + v[j].y * v[j].y) + (v[j].z * v[j].z + v[j].w * v[j].w); }
    const float rstd = 1.f / sqrtf(dpp_sum1(s2) * (1.f / D) + LN_EPS);
#pragma unroll
    for (int j = 0; j < 4; ++j) v[j] = v[j] * rstd * gg[j] + bb[j];
}
__device__ __forceinline__ float dot_lds(const f32x4 (&v)[4], const LAS f32x4* w, int lane) {
    float a = 0.f;
#pragma unroll
    for (int j = 0; j < 4; ++j) { const f32x4 ww = w[64 * j + lane]; a += (v[j].x * ww.x + v[j].y * ww.y) + (v[j].z * ww.z + v[j].w * ww.w); }
    return a;
}
typedef short bf16x8v __attribute__((ext_vector_type(8)));
__device__ __forceinline__ void ln_router_mfma(LAS unsigned char* lds, int layer, int rep) {
    const ArgsP a = kargs(); const Ctx cx = mkctx(a); const int lane = cx.lane, wave = cx.wave, tid = cx.tid;
    unsigned char* ws = cx.ws;
    const float* Z = (const float*)(ws + LZ(layer)); bf16* Xb = (bf16*)(ws + (layer == 0 ? WS_X1B : WS_X3B));
    const float* g = a->ln1_g + layer * D; const float* b = a->ln1_b + layer * D;
    const float* rgb = a->rg_b + layer * NG; const float* reb = a->re_b + layer * NE;
    int* cnt = (int*)(ws + WS_CTL) + layer * NE * CNT_STRIDE; v2u* perm = (v2u*)(ws + LPERM(layer));
    const int i = lane & 15, kq = lane >> 4, grp = wave >> 1, half = wave & 1;
    const int row = cx.bx * 64 + grp * 16 + i, col0 = 512 * half + 8 * kq;
    { const unsigned char* wg = ws + WS_RWH + (size_t)layer * RWH_PAD;
      for (int q = wave; q < RWH_PAD / 1024; q += NWAVES)
          __builtin_amdgcn_global_load_lds((const unsigned*)(wg + (size_t)q * 1024 + lane * 16), (LAS unsigned*)(lds + q * 1024), 16, 0, 0); }
    f32x4 x[16][2];
#pragma unroll
    for (int s = 0; s < 16; ++s) { const float* p = Z + (size_t)row * D + col0 + 32 * s; x[s][0] = *(const f32x4*)p; x[s][1] = *(const f32x4*)(p + 4); }
    LAS float* xs = (LAS float*)(lds + MISC_OFF + 4096);
    LAS float* part = (LAS float*)lds;
    float s1 = 0.f, s2 = 0.f;
#pragma unroll
    for (int s = 0; s < 16; ++s)
#pragma unroll
        for (int h2 = 0; h2 < 2; ++h2) { const f32x4 v = x[s][h2]; s1 += (v.x + v.y) + (v.z + v.w); s2 += (v.x * v.x + v.y * v.y) + (v.z * v.z + v.w * v.w); }
    s1 += __shfl_xor(s1, 16); s2 += __shfl_xor(s2, 16); s1 += __shfl_xor(s1, 32); s2 += __shfl_xor(s2, 32);
    if (kq == 0) { xs[(wave * 16 + i) * 2] = s1; xs[(wave * 16 + i) * 2 + 1] = s2; }
    __syncthreads();
    const float t1 = xs[((wave ^ 1) * 16 + i) * 2] + s1, t2 = xs[((wave ^ 1) * 16 + i) * 2 + 1] + s2;
    const float mean = t1 * (1.f / D), rstd = 1.f / sqrtf(fmaxf(t2 * (1.f / D) - mean * mean, 0.f) + LN_EPS);
    typedef float f32x4a __attribute__((ext_vector_type(4)));
    f32x4a acc0 = {0.f, 0.f, 0.f, 0.f}, acc1 = acc0, acc2 = acc0;
    const LAS unsigned char* wb = (const LAS unsigned char*)lds + (size_t)(lane & 15) * RWH_PITCH + (size_t)col0 * 2;
    const int n2 = (32 + (lane & 15)) < NRW ? 32 + (lane & 15) : NRW - 1;
    const LAS unsigned char* wb2 = (const LAS unsigned char*)lds + (size_t)n2 * RWH_PITCH + (size_t)col0 * 2;
    constexpr int LO = NRW * RWH_PITCH;
#pragma unroll
    for (int s = 0; s < 16; ++s) {
        const float* gp = g + col0 + 32 * s; const float* bp = b + col0 + 32 * s;
        const f32x4 g0 = *(const f32x4*)gp, g1 = *(const f32x4*)(gp + 4), b0 = *(const f32x4*)bp, b1 = *(const f32x4*)(bp + 4);
        const f32x4 v0 = (x[s][0] - mean) * rstd * g0 + b0, v1 = (x[s][1] - mean) * rstd * g1 + b1;
        const float vv[8] = {v0.x, v0.y, v0.z, v0.w, v1.x, v1.y, v1.z, v1.w};
        unsigned hi[8], lo[8];
#pragma unroll
        for (int j = 0; j < 8; ++j) { hi[j] = f2bf(vv[j]); lo[j] = f2bf(vv[j] - __builtin_bit_cast(float, hi[j] << 16)); }
        v4u hw, lw;
#pragma unroll
        for (int j = 0; j < 4; ++j) { hw[j] = hi[2 * j] | (hi[2 * j + 1] << 16); lw[j] = lo[2 * j] | (lo[2 * j + 1] << 16); }
        *(v4u*)(Xb + (size_t)row * D + col0 + 32 * s) = hw;
        const bf16x8v ah = __builtin_bit_cast(bf16x8v, hw), al = __builtin_bit_cast(bf16x8v, lw);
        const bf16x8v w0h = *(const LAS bf16x8v*)(wb + 64 * s), w0l = *(const LAS bf16x8v*)(wb + LO + 64 * s);
        const bf16x8v w1h = *(const LAS bf16x8v*)(wb + 16 * RWH_PITCH + 64 * s), w1l = *(const LAS bf16x8v*)(wb + 16 * RWH_PITCH + LO + 64 * s);
        const bf16x8v w2h = *(const LAS bf16x8v*)(wb2 + 64 * s), w2l = *(const LAS bf16x8v*)(wb2 + LO + 64 * s);
        acc0 = __builtin_amdgcn_mfma_f32_16x16x32_bf16(ah, w0h, acc0, 0, 0, 0); acc0 = __builtin_amdgcn_mfma_f32_16x16x32_bf16(al, w0h, acc0, 0, 0, 0); acc0 = __builtin_amdgcn_mfma_f32_16x16x32_bf16(ah, w0l, acc0, 0, 0, 0);
        acc1 = __builtin_amdgcn_mfma_f32_16x16x32_bf16(ah, w1h, acc1, 0, 0, 0); acc1 = __builtin_amdgcn_mfma_f32_16x16x32_bf16(al, w1h, acc1, 0, 0, 0); acc1 = __builtin_amdgcn_mfma_f32_16x16x32_bf16(ah, w1l, acc1, 0, 0, 0);
        acc2 = __builtin_amdgcn_mfma_f32_16x16x32_bf16(ah, w2h, acc2, 0, 0, 0); acc2 = __builtin_amdgcn_mfma_f32_16x16x32_bf16(al, w2h, acc2, 0, 0, 0); acc2 = __builtin_amdgcn_mfma_f32_16x16x32_bf16(ah, w2l, acc2, 0, 0, 0);
    }
    __syncthreads();
#pragma unroll
    for (int r = 0; r < 4; ++r) { LAS float* pr = part + (size_t)(wave * 16 + 4 * kq + r) * 48 + (lane & 15); pr[0] = acc0[r]; pr[16] = acc1[r]; pr[32] = acc2[r]; }
    LAS int* rt_e = (LAS int*)(part + 8 * 16 * 48);
    LAS float* rt_g = (LAS float*)(rt_e + 128);
    LAS int* rt_base = (LAS int*)(rt_g + 128);
    __syncthreads();
    if (tid < 64) {
        const int gq = tid >> 4, ii = tid & 15; const LAS float* p0 = part + (size_t)((2 * gq) * 16 + ii) * 48; const LAS float* p1 = p0 + 16 * 48;
        int gi = 0; float gm = -INFINITY, gl[NG];
#pragma unroll
        for (int n = 0; n < NG; ++n) { gl[n] = p0[n] + p1[n] + rgb[n]; if (gl[n] > gm) { gm = gl[n]; gi = n; } }
        float gs = 0.f;
#pragma unroll
        for (int n = 0; n < NG; ++n) gs += __expf(gl[n] - gm);
        const float gtop = 1.0f / gs;
        float m0 = -INFINITY, m1 = -INFINITY; int i0 = 0, i1 = 0;
        for (int n = 0; n < EPG; ++n) { const int c = NG + gi * EPG + n; const float e = p0[c] + p1[c] + reb[gi * EPG + n];
            if (e > m0) { m1 = m0; i1 = i0; m0 = e; i0 = n; } else if (e > m1) { m1 = e; i1 = n; } }
        const float e1 = __expf(m1 - m0), w0 = 1.0f / (1.0f + e1), w1 = e1 * w0;
        rt_e[2 * tid] = gi * EPG + i0; rt_e[2 * tid + 1] = gi * EPG + i1; rt_g[2 * tid] = gtop * w0; rt_g[2 * tid + 1] = gtop * w1;
    }
    __syncthreads();
    if (rep == 0) {
        if (tid < NE) { int c = 0; for (int q = 0; q < 128; ++q) c += (rt_e[q] == tid) ? 1 : 0; rt_base[tid] = c ? atomicAdd(&cnt[tid * CNT_STRIDE], c) : 0; }
        __syncthreads();
        if (tid < 128) { const int e = rt_e[tid]; int rank = 0; for (int q = 0; q < tid; ++q) rank += (rt_e[q] == e) ? 1 : 0;
            const int pair = 2 * (cx.bx * 64 + (tid >> 1)) + (tid & 1);
            perm[e * CAP + rt_base[e] + rank] = (v2u){__builtin_bit_cast(unsigned, rt_g[tid]), (unsigned)pair}; }
    }
}
__device__ __forceinline__ void ln_router_phase(LAS unsigned char* lds, int layer, int rep = 0) {
    const ArgsP a = kargs(); const Ctx cx = mkctx(a); const int gw = cx.gw, NGW = cx.NGW, lane = cx.lane;
    unsigned char* ws = cx.ws;
    const float* Z = (const float*)(ws + LZ(layer)); bf16* Xb = (bf16*)(ws + (layer == 0 ? WS_X1B : WS_X3B));
    const float* g = a->ln1_g + layer * D; const float* b = a->ln1_b + layer * D;
    const float* rgb = a->rg_b + layer * NG; const float* reb = a->re_b + layer * NE;
    int* cnt = (int*)(ws + WS_CTL) + layer * NE * CNT_STRIDE; v2u* perm = (v2u*)(ws + LPERM(layer));
    LAS f32x4* wl = (LAS f32x4*)lds;
    { const f32x4* wg = (const f32x4*)((const float*)(ws + WS_RWT) + (size_t)layer * NRW * D);
      for (int i = cx.tid; i < NRW * D / 4; i += NTHREADS) wl[i] = wg[i]; }
    f32x4 gg[4], bb[4];
#pragma unroll
    for (int j = 0; j < 4; ++j) { gg[j] = *(const f32x4*)(g + 256 * j + 4 * lane); bb[j] = *(const f32x4*)(b + 256 * j + 4 * lane); }
    constexpr int RPW = 16;
    LAS int* rt_row = (LAS int*)(lds + MISC_OFF + 2048);
    LAS int* rt_e = rt_row + NWAVES * RPW;
    LAS float* rt_g = (LAS float*)(rt_e + 2 * NWAVES * RPW);
    LAS int* rt_base = (LAS int*)(rt_g + 2 * NWAVES * RPW);
    LAS int* wave_rows = rt_base + NE;
    f32x4 nv[2][4];
#pragma unroll
    for (int r = 0; r < 2; ++r) { const int row = gw + r * NGW;
        if (row < T) {
#pragma unroll
            for (int j = 0; j < 4; ++j) nv[r][j] = *(const f32x4*)(Z + (size_t)row * D + 256 * j + 4 * lane);
        } }
    __syncthreads();
    int it = 0;
#pragma unroll 1
    for (int row0 = gw; row0 < T && it < RPW; row0 += 2 * NGW, it += 2) {
        const bool two = row0 + NGW < T;
        f32x4 v[2][4];
#pragma unroll
        for (int r = 0; r < 2; ++r)
#pragma unroll
            for (int j = 0; j < 4; ++j) v[r][j] = nv[r][j];
#pragma unroll
        for (int r = 0; r < 2; ++r) { const int row = row0 + (2 + r) * NGW;
            if (row < T) {
#pragma unroll
                for (int j = 0; j < 4; ++j) nv[r][j] = *(const f32x4*)(Z + (size_t)row * D + 256 * j + 4 * lane);
            } }
        if (!two) {
#pragma unroll
            for (int j = 0; j < 4; ++j) v[1][j] = v[0][j];
        }
        float s1[2];
#pragma unroll
        for (int r = 0; r < 2; ++r) { float s = 0.f;
#pragma unroll
            for (int j = 0; j < 4; ++j) s += (v[r][j].x + v[r][j].y) + (v[r][j].z + v[r][j].w);
            s1[r] = s; }
        dpp_sum(s1);
        float s2[2];
#pragma unroll
        for (int r = 0; r < 2; ++r) { const float mean = s1[r] * (1.f / D); float q = 0.f;
#pragma unroll
            for (int j = 0; j < 4; ++j) { v[r][j] = v[r][j] - mean; q += (v[r][j].x * v[r][j].x + v[r][j].y * v[r][j].y) + (v[r][j].z * v[r][j].z + v[r][j].w * v[r][j].w); }
            s2[r] = q; }
        dpp_sum(s2);
#pragma unroll
        for (int r = 0; r < 2; ++r) { const float rstd = 1.f / sqrtf(s2[r] * (1.f / D) + LN_EPS);
#pragma unroll
            for (int j = 0; j < 4; ++j) v[r][j] = v[r][j] * rstd * gg[j] + bb[j]; }
#pragma unroll
        for (int r = 0; r < 2; ++r) { const int row = row0 + r * NGW;
            if (r == 0 || two) {
#pragma unroll
                for (int j = 0; j < 4; ++j) { v2u w; w.x = pk2(v[r][j].x, v[r][j].y); w.y = pk2(v[r][j].z, v[r][j].w); *(v2u*)(Xb + (size_t)row * D + 256 * j + 4 * lane) = w; }
            } }
        float gl[2 * NG];
#pragma unroll
        for (int r = 0; r < 2; ++r)
#pragma unroll
            for (int n = 0; n < NG; ++n) gl[r * NG + n] = dot_lds(v[r], wl + n * (D / 4), lane);
        dpp_sum(gl);
        int gi[2]; float gtop[2];
#pragma unroll
        for (int r = 0; r < 2; ++r) { int g_ = 0; float gm = -INFINITY;
#pragma unroll
            for (int n = 0; n < NG; ++n) { gl[r * NG + n] += rgb[n]; if (gl[r * NG + n] > gm) { gm = gl[r * NG + n]; g_ = n; } }
            float gs = 0.f;
#pragma unroll
            for (int n = 0; n < NG; ++n) gs += __expf(gl[r * NG + n] - gm);
            gi[r] = g_; gtop[r] = 1.0f / gs; }
        float el[2 * EPG];
#pragma unroll
        for (int r = 0; r < 2; ++r)
#pragma unroll
            for (int n = 0; n < EPG; ++n) el[r * EPG + n] = dot_lds(v[r], wl + (NG + gi[r] * EPG + n) * (D / 4), lane);
        dpp_sum(el);
#pragma unroll
        for (int r = 0; r < 2; ++r) {
            float m0 = -INFINITY, m1 = -INFINITY; int i0 = 0, i1 = 0;
#pragma unroll
            for (int n = 0; n < EPG; ++n) { const float e = el[r * EPG + n] + reb[gi[r] * EPG + n];
                if (e > m0) { m1 = m0; i1 = i0; m0 = e; i0 = n; } else if (e > m1) { m1 = e; i1 = n; } }
            const float e1 = __expf(m1 - m0), w0 = 1.0f / (1.0f + e1), w1 = e1 * w0;
            if (lane == 0 && (r == 0 || two)) {
                const int li = cx.wave * RPW + it + r;
                rt_row[li] = row0 + r * NGW; rt_e[2 * li] = gi[r] * EPG + i0; rt_e[2 * li + 1] = gi[r] * EPG + i1; rt_g[2 * li] = gtop[r] * w0; rt_g[2 * li + 1] = gtop[r] * w1;
            }
        }
        if (!two) { it += 1; break; }
    }
    if (lane == 0) wave_rows[cx.wave] = it;
    __syncthreads();
    if (rep == 0) {
        if (cx.tid < NE) { int c = 0;
            for (int w = 0; w < NWAVES; ++w) { const int n = wave_rows[w]; for (int i = 0; i < 2 * n; ++i) c += (rt_e[2 * (w * RPW) + i] == cx.tid) ? 1 : 0; }
            rt_base[cx.tid] = c ? atomicAdd(&cnt[cx.tid * CNT_STRIDE], c) : 0; }
        __syncthreads();
        if (cx.tid < 2 * NWAVES * RPW) { const int w = cx.tid / (2 * RPW), i = cx.tid % (2 * RPW);
            if (i < 2 * wave_rows[w]) { const int e = rt_e[cx.tid]; int rank = 0;
                for (int w2 = 0; w2 <= w; ++w2) { const int lim = (w2 < w) ? 2 * wave_rows[w2] : i; for (int q = 0; q < lim; ++q) rank += (rt_e[2 * (w2 * RPW) + q] == e) ? 1 : 0; }
                const int pair = 2 * rt_row[cx.tid >> 1] + (cx.tid & 1);
                perm[e * CAP + rt_base[e] + rank] = (v2u){__builtin_bit_cast(unsigned, rt_g[cx.tid]), (unsigned)pair}; } }
    }
}
__device__ __forceinline__ void ln2_phase(int layer) {
    const ArgsP a = kargs(); const Ctx cx = mkctx(a); const int gw = cx.gw, NGW = cx.NGW, lane = cx.lane;
    unsigned char* ws = cx.ws;
    const bf16* Xin = (const bf16*)(ws + (layer == 0 ? WS_X1B : WS_X3B)); const bf16* YP = (const bf16*)(ws + LYP(layer));
    const float* g = a->ln2_g + layer * D; const float* b = a->ln2_b + layer * D;
    f32x4 gg[4], bb[4];
#pragma unroll
    for (int j = 0; j < 4; ++j) { gg[j] = *(const f32x4*)(g + 256 * j + 4 * lane); bb[j] = *(const f32x4*)(b + 256 * j + 4 * lane); }
    v2u nx[4], ny0[4], ny1[4];
    if (gw < T) {
#pragma unroll
        for (int j = 0; j < 4; ++j) { const size_t c = 256 * j + 4 * lane;
            nx[j] = *(const v2u*)(Xin + (size_t)gw * D + c); ny0[j] = *(const v2u*)(YP + (size_t)(2 * gw) * D + c); ny1[j] = *(const v2u*)(YP + (size_t)(2 * gw + 1) * D + c); }
    }
#pragma unroll 1
    for (int row = gw; row < T; row += NGW) {
        f32x4 v[4];
#pragma unroll
        for (int j = 0; j < 4; ++j) { const v2u xw = nx[j], y0 = ny0[j], y1 = ny1[j];
            v[j].x = ALPHA * bflo(xw.x) + (bflo(y0.x) + bflo(y1.x)); v[j].y = ALPHA * bfhi(xw.x) + (bfhi(y0.x) + bfhi(y1.x));
            v[j].z = ALPHA * bflo(xw.y) + (bflo(y0.y) + bflo(y1.y)); v[j].w = ALPHA * bfhi(xw.y) + (bfhi(y0.y) + bfhi(y1.y)); }
        if (row + NGW < T) { const int r2 = row + NGW;
#pragma unroll
            for (int j = 0; j < 4; ++j) { const size_t c = 256 * j + 4 * lane;
                nx[j] = *(const v2u*)(Xin + (size_t)r2 * D + c); ny0[j] = *(const v2u*)(YP + (size_t)(2 * r2) * D + c); ny1[j] = *(const v2u*)(YP + (size_t)(2 * r2 + 1) * D + c); }
        }
        ln_rows(v, gg, bb);
        if (layer == 0) {
#pragma unroll
            for (int j = 0; j < 4; ++j) { v2u w; w.x = pk2(v[j].x, v[j].y); w.y = pk2(v[j].z, v[j].w); *(v2u*)((bf16*)(ws + WS_X2B) + (size_t)row * D + 256 * j + 4 * lane) = w; }
        } else {
#pragma unroll
            for (int j = 0; j < 4; ++j) *(f32x4*)(a->out + (size_t)row * D + 256 * j + 4 * lane) = v[j];
        }
    }
}
__device__ __forceinline__ void conv_phase() {
    const ArgsP a = kargs(); const Ctx cx = mkctx(a); const int gtid = cx.bx * NTHREADS + cx.tid, NGT = cx.G * NTHREADS;
    unsigned char* ws = cx.ws;
    const bf16* GB = (const bf16*)(ws + WS_GB); const bf16* U = (const bf16*)(ws + WS_U); bf16* A2 = (bf16*)(ws + WS_A2);
    for (int it = gtid; it < T * (D / 8); it += NGT) {
        const int t = it >> 7, d0 = (it & 127) * 8, s = t & (SEQ - 1);
        const size_t o = (size_t)t * D + d0;
        const v4u g = *(const v4u*)(GB + o), u0 = *(const v4u*)(U + o);
        v4u u1 = (v4u){0u, 0u, 0u, 0u}, u2 = u1;
        if (s >= 1) u1 = *(const v4u*)(U + o - D);
        if (s >= 2) u2 = *(const v4u*)(U + o - 2 * D);
        v4u r;
#pragma unroll
        for (int q = 0; q < 4; ++q) {
            const int d = d0 + 2 * q;
            const float c0 = a->a_conv_w[d] * bflo(u2[q]) + a->a_conv_w[D + d] * bflo(u1[q]) + a->a_conv_w[2 * D + d] * bflo(u0[q]);
            const float c1 = a->a_conv_w[d + 1] * bfhi(u2[q]) + a->a_conv_w[D + d + 1] * bfhi(u1[q]) + a->a_conv_w[2 * D + d + 1] * bfhi(u0[q]);
            r[q] = pk2(bflo(g[q]) * c0, bfhi(g[q]) * c1);
        }
        *(v4u*)(A2 + o) = r;
    }
}
__device__ __forceinline__ void combine_phase() {
    const ArgsP a = kargs(); const Ctx cx = mkctx(a); const int gw = cx.gw, NGW = cx.NGW, lane = cx.lane;
    unsigned char* ws = cx.ws;
    const bf16* O0 = (const bf16*)(ws + WS_O0); const bf16* O1 = (const bf16*)(ws + WS_O1); bf16* A3 = (bf16*)(ws + WS_A3);
    const float l01 = wave_sum(a->b_lambda[lane] * a->b_lambda[64 + lane]), l23 = wave_sum(a->b_lambda[128 + lane] * a->b_lambda[192 + lane]);
    const float lam = __expf(l01) - __expf(l23) + LAM_INIT;
    float gsc[16];
#pragma unroll
    for (int i = 0; i < 16; ++i) gsc[i] = a->b_subln_g[(lane & 7) * 16 + i] * (1.0f - LAM_INIT);
    for (int row = gw; row < T; row += NGW) {
        const size_t o = (size_t)row * D + lane * 16;
        const v4u p0 = *(const v4u*)(O0 + o), p1 = *(const v4u*)(O0 + o + 8), q0 = *(const v4u*)(O1 + o), q1 = *(const v4u*)(O1 + o + 8);
        float d[16]; float ss = 0.f;
#pragma unroll
        for (int i = 0; i < 4; ++i) { d[2 * i] = bflo(p0[i]) - lam * bflo(q0[i]); d[2 * i + 1] = bfhi(p0[i]) - lam * bfhi(q0[i]);
            d[8 + 2 * i] = bflo(p1[i]) - lam * bflo(q1[i]); d[8 + 2 * i + 1] = bfhi(p1[i]) - lam * bfhi(q1[i]); }
#pragma unroll
        for (int i = 0; i < 16; ++i) ss += d[i] * d[i];
        ss += __shfl_xor(ss, 1); ss += __shfl_xor(ss, 2); ss += __shfl_xor(ss, 4);
        const float r = 1.0f / sqrtf(ss * (1.0f / 128.0f) + RMS_EPS);
        v4u w0, w1;
#pragma unroll
        for (int i = 0; i < 4; ++i) { w0[i] = pk2(d[2 * i] * r * gsc[2 * i], d[2 * i + 1] * r * gsc[2 * i + 1]); w1[i] = pk2(d[8 + 2 * i] * r * gsc[8 + 2 * i], d[8 + 2 * i + 1] * r * gsc[8 + 2 * i + 1]); }
        *(v4u*)(A3 + o) = w0; *(v4u*)(A3 + o + 8) = w1;
    }
}

#ifndef MKMASK
#define MKMASK 0xffff
#endif
#ifndef MKREP
#define MKREP 0
#endif
#ifndef MKSYNC
#define MKSYNC 0
#endif
#ifndef MKMASK2
#define MKMASK2 MKMASK
#endif
#define PH(k) _Pragma("unroll 1") for (int rep_ = 0; rep_ < (int)(((pass_ ? MKMASK2 : MKMASK) >> (k)) & 1) + (int)((MKREP >> (k)) & 1); ++rep_)
#define XB_TMO      128
#define XB_XCNT(j)  (256  + 64 * (j))
#define XB_XSUB(j)  (1280 + 64 * (j))
#define XB_XGEN(j)  (2304 + 64 * (j))
#define XB_TOP      3328
#define XB_TOPGEN   3392
#define XCD_BAR_WORDS 3456
#define XB_SPIN_CAP (1u << 18)

__device__ __forceinline__ unsigned xb_ld(unsigned* p)              { return __hip_atomic_load(p, __ATOMIC_RELAXED, __HIP_MEMORY_SCOPE_AGENT); }
__device__ __forceinline__ unsigned xb_add(unsigned* p, unsigned v) { return __hip_atomic_fetch_add(p, v, __ATOMIC_RELAXED, __HIP_MEMORY_SCOPE_AGENT); }
__device__ __forceinline__ unsigned xb_xcc_id() { return (unsigned)__builtin_amdgcn_s_getreg((3 << 11) | 20) & 0xFu; }
#define XB_SPIN(cond, bar) do { unsigned _sp = 0; while (cond) { __builtin_amdgcn_s_sleep(1); \
    if ((++_sp & 255u) == 0u) { if (xb_ld(&(bar)[XB_TMO])) break; if (_sp > XB_SPIN_CAP) { atomicAdd(&(bar)[XB_TMO], 1u); break; } } } } while (0)

struct XcdBarrier {
    unsigned* bar; unsigned x;
    volatile LAS unsigned* st;
};

__device__ __forceinline__ XcdBarrier xcd_barrier_post(unsigned* bar, volatile LAS unsigned* st) {
    XcdBarrier b; b.bar = bar; b.x = xb_xcc_id(); b.st = st;
    if (threadIdx.x == 0) (void)xb_add(&bar[XB_XCNT(b.x)], 1u);
    return b;
}
__device__ __forceinline__ void xcd_barrier_complete(unsigned* bar, unsigned x, unsigned& nloc, unsigned& nx) {
    const unsigned G = gridDim.x * gridDim.y * gridDim.z;
    unsigned sum, cnt, mine, sp = 0u;
    for (;;) {
        sum = 0u; cnt = 0u; mine = 0u;
#pragma unroll
        for (unsigned j = 0; j < 16; ++j) { const unsigned c = xb_ld(&bar[XB_XCNT(j)]); sum += c; cnt += (c > 0u) ? 1u : 0u; mine = (j == x) ? c : mine; }
        if (sum == G) break;
        __builtin_amdgcn_s_sleep(1);
        if ((++sp & 255u) == 0u) { if (xb_ld(&bar[XB_TMO])) break; if (sp > XB_SPIN_CAP) { atomicAdd(&bar[XB_TMO], 1u); break; } }
    }
    nloc = mine > 0u ? mine : 1u; nx = cnt > 0u ? cnt : 1u;
}

__device__ __forceinline__ void xcd_barrier(const XcdBarrier& b) {
    asm volatile("s_waitcnt vmcnt(0)" ::: "memory");
    __syncthreads();
    if (threadIdx.x == 0) {
        unsigned* bar = b.bar;
        __builtin_amdgcn_s_waitcnt(0);
        unsigned nloc = b.st[0], nx = b.st[1];
        if (nloc == 0u) { xcd_barrier_complete(bar, b.x, nloc, nx); b.st[0] = nloc; b.st[1] = nx; }
        const unsigned old = xb_add(&bar[XB_XSUB(b.x)], 1u);
        const unsigned gen = old / nloc;
        if (old + 1u == (gen + 1u) * nloc) {
            __builtin_amdgcn_fence(__ATOMIC_RELEASE, "agent");
            asm volatile("s_waitcnt vmcnt(0)" ::: "memory");
            const unsigned og = xb_add(&bar[XB_TOP], 1u);
            const unsigned tg = og / nx;
            if (og + 1u == (tg + 1u) * nx) xb_add(&bar[XB_TOPGEN], 1u);
            else XB_SPIN(xb_ld(&bar[XB_TOPGEN]) == tg, bar);
            __builtin_amdgcn_fence(__ATOMIC_ACQUIRE, "agent");
            xb_add(&bar[XB_XGEN(b.x)], 1u);
            asm volatile("s_waitcnt vmcnt(0)" ::: "memory");
        } else {
            XB_SPIN(xb_ld(&bar[XB_XGEN(b.x)]) == gen, bar);
            __builtin_amdgcn_fence(__ATOMIC_ACQUIRE, "agent");
            asm volatile("s_waitcnt vmcnt(0)" ::: "memory");
        }
    }
    __syncthreads();
}

constexpr int CW_BAR = 16384;
constexpr int ST_OFF = MISC_OFF + 1024;
__device__ __forceinline__ void seam(LAS unsigned char* lds) { const ArgsP a = kargs(); XcdBarrier b; b.bar = (unsigned*)(a->ws + WS_CTL) + CW_BAR; b.x = xb_xcc_id(); b.st = (volatile LAS unsigned*)(lds + ST_OFF); xcd_barrier(b); }
__device__ __forceinline__ void gemm1_phase(LAS unsigned char* lds) { const ArgsP a = kargs(); const Ctx cx = mkctx(a); unsigned char* ws = cx.ws;
    const int ng = ROLE_SPLIT ? cx.G - cx.G / 4 : cx.G;
    if (cx.bx < ng) { SchedDense S{ng, cx.bx, 12, 0, D, (const char*)(ws + WS_W1T)}; EpiConvIn E{(bf16*)(ws + WS_GB), (bf16*)(ws + WS_U)};
        pg8::gemm_phase(lds, (const char*)(ws + WS_XB), D, S, E); }
    else p0_items(lds, PS1 + P0A_EXTRA, P0_NITEMS, (cx.bx - ng) * NWAVES + cx.wave, (cx.G - ng) * NWAVES); }
__device__ __forceinline__ void gemm2_phase(LAS unsigned char* lds) { const ArgsP a = kargs(); const Ctx cx = mkctx(a); unsigned char* ws = cx.ws;
    SchedDense S{cx.G, cx.bx, 4, 1, D, (const char*)(ws + WS_W2T)}; EpiResZ<false> E{(const void*)a->x, (float*)(ws + LZ(0))};
    pg8::gemm_phase(lds, (const char*)(ws + WS_A2), D, S, E); }
__device__ __forceinline__ void kvq_phase(LAS unsigned char* lds) { const ArgsP a = kargs(); const Ctx cx = mkctx(a); unsigned char* ws = cx.ws;
    SchedDense S{cx.G, cx.bx, 12, 1, D, (const char*)(ws + WS_WKVQ)}; EpiKVQ E{(bf16*)(ws + WS_K)};
    pg8::gemm_phase(lds, (const char*)(ws + WS_X2B), D, S, E); }
__device__ __forceinline__ void wo_phase(LAS unsigned char* lds) { const ArgsP a = kargs(); const Ctx cx = mkctx(a); unsigned char* ws = cx.ws;
    SchedDense S{cx.G, cx.bx, 4, 1, D, (const char*)(ws + WS_WOT)}; EpiResZ<true> E{(const void*)(ws + WS_X2B), (float*)(ws + LZ(1))};
    pg8::gemm_phase(lds, (const char*)(ws + WS_A3), D, S, E); }
__device__ __forceinline__ void attn_phase(char* lds_generic) { const ArgsP a = kargs(); const Ctx cx = mkctx(a); unsigned char* ws = cx.ws;
#pragma unroll 1
    for (int uix = cx.bx; uix < BATCH * NH * 4 * (SEQ / 256); uix += cx.G) {
        const int combo = uix & 255, qi = uix >> 8;
        const int b = combo >> 5, h = (combo >> 2) & 7, c = (combo >> 1) & 1, vh = combo & 1;
        const int qb = (qi & 1) ? (SEQ / 256 - 1 - (qi >> 1)) : (qi >> 1);
        const attn_body::bf16* QK = (const attn_body::bf16*)(ws + WS_K) + h * 128 + c * 64;
        const attn_body::bf16* Vc = (const attn_body::bf16*)(ws + WS_V) + h * 128 + vh * 64;
        attn_body::bf16* Oc = (attn_body::bf16*)(ws + (c ? WS_O1 : WS_O0)) + h * 128 + vh * 64;
        attn_body::attn_unit<8>((long)b * SEQ, qb, QK + (WS_Q - WS_K) / 2, QK, Vc, Oc, lds_generic);
    }
}
__device__ __forceinline__ void moe_tables(LAS unsigned char* lds, int layer) { const ArgsP a = kargs(); const Ctx cx = mkctx(a); LAS int* misc = (LAS int*)(lds + MISC_OFF);
    const int* cnt = (const int*)(cx.ws + WS_CTL) + layer * NE * CNT_STRIDE;
    if (cx.tid < NE) misc[128 + cx.tid] = __hip_atomic_load(cnt + cx.tid * CNT_STRIDE, __ATOMIC_RELAXED, __HIP_MEMORY_SCOPE_AGENT);
    __syncthreads();
    if (cx.tid == 0) { int ub = 0, ps = 0; for (int e = 0; e < NE; ++e) { misc[e] = ub; misc[192 + e] = ps; const int cn = misc[128 + e], rt = (cn + 255) >> 8, half = (cn > 0 && ((cn - 1) & 255) < 128) ? 1 : 0; ub += 4 * (rt - half); ps += 256 * rt; }
        misc[192 + NE] = ps;
        for (int e = 0; e < NE; ++e) { misc[NE + e] = ub; const int cn = misc[128 + e]; ub += (cn > 0 && ((cn - 1) & 255) < 128) ? 4 : 0; } misc[2 * NE] = ub; }
    __syncthreads(); }
constexpr int CW_READY = 4096;
__device__ __forceinline__ void moe_up_phase(LAS unsigned char* lds, int layer, bool merged) { const ArgsP a = kargs(); const Ctx cx = mkctx(a); unsigned char* ws = cx.ws; LAS int* misc = (LAS int*)(lds + MISC_OFF);
    const MoeTab tb{misc, misc + 192, misc + 128};
    SchedMoe S{cx.G, cx.bx, D, true, (const char*)(ws + WS_WUT) + (size_t)layer * NE * D * D * 2, (const v2u*)(ws + LPERM(layer)), tb, (unsigned*)(ws + WS_CTL) + CW_READY, merged ? 1 : 0, 0, 0};
    if (merged) { EpiUp<true> E{(bf16*)(ws + LACT(layer))}; pg8::gemm_phase(lds, (const char*)(ws + (layer == 0 ? WS_X1B : WS_X3B)), D, S, E); }
    else { EpiUp<false> E{(bf16*)(ws + LACT(layer))}; pg8::gemm_phase(lds, (const char*)(ws + (layer == 0 ? WS_X1B : WS_X3B)), D, S, E); } }
__device__ __forceinline__ void moe_down_phase(LAS unsigned char* lds, int layer, bool merged) { const ArgsP a = kargs(); const Ctx cx = mkctx(a); unsigned char* ws = cx.ws; LAS int* misc = (LAS int*)(lds + MISC_OFF);
    const MoeTab tb{misc, misc + 192, misc + 128};
    int nb = 0;
    if (merged) { const int U = misc[2 * NE], rem = U % cx.G; nb = rem ? cx.G - rem : 0; }
    SchedMoe S{cx.G, cx.bx, DE, false, (const char*)(ws + WS_WDT) + (size_t)layer * NE * D * DE * 2, (const v2u*)(ws + LPERM(layer)), tb, (unsigned*)(ws + WS_CTL) + CW_READY, merged ? 2 : 0, 0, nb};
    EpiDown E{(bf16*)(ws + LYP(layer)), (const v2u*)(ws + LPERM(layer))};
    pg8::gemm_phase(lds, (const char*)(ws + LACT(layer)), DE, S, E); }

__global__ void __launch_bounds__(NTHREADS, 2) fwd_megakernel(Args args_unused) {
    extern __shared__ __attribute__((aligned(16))) unsigned char lds_raw[];
#ifdef NOSYNC
    struct { __device__ void sync() const {} } grid;
#else
    cg::grid_group grid = cg::this_grid();
#endif
#define SEAM() seam(lds)
    LAS unsigned char* lds = (LAS unsigned char*)lds_raw;
#ifndef MKPASS
#define MKPASS 1
#endif
    { const ArgsP a = kargs(); int t = threadIdx.x; asm volatile("" : "+v"(t));
      if (t < 2) ((volatile LAS unsigned*)(lds + ST_OFF))[t] = 0u;
      __syncthreads();
      (void)xcd_barrier_post((unsigned*)(a->ws + WS_CTL) + CW_BAR, (volatile LAS unsigned*)(lds + ST_OFF));
      if (a->ws == nullptr) grid.sync(); }
#pragma unroll 1
    for (int pass_ = 0; pass_ < MKPASS; ++pass_) {
    if (pass_) SEAM();
    PH(0) p0_prologue(lds);
    SEAM();
    PH(1) gemm1_phase(lds);
    SEAM();
    PH(2) conv_phase();
    SEAM();
    PH(3) gemm2_phase(lds);
    SEAM();
    PH(8) { if (gridDim.x == 256) ln_router_mfma(lds, 0, rep_ + pass_); else ln_router_phase(lds, 0, rep_ + pass_); }
    SEAM();
    moe_tables(lds, 0);
    PH(9) { moe_up_phase(lds, 0, false); if (P0B_FILL && pass_ == 0) p0b_idle_fill(lds, 0, P0B_SPLIT); }
    SEAM();
    PH(10) { moe_down_phase(lds, 0, false); if (P0B_FILL && pass_ == 0) p0b_idle_fill(lds, P0B_SPLIT, P0B_ITEMS); }
    SEAM();
    PH(11) ln2_phase(0);
    SEAM();
    PH(4) kvq_phase(lds);
    SEAM();
    PH(5) attn_phase((char*)lds_raw);
    SEAM();
    PH(6) combine_phase();
    SEAM();
    PH(7) wo_phase(lds);
    SEAM();
    PH(8) { if (gridDim.x == 256) ln_router_mfma(lds, 1, rep_ + pass_); else ln_router_phase(lds, 1, rep_ + pass_); }
    SEAM();
    moe_tables(lds, 1);
#if MOE_MERGE
    PH(9) moe_up_phase(lds, 1, pass_ == 0);
    if (pass_) SEAM();
    PH(10) moe_down_phase(lds, 1, pass_ == 0);
#else
    PH(9) moe_up_phase(lds, 1, false);
    SEAM();
    PH(10) moe_down_phase(lds, 1, false);
#endif
    SEAM();
    PH(11) ln2_phase(1);
    }
#pragma unroll 1
    for (int i = 0; i < MKSYNC; ++i) SEAM();
}
}

extern "C" void kernel_launch(void* const* d_in, const int* in_sizes, int n_in, void* d_out, int out_size, void* d_ws, size_t ws_size, hipStream_t stream) {
    using namespace mk;
    static int grid = 0;
    if (grid == 0) {
        if (n_in != 19 || out_size != T * D || ws_size < WS_END) { fprintf(stderr, "kernel_launch: unexpected shapes / workspace (n_in %d out %d ws %zu, need %zu)\n", n_in, out_size, ws_size, (size_t)WS_END); grid = -1; return; }
        int dev = 0, cus = 0, per_cu = 0;
        (void)hipGetDevice(&dev); (void)hipDeviceGetAttribute(&cus, hipDeviceAttributeMultiprocessorCount, dev);
        if (hipFuncSetAttribute((const void*)fwd_megakernel, hipFuncAttributeMaxDynamicSharedMemorySize, LDS_BYTES) != hipSuccess) { fprintf(stderr, "kernel_launch: hipFuncSetAttribute failed\n"); grid = -1; return; }
        if (hipOccupancyMaxActiveBlocksPerMultiprocessor(&per_cu, (const void*)fwd_megakernel, NTHREADS, LDS_BYTES) != hipSuccess || per_cu < 1) { fprintf(stderr, "kernel_launch: occupancy query says %d blocks per CU\n", per_cu); grid = -1; return; }
        grid = cus * 1;
        (void)hipGetLastError();
    }
    if (grid < 0) return;
    if (hipMemsetAsync((char*)d_ws + WS_CTL, 0, (size_t)(CW_BAR + XCD_BAR_WORDS) * 4, stream) != hipSuccess) { fprintf(stderr, "kernel_launch: hipMemsetAsync of the control words failed\n"); return; }
    Args a{};
    a.x = (const float*)d_in[0]; a.a_w_in = (const float*)d_in[1]; a.a_conv_w = (const float*)d_in[2]; a.a_w_out = (const float*)d_in[3]; a.kv_w = (const float*)d_in[4];
    a.b_w_q = (const float*)d_in[5]; a.b_lambda = (const float*)d_in[6]; a.b_subln_g = (const float*)d_in[7]; a.b_w_o = (const float*)d_in[8];
    a.ln1_g = (const float*)d_in[9]; a.ln1_b = (const float*)d_in[10]; a.ln2_g = (const float*)d_in[11]; a.ln2_b = (const float*)d_in[12];
    a.rg_w = (const float*)d_in[13]; a.rg_b = (const float*)d_in[14]; a.re_w = (const float*)d_in[15]; a.re_b = (const float*)d_in[16];
    a.e_w_in = (const float*)d_in[17]; a.e_w_down = (const float*)d_in[18];
    a.out = (float*)d_out; a.ws = (unsigned char*)d_ws;
    void* kargs[] = {&a};
    const hipError_t e = hipLaunchCooperativeKernel((const void*)fwd_megakernel, dim3(grid), dim3(NTHREADS), kargs, LDS_BYTES, stream);
    if (e != hipSuccess) fprintf(stderr, "kernel_launch: cooperative launch failed: %s (grid %d)\n", hipGetErrorString(e), grid);
}
```

```cpp
#include <hip/hip_runtime.h>
#include <hip/hip_cooperative_groups.h>
#include <cstdio>
#include <cstdint>
namespace cg = cooperative_groups;

namespace pg8 {
#define PG8_LAS __attribute__((address_space(3)))
typedef unsigned short bf16_t;
typedef short bf16x8 __attribute__((ext_vector_type(8)));
typedef float f32x4 __attribute__((ext_vector_type(4)));
typedef unsigned u32x4 __attribute__((ext_vector_type(4)));
typedef unsigned u32x2 __attribute__((ext_vector_type(2)));
constexpr int BM = 256, BK = 64, HALF = 128, HTB = HALF * BK * 2  , STAGE_BYTES = 8 * HTB, NXCD = 8, WGM = 8;

__host__ __device__ __forceinline__ int lds_byte(int r, int c) { const int st = (r >> 4) * 2 + (c >> 5), rr = r & 15, cc = c & 31, ob = rr * 64 + cc * 2; return st * 1024 + (ob ^ (((ob >> 9) & 1) << 5)); }
__host__ __device__ __forceinline__ void stage_rc(int b, int& R, int& C) { const int st = b / 1024, sb = b % 1024, swz = sb ^ (((sb >> 9) & 1) << 5); R = (st >> 1) * 16 + swz / 64; C = (st & 1) * 32 + (swz % 64) / 2; }
__host__ __device__ __forceinline__ int perm32(int rho) { const int n = rho >> 4, i = rho & 15; return 8 * (i >> 2) + 4 * n + (i & 3); }

struct Unit { const char* b0; const char* b1; int arow; int p0, p1, p2, p3; };

__device__ __forceinline__ bool static_tile(int i, int G, int c, int nM, int nN, int& pm, int& pn) {
    const int nwg = nM * nN; const long L = (long)i * G + c; if (L >= nwg) return false;
    int wgid = (int)L; { const int q = nwg / NXCD, r = nwg % NXCD, xcd = wgid % NXCD, off = wgid / NXCD; wgid = (xcd < r ? xcd * (q + 1) : r * (q + 1) + (xcd - r) * q) + off; }
    const int nig = WGM * nN, gid = wgid / nig, fm = gid * WGM, gsz = (nM - fm) < WGM ? (nM - fm) : WGM;
    pm = fm + ((wgid % nig) % gsz); pn = (wgid % nig) / gsz; return true;
}

__device__ __forceinline__ unsigned cvt_pk_bf16(float lo, float hi) { unsigned r; asm volatile("v_cvt_pk_bf16_f32 %0, %1, %2" : "=v"(r) : "v"(lo), "v"(hi)); return r; }

template <class Epi, class Sched>
__device__ __forceinline__ void gemm_phase(PG8_LAS unsigned char* lds, const char* Abase, const int K, const Sched& S, const Epi& E) {
    int tid_ = threadIdx.x; asm volatile("" : "+v"(tid_));
    const int tid = tid_, wid = __builtin_amdgcn_readfirstlane(tid >> 6), lane = tid & 63, wr = wid >> 2, wc = wid & 3, fr = lane & 15, fq = lane >> 4;
    const int nt = K / BK;
    int R[2], C[2]; unsigned voffB[2];
#pragma unroll
    for (int i = 0; i < 2; ++i) { stage_rc(tid * 16 + i * 8192, R[i], C[i]); const int Rb = Epi::PERM ? ((R[i] & ~31) + perm32(R[i] & 31)) : R[i]; voffB[i] = (unsigned)(Rb * K + C[i]) * 2u; }
    const size_t kstep = (size_t)(BK * 2);
    const unsigned ldsw = (unsigned)wid * 1024u;
    const int aoff = lds_byte(wr * 64 + fr, fq * 8), boff = lds_byte(wc * 32 + fr, fq * 8);
#define PG8_SA(b, h) (((b) * 2 + (h)) * HTB)
#define PG8_SB(b, h) ((4 + (b) * 2 + (h)) * HTB)
#define PG8_STAGE(bufoff, gbase, v0, v1) do { \
        __builtin_amdgcn_global_load_lds((const unsigned*)((const char*)(gbase) + (v0)), (PG8_LAS unsigned*)(lds + (bufoff) + ldsw), 16, 0, 0); \
        __builtin_amdgcn_global_load_lds((const unsigned*)((const char*)(gbase) + (v1)), (PG8_LAS unsigned*)(lds + (bufoff) + ldsw + 8192), 16, 0, 0); } while (0)
#define PG8_STAGEB(bufoff, gbase) PG8_STAGE(bufoff, gbase, voffB[0], voffB[1])
#define PG8_LDA(dst, b, h) do { _Pragma("unroll") for (int m = 0; m < 4; ++m) _Pragma("unroll") for (int k = 0; k < 2; ++k) dst[m][k] = *(const PG8_LAS bf16x8*)(lds + PG8_SA(b, h) + aoff + m * 2048 + k * 1024); } while (0)
#define PG8_LDB(dst, b, h) do { _Pragma("unroll") for (int n = 0; n < 2; ++n) _Pragma("unroll") for (int k = 0; k < 2; ++k) dst[n][k] = *(const PG8_LAS bf16x8*)(lds + PG8_SB(b, h) + boff + n * 2048 + k * 1024); } while (0)
#define PG8_MMA(ai, bj, At, Bt) do { __builtin_amdgcn_s_setprio(1); _Pragma("unroll") for (int m = 0; m < 4; ++m) _Pragma("unroll") for (int n = 0; n < 2; ++n) _Pragma("unroll") for (int k = 0; k < 2; ++k) \
        acc[ai][bj][m][n] = __builtin_amdgcn_mfma_f32_16x16x32_bf16(Bt[n][k], At[m][k], acc[ai][bj][m][n], 0, 0, 0); __builtin_amdgcn_s_setprio(0); } while (0)
#define PG8_WAIT_V(n) asm volatile("s_waitcnt vmcnt(" #n ")" ::: "memory")
#define PG8_WAIT_L(n) asm volatile("s_waitcnt lgkmcnt(" #n ")" ::: "memory")
#define PG8_BAR __builtin_amdgcn_s_barrier()
#define PG8_SCHED __builtin_amdgcn_sched_barrier(0)
    Unit cur, nxt; int ui = 0;
    if (!S.next(0, cur)) return;
    f32x4 acc[2][2][4][2];
#pragma unroll
    for (int a = 0; a < 2; ++a)
#pragma unroll
        for (int b = 0; b < 2; ++b)
#pragma unroll
            for (int m = 0; m < 4; ++m)
#pragma unroll
                for (int n = 0; n < 2; ++n) acc[a][b][m][n] = (f32x4){0.f, 0.f, 0.f, 0.f};
    bf16x8 At[4][2], B0[2][2], B1[2][2];
    unsigned vA00, vA01, vA10, vA11, vN00, vN01, vN10, vN11;
    S.a_ready(cur, S.peek(cur));
    S.a_offs(cur, R, C, vA00, vA01, vA10, vA11);
    const char* cB0 = cur.b0; const char* cB1 = cur.b1;
    PG8_STAGEB(PG8_SB(0, 0), cB0); PG8_STAGEB(PG8_SB(0, 1), cB1); PG8_STAGE(PG8_SA(0, 0), Abase, vA00, vA01); PG8_STAGE(PG8_SA(0, 1), Abase, vA10, vA11);
    if (wr == 1) PG8_BAR;
    PG8_WAIT_V(2); PG8_BAR;
    PG8_STAGEB(PG8_SB(1, 0), cB0 + kstep); PG8_STAGE(PG8_SA(1, 0), Abase + kstep, vA00, vA01); PG8_STAGEB(PG8_SB(1, 1), cB1 + kstep);
    PG8_WAIT_V(6); PG8_BAR;
    for (;;) {
        const bool has_next = S.next(ui + 1, nxt);
        if (has_next) S.a_offs(nxt, R, C, vN00, vN01, vN10, vN11); else { vN00 = vA00; vN01 = vA01; vN10 = vA10; vN11 = vA11; }
        const char* nB0 = has_next ? nxt.b0 : cB0; const char* nB1 = has_next ? nxt.b1 : cB1;
        const unsigned pk = has_next ? S.peek(nxt) : 0u;
        const bool skip1 = S.half_only(cur);
        for (int t = 0; t < nt; t += 2) {
            const bool last = (t == nt - 2);
            if (last && has_next) S.a_ready(nxt, pk);
            const char* a1 = Abase + (size_t)(t + 1) * kstep;
            PG8_LDB(B0, 0, 0); PG8_LDB(B1, 0, 1); PG8_SCHED; PG8_LDA(At, 0, 0); PG8_STAGE(PG8_SA(1, 1), a1, vA10, vA11);
            PG8_WAIT_V(8); PG8_WAIT_L(0); PG8_BAR; PG8_MMA(0, 0, At, B0); PG8_MMA(0, 1, At, B1); PG8_BAR; PG8_SCHED;
            if (last) { vA00 = vN00; vA01 = vN01; vA10 = vN10; vA11 = vN11; }
            const char* a2 = last ? Abase : Abase + (size_t)(t + 2) * kstep;
            const char* b20 = last ? nB0 : cB0 + (size_t)(t + 2) * kstep; const char* b21 = last ? nB1 : cB1 + (size_t)(t + 2) * kstep;
            const char* a3 = a2 + kstep; const char* b30 = b20 + kstep; const char* b31 = b21 + kstep;
            PG8_LDA(At, 0, 1); PG8_STAGEB(PG8_SB(0, 0), b20); PG8_STAGEB(PG8_SB(0, 1), b21); PG8_STAGE(PG8_SA(0, 0), a2, vA00, vA01);
            PG8_WAIT_V(8); PG8_WAIT_L(0); PG8_BAR; if (!skip1) { PG8_MMA(1, 0, At, B0); PG8_MMA(1, 1, At, B1); } PG8_BAR; PG8_SCHED;
            PG8_LDB(B0, 1, 0); PG8_LDB(B1, 1, 1); PG8_SCHED; PG8_LDA(At, 1, 0); PG8_STAGE(PG8_SA(0, 1), a2, vA10, vA11);
            PG8_WAIT_V(8); PG8_WAIT_L(0); PG8_BAR; PG8_MMA(0, 0, At, B0); PG8_MMA(0, 1, At, B1); PG8_BAR; PG8_SCHED;
            PG8_LDA(At, 1, 1); PG8_STAGEB(PG8_SB(1, 0), b30); PG8_STAGEB(PG8_SB(1, 1), b31); PG8_STAGE(PG8_SA(1, 0), a3, vA00, vA01);
            PG8_WAIT_V(8); PG8_WAIT_L(0); PG8_BAR; if (!skip1) { PG8_MMA(1, 0, At, B0); PG8_MMA(1, 1, At, B1); } PG8_BAR; PG8_SCHED;
        }
        if (wr == 0) PG8_BAR;
        E(acc, cur, wr, wc, fr, fq);
        S.done(cur);
        if (!has_next) break;
#pragma unroll
        for (int a = 0; a < 2; ++a)
#pragma unroll
            for (int b = 0; b < 2; ++b)
#pragma unroll
                for (int m = 0; m < 4; ++m)
#pragma unroll
                    for (int n = 0; n < 2; ++n) acc[a][b][m][n] = (f32x4){0.f, 0.f, 0.f, 0.f};
        cur = nxt; cB0 = nB0; cB1 = nB1; ++ui;
        if (wr == 1) PG8_BAR;
    }
    PG8_WAIT_V(0);
    PG8_BAR;
#undef PG8_SA
#undef PG8_SB
#undef PG8_STAGE
#undef PG8_STAGEB
#undef PG8_LDA
#undef PG8_LDB
#undef PG8_MMA
#undef PG8_WAIT_V
#undef PG8_WAIT_L
#undef PG8_BAR
#undef PG8_SCHED
}
}
#include <hip/hip_bf16.h>
#include <cmath>
namespace attn_body {
using bf16=__hip_bfloat16;
using bf16x8=__attribute__((ext_vector_type(8)))short;
using s16x4=__attribute__((ext_vector_type(4)))short;
using f32x16=__attribute__((ext_vector_type(16)))float;
using u32x4=__attribute__((ext_vector_type(4)))unsigned;
constexpr int D=64,DM=1024;
constexpr int NW=8,QBLK=32,QB=QBLK*NW,KVBLK=64;
constexpr int ATTN_PITCH=DM, ATTN_UNIT_ROWS=QB;
__device__ __forceinline__ int crow(int r,int hi){return (r&3)+8*(r>>2)+4*hi;}
#define SBAR() __builtin_amdgcn_sched_barrier(0)
__device__ __forceinline__ void cmask(f32x16&p0,f32x16&p1,int jb,int qrel,int hi){
  const float NEG=-INFINITY; int kb=64*jb+4*hi;
  #pragma unroll
  for(int r=0;r<16;++r){int kv=kb+(r&3)+8*(r>>2); if(kv>qrel)p0[r]=NEG; if(kv+32>qrel)p1[r]=NEG;}
}

constexpr int NSLOT=3, SLOTB=8192;
constexpr int LDS_K=0, LDS_V=NSLOT*SLOTB, LDS_WS=2*NSLOT*SLOTB, LDS_OST=LDS_WS+NW*64*4, LDS_BYTES=LDS_OST+NW*4096;
constexpr float C2=0.125f*1.4426950408889634f;
__device__ __forceinline__ void glds16(const void*gsrc,unsigned lds_dst){unsigned keep;
  asm volatile("s_mov_b32 %0, m0\n\ts_mov_b32 m0, %2\n\ts_nop 0\n\tglobal_load_lds_dwordx4 %1, off\n\ts_mov_b32 m0, %0":"=&s"(keep):"v"(gsrc),"s"(lds_dst):"memory");}
__device__ __forceinline__ void glds16s(const void*sbase,unsigned voff,unsigned lds_dst){unsigned keep;
  asm volatile("s_mov_b32 %0, m0\n\ts_mov_b32 m0, %3\n\ts_nop 4\n\tglobal_load_lds_dwordx4 %1, %2\n\ts_mov_b32 m0, %0":"=&s"(keep):"v"(voff),"s"(sbase),"s"(lds_dst):"memory");}
__device__ __forceinline__ float max3f(float a,float b,float c){float r;asm("v_max3_f32 %0, %1, %2, %3":"=v"(r):"v"(a),"v"(b),"v"(c));return r;}
__device__ __forceinline__ float max2f(float a,float b){float r;asm("v_max_f32_e32 %0, %1, %2":"=v"(r):"v"(a),"v"(b));return r;}
__device__ __forceinline__ float fadd_s(float a,float b){float r;asm("v_add_f32_e32 %0, %1, %2":"=v"(r):"v"(a),"v"(b));return r;}
__device__ __forceinline__ float fsub_s(float a,float b){float r;asm("v_sub_f32_e32 %0, %1, %2":"=v"(r):"v"(a),"v"(b));return r;}
typedef float f32x2_t __attribute__((ext_vector_type(2))); typedef __bf16 bf16x2_t __attribute__((ext_vector_type(2)));
__device__ __forceinline__ unsigned cvtpk_s(float lo,float hi){f32x2_t v={lo,hi};bf16x2_t b=__builtin_convertvector(v,bf16x2_t);return __builtin_bit_cast(unsigned,b);}
#define WAIT_BAR(N) asm volatile("s_waitcnt vmcnt(" #N ") lgkmcnt(0)\n\ts_barrier":::"memory")

__device__ __forceinline__ void qkt(f32x16&p0,f32x16&p1,const char*Kslot,const bf16x8*qr,const f32x16&negm,int r32,int hi){
  const char*kb=Kslot+hi*1024+r32*16;
  #pragma unroll
  for(int d0=0;d0<4;++d0){
    const bf16x8 b0=*reinterpret_cast<const bf16x8*>(kb+d0*2048);
    const bf16x8 b1=*reinterpret_cast<const bf16x8*>(kb+d0*2048+512);
    if(d0==0){p0=__builtin_amdgcn_mfma_f32_32x32x16_bf16(b0,qr[0],negm,0,0,0);p1=__builtin_amdgcn_mfma_f32_32x32x16_bf16(b1,qr[0],negm,0,0,0);}
    else{p0=__builtin_amdgcn_mfma_f32_32x32x16_bf16(b0,qr[d0],p0,0,0,0);p1=__builtin_amdgcn_mfma_f32_32x32x16_bf16(b1,qr[d0],p1,0,0,0);}}
}
typedef __attribute__((address_space(3))) const char* lds_cptr;
typedef short v4i16_t __attribute__((ext_vector_type(4)));
__device__ __forceinline__ void kload8(bf16x8*kf,lds_cptr kp){
  kf[0]=*(const __attribute__((address_space(3))) bf16x8*)(kp);      kf[1]=*(const __attribute__((address_space(3))) bf16x8*)(kp+512);
  kf[2]=*(const __attribute__((address_space(3))) bf16x8*)(kp+2048); kf[3]=*(const __attribute__((address_space(3))) bf16x8*)(kp+2560);
  kf[4]=*(const __attribute__((address_space(3))) bf16x8*)(kp+4096); kf[5]=*(const __attribute__((address_space(3))) bf16x8*)(kp+4608);
  kf[6]=*(const __attribute__((address_space(3))) bf16x8*)(kp+6144); kf[7]=*(const __attribute__((address_space(3))) bf16x8*)(kp+6656);
}
__device__ __forceinline__ void kload2(bf16x8*kf,lds_cptr kp,int j){ kf[2*j]=*(const __attribute__((address_space(3))) bf16x8*)(kp+j*2048); kf[2*j+1]=*(const __attribute__((address_space(3))) bf16x8*)(kp+j*2048+512); }
__device__ __forceinline__ s16x4 vtr(lds_cptr p){ return __builtin_bit_cast(s16x4,__builtin_amdgcn_ds_read_tr16_b64_v4i16((__attribute__((address_space(3))) v4i16_t*)p)); }
__device__ __forceinline__ float rowmax(const f32x16&p0,const f32x16&p1){
  float a=max3f(p0[0],p0[1],p1[0]),b=max3f(p0[2],p0[3],p1[1]);a=max3f(a,p1[2],p1[3]);
  #pragma unroll
  for(int r=4;r<16;r+=4){a=max3f(a,p0[r],p0[r+1]);b=max3f(b,p0[r+2],p0[r+3]);a=max3f(a,p1[r],p1[r+1]);b=max3f(b,p1[r+2],p1[r+3]);}
  const float m=max2f(a,b);
  auto rr=__builtin_amdgcn_permlane32_swap(__float_as_uint(m),__float_as_uint(m),false,false);
  return max2f(__uint_as_float(rr[0]),__uint_as_float(rr[1]));
}
__device__ __forceinline__ void pv(f32x16*o,int vb,bf16x8 pa0,bf16x8 pa1,bf16x8 pa2,bf16x8 pa3){
  #pragma unroll
  for(int d0=0;d0<2;++d0){s16x4 lo[4],hi[4];
    #pragma unroll
    for(int ks=0;ks<4;++ks){
      asm volatile("ds_read_b64_tr_b16 %0,%1 offset:%c2":"=&v"(lo[ks]):"v"(vb),"i"(d0*4096+ks*1024):"memory");
      asm volatile("ds_read_b64_tr_b16 %0,%1 offset:%c2":"=&v"(hi[ks]):"v"(vb),"i"(d0*4096+ks*1024+512):"memory");}
    asm volatile("s_waitcnt lgkmcnt(0)":::"memory");SBAR();
    #define PK(k) (bf16x8){lo[k][0],lo[k][1],lo[k][2],lo[k][3],hi[k][0],hi[k][1],hi[k][2],hi[k][3]}
    o[d0]=__builtin_amdgcn_mfma_f32_32x32x16_bf16(pa0,PK(0),o[d0],0,0,0);
    o[d0]=__builtin_amdgcn_mfma_f32_32x32x16_bf16(pa1,PK(1),o[d0],0,0,0);
    o[d0]=__builtin_amdgcn_mfma_f32_32x32x16_bf16(pa2,PK(2),o[d0],0,0,0);
    o[d0]=__builtin_amdgcn_mfma_f32_32x32x16_bf16(pa3,PK(3),o[d0],0,0,0);
    #undef PK
  }
}

#ifndef ATTN_STORE16
#define ATTN_STORE16(p,v) (*(u32x4*)(p)=(v))
#endif
template<int THRL> __device__ __forceinline__ void attn_unit(long rowbase,int qb,const bf16*Qc,const bf16*__restrict__ Kc,const bf16*__restrict__ Vc,bf16*Oc,char*shm){
  int tid_=threadIdx.x; asm volatile("":"+v"(tid_)); const int tid=tid_,lane=tid&63,r32=lane&31,hi=lane>>5; const int wid=__builtin_amdgcn_readfirstlane(tid>>6);
  const int q0=qb*QB;
  const bf16*Qw=Qc+(rowbase+q0+wid*QBLK)*DM;
  const bf16*Kh=Kc+rowbase*DM,*Vh=Vc+rowbase*DM;
  const unsigned lds0=(unsigned)(uintptr_t)shm;
  float*wsf=(float*)(shm+LDS_WS)+wid*64;
  const unsigned koff=(unsigned)(lane*DM+wid*8)*2u;
  const unsigned voffv=(unsigned)((16*(wid&3)+(lane>>2))*DM+(wid>>2)*32+(lane&3)*8)*2u;
  const unsigned kdst=lds0+LDS_K+wid*1024, vdst=lds0+LDS_V+wid*1024;
  #define DMA_K(t,slot) glds16s(Kh+(long)(t)*KVBLK*DM,koff,(unsigned)__builtin_amdgcn_readfirstlane(kdst+(slot)))
  #define DMA_V(t,slot) glds16s(Vh+(long)(t)*KVBLK*DM,voffv,(unsigned)__builtin_amdgcn_readfirstlane(vdst+(slot)))
  const int vb0=(int)(lds0+LDS_V)+((lane>>4)&1)*32+(lane&3)*8+(4*hi+((lane&15)>>2))*64;
  const char*Kbase=shm+LDS_K; bf16x8 kf[8];
  const lds_cptr shm3=(lds_cptr)shm; const lds_cptr kp0=shm3+LDS_K+hi*1024+r32*16; const lds_cptr vp0=shm3+LDS_V+((lane>>4)&1)*32+(lane&3)*8+(4*hi+((lane&15)>>2))*64;
  const int NT=(q0+QB)/KVBLK;
  DMA_K(0,0);DMA_V(0,0);DMA_K(1,SLOTB);
  bf16x8 qr[4];
  #pragma unroll
  for(int d0=0;d0<4;++d0)qr[d0]=*reinterpret_cast<const bf16x8*>(&Qw[(long)r32*DM+d0*16+hi*8]);
  float mhat=0.f,l_reg=0.f;f32x16 o[2];o[0]=f32x16{};o[1]=f32x16{};f32x16 negm=f32x16{};asm volatile("":"+v"(negm));
  const int qrel=wid*QBLK+r32;
  #define CMASK(P0,P1,t) do{int jb_=(t)-(NT-4); if(jb_>=0)cmask(P0,P1,jb_,qrel,hi);}while(0)
  bool resc=false;
  #define START(P0,P1) do{ const float rm=rowmax(P0,P1); resc=false; \
    { const float dl=rm; mhat=fadd_s(mhat,dl); \
      _Pragma("unroll") for(int r=0;r<16;++r){P0[r]=fsub_s(P0[r],dl);P1[r]=fsub_s(P1[r],dl);} \
      _Pragma("unroll") for(int r=0;r<16;++r)negm[r]=-mhat; asm volatile("":"+v"(negm)); } \
    _Pragma("unroll") for(int r=0;r<16;++r)P0[r]=__builtin_amdgcn_exp2f(P0[r]); }while(0)
  #define RESC() do{ if(resc){ asm volatile("s_waitcnt lgkmcnt(0)":::"memory"); \
      _Pragma("unroll") for(int d_=0;d_<2;++d_) _Pragma("unroll") for(int r=0;r<16;++r)o[d_][r]*=wsf[crow(r,hi)]; } }while(0)
  f32x16 pA0,pA1,pB0,pB1;
  int sl_prev=0,sl_cur=0,sl_next=SLOTB;
  #define ROT() do{sl_prev=sl_cur;sl_cur=sl_next;sl_next=(sl_next==(NSLOT-1)*SLOTB)?0:sl_next+SLOTB;}while(0)
  DMA_K(2,2*SLOTB);
  WAIT_BAR(3);
  qkt(pA0,pA1,Kbase,qr,negm,r32,hi);asm volatile("s_nop 15\n\ts_nop 7":"+v"(pA0),"+v"(pA1));CMASK(pA0,pA1,0);
  START(pA0,pA1);
  _Pragma("unroll") for(int r=0;r<16;++r)pA1[r]=__builtin_amdgcn_exp2f(pA1[r]);
  WAIT_BAR(0);
  DMA_K(3,0);DMA_V(1,SLOTB);
  ROT();
  kload8(kf,kp0+sl_cur);
  WAIT_BAR(2);
  s16x4 vlo[8],vhi[8]; u32x4 pw0,pw1,pw2,pw3;
  #define PKW(P,B) cvtpk_s(P[B],P[B+1])
  #define PAF(k) __builtin_bit_cast(bf16x8,pw##k)
  #define VFR(i) (bf16x8){vlo[i][0],vlo[i][1],vlo[i][2],vlo[i][3],vhi[i][0],vhi[i][1],vhi[i][2],vhi[i][3]}
  #define PIN(x) asm volatile("":"+v"(x))
  #define MX3(a,b,c) __builtin_fmaxf(__builtin_fmaxf((a),(b)),(c))
  #define GAPA(MF,A0,A1,A2,A3,W0,W1,PW) do{ MF; sacc+=A0; sacc+=A1; sacc+=A2; sacc+=A3; PIN(sacc); W0; W1; PIN(PW); SBAR(); }while(0)
  #define EX(v) __builtin_amdgcn_exp2f(v)
  #define GAPB(MF,X,B) do{ MF; X[B]=EX(X[B]); X[B+1]=EX(X[B+1]); X[B+2]=EX(X[B+2]); X[B+3]=EX(X[B+3]); PIN(X); SBAR(); }while(0)
  #define VRD(i) do{ vlo[i]=vtr(vp_+(((i)>>2)*4096+((i)&3)*1024)); vhi[i]=vtr(vp_+(((i)>>2)*4096+((i)&3)*1024+512)); }while(0)
  #define KRD(G,j) do{ if(G){ kload2(kf,kp0+sl_next,j); SBAR(); } }while(0)
  #define STEP(C0,C1,P0,P1,t,GK,GV,GL) do{ SBAR(); \
    const lds_cptr vp_=vp0+sl_prev; \
    VRD(0); SBAR(); float sacc=(P0[0]+P0[1]); \
    GAPA(C0=__builtin_amdgcn_mfma_f32_32x32x16_bf16(kf[0],qr[0],negm,0,0,0), P0[2],P0[3],P0[4],P0[5],     pw0[0]=PKW(P0,0), pw0[1]=PKW(P0,2), pw0); \
    VRD(4); SBAR(); GAPA(C1=__builtin_amdgcn_mfma_f32_32x32x16_bf16(kf[1],qr[0],negm,0,0,0), P0[6],P0[7],P0[8],P0[9],     pw0[2]=PKW(P0,4), pw0[3]=PKW(P0,6), pw0); \
    VRD(1); SBAR(); GAPA(C0=__builtin_amdgcn_mfma_f32_32x32x16_bf16(kf[2],qr[1],C0,0,0,0),   P0[10],P0[11],P0[12],P0[13], pw1[0]=PKW(P0,8), pw1[1]=PKW(P0,10), pw1); \
    VRD(5); SBAR(); GAPA(C1=__builtin_amdgcn_mfma_f32_32x32x16_bf16(kf[3],qr[1],C1,0,0,0),   P0[14],P0[15],P1[0],P1[1],   pw1[2]=PKW(P0,12),pw1[3]=PKW(P0,14), pw1); \
    VRD(2); SBAR(); GAPA(C0=__builtin_amdgcn_mfma_f32_32x32x16_bf16(kf[4],qr[2],C0,0,0,0),   P1[2],P1[3],P1[4],P1[5],     pw2[0]=PKW(P1,0), pw2[1]=PKW(P1,2), pw2); \
    VRD(6); SBAR(); GAPA(C1=__builtin_amdgcn_mfma_f32_32x32x16_bf16(kf[5],qr[2],C1,0,0,0),   P1[6],P1[7],P1[8],P1[9],     pw2[2]=PKW(P1,4), pw2[3]=PKW(P1,6), pw2); \
    VRD(3); SBAR(); GAPA(C0=__builtin_amdgcn_mfma_f32_32x32x16_bf16(kf[6],qr[3],C0,0,0,0),   P1[10],P1[11],P1[12],P1[13], pw3[0]=PKW(P1,8), pw3[1]=PKW(P1,10), pw3); \
    VRD(7); SBAR(); GAPA(C1=__builtin_amdgcn_mfma_f32_32x32x16_bf16(kf[7],qr[3],C1,0,0,0),   P1[14],P1[15],0.f,0.f,       pw3[2]=PKW(P1,12),pw3[3]=PKW(P1,14), pw3); \
    l_reg+=sacc; \
    if(GK){DMA_K((t)+3,sl_cur);} if(GV){DMA_V((t)+1,sl_next);} \
    CMASK(C0,C1,t); \
    { float a=MX3(C0[0],C0[1],C1[0]),b=MX3(C0[2],C0[3],C1[1]); a=MX3(a,C1[2],C1[3]); \
      _Pragma("unroll") for(int r=4;r<16;r+=4){a=MX3(a,C0[r],C0[r+1]);b=MX3(b,C0[r+2],C0[r+3]);a=MX3(a,C1[r],C1[r+1]);b=MX3(b,C1[r+2],C1[r+3]);} \
      float rm=__builtin_fmaxf(a,b); { auto rr=__builtin_amdgcn_permlane32_swap(__float_as_uint(rm),__float_as_uint(rm),false,false); rm=__builtin_fmaxf(__uint_as_float(rr[0]),__uint_as_float(rr[1])); } \
      resc=false; \
      if(__builtin_expect(__any(rm>(float)THRL),0)){ const float dl=__builtin_fmaxf(rm,0.f); mhat+=dl; \
        _Pragma("unroll") for(int r=0;r<16;++r){C0[r]-=dl;C1[r]-=dl;} \
        _Pragma("unroll") for(int r=0;r<16;++r)negm[r]=-mhat; asm volatile("":"+v"(negm)); \
        const float f=__builtin_amdgcn_exp2f(-dl); l_reg*=f; if(hi==0)wsf[r32]=f; resc=true; } } \
    SBAR(); \
    GAPB(o[0]=__builtin_amdgcn_mfma_f32_32x32x16_bf16(PAF(0),VFR(0),o[0],0,0,0), C0,0); \
    GAPB(o[1]=__builtin_amdgcn_mfma_f32_32x32x16_bf16(PAF(0),VFR(4),o[1],0,0,0), C0,4); \
    KRD(GL,0); GAPB(o[0]=__builtin_amdgcn_mfma_f32_32x32x16_bf16(PAF(1),VFR(1),o[0],0,0,0), C0,8); \
    KRD(GL,1); GAPB(o[1]=__builtin_amdgcn_mfma_f32_32x32x16_bf16(PAF(1),VFR(5),o[1],0,0,0), C0,12); \
    KRD(GL,2); GAPB(o[0]=__builtin_amdgcn_mfma_f32_32x32x16_bf16(PAF(2),VFR(2),o[0],0,0,0), C1,0); \
    KRD(GL,3); GAPB(o[1]=__builtin_amdgcn_mfma_f32_32x32x16_bf16(PAF(2),VFR(6),o[1],0,0,0), C1,4); \
    GAPB(o[0]=__builtin_amdgcn_mfma_f32_32x32x16_bf16(PAF(3),VFR(3),o[0],0,0,0), C1,8); \
    GAPB(o[1]=__builtin_amdgcn_mfma_f32_32x32x16_bf16(PAF(3),VFR(7),o[1],0,0,0), C1,12); \
    }while(0)
  int t=1;
  #undef CMASK
  #define CMASK(P0,P1,t) do{}while(0)
  for(;t+5<NT;t+=2){
    STEP(pB0,pB1,pA0,pA1,t,true,true,true);     WAIT_BAR(2); RESC(); ROT();
    STEP(pA0,pA1,pB0,pB1,t+1,true,true,true);   WAIT_BAR(2); RESC(); ROT();
  }
  #undef CMASK
  #define CMASK(P0,P1,t) do{int jb_=(t)-(NT-4); if(jb_>=0)cmask(P0,P1,jb_,qrel,hi);}while(0)
  #define ENDW(tt) do{ if((tt)+3<NT){WAIT_BAR(2);} else if((tt)+2<NT){WAIT_BAR(1);} else {WAIT_BAR(0);} }while(0)
  for(;t+1<NT;t+=2){
    STEP(pB0,pB1,pA0,pA1,t,(t+3<NT),(t+1<NT),(t+1<NT));       ENDW(t);   RESC(); ROT();
    STEP(pA0,pA1,pB0,pB1,t+1,(t+4<NT),(t+2<NT),(t+2<NT));     ENDW(t+1); RESC(); ROT();
  }
  STEP(pB0,pB1,pA0,pA1,NT-1,false,false,false); RESC();
  { float sacc=pB0[0]+pB0[1]; _Pragma("unroll") for(int r=2;r<16;++r)sacc+=pB0[r]; _Pragma("unroll") for(int r=0;r<16;++r)sacc+=pB1[r]; l_reg+=sacc;
    pw0=(u32x4){PKW(pB0,0),PKW(pB0,2),PKW(pB0,4),PKW(pB0,6)};pw1=(u32x4){PKW(pB0,8),PKW(pB0,10),PKW(pB0,12),PKW(pB0,14)};pw2=(u32x4){PKW(pB1,0),PKW(pB1,2),PKW(pB1,4),PKW(pB1,6)};pw3=(u32x4){PKW(pB1,8),PKW(pB1,10),PKW(pB1,12),PKW(pB1,14)};
    SBAR(); pv(o,vb0+sl_cur,PAF(0),PAF(1),PAF(2),PAF(3)); }
  #undef PKW
  #undef PAF
  #undef VFR
  #undef PIN
  #undef MX3
  #undef GAPA
  #undef GAPB
  #undef EX
  #undef VRD
  #undef KRD
  #undef STEP
  #undef ENDW
  {auto rr=__builtin_amdgcn_permlane32_swap(__float_as_uint(l_reg),__float_as_uint(l_reg),false,false);l_reg=__uint_as_float(rr[0])+__uint_as_float(rr[1]);}
  if(hi==0)wsf[32+r32]=l_reg;asm volatile("s_waitcnt lgkmcnt(0)":::"memory");
  float rli[16];
  #pragma unroll
  for(int r=0;r<16;++r)rli[r]=__builtin_amdgcn_rcpf(wsf[32+crow(r,hi)]);
  bf16*Ow=Oc+(rowbase+q0+wid*QBLK)*DM;
  { bf16*stg=(bf16*)(shm+LDS_OST)+wid*2048;
    #pragma unroll
    for(int r=0;r<16;++r){const int orow=crow(r,hi);
      #pragma unroll
      for(int d0=0;d0<2;++d0)stg[orow*64+d0*32+r32]=__float2bfloat16(o[d0][r]*rli[r]);}
    asm volatile("s_waitcnt lgkmcnt(0)":::"memory");
    #pragma unroll
    for(int i=0;i<4;++i){const int row=i*8+(lane>>3),ch=lane&7; const u32x4 v=*(const u32x4*)(stg+row*64+ch*8); ATTN_STORE16(Ow+(long)row*DM+ch*8,v);} }
  asm volatile("s_waitcnt lgkmcnt(0)\n\ts_barrier":::"memory");
  #undef DMA_K
  #undef DMA_V
  #undef CMASK
  #undef START
  #undef RESC
  #undef ROT
}
constexpr int ATTN_LDS_BYTES=LDS_BYTES;
#undef SBAR
#undef WAIT_BAR
}
namespace mk {
#define GAS __attribute__((address_space(1)))
#define LAS __attribute__((address_space(3)))
typedef unsigned short bf16;
typedef unsigned v4u __attribute__((ext_vector_type(4)));
typedef unsigned v2u __attribute__((ext_vector_type(2)));
typedef float f32x4 __attribute__((ext_vector_type(4)));
using pg8::Unit;
using pg8::cvt_pk_bf16;

constexpr int D = 1024, BATCH = 8, SEQ = 2048, T = BATCH * SEQ, NH = 8, NG = 4, EPG = 8, NE = 32, DE = 512, NRW = NG + NE;
constexpr float ALPHA = 1.4142135623730951f, LN_EPS = 1e-5f, RMS_EPS = 1e-5f;
constexpr float LAM_INIT = 0.35550906f;
constexpr float QSCALE = 0.125f * 1.4426950408889634f;
constexpr int CNT_STRIDE = 64;
constexpr int CAP = T;
constexpr int NWAVES = 8, NTHREADS = 512;
#ifndef P0B_FILL
#define P0B_FILL 1
#endif
#ifndef MOE_MERGE
#define MOE_MERGE 0
#endif
#ifndef P0B_SPLIT
#define P0B_SPLIT 9216
#endif

constexpr size_t MiB = 1u << 20;
constexpr size_t WS_CTL = 0, WS_W1T = 1 * MiB, WS_W2T = 7 * MiB, WS_WKVQ = 9 * MiB, WS_WOT = 15 * MiB, WS_RWT = 17 * MiB;
constexpr size_t WS_RWH = 17 * MiB + 512 * 1024;
constexpr size_t WS_WUT = 24 * MiB, WS_WDT = 152 * MiB, WS_XB = 216 * MiB, WS_GB = 248 * MiB, WS_U = 280 * MiB, WS_A2 = 312 * MiB, WS_Z = 344 * MiB, WS_X1B = 408 * MiB;
constexpr size_t WS_ACT = 440 * MiB, WS_YP = 480 * MiB, WS_X2B = 544 * MiB, WS_K = 576 * MiB, WS_V = 608 * MiB, WS_Q = 640 * MiB, WS_O0 = 672 * MiB, WS_O1 = 704 * MiB;
constexpr size_t WS_A3 = 736 * MiB, WS_X3B = 768 * MiB;
#ifdef MKPROBE
constexpr size_t WS_PERM = 18 * MiB;
constexpr size_t WS_Z1 = 800 * MiB, WS_ACT1 = 864 * MiB, WS_YP1 = 904 * MiB, WS_PERM1 = 968 * MiB, WS_END = 972 * MiB;
#else
constexpr size_t WS_PERM = 18 * MiB;
constexpr size_t WS_Z1 = WS_Z, WS_ACT1 = WS_ACT, WS_YP1 = WS_YP, WS_PERM1 = WS_PERM, WS_END = 800 * MiB;
#endif
#define LZ(l) ((l) ? WS_Z1 : WS_Z)
#define LACT(l) ((l) ? WS_ACT1 : WS_ACT)
#define LYP(l) ((l) ? WS_YP1 : WS_YP)
#define LPERM(l) ((l) ? WS_PERM1 : WS_PERM)
constexpr int RWH_PITCH = 2064  , RWH_BYTES = 2 * 36 * RWH_PITCH  ;
constexpr int RWH_PAD = 149504;
constexpr int RING_BYTES = 131072, RW_BYTES = RWH_PAD  , MISC_OFF = RW_BYTES, LDS_BYTES = 163840;

struct Args {
    const float *x, *a_w_in, *a_conv_w, *a_w_out, *kv_w, *b_w_q, *b_lambda, *b_subln_g, *b_w_o, *ln1_g, *ln1_b, *ln2_g, *ln2_b, *rg_w, *rg_b, *re_w, *re_b, *e_w_in, *e_w_down;
    float* out; unsigned char* ws;
};

typedef const __attribute__((address_space(4))) Args* ArgsP;
__device__ __forceinline__ ArgsP kargs() { ArgsP p = (ArgsP)__builtin_amdgcn_kernarg_segment_ptr(); asm volatile("" : "+s"(p)); return p; }
struct Ctx { int tid, lane, wave, G, bx, gw, NGW; unsigned char* ws; };
__device__ __forceinline__ Ctx mkctx(ArgsP ap) { Ctx c; int t = threadIdx.x; asm volatile("" : "+v"(t)); c.tid = t; c.lane = t & 63; c.wave = __builtin_amdgcn_readfirstlane(t >> 6);
    c.G = gridDim.x; c.bx = blockIdx.x; c.gw = c.bx * 8 + c.wave; c.NGW = c.G * 8; c.ws = ap->ws; return c; }
__device__ __forceinline__ unsigned f2bf(float f) { unsigned u = __builtin_bit_cast(unsigned, f); return (u + 0x7fffu + ((u >> 16) & 1u)) >> 16; }
__device__ __forceinline__ unsigned pk2(float lo, float hi) { return f2bf(lo) | (f2bf(hi) << 16); }
__device__ __forceinline__ float bflo(unsigned w) { return __builtin_bit_cast(float, w << 16); }
__device__ __forceinline__ float bfhi(unsigned w) { return __builtin_bit_cast(float, w & 0xffff0000u); }
__device__ __forceinline__ f32x4 ldz4(const bf16* p) { const v2u w = *(const v2u*)p; return (f32x4){bflo(w.x), bfhi(w.x), bflo(w.y), bfhi(w.y)}; }
__device__ __forceinline__ float wave_sum(float v) {
#pragma unroll
    for (int o = 1; o < 64; o <<= 1) v += __shfl_xor(v, o);
    return v;
}

__device__ __forceinline__ float dpp_add(float v, const int ctrl_sel) {
    const int iv = __builtin_bit_cast(int, v); int t;
    if (ctrl_sel == 0) t = __builtin_amdgcn_update_dpp(0, iv, 0xB1, 0xF, 0xF, true);
    else if (ctrl_sel == 1) t = __builtin_amdgcn_update_dpp(0, iv, 0x4E, 0xF, 0xF, true);
    else if (ctrl_sel == 2) t = __builtin_amdgcn_update_dpp(0, iv, 0x141, 0xF, 0xF, true);
    else if (ctrl_sel == 3) t = __builtin_amdgcn_update_dpp(0, iv, 0x140, 0xF, 0xF, true);
    else if (ctrl_sel == 4) t = __builtin_amdgcn_update_dpp(0, iv, 0x142, 0xA, 0xF, false);
    else t = __builtin_amdgcn_update_dpp(0, iv, 0x143, 0xC, 0xF, false);
    return v + __builtin_bit_cast(float, t);
}
template <int N> __device__ __forceinline__ void dpp_sum(float (&v)[N]) {
#pragma unroll
    for (int st = 0; st < 6; ++st) {
#pragma unroll
        for (int i = 0; i < N; ++i) v[i] = dpp_add(v[i], st);
    }
#pragma unroll
    for (int i = 0; i < N; ++i) v[i] = __builtin_bit_cast(float, __builtin_amdgcn_readlane(__builtin_bit_cast(int, v[i]), 63));
}
__device__ __forceinline__ float dpp_sum1(float v) { float a[1] = {v}; dpp_sum(a); return a[0]; }

__device__ __forceinline__ void p0_transpose_item(const float* W, int K, int N, bf16* WT, int row_off, LAS float* scr, int item, int lane) {
    const int nblk = N / 64, kb = item / nblk, nb = item % nblk, k0 = 64 * kb, n0 = 64 * nb;
    const float* src = W + (size_t)(k0 + (lane >> 4)) * N + n0 + (lane & 15) * 4;
    f32x4 v[16];
#pragma unroll
    for (int i = 0; i < 16; ++i) v[i] = __builtin_nontemporal_load((const f32x4*)(src + (size_t)(4 * i) * N));
#pragma unroll
    for (int i = 0; i < 16; ++i) { LAS float* d = scr + (4 * i + (lane >> 4)) * 65 + (lane & 15) * 4; d[0] = v[i].x; d[1] = v[i].y; d[2] = v[i].z; d[3] = v[i].w; }
    asm volatile("s_waitcnt lgkmcnt(0)" ::: "memory");
    const int c = lane & 7;
#pragma unroll
    for (int j = 0; j < 8; ++j) { const int n = (lane >> 3) + 8 * j; const LAS float* s = scr + (8 * c) * 65 + n;
        v4u o; o.x = pk2(s[0 * 65], s[1 * 65]); o.y = pk2(s[2 * 65], s[3 * 65]); o.z = pk2(s[4 * 65], s[5 * 65]); o.w = pk2(s[6 * 65], s[7 * 65]);
        *(GAS v4u*)(WT + (size_t)(row_off + n0 + n) * K + k0 + 8 * c) = o; }
    asm volatile("s_waitcnt lgkmcnt(0)" ::: "memory");
}

constexpr int I_IN = 16 * 48, I_SQ = 16 * 16, I_KV = 16 * 32, I_DN = 8 * 16;
constexpr int NEM = P0B_FILL ? NE : 2 * NE;
constexpr int PS1 = I_IN, PS2 = PS1 + I_SQ, PS3 = PS2 + I_KV, PS4 = PS3 + I_SQ, PS5 = PS4 + I_SQ, PS6 = PS5 + NEM * I_SQ, P0_NITEMS = PS6 + NEM * I_DN;
__device__ __forceinline__ void p0_items(LAS unsigned char* lds, int lo, int hi, int w, int nw) {
    const ArgsP a = kargs(); const Ctx cx = mkctx(a); const int lane = cx.lane; unsigned char* ws = cx.ws;
    LAS float* scr = (LAS float*)(lds + cx.wave * 16640);
    for (int it = lo + w; it < hi; it += nw) {
        if (it < PS1) p0_transpose_item(a->a_w_in, D, 3 * D, (bf16*)(ws + WS_W1T), 0, scr, it, lane);
        else if (it < PS2) p0_transpose_item(a->a_w_out, D, D, (bf16*)(ws + WS_W2T), 0, scr, it - PS1, lane);
        else if (it < PS3) p0_transpose_item(a->kv_w, D, 2 * D, (bf16*)(ws + WS_WKVQ), 0, scr, it - PS2, lane);
        else if (it < PS4) p0_transpose_item(a->b_w_q, D, D, (bf16*)(ws + WS_WKVQ), 2 * D, scr, it - PS3, lane);
        else if (it < PS5) p0_transpose_item(a->b_w_o, D, D, (bf16*)(ws + WS_WOT), 0, scr, it - PS4, lane);
        else if (it < PS6) { const int r = it - PS5, mtx = r / I_SQ; p0_transpose_item(a->e_w_in + (size_t)mtx * D * D, D, D, (bf16*)(ws + WS_WUT) + (size_t)mtx * D * D, 0, scr, r % I_SQ, lane); }
        else { const int r = it - PS6, mtx = r / I_DN; p0_transpose_item(a->e_w_down + (size_t)mtx * DE * D, DE, D, (bf16*)(ws + WS_WDT) + (size_t)mtx * D * DE, 0, scr, r % I_DN, lane); }
    }
}
#ifndef ROLE_SPLIT
#define ROLE_SPLIT 1
#endif
#ifndef P0A_EXTRA
#define P0A_EXTRA 6656
#endif
__device__ __forceinline__ void p0_prologue(LAS unsigned char* lds) {
    const ArgsP a = kargs(); const Ctx cx = mkctx(a); const int gw = cx.gw, NGW = cx.NGW, lane = cx.lane;
    unsigned char* ws = cx.ws;
    p0_items(lds, 0, ROLE_SPLIT ? PS1 + P0A_EXTRA : P0_NITEMS, gw, NGW);
    for (int m = gw; m < T; m += NGW) {
        const GAS f32x4* xr = (const GAS f32x4*)(a->x + (size_t)m * D) + lane;
        GAS v2u* o = (GAS v2u*)((bf16*)(ws + WS_XB) + (size_t)m * D) + lane;
#pragma unroll
        for (int j = 0; j < 4; ++j) { const f32x4 v = xr[64 * j]; v2u w; w.x = pk2(v.x, v.y); w.y = pk2(v.z, v.w); o[64 * j] = w; }
    }
    { float* rwt = (float*)(ws + WS_RWT);
      for (int idx = gw * 64 + lane; idx < 2 * NRW * D; idx += NGW * 64) { const int l = idx / (NRW * D), n = (idx / D) % NRW, k = idx % D;
          const float w = n < NG ? a->rg_w[((size_t)l * D + k) * NG + n] : a->re_w[((size_t)l * D + k) * NE + (n - NG)];
          rwt[idx] = w;
          const unsigned hi = f2bf(w), lo = f2bf(w - __builtin_bit_cast(float, hi << 16));
          bf16* img = (bf16*)(ws + WS_RWH) + (size_t)l * (RWH_PAD / 2);
          img[(size_t)n * (RWH_PITCH / 2) + k] = (bf16)hi; img[(size_t)(NRW + n) * (RWH_PITCH / 2) + k] = (bf16)lo; } }
}
__device__ __forceinline__ void p0b_fill(LAS unsigned char* lds, int lo, int hi, int r, int nidle) {
    const ArgsP a = kargs(); const Ctx cx = mkctx(a); unsigned char* ws = cx.ws;
    LAS float* scr = (LAS float*)(lds + cx.wave * 16640);
    for (int it = lo + r * NWAVES + cx.wave; it < hi; it += nidle * NWAVES) {
        if (it < NE * 256) { const int mtx = NE + it / 256; p0_transpose_item(a->e_w_in + (size_t)mtx * D * D, D, D, (bf16*)(ws + WS_WUT) + (size_t)mtx * D * D, 0, scr, it % 256, cx.lane); }
        else { const int r2 = it - NE * 256, mtx = NE + r2 / 128; p0_transpose_item(a->e_w_down + (size_t)mtx * DE * D, DE, D, (bf16*)(ws + WS_WDT) + (size_t)mtx * D * DE, 0, scr, r2 % 128, cx.lane); }
    }
}
constexpr int P0B_ITEMS = NE * 256 + NE * 128;
__device__ __forceinline__ void p0b_idle_fill(LAS unsigned char* lds, int lo, int hi) {
    const ArgsP a = kargs(); const Ctx cx = mkctx(a); const LAS int* misc = (const LAS int*)(lds + MISC_OFF);
    const int U = misc[2 * NE], rem = U % cx.G;
    if (rem == 0) p0b_fill(lds, lo, hi, cx.bx, cx.G);
    else if (cx.bx >= rem) p0b_fill(lds, lo, hi, cx.bx - rem, cx.G - rem);
}
struct SchedDense {
    int G, c, nN, mode, K; const char* W;
    __device__ __forceinline__ bool next(int i, Unit& u) const {
        int pm, pn; if (!pg8::static_tile(i, G, c, T / 256, nN, pm, pn)) return false;
        u.arow = pm * 256; u.p0 = pm; u.p1 = pn; u.p2 = 0; u.p3 = 0;
        const size_t rb = (size_t)K * 2;
        if (mode == 0 && pn >= 4) { const int jj = pn - 4; u.b0 = W + (size_t)(D + 128 * jj) * rb; u.b1 = W + (size_t)(2 * D + 128 * jj) * rb; }
        else { u.b0 = W + (size_t)(256 * pn) * rb; u.b1 = u.b0 + 128 * rb; }
        return true;
    }
    __device__ __forceinline__ void a_offs(const Unit& u, const int (&R)[2], const int (&C)[2], unsigned& v00, unsigned& v01, unsigned& v10, unsigned& v11) const {
        v00 = (unsigned)((u.arow + R[0]) * K + C[0]) * 2u; v01 = (unsigned)((u.arow + R[1]) * K + C[1]) * 2u;
        v10 = (unsigned)((u.arow + 128 + R[0]) * K + C[0]) * 2u; v11 = (unsigned)((u.arow + 128 + R[1]) * K + C[1]) * 2u;
    }
    __device__ __forceinline__ bool half_only(const Unit&) const { return false; }
    __device__ __forceinline__ unsigned peek(const Unit&) const { return 0u; }
    __device__ __forceinline__ void a_ready(const Unit&, unsigned) const {}
    __device__ __forceinline__ void done(const Unit&) const {}
};
struct MoeTab { const LAS int* ub; const LAS int* ps; const LAS int* cn; };
struct SchedMoe {
    int G, c, K; bool up; const char* W; const v2u* perm; MoeTab tb;
    unsigned* ready; int hook; int off, nb;
    __device__ __forceinline__ bool half_only(const Unit& u) const { return u.p2 <= 128; }
    __device__ __forceinline__ unsigned peek(const Unit& u) const {
        return hook == 2 ? __hip_atomic_load(ready + 64 * u.p3, __ATOMIC_RELAXED, __HIP_MEMORY_SCOPE_AGENT) : 0u;
    }
    __device__ __forceinline__ void a_ready(const Unit& u, unsigned pk) const {
        if (hook != 2) return;
        if ((unsigned)__builtin_amdgcn_readfirstlane(pk) >= 32u) return;
        const unsigned long long t0 = __builtin_amdgcn_s_memrealtime();
        while ((unsigned)__builtin_amdgcn_readfirstlane(__hip_atomic_load(ready + 64 * u.p3, __ATOMIC_RELAXED, __HIP_MEMORY_SCOPE_AGENT)) < 32u) {
            if (__builtin_amdgcn_s_memrealtime() - t0 > 2000000ull) break;
            __builtin_amdgcn_s_sleep(2); }
        __builtin_amdgcn_fence(__ATOMIC_ACQUIRE, "agent");
        asm volatile("s_waitcnt vmcnt(0)" ::: "memory");
    }
    __device__ __forceinline__ void done(const Unit& u) const {
        if (hook != 1) return;
        asm volatile("s_waitcnt vmcnt(0)" ::: "memory");
        if ((threadIdx.x & 63) == 0) __hip_atomic_fetch_add(ready + 64 * u.p3, 1u, __ATOMIC_RELAXED, __HIP_MEMORY_SCOPE_AGENT);
    }
    __device__ __forceinline__ bool next(int i, Unit& u) const {
        int idx = i * G + c;
        if (nb > 0) {
            const int v = c - (G - nb);
            if (v >= 0) idx = i == 0 ? v : i == 1 ? v + nb : 2 * nb + v + (i - 2) * G;
            else idx = 3 * nb + c + i * G;
        }
        if (idx >= tb.ub[2 * NE]) return false;
        int k = 0;
#pragma unroll 1
        for (int q = 1; q < 2 * NE; ++q) if (idx >= tb.ub[q]) k = q;
        const int e = k & (NE - 1), local = idx - tb.ub[k];
        int ct, rti;
        if (k < NE) { const int rtn = (tb.ub[k + 1] - tb.ub[k]) >> 2; ct = local / rtn; rti = local - ct * rtn; }
        else { ct = local; rti = (tb.cn[e] - 1) >> 8; }
        const size_t rb = (size_t)K * 2; const char* We = W + (size_t)e * D * rb;
        if (up) { u.b0 = We + (size_t)(128 * ct) * rb; u.b1 = We + (size_t)(DE + 128 * ct) * rb; u.arow = e * CAP + rti * 256; u.p0 = tb.ps[e] + rti * 256; }
        else { u.b0 = We + (size_t)(256 * ct) * rb; u.b1 = u.b0 + 128 * rb; u.arow = tb.ps[e] + rti * 256; u.p0 = e * CAP + rti * 256; }
        u.p1 = ct; u.p2 = tb.cn[e] - rti * 256; u.p3 = (tb.ps[e] >> 8) + rti;
        return true;
    }
    __device__ __forceinline__ void a_offs(const Unit& u, const int (&R)[2], const int (&C)[2], unsigned& v00, unsigned& v01, unsigned& v10, unsigned& v11) const {
        if (up) {
            const int r00 = R[0] < u.p2 ? R[0] : 0, r01 = R[1] < u.p2 ? R[1] : 0, r10 = 128 + R[0] < u.p2 ? 128 + R[0] : 0, r11 = 128 + R[1] < u.p2 ? 128 + R[1] : 0;
            const int t00 = (int)(perm[u.arow + r00].y >> 1), t01 = (int)(perm[u.arow + r01].y >> 1), t10 = (int)(perm[u.arow + r10].y >> 1), t11 = (int)(perm[u.arow + r11].y >> 1);
            v00 = (unsigned)(t00 * K + C[0]) * 2u; v01 = (unsigned)(t01 * K + C[1]) * 2u; v10 = (unsigned)(t10 * K + C[0]) * 2u; v11 = (unsigned)(t11 * K + C[1]) * 2u;
        } else {
            v00 = (unsigned)((u.arow + R[0]) * K + C[0]) * 2u; v01 = (unsigned)((u.arow + R[1]) * K + C[1]) * 2u;
            v10 = (unsigned)((u.arow + 128 + R[0]) * K + C[0]) * 2u; v11 = (unsigned)((u.arow + 128 + R[1]) * K + C[1]) * 2u;
        }
    }
};

struct EpiConvIn {
    static constexpr bool PERM = true; bf16* GB; bf16* U;
    __device__ __forceinline__ void operator()(const f32x4 (&acc)[2][2][4][2], const Unit& u, int wr, int wc, int fr, int fq) const {
        const int row0 = u.p0 * 256 + wr * 64 + fr;
        if (u.p1 < 4) {
            const int col0 = u.p1 * 256 + wc * 32 + 8 * fq;
#pragma unroll
            for (int ai = 0; ai < 2; ++ai)
#pragma unroll
                for (int m = 0; m < 4; ++m) { bf16* rowp = GB + (size_t)(row0 + ai * 128 + m * 16) * D + col0;
#pragma unroll
                    for (int bj = 0; bj < 2; ++bj) { const f32x4 v0 = acc[ai][bj][m][0], v1 = acc[ai][bj][m][1];
                        v4u w; w.x = cvt_pk_bf16(v0[0], v0[1]); w.y = cvt_pk_bf16(v0[2], v0[3]); w.z = cvt_pk_bf16(v1[0], v1[1]); w.w = cvt_pk_bf16(v1[2], v1[3]);
                        *(v4u*)(rowp + bj * 128) = w; } }
        } else {
            const int col0 = (u.p1 - 4) * 128 + wc * 32 + 8 * fq;
#pragma unroll
            for (int ai = 0; ai < 2; ++ai)
#pragma unroll
                for (int m = 0; m < 4; ++m) { const f32x4 v0 = acc[ai][0][m][0] * acc[ai][1][m][0], v1 = acc[ai][0][m][1] * acc[ai][1][m][1];
                    v4u w; w.x = cvt_pk_bf16(v0[0], v0[1]); w.y = cvt_pk_bf16(v0[2], v0[3]); w.z = cvt_pk_bf16(v1[0], v1[1]); w.w = cvt_pk_bf16(v1[2], v1[3]);
                    *(v4u*)(U + (size_t)(row0 + ai * 128 + m * 16) * D + col0) = w; }
        }
    }
};
template <bool RES_BF16> struct EpiResZ {
    static constexpr bool PERM = true; const void* res; bf16* Z;
    __device__ __forceinline__ void operator()(const f32x4 (&acc)[2][2][4][2], const Unit& u, int wr, int wc, int fr, int fq) const {
        const int row0 = u.p0 * 256 + wr * 64 + fr, col0 = u.p1 * 256 + wc * 32 + 8 * fq;
#pragma unroll
        for (int ai = 0; ai < 2; ++ai)
#pragma unroll
            for (int m = 0; m < 4; ++m) { const size_t off = (size_t)(row0 + ai * 128 + m * 16) * D + col0;
#pragma unroll
                for (int bj = 0; bj < 2; ++bj) { const size_t o = off + bj * 128; f32x4 r0, r1;
                    if (RES_BF16) { const v4u w = *(const v4u*)((const bf16*)res + o); r0 = (f32x4){bflo(w.x), bfhi(w.x), bflo(w.y), bfhi(w.y)}; r1 = (f32x4){bflo(w.z), bfhi(w.z), bflo(w.w), bfhi(w.w)}; }
                    else { r0 = *(const f32x4*)((const float*)res + o); r1 = *(const f32x4*)((const float*)res + o + 4); }
                    const f32x4 v0 = r0 * ALPHA + acc[ai][bj][m][0], v1 = r1 * ALPHA + acc[ai][bj][m][1];
                    v4u w; w.x = cvt_pk_bf16(v0[0], v0[1]); w.y = cvt_pk_bf16(v0[2], v0[3]); w.z = cvt_pk_bf16(v1[0], v1[1]); w.w = cvt_pk_bf16(v1[2], v1[3]);
                    *(v4u*)(Z + o) = w; } }
    }
};
template <bool WT> struct EpiUp {
    static constexpr bool PERM = true; bf16* ACT;
    __device__ __forceinline__ void operator()(const f32x4 (&acc)[2][2][4][2], const Unit& u, int wr, int wc, int fr, int fq) const {
        const int row0 = u.p0 + wr * 64 + fr, col0 = u.p1 * 128 + wc * 32 + 8 * fq;
#pragma unroll
        for (int ai = 0; ai < 2; ++ai)
#pragma unroll
            for (int m = 0; m < 4; ++m) { f32x4 v[2];
#pragma unroll
                for (int n = 0; n < 2; ++n) { const f32x4 g = acc[ai][0][m][n], uu = acc[ai][1][m][n];
#pragma unroll
                    for (int j = 0; j < 4; ++j) { const float e = __builtin_amdgcn_exp2f(g[j] * -1.4426950408889634f); v[n][j] = g[j] * __builtin_amdgcn_rcpf(1.0f + e) * uu[j]; } }
                v4u w; w.x = cvt_pk_bf16(v[0][0], v[0][1]); w.y = cvt_pk_bf16(v[0][2], v[0][3]); w.z = cvt_pk_bf16(v[1][0], v[1][1]); w.w = cvt_pk_bf16(v[1][2], v[1][3]);
                bf16* dst = ACT + (size_t)(row0 + ai * 128 + m * 16) * DE + col0;
                if (WT) { __hip_atomic_store((unsigned long long*)dst, ((unsigned long long)w.y << 32) | w.x, __ATOMIC_RELAXED, __HIP_MEMORY_SCOPE_AGENT);
                          __hip_atomic_store((unsigned long long*)dst + 1, ((unsigned long long)w.w << 32) | w.z, __ATOMIC_RELAXED, __HIP_MEMORY_SCOPE_AGENT); }
                else *(v4u*)dst = w; }
    }
};
struct EpiDown {
    static constexpr bool PERM = true; bf16* YP; const v2u* perm;
    __device__ __forceinline__ void operator()(const f32x4 (&acc)[2][2][4][2], const Unit& u, int wr, int wc, int fr, int fq) const {
        const int col0 = u.p1 * 256 + wc * 32 + 8 * fq;
        v2u rec[2][4];
#pragma unroll
        for (int ai = 0; ai < 2; ++ai)
#pragma unroll
            for (int m = 0; m < 4; ++m) { const int r = ai * 128 + wr * 64 + m * 16 + fr; rec[ai][m] = perm[u.p0 + (r < u.p2 ? r : 0)]; }
#pragma unroll
        for (int ai = 0; ai < 2; ++ai)
#pragma unroll
            for (int m = 0; m < 4; ++m) { const int r = ai * 128 + wr * 64 + m * 16 + fr;
                if (r < u.p2) { const int pair = (int)rec[ai][m].y; float g = __builtin_bit_cast(float, rec[ai][m].x); asm volatile("" : "+v"(g)); bf16* rowp = YP + (size_t)pair * D + col0;
#pragma unroll
                    for (int bj = 0; bj < 2; ++bj) { const f32x4 v0 = acc[ai][bj][m][0] * g, v1 = acc[ai][bj][m][1] * g;
                        v4u w; w.x = cvt_pk_bf16(v0[0], v0[1]); w.y = cvt_pk_bf16(v0[2], v0[3]); w.z = cvt_pk_bf16(v1[0], v1[1]); w.w = cvt_pk_bf16(v1[2], v1[3]);
                        *(v4u*)(rowp + bj * 128) = w; } } }
    }
};
struct EpiKVQ {
    static constexpr bool PERM = true; bf16* KB;
    __device__ __forceinline__ void operator()(const f32x4 (&acc)[2][2][4][2], const Unit& u, int wr, int wc, int fr, int fq) const {
        const int t = u.p1 >> 2; const float sc = t == 2 ? QSCALE : 1.0f;
        bf16* base = KB + (size_t)t * (32 * MiB / 2);
        const int row0 = u.p0 * 256 + wr * 64 + fr, col0 = (u.p1 & 3) * 256 + wc * 32 + 8 * fq;
#pragma unroll
        for (int ai = 0; ai < 2; ++ai)
#pragma unroll
            for (int m = 0; m < 4; ++m) { bf16* rowp = base + (size_t)(row0 + ai * 128 + m * 16) * D + col0;
#pragma unroll
                for (int bj = 0; bj < 2; ++bj) { const f32x4 v0 = acc[ai][bj][m][0] * sc, v1 = acc[ai][bj][m][1] * sc;
                    v4u w; w.x = cvt_pk_bf16(v0[0], v0[1]); w.y = cvt_pk_bf16(v0[2], v0[3]); w.z = cvt_pk_bf16(v1[0], v1[1]); w.w = cvt_pk_bf16(v1[2], v1[3]);
                    *(v4u*)(rowp + bj * 128) = w; } }
    }
};

__device__ __forceinline__ void ln_rows(f32x4 (&v)[4], const f32x4 (&gg)[4], const f32x4 (&bb)[4]) {
    float s = 0.f;
#pragma unroll
    for (int j = 0; j < 4; ++j) s += (v[j].x + v[j].y) + (v[j].z + v[j].w);
    const float mean = dpp_sum1(s) * (1.f / D); float s2 = 0.f;
#pragma unroll
    for (int j = 0; j < 4; ++j) { v[j] = v[j] - mean; s2 += (v[j].x * v[j].x + v[j].y * v[j].y) + (v[j].z * v[j].z + v[j].w * v[j].w); }
    const float rstd = 1.f / sqrtf(dpp_sum1(s2) * (1.f / D) + LN_EPS);
#pragma unroll
    for (int j = 0; j < 4; ++j) v[j] = v[j] * rstd * gg[j] + bb[j];
}
__device__ __forceinline__ float dot_lds(const f32x4 (&v)[4], const LAS f32x4* w, int lane) {
    float a = 0.f;
#pragma unroll
    for (int j = 0; j < 4; ++j) { const f32x4 ww = w[64 * j + lane]; a += (v[j].x * ww.x + v[j].y * ww.y) + (v[j].z * ww.z + v[j].w * ww.w); }
    return a;
}
typedef short bf16x8v __attribute__((ext_vector_type(8)));
__device__ __forceinline__ void ln_router_mfma(LAS unsigned char* lds, int layer, int rep) {
    const ArgsP a = kargs(); const Ctx cx = mkctx(a); const int lane = cx.lane, wave = cx.wave, tid = cx.tid;
    unsigned char* ws = cx.ws;
    const bf16* Z = (const bf16*)(ws + LZ(layer)); bf16* Xb = (bf16*)(ws + (layer == 0 ? WS_X1B : WS_X3B));
    const float* g = a->ln1_g + layer * D; const float* b = a->ln1_b + layer * D;
    const float* rgb = a->rg_b + layer * NG; const float* reb = a->re_b + layer * NE;
    int* cnt = (int*)(ws + WS_CTL) + layer * NE * CNT_STRIDE; v2u* perm = (v2u*)(ws + LPERM(layer));
    const int i = lane & 15, kq = lane >> 4, grp = wave >> 1, half = wave & 1;
    const int row = cx.bx * 64 + grp * 16 + i, col0 = 512 * half + 8 * kq;
    { const unsigned char* wg = ws + WS_RWH + (size_t)layer * RWH_PAD;
      for (int q = wave; q < RWH_PAD / 1024; q += NWAVES)
          __builtin_amdgcn_global_load_lds((const unsigned*)(wg + (size_t)q * 1024 + lane * 16), (LAS unsigned*)(lds + q * 1024), 16, 0, 0); }
    v4u xw[16];
#pragma unroll
    for (int s = 0; s < 16; ++s) xw[s] = *(const v4u*)(Z + (size_t)row * D + col0 + 32 * s);
#define XLO(s) ((f32x4){bflo(xw[s].x), bfhi(xw[s].x), bflo(xw[s].y), bfhi(xw[s].y)})
#define XHI(s) ((f32x4){bflo(xw[s].z), bfhi(xw[s].z), bflo(xw[s].w), bfhi(xw[s].w)})
    LAS float* xs = (LAS float*)(lds + MISC_OFF + 4096);
    LAS float* part = (LAS float*)lds;
    float s1 = 0.f, s2 = 0.f;
#pragma unroll
    for (int s = 0; s < 16; ++s)
#pragma unroll
        for (int h2 = 0; h2 < 2; ++h2) { const f32x4 v = h2 ? XHI(s) : XLO(s); s1 += (v.x + v.y) + (v.z + v.w); s2 += (v.x * v.x + v.y * v.y) + (v.z * v.z + v.w * v.w); }
#pragma unroll
    for (int s = 0; s < 16; ++s) asm volatile("" : "+v"(xw[s]));
    s1 += __shfl_xor(s1, 16); s2 += __shfl_xor(s2, 16); s1 += __shfl_xor(s1, 32); s2 += __shfl_xor(s2, 32);
    if (kq == 0) { xs[(wave * 16 + i) * 2] = s1; xs[(wave * 16 + i) * 2 + 1] = s2; }
    __syncthreads();
    const float t1 = xs[((wave ^ 1) * 16 + i) * 2] + s1, t2 = xs[((wave ^ 1) * 16 + i) * 2 + 1] + s2;
    const float mean = t1 * (1.f / D), rstd = 1.f / sqrtf(fmaxf(t2 * (1.f / D) - mean * mean, 0.f) + LN_EPS);
    typedef float f32x4a __attribute__((ext_vector_type(4)));
    f32x4a acc0 = {0.f, 0.f, 0.f, 0.f}, acc1 = acc0, acc2 = acc0;
    const LAS unsigned char* wb = (const LAS unsigned char*)lds + (size_t)(lane & 15) * RWH_PITCH + (size_t)col0 * 2;
    const int n2 = (32 + (lane & 15)) < NRW ? 32 + (lane & 15) : NRW - 1;
    const LAS unsigned char* wb2 = (const LAS unsigned char*)lds + (size_t)n2 * RWH_PITCH + (size_t)col0 * 2;
    constexpr int LO = NRW * RWH_PITCH;
#pragma unroll
    for (int s = 0; s < 16; ++s) {
        if ((s & 3) == 0) asm volatile("" ::: "memory");
        const float* gp = g + col0 + 32 * s; const float* bp = b + col0 + 32 * s;
        const f32x4 g0 = *(const f32x4*)gp, g1 = *(const f32x4*)(gp + 4), b0 = *(const f32x4*)bp, b1 = *(const f32x4*)(bp + 4);
        const f32x4 v0 = (XLO(s) - mean) * rstd * g0 + b0, v1 = (XHI(s) - mean) * rstd * g1 + b1;
        const float vv[8] = {v0.x, v0.y, v0.z, v0.w, v1.x, v1.y, v1.z, v1.w};
        unsigned hi[8], lo[8];
#pragma unroll
        for (int j = 0; j < 8; ++j) { hi[j] = f2bf(vv[j]); lo[j] = f2bf(vv[j] - __builtin_bit_cast(float, hi[j] << 16)); }
        v4u hw, lw;
#pragma unroll
        for (int j = 0; j < 4; ++j) { hw[j] = hi[2 * j] | (hi[2 * j + 1] << 16); lw[j] = lo[2 * j] | (lo[2 * j + 1] << 16); }
        *(v4u*)(Xb + (size_t)row * D + col0 + 32 * s) = hw;
        const bf16x8v ah = __builtin_bit_cast(bf16x8v, hw), al = __builtin_bit_cast(bf16x8v, lw);
        const bf16x8v w0h = *(const LAS bf16x8v*)(wb + 64 * s), w0l = *(const LAS bf16x8v*)(wb + LO + 64 * s);
        const bf16x8v w1h = *(const LAS bf16x8v*)(wb + 16 * RWH_PITCH + 64 * s), w1l = *(const LAS bf16x8v*)(wb + 16 * RWH_PITCH + LO + 64 * s);
        const bf16x8v w2h = *(const LAS bf16x8v*)(wb2 + 64 * s), w2l = *(const LAS bf16x8v*)(wb2 + LO + 64 * s);
        acc0 = __builtin_amdgcn_mfma_f32_16x16x32_bf16(ah, w0h, acc0, 0, 0, 0); acc0 = __builtin_amdgcn_mfma_f32_16x16x32_bf16(al, w0h, acc0, 0, 0, 0); acc0 = __builtin_amdgcn_mfma_f32_16x16x32_bf16(ah, w0l, acc0, 0, 0, 0);
        acc1 = __builtin_amdgcn_mfma_f32_16x16x32_bf16(ah, w1h, acc1, 0, 0, 0); acc1 = __builtin_amdgcn_mfma_f32_16x16x32_bf16(al, w1h, acc1, 0, 0, 0); acc1 = __builtin_amdgcn_mfma_f32_16x16x32_bf16(ah, w1l, acc1, 0, 0, 0);
        acc2 = __builtin_amdgcn_mfma_f32_16x16x32_bf16(ah, w2h, acc2, 0, 0, 0); acc2 = __builtin_amdgcn_mfma_f32_16x16x32_bf16(al, w2h, acc2, 0, 0, 0); acc2 = __builtin_amdgcn_mfma_f32_16x16x32_bf16(ah, w2l, acc2, 0, 0, 0);
    }
    __syncthreads();
#undef XLO
#undef XHI
#pragma unroll
    for (int r = 0; r < 4; ++r) { LAS float* pr = part + (size_t)(wave * 16 + 4 * kq + r) * 48 + (lane & 15); pr[0] = acc0[r]; pr[16] = acc1[r]; pr[32] = acc2[r]; }
    LAS int* rt_e = (LAS int*)(part + 8 * 16 * 48);
    LAS float* rt_g = (LAS float*)(rt_e + 128);
    LAS int* rt_base = (LAS int*)(rt_g + 128);
    __syncthreads();
    if (tid < 64) {
        const int gq = tid >> 4, ii = tid & 15; const LAS float* p0 = part + (size_t)((2 * gq) * 16 + ii) * 48; const LAS float* p1 = p0 + 16 * 48;
        int gi = 0; float gm = -INFINITY, gl[NG];
#pragma unroll
        for (int n = 0; n < NG; ++n) { gl[n] = p0[n] + p1[n] + rgb[n]; if (gl[n] > gm) { gm = gl[n]; gi = n; } }
        float gs = 0.f;
#pragma unroll
        for (int n = 0; n < NG; ++n) gs += __expf(gl[n] - gm);
        const float gtop = 1.0f / gs;
        float m0 = -INFINITY, m1 = -INFINITY; int i0 = 0, i1 = 0;
        for (int n = 0; n < EPG; ++n) { const int c = NG + gi * EPG + n; const float e = p0[c] + p1[c] + reb[gi * EPG + n];
            if (e > m0) { m1 = m0; i1 = i0; m0 = e; i0 = n; } else if (e > m1) { m1 = e; i1 = n; } }
        const float e1 = __expf(m1 - m0), w0 = 1.0f / (1.0f + e1), w1 = e1 * w0;
        rt_e[2 * tid] = gi * EPG + i0; rt_e[2 * tid + 1] = gi * EPG + i1; rt_g[2 * tid] = gtop * w0; rt_g[2 * tid + 1] = gtop * w1;
    }
    __syncthreads();
    if (rep == 0) {
        if (tid < NE) { int c = 0; for (int q = 0; q < 128; ++q) c += (rt_e[q] == tid) ? 1 : 0; rt_base[tid] = c ? atomicAdd(&cnt[tid * CNT_STRIDE], c) : 0; }
        __syncthreads();
        if (tid < 128) { const int e = rt_e[tid]; int rank = 0; for (int q = 0; q < tid; ++q) rank += (rt_e[q] == e) ? 1 : 0;
            const int pair = 2 * (cx.bx * 64 + (tid >> 1)) + (tid & 1);
            perm[e * CAP + rt_base[e] + rank] = (v2u){__builtin_bit_cast(unsigned, rt_g[tid]), (unsigned)pair}; }
    }
}
__device__ __forceinline__ void ln_router_phase(LAS unsigned char* lds, int layer, int rep = 0) {
    const ArgsP a = kargs(); const Ctx cx = mkctx(a); const int gw = cx.gw, NGW = cx.NGW, lane = cx.lane;
    unsigned char* ws = cx.ws;
    const bf16* Z = (const bf16*)(ws + LZ(layer)); bf16* Xb = (bf16*)(ws + (layer == 0 ? WS_X1B : WS_X3B));
    const float* g = a->ln1_g + layer * D; const float* b = a->ln1_b + layer * D;
    const float* rgb = a->rg_b + layer * NG; const float* reb = a->re_b + layer * NE;
    int* cnt = (int*)(ws + WS_CTL) + layer * NE * CNT_STRIDE; v2u* perm = (v2u*)(ws + LPERM(layer));
    LAS f32x4* wl = (LAS f32x4*)lds;
    { const f32x4* wg = (const f32x4*)((const float*)(ws + WS_RWT) + (size_t)layer * NRW * D);
      for (int i = cx.tid; i < NRW * D / 4; i += NTHREADS) wl[i] = wg[i]; }
    f32x4 gg[4], bb[4];
#pragma unroll
    for (int j = 0; j < 4; ++j) { gg[j] = *(const f32x4*)(g + 256 * j + 4 * lane); bb[j] = *(const f32x4*)(b + 256 * j + 4 * lane); }
    constexpr int RPW = 16;
    LAS int* rt_row = (LAS int*)(lds + MISC_OFF + 2048);
    LAS int* rt_e = rt_row + NWAVES * RPW;
    LAS float* rt_g = (LAS float*)(rt_e + 2 * NWAVES * RPW);
    LAS int* rt_base = (LAS int*)(rt_g + 2 * NWAVES * RPW);
    LAS int* wave_rows = rt_base + NE;
    f32x4 nv[2][4];
#pragma unroll
    for (int r = 0; r < 2; ++r) { const int row = gw + r * NGW;
        if (row < T) {
#pragma unroll
            for (int j = 0; j < 4; ++j) nv[r][j] = ldz4(Z + (size_t)row * D + 256 * j + 4 * lane);
        } }
    __syncthreads();
    int it = 0;
#pragma unroll 1
    for (int row0 = gw; row0 < T && it < RPW; row0 += 2 * NGW, it += 2) {
        const bool two = row0 + NGW < T;
        f32x4 v[2][4];
#pragma unroll
        for (int r = 0; r < 2; ++r)
#pragma unroll
            for (int j = 0; j < 4; ++j) v[r][j] = nv[r][j];
#pragma unroll
        for (int r = 0; r < 2; ++r) { const int row = row0 + (2 + r) * NGW;
            if (row < T) {
#pragma unroll
                for (int j = 0; j < 4; ++j) nv[r][j] = ldz4(Z + (size_t)row * D + 256 * j + 4 * lane);
            } }
        if (!two) {
#pragma unroll
            for (int j = 0; j < 4; ++j) v[1][j] = v[0][j];
        }
        float s1[2];
#pragma unroll
        for (int r = 0; r < 2; ++r) { float s = 0.f;
#pragma unroll
            for (int j = 0; j < 4; ++j) s += (v[r][j].x + v[r][j].y) + (v[r][j].z + v[r][j].w);
            s1[r] = s; }
        dpp_sum(s1);
        float s2[2];
#pragma unroll
        for (int r = 0; r < 2; ++r) { const float mean = s1[r] * (1.f / D); float q = 0.f;
#pragma unroll
            for (int j = 0; j < 4; ++j) { v[r][j] = v[r][j] - mean; q += (v[r][j].x * v[r][j].x + v[r][j].y * v[r][j].y) + (v[r][j].z * v[r][j].z + v[r][j].w * v[r][j].w); }
            s2[r] = q; }
        dpp_sum(s2);
#pragma unroll
        for (int r = 0; r < 2; ++r) { const float rstd = 1.f / sqrtf(s2[r] * (1.f / D) + LN_EPS);
#pragma unroll
            for (int j = 0; j < 4; ++j) v[r][j] = v[r][j] * rstd * gg[j] + bb[j]; }
#pragma unroll
        for (int r = 0; r < 2; ++r) { const int row = row0 + r * NGW;
            if (r == 0 || two) {
#pragma unroll
                for (int j = 0; j < 4; ++j) { v2u w; w.x = pk2(v[r][j].x, v[r][j].y); w.y = pk2(v[r][j].z, v[r][j].w); *(v2u*)(Xb + (size_t)row * D + 256 * j + 4 * lane) = w; }
            } }
        float gl[2 * NG];
#pragma unroll
        for (int r = 0; r < 2; ++r)
#pragma unroll
            for (int n = 0; n < NG; ++n) gl[r * NG + n] = dot_lds(v[r], wl + n * (D / 4), lane);
        dpp_sum(gl);
        int gi[2]; float gtop[2];
#pragma unroll
        for (int r = 0; r < 2; ++r) { int g_ = 0; float gm = -INFINITY;
#pragma unroll
            for (int n = 0; n < NG; ++n) { gl[r * NG + n] += rgb[n]; if (gl[r * NG + n] > gm) { gm = gl[r * NG + n]; g_ = n; } }
            float gs = 0.f;
#pragma unroll
            for (int n = 0; n < NG; ++n) gs += __expf(gl[r * NG + n] - gm);
            gi[r] = g_; gtop[r] = 1.0f / gs; }
        float el[2 * EPG];
#pragma unroll
        for (int r = 0; r < 2; ++r)
#pragma unroll
            for (int n = 0; n < EPG; ++n) el[r * EPG + n] = dot_lds(v[r], wl + (NG + gi[r] * EPG + n) * (D / 4), lane);
        dpp_sum(el);
#pragma unroll
        for (int r = 0; r < 2; ++r) {
            float m0 = -INFINITY, m1 = -INFINITY; int i0 = 0, i1 = 0;
#pragma unroll
            for (int n = 0; n < EPG; ++n) { const float e = el[r * EPG + n] + reb[gi[r] * EPG + n];
                if (e > m0) { m1 = m0; i1 = i0; m0 = e; i0 = n; } else if (e > m1) { m1 = e; i1 = n; } }
            const float e1 = __expf(m1 - m0), w0 = 1.0f / (1.0f + e1), w1 = e1 * w0;
            if (lane == 0 && (r == 0 || two)) {
                const int li = cx.wave * RPW + it + r;
                rt_row[li] = row0 + r * NGW; rt_e[2 * li] = gi[r] * EPG + i0; rt_e[2 * li + 1] = gi[r] * EPG + i1; rt_g[2 * li] = gtop[r] * w0; rt_g[2 * li + 1] = gtop[r] * w1;
            }
        }
        if (!two) { it += 1; break; }
    }
    if (lane == 0) wave_rows[cx.wave] = it;
    __syncthreads();
    if (rep == 0) {
        if (cx.tid < NE) { int c = 0;
            for (int w = 0; w < NWAVES; ++w) { const int n = wave_rows[w]; for (int i = 0; i < 2 * n; ++i) c += (rt_e[2 * (w * RPW) + i] == cx.tid) ? 1 : 0; }
            rt_base[cx.tid] = c ? atomicAdd(&cnt[cx.tid * CNT_STRIDE], c) : 0; }
        __syncthreads();
        if (cx.tid < 2 * NWAVES * RPW) { const int w = cx.tid / (2 * RPW), i = cx.tid % (2 * RPW);
            if (i < 2 * wave_rows[w]) { const int e = rt_e[cx.tid]; int rank = 0;
                for (int w2 = 0; w2 <= w; ++w2) { const int lim = (w2 < w) ? 2 * wave_rows[w2] : i; for (int q = 0; q < lim; ++q) rank += (rt_e[2 * (w2 * RPW) + q] == e) ? 1 : 0; }
                const int pair = 2 * rt_row[cx.tid >> 1] + (cx.tid & 1);
                perm[e * CAP + rt_base[e] + rank] = (v2u){__builtin_bit_cast(unsigned, rt_g[cx.tid]), (unsigned)pair}; } }
    }
}
__device__ __forceinline__ void ln2_phase(int layer) {
    const ArgsP a = kargs(); const Ctx cx = mkctx(a); const int gw = cx.gw, NGW = cx.NGW, lane = cx.lane;
    unsigned char* ws = cx.ws;
    const bf16* Xin = (const bf16*)(ws + (layer == 0 ? WS_X1B : WS_X3B)); const bf16* YP = (const bf16*)(ws + LYP(layer));
    const float* g = a->ln2_g + layer * D; const float* b = a->ln2_b + layer * D;
    f32x4 gg[4], bb[4];
#pragma unroll
    for (int j = 0; j < 4; ++j) { gg[j] = *(const f32x4*)(g + 256 * j + 4 * lane); bb[j] = *(const f32x4*)(b + 256 * j + 4 * lane); }
    v2u nx[4], ny0[4], ny1[4];
    if (gw < T) {
#pragma unroll
        for (int j = 0; j < 4; ++j) { const size_t c = 256 * j + 4 * lane;
            nx[j] = *(const v2u*)(Xin + (size_t)gw * D + c); ny0[j] = *(const v2u*)(YP + (size_t)(2 * gw) * D + c); ny1[j] = *(const v2u*)(YP + (size_t)(2 * gw + 1) * D + c); }
    }
#pragma unroll 1
    for (int row = gw; row < T; row += NGW) {
        f32x4 v[4];
#pragma unroll
        for (int j = 0; j < 4; ++j) { const v2u xw = nx[j], y0 = ny0[j], y1 = ny1[j];
            v[j].x = ALPHA * bflo(xw.x) + (bflo(y0.x) + bflo(y1.x)); v[j].y = ALPHA * bfhi(xw.x) + (bfhi(y0.x) + bfhi(y1.x));
            v[j].z = ALPHA * bflo(xw.y) + (bflo(y0.y) + bflo(y1.y)); v[j].w = ALPHA * bfhi(xw.y) + (bfhi(y0.y) + bfhi(y1.y)); }
        if (row + NGW < T) { const int r2 = row + NGW;
#pragma unroll
            for (int j = 0; j < 4; ++j) { const size_t c = 256 * j + 4 * lane;
                nx[j] = *(const v2u*)(Xin + (size_t)r2 * D + c); ny0[j] = *(const v2u*)(YP + (size_t)(2 * r2) * D + c); ny1[j] = *(const v2u*)(YP + (size_t)(2 * r2 + 1) * D + c); }
        }
        ln_rows(v, gg, bb);
        if (layer == 0) {
#pragma unroll
            for (int j = 0; j < 4; ++j) { v2u w; w.x = pk2(v[j].x, v[j].y); w.y = pk2(v[j].z, v[j].w); *(v2u*)((bf16*)(ws + WS_X2B) + (size_t)row * D + 256 * j + 4 * lane) = w; }
        } else {
#pragma unroll
            for (int j = 0; j < 4; ++j) *(f32x4*)(a->out + (size_t)row * D + 256 * j + 4 * lane) = v[j];
        }
    }
}
__device__ __forceinline__ void conv_phase() {
    const ArgsP a = kargs(); const Ctx cx = mkctx(a); const int gtid = cx.bx * NTHREADS + cx.tid, NGT = cx.G * NTHREADS;
    unsigned char* ws = cx.ws;
    const bf16* GB = (const bf16*)(ws + WS_GB); const bf16* U = (const bf16*)(ws + WS_U); bf16* A2 = (bf16*)(ws + WS_A2);
    for (int it = gtid; it < T * (D / 8); it += NGT) {
        const int t = it >> 7, d0 = (it & 127) * 8, s = t & (SEQ - 1);
        const size_t o = (size_t)t * D + d0;
        const v4u g = *(const v4u*)(GB + o), u0 = *(const v4u*)(U + o);
        v4u u1 = (v4u){0u, 0u, 0u, 0u}, u2 = u1;
        if (s >= 1) u1 = *(const v4u*)(U + o - D);
        if (s >= 2) u2 = *(const v4u*)(U + o - 2 * D);
        v4u r;
#pragma unroll
        for (int q = 0; q < 4; ++q) {
            const int d = d0 + 2 * q;
            const float c0 = a->a_conv_w[d] * bflo(u2[q]) + a->a_conv_w[D + d] * bflo(u1[q]) + a->a_conv_w[2 * D + d] * bflo(u0[q]);
            const float c1 = a->a_conv_w[d + 1] * bfhi(u2[q]) + a->a_conv_w[D + d + 1] * bfhi(u1[q]) + a->a_conv_w[2 * D + d + 1] * bfhi(u0[q]);
            r[q] = pk2(bflo(g[q]) * c0, bfhi(g[q]) * c1);
        }
        *(v4u*)(A2 + o) = r;
    }
}
__device__ __forceinline__ void combine_phase() {
    const ArgsP a = kargs(); const Ctx cx = mkctx(a); const int gw = cx.gw, NGW = cx.NGW, lane = cx.lane;
    unsigned char* ws = cx.ws;
    const bf16* O0 = (const bf16*)(ws + WS_O0); const bf16* O1 = (const bf16*)(ws + WS_O1); bf16* A3 = (bf16*)(ws + WS_A3);
    const float l01 = wave_sum(a->b_lambda[lane] * a->b_lambda[64 + lane]), l23 = wave_sum(a->b_lambda[128 + lane] * a->b_lambda[192 + lane]);
    const float lam = __expf(l01) - __expf(l23) + LAM_INIT;
    float gsc[16];
#pragma unroll
    for (int i = 0; i < 16; ++i) gsc[i] = a->b_subln_g[(lane & 7) * 16 + i] * (1.0f - LAM_INIT);
    for (int row = gw; row < T; row += NGW) {
        const size_t o = (size_t)row * D + lane * 16;
        const v4u p0 = *(const v4u*)(O0 + o), p1 = *(const v4u*)(O0 + o + 8), q0 = *(const v4u*)(O1 + o), q1 = *(const v4u*)(O1 + o + 8);
        float d[16]; float ss = 0.f;
#pragma unroll
        for (int i = 0; i < 4; ++i) { d[2 * i] = bflo(p0[i]) - lam * bflo(q0[i]); d[2 * i + 1] = bfhi(p0[i]) - lam * bfhi(q0[i]);
            d[8 + 2 * i] = bflo(p1[i]) - lam * bflo(q1[i]); d[8 + 2 * i + 1] = bfhi(p1[i]) - lam * bfhi(q1[i]); }
#pragma unroll
        for (int i = 0; i < 16; ++i) ss += d[i] * d[i];
        ss += __shfl_xor(ss, 1); ss += __shfl_xor(ss, 2); ss += __shfl_xor(ss, 4);
        const float r = 1.0f / sqrtf(ss * (1.0f / 128.0f) + RMS_EPS);
        v4u w0, w1;
#pragma unroll
        for (int i = 0; i < 4; ++i) { w0[i] = pk2(d[2 * i] * r * gsc[2 * i], d[2 * i + 1] * r * gsc[2 * i + 1]); w1[i] = pk2(d[8 + 2 * i] * r * gsc[8 + 2 * i], d[8 + 2 * i + 1] * r * gsc[8 + 2 * i + 1]); }
        *(v4u*)(A3 + o) = w0; *(v4u*)(A3 + o + 8) = w1;
    }
}

#ifndef MKMASK
#define MKMASK 0xffff
#endif
#ifndef MKREP
#define MKREP 0
#endif
#ifndef MKSYNC
#define MKSYNC 0
#endif
#ifndef MKMASK2
#define MKMASK2 MKMASK
#endif
#define PH(k) _Pragma("unroll 1") for (int rep_ = 0; rep_ < (int)(((pass_ ? MKMASK2 : MKMASK) >> (k)) & 1) + (int)((MKREP >> (k)) & 1); ++rep_)
#define XB_TMO      128
#define XB_XCNT(j)  (256  + 64 * (j))
#define XB_XSUB(j)  (1280 + 64 * (j))
#define XB_XGEN(j)  (2304 + 64 * (j))
#define XB_TOP      3328
#define XB_TOPGEN   3392
#define XCD_BAR_WORDS 3456
#define XB_SPIN_CAP (1u << 18)

__device__ __forceinline__ unsigned xb_ld(unsigned* p)              { return __hip_atomic_load(p, __ATOMIC_RELAXED, __HIP_MEMORY_SCOPE_AGENT); }
__device__ __forceinline__ unsigned xb_add(unsigned* p, unsigned v) { return __hip_atomic_fetch_add(p, v, __ATOMIC_RELAXED, __HIP_MEMORY_SCOPE_AGENT); }
__device__ __forceinline__ unsigned xb_xcc_id() { return (unsigned)__builtin_amdgcn_s_getreg((3 << 11) | 20) & 0xFu; }
#define XB_SPIN(cond, bar) do { unsigned _sp = 0; while (cond) { __builtin_amdgcn_s_sleep(1); \
    if ((++_sp & 255u) == 0u) { if (xb_ld(&(bar)[XB_TMO])) break; if (_sp > XB_SPIN_CAP) { atomicAdd(&(bar)[XB_TMO], 1u); break; } } } } while (0)

struct XcdBarrier {
    unsigned* bar; unsigned x;
    volatile LAS unsigned* st;
};

__device__ __forceinline__ XcdBarrier xcd_barrier_post(unsigned* bar, volatile LAS unsigned* st) {
    XcdBarrier b; b.bar = bar; b.x = xb_xcc_id(); b.st = st;
    if (threadIdx.x == 0) (void)xb_add(&bar[XB_XCNT(b.x)], 1u);
    return b;
}
__device__ __forceinline__ void xcd_barrier_complete(unsigned* bar, unsigned x, unsigned& nloc, unsigned& nx) {
    const unsigned G = gridDim.x * gridDim.y * gridDim.z;
    unsigned sum, cnt, mine, sp = 0u;
    for (;;) {
        sum = 0u; cnt = 0u; mine = 0u;
#pragma unroll
        for (unsigned j = 0; j < 16; ++j) { const unsigned c = xb_ld(&bar[XB_XCNT(j)]); sum += c; cnt += (c > 0u) ? 1u : 0u; mine = (j == x) ? c : mine; }
        if (sum == G) break;
        __builtin_amdgcn_s_sleep(1);
        if ((++sp & 255u) == 0u) { if (xb_ld(&bar[XB_TMO])) break; if (sp > XB_SPIN_CAP) { atomicAdd(&bar[XB_TMO], 1u); break; } }
    }
    nloc = mine > 0u ? mine : 1u; nx = cnt > 0u ? cnt : 1u;
}

__device__ __forceinline__ void xcd_barrier(const XcdBarrier& b) {
    asm volatile("s_waitcnt vmcnt(0)" ::: "memory");
    __syncthreads();
    if (threadIdx.x == 0) {
        unsigned* bar = b.bar;
        __builtin_amdgcn_s_waitcnt(0);
        unsigned nloc = b.st[0], nx = b.st[1];
        if (nloc == 0u) { xcd_barrier_complete(bar, b.x, nloc, nx); b.st[0] = nloc; b.st[1] = nx; }
        const unsigned old = xb_add(&bar[XB_XSUB(b.x)], 1u);
        const unsigned gen = old / nloc;
        if (old + 1u == (gen + 1u) * nloc) {
            __builtin_amdgcn_fence(__ATOMIC_RELEASE, "agent");
            asm volatile("s_waitcnt vmcnt(0)" ::: "memory");
            const unsigned og = xb_add(&bar[XB_TOP], 1u);
            const unsigned tg = og / nx;
            if (og + 1u == (tg + 1u) * nx) xb_add(&bar[XB_TOPGEN], 1u);
            else XB_SPIN(xb_ld(&bar[XB_TOPGEN]) == tg, bar);
            __builtin_amdgcn_fence(__ATOMIC_ACQUIRE, "agent");
            xb_add(&bar[XB_XGEN(b.x)], 1u);
            asm volatile("s_waitcnt vmcnt(0)" ::: "memory");
        } else {
            XB_SPIN(xb_ld(&bar[XB_XGEN(b.x)]) == gen, bar);
            __builtin_amdgcn_fence(__ATOMIC_ACQUIRE, "agent");
            asm volatile("s_waitcnt vmcnt(0)" ::: "memory");
        }
    }
    __syncthreads();
}

constexpr int CW_BAR = 16384;
constexpr int ST_OFF = MISC_OFF + 1024;
__device__ __forceinline__ void seam(LAS unsigned char* lds) { const ArgsP a = kargs(); XcdBarrier b; b.bar = (unsigned*)(a->ws + WS_CTL) + CW_BAR; b.x = xb_xcc_id(); b.st = (volatile LAS unsigned*)(lds + ST_OFF); xcd_barrier(b); }
__device__ __forceinline__ void gemm1_phase(LAS unsigned char* lds) { const ArgsP a = kargs(); const Ctx cx = mkctx(a); unsigned char* ws = cx.ws;
    const int ng = ROLE_SPLIT ? cx.G - cx.G / 4 : cx.G;
    if (cx.bx < ng) { SchedDense S{ng, cx.bx, 12, 0, D, (const char*)(ws + WS_W1T)}; EpiConvIn E{(bf16*)(ws + WS_GB), (bf16*)(ws + WS_U)};
        pg8::gemm_phase(lds, (const char*)(ws + WS_XB), D, S, E); }
    else p0_items(lds, PS1 + P0A_EXTRA, P0_NITEMS, (cx.bx - ng) * NWAVES + cx.wave, (cx.G - ng) * NWAVES); }
__device__ __forceinline__ void gemm2_phase(LAS unsigned char* lds) { const ArgsP a = kargs(); const Ctx cx = mkctx(a); unsigned char* ws = cx.ws;
    SchedDense S{cx.G, cx.bx, 4, 1, D, (const char*)(ws + WS_W2T)}; EpiResZ<false> E{(const void*)a->x, (bf16*)(ws + LZ(0))};
    pg8::gemm_phase(lds, (const char*)(ws + WS_A2), D, S, E); }
__device__ __forceinline__ void kvq_phase(LAS unsigned char* lds) { const ArgsP a = kargs(); const Ctx cx = mkctx(a); unsigned char* ws = cx.ws;
    SchedDense S{cx.G, cx.bx, 12, 1, D, (const char*)(ws + WS_WKVQ)}; EpiKVQ E{(bf16*)(ws + WS_K)};
    pg8::gemm_phase(lds, (const char*)(ws + WS_X2B), D, S, E); }
__device__ __forceinline__ void wo_phase(LAS unsigned char* lds) { const ArgsP a = kargs(); const Ctx cx = mkctx(a); unsigned char* ws = cx.ws;
    SchedDense S{cx.G, cx.bx, 4, 1, D, (const char*)(ws + WS_WOT)}; EpiResZ<true> E{(const void*)(ws + WS_X2B), (bf16*)(ws + LZ(1))};
    pg8::gemm_phase(lds, (const char*)(ws + WS_A3), D, S, E); }
__device__ __forceinline__ void attn_phase(char* lds_generic) { const ArgsP a = kargs(); const Ctx cx = mkctx(a); unsigned char* ws = cx.ws;
#pragma unroll 1
    for (int uix = cx.bx; uix < BATCH * NH * 4 * (SEQ / 256); uix += cx.G) {
        const int combo = uix & 255, qi = uix >> 8;
        const int b = combo >> 5, h = (combo >> 2) & 7, c = (combo >> 1) & 1, vh = combo & 1;
        const int qb = (qi & 1) ? (SEQ / 256 - 1 - (qi >> 1)) : (qi >> 1);
        const attn_body::bf16* QK = (const attn_body::bf16*)(ws + WS_K) + h * 128 + c * 64;
        const attn_body::bf16* Vc = (const attn_body::bf16*)(ws + WS_V) + h * 128 + vh * 64;
        attn_body::bf16* Oc = (attn_body::bf16*)(ws + (c ? WS_O1 : WS_O0)) + h * 128 + vh * 64;
        attn_body::attn_unit<8>((long)b * SEQ, qb, QK + (WS_Q - WS_K) / 2, QK, Vc, Oc, lds_generic);
    }
}
__device__ __forceinline__ void moe_tables(LAS unsigned char* lds, int layer) { const ArgsP a = kargs(); const Ctx cx = mkctx(a); LAS int* misc = (LAS int*)(lds + MISC_OFF);
    const int* cnt = (const int*)(cx.ws + WS_CTL) + layer * NE * CNT_STRIDE;
    if (cx.tid < NE) misc[128 + cx.tid] = __hip_atomic_load(cnt + cx.tid * CNT_STRIDE, __ATOMIC_RELAXED, __HIP_MEMORY_SCOPE_AGENT);
    __syncthreads();
    if (cx.tid == 0) { int ub = 0, ps = 0; for (int e = 0; e < NE; ++e) { misc[e] = ub; misc[192 + e] = ps; const int cn = misc[128 + e], rt = (cn + 255) >> 8, half = (cn > 0 && ((cn - 1) & 255) < 128) ? 1 : 0; ub += 4 * (rt - half); ps += 256 * rt; }
        misc[192 + NE] = ps;
        for (int e = 0; e < NE; ++e) { misc[NE + e] = ub; const int cn = misc[128 + e]; ub += (cn > 0 && ((cn - 1) & 255) < 128) ? 4 : 0; } misc[2 * NE] = ub; }
    __syncthreads(); }
constexpr int CW_READY = 4096;
__device__ __forceinline__ void moe_up_phase(LAS unsigned char* lds, int layer, bool merged) { const ArgsP a = kargs(); const Ctx cx = mkctx(a); unsigned char* ws = cx.ws; LAS int* misc = (LAS int*)(lds + MISC_OFF);
    const MoeTab tb{misc, misc + 192, misc + 128};
    SchedMoe S{cx.G, cx.bx, D, true, (const char*)(ws + WS_WUT) + (size_t)layer * NE * D * D * 2, (const v2u*)(ws + LPERM(layer)), tb, (unsigned*)(ws + WS_CTL) + CW_READY, merged ? 1 : 0, 0, 0};
    if (merged) { EpiUp<true> E{(bf16*)(ws + LACT(layer))}; pg8::gemm_phase(lds, (const char*)(ws + (layer == 0 ? WS_X1B : WS_X3B)), D, S, E); }
    else { EpiUp<false> E{(bf16*)(ws + LACT(layer))}; pg8::gemm_phase(lds, (const char*)(ws + (layer == 0 ? WS_X1B : WS_X3B)), D, S, E); } }
__device__ __forceinline__ void moe_down_phase(LAS unsigned char* lds, int layer, bool merged) { const ArgsP a = kargs(); const Ctx cx = mkctx(a); unsigned char* ws = cx.ws; LAS int* misc = (LAS int*)(lds + MISC_OFF);
    const MoeTab tb{misc, misc + 192, misc + 128};
    int nb = 0;
    if (merged) { const int U = misc[2 * NE], rem = U % cx.G; nb = rem ? cx.G - rem : 0; }
    SchedMoe S{cx.G, cx.bx, DE, false, (const char*)(ws + WS_WDT) + (size_t)layer * NE * D * DE * 2, (const v2u*)(ws + LPERM(layer)), tb, (unsigned*)(ws + WS_CTL) + CW_READY, merged ? 2 : 0, 0, nb};
    EpiDown E{(bf16*)(ws + LYP(layer)), (const v2u*)(ws + LPERM(layer))};
    pg8::gemm_phase(lds, (const char*)(ws + LACT(layer)), DE, S, E); }

__global__ void __launch_bounds__(NTHREADS, 2) fwd_megakernel(Args args_unused) {
    extern __shared__ __attribute__((aligned(16))) unsigned char lds_raw[];
#ifdef NOSYNC
    struct { __device__ void sync() const {} } grid;
#else
    cg::grid_group grid = cg::this_grid();
#endif
#define SEAM() seam(lds)
    LAS unsigned char* lds = (LAS unsigned char*)lds_raw;
#ifndef MKPASS
#define MKPASS 1
#endif
    { const ArgsP a = kargs(); int t = threadIdx.x; asm volatile("" : "+v"(t));
      if (t < 2) ((volatile LAS unsigned*)(lds + ST_OFF))[t] = 0u;
      __syncthreads();
      (void)xcd_barrier_post((unsigned*)(a->ws + WS_CTL) + CW_BAR, (volatile LAS unsigned*)(lds + ST_OFF));
      if (a->ws == nullptr) grid.sync(); }
#pragma unroll 1
    for (int pass_ = 0; pass_ < MKPASS; ++pass_) {
    if (pass_) SEAM();
    PH(0) p0_prologue(lds);
    SEAM();
    PH(1) gemm1_phase(lds);
    SEAM();
    PH(2) conv_phase();
    SEAM();
    PH(3) gemm2_phase(lds);
    SEAM();
    PH(8) ln_router_mfma(lds, 0, rep_ + pass_);
    SEAM();
    moe_tables(lds, 0);
    PH(9) { moe_up_phase(lds, 0, false); if (P0B_FILL && pass_ == 0) p0b_idle_fill(lds, 0, P0B_SPLIT); }
    SEAM();
    PH(10) { moe_down_phase(lds, 0, false); if (P0B_FILL && pass_ == 0) p0b_idle_fill(lds, P0B_SPLIT, P0B_ITEMS); }
    SEAM();
    PH(11) ln2_phase(0);
    SEAM();
    PH(4) kvq_phase(lds);
    SEAM();
    PH(5) attn_phase((char*)lds_raw);
    SEAM();
    PH(6) combine_phase();
    SEAM();
    PH(7) wo_phase(lds);
    SEAM();
    PH(8) ln_router_mfma(lds, 1, rep_ + pass_);
    SEAM();
    moe_tables(lds, 1);
#if MOE_MERGE
    PH(9) moe_up_phase(lds, 1, pass_ == 0);
    if (pass_) SEAM();
    PH(10) moe_down_phase(lds, 1, pass_ == 0);
#else
    PH(9) moe_up_phase(lds, 1, false);
    SEAM();
    PH(10) moe_down_phase(lds, 1, false);
#endif
    SEAM();
    PH(11) ln2_phase(1);
    }
#pragma unroll 1
    for (int i = 0; i < MKSYNC; ++i) SEAM();
}
}

extern "C" void kernel_launch(void* const* d_in, const int* in_sizes, int n_in, void* d_out, int out_size, void* d_ws, size_t ws_size, hipStream_t stream) {
    using namespace mk;
    static int grid = 0;
    if (grid == 0) {
        if (n_in != 19 || out_size != T * D || ws_size < WS_END) { fprintf(stderr, "kernel_launch: unexpected shapes / workspace (n_in %d out %d ws %zu, need %zu)\n", n_in, out_size, ws_size, (size_t)WS_END); grid = -1; return; }
        int dev = 0, cus = 0, per_cu = 0;
        (void)hipGetDevice(&dev); (void)hipDeviceGetAttribute(&cus, hipDeviceAttributeMultiprocessorCount, dev);
        if (hipFuncSetAttribute((const void*)fwd_megakernel, hipFuncAttributeMaxDynamicSharedMemorySize, LDS_BYTES) != hipSuccess) { fprintf(stderr, "kernel_launch: hipFuncSetAttribute failed\n"); grid = -1; return; }
        if (hipOccupancyMaxActiveBlocksPerMultiprocessor(&per_cu, (const void*)fwd_megakernel, NTHREADS, LDS_BYTES) != hipSuccess || per_cu < 1) { fprintf(stderr, "kernel_launch: occupancy query says %d blocks per CU\n", per_cu); grid = -1; return; }
        grid = cus * 1;
        if (grid != T / 64) { fprintf(stderr, "kernel_launch: this build needs exactly %d workgroups (one per CU of a 256-CU MI355X: the LN1 + router phase gives each 64 rows); device has %d CUs\n", T / 64, cus); grid = -1; return; }
        (void)hipGetLastError();
    }
    if (grid < 0) return;
    if (hipMemsetAsync((char*)d_ws + WS_CTL, 0, (size_t)(CW_BAR + XCD_BAR_WORDS) * 4, stream) != hipSuccess) { fprintf(stderr, "kernel_launch: hipMemsetAsync of the control words failed\n"); return; }
    Args a{};
    a.x = (const float*)d_in[0]; a.a_w_in = (const float*)d_in[1]; a.a_conv_w = (const float*)d_in[2]; a.a_w_out = (const float*)d_in[3]; a.kv_w = (const float*)d_in[4];
    a.b_w_q = (const float*)d_in[5]; a.b_lambda = (const float*)d_in[6]; a.b_subln_g = (const float*)d_in[7]; a.b_w_o = (const float*)d_in[8];
    a.ln1_g = (const float*)d_in[9]; a.ln1_b = (const float*)d_in[10]; a.ln2_g = (const float*)d_in[11]; a.ln2_b = (const float*)d_in[12];
    a.rg_w = (const float*)d_in[13]; a.rg_b = (const float*)d_in[14]; a.re_w = (const float*)d_in[15]; a.re_b = (const float*)d_in[16];
    a.e_w_in = (const float*)d_in[17]; a.e_w_down = (const float*)d_in[18];
    a.out = (float*)d_out; a.ws = (unsigned char*)d_ws;
    void* kargs[] = {&a};
    const hipError_t e = hipLaunchCooperativeKernel((const void*)fwd_megakernel, dim3(grid), dim3(NTHREADS), kargs, LDS_BYTES, stream);
    if (e != hipSuccess) fprintf(stderr, "kernel_launch: cooperative launch failed: %s (grid %d)\n", hipGetErrorString(e), grid);
}
```

```cpp
#include <hip/hip_runtime.h>
#include <hip/hip_cooperative_groups.h>
#include <cstdio>
#include <cstdint>
namespace cg = cooperative_groups;

namespace pg8 {
#define PG8_LAS __attribute__((address_space(3)))
typedef unsigned short bf16_t;
typedef short bf16x8 __attribute__((ext_vector_type(8)));
typedef float f32x4 __attribute__((ext_vector_type(4)));
typedef unsigned u32x4 __attribute__((ext_vector_type(4)));
typedef unsigned u32x2 __attribute__((ext_vector_type(2)));
constexpr int BM = 256, BK = 64, HALF = 128, HTB = HALF * BK * 2  , STAGE_BYTES = 8 * HTB, NXCD = 8, WGM = 8;

__host__ __device__ __forceinline__ int lds_byte(int r, int c) { const int st = (r >> 4) * 2 + (c >> 5), rr = r & 15, cc = c & 31, ob = rr * 64 + cc * 2; return st * 1024 + (ob ^ (((ob >> 9) & 1) << 5)); }
__host__ __device__ __forceinline__ void stage_rc(int b, int& R, int& C) { const int st = b / 1024, sb = b % 1024, swz = sb ^ (((sb >> 9) & 1) << 5); R = (st >> 1) * 16 + swz / 64; C = (st & 1) * 32 + (swz % 64) / 2; }
__host__ __device__ __forceinline__ int perm32(int rho) { const int n = rho >> 4, i = rho & 15; return 8 * (i >> 2) + 4 * n + (i & 3); }

struct Unit { const char* b0; const char* b1; int arow; int p0, p1, p2, p3; };

__device__ __forceinline__ bool static_tile(int i, int G, int c, int nM, int nN, int& pm, int& pn) {
    const int nwg = nM * nN; const long L = (long)i * G + c; if (L >= nwg) return false;
    int wgid = (int)L; { const int q = nwg / NXCD, r = nwg % NXCD, xcd = wgid % NXCD, off = wgid / NXCD; wgid = (xcd < r ? xcd * (q + 1) : r * (q + 1) + (xcd - r) * q) + off; }
    const int nig = WGM * nN, gid = wgid / nig, fm = gid * WGM, gsz = (nM - fm) < WGM ? (nM - fm) : WGM;
    pm = fm + ((wgid % nig) % gsz); pn = (wgid % nig) / gsz; return true;
}

__device__ __forceinline__ unsigned cvt_pk_bf16(float lo, float hi) { unsigned r; asm volatile("v_cvt_pk_bf16_f32 %0, %1, %2" : "=v"(r) : "v"(lo), "v"(hi)); return r; }

template <class Epi, class Sched>
__device__ __forceinline__ void gemm_phase(PG8_LAS unsigned char* lds, const char* Abase, const int K, const Sched& S, const Epi& E) {
    int tid_ = threadIdx.x; asm volatile("" : "+v"(tid_));
    const int tid = tid_, wid = __builtin_amdgcn_readfirstlane(tid >> 6), lane = tid & 63, wr = wid >> 2, wc = wid & 3, fr = lane & 15, fq = lane >> 4;
    const int nt = K / BK;
    int R[2], C[2]; unsigned voffB[2];
#pragma unroll
    for (int i = 0; i < 2; ++i) { stage_rc(tid * 16 + i * 8192, R[i], C[i]); const int Rb = Epi::PERM ? ((R[i] & ~31) + perm32(R[i] & 31)) : R[i]; voffB[i] = (unsigned)(Rb * K + C[i]) * 2u; }
    const size_t kstep = (size_t)(BK * 2);
    const unsigned ldsw = (unsigned)wid * 1024u;
    const int aoff = lds_byte(wr * 64 + fr, fq * 8), boff = lds_byte(wc * 32 + fr, fq * 8);
#define PG8_SA(b, h) (((b) * 2 + (h)) * HTB)
#define PG8_SB(b, h) ((4 + (b) * 2 + (h)) * HTB)
#define PG8_STAGE(bufoff, gbase, v0, v1) do { \
        __builtin_amdgcn_global_load_lds((const unsigned*)((const char*)(gbase) + (v0)), (PG8_LAS unsigned*)(lds + (bufoff) + ldsw), 16, 0, 0); \
        __builtin_amdgcn_global_load_lds((const unsigned*)((const char*)(gbase) + (v1)), (PG8_LAS unsigned*)(lds + (bufoff) + ldsw + 8192), 16, 0, 0); } while (0)
#define PG8_STAGEB(bufoff, gbase) PG8_STAGE(bufoff, gbase, voffB[0], voffB[1])
#define PG8_LDA(dst, b, h) do { _Pragma("unroll") for (int m = 0; m < 4; ++m) _Pragma("unroll") for (int k = 0; k < 2; ++k) dst[m][k] = *(const PG8_LAS bf16x8*)(lds + PG8_SA(b, h) + aoff + m * 2048 + k * 1024); } while (0)
#define PG8_LDB(dst, b, h) do { _Pragma("unroll") for (int n = 0; n < 2; ++n) _Pragma("unroll") for (int k = 0; k < 2; ++k) dst[n][k] = *(const PG8_LAS bf16x8*)(lds + PG8_SB(b, h) + boff + n * 2048 + k * 1024); } while (0)
#define PG8_MMA(ai, bj, At, Bt) do { __builtin_amdgcn_s_setprio(1); _Pragma("unroll") for (int m = 0; m < 4; ++m) _Pragma("unroll") for (int n = 0; n < 2; ++n) _Pragma("unroll") for (int k = 0; k < 2; ++k) \
        acc[ai][bj][m][n] = __builtin_amdgcn_mfma_f32_16x16x32_bf16(Bt[n][k], At[m][k], acc[ai][bj][m][n], 0, 0, 0); __builtin_amdgcn_s_setprio(0); } while (0)
#define PG8_WAIT_V(n) asm volatile("s_waitcnt vmcnt(" #n ")" ::: "memory")
#define PG8_WAIT_L(n) asm volatile("s_waitcnt lgkmcnt(" #n ")" ::: "memory")
#define PG8_BAR __builtin_amdgcn_s_barrier()
#define PG8_SCHED __builtin_amdgcn_sched_barrier(0)
    Unit cur, nxt; int ui = 0;
    if (!S.next(0, cur)) return;
    f32x4 acc[2][2][4][2];
#pragma unroll
    for (int a = 0; a < 2; ++a)
#pragma unroll
        for (int b = 0; b < 2; ++b)
#pragma unroll
            for (int m = 0; m < 4; ++m)
#pragma unroll
                for (int n = 0; n < 2; ++n) acc[a][b][m][n] = (f32x4){0.f, 0.f, 0.f, 0.f};
    bf16x8 At[4][2], B0[2][2], B1[2][2];
    unsigned vA00, vA01, vA10, vA11, vN00, vN01, vN10, vN11;
    S.a_ready(cur, S.peek(cur));
    S.a_offs(cur, R, C, vA00, vA01, vA10, vA11);
    const char* cB0 = cur.b0; const char* cB1 = cur.b1;
    PG8_STAGEB(PG8_SB(0, 0), cB0); PG8_STAGEB(PG8_SB(0, 1), cB1); PG8_STAGE(PG8_SA(0, 0), Abase, vA00, vA01); PG8_STAGE(PG8_SA(0, 1), Abase, vA10, vA11);
    if (wr == 1) PG8_BAR;
    PG8_WAIT_V(2); PG8_BAR;
    PG8_STAGEB(PG8_SB(1, 0), cB0 + kstep); PG8_STAGE(PG8_SA(1, 0), Abase + kstep, vA00, vA01); PG8_STAGEB(PG8_SB(1, 1), cB1 + kstep);
    PG8_WAIT_V(6); PG8_BAR;
    for (;;) {
        const bool has_next = S.next(ui + 1, nxt);
        if (has_next) S.a_offs(nxt, R, C, vN00, vN01, vN10, vN11); else { vN00 = vA00; vN01 = vA01; vN10 = vA10; vN11 = vA11; }
        const char* nB0 = has_next ? nxt.b0 : cB0; const char* nB1 = has_next ? nxt.b1 : cB1;
        const unsigned pk = has_next ? S.peek(nxt) : 0u;
        const bool skip1 = S.half_only(cur);
        for (int t = 0; t < nt; t += 2) {
            const bool last = (t == nt - 2);
            if (last && has_next) S.a_ready(nxt, pk);
            const char* a1 = Abase + (size_t)(t + 1) * kstep;
            PG8_LDB(B0, 0, 0); PG8_LDB(B1, 0, 1); PG8_SCHED; PG8_LDA(At, 0, 0); PG8_STAGE(PG8_SA(1, 1), a1, vA10, vA11);
            PG8_WAIT_V(8); PG8_WAIT_L(0); PG8_BAR; PG8_MMA(0, 0, At, B0); PG8_MMA(0, 1, At, B1); PG8_BAR; PG8_SCHED;
            if (last) { vA00 = vN00; vA01 = vN01; vA10 = vN10; vA11 = vN11; }
            const char* a2 = last ? Abase : Abase + (size_t)(t + 2) * kstep;
            const char* b20 = last ? nB0 : cB0 + (size_t)(t + 2) * kstep; const char* b21 = last ? nB1 : cB1 + (size_t)(t + 2) * kstep;
            const char* a3 = a2 + kstep; const char* b30 = b20 + kstep; const char* b31 = b21 + kstep;
            PG8_LDA(At, 0, 1); PG8_STAGEB(PG8_SB(0, 0), b20); PG8_STAGEB(PG8_SB(0, 1), b21); PG8_STAGE(PG8_SA(0, 0), a2, vA00, vA01);
            PG8_WAIT_V(8); PG8_WAIT_L(0); PG8_BAR; if (!skip1) { PG8_MMA(1, 0, At, B0); PG8_MMA(1, 1, At, B1); } PG8_BAR; PG8_SCHED;
            PG8_LDB(B0, 1, 0); PG8_LDB(B1, 1, 1); PG8_SCHED; PG8_LDA(At, 1, 0); PG8_STAGE(PG8_SA(0, 1), a2, vA10, vA11);
            PG8_WAIT_V(8); PG8_WAIT_L(0); PG8_BAR; PG8_MMA(0, 0, At, B0); PG8_MMA(0, 1, At, B1); PG8_BAR; PG8_SCHED;
            PG8_LDA(At, 1, 1); PG8_STAGEB(PG8_SB(1, 0), b30); PG8_STAGEB(PG8_SB(1, 1), b31); PG8_STAGE(PG8_SA(1, 0), a3, vA00, vA01);
            PG8_WAIT_V(8); PG8_WAIT_L(0); PG8_BAR; if (!skip1) { PG8_MMA(1, 0, At, B0); PG8_MMA(1, 1, At, B1); } PG8_BAR; PG8_SCHED;
        }
        if (wr == 0) PG8_BAR;
        E(acc, cur, wr, wc, fr, fq);
        S.done(cur);
        if (!has_next) break;
#pragma unroll
        for (int a = 0; a < 2; ++a)
#pragma unroll
            for (int b = 0; b < 2; ++b)
#pragma unroll
                for (int m = 0; m < 4; ++m)
#pragma unroll
                    for (int n = 0; n < 2; ++n) acc[a][b][m][n] = (f32x4){0.f, 0.f, 0.f, 0.f};
        cur = nxt; cB0 = nB0; cB1 = nB1; ++ui;
        if (wr == 1) PG8_BAR;
    }
    PG8_WAIT_V(0);
    PG8_BAR;
#undef PG8_SA
#undef PG8_SB
#undef PG8_STAGE
#undef PG8_STAGEB
#undef PG8_LDA
#undef PG8_LDB
#undef PG8_MMA
#undef PG8_WAIT_V
#undef PG8_WAIT_L
#undef PG8_BAR
#undef PG8_SCHED
}
}
#include <hip/hip_bf16.h>
#include <cmath>
namespace attn_body {
using bf16=__hip_bfloat16;
using bf16x8=__attribute__((ext_vector_type(8)))short;
using s16x4=__attribute__((ext_vector_type(4)))short;
using f32x16=__attribute__((ext_vector_type(16)))float;
using u32x4=__attribute__((ext_vector_type(4)))unsigned;
constexpr int D=64,DM=1024;
constexpr int NW=8,QBLK=32,QB=QBLK*NW,KVBLK=64;
constexpr int ATTN_PITCH=DM, ATTN_UNIT_ROWS=QB;
__device__ __forceinline__ int crow(int r,int hi){return (r&3)+8*(r>>2)+4*hi;}
#define SBAR() __builtin_amdgcn_sched_barrier(0)
__device__ __forceinline__ void cmask(f32x16&p0,f32x16&p1,int jb,int qrel,int hi){
  const float NEG=-INFINITY; int kb=64*jb+4*hi;
  #pragma unroll
  for(int r=0;r<16;++r){int kv=kb+(r&3)+8*(r>>2); if(kv>qrel)p0[r]=NEG; if(kv+32>qrel)p1[r]=NEG;}
}

constexpr int NSLOT=3, SLOTB=8192;
constexpr int LDS_K=0, LDS_V=NSLOT*SLOTB, LDS_WS=2*NSLOT*SLOTB, LDS_OST=LDS_WS+NW*64*4, LDS_BYTES=LDS_OST+NW*4096;
constexpr float C2=0.125f*1.4426950408889634f;
__device__ __forceinline__ void glds16(const void*gsrc,unsigned lds_dst){unsigned keep;
  asm volatile("s_mov_b32 %0, m0\n\ts_mov_b32 m0, %2\n\ts_nop 0\n\tglobal_load_lds_dwordx4 %1, off\n\ts_mov_b32 m0, %0":"=&s"(keep):"v"(gsrc),"s"(lds_dst):"memory");}
__device__ __forceinline__ void glds16s(const void*sbase,unsigned voff,unsigned lds_dst){unsigned keep;
  asm volatile("s_mov_b32 %0, m0\n\ts_mov_b32 m0, %3\n\ts_nop 4\n\tglobal_load_lds_dwordx4 %1, %2\n\ts_mov_b32 m0, %0":"=&s"(keep):"v"(voff),"s"(sbase),"s"(lds_dst):"memory");}
__device__ __forceinline__ float max3f(float a,float b,float c){float r;asm("v_max3_f32 %0, %1, %2, %3":"=v"(r):"v"(a),"v"(b),"v"(c));return r;}
__device__ __forceinline__ float max2f(float a,float b){float r;asm("v_max_f32_e32 %0, %1, %2":"=v"(r):"v"(a),"v"(b));return r;}
__device__ __forceinline__ float fadd_s(float a,float b){float r;asm("v_add_f32_e32 %0, %1, %2":"=v"(r):"v"(a),"v"(b));return r;}
__device__ __forceinline__ float fsub_s(float a,float b){float r;asm("v_sub_f32_e32 %0, %1, %2":"=v"(r):"v"(a),"v"(b));return r;}
typedef float f32x2_t __attribute__((ext_vector_type(2))); typedef __bf16 bf16x2_t __attribute__((ext_vector_type(2)));
__device__ __forceinline__ unsigned cvtpk_s(float lo,float hi){f32x2_t v={lo,hi};bf16x2_t b=__builtin_convertvector(v,bf16x2_t);return __builtin_bit_cast(unsigned,b);}
#define WAIT_BAR(N) asm volatile("s_waitcnt vmcnt(" #N ") lgkmcnt(0)\n\ts_barrier":::"memory")

__device__ __forceinline__ void qkt(f32x16&p0,f32x16&p1,const char*Kslot,const bf16x8*qr,const f32x16&negm,int r32,int hi){
  const char*kb=Kslot+hi*1024+r32*16;
  #pragma unroll
  for(int d0=0;d0<4;++d0){
    const bf16x8 b0=*reinterpret_cast<const bf16x8*>(kb+d0*2048);
    const bf16x8 b1=*reinterpret_cast<const bf16x8*>(kb+d0*2048+512);
    if(d0==0){p0=__builtin_amdgcn_mfma_f32_32x32x16_bf16(b0,qr[0],negm,0,0,0);p1=__builtin_amdgcn_mfma_f32_32x32x16_bf16(b1,qr[0],negm,0,0,0);}
    else{p0=__builtin_amdgcn_mfma_f32_32x32x16_bf16(b0,qr[d0],p0,0,0,0);p1=__builtin_amdgcn_mfma_f32_32x32x16_bf16(b1,qr[d0],p1,0,0,0);}}
}
typedef __attribute__((address_space(3))) const char* lds_cptr;
typedef short v4i16_t __attribute__((ext_vector_type(4)));
__device__ __forceinline__ void kload8(bf16x8*kf,lds_cptr kp){
  kf[0]=*(const __attribute__((address_space(3))) bf16x8*)(kp);      kf[1]=*(const __attribute__((address_space(3))) bf16x8*)(kp+512);
  kf[2]=*(const __attribute__((address_space(3))) bf16x8*)(kp+2048); kf[3]=*(const __attribute__((address_space(3))) bf16x8*)(kp+2560);
  kf[4]=*(const __attribute__((address_space(3))) bf16x8*)(kp+4096); kf[5]=*(const __attribute__((address_space(3))) bf16x8*)(kp+4608);
  kf[6]=*(const __attribute__((address_space(3))) bf16x8*)(kp+6144); kf[7]=*(const __attribute__((address_space(3))) bf16x8*)(kp+6656);
}
__device__ __forceinline__ void kload2(bf16x8*kf,lds_cptr kp,int j){ kf[2*j]=*(const __attribute__((address_space(3))) bf16x8*)(kp+j*2048); kf[2*j+1]=*(const __attribute__((address_space(3))) bf16x8*)(kp+j*2048+512); }
__device__ __forceinline__ s16x4 vtr(lds_cptr p){ return __builtin_bit_cast(s16x4,__builtin_amdgcn_ds_read_tr16_b64_v4i16((__attribute__((address_space(3))) v4i16_t*)p)); }
__device__ __forceinline__ float rowmax(const f32x16&p0,const f32x16&p1){
  float a=max3f(p0[0],p0[1],p1[0]),b=max3f(p0[2],p0[3],p1[1]);a=max3f(a,p1[2],p1[3]);
  #pragma unroll
  for(int r=4;r<16;r+=4){a=max3f(a,p0[r],p0[r+1]);b=max3f(b,p0[r+2],p0[r+3]);a=max3f(a,p1[r],p1[r+1]);b=max3f(b,p1[r+2],p1[r+3]);}
  const float m=max2f(a,b);
  auto rr=__builtin_amdgcn_permlane32_swap(__float_as_uint(m),__float_as_uint(m),false,false);
  return max2f(__uint_as_float(rr[0]),__uint_as_float(rr[1]));
}
__device__ __forceinline__ void pv(f32x16*o,int vb,bf16x8 pa0,bf16x8 pa1,bf16x8 pa2,bf16x8 pa3){
  #pragma unroll
  for(int d0=0;d0<2;++d0){s16x4 lo[4],hi[4];
    #pragma unroll
    for(int ks=0;ks<4;++ks){
      asm volatile("ds_read_b64_tr_b16 %0,%1 offset:%c2":"=&v"(lo[ks]):"v"(vb),"i"(d0*4096+ks*1024):"memory");
      asm volatile("ds_read_b64_tr_b16 %0,%1 offset:%c2":"=&v"(hi[ks]):"v"(vb),"i"(d0*4096+ks*1024+512):"memory");}
    asm volatile("s_waitcnt lgkmcnt(0)":::"memory");SBAR();
    #define PK(k) (bf16x8){lo[k][0],lo[k][1],lo[k][2],lo[k][3],hi[k][0],hi[k][1],hi[k][2],hi[k][3]}
    o[d0]=__builtin_amdgcn_mfma_f32_32x32x16_bf16(pa0,PK(0),o[d0],0,0,0);
    o[d0]=__builtin_amdgcn_mfma_f32_32x32x16_bf16(pa1,PK(1),o[d0],0,0,0);
    o[d0]=__builtin_amdgcn_mfma_f32_32x32x16_bf16(pa2,PK(2),o[d0],0,0,0);
    o[d0]=__builtin_amdgcn_mfma_f32_32x32x16_bf16(pa3,PK(3),o[d0],0,0,0);
    #undef PK
  }
}

#ifndef ATTN_STORE16
#define ATTN_STORE16(p,v) (*(u32x4*)(p)=(v))
#endif
template<int THRL> __device__ __forceinline__ void attn_unit(long rowbase,int qb,const bf16*Qc,const bf16*__restrict__ Kc,const bf16*__restrict__ Vc,bf16*Oc,char*shm){
  int tid_=threadIdx.x; asm volatile("":"+v"(tid_)); const int tid=tid_,lane=tid&63,r32=lane&31,hi=lane>>5; const int wid=__builtin_amdgcn_readfirstlane(tid>>6);
  const int q0=qb*QB;
  const bf16*Qw=Qc+(rowbase+q0+wid*QBLK)*DM;
  const bf16*Kh=Kc+rowbase*DM,*Vh=Vc+rowbase*DM;
  const unsigned lds0=(unsigned)(uintptr_t)shm;
  float*wsf=(float*)(shm+LDS_WS)+wid*64;
  const unsigned koff=(unsigned)(lane*DM+wid*8)*2u;
  const unsigned voffv=(unsigned)((16*(wid&3)+(lane>>2))*DM+(wid>>2)*32+(lane&3)*8)*2u;
  const unsigned kdst=lds0+LDS_K+wid*1024, vdst=lds0+LDS_V+wid*1024;
  #define DMA_K(t,slot) glds16s(Kh+(long)(t)*KVBLK*DM,koff,(unsigned)__builtin_amdgcn_readfirstlane(kdst+(slot)))
  #define DMA_V(t,slot) glds16s(Vh+(long)(t)*KVBLK*DM,voffv,(unsigned)__builtin_amdgcn_readfirstlane(vdst+(slot)))
  const int vb0=(int)(lds0+LDS_V)+((lane>>4)&1)*32+(lane&3)*8+(4*hi+((lane&15)>>2))*64;
  const char*Kbase=shm+LDS_K; bf16x8 kf[8];
  const lds_cptr shm3=(lds_cptr)shm; const lds_cptr kp0=shm3+LDS_K+hi*1024+r32*16; const lds_cptr vp0=shm3+LDS_V+((lane>>4)&1)*32+(lane&3)*8+(4*hi+((lane&15)>>2))*64;
  const int NT=(q0+QB)/KVBLK;
  DMA_K(0,0);DMA_V(0,0);DMA_K(1,SLOTB);
  bf16x8 qr[4];
  #pragma unroll
  for(int d0=0;d0<4;++d0)qr[d0]=*reinterpret_cast<const bf16x8*>(&Qw[(long)r32*DM+d0*16+hi*8]);
  float mhat=0.f,l_reg=0.f;f32x16 o[2];o[0]=f32x16{};o[1]=f32x16{};f32x16 negm=f32x16{};asm volatile("":"+v"(negm));
  const int qrel=wid*QBLK+r32;
  #define CMASK(P0,P1,t) do{int jb_=(t)-(NT-4); if(jb_>=0)cmask(P0,P1,jb_,qrel,hi);}while(0)
  bool resc=false;
  #define START(P0,P1) do{ const float rm=rowmax(P0,P1); resc=false; \
    { const float dl=rm; mhat=fadd_s(mhat,dl); \
      _Pragma("unroll") for(int r=0;r<16;++r){P0[r]=fsub_s(P0[r],dl);P1[r]=fsub_s(P1[r],dl);} \
      _Pragma("unroll") for(int r=0;r<16;++r)negm[r]=-mhat; asm volatile("":"+v"(negm)); } \
    _Pragma("unroll") for(int r=0;r<16;++r)P0[r]=__builtin_amdgcn_exp2f(P0[r]); }while(0)
  #define RESC() do{ if(resc){ asm volatile("s_waitcnt lgkmcnt(0)":::"memory"); \
      _Pragma("unroll") for(int d_=0;d_<2;++d_) _Pragma("unroll") for(int r=0;r<16;++r)o[d_][r]*=wsf[crow(r,hi)]; } }while(0)
  f32x16 pA0,pA1,pB0,pB1;
  int sl_prev=0,sl_cur=0,sl_next=SLOTB;
  #define ROT() do{sl_prev=sl_cur;sl_cur=sl_next;sl_next=(sl_next==(NSLOT-1)*SLOTB)?0:sl_next+SLOTB;}while(0)
  DMA_K(2,2*SLOTB);
  WAIT_BAR(3);
  qkt(pA0,pA1,Kbase,qr,negm,r32,hi);asm volatile("s_nop 15\n\ts_nop 7":"+v"(pA0),"+v"(pA1));CMASK(pA0,pA1,0);
  START(pA0,pA1);
  _Pragma("unroll") for(int r=0;r<16;++r)pA1[r]=__builtin_amdgcn_exp2f(pA1[r]);
  WAIT_BAR(0);
  DMA_K(3,0);DMA_V(1,SLOTB);
  ROT();
  kload8(kf,kp0+sl_cur);
  WAIT_BAR(2);
  s16x4 vlo[8],vhi[8]; u32x4 pw0,pw1,pw2,pw3;
  #define PKW(P,B) cvtpk_s(P[B],P[B+1])
  #define PAF(k) __builtin_bit_cast(bf16x8,pw##k)
  #define VFR(i) (bf16x8){vlo[i][0],vlo[i][1],vlo[i][2],vlo[i][3],vhi[i][0],vhi[i][1],vhi[i][2],vhi[i][3]}
  #define PIN(x) asm volatile("":"+v"(x))
  #define MX3(a,b,c) __builtin_fmaxf(__builtin_fmaxf((a),(b)),(c))
  #define GAPA(MF,A0,A1,A2,A3,W0,W1,PW) do{ MF; sacc+=A0; sacc+=A1; sacc+=A2; sacc+=A3; PIN(sacc); W0; W1; PIN(PW); SBAR(); }while(0)
  #define EX(v) __builtin_amdgcn_exp2f(v)
  #define GAPB(MF,X,B) do{ MF; X[B]=EX(X[B]); X[B+1]=EX(X[B+1]); X[B+2]=EX(X[B+2]); X[B+3]=EX(X[B+3]); PIN(X); SBAR(); }while(0)
  #define VRD(i) do{ vlo[i]=vtr(vp_+(((i)>>2)*4096+((i)&3)*1024)); vhi[i]=vtr(vp_+(((i)>>2)*4096+((i)&3)*1024+512)); }while(0)
  #define KRD(G,j) do{ if(G){ kload2(kf,kp0+sl_next,j); SBAR(); } }while(0)
  #define STEP(C0,C1,P0,P1,t,GK,GV,GL) do{ SBAR(); \
    const lds_cptr vp_=vp0+sl_prev; \
    VRD(0); SBAR(); float sacc=(P0[0]+P0[1]); \
    GAPA(C0=__builtin_amdgcn_mfma_f32_32x32x16_bf16(kf[0],qr[0],negm,0,0,0), P0[2],P0[3],P0[4],P0[5],     pw0[0]=PKW(P0,0), pw0[1]=PKW(P0,2), pw0); \
    VRD(4); SBAR(); GAPA(C1=__builtin_amdgcn_mfma_f32_32x32x16_bf16(kf[1],qr[0],negm,0,0,0), P0[6],P0[7],P0[8],P0[9],     pw0[2]=PKW(P0,4), pw0[3]=PKW(P0,6), pw0); \
    VRD(1); SBAR(); GAPA(C0=__builtin_amdgcn_mfma_f32_32x32x16_bf16(kf[2],qr[1],C0,0,0,0),   P0[10],P0[11],P0[12],P0[13], pw1[0]=PKW(P0,8), pw1[1]=PKW(P0,10), pw1); \
    VRD(5); SBAR(); GAPA(C1=__builtin_amdgcn_mfma_f32_32x32x16_bf16(kf[3],qr[1],C1,0,0,0),   P0[14],P0[15],P1[0],P1[1],   pw1[2]=PKW(P0,12),pw1[3]=PKW(P0,14), pw1); \
    VRD(2); SBAR(); GAPA(C0=__builtin_amdgcn_mfma_f32_32x32x16_bf16(kf[4],qr[2],C0,0,0,0),   P1[2],P1[3],P1[4],P1[5],     pw2[0]=PKW(P1,0), pw2[1]=PKW(P1,2), pw2); \
    VRD(6); SBAR(); GAPA(C1=__builtin_amdgcn_mfma_f32_32x32x16_bf16(kf[5],qr[2],C1,0,0,0),   P1[6],P1[7],P1[8],P1[9],     pw2[2]=PKW(P1,4), pw2[3]=PKW(P1,6), pw2); \
    VRD(3); SBAR(); GAPA(C0=__builtin_amdgcn_mfma_f32_32x32x16_bf16(kf[6],qr[3],C0,0,0,0),   P1[10],P1[11],P1[12],P1[13], pw3[0]=PKW(P1,8), pw3[1]=PKW(P1,10), pw3); \
    VRD(7); SBAR(); GAPA(C1=__builtin_amdgcn_mfma_f32_32x32x16_bf16(kf[7],qr[3],C1,0,0,0),   P1[14],P1[15],0.f,0.f,       pw3[2]=PKW(P1,12),pw3[3]=PKW(P1,14), pw3); \
    l_reg+=sacc; \
    if(GK){DMA_K((t)+3,sl_cur);} if(GV){DMA_V((t)+1,sl_next);} \
    CMASK(C0,C1,t); \
    { float a=MX3(C0[0],C0[1],C1[0]),b=MX3(C0[2],C0[3],C1[1]); a=MX3(a,C1[2],C1[3]); \
      _Pragma("unroll") for(int r=4;r<16;r+=4){a=MX3(a,C0[r],C0[r+1]);b=MX3(b,C0[r+2],C0[r+3]);a=MX3(a,C1[r],C1[r+1]);b=MX3(b,C1[r+2],C1[r+3]);} \
      float rm=__builtin_fmaxf(a,b); { auto rr=__builtin_amdgcn_permlane32_swap(__float_as_uint(rm),__float_as_uint(rm),false,false); rm=__builtin_fmaxf(__uint_as_float(rr[0]),__uint_as_float(rr[1])); } \
      resc=false; \
      if(__builtin_expect(__any(rm>(float)THRL),0)){ const float dl=__builtin_fmaxf(rm,0.f); mhat+=dl; \
        _Pragma("unroll") for(int r=0;r<16;++r){C0[r]-=dl;C1[r]-=dl;} \
        _Pragma("unroll") for(int r=0;r<16;++r)negm[r]=-mhat; asm volatile("":"+v"(negm)); \
        const float f=__builtin_amdgcn_exp2f(-dl); l_reg*=f; if(hi==0)wsf[r32]=f; resc=true; } } \
    SBAR(); \
    GAPB(o[0]=__builtin_amdgcn_mfma_f32_32x32x16_bf16(PAF(0),VFR(0),o[0],0,0,0), C0,0); \
    GAPB(o[1]=__builtin_amdgcn_mfma_f32_32x32x16_bf16(PAF(0),VFR(4),o[1],0,0,0), C0,4); \
    KRD(GL,0); GAPB(o[0]=__builtin_amdgcn_mfma_f32_32x32x16_bf16(PAF(1),VFR(1),o[0],0,0,0), C0,8); \
    KRD(GL,1); GAPB(o[1]=__builtin_amdgcn_mfma_f32_32x32x16_bf16(PAF(1),VFR(5),o[1],0,0,0), C0,12); \
    KRD(GL,2); GAPB(o[0]=__builtin_amdgcn_mfma_f32_32x32x16_bf16(PAF(2),VFR(2),o[0],0,0,0), C1,0); \
    KRD(GL,3); GAPB(o[1]=__builtin_amdgcn_mfma_f32_32x32x16_bf16(PAF(2),VFR(6),o[1],0,0,0), C1,4); \
    GAPB(o[0]=__builtin_amdgcn_mfma_f32_32x32x16_bf16(PAF(3),VFR(3),o[0],0,0,0), C1,8); \
    GAPB(o[1]=__builtin_amdgcn_mfma_f32_32x32x16_bf16(PAF(3),VFR(7),o[1],0,0,0), C1,12); \
    }while(0)
  int t=1;
  #undef CMASK
  #define CMASK(P0,P1,t) do{}while(0)
  for(;t+5<NT;t+=2){
    STEP(pB0,pB1,pA0,pA1,t,true,true,true);     WAIT_BAR(2); RESC(); ROT();
    STEP(pA0,pA1,pB0,pB1,t+1,true,true,true);   WAIT_BAR(2); RESC(); ROT();
  }
  #undef CMASK
  #define CMASK(P0,P1,t) do{int jb_=(t)-(NT-4); if(jb_>=0)cmask(P0,P1,jb_,qrel,hi);}while(0)
  #define ENDW(tt) do{ if((tt)+3<NT){WAIT_BAR(2);} else if((tt)+2<NT){WAIT_BAR(1);} else {WAIT_BAR(0);} }while(0)
  for(;t+1<NT;t+=2){
    STEP(pB0,pB1,pA0,pA1,t,(t+3<NT),(t+1<NT),(t+1<NT));       ENDW(t);   RESC(); ROT();
    STEP(pA0,pA1,pB0,pB1,t+1,(t+4<NT),(t+2<NT),(t+2<NT));     ENDW(t+1); RESC(); ROT();
  }
  STEP(pB0,pB1,pA0,pA1,NT-1,false,false,false); RESC();
  { float sacc=pB0[0]+pB0[1]; _Pragma("unroll") for(int r=2;r<16;++r)sacc+=pB0[r]; _Pragma("unroll") for(int r=0;r<16;++r)sacc+=pB1[r]; l_reg+=sacc;
    pw0=(u32x4){PKW(pB0,0),PKW(pB0,2),PKW(pB0,4),PKW(pB0,6)};pw1=(u32x4){PKW(pB0,8),PKW(pB0,10),PKW(pB0,12),PKW(pB0,14)};pw2=(u32x4){PKW(pB1,0),PKW(pB1,2),PKW(pB1,4),PKW(pB1,6)};pw3=(u32x4){PKW(pB1,8),PKW(pB1,10),PKW(pB1,12),PKW(pB1,14)};
    SBAR(); pv(o,vb0+sl_cur,PAF(0),PAF(1),PAF(2),PAF(3)); }
  #undef PKW
  #undef PAF
  #undef VFR
  #undef PIN
  #undef MX3
  #undef GAPA
  #undef GAPB
  #undef EX
  #undef VRD
  #undef KRD
  #undef STEP
  #undef ENDW
  {auto rr=__builtin_amdgcn_permlane32_swap(__float_as_uint(l_reg),__float_as_uint(l_reg),false,false);l_reg=__uint_as_float(rr[0])+__uint_as_float(rr[1]);}
  if(hi==0)wsf[32+r32]=l_reg;asm volatile("s_waitcnt lgkmcnt(0)":::"memory");
  float rli[16];
  #pragma unroll
  for(int r=0;r<16;++r)rli[r]=__builtin_amdgcn_rcpf(wsf[32+crow(r,hi)]);
  bf16*Ow=Oc+(rowbase+q0+wid*QBLK)*DM;
  { bf16*stg=(bf16*)(shm+LDS_OST)+wid*2048;
    #pragma unroll
    for(int r=0;r<16;++r){const int orow=crow(r,hi);
      #pragma unroll
      for(int d0=0;d0<2;++d0)stg[orow*64+d0*32+r32]=__float2bfloat16(o[d0][r]*rli[r]);}
    asm volatile("s_waitcnt lgkmcnt(0)":::"memory");
    #pragma unroll
    for(int i=0;i<4;++i){const int row=i*8+(lane>>3),ch=lane&7; const u32x4 v=*(const u32x4*)(stg+row*64+ch*8); ATTN_STORE16(Ow+(long)row*DM+ch*8,v);} }
  asm volatile("s_waitcnt lgkmcnt(0)\n\ts_barrier":::"memory");
  #undef DMA_K
  #undef DMA_V
  #undef CMASK
  #undef START
  #undef RESC
  #undef ROT
}
constexpr int ATTN_LDS_BYTES=LDS_BYTES;
#undef SBAR
#undef WAIT_BAR
}
namespace attn128 {
using bf16=__hip_bfloat16;
using bf16x8=__attribute__((ext_vector_type(8)))short;
using s16x4=__attribute__((ext_vector_type(4)))short;
using f32x16=__attribute__((ext_vector_type(16)))float;
using u32x4=__attribute__((ext_vector_type(4)))unsigned;
constexpr int D=64,DM=1024;
constexpr int NW=8,QBLK=32,QB=QBLK*NW,KVBLK=64;
constexpr int ATTN_PITCH=DM, ATTN_UNIT_ROWS=QB;
__device__ __forceinline__ int crow(int r,int hi){return (r&3)+8*(r>>2)+4*hi;}
#define SBAR() __builtin_amdgcn_sched_barrier(0)
__device__ __forceinline__ void cmask(f32x16&p0,f32x16&p1,int jb,int qrel,int hi){
  const float NEG=-INFINITY; int kb=64*jb+4*hi;
  #pragma unroll
  for(int r=0;r<16;++r){int kv=kb+(r&3)+8*(r>>2); if(kv>qrel)p0[r]=NEG; if(kv+32>qrel)p1[r]=NEG;}
}

constexpr int NSLOT=3, SLOTB=8192;
constexpr int LDS_K=0, LDS_V=NSLOT*SLOTB, LDS_WS=LDS_V+NSLOT*2*SLOTB, LDS_OST=LDS_WS+NW*64*4, LDS_BYTES=LDS_OST+NW*8192;
constexpr float C2=0.125f*1.4426950408889634f;
__device__ __forceinline__ void glds16(const void*gsrc,unsigned lds_dst){unsigned keep;
  asm volatile("s_mov_b32 %0, m0\n\ts_mov_b32 m0, %2\n\ts_nop 0\n\tglobal_load_lds_dwordx4 %1, off\n\ts_mov_b32 m0, %0":"=&s"(keep):"v"(gsrc),"s"(lds_dst):"memory");}
__device__ __forceinline__ void glds16s(const void*sbase,unsigned voff,unsigned lds_dst){unsigned keep;
  asm volatile("s_mov_b32 %0, m0\n\ts_mov_b32 m0, %3\n\ts_nop 4\n\tglobal_load_lds_dwordx4 %1, %2\n\ts_mov_b32 m0, %0":"=&s"(keep):"v"(voff),"s"(sbase),"s"(lds_dst):"memory");}
__device__ __forceinline__ float max3f(float a,float b,float c){float r;asm("v_max3_f32 %0, %1, %2, %3":"=v"(r):"v"(a),"v"(b),"v"(c));return r;}
__device__ __forceinline__ float max2f(float a,float b){float r;asm("v_max_f32_e32 %0, %1, %2":"=v"(r):"v"(a),"v"(b));return r;}
__device__ __forceinline__ float fadd_s(float a,float b){float r;asm("v_add_f32_e32 %0, %1, %2":"=v"(r):"v"(a),"v"(b));return r;}
__device__ __forceinline__ float fsub_s(float a,float b){float r;asm("v_sub_f32_e32 %0, %1, %2":"=v"(r):"v"(a),"v"(b));return r;}
typedef float f32x2_t __attribute__((ext_vector_type(2))); typedef __bf16 bf16x2_t __attribute__((ext_vector_type(2)));
__device__ __forceinline__ unsigned cvtpk_s(float lo,float hi){f32x2_t v={lo,hi};bf16x2_t b=__builtin_convertvector(v,bf16x2_t);return __builtin_bit_cast(unsigned,b);}
#define WAIT_BAR(N) asm volatile("s_waitcnt vmcnt(" #N ") lgkmcnt(0)\n\ts_barrier":::"memory")

__device__ __forceinline__ void qkt(f32x16&p0,f32x16&p1,const char*Kslot,const bf16x8*qr,const f32x16&negm,int r32,int hi){
  const char*kb=Kslot+hi*1024+r32*16;
  #pragma unroll
  for(int d0=0;d0<4;++d0){
    const bf16x8 b0=*reinterpret_cast<const bf16x8*>(kb+d0*2048);
    const bf16x8 b1=*reinterpret_cast<const bf16x8*>(kb+d0*2048+512);
    if(d0==0){p0=__builtin_amdgcn_mfma_f32_32x32x16_bf16(b0,qr[0],negm,0,0,0);p1=__builtin_amdgcn_mfma_f32_32x32x16_bf16(b1,qr[0],negm,0,0,0);}
    else{p0=__builtin_amdgcn_mfma_f32_32x32x16_bf16(b0,qr[d0],p0,0,0,0);p1=__builtin_amdgcn_mfma_f32_32x32x16_bf16(b1,qr[d0],p1,0,0,0);}}
}
typedef __attribute__((address_space(3))) const char* lds_cptr;
typedef short v4i16_t __attribute__((ext_vector_type(4)));
__device__ __forceinline__ void kload8(bf16x8*kf,lds_cptr kp){
  kf[0]=*(const __attribute__((address_space(3))) bf16x8*)(kp);      kf[1]=*(const __attribute__((address_space(3))) bf16x8*)(kp+512);
  kf[2]=*(const __attribute__((address_space(3))) bf16x8*)(kp+2048); kf[3]=*(const __attribute__((address_space(3))) bf16x8*)(kp+2560);
  kf[4]=*(const __attribute__((address_space(3))) bf16x8*)(kp+4096); kf[5]=*(const __attribute__((address_space(3))) bf16x8*)(kp+4608);
  kf[6]=*(const __attribute__((address_space(3))) bf16x8*)(kp+6144); kf[7]=*(const __attribute__((address_space(3))) bf16x8*)(kp+6656);
}
__device__ __forceinline__ void kload2(bf16x8*kf,lds_cptr kp,int j){ kf[2*j]=*(const __attribute__((address_space(3))) bf16x8*)(kp+j*2048); kf[2*j+1]=*(const __attribute__((address_space(3))) bf16x8*)(kp+j*2048+512); }
__device__ __forceinline__ s16x4 vtr(lds_cptr p){ return __builtin_bit_cast(s16x4,__builtin_amdgcn_ds_read_tr16_b64_v4i16((__attribute__((address_space(3))) v4i16_t*)p)); }
__device__ __forceinline__ float rowmax(const f32x16&p0,const f32x16&p1){
  float a=max3f(p0[0],p0[1],p1[0]),b=max3f(p0[2],p0[3],p1[1]);a=max3f(a,p1[2],p1[3]);
  #pragma unroll
  for(int r=4;r<16;r+=4){a=max3f(a,p0[r],p0[r+1]);b=max3f(b,p0[r+2],p0[r+3]);a=max3f(a,p1[r],p1[r+1]);b=max3f(b,p1[r+2],p1[r+3]);}
  const float m=max2f(a,b);
  auto rr=__builtin_amdgcn_permlane32_swap(__float_as_uint(m),__float_as_uint(m),false,false);
  return max2f(__uint_as_float(rr[0]),__uint_as_float(rr[1]));
}
__device__ __forceinline__ void pv(f32x16*o,int vb,bf16x8 pa0,bf16x8 pa1,bf16x8 pa2,bf16x8 pa3){
  #pragma unroll
  for(int d0=0;d0<2;++d0){s16x4 lo[4],hi[4];
    #pragma unroll
    for(int ks=0;ks<4;++ks){
      asm volatile("ds_read_b64_tr_b16 %0,%1 offset:%c2":"=&v"(lo[ks]):"v"(vb),"i"(d0*4096+ks*1024):"memory");
      asm volatile("ds_read_b64_tr_b16 %0,%1 offset:%c2":"=&v"(hi[ks]):"v"(vb),"i"(d0*4096+ks*1024+512):"memory");}
    asm volatile("s_waitcnt lgkmcnt(0)":::"memory");SBAR();
    #define PK(k) (bf16x8){lo[k][0],lo[k][1],lo[k][2],lo[k][3],hi[k][0],hi[k][1],hi[k][2],hi[k][3]}
    o[d0]=__builtin_amdgcn_mfma_f32_32x32x16_bf16(pa0,PK(0),o[d0],0,0,0);
    o[d0]=__builtin_amdgcn_mfma_f32_32x32x16_bf16(pa1,PK(1),o[d0],0,0,0);
    o[d0]=__builtin_amdgcn_mfma_f32_32x32x16_bf16(pa2,PK(2),o[d0],0,0,0);
    o[d0]=__builtin_amdgcn_mfma_f32_32x32x16_bf16(pa3,PK(3),o[d0],0,0,0);
    #undef PK
  }
}

#ifndef ATTN_STORE16
#define ATTN_STORE16(p,v) (*(u32x4*)(p)=(v))
#endif
template<int THRL> __device__ __forceinline__ void attn_unit(long rowbase,int qb,const bf16*Qc,const bf16*__restrict__ Kc,const bf16*__restrict__ Vc,bf16*Oc,char*shm){
  int tid_=threadIdx.x; asm volatile("":"+v"(tid_)); const int tid=tid_,lane=tid&63,r32=lane&31,hi=lane>>5; const int wid=__builtin_amdgcn_readfirstlane(tid>>6);
  const int q0=qb*QB;
  const bf16*Qw=Qc+(rowbase+q0+wid*QBLK)*DM;
  const bf16*Kh=Kc+rowbase*DM,*Vh=Vc+rowbase*DM;
  const unsigned lds0=(unsigned)(uintptr_t)shm;
  float*wsf=(float*)(shm+LDS_WS)+wid*64;
  const unsigned koff=(unsigned)(lane*DM+wid*8)*2u;
  const unsigned voffv=(unsigned)((16*(wid&3)+(lane>>2))*DM+(wid>>2)*32+(lane&3)*8)*2u;
  const unsigned kdst=lds0+LDS_K+wid*1024, vdst=lds0+LDS_V+wid*1024;
  #define DMA_K(t,slot) glds16s(Kh+(long)(t)*KVBLK*DM,koff,(unsigned)__builtin_amdgcn_readfirstlane(kdst+(slot)))
  #define DMA_V(t,slot) do{ glds16s(Vh+(long)(t)*KVBLK*DM,voffv,(unsigned)__builtin_amdgcn_readfirstlane(vdst+2*(slot))); glds16s(Vh+(long)(t)*KVBLK*DM+64,voffv,(unsigned)__builtin_amdgcn_readfirstlane(vdst+2*(slot)+8192)); }while(0)
  const int vb0=(int)(lds0+LDS_V)+((lane>>4)&1)*32+(lane&3)*8+(4*hi+((lane&15)>>2))*64;
  const char*Kbase=shm+LDS_K; bf16x8 kf[8];
  const lds_cptr shm3=(lds_cptr)shm; const lds_cptr kp0=shm3+LDS_K+hi*1024+r32*16; const lds_cptr vp0=shm3+LDS_V+((lane>>4)&1)*32+(lane&3)*8+(4*hi+((lane&15)>>2))*64;
  const int NT=(q0+QB)/KVBLK;
  DMA_K(0,0);DMA_V(0,0);DMA_K(1,SLOTB);
  bf16x8 qr[4];
  #pragma unroll
  for(int d0=0;d0<4;++d0)qr[d0]=*reinterpret_cast<const bf16x8*>(&Qw[(long)r32*DM+d0*16+hi*8]);
  float mhat=0.f,l_reg=0.f;f32x16 o[4];o[0]=f32x16{};o[1]=f32x16{};o[2]=f32x16{};o[3]=f32x16{};const f32x16 zf=f32x16{};
  const int qrel=wid*QBLK+r32;
  #define CMASK(P0,P1,t) do{int jb_=(t)-(NT-4); if(jb_>=0)cmask(P0,P1,jb_,qrel,hi);}while(0)
  bool resc=false;
  #define START(P0,P1) do{ const float rm=rowmax(P0,P1); resc=false; \
    { const float dl=rm; mhat=fadd_s(mhat,dl); \
      _Pragma("unroll") for(int r=0;r<16;++r){P0[r]=fsub_s(P0[r],dl);P1[r]=fsub_s(P1[r],dl);} \
      } \
    _Pragma("unroll") for(int r=0;r<16;++r)P0[r]=__builtin_amdgcn_exp2f(P0[r]); }while(0)
  #define RESC() do{ if(resc){ asm volatile("s_waitcnt lgkmcnt(0)":::"memory"); \
      _Pragma("unroll") for(int d_=0;d_<4;++d_) _Pragma("unroll") for(int r=0;r<16;++r)o[d_][r]*=wsf[crow(r,hi)]; } }while(0)
  f32x16 pA0,pA1,pB0,pB1;
  int sl_prev=0,sl_cur=0,sl_next=SLOTB;
  #define ROT() do{sl_prev=sl_cur;sl_cur=sl_next;sl_next=(sl_next==(NSLOT-1)*SLOTB)?0:sl_next+SLOTB;}while(0)
  DMA_K(2,2*SLOTB);
  WAIT_BAR(4);
  qkt(pA0,pA1,Kbase,qr,zf,r32,hi);asm volatile("s_nop 15\n\ts_nop 7":"+v"(pA0),"+v"(pA1));CMASK(pA0,pA1,0);
  START(pA0,pA1);
  _Pragma("unroll") for(int r=0;r<16;++r)pA1[r]=__builtin_amdgcn_exp2f(pA1[r]);
  WAIT_BAR(0);
  DMA_K(3,0);DMA_V(1,SLOTB);
  ROT();
  kload8(kf,kp0+sl_cur);
  WAIT_BAR(3);
  s16x4 vlo[8],vhi[8]; u32x4 pw0,pw1,pw2,pw3;
  #define PKW(P,B) cvtpk_s(P[B],P[B+1])
  #define PAF(k) __builtin_bit_cast(bf16x8,pw##k)
  #define VFR(i) (bf16x8){vlo[i][0],vlo[i][1],vlo[i][2],vlo[i][3],vhi[i][0],vhi[i][1],vhi[i][2],vhi[i][3]}
  #define PIN(x) asm volatile("":"+v"(x))
  #define MX3(a,b,c) __builtin_fmaxf(__builtin_fmaxf((a),(b)),(c))
  #define GAPA(MF,A0,A1,A2,A3,W0,W1,PW) do{ MF; sacc+=A0; sacc+=A1; sacc+=A2; sacc+=A3; PIN(sacc); W0; W1; PIN(PW); SBAR(); }while(0)
  #define EX(v) __builtin_amdgcn_exp2f(v)
  #define GAPB(MF,X,B) do{ MF; X[B]=EX(X[B]); X[B+1]=EX(X[B+1]); X[B+2]=EX(X[B+2]); X[B+3]=EX(X[B+3]); PIN(X); SBAR(); }while(0)
  #define VRD(i) do{ vlo[i]=vtr(vp_+(((i)>>2)*4096+((i)&3)*1024)); vhi[i]=vtr(vp_+(((i)>>2)*4096+((i)&3)*1024+512)); }while(0)
  #define KRD(G,j) do{ if(G){ kload2(kf,kp0+sl_next,j); SBAR(); } }while(0)
  #define STEP(C0,C1,P0,P1,t,GK,GV,GL) do{ SBAR(); \
    const lds_cptr vp_=vp0+2*sl_prev; \
    VRD(0); SBAR(); float sacc=(P0[0]+P0[1]); \
    GAPA(C0=__builtin_amdgcn_mfma_f32_32x32x16_bf16(kf[0],qr[0],zf,0,0,0), P0[2],P0[3],P0[4],P0[5],     pw0[0]=PKW(P0,0), pw0[1]=PKW(P0,2), pw0); \
    VRD(4); SBAR(); GAPA(C1=__builtin_amdgcn_mfma_f32_32x32x16_bf16(kf[1],qr[0],zf,0,0,0), P0[6],P0[7],P0[8],P0[9],     pw0[2]=PKW(P0,4), pw0[3]=PKW(P0,6), pw0); \
    VRD(1); SBAR(); GAPA(C0=__builtin_amdgcn_mfma_f32_32x32x16_bf16(kf[2],qr[1],C0,0,0,0),   P0[10],P0[11],P0[12],P0[13], pw1[0]=PKW(P0,8), pw1[1]=PKW(P0,10), pw1); \
    VRD(5); SBAR(); GAPA(C1=__builtin_amdgcn_mfma_f32_32x32x16_bf16(kf[3],qr[1],C1,0,0,0),   P0[14],P0[15],P1[0],P1[1],   pw1[2]=PKW(P0,12),pw1[3]=PKW(P0,14), pw1); \
    VRD(2); SBAR(); GAPA(C0=__builtin_amdgcn_mfma_f32_32x32x16_bf16(kf[4],qr[2],C0,0,0,0),   P1[2],P1[3],P1[4],P1[5],     pw2[0]=PKW(P1,0), pw2[1]=PKW(P1,2), pw2); \
    VRD(6); SBAR(); GAPA(C1=__builtin_amdgcn_mfma_f32_32x32x16_bf16(kf[5],qr[2],C1,0,0,0),   P1[6],P1[7],P1[8],P1[9],     pw2[2]=PKW(P1,4), pw2[3]=PKW(P1,6), pw2); \
    VRD(3); SBAR(); GAPA(C0=__builtin_amdgcn_mfma_f32_32x32x16_bf16(kf[6],qr[3],C0,0,0,0),   P1[10],P1[11],P1[12],P1[13], pw3[0]=PKW(P1,8), pw3[1]=PKW(P1,10), pw3); \
    VRD(7); SBAR(); GAPA(C1=__builtin_amdgcn_mfma_f32_32x32x16_bf16(kf[7],qr[3],C1,0,0,0),   P1[14],P1[15],0.f,0.f,       pw3[2]=PKW(P1,12),pw3[3]=PKW(P1,14), pw3); \
    l_reg+=sacc; \
    if(GK){DMA_K((t)+3,sl_cur);} if(GV){DMA_V((t)+1,sl_next);} \
    _Pragma("unroll") for(int r=0;r<16;++r){C0[r]-=mhat;C1[r]-=mhat;} \
    CMASK(C0,C1,t); \
    { float a=MX3(C0[0],C0[1],C1[0]),b=MX3(C0[2],C0[3],C1[1]); a=MX3(a,C1[2],C1[3]); \
      _Pragma("unroll") for(int r=4;r<16;r+=4){a=MX3(a,C0[r],C0[r+1]);b=MX3(b,C0[r+2],C0[r+3]);a=MX3(a,C1[r],C1[r+1]);b=MX3(b,C1[r+2],C1[r+3]);} \
      float rm=__builtin_fmaxf(a,b); { auto rr=__builtin_amdgcn_permlane32_swap(__float_as_uint(rm),__float_as_uint(rm),false,false); rm=__builtin_fmaxf(__uint_as_float(rr[0]),__uint_as_float(rr[1])); } \
      resc=false; \
      if(__builtin_expect(__any(rm>(float)THRL),0)){ const float dl=__builtin_fmaxf(rm,0.f); mhat+=dl; \
        _Pragma("unroll") for(int r=0;r<16;++r){C0[r]-=dl;C1[r]-=dl;} \
        const float f=__builtin_amdgcn_exp2f(-dl); l_reg*=f; if(hi==0)wsf[r32]=f; resc=true; } } \
    SBAR(); \
    GAPB(o[0]=__builtin_amdgcn_mfma_f32_32x32x16_bf16(PAF(0),VFR(0),o[0],0,0,0), C0,0); \
    GAPB(o[1]=__builtin_amdgcn_mfma_f32_32x32x16_bf16(PAF(0),VFR(4),o[1],0,0,0), C0,4); \
    KRD(GL,0); GAPB(o[0]=__builtin_amdgcn_mfma_f32_32x32x16_bf16(PAF(1),VFR(1),o[0],0,0,0), C0,8); \
    KRD(GL,1); GAPB(o[1]=__builtin_amdgcn_mfma_f32_32x32x16_bf16(PAF(1),VFR(5),o[1],0,0,0), C0,12); \
    KRD(GL,2); GAPB(o[0]=__builtin_amdgcn_mfma_f32_32x32x16_bf16(PAF(2),VFR(2),o[0],0,0,0), C1,0); \
    KRD(GL,3); GAPB(o[1]=__builtin_amdgcn_mfma_f32_32x32x16_bf16(PAF(2),VFR(6),o[1],0,0,0), C1,4); \
    GAPB(o[0]=__builtin_amdgcn_mfma_f32_32x32x16_bf16(PAF(3),VFR(3),o[0],0,0,0), C1,8); \
    GAPB(o[1]=__builtin_amdgcn_mfma_f32_32x32x16_bf16(PAF(3),VFR(7),o[1],0,0,0), C1,12); \
    pv(o+2,vb0+2*sl_prev+8192,PAF(0),PAF(1),PAF(2),PAF(3)); SBAR(); \
    }while(0)
  int t=1;
  #undef CMASK
  #define CMASK(P0,P1,t) do{}while(0)
  for(;t+5<NT;t+=2){
    STEP(pB0,pB1,pA0,pA1,t,true,true,true);     WAIT_BAR(3); RESC(); ROT();
    STEP(pA0,pA1,pB0,pB1,t+1,true,true,true);   WAIT_BAR(3); RESC(); ROT();
  }
  #undef CMASK
  #define CMASK(P0,P1,t) do{int jb_=(t)-(NT-4); if(jb_>=0)cmask(P0,P1,jb_,qrel,hi);}while(0)
  #define ENDW(tt) do{ if((tt)+3<NT){WAIT_BAR(3);} else if((tt)+2<NT){WAIT_BAR(2);} else {WAIT_BAR(0);} }while(0)
  for(;t+1<NT;t+=2){
    STEP(pB0,pB1,pA0,pA1,t,(t+3<NT),(t+1<NT),(t+1<NT));       ENDW(t);   RESC(); ROT();
    STEP(pA0,pA1,pB0,pB1,t+1,(t+4<NT),(t+2<NT),(t+2<NT));     ENDW(t+1); RESC(); ROT();
  }
  STEP(pB0,pB1,pA0,pA1,NT-1,false,false,false); RESC();
  { float sacc=pB0[0]+pB0[1]; _Pragma("unroll") for(int r=2;r<16;++r)sacc+=pB0[r]; _Pragma("unroll") for(int r=0;r<16;++r)sacc+=pB1[r]; l_reg+=sacc;
    pw0=(u32x4){PKW(pB0,0),PKW(pB0,2),PKW(pB0,4),PKW(pB0,6)};pw1=(u32x4){PKW(pB0,8),PKW(pB0,10),PKW(pB0,12),PKW(pB0,14)};pw2=(u32x4){PKW(pB1,0),PKW(pB1,2),PKW(pB1,4),PKW(pB1,6)};pw3=(u32x4){PKW(pB1,8),PKW(pB1,10),PKW(pB1,12),PKW(pB1,14)};
    SBAR(); pv(o,vb0+2*sl_cur,PAF(0),PAF(1),PAF(2),PAF(3)); pv(o+2,vb0+2*sl_cur+8192,PAF(0),PAF(1),PAF(2),PAF(3)); }
  #undef PKW
  #undef PAF
  #undef VFR
  #undef PIN
  #undef MX3
  #undef GAPA
  #undef GAPB
  #undef EX
  #undef VRD
  #undef KRD
  #undef STEP
  #undef ENDW
  {auto rr=__builtin_amdgcn_permlane32_swap(__float_as_uint(l_reg),__float_as_uint(l_reg),false,false);l_reg=__uint_as_float(rr[0])+__uint_as_float(rr[1]);}
  if(hi==0)wsf[32+r32]=l_reg;asm volatile("s_waitcnt lgkmcnt(0)":::"memory");
  float rli[16];
  #pragma unroll
  for(int r=0;r<16;++r)rli[r]=__builtin_amdgcn_rcpf(wsf[32+crow(r,hi)]);
  bf16*Ow=Oc+(rowbase+q0+wid*QBLK)*DM;
  { bf16*stg=(bf16*)(shm+LDS_OST)+wid*4096;
    #pragma unroll
    for(int r=0;r<16;++r){const int orow=crow(r,hi);
      #pragma unroll
      for(int d0=0;d0<4;++d0)stg[orow*128+d0*32+r32]=__float2bfloat16(o[d0][r]*rli[r]);}
    asm volatile("s_waitcnt lgkmcnt(0)":::"memory");
    #pragma unroll
    for(int i=0;i<8;++i){const int row=i*4+(lane>>4),ch=lane&15; const u32x4 v=*(const u32x4*)(stg+row*128+ch*8); ATTN_STORE16(Ow+(long)row*DM+ch*8,v);} }
  asm volatile("s_waitcnt lgkmcnt(0)\n\ts_barrier":::"memory");
  #undef DMA_K
  #undef DMA_V
  #undef CMASK
  #undef START
  #undef RESC
  #undef ROT
}
constexpr int ATTN_LDS_BYTES=LDS_BYTES;
#undef SBAR
#undef WAIT_BAR
}
namespace mk {
#define GAS __attribute__((address_space(1)))
#define LAS __attribute__((address_space(3)))
typedef unsigned short bf16;
typedef unsigned v4u __attribute__((ext_vector_type(4)));
typedef unsigned v2u __attribute__((ext_vector_type(2)));
typedef float f32x4 __attribute__((ext_vector_type(4)));
using pg8::Unit;
using pg8::cvt_pk_bf16;

constexpr int D = 1024, BATCH = 8, SEQ = 2048, T = BATCH * SEQ, NH = 8, NG = 4, EPG = 8, NE = 32, DE = 512, NRW = NG + NE;
constexpr float ALPHA = 1.4142135623730951f, LN_EPS = 1e-5f, RMS_EPS = 1e-5f;
constexpr float LAM_INIT = 0.35550906f;
constexpr float QSCALE = 0.125f * 1.4426950408889634f;
constexpr int CNT_STRIDE = 64;
constexpr int CAP = T;
constexpr int NWAVES = 8, NTHREADS = 512;
#ifndef P0B_FILL
#define P0B_FILL 1
#endif
#ifndef MOE_MERGE
#define MOE_MERGE 0
#endif
#ifndef P0B_SPLIT
#define P0B_SPLIT 8192
#endif

constexpr size_t MiB = 1u << 20;
constexpr size_t WS_CTL = 0, WS_W1T = 1 * MiB, WS_W2T = 7 * MiB, WS_WKVQ = 9 * MiB, WS_WOT = 15 * MiB, WS_RWT = 17 * MiB;
constexpr size_t WS_RWH = 17 * MiB + 512 * 1024;
constexpr size_t WS_WUT = 24 * MiB, WS_WDT = 152 * MiB, WS_XB = 216 * MiB, WS_GB = 248 * MiB, WS_U = 280 * MiB, WS_A2 = 312 * MiB, WS_Z = 344 * MiB, WS_X1B = 408 * MiB;
constexpr size_t WS_ACT = 440 * MiB, WS_YP = 480 * MiB, WS_X2B = 544 * MiB, WS_K = 576 * MiB, WS_V = 608 * MiB, WS_Q = 640 * MiB, WS_O0 = 672 * MiB, WS_O1 = 704 * MiB;
constexpr size_t WS_A3 = 736 * MiB, WS_X3B = 768 * MiB;
#ifdef MKPROBE
constexpr size_t WS_PERM = 18 * MiB;
constexpr size_t WS_Z1 = 800 * MiB, WS_ACT1 = 864 * MiB, WS_YP1 = 904 * MiB, WS_PERM1 = 968 * MiB, WS_END = 972 * MiB;
#else
constexpr size_t WS_PERM = 18 * MiB;
constexpr size_t WS_Z1 = WS_Z, WS_ACT1 = WS_ACT, WS_YP1 = WS_YP, WS_PERM1 = WS_PERM, WS_END = 800 * MiB;
#endif
#define LZ(l) ((l) ? WS_Z1 : WS_Z)
#define LACT(l) ((l) ? WS_ACT1 : WS_ACT)
#define LYP(l) ((l) ? WS_YP1 : WS_YP)
#define LPERM(l) ((l) ? WS_PERM1 : WS_PERM)
constexpr int RWH_PITCH = 2064  , RWH_BYTES = 2 * 36 * RWH_PITCH  ;
constexpr int RWH_PAD = 149504;
constexpr int RING_BYTES = 131072, RW_BYTES = RWH_PAD  , MISC_OFF = RW_BYTES, LDS_BYTES = 163840;

struct Args {
    const float *x, *a_w_in, *a_conv_w, *a_w_out, *kv_w, *b_w_q, *b_lambda, *b_subln_g, *b_w_o, *ln1_g, *ln1_b, *ln2_g, *ln2_b, *rg_w, *rg_b, *re_w, *re_b, *e_w_in, *e_w_down;
    float* out; unsigned char* ws;
};

typedef const __attribute__((address_space(4))) Args* ArgsP;
__device__ __forceinline__ ArgsP kargs() { ArgsP p = (ArgsP)__builtin_amdgcn_kernarg_segment_ptr(); asm volatile("" : "+s"(p)); return p; }
struct Ctx { int tid, lane, wave, G, bx, gw, NGW; unsigned char* ws; };
__device__ __forceinline__ Ctx mkctx(ArgsP ap) { Ctx c; int t = threadIdx.x; asm volatile("" : "+v"(t)); c.tid = t; c.lane = t & 63; c.wave = __builtin_amdgcn_readfirstlane(t >> 6);
    c.G = gridDim.x; c.bx = blockIdx.x; c.gw = c.bx * 8 + c.wave; c.NGW = c.G * 8; c.ws = ap->ws; return c; }
__device__ __forceinline__ unsigned f2bf(float f) { unsigned u = __builtin_bit_cast(unsigned, f); return (u + 0x7fffu + ((u >> 16) & 1u)) >> 16; }
__device__ __forceinline__ unsigned pk2(float lo, float hi) { return f2bf(lo) | (f2bf(hi) << 16); }
__device__ __forceinline__ float bflo(unsigned w) { return __builtin_bit_cast(float, w << 16); }
__device__ __forceinline__ float bfhi(unsigned w) { return __builtin_bit_cast(float, w & 0xffff0000u); }
__device__ __forceinline__ f32x4 ldz4(const bf16* p) { const v2u w = *(const v2u*)p; return (f32x4){bflo(w.x), bfhi(w.x), bflo(w.y), bfhi(w.y)}; }
__device__ __forceinline__ float wave_sum(float v) {
#pragma unroll
    for (int o = 1; o < 64; o <<= 1) v += __shfl_xor(v, o);
    return v;
}

__device__ __forceinline__ float dpp_add(float v, const int ctrl_sel) {
    const int iv = __builtin_bit_cast(int, v); int t;
    if (ctrl_sel == 0) t = __builtin_amdgcn_update_dpp(0, iv, 0xB1, 0xF, 0xF, true);
    else if (ctrl_sel == 1) t = __builtin_amdgcn_update_dpp(0, iv, 0x4E, 0xF, 0xF, true);
    else if (ctrl_sel == 2) t = __builtin_amdgcn_update_dpp(0, iv, 0x141, 0xF, 0xF, true);
    else if (ctrl_sel == 3) t = __builtin_amdgcn_update_dpp(0, iv, 0x140, 0xF, 0xF, true);
    else if (ctrl_sel == 4) t = __builtin_amdgcn_update_dpp(0, iv, 0x142, 0xA, 0xF, false);
    else t = __builtin_amdgcn_update_dpp(0, iv, 0x143, 0xC, 0xF, false);
    return v + __builtin_bit_cast(float, t);
}
template <int N> __device__ __forceinline__ void dpp_sum(float (&v)[N]) {
#pragma unroll
    for (int st = 0; st < 6; ++st) {
#pragma unroll
        for (int i = 0; i < N; ++i) v[i] = dpp_add(v[i], st);
    }
#pragma unroll
    for (int i = 0; i < N; ++i) v[i] = __builtin_bit_cast(float, __builtin_amdgcn_readlane(__builtin_bit_cast(int, v[i]), 63));
}
__device__ __forceinline__ float dpp_sum1(float v) { float a[1] = {v}; dpp_sum(a); return a[0]; }

__device__ __forceinline__ void p0_transpose_item(const float* W, int K, int N, bf16* WT, int row_off, LAS float* scr, int item, int lane) {
    const int nblk = N / 64, kb = item / nblk, nb = item % nblk, k0 = 64 * kb, n0 = 64 * nb;
    const float* src = W + (size_t)(k0 + (lane >> 4)) * N + n0 + (lane & 15) * 4;
    f32x4 v[16];
#pragma unroll
    for (int i = 0; i < 16; ++i) v[i] = __builtin_nontemporal_load((const f32x4*)(src + (size_t)(4 * i) * N));
#pragma unroll
    for (int i = 0; i < 16; ++i) { LAS float* d = scr + (4 * i + (lane >> 4)) * 65 + (lane & 15) * 4; d[0] = v[i].x; d[1] = v[i].y; d[2] = v[i].z; d[3] = v[i].w; }
    asm volatile("s_waitcnt lgkmcnt(0)" ::: "memory");
    const int c = lane & 7;
#pragma unroll
    for (int j = 0; j < 8; ++j) { const int n = (lane >> 3) + 8 * j; const LAS float* s = scr + (8 * c) * 65 + n;
        v4u o; o.x = pk2(s[0 * 65], s[1 * 65]); o.y = pk2(s[2 * 65], s[3 * 65]); o.z = pk2(s[4 * 65], s[5 * 65]); o.w = pk2(s[6 * 65], s[7 * 65]);
        *(GAS v4u*)(WT + (size_t)(row_off + n0 + n) * K + k0 + 8 * c) = o; }
    asm volatile("s_waitcnt lgkmcnt(0)" ::: "memory");
}

constexpr int I_IN = 16 * 48, I_SQ = 16 * 16, I_KV = 16 * 32, I_DN = 8 * 16;
constexpr int NEM = P0B_FILL ? NE : 2 * NE;
constexpr int PS1 = I_IN, PS2 = PS1 + I_SQ, PS3 = PS2 + I_KV, PS4 = PS3 + I_SQ, PS5 = PS4 + I_SQ, PS6 = PS5 + NEM * I_SQ, P0_NITEMS = PS6 + NEM * I_DN;
__device__ __forceinline__ void p0_items(LAS unsigned char* lds, int lo, int hi, int w, int nw) {
    const ArgsP a = kargs(); const Ctx cx = mkctx(a); const int lane = cx.lane; unsigned char* ws = cx.ws;
    LAS float* scr = (LAS float*)(lds + cx.wave * 16640);
    for (int it = lo + w; it < hi; it += nw) {
        if (it < PS1) p0_transpose_item(a->a_w_in, D, 3 * D, (bf16*)(ws + WS_W1T), 0, scr, it, lane);
        else if (it < PS2) p0_transpose_item(a->a_w_out, D, D, (bf16*)(ws + WS_W2T), 0, scr, it - PS1, lane);
        else if (it < PS3) p0_transpose_item(a->kv_w, D, 2 * D, (bf16*)(ws + WS_WKVQ), 0, scr, it - PS2, lane);
        else if (it < PS4) p0_transpose_item(a->b_w_q, D, D, (bf16*)(ws + WS_WKVQ), 2 * D, scr, it - PS3, lane);
        else if (it < PS5) p0_transpose_item(a->b_w_o, D, D, (bf16*)(ws + WS_WOT), 0, scr, it - PS4, lane);
        else if (it < PS6) { const int r = it - PS5, mtx = r / I_SQ; p0_transpose_item(a->e_w_in + (size_t)mtx * D * D, D, D, (bf16*)(ws + WS_WUT) + (size_t)mtx * D * D, 0, scr, r % I_SQ, lane); }
        else { const int r = it - PS6, mtx = r / I_DN; p0_transpose_item(a->e_w_down + (size_t)mtx * DE * D, DE, D, (bf16*)(ws + WS_WDT) + (size_t)mtx * D * DE, 0, scr, r % I_DN, lane); }
    }
}
#ifndef ROLE_SPLIT
#define ROLE_SPLIT 1
#endif
#ifndef P0A_EXTRA
#define P0A_EXTRA 5632
#endif
__device__ __forceinline__ void p0_prologue(LAS unsigned char* lds) {
    const ArgsP a = kargs(); const Ctx cx = mkctx(a); const int gw = cx.gw, NGW = cx.NGW, lane = cx.lane;
    unsigned char* ws = cx.ws;
    p0_items(lds, 0, ROLE_SPLIT ? PS1 + P0A_EXTRA : P0_NITEMS, gw, NGW);
    for (int m = gw; m < T; m += NGW) {
        const GAS f32x4* xr = (const GAS f32x4*)(a->x + (size_t)m * D) + lane;
        GAS v2u* o = (GAS v2u*)((bf16*)(ws + WS_XB) + (size_t)m * D) + lane;
#pragma unroll
        for (int j = 0; j < 4; ++j) { const f32x4 v = xr[64 * j]; v2u w; w.x = pk2(v.x, v.y); w.y = pk2(v.z, v.w); o[64 * j] = w; }
    }
    { float* rwt = (float*)(ws + WS_RWT);
      for (int idx = gw * 64 + lane; idx < 2 * NRW * D; idx += NGW * 64) { const int l = idx / (NRW * D), n = (idx / D) % NRW, k = idx % D;
          const float w = n < NG ? a->rg_w[((size_t)l * D + k) * NG + n] : a->re_w[((size_t)l * D + k) * NE + (n - NG)];
          rwt[idx] = w;
          const unsigned hi = f2bf(w), lo = f2bf(w - __builtin_bit_cast(float, hi << 16));
          bf16* img = (bf16*)(ws + WS_RWH) + (size_t)l * (RWH_PAD / 2);
          img[(size_t)n * (RWH_PITCH / 2) + k] = (bf16)hi; img[(size_t)(NRW + n) * (RWH_PITCH / 2) + k] = (bf16)lo; } }
}
__device__ __forceinline__ void p0b_fill(LAS unsigned char* lds, int lo, int hi, int r, int nidle) {
    const ArgsP a = kargs(); const Ctx cx = mkctx(a); unsigned char* ws = cx.ws;
    LAS float* scr = (LAS float*)(lds + cx.wave * 16640);
    for (int it = lo + r * NWAVES + cx.wave; it < hi; it += nidle * NWAVES) {
        if (it < NE * 256) { const int mtx = NE + it / 256; p0_transpose_item(a->e_w_in + (size_t)mtx * D * D, D, D, (bf16*)(ws + WS_WUT) + (size_t)mtx * D * D, 0, scr, it % 256, cx.lane); }
        else { const int r2 = it - NE * 256, mtx = NE + r2 / 128; p0_transpose_item(a->e_w_down + (size_t)mtx * DE * D, DE, D, (bf16*)(ws + WS_WDT) + (size_t)mtx * D * DE, 0, scr, r2 % 128, cx.lane); }
    }
}
constexpr int P0B_ITEMS = NE * 256 + NE * 128;
__device__ __forceinline__ void p0b_idle_fill(LAS unsigned char* lds, int lo, int hi) {
    const ArgsP a = kargs(); const Ctx cx = mkctx(a); const LAS int* misc = (const LAS int*)(lds + MISC_OFF);
    const int U = misc[2 * NE], rem = U % cx.G;
    if (rem == 0) p0b_fill(lds, lo, hi, cx.bx, cx.G);
    else if (cx.bx >= rem) p0b_fill(lds, lo, hi, cx.bx - rem, cx.G - rem);
}
struct SchedDense {
    int G, c, nN, mode, K; const char* W;
    __device__ __forceinline__ bool next(int i, Unit& u) const {
        int pm, pn; if (!pg8::static_tile(i, G, c, T / 256, nN, pm, pn)) return false;
        u.arow = pm * 256; u.p0 = pm; u.p1 = pn; u.p2 = 0; u.p3 = 0;
        const size_t rb = (size_t)K * 2;
        if (mode == 0 && pn >= 4) { const int jj = pn - 4; u.b0 = W + (size_t)(D + 128 * jj) * rb; u.b1 = W + (size_t)(2 * D + 128 * jj) * rb; }
        else { u.b0 = W + (size_t)(256 * pn) * rb; u.b1 = u.b0 + 128 * rb; }
        return true;
    }
    __device__ __forceinline__ void a_offs(const Unit& u, const int (&R)[2], const int (&C)[2], unsigned& v00, unsigned& v01, unsigned& v10, unsigned& v11) const {
        v00 = (unsigned)((u.arow + R[0]) * K + C[0]) * 2u; v01 = (unsigned)((u.arow + R[1]) * K + C[1]) * 2u;
        v10 = (unsigned)((u.arow + 128 + R[0]) * K + C[0]) * 2u; v11 = (unsigned)((u.arow + 128 + R[1]) * K + C[1]) * 2u;
    }
    __device__ __forceinline__ bool half_only(const Unit&) const { return false; }
    __device__ __forceinline__ unsigned peek(const Unit&) const { return 0u; }
    __device__ __forceinline__ void a_ready(const Unit&, unsigned) const {}
    __device__ __forceinline__ void done(const Unit&) const {}
};
struct MoeTab { const LAS int* ub; const LAS int* ps; const LAS int* cn; };
struct SchedMoe {
    int G, c, K; bool up; const char* W; const v2u* perm; MoeTab tb;
    unsigned* ready; int hook; int off, nb;
    __device__ __forceinline__ bool half_only(const Unit& u) const { return u.p2 <= 128; }
    __device__ __forceinline__ unsigned peek(const Unit& u) const {
        return hook == 2 ? __hip_atomic_load(ready + 64 * u.p3, __ATOMIC_RELAXED, __HIP_MEMORY_SCOPE_AGENT) : 0u;
    }
    __device__ __forceinline__ void a_ready(const Unit& u, unsigned pk) const {
        if (hook != 2) return;
        if ((unsigned)__builtin_amdgcn_readfirstlane(pk) >= 32u) return;
        const unsigned long long t0 = __builtin_amdgcn_s_memrealtime();
        while ((unsigned)__builtin_amdgcn_readfirstlane(__hip_atomic_load(ready + 64 * u.p3, __ATOMIC_RELAXED, __HIP_MEMORY_SCOPE_AGENT)) < 32u) {
            if (__builtin_amdgcn_s_memrealtime() - t0 > 2000000ull) break;
            __builtin_amdgcn_s_sleep(2); }
        __builtin_amdgcn_fence(__ATOMIC_ACQUIRE, "agent");
        asm volatile("s_waitcnt vmcnt(0)" ::: "memory");
    }
    __device__ __forceinline__ void done(const Unit& u) const {
        if (hook != 1) return;
        asm volatile("s_waitcnt vmcnt(0)" ::: "memory");
        if ((threadIdx.x & 63) == 0) __hip_atomic_fetch_add(ready + 64 * u.p3, 1u, __ATOMIC_RELAXED, __HIP_MEMORY_SCOPE_AGENT);
    }
    __device__ __forceinline__ bool next(int i, Unit& u) const {
        int idx = i * G + c;
        if (nb > 0) {
            const int v = c - (G - nb);
            if (v >= 0) idx = i == 0 ? v : i == 1 ? v + nb : 2 * nb + v + (i - 2) * G;
            else idx = 3 * nb + c + i * G;
        }
        if (idx >= tb.ub[2 * NE]) return false;
        int k = 0;
#pragma unroll 1
        for (int q = 1; q < 2 * NE; ++q) if (idx >= tb.ub[q]) k = q;
        const int e = k & (NE - 1), local = idx - tb.ub[k];
        int ct, rti;
        if (k < NE) { const int rtn = (tb.ub[k + 1] - tb.ub[k]) >> 2; ct = local / rtn; rti = local - ct * rtn; }
        else { ct = local; rti = (tb.cn[e] - 1) >> 8; }
        const size_t rb = (size_t)K * 2; const char* We = W + (size_t)e * D * rb;
        if (up) { u.b0 = We + (size_t)(128 * ct) * rb; u.b1 = We + (size_t)(DE + 128 * ct) * rb; u.arow = e * CAP + rti * 256; u.p0 = tb.ps[e] + rti * 256; }
        else { u.b0 = We + (size_t)(256 * ct) * rb; u.b1 = u.b0 + 128 * rb; u.arow = tb.ps[e] + rti * 256; u.p0 = e * CAP + rti * 256; }
        u.p1 = ct; u.p2 = tb.cn[e] - rti * 256; u.p3 = (tb.ps[e] >> 8) + rti;
        return true;
    }
    __device__ __forceinline__ void a_offs(const Unit& u, const int (&R)[2], const int (&C)[2], unsigned& v00, unsigned& v01, unsigned& v10, unsigned& v11) const {
        if (up) {
            const int r00 = R[0] < u.p2 ? R[0] : 0, r01 = R[1] < u.p2 ? R[1] : 0, r10 = 128 + R[0] < u.p2 ? 128 + R[0] : 0, r11 = 128 + R[1] < u.p2 ? 128 + R[1] : 0;
            const int t00 = (int)(perm[u.arow + r00].y >> 1), t01 = (int)(perm[u.arow + r01].y >> 1), t10 = (int)(perm[u.arow + r10].y >> 1), t11 = (int)(perm[u.arow + r11].y >> 1);
            v00 = (unsigned)(t00 * K + C[0]) * 2u; v01 = (unsigned)(t01 * K + C[1]) * 2u; v10 = (unsigned)(t10 * K + C[0]) * 2u; v11 = (unsigned)(t11 * K + C[1]) * 2u;
        } else {
            v00 = (unsigned)((u.arow + R[0]) * K + C[0]) * 2u; v01 = (unsigned)((u.arow + R[1]) * K + C[1]) * 2u;
            v10 = (unsigned)((u.arow + 128 + R[0]) * K + C[0]) * 2u; v11 = (unsigned)((u.arow + 128 + R[1]) * K + C[1]) * 2u;
        }
    }
};

struct EpiConvIn {
    static constexpr bool PERM = true; bf16* GB; bf16* U;
    __device__ __forceinline__ void operator()(const f32x4 (&acc)[2][2][4][2], const Unit& u, int wr, int wc, int fr, int fq) const {
        const int row0 = u.p0 * 256 + wr * 64 + fr;
        if (u.p1 < 4) {
            const int col0 = u.p1 * 256 + wc * 32 + 8 * fq;
#pragma unroll
            for (int ai = 0; ai < 2; ++ai)
#pragma unroll
                for (int m = 0; m < 4; ++m) { bf16* rowp = GB + (size_t)(row0 + ai * 128 + m * 16) * D + col0;
#pragma unroll
                    for (int bj = 0; bj < 2; ++bj) { const f32x4 v0 = acc[ai][bj][m][0], v1 = acc[ai][bj][m][1];
                        v4u w; w.x = cvt_pk_bf16(v0[0], v0[1]); w.y = cvt_pk_bf16(v0[2], v0[3]); w.z = cvt_pk_bf16(v1[0], v1[1]); w.w = cvt_pk_bf16(v1[2], v1[3]);
                        *(v4u*)(rowp + bj * 128) = w; } }
        } else {
            const int col0 = (u.p1 - 4) * 128 + wc * 32 + 8 * fq;
#pragma unroll
            for (int ai = 0; ai < 2; ++ai)
#pragma unroll
                for (int m = 0; m < 4; ++m) { const f32x4 v0 = acc[ai][0][m][0] * acc[ai][1][m][0], v1 = acc[ai][0][m][1] * acc[ai][1][m][1];
                    v4u w; w.x = cvt_pk_bf16(v0[0], v0[1]); w.y = cvt_pk_bf16(v0[2], v0[3]); w.z = cvt_pk_bf16(v1[0], v1[1]); w.w = cvt_pk_bf16(v1[2], v1[3]);
                    *(v4u*)(U + (size_t)(row0 + ai * 128 + m * 16) * D + col0) = w; }
        }
    }
};
template <bool RES_BF16> struct EpiResZ {
    static constexpr bool PERM = true; const void* res; bf16* Z;
    __device__ __forceinline__ void operator()(const f32x4 (&acc)[2][2][4][2], const Unit& u, int wr, int wc, int fr, int fq) const {
        const int row0 = u.p0 * 256 + wr * 64 + fr, col0 = u.p1 * 256 + wc * 32 + 8 * fq;
#pragma unroll
        for (int ai = 0; ai < 2; ++ai)
#pragma unroll
            for (int m = 0; m < 4; ++m) { const size_t off = (size_t)(row0 + ai * 128 + m * 16) * D + col0;
#pragma unroll
                for (int bj = 0; bj < 2; ++bj) { const size_t o = off + bj * 128; f32x4 r0, r1;
                    if (RES_BF16) { const v4u w = *(const v4u*)((const bf16*)res + o); r0 = (f32x4){bflo(w.x), bfhi(w.x), bflo(w.y), bfhi(w.y)}; r1 = (f32x4){bflo(w.z), bfhi(w.z), bflo(w.w), bfhi(w.w)}; }
                    else { r0 = *(const f32x4*)((const float*)res + o); r1 = *(const f32x4*)((const float*)res + o + 4); }
                    const f32x4 v0 = r0 * ALPHA + acc[ai][bj][m][0], v1 = r1 * ALPHA + acc[ai][bj][m][1];
                    v4u w; w.x = cvt_pk_bf16(v0[0], v0[1]); w.y = cvt_pk_bf16(v0[2], v0[3]); w.z = cvt_pk_bf16(v1[0], v1[1]); w.w = cvt_pk_bf16(v1[2], v1[3]);
                    *(v4u*)(Z + o) = w; } }
    }
};
template <bool WT> struct EpiUp {
    static constexpr bool PERM = true; bf16* ACT;
    __device__ __forceinline__ void operator()(const f32x4 (&acc)[2][2][4][2], const Unit& u, int wr, int wc, int fr, int fq) const {
        const int row0 = u.p0 + wr * 64 + fr, col0 = u.p1 * 128 + wc * 32 + 8 * fq;
#pragma unroll
        for (int ai = 0; ai < 2; ++ai)
#pragma unroll
            for (int m = 0; m < 4; ++m) { f32x4 v[2];
#pragma unroll
                for (int n = 0; n < 2; ++n) { const f32x4 g = acc[ai][0][m][n], uu = acc[ai][1][m][n];
#pragma unroll
                    for (int j = 0; j < 4; ++j) { const float e = __builtin_amdgcn_exp2f(g[j] * -1.4426950408889634f); v[n][j] = g[j] * __builtin_amdgcn_rcpf(1.0f + e) * uu[j]; } }
                v4u w; w.x = cvt_pk_bf16(v[0][0], v[0][1]); w.y = cvt_pk_bf16(v[0][2], v[0][3]); w.z = cvt_pk_bf16(v[1][0], v[1][1]); w.w = cvt_pk_bf16(v[1][2], v[1][3]);
                bf16* dst = ACT + (size_t)(row0 + ai * 128 + m * 16) * DE + col0;
                if (WT) { __hip_atomic_store((unsigned long long*)dst, ((unsigned long long)w.y << 32) | w.x, __ATOMIC_RELAXED, __HIP_MEMORY_SCOPE_AGENT);
                          __hip_atomic_store((unsigned long long*)dst + 1, ((unsigned long long)w.w << 32) | w.z, __ATOMIC_RELAXED, __HIP_MEMORY_SCOPE_AGENT); }
                else *(v4u*)dst = w; }
    }
};
struct EpiDown {
    static constexpr bool PERM = true; bf16* YP; const v2u* perm;
    __device__ __forceinline__ void operator()(const f32x4 (&acc)[2][2][4][2], const Unit& u, int wr, int wc, int fr, int fq) const {
        const int col0 = u.p1 * 256 + wc * 32 + 8 * fq;
        v2u rec[2][4];
#pragma unroll
        for (int ai = 0; ai < 2; ++ai)
#pragma unroll
            for (int m = 0; m < 4; ++m) { const int r = ai * 128 + wr * 64 + m * 16 + fr; rec[ai][m] = perm[u.p0 + (r < u.p2 ? r : 0)]; }
#pragma unroll
        for (int ai = 0; ai < 2; ++ai)
#pragma unroll
            for (int m = 0; m < 4; ++m) { const int r = ai * 128 + wr * 64 + m * 16 + fr;
                if (r < u.p2) { const int pair = (int)rec[ai][m].y; float g = __builtin_bit_cast(float, rec[ai][m].x); asm volatile("" : "+v"(g)); bf16* rowp = YP + (size_t)pair * D + col0;
#pragma unroll
                    for (int bj = 0; bj < 2; ++bj) { const f32x4 v0 = acc[ai][bj][m][0] * g, v1 = acc[ai][bj][m][1] * g;
                        v4u w; w.x = cvt_pk_bf16(v0[0], v0[1]); w.y = cvt_pk_bf16(v0[2], v0[3]); w.z = cvt_pk_bf16(v1[0], v1[1]); w.w = cvt_pk_bf16(v1[2], v1[3]);
                        *(v4u*)(rowp + bj * 128) = w; } } }
    }
};
struct EpiKVQ {
    static constexpr bool PERM = true; bf16* KB;
    __device__ __forceinline__ void operator()(const f32x4 (&acc)[2][2][4][2], const Unit& u, int wr, int wc, int fr, int fq) const {
        const int t = u.p1 >> 2; const float sc = t == 2 ? QSCALE : 1.0f;
        bf16* base = KB + (size_t)t * (32 * MiB / 2);
        const int row0 = u.p0 * 256 + wr * 64 + fr, col0 = (u.p1 & 3) * 256 + wc * 32 + 8 * fq;
#pragma unroll
        for (int ai = 0; ai < 2; ++ai)
#pragma unroll
            for (int m = 0; m < 4; ++m) { bf16* rowp = base + (size_t)(row0 + ai * 128 + m * 16) * D + col0;
#pragma unroll
                for (int bj = 0; bj < 2; ++bj) { const f32x4 v0 = acc[ai][bj][m][0] * sc, v1 = acc[ai][bj][m][1] * sc;
                    v4u w; w.x = cvt_pk_bf16(v0[0], v0[1]); w.y = cvt_pk_bf16(v0[2], v0[3]); w.z = cvt_pk_bf16(v1[0], v1[1]); w.w = cvt_pk_bf16(v1[2], v1[3]);
                    *(v4u*)(rowp + bj * 128) = w; } }
    }
};

__device__ __forceinline__ void ln_rows(f32x4 (&v)[4], const f32x4 (&gg)[4], const f32x4 (&bb)[4]) {
    float s = 0.f;
#pragma unroll
    for (int j = 0; j < 4; ++j) s += (v[j].x + v[j].y) + (v[j].z + v[j].w);
    const float mean = dpp_sum1(s) * (1.f / D); float s2 = 0.f;
#pragma unroll
    for (int j = 0; j < 4; ++j) { v[j] = v[j] - mean; s2 += (v[j].x * v[j].x + v[j].y * v[j].y) + (v[j].z * v[j].z + v[j].w * v[j].w); }
    const float rstd = 1.f / sqrtf(dpp_sum1(s2) * (1.f / D) + LN_EPS);
#pragma unroll
    for (int j = 0; j < 4; ++j) v[j] = v[j] * rstd * gg[j] + bb[j];
}
__device__ __forceinline__ float dot_lds(const f32x4 (&v)[4], const LAS f32x4* w, int lane) {
    float a = 0.f;
#pragma unroll
    for (int j = 0; j < 4; ++j) { const f32x4 ww = w[64 * j + lane]; a += (v[j].x * ww.x + v[j].y * ww.y) + (v[j].z * ww.z + v[j].w * ww.w); }
    return a;
}
typedef short bf16x8v __attribute__((ext_vector_type(8)));
__device__ __forceinline__ void ln_router_mfma(LAS unsigned char* lds, int layer, int rep) {
    const ArgsP a = kargs(); const Ctx cx = mkctx(a); const int lane = cx.lane, wave = cx.wave, tid = cx.tid;
    unsigned char* ws = cx.ws;
    const bf16* Z = (const bf16*)(ws + LZ(layer)); bf16* Xb = (bf16*)(ws + (layer == 0 ? WS_X1B : WS_X3B));
    const float* g = a->ln1_g + layer * D; const float* b = a->ln1_b + layer * D;
    const float* rgb = a->rg_b + layer * NG; const float* reb = a->re_b + layer * NE;
    int* cnt = (int*)(ws + WS_CTL) + layer * NE * CNT_STRIDE; v2u* perm = (v2u*)(ws + LPERM(layer));
    const int i = lane & 15, kq = lane >> 4, grp = wave >> 1, half = wave & 1;
    const int row = cx.bx * 64 + grp * 16 + i, col0 = 512 * half + 8 * kq;
    { const unsigned char* wg = ws + WS_RWH + (size_t)layer * RWH_PAD;
      for (int q = wave; q < RWH_PAD / 1024; q += NWAVES)
          __builtin_amdgcn_global_load_lds((const unsigned*)(wg + (size_t)q * 1024 + lane * 16), (LAS unsigned*)(lds + q * 1024), 16, 0, 0); }
    v4u xw[16];
#pragma unroll
    for (int s = 0; s < 16; ++s) xw[s] = *(const v4u*)(Z + (size_t)row * D + col0 + 32 * s);
#define XLO(s) ((f32x4){bflo(xw[s].x), bfhi(xw[s].x), bflo(xw[s].y), bfhi(xw[s].y)})
#define XHI(s) ((f32x4){bflo(xw[s].z), bfhi(xw[s].z), bflo(xw[s].w), bfhi(xw[s].w)})
    LAS float* xs = (LAS float*)(lds + MISC_OFF + 4096);
    LAS float* part = (LAS float*)lds;
    float s1 = 0.f, s2 = 0.f;
#pragma unroll
    for (int s = 0; s < 16; ++s)
#pragma unroll
        for (int h2 = 0; h2 < 2; ++h2) { const f32x4 v = h2 ? XHI(s) : XLO(s); s1 += (v.x + v.y) + (v.z + v.w); s2 += (v.x * v.x + v.y * v.y) + (v.z * v.z + v.w * v.w); }
#pragma unroll
    for (int s = 0; s < 16; ++s) asm volatile("" : "+v"(xw[s]));
    s1 += __shfl_xor(s1, 16); s2 += __shfl_xor(s2, 16); s1 += __shfl_xor(s1, 32); s2 += __shfl_xor(s2, 32);
    if (kq == 0) { xs[(wave * 16 + i) * 2] = s1; xs[(wave * 16 + i) * 2 + 1] = s2; }
    __syncthreads();
    const float t1 = xs[((wave ^ 1) * 16 + i) * 2] + s1, t2 = xs[((wave ^ 1) * 16 + i) * 2 + 1] + s2;
    const float mean = t1 * (1.f / D), rstd = 1.f / sqrtf(fmaxf(t2 * (1.f / D) - mean * mean, 0.f) + LN_EPS);
    typedef float f32x4a __attribute__((ext_vector_type(4)));
    f32x4a acc0 = {0.f, 0.f, 0.f, 0.f}, acc1 = acc0, acc2 = acc0;
    const LAS unsigned char* wb = (const LAS unsigned char*)lds + (size_t)(lane & 15) * RWH_PITCH + (size_t)col0 * 2;
    const int n2 = (32 + (lane & 15)) < NRW ? 32 + (lane & 15) : NRW - 1;
    const LAS unsigned char* wb2 = (const LAS unsigned char*)lds + (size_t)n2 * RWH_PITCH + (size_t)col0 * 2;
    constexpr int LO = NRW * RWH_PITCH;
#pragma unroll
    for (int s = 0; s < 16; ++s) {
        if ((s & 3) == 0) asm volatile("" ::: "memory");
        const float* gp = g + col0 + 32 * s; const float* bp = b + col0 + 32 * s;
        const f32x4 g0 = *(const f32x4*)gp, g1 = *(const f32x4*)(gp + 4), b0 = *(const f32x4*)bp, b1 = *(const f32x4*)(bp + 4);
        const f32x4 v0 = (XLO(s) - mean) * rstd * g0 + b0, v1 = (XHI(s) - mean) * rstd * g1 + b1;
        const float vv[8] = {v0.x, v0.y, v0.z, v0.w, v1.x, v1.y, v1.z, v1.w};
        unsigned hi[8], lo[8];
#pragma unroll
        for (int j = 0; j < 8; ++j) { hi[j] = f2bf(vv[j]); lo[j] = f2bf(vv[j] - __builtin_bit_cast(float, hi[j] << 16)); }
        v4u hw, lw;
#pragma unroll
        for (int j = 0; j < 4; ++j) { hw[j] = hi[2 * j] | (hi[2 * j + 1] << 16); lw[j] = lo[2 * j] | (lo[2 * j + 1] << 16); }
        *(v4u*)(Xb + (size_t)row * D + col0 + 32 * s) = hw;
        const bf16x8v ah = __builtin_bit_cast(bf16x8v, hw), al = __builtin_bit_cast(bf16x8v, lw);
        const bf16x8v w0h = *(const LAS bf16x8v*)(wb + 64 * s), w0l = *(const LAS bf16x8v*)(wb + LO + 64 * s);
        const bf16x8v w1h = *(const LAS bf16x8v*)(wb + 16 * RWH_PITCH + 64 * s), w1l = *(const LAS bf16x8v*)(wb + 16 * RWH_PITCH + LO + 64 * s);
        const bf16x8v w2h = *(const LAS bf16x8v*)(wb2 + 64 * s), w2l = *(const LAS bf16x8v*)(wb2 + LO + 64 * s);
        acc0 = __builtin_amdgcn_mfma_f32_16x16x32_bf16(ah, w0h, acc0, 0, 0, 0); acc0 = __builtin_amdgcn_mfma_f32_16x16x32_bf16(al, w0h, acc0, 0, 0, 0); acc0 = __builtin_amdgcn_mfma_f32_16x16x32_bf16(ah, w0l, acc0, 0, 0, 0);
        acc1 = __builtin_amdgcn_mfma_f32_16x16x32_bf16(ah, w1h, acc1, 0, 0, 0); acc1 = __builtin_amdgcn_mfma_f32_16x16x32_bf16(al, w1h, acc1, 0, 0, 0); acc1 = __builtin_amdgcn_mfma_f32_16x16x32_bf16(ah, w1l, acc1, 0, 0, 0);
        acc2 = __builtin_amdgcn_mfma_f32_16x16x32_bf16(ah, w2h, acc2, 0, 0, 0); acc2 = __builtin_amdgcn_mfma_f32_16x16x32_bf16(al, w2h, acc2, 0, 0, 0); acc2 = __builtin_amdgcn_mfma_f32_16x16x32_bf16(ah, w2l, acc2, 0, 0, 0);
    }
    __syncthreads();
#undef XLO
#undef XHI
#pragma unroll
    for (int r = 0; r < 4; ++r) { LAS float* pr = part + (size_t)(wave * 16 + 4 * kq + r) * 48 + (lane & 15); pr[0] = acc0[r]; pr[16] = acc1[r]; pr[32] = acc2[r]; }
    LAS int* rt_e = (LAS int*)(part + 8 * 16 * 48);
    LAS float* rt_g = (LAS float*)(rt_e + 128);
    LAS int* rt_base = (LAS int*)(rt_g + 128);
    __syncthreads();
    if (tid < 64) {
        const int gq = tid >> 4, ii = tid & 15; const LAS float* p0 = part + (size_t)((2 * gq) * 16 + ii) * 48; const LAS float* p1 = p0 + 16 * 48;
        int gi = 0; float gm = -INFINITY, gl[NG];
#pragma unroll
        for (int n = 0; n < NG; ++n) { gl[n] = p0[n] + p1[n] + rgb[n]; if (gl[n] > gm) { gm = gl[n]; gi = n; } }
        float gs = 0.f;
#pragma unroll
        for (int n = 0; n < NG; ++n) gs += __expf(gl[n] - gm);
        const float gtop = 1.0f / gs;
        float m0 = -INFINITY, m1 = -INFINITY; int i0 = 0, i1 = 0;
        for (int n = 0; n < EPG; ++n) { const int c = NG + gi * EPG + n; const float e = p0[c] + p1[c] + reb[gi * EPG + n];
            if (e > m0) { m1 = m0; i1 = i0; m0 = e; i0 = n; } else if (e > m1) { m1 = e; i1 = n; } }
        const float e1 = __expf(m1 - m0), w0 = 1.0f / (1.0f + e1), w1 = e1 * w0;
        rt_e[2 * tid] = gi * EPG + i0; rt_e[2 * tid + 1] = gi * EPG + i1; rt_g[2 * tid] = gtop * w0; rt_g[2 * tid + 1] = gtop * w1;
    }
    __syncthreads();
    if (rep == 0) {
        if (tid < NE) { int c = 0; for (int q = 0; q < 128; ++q) c += (rt_e[q] == tid) ? 1 : 0; rt_base[tid] = c ? atomicAdd(&cnt[tid * CNT_STRIDE], c) : 0; }
        __syncthreads();
        if (tid < 128) { const int e = rt_e[tid]; int rank = 0; for (int q = 0; q < tid; ++q) rank += (rt_e[q] == e) ? 1 : 0;
            const int pair = 2 * (cx.bx * 64 + (tid >> 1)) + (tid & 1);
            perm[e * CAP + rt_base[e] + rank] = (v2u){__builtin_bit_cast(unsigned, rt_g[tid]), (unsigned)pair}; }
    }
}
__device__ __forceinline__ void ln_router_phase(LAS unsigned char* lds, int layer, int rep = 0) {
    const ArgsP a = kargs(); const Ctx cx = mkctx(a); const int gw = cx.gw, NGW = cx.NGW, lane = cx.lane;
    unsigned char* ws = cx.ws;
    const bf16* Z = (const bf16*)(ws + LZ(layer)); bf16* Xb = (bf16*)(ws + (layer == 0 ? WS_X1B : WS_X3B));
    const float* g = a->ln1_g + layer * D; const float* b = a->ln1_b + layer * D;
    const float* rgb = a->rg_b + layer * NG; const float* reb = a->re_b + layer * NE;
    int* cnt = (int*)(ws + WS_CTL) + layer * NE * CNT_STRIDE; v2u* perm = (v2u*)(ws + LPERM(layer));
    LAS f32x4* wl = (LAS f32x4*)lds;
    { const f32x4* wg = (const f32x4*)((const float*)(ws + WS_RWT) + (size_t)layer * NRW * D);
      for (int i = cx.tid; i < NRW * D / 4; i += NTHREADS) wl[i] = wg[i]; }
    f32x4 gg[4], bb[4];
#pragma unroll
    for (int j = 0; j < 4; ++j) { gg[j] = *(const f32x4*)(g + 256 * j + 4 * lane); bb[j] = *(const f32x4*)(b + 256 * j + 4 * lane); }
    constexpr int RPW = 16;
    LAS int* rt_row = (LAS int*)(lds + MISC_OFF + 2048);
    LAS int* rt_e = rt_row + NWAVES * RPW;
    LAS float* rt_g = (LAS float*)(rt_e + 2 * NWAVES * RPW);
    LAS int* rt_base = (LAS int*)(rt_g + 2 * NWAVES * RPW);
    LAS int* wave_rows = rt_base + NE;
    f32x4 nv[2][4];
#pragma unroll
    for (int r = 0; r < 2; ++r) { const int row = gw + r * NGW;
        if (row < T) {
#pragma unroll
            for (int j = 0; j < 4; ++j) nv[r][j] = ldz4(Z + (size_t)row * D + 256 * j + 4 * lane);
        } }
    __syncthreads();
    int it = 0;
#pragma unroll 1
    for (int row0 = gw; row0 < T && it < RPW; row0 += 2 * NGW, it += 2) {
        const bool two = row0 + NGW < T;
        f32x4 v[2][4];
#pragma unroll
        for (int r = 0; r < 2; ++r)
#pragma unroll
            for (int j = 0; j < 4; ++j) v[r][j] = nv[r][j];
#pragma unroll
        for (int r = 0; r < 2; ++r) { const int row = row0 + (2 + r) * NGW;
            if (row < T) {
#pragma unroll
                for (int j = 0; j < 4; ++j) nv[r][j] = ldz4(Z + (size_t)row * D + 256 * j + 4 * lane);
            } }
        if (!two) {
#pragma unroll
            for (int j = 0; j < 4; ++j) v[1][j] = v[0][j];
        }
        float s1[2];
#pragma unroll
        for (int r = 0; r < 2; ++r) { float s = 0.f;
#pragma unroll
            for (int j = 0; j < 4; ++j) s += (v[r][j].x + v[r][j].y) + (v[r][j].z + v[r][j].w);
            s1[r] = s; }
        dpp_sum(s1);
        float s2[2];
#pragma unroll
        for (int r = 0; r < 2; ++r) { const float mean = s1[r] * (1.f / D); float q = 0.f;
#pragma unroll
            for (int j = 0; j < 4; ++j) { v[r][j] = v[r][j] - mean; q += (v[r][j].x * v[r][j].x + v[r][j].y * v[r][j].y) + (v[r][j].z * v[r][j].z + v[r][j].w * v[r][j].w); }
            s2[r] = q; }
        dpp_sum(s2);
#pragma unroll
        for (int r = 0; r < 2; ++r) { const float rstd = 1.f / sqrtf(s2[r] * (1.f / D) + LN_EPS);
#pragma unroll
            for (int j = 0; j < 4; ++j) v[r][j] = v[r][j] * rstd * gg[j] + bb[j]; }
#pragma unroll
        for (int r = 0; r < 2; ++r) { const int row = row0 + r * NGW;
            if (r == 0 || two) {
#pragma unroll
                for (int j = 0; j < 4; ++j) { v2u w; w.x = pk2(v[r][j].x, v[r][j].y); w.y = pk2(v[r][j].z, v[r][j].w); *(v2u*)(Xb + (size_t)row * D + 256 * j + 4 * lane) = w; }
            } }
        float gl[2 * NG];
#pragma unroll
        for (int r = 0; r < 2; ++r)
#pragma unroll
            for (int n = 0; n < NG; ++n) gl[r * NG + n] = dot_lds(v[r], wl + n * (D / 4), lane);
        dpp_sum(gl);
        int gi[2]; float gtop[2];
#pragma unroll
        for (int r = 0; r < 2; ++r) { int g_ = 0; float gm = -INFINITY;
#pragma unroll
            for (int n = 0; n < NG; ++n) { gl[r * NG + n] += rgb[n]; if (gl[r * NG + n] > gm) { gm = gl[r * NG + n]; g_ = n; } }
            float gs = 0.f;
#pragma unroll
            for (int n = 0; n < NG; ++n) gs += __expf(gl[r * NG + n] - gm);
            gi[r] = g_; gtop[r] = 1.0f / gs; }
        float el[2 * EPG];
#pragma unroll
        for (int r = 0; r < 2; ++r)
#pragma unroll
            for (int n = 0; n < EPG; ++n) el[r * EPG + n] = dot_lds(v[r], wl + (NG + gi[r] * EPG + n) * (D / 4), lane);
        dpp_sum(el);
#pragma unroll
        for (int r = 0; r < 2; ++r) {
            float m0 = -INFINITY, m1 = -INFINITY; int i0 = 0, i1 = 0;
#pragma unroll
            for (int n = 0; n < EPG; ++n) { const float e = el[r * EPG + n] + reb[gi[r] * EPG + n];
                if (e > m0) { m1 = m0; i1 = i0; m0 = e; i0 = n; } else if (e > m1) { m1 = e; i1 = n; } }
            const float e1 = __expf(m1 - m0), w0 = 1.0f / (1.0f + e1), w1 = e1 * w0;
            if (lane == 0 && (r == 0 || two)) {
                const int li = cx.wave * RPW + it + r;
                rt_row[li] = row0 + r * NGW; rt_e[2 * li] = gi[r] * EPG + i0; rt_e[2 * li + 1] = gi[r] * EPG + i1; rt_g[2 * li] = gtop[r] * w0; rt_g[2 * li + 1] = gtop[r] * w1;
            }
        }
        if (!two) { it += 1; break; }
    }
    if (lane == 0) wave_rows[cx.wave] = it;
    __syncthreads();
    if (rep == 0) {
        if (cx.tid < NE) { int c = 0;
            for (int w = 0; w < NWAVES; ++w) { const int n = wave_rows[w]; for (int i = 0; i < 2 * n; ++i) c += (rt_e[2 * (w * RPW) + i] == cx.tid) ? 1 : 0; }
            rt_base[cx.tid] = c ? atomicAdd(&cnt[cx.tid * CNT_STRIDE], c) : 0; }
        __syncthreads();
        if (cx.tid < 2 * NWAVES * RPW) { const int w = cx.tid / (2 * RPW), i = cx.tid % (2 * RPW);
            if (i < 2 * wave_rows[w]) { const int e = rt_e[cx.tid]; int rank = 0;
                for (int w2 = 0; w2 <= w; ++w2) { const int lim = (w2 < w) ? 2 * wave_rows[w2] : i; for (int q = 0; q < lim; ++q) rank += (rt_e[2 * (w2 * RPW) + q] == e) ? 1 : 0; }
                const int pair = 2 * rt_row[cx.tid >> 1] + (cx.tid & 1);
                perm[e * CAP + rt_base[e] + rank] = (v2u){__builtin_bit_cast(unsigned, rt_g[cx.tid]), (unsigned)pair}; } }
    }
}
__device__ __forceinline__ void ln2_phase(int layer) {
    const ArgsP a = kargs(); const Ctx cx = mkctx(a); const int gw = cx.gw, NGW = cx.NGW, lane = cx.lane;
    unsigned char* ws = cx.ws;
    const bf16* Xin = (const bf16*)(ws + (layer == 0 ? WS_X1B : WS_X3B)); const bf16* YP = (const bf16*)(ws + LYP(layer));
    const float* g = a->ln2_g + layer * D; const float* b = a->ln2_b + layer * D;
    f32x4 gg[4], bb[4];
#pragma unroll
    for (int j = 0; j < 4; ++j) { gg[j] = *(const f32x4*)(g + 256 * j + 4 * lane); bb[j] = *(const f32x4*)(b + 256 * j + 4 * lane); }
    v2u nx[4], ny0[4], ny1[4];
    if (gw < T) {
#pragma unroll
        for (int j = 0; j < 4; ++j) { const size_t c = 256 * j + 4 * lane;
            nx[j] = *(const v2u*)(Xin + (size_t)gw * D + c); ny0[j] = *(const v2u*)(YP + (size_t)(2 * gw) * D + c); ny1[j] = *(const v2u*)(YP + (size_t)(2 * gw + 1) * D + c); }
    }
#pragma unroll 1
    for (int row = gw; row < T; row += NGW) {
        f32x4 v[4];
#pragma unroll
        for (int j = 0; j < 4; ++j) { const v2u xw = nx[j], y0 = ny0[j], y1 = ny1[j];
            v[j].x = ALPHA * bflo(xw.x) + (bflo(y0.x) + bflo(y1.x)); v[j].y = ALPHA * bfhi(xw.x) + (bfhi(y0.x) + bfhi(y1.x));
            v[j].z = ALPHA * bflo(xw.y) + (bflo(y0.y) + bflo(y1.y)); v[j].w = ALPHA * bfhi(xw.y) + (bfhi(y0.y) + bfhi(y1.y)); }
        if (row + NGW < T) { const int r2 = row + NGW;
#pragma unroll
            for (int j = 0; j < 4; ++j) { const size_t c = 256 * j + 4 * lane;
                nx[j] = *(const v2u*)(Xin + (size_t)r2 * D + c); ny0[j] = *(const v2u*)(YP + (size_t)(2 * r2) * D + c); ny1[j] = *(const v2u*)(YP + (size_t)(2 * r2 + 1) * D + c); }
        }
        ln_rows(v, gg, bb);
        if (layer == 0) {
#pragma unroll
            for (int j = 0; j < 4; ++j) { v2u w; w.x = pk2(v[j].x, v[j].y); w.y = pk2(v[j].z, v[j].w); *(v2u*)((bf16*)(ws + WS_X2B) + (size_t)row * D + 256 * j + 4 * lane) = w; }
        } else {
#pragma unroll
            for (int j = 0; j < 4; ++j) *(f32x4*)(a->out + (size_t)row * D + 256 * j + 4 * lane) = v[j];
        }
    }
}
__device__ __forceinline__ void conv_phase() {
    const ArgsP a = kargs(); const Ctx cx = mkctx(a); const int gtid = cx.bx * NTHREADS + cx.tid, NGT = cx.G * NTHREADS;
    unsigned char* ws = cx.ws;
    const bf16* GB = (const bf16*)(ws + WS_GB); const bf16* U = (const bf16*)(ws + WS_U); bf16* A2 = (bf16*)(ws + WS_A2);
    for (int it = gtid; it < T * (D / 8); it += NGT) {
        const int t = it >> 7, d0 = (it & 127) * 8, s = t & (SEQ - 1);
        const size_t o = (size_t)t * D + d0;
        const v4u g = *(const v4u*)(GB + o), u0 = *(const v4u*)(U + o);
        v4u u1 = (v4u){0u, 0u, 0u, 0u}, u2 = u1;
        if (s >= 1) u1 = *(const v4u*)(U + o - D);
        if (s >= 2) u2 = *(const v4u*)(U + o - 2 * D);
        v4u r;
#pragma unroll
        for (int q = 0; q < 4; ++q) {
            const int d = d0 + 2 * q;
            const float c0 = a->a_conv_w[d] * bflo(u2[q]) + a->a_conv_w[D + d] * bflo(u1[q]) + a->a_conv_w[2 * D + d] * bflo(u0[q]);
            const float c1 = a->a_conv_w[d + 1] * bfhi(u2[q]) + a->a_conv_w[D + d + 1] * bfhi(u1[q]) + a->a_conv_w[2 * D + d + 1] * bfhi(u0[q]);
            r[q] = pk2(bflo(g[q]) * c0, bfhi(g[q]) * c1);
        }
        *(v4u*)(A2 + o) = r;
    }
}
__device__ __forceinline__ void combine_phase() {
    const ArgsP a = kargs(); const Ctx cx = mkctx(a); const int gw = cx.gw, NGW = cx.NGW, lane = cx.lane;
    unsigned char* ws = cx.ws;
    const bf16* O0 = (const bf16*)(ws + WS_O0); const bf16* O1 = (const bf16*)(ws + WS_O1); bf16* A3 = (bf16*)(ws + WS_A3);
    const float l01 = wave_sum(a->b_lambda[lane] * a->b_lambda[64 + lane]), l23 = wave_sum(a->b_lambda[128 + lane] * a->b_lambda[192 + lane]);
    const float lam = __expf(l01) - __expf(l23) + LAM_INIT;
    float gsc[16];
#pragma unroll
    for (int i = 0; i < 16; ++i) gsc[i] = a->b_subln_g[(lane & 7) * 16 + i] * (1.0f - LAM_INIT);
    for (int row = gw; row < T; row += NGW) {
        const size_t o = (size_t)row * D + lane * 16;
        const v4u p0 = *(const v4u*)(O0 + o), p1 = *(const v4u*)(O0 + o + 8), q0 = *(const v4u*)(O1 + o), q1 = *(const v4u*)(O1 + o + 8);
        float d[16]; float ss = 0.f;
#pragma unroll
        for (int i = 0; i < 4; ++i) { d[2 * i] = bflo(p0[i]) - lam * bflo(q0[i]); d[2 * i + 1] = bfhi(p0[i]) - lam * bfhi(q0[i]);
            d[8 + 2 * i] = bflo(p1[i]) - lam * bflo(q1[i]); d[8 + 2 * i + 1] = bfhi(p1[i]) - lam * bfhi(q1[i]); }
#pragma unroll
        for (int i = 0; i < 16; ++i) ss += d[i] * d[i];
        ss += __shfl_xor(ss, 1); ss += __shfl_xor(ss, 2); ss += __shfl_xor(ss, 4);
        const float r = 1.0f / sqrtf(ss * (1.0f / 128.0f) + RMS_EPS);
        v4u w0, w1;
#pragma unroll
        for (int i = 0; i < 4; ++i) { w0[i] = pk2(d[2 * i] * r * gsc[2 * i], d[2 * i + 1] * r * gsc[2 * i + 1]); w1[i] = pk2(d[8 + 2 * i] * r * gsc[8 + 2 * i], d[8 + 2 * i + 1] * r * gsc[8 + 2 * i + 1]); }
        *(v4u*)(A3 + o) = w0; *(v4u*)(A3 + o + 8) = w1;
    }
}

#ifndef MKMASK
#define MKMASK 0xffff
#endif
#ifndef MKREP
#define MKREP 0
#endif
#ifndef MKSYNC
#define MKSYNC 0
#endif
#ifndef MKMASK2
#define MKMASK2 MKMASK
#endif
#define PH(k) _Pragma("unroll 1") for (int rep_ = 0; rep_ < (int)(((pass_ ? MKMASK2 : MKMASK) >> (k)) & 1) + (int)((MKREP >> (k)) & 1); ++rep_)
#define XB_TMO      128
#define XB_XCNT(j)  (256  + 64 * (j))
#define XB_XSUB(j)  (1280 + 64 * (j))
#define XB_XGEN(j)  (2304 + 64 * (j))
#define XB_TOP      3328
#define XB_TOPGEN   3392
#define XCD_BAR_WORDS 3456
#define XB_SPIN_CAP (1u << 18)

__device__ __forceinline__ unsigned xb_ld(unsigned* p)              { return __hip_atomic_load(p, __ATOMIC_RELAXED, __HIP_MEMORY_SCOPE_AGENT); }
__device__ __forceinline__ unsigned xb_add(unsigned* p, unsigned v) { return __hip_atomic_fetch_add(p, v, __ATOMIC_RELAXED, __HIP_MEMORY_SCOPE_AGENT); }
__device__ __forceinline__ unsigned xb_xcc_id() { return (unsigned)__builtin_amdgcn_s_getreg((3 << 11) | 20) & 0xFu; }
#define XB_SPIN(cond, bar) do { unsigned _sp = 0; while (cond) { __builtin_amdgcn_s_sleep(1); \
    if ((++_sp & 255u) == 0u) { if (xb_ld(&(bar)[XB_TMO])) break; if (_sp > XB_SPIN_CAP) { atomicAdd(&(bar)[XB_TMO], 1u); break; } } } } while (0)

struct XcdBarrier {
    unsigned* bar; unsigned x;
    volatile LAS unsigned* st;
};

__device__ __forceinline__ XcdBarrier xcd_barrier_post(unsigned* bar, volatile LAS unsigned* st) {
    XcdBarrier b; b.bar = bar; b.x = xb_xcc_id(); b.st = st;
    if (threadIdx.x == 0) (void)xb_add(&bar[XB_XCNT(b.x)], 1u);
    return b;
}
__device__ __forceinline__ void xcd_barrier_complete(unsigned* bar, unsigned x, unsigned& nloc, unsigned& nx) {
    const unsigned G = gridDim.x * gridDim.y * gridDim.z;
    unsigned sum, cnt, mine, sp = 0u;
    for (;;) {
        sum = 0u; cnt = 0u; mine = 0u;
#pragma unroll
        for (unsigned j = 0; j < 16; ++j) { const unsigned c = xb_ld(&bar[XB_XCNT(j)]); sum += c; cnt += (c > 0u) ? 1u : 0u; mine = (j == x) ? c : mine; }
        if (sum == G) break;
        __builtin_amdgcn_s_sleep(1);
        if ((++sp & 255u) == 0u) { if (xb_ld(&bar[XB_TMO])) break; if (sp > XB_SPIN_CAP) { atomicAdd(&bar[XB_TMO], 1u); break; } }
    }
    nloc = mine > 0u ? mine : 1u; nx = cnt > 0u ? cnt : 1u;
}

__device__ __forceinline__ void xcd_barrier(const XcdBarrier& b) {
    asm volatile("s_waitcnt vmcnt(0)" ::: "memory");
    __syncthreads();
    if (threadIdx.x == 0) {
        unsigned* bar = b.bar;
        __builtin_amdgcn_s_waitcnt(0);
        unsigned nloc = b.st[0], nx = b.st[1];
        if (nloc == 0u) { xcd_barrier_complete(bar, b.x, nloc, nx); b.st[0] = nloc; b.st[1] = nx; }
        const unsigned old = xb_add(&bar[XB_XSUB(b.x)], 1u);
        const unsigned gen = old / nloc;
        if (old + 1u == (gen + 1u) * nloc) {
            __builtin_amdgcn_fence(__ATOMIC_RELEASE, "agent");
            asm volatile("s_waitcnt vmcnt(0)" ::: "memory");
            const unsigned og = xb_add(&bar[XB_TOP], 1u);
            const unsigned tg = og / nx;
            if (og + 1u == (tg + 1u) * nx) xb_add(&bar[XB_TOPGEN], 1u);
            else XB_SPIN(xb_ld(&bar[XB_TOPGEN]) == tg, bar);
            __builtin_amdgcn_fence(__ATOMIC_ACQUIRE, "agent");
            xb_add(&bar[XB_XGEN(b.x)], 1u);
            asm volatile("s_waitcnt vmcnt(0)" ::: "memory");
        } else {
            XB_SPIN(xb_ld(&bar[XB_XGEN(b.x)]) == gen, bar);
            __builtin_amdgcn_fence(__ATOMIC_ACQUIRE, "agent");
            asm volatile("s_waitcnt vmcnt(0)" ::: "memory");
        }
    }
    __syncthreads();
}

constexpr int CW_BAR = 16384;
constexpr int ST_OFF = MISC_OFF + 1024;
__device__ __forceinline__ void seam(LAS unsigned char* lds) { const ArgsP a = kargs(); XcdBarrier b; b.bar = (unsigned*)(a->ws + WS_CTL) + CW_BAR; b.x = xb_xcc_id(); b.st = (volatile LAS unsigned*)(lds + ST_OFF); xcd_barrier(b); }
__device__ __forceinline__ void gemm1_phase(LAS unsigned char* lds) { const ArgsP a = kargs(); const Ctx cx = mkctx(a); unsigned char* ws = cx.ws;
    const int ng = ROLE_SPLIT ? cx.G - cx.G / 4 : cx.G;
    if (cx.bx < ng) { SchedDense S{ng, cx.bx, 12, 0, D, (const char*)(ws + WS_W1T)}; EpiConvIn E{(bf16*)(ws + WS_GB), (bf16*)(ws + WS_U)};
        pg8::gemm_phase(lds, (const char*)(ws + WS_XB), D, S, E); }
    else p0_items(lds, PS1 + P0A_EXTRA, P0_NITEMS, (cx.bx - ng) * NWAVES + cx.wave, (cx.G - ng) * NWAVES); }
__device__ __forceinline__ void gemm2_phase(LAS unsigned char* lds) { const ArgsP a = kargs(); const Ctx cx = mkctx(a); unsigned char* ws = cx.ws;
    SchedDense S{cx.G, cx.bx, 4, 1, D, (const char*)(ws + WS_W2T)}; EpiResZ<true> E{(const void*)(ws + WS_XB), (bf16*)(ws + LZ(0))};
    pg8::gemm_phase(lds, (const char*)(ws + WS_A2), D, S, E); }
__device__ __forceinline__ void kvq_phase(LAS unsigned char* lds) { const ArgsP a = kargs(); const Ctx cx = mkctx(a); unsigned char* ws = cx.ws;
    SchedDense S{cx.G, cx.bx, 12, 1, D, (const char*)(ws + WS_WKVQ)}; EpiKVQ E{(bf16*)(ws + WS_K)};
    pg8::gemm_phase(lds, (const char*)(ws + WS_X2B), D, S, E); }
__device__ __forceinline__ void wo_phase(LAS unsigned char* lds) { const ArgsP a = kargs(); const Ctx cx = mkctx(a); unsigned char* ws = cx.ws;
    SchedDense S{cx.G, cx.bx, 4, 1, D, (const char*)(ws + WS_WOT)}; EpiResZ<true> E{(const void*)(ws + WS_X2B), (bf16*)(ws + LZ(1))};
    pg8::gemm_phase(lds, (const char*)(ws + WS_A3), D, S, E); }
#ifndef ATTN128
#define ATTN128 1
#endif
#if ATTN128
__device__ __forceinline__ void attn_phase(char* lds_generic) { const ArgsP a = kargs(); const Ctx cx = mkctx(a); unsigned char* ws = cx.ws;
#pragma unroll 1
    for (int uix = cx.bx; uix < BATCH * NH * 2 * (SEQ / 256); uix += cx.G) {
        const int combo = (uix & 255) >> 1, par = uix & 1, qi = uix >> 8;
        const int b = combo >> 4, h = (combo >> 1) & 7, c = combo & 1;
        const int qb = par == 0 ? (qi == 0 ? 0 : qi == 1 ? 7 : qi == 2 ? 2 : 5) : (qi == 0 ? 1 : qi == 1 ? 6 : qi == 2 ? 3 : 4);
        const attn128::bf16* QK = (const attn128::bf16*)(ws + WS_K) + h * 128 + c * 64;
        const attn128::bf16* Vc = (const attn128::bf16*)(ws + WS_V) + h * 128;
        attn128::bf16* Oc = (attn128::bf16*)(ws + (c ? WS_O1 : WS_O0)) + h * 128;
        attn128::attn_unit<8>((long)b * SEQ, qb, QK + (WS_Q - WS_K) / 2, QK, Vc, Oc, lds_generic);
    }
}
#else
__device__ __forceinline__ void attn_phase(char* lds_generic) { const ArgsP a = kargs(); const Ctx cx = mkctx(a); unsigned char* ws = cx.ws;
#pragma unroll 1
    for (int uix = cx.bx; uix < BATCH * NH * 4 * (SEQ / 256); uix += cx.G) {
        const int combo = uix & 255, qi = uix >> 8;
        const int b = combo >> 5, h = (combo >> 2) & 7, c = (combo >> 1) & 1, vh = combo & 1;
        const int qb = (qi & 1) ? (SEQ / 256 - 1 - (qi >> 1)) : (qi >> 1);
        const attn_body::bf16* QK = (const attn_body::bf16*)(ws + WS_K) + h * 128 + c * 64;
        const attn_body::bf16* Vc = (const attn_body::bf16*)(ws + WS_V) + h * 128 + vh * 64;
        attn_body::bf16* Oc = (attn_body::bf16*)(ws + (c ? WS_O1 : WS_O0)) + h * 128 + vh * 64;
        attn_body::attn_unit<8>((long)b * SEQ, qb, QK + (WS_Q - WS_K) / 2, QK, Vc, Oc, lds_generic);
    }
}
#endif
__device__ __forceinline__ void moe_tables(LAS unsigned char* lds, int layer) { const ArgsP a = kargs(); const Ctx cx = mkctx(a); LAS int* misc = (LAS int*)(lds + MISC_OFF);
    const int* cnt = (const int*)(cx.ws + WS_CTL) + layer * NE * CNT_STRIDE;
    if (cx.tid < NE) misc[128 + cx.tid] = __hip_atomic_load(cnt + cx.tid * CNT_STRIDE, __ATOMIC_RELAXED, __HIP_MEMORY_SCOPE_AGENT);
    __syncthreads();
    if (cx.tid == 0) { int ub = 0, ps = 0; for (int e = 0; e < NE; ++e) { misc[e] = ub; misc[192 + e] = ps; const int cn = misc[128 + e], rt = (cn + 255) >> 8, half = (cn > 0 && ((cn - 1) & 255) < 128) ? 1 : 0; ub += 4 * (rt - half); ps += 256 * rt; }
        misc[192 + NE] = ps;
        for (int e = 0; e < NE; ++e) { misc[NE + e] = ub; const int cn = misc[128 + e]; ub += (cn > 0 && ((cn - 1) & 255) < 128) ? 4 : 0; } misc[2 * NE] = ub; }
    __syncthreads(); }
constexpr int CW_READY = 4096;
__device__ __forceinline__ void moe_up_phase(LAS unsigned char* lds, int layer, bool merged) { const ArgsP a = kargs(); const Ctx cx = mkctx(a); unsigned char* ws = cx.ws; LAS int* misc = (LAS int*)(lds + MISC_OFF);
    const MoeTab tb{misc, misc + 192, misc + 128};
    SchedMoe S{cx.G, cx.bx, D, true, (const char*)(ws + WS_WUT) + (size_t)layer * NE * D * D * 2, (const v2u*)(ws + LPERM(layer)), tb, (unsigned*)(ws + WS_CTL) + CW_READY, merged ? 1 : 0, 0, 0};
    if (merged) { EpiUp<true> E{(bf16*)(ws + LACT(layer))}; pg8::gemm_phase(lds, (const char*)(ws + (layer == 0 ? WS_X1B : WS_X3B)), D, S, E); }
    else { EpiUp<false> E{(bf16*)(ws + LACT(layer))}; pg8::gemm_phase(lds, (const char*)(ws + (layer == 0 ? WS_X1B : WS_X3B)), D, S, E); } }
__device__ __forceinline__ void moe_down_phase(LAS unsigned char* lds, int layer, bool merged) { const ArgsP a = kargs(); const Ctx cx = mkctx(a); unsigned char* ws = cx.ws; LAS int* misc = (LAS int*)(lds + MISC_OFF);
    const MoeTab tb{misc, misc + 192, misc + 128};
    int nb = 0;
    if (merged) { const int U = misc[2 * NE], rem = U % cx.G; nb = rem ? cx.G - rem : 0; }
    SchedMoe S{cx.G, cx.bx, DE, false, (const char*)(ws + WS_WDT) + (size_t)layer * NE * D * DE * 2, (const v2u*)(ws + LPERM(layer)), tb, (unsigned*)(ws + WS_CTL) + CW_READY, merged ? 2 : 0, 0, nb};
    EpiDown E{(bf16*)(ws + LYP(layer)), (const v2u*)(ws + LPERM(layer))};
    pg8::gemm_phase(lds, (const char*)(ws + LACT(layer)), DE, S, E); }

__global__ void __launch_bounds__(NTHREADS, 2) fwd_megakernel(Args args_unused) {
    extern __shared__ __attribute__((aligned(16))) unsigned char lds_raw[];
#ifdef NOSYNC
    struct { __device__ void sync() const {} } grid;
#else
    cg::grid_group grid = cg::this_grid();
#endif
#define SEAM() seam(lds)
    LAS unsigned char* lds = (LAS unsigned char*)lds_raw;
#ifndef MKPASS
#define MKPASS 1
#endif
    { const ArgsP a = kargs(); int t = threadIdx.x; asm volatile("" : "+v"(t));
      if (t < 2) ((volatile LAS unsigned*)(lds + ST_OFF))[t] = 0u;
      __syncthreads();
      (void)xcd_barrier_post((unsigned*)(a->ws + WS_CTL) + CW_BAR, (volatile LAS unsigned*)(lds + ST_OFF));
      if (a->ws == nullptr) grid.sync(); }
#pragma unroll 1
    for (int pass_ = 0; pass_ < MKPASS; ++pass_) {
    if (pass_) SEAM();
    PH(0) p0_prologue(lds);
    SEAM();
    PH(1) gemm1_phase(lds);
    SEAM();
    PH(2) conv_phase();
    SEAM();
    PH(3) gemm2_phase(lds);
    SEAM();
    PH(8) ln_router_mfma(lds, 0, rep_ + pass_);
    SEAM();
    moe_tables(lds, 0);
    PH(9) { moe_up_phase(lds, 0, false); if (P0B_FILL && pass_ == 0) p0b_idle_fill(lds, 0, P0B_SPLIT); }
    SEAM();
    PH(10) { moe_down_phase(lds, 0, false); if (P0B_FILL && pass_ == 0) p0b_idle_fill(lds, P0B_SPLIT, P0B_ITEMS); }
    SEAM();
    PH(11) ln2_phase(0);
    SEAM();
    PH(4) kvq_phase(lds);
    SEAM();
    PH(5) attn_phase((char*)lds_raw);
    SEAM();
    PH(6) combine_phase();
    SEAM();
    PH(7) wo_phase(lds);
    SEAM();
    PH(8) ln_router_mfma(lds, 1, rep_ + pass_);
    SEAM();
    moe_tables(lds, 1);
#if MOE_MERGE
    PH(9) moe_up_phase(lds, 1, pass_ == 0);
    if (pass_) SEAM();
    PH(10) moe_down_phase(lds, 1, pass_ == 0);
#else
    PH(9) moe_up_phase(lds, 1, false);
    SEAM();
    PH(10) moe_down_phase(lds, 1, false);
#endif
    SEAM();
    PH(11) ln2_phase(1);
    }
#pragma unroll 1
    for (int i = 0; i < MKSYNC; ++i) SEAM();
}
}

extern "C" void kernel_launch(void* const* d_in, const int* in_sizes, int n_in, void* d_out, int out_size, void* d_ws, size_t ws_size, hipStream_t stream) {
    using namespace mk;
    static int grid = 0;
    if (grid == 0) {
        if (n_in != 19 || out_size != T * D || ws_size < WS_END) { fprintf(stderr, "kernel_launch: unexpected shapes / workspace (n_in %d out %d ws %zu, need %zu)\n", n_in, out_size, ws_size, (size_t)WS_END); grid = -1; return; }
        int dev = 0, cus = 0, per_cu = 0;
        (void)hipGetDevice(&dev); (void)hipDeviceGetAttribute(&cus, hipDeviceAttributeMultiprocessorCount, dev);
        if (hipFuncSetAttribute((const void*)fwd_megakernel, hipFuncAttributeMaxDynamicSharedMemorySize, LDS_BYTES) != hipSuccess) { fprintf(stderr, "kernel_launch: hipFuncSetAttribute failed\n"); grid = -1; return; }
        if (hipOccupancyMaxActiveBlocksPerMultiprocessor(&per_cu, (const void*)fwd_megakernel, NTHREADS, LDS_BYTES) != hipSuccess || per_cu < 1) { fprintf(stderr, "kernel_launch: occupancy query says %d blocks per CU\n", per_cu); grid = -1; return; }
        grid = cus * 1;
        if (grid != T / 64) { fprintf(stderr, "kernel_launch: this build needs exactly %d workgroups (one per CU of a 256-CU MI355X: the LN1 + router phase gives each 64 rows); device has %d CUs\n", T / 64, cus); grid = -1; return; }
        (void)hipGetLastError();
    }
    if (grid < 0) return;
    if (hipMemsetAsync((char*)d_ws + WS_CTL, 0, (size_t)(CW_BAR + XCD_BAR_WORDS) * 4, stream) != hipSuccess) { fprintf(stderr, "kernel_launch: hipMemsetAsync of the control words failed\n"); return; }
    Args a{};
    a.x = (const float*)d_in[0]; a.a_w_in = (const float*)d_in[1]; a.a_conv_w = (const float*)d_in[2]; a.a_w_out = (const float*)d_in[3]; a.kv_w = (const float*)d_in[4];
    a.b_w_q = (const float*)d_in[5]; a.b_lambda = (const float*)d_in[6]; a.b_subln_g = (const float*)d_in[7]; a.b_w_o = (const float*)d_in[8];
    a.ln1_g = (const float*)d_in[9]; a.ln1_b = (const float*)d_in[10]; a.ln2_g = (const float*)d_in[11]; a.ln2_b = (const float*)d_in[12];
    a.rg_w = (const float*)d_in[13]; a.rg_b = (const float*)d_in[14]; a.re_w = (const float*)d_in[15]; a.re_b = (const float*)d_in[16];
    a.e_w_in = (const float*)d_in[17]; a.e_w_down = (const float*)d_in[18];
    a.out = (float*)d_out; a.ws = (unsigned char*)d_ws;
    void* kargs[] = {&a};
    const hipError_t e = hipLaunchCooperativeKernel((const void*)fwd_megakernel, dim3(grid), dim3(NTHREADS), kargs, LDS_BYTES, stream);
    if (e != hipSuccess) fprintf(stderr, "kernel_launch: cooperative launch failed: %s (grid %d)\n", hipGetErrorString(e), grid);
}
```

```cpp
#include <hip/hip_runtime.h>
#include <hip/hip_cooperative_groups.h>
#include <cstdio>
#include <cstdint>
namespace cg = cooperative_groups;

namespace pg8 {
#define PG8_LAS __attribute__((address_space(3)))
typedef unsigned short bf16_t;
typedef short bf16x8 __attribute__((ext_vector_type(8)));
typedef float f32x4 __attribute__((ext_vector_type(4)));
typedef unsigned u32x4 __attribute__((ext_vector_type(4)));
typedef unsigned u32x2 __attribute__((ext_vector_type(2)));
constexpr int BM = 256, BK = 64, HALF = 128, HTB = HALF * BK * 2  , STAGE_BYTES = 8 * HTB, NXCD = 8, WGM = 8;

__host__ __device__ __forceinline__ int lds_byte(int r, int c) { const int st = (r >> 4) * 2 + (c >> 5), rr = r & 15, cc = c & 31, ob = rr * 64 + cc * 2; return st * 1024 + (ob ^ (((ob >> 9) & 1) << 5)); }
__host__ __device__ __forceinline__ void stage_rc(int b, int& R, int& C) { const int st = b / 1024, sb = b % 1024, swz = sb ^ (((sb >> 9) & 1) << 5); R = (st >> 1) * 16 + swz / 64; C = (st & 1) * 32 + (swz % 64) / 2; }
__host__ __device__ __forceinline__ int perm32(int rho) { const int n = rho >> 4, i = rho & 15; return 8 * (i >> 2) + 4 * n + (i & 3); }

struct Unit { const char* b0; const char* b1; int arow; int p0, p1, p2, p3; };

__device__ __forceinline__ bool static_tile(int i, int G, int c, int nM, int nN, int& pm, int& pn) {
    const int nwg = nM * nN; const long L = (long)i * G + c; if (L >= nwg) return false;
    int wgid = (int)L; { const int q = nwg / NXCD, r = nwg % NXCD, xcd = wgid % NXCD, off = wgid / NXCD; wgid = (xcd < r ? xcd * (q + 1) : r * (q + 1) + (xcd - r) * q) + off; }
    const int nig = WGM * nN, gid = wgid / nig, fm = gid * WGM, gsz = (nM - fm) < WGM ? (nM - fm) : WGM;
    pm = fm + ((wgid % nig) % gsz); pn = (wgid % nig) / gsz; return true;
}

__device__ __forceinline__ unsigned cvt_pk_bf16(float lo, float hi) { unsigned r; asm volatile("v_cvt_pk_bf16_f32 %0, %1, %2" : "=v"(r) : "v"(lo), "v"(hi)); return r; }

template <class Epi, class Sched>
__device__ __forceinline__ void gemm_phase(PG8_LAS unsigned char* lds, const char* Abase, const int K, const Sched& S, const Epi& E) {
    int tid_ = threadIdx.x; asm volatile("" : "+v"(tid_));
    const int tid = tid_, wid = __builtin_amdgcn_readfirstlane(tid >> 6), lane = tid & 63, wr = wid >> 2, wc = wid & 3, fr = lane & 15, fq = lane >> 4;
    const int nt = K / BK;
    int R[2], C[2]; unsigned voffB[2];
#pragma unroll
    for (int i = 0; i < 2; ++i) { stage_rc(tid * 16 + i * 8192, R[i], C[i]); const int Rb = Epi::PERM ? ((R[i] & ~31) + perm32(R[i] & 31)) : R[i]; voffB[i] = (unsigned)(Rb * K + C[i]) * 2u; }
    const size_t kstep = (size_t)(BK * 2);
    const unsigned ldsw = (unsigned)wid * 1024u;
    const int aoff = lds_byte(wr * 64 + fr, fq * 8), boff = lds_byte(wc * 32 + fr, fq * 8);
#define PG8_SA(b, h) (((b) * 2 + (h)) * HTB)
#define PG8_SB(b, h) ((4 + (b) * 2 + (h)) * HTB)
#define PG8_STAGE(bufoff, gbase, v0, v1) do { \
        __builtin_amdgcn_global_load_lds((const unsigned*)((const char*)(gbase) + (v0)), (PG8_LAS unsigned*)(lds + (bufoff) + ldsw), 16, 0, 0); \
        __builtin_amdgcn_global_load_lds((const unsigned*)((const char*)(gbase) + (v1)), (PG8_LAS unsigned*)(lds + (bufoff) + ldsw + 8192), 16, 0, 0); } while (0)
#define PG8_STAGEB(bufoff, gbase) PG8_STAGE(bufoff, gbase, voffB[0], voffB[1])
#define PG8_LDA(dst, b, h) do { _Pragma("unroll") for (int m = 0; m < 4; ++m) _Pragma("unroll") for (int k = 0; k < 2; ++k) dst[m][k] = *(const PG8_LAS bf16x8*)(lds + PG8_SA(b, h) + aoff + m * 2048 + k * 1024); } while (0)
#define PG8_LDB(dst, b, h) do { _Pragma("unroll") for (int n = 0; n < 2; ++n) _Pragma("unroll") for (int k = 0; k < 2; ++k) dst[n][k] = *(const PG8_LAS bf16x8*)(lds + PG8_SB(b, h) + boff + n * 2048 + k * 1024); } while (0)
#define PG8_MMA(ai, bj, At, Bt) do { __builtin_amdgcn_s_setprio(1); _Pragma("unroll") for (int m = 0; m < 4; ++m) _Pragma("unroll") for (int n = 0; n < 2; ++n) _Pragma("unroll") for (int k = 0; k < 2; ++k) \
        acc[ai][bj][m][n] = __builtin_amdgcn_mfma_f32_16x16x32_bf16(Bt[n][k], At[m][k], acc[ai][bj][m][n], 0, 0, 0); __builtin_amdgcn_s_setprio(0); } while (0)
#define PG8_WAIT_V(n) asm volatile("s_waitcnt vmcnt(" #n ")" ::: "memory")
#define PG8_WAIT_L(n) asm volatile("s_waitcnt lgkmcnt(" #n ")" ::: "memory")
#define PG8_BAR __builtin_amdgcn_s_barrier()
#define PG8_SCHED __builtin_amdgcn_sched_barrier(0)
    Unit cur, nxt; int ui = 0;
    if (!S.next(0, cur)) return;
    f32x4 acc[2][2][4][2];
#pragma unroll
    for (int a = 0; a < 2; ++a)
#pragma unroll
        for (int b = 0; b < 2; ++b)
#pragma unroll
            for (int m = 0; m < 4; ++m)
#pragma unroll
                for (int n = 0; n < 2; ++n) acc[a][b][m][n] = (f32x4){0.f, 0.f, 0.f, 0.f};
    bf16x8 At[4][2], B0[2][2], B1[2][2];
    unsigned vA00, vA01, vA10, vA11, vN00, vN01, vN10, vN11;
    S.a_ready(cur, S.peek(cur));
    S.a_offs(cur, R, C, vA00, vA01, vA10, vA11);
    const char* cB0 = cur.b0; const char* cB1 = cur.b1;
    PG8_STAGEB(PG8_SB(0, 0), cB0); PG8_STAGEB(PG8_SB(0, 1), cB1); PG8_STAGE(PG8_SA(0, 0), Abase, vA00, vA01); PG8_STAGE(PG8_SA(0, 1), Abase, vA10, vA11);
    if (wr == 1) PG8_BAR;
    PG8_WAIT_V(2); PG8_BAR;
    PG8_STAGEB(PG8_SB(1, 0), cB0 + kstep); PG8_STAGE(PG8_SA(1, 0), Abase + kstep, vA00, vA01); PG8_STAGEB(PG8_SB(1, 1), cB1 + kstep);
    PG8_WAIT_V(6); PG8_BAR;
    for (;;) {
        const bool has_next = S.next(ui + 1, nxt);
        if (has_next) S.a_offs(nxt, R, C, vN00, vN01, vN10, vN11); else { vN00 = vA00; vN01 = vA01; vN10 = vA10; vN11 = vA11; }
        const char* nB0 = has_next ? nxt.b0 : cB0; const char* nB1 = has_next ? nxt.b1 : cB1;
        const unsigned pk = has_next ? S.peek(nxt) : 0u;
        const bool skip1 = S.half_only(cur);
        for (int t = 0; t < nt; t += 2) {
            const bool last = (t == nt - 2);
            if (last && has_next) S.a_ready(nxt, pk);
            const char* a1 = Abase + (size_t)(t + 1) * kstep;
            PG8_LDB(B0, 0, 0); PG8_LDB(B1, 0, 1); PG8_SCHED; PG8_LDA(At, 0, 0); PG8_STAGE(PG8_SA(1, 1), a1, vA10, vA11);
            PG8_WAIT_V(8); PG8_WAIT_L(0); PG8_BAR; PG8_MMA(0, 0, At, B0); PG8_MMA(0, 1, At, B1); PG8_BAR; PG8_SCHED;
            if (last) { vA00 = vN00; vA01 = vN01; vA10 = vN10; vA11 = vN11; }
            const char* a2 = last ? Abase : Abase + (size_t)(t + 2) * kstep;
            const char* b20 = last ? nB0 : cB0 + (size_t)(t + 2) * kstep; const char* b21 = last ? nB1 : cB1 + (size_t)(t + 2) * kstep;
            const char* a3 = a2 + kstep; const char* b30 = b20 + kstep; const char* b31 = b21 + kstep;
            PG8_LDA(At, 0, 1); PG8_STAGEB(PG8_SB(0, 0), b20); PG8_STAGEB(PG8_SB(0, 1), b21); PG8_STAGE(PG8_SA(0, 0), a2, vA00, vA01);
            PG8_WAIT_V(8); PG8_WAIT_L(0); PG8_BAR; if (!skip1) { PG8_MMA(1, 0, At, B0); PG8_MMA(1, 1, At, B1); } PG8_BAR; PG8_SCHED;
            PG8_LDB(B0, 1, 0); PG8_LDB(B1, 1, 1); PG8_SCHED; PG8_LDA(At, 1, 0); PG8_STAGE(PG8_SA(0, 1), a2, vA10, vA11);
            PG8_WAIT_V(8); PG8_WAIT_L(0); PG8_BAR; PG8_MMA(0, 0, At, B0); PG8_MMA(0, 1, At, B1); PG8_BAR; PG8_SCHED;
            PG8_LDA(At, 1, 1); PG8_STAGEB(PG8_SB(1, 0), b30); PG8_STAGEB(PG8_SB(1, 1), b31); PG8_STAGE(PG8_SA(1, 0), a3, vA00, vA01);
            PG8_WAIT_V(8); PG8_WAIT_L(0); PG8_BAR; if (!skip1) { PG8_MMA(1, 0, At, B0); PG8_MMA(1, 1, At, B1); } PG8_BAR; PG8_SCHED;
        }
        if (wr == 0) PG8_BAR;
        E(acc, cur, wr, wc, fr, fq);
        S.done(cur);
        if (!has_next) break;
#pragma unroll
        for (int a = 0; a < 2; ++a)
#pragma unroll
            for (int b = 0; b < 2; ++b)
#pragma unroll
                for (int m = 0; m < 4; ++m)
#pragma unroll
                    for (int n = 0; n < 2; ++n) acc[a][b][m][n] = (f32x4){0.f, 0.f, 0.f, 0.f};
        cur = nxt; cB0 = nB0; cB1 = nB1; ++ui;
        if (wr == 1) PG8_BAR;
    }
    PG8_WAIT_V(0);
    PG8_BAR;
#undef PG8_SA
#undef PG8_SB
#undef PG8_STAGE
#undef PG8_STAGEB
#undef PG8_LDA
#undef PG8_LDB
#undef PG8_MMA
#undef PG8_WAIT_V
#undef PG8_WAIT_L
#undef PG8_BAR
#undef PG8_SCHED
}
}
#include <hip/hip_bf16.h>
#include <cmath>
namespace attn_body {
using bf16=__hip_bfloat16;
using bf16x8=__attribute__((ext_vector_type(8)))short;
using s16x4=__attribute__((ext_vector_type(4)))short;
using f32x16=__attribute__((ext_vector_type(16)))float;
using u32x4=__attribute__((ext_vector_type(4)))unsigned;
constexpr int D=64,DM=1024;
constexpr int NW=8,QBLK=32,QB=QBLK*NW,KVBLK=64;
constexpr int ATTN_PITCH=DM, ATTN_UNIT_ROWS=QB;
__device__ __forceinline__ int crow(int r,int hi){return (r&3)+8*(r>>2)+4*hi;}
#define SBAR() __builtin_amdgcn_sched_barrier(0)
__device__ __forceinline__ void cmask(f32x16&p0,f32x16&p1,int jb,int qrel,int hi){
  const float NEG=-INFINITY; int kb=64*jb+4*hi;
  #pragma unroll
  for(int r=0;r<16;++r){int kv=kb+(r&3)+8*(r>>2); if(kv>qrel)p0[r]=NEG; if(kv+32>qrel)p1[r]=NEG;}
}

constexpr int NSLOT=3, SLOTB=8192;
constexpr int LDS_K=0, LDS_V=NSLOT*SLOTB, LDS_WS=2*NSLOT*SLOTB, LDS_OST=LDS_WS+NW*64*4, LDS_BYTES=LDS_OST+NW*4096;
constexpr float C2=0.125f*1.4426950408889634f;
__device__ __forceinline__ void glds16(const void*gsrc,unsigned lds_dst){unsigned keep;
  asm volatile("s_mov_b32 %0, m0\n\ts_mov_b32 m0, %2\n\ts_nop 0\n\tglobal_load_lds_dwordx4 %1, off\n\ts_mov_b32 m0, %0":"=&s"(keep):"v"(gsrc),"s"(lds_dst):"memory");}
__device__ __forceinline__ void glds16s(const void*sbase,unsigned voff,unsigned lds_dst){unsigned keep;
  asm volatile("s_mov_b32 %0, m0\n\ts_mov_b32 m0, %3\n\ts_nop 4\n\tglobal_load_lds_dwordx4 %1, %2\n\ts_mov_b32 m0, %0":"=&s"(keep):"v"(voff),"s"(sbase),"s"(lds_dst):"memory");}
__device__ __forceinline__ float max3f(float a,float b,float c){float r;asm("v_max3_f32 %0, %1, %2, %3":"=v"(r):"v"(a),"v"(b),"v"(c));return r;}
__device__ __forceinline__ float max2f(float a,float b){float r;asm("v_max_f32_e32 %0, %1, %2":"=v"(r):"v"(a),"v"(b));return r;}
__device__ __forceinline__ float fadd_s(float a,float b){float r;asm("v_add_f32_e32 %0, %1, %2":"=v"(r):"v"(a),"v"(b));return r;}
__device__ __forceinline__ float fsub_s(float a,float b){float r;asm("v_sub_f32_e32 %0, %1, %2":"=v"(r):"v"(a),"v"(b));return r;}
typedef float f32x2_t __attribute__((ext_vector_type(2))); typedef __bf16 bf16x2_t __attribute__((ext_vector_type(2)));
__device__ __forceinline__ unsigned cvtpk_s(float lo,float hi){f32x2_t v={lo,hi};bf16x2_t b=__builtin_convertvector(v,bf16x2_t);return __builtin_bit_cast(unsigned,b);}
#define WAIT_BAR(N) asm volatile("s_waitcnt vmcnt(" #N ") lgkmcnt(0)\n\ts_barrier":::"memory")

__device__ __forceinline__ void qkt(f32x16&p0,f32x16&p1,const char*Kslot,const bf16x8*qr,const f32x16&negm,int r32,int hi){
  const char*kb=Kslot+hi*1024+r32*16;
  #pragma unroll
  for(int d0=0;d0<4;++d0){
    const bf16x8 b0=*reinterpret_cast<const bf16x8*>(kb+d0*2048);
    const bf16x8 b1=*reinterpret_cast<const bf16x8*>(kb+d0*2048+512);
    if(d0==0){p0=__builtin_amdgcn_mfma_f32_32x32x16_bf16(b0,qr[0],negm,0,0,0);p1=__builtin_amdgcn_mfma_f32_32x32x16_bf16(b1,qr[0],negm,0,0,0);}
    else{p0=__builtin_amdgcn_mfma_f32_32x32x16_bf16(b0,qr[d0],p0,0,0,0);p1=__builtin_amdgcn_mfma_f32_32x32x16_bf16(b1,qr[d0],p1,0,0,0);}}
}
typedef __attribute__((address_space(3))) const char* lds_cptr;
typedef short v4i16_t __attribute__((ext_vector_type(4)));
__device__ __forceinline__ void kload8(bf16x8*kf,lds_cptr kp){
  kf[0]=*(const __attribute__((address_space(3))) bf16x8*)(kp);      kf[1]=*(const __attribute__((address_space(3))) bf16x8*)(kp+512);
  kf[2]=*(const __attribute__((address_space(3))) bf16x8*)(kp+2048); kf[3]=*(const __attribute__((address_space(3))) bf16x8*)(kp+2560);
  kf[4]=*(const __attribute__((address_space(3))) bf16x8*)(kp+4096); kf[5]=*(const __attribute__((address_space(3))) bf16x8*)(kp+4608);
  kf[6]=*(const __attribute__((address_space(3))) bf16x8*)(kp+6144); kf[7]=*(const __attribute__((address_space(3))) bf16x8*)(kp+6656);
}
__device__ __forceinline__ void kload2(bf16x8*kf,lds_cptr kp,int j){ kf[2*j]=*(const __attribute__((address_space(3))) bf16x8*)(kp+j*2048); kf[2*j+1]=*(const __attribute__((address_space(3))) bf16x8*)(kp+j*2048+512); }
__device__ __forceinline__ s16x4 vtr(lds_cptr p){ return __builtin_bit_cast(s16x4,__builtin_amdgcn_ds_read_tr16_b64_v4i16((__attribute__((address_space(3))) v4i16_t*)p)); }
__device__ __forceinline__ float rowmax(const f32x16&p0,const f32x16&p1){
  float a=max3f(p0[0],p0[1],p1[0]),b=max3f(p0[2],p0[3],p1[1]);a=max3f(a,p1[2],p1[3]);
  #pragma unroll
  for(int r=4;r<16;r+=4){a=max3f(a,p0[r],p0[r+1]);b=max3f(b,p0[r+2],p0[r+3]);a=max3f(a,p1[r],p1[r+1]);b=max3f(b,p1[r+2],p1[r+3]);}
  const float m=max2f(a,b);
  auto rr=__builtin_amdgcn_permlane32_swap(__float_as_uint(m),__float_as_uint(m),false,false);
  return max2f(__uint_as_float(rr[0]),__uint_as_float(rr[1]));
}
__device__ __forceinline__ void pv(f32x16*o,int vb,bf16x8 pa0,bf16x8 pa1,bf16x8 pa2,bf16x8 pa3){
  #pragma unroll
  for(int d0=0;d0<2;++d0){s16x4 lo[4],hi[4];
    #pragma unroll
    for(int ks=0;ks<4;++ks){
      asm volatile("ds_read_b64_tr_b16 %0,%1 offset:%c2":"=&v"(lo[ks]):"v"(vb),"i"(d0*4096+ks*1024):"memory");
      asm volatile("ds_read_b64_tr_b16 %0,%1 offset:%c2":"=&v"(hi[ks]):"v"(vb),"i"(d0*4096+ks*1024+512):"memory");}
    asm volatile("s_waitcnt lgkmcnt(0)":::"memory");SBAR();
    #define PK(k) (bf16x8){lo[k][0],lo[k][1],lo[k][2],lo[k][3],hi[k][0],hi[k][1],hi[k][2],hi[k][3]}
    o[d0]=__builtin_amdgcn_mfma_f32_32x32x16_bf16(pa0,PK(0),o[d0],0,0,0);
    o[d0]=__builtin_amdgcn_mfma_f32_32x32x16_bf16(pa1,PK(1),o[d0],0,0,0);
    o[d0]=__builtin_amdgcn_mfma_f32_32x32x16_bf16(pa2,PK(2),o[d0],0,0,0);
    o[d0]=__builtin_amdgcn_mfma_f32_32x32x16_bf16(pa3,PK(3),o[d0],0,0,0);
    #undef PK
  }
}

#ifndef ATTN_STORE16
#define ATTN_STORE16(p,v) (*(u32x4*)(p)=(v))
#endif
template<int THRL> __device__ __forceinline__ void attn_unit(long rowbase,int qb,const bf16*Qc,const bf16*__restrict__ Kc,const bf16*__restrict__ Vc,bf16*Oc,char*shm){
  int tid_=threadIdx.x; asm volatile("":"+v"(tid_)); const int tid=tid_,lane=tid&63,r32=lane&31,hi=lane>>5; const int wid=__builtin_amdgcn_readfirstlane(tid>>6);
  const int q0=qb*QB;
  const bf16*Qw=Qc+(rowbase+q0+wid*QBLK)*DM;
  const bf16*Kh=Kc+rowbase*DM,*Vh=Vc+rowbase*DM;
  const unsigned lds0=(unsigned)(uintptr_t)shm;
  float*wsf=(float*)(shm+LDS_WS)+wid*64;
  const unsigned koff=(unsigned)(lane*DM+wid*8)*2u;
  const unsigned voffv=(unsigned)((16*(wid&3)+(lane>>2))*DM+(wid>>2)*32+(lane&3)*8)*2u;
  const unsigned kdst=lds0+LDS_K+wid*1024, vdst=lds0+LDS_V+wid*1024;
  #define DMA_K(t,slot) glds16s(Kh+(long)(t)*KVBLK*DM,koff,(unsigned)__builtin_amdgcn_readfirstlane(kdst+(slot)))
  #define DMA_V(t,slot) glds16s(Vh+(long)(t)*KVBLK*DM,voffv,(unsigned)__builtin_amdgcn_readfirstlane(vdst+(slot)))
  const int vb0=(int)(lds0+LDS_V)+((lane>>4)&1)*32+(lane&3)*8+(4*hi+((lane&15)>>2))*64;
  const char*Kbase=shm+LDS_K; bf16x8 kf[8];
  const lds_cptr shm3=(lds_cptr)shm; const lds_cptr kp0=shm3+LDS_K+hi*1024+r32*16; const lds_cptr vp0=shm3+LDS_V+((lane>>4)&1)*32+(lane&3)*8+(4*hi+((lane&15)>>2))*64;
  const int NT=(q0+QB)/KVBLK;
  DMA_K(0,0);DMA_V(0,0);DMA_K(1,SLOTB);
  bf16x8 qr[4];
  #pragma unroll
  for(int d0=0;d0<4;++d0)qr[d0]=*reinterpret_cast<const bf16x8*>(&Qw[(long)r32*DM+d0*16+hi*8]);
  float mhat=0.f,l_reg=0.f;f32x16 o[2];o[0]=f32x16{};o[1]=f32x16{};f32x16 negm=f32x16{};asm volatile("":"+v"(negm));
  const int qrel=wid*QBLK+r32;
  #define CMASK(P0,P1,t) do{int jb_=(t)-(NT-4); if(jb_>=0)cmask(P0,P1,jb_,qrel,hi);}while(0)
  bool resc=false;
  #define START(P0,P1) do{ const float rm=rowmax(P0,P1); resc=false; \
    { const float dl=rm; mhat=fadd_s(mhat,dl); \
      _Pragma("unroll") for(int r=0;r<16;++r){P0[r]=fsub_s(P0[r],dl);P1[r]=fsub_s(P1[r],dl);} \
      _Pragma("unroll") for(int r=0;r<16;++r)negm[r]=-mhat; asm volatile("":"+v"(negm)); } \
    _Pragma("unroll") for(int r=0;r<16;++r)P0[r]=__builtin_amdgcn_exp2f(P0[r]); }while(0)
  #define RESC() do{ if(resc){ asm volatile("s_waitcnt lgkmcnt(0)":::"memory"); \
      _Pragma("unroll") for(int d_=0;d_<2;++d_) _Pragma("unroll") for(int r=0;r<16;++r)o[d_][r]*=wsf[crow(r,hi)]; } }while(0)
  f32x16 pA0,pA1,pB0,pB1;
  int sl_prev=0,sl_cur=0,sl_next=SLOTB;
  #define ROT() do{sl_prev=sl_cur;sl_cur=sl_next;sl_next=(sl_next==(NSLOT-1)*SLOTB)?0:sl_next+SLOTB;}while(0)
  DMA_K(2,2*SLOTB);
  WAIT_BAR(3);
  qkt(pA0,pA1,Kbase,qr,negm,r32,hi);asm volatile("s_nop 15\n\ts_nop 7":"+v"(pA0),"+v"(pA1));CMASK(pA0,pA1,0);
  START(pA0,pA1);
  _Pragma("unroll") for(int r=0;r<16;++r)pA1[r]=__builtin_amdgcn_exp2f(pA1[r]);
  WAIT_BAR(0);
  DMA_K(3,0);DMA_V(1,SLOTB);
  ROT();
  kload8(kf,kp0+sl_cur);
  WAIT_BAR(2);
  s16x4 vlo[8],vhi[8]; u32x4 pw0,pw1,pw2,pw3;
  #define PKW(P,B) cvtpk_s(P[B],P[B+1])
  #define PAF(k) __builtin_bit_cast(bf16x8,pw##k)
  #define VFR(i) (bf16x8){vlo[i][0],vlo[i][1],vlo[i][2],vlo[i][3],vhi[i][0],vhi[i][1],vhi[i][2],vhi[i][3]}
  #define PIN(x) asm volatile("":"+v"(x))
  #define MX3(a,b,c) __builtin_fmaxf(__builtin_fmaxf((a),(b)),(c))
  #define GAPA(MF,A0,A1,A2,A3,W0,W1,PW) do{ MF; sacc+=A0; sacc+=A1; sacc+=A2; sacc+=A3; PIN(sacc); W0; W1; PIN(PW); SBAR(); }while(0)
  #define EX(v) __builtin_amdgcn_exp2f(v)
  #define GAPB(MF,X,B) do{ MF; X[B]=EX(X[B]); X[B+1]=EX(X[B+1]); X[B+2]=EX(X[B+2]); X[B+3]=EX(X[B+3]); PIN(X); SBAR(); }while(0)
  #define VRD(i) do{ vlo[i]=vtr(vp_+(((i)>>2)*4096+((i)&3)*1024)); vhi[i]=vtr(vp_+(((i)>>2)*4096+((i)&3)*1024+512)); }while(0)
  #define KRD(G,j) do{ if(G){ kload2(kf,kp0+sl_next,j); SBAR(); } }while(0)
  #define STEP(C0,C1,P0,P1,t,GK,GV,GL) do{ SBAR(); \
    const lds_cptr vp_=vp0+sl_prev; \
    VRD(0); SBAR(); float sacc=(P0[0]+P0[1]); \
    GAPA(C0=__builtin_amdgcn_mfma_f32_32x32x16_bf16(kf[0],qr[0],negm,0,0,0), P0[2],P0[3],P0[4],P0[5],     pw0[0]=PKW(P0,0), pw0[1]=PKW(P0,2), pw0); \
    VRD(4); SBAR(); GAPA(C1=__builtin_amdgcn_mfma_f32_32x32x16_bf16(kf[1],qr[0],negm,0,0,0), P0[6],P0[7],P0[8],P0[9],     pw0[2]=PKW(P0,4), pw0[3]=PKW(P0,6), pw0); \
    VRD(1); SBAR(); GAPA(C0=__builtin_amdgcn_mfma_f32_32x32x16_bf16(kf[2],qr[1],C0,0,0,0),   P0[10],P0[11],P0[12],P0[13], pw1[0]=PKW(P0,8), pw1[1]=PKW(P0,10), pw1); \
    VRD(5); SBAR(); GAPA(C1=__builtin_amdgcn_mfma_f32_32x32x16_bf16(kf[3],qr[1],C1,0,0,0),   P0[14],P0[15],P1[0],P1[1],   pw1[2]=PKW(P0,12),pw1[3]=PKW(P0,14), pw1); \
    VRD(2); SBAR(); GAPA(C0=__builtin_amdgcn_mfma_f32_32x32x16_bf16(kf[4],qr[2],C0,0,0,0),   P1[2],P1[3],P1[4],P1[5],     pw2[0]=PKW(P1,0), pw2[1]=PKW(P1,2), pw2); \
    VRD(6); SBAR(); GAPA(C1=__builtin_amdgcn_mfma_f32_32x32x16_bf16(kf[5],qr[2],C1,0,0,0),   P1[6],P1[7],P1[8],P1[9],     pw2[2]=PKW(P1,4), pw2[3]=PKW(P1,6), pw2); \
    VRD(3); SBAR(); GAPA(C0=__builtin_amdgcn_mfma_f32_32x32x16_bf16(kf[6],qr[3],C0,0,0,0),   P1[10],P1[11],P1[12],P1[13], pw3[0]=PKW(P1,8), pw3[1]=PKW(P1,10), pw3); \
    VRD(7); SBAR(); GAPA(C1=__builtin_amdgcn_mfma_f32_32x32x16_bf16(kf[7],qr[3],C1,0,0,0),   P1[14],P1[15],0.f,0.f,       pw3[2]=PKW(P1,12),pw3[3]=PKW(P1,14), pw3); \
    l_reg+=sacc; \
    if(GK){DMA_K((t)+3,sl_cur);} if(GV){DMA_V((t)+1,sl_next);} \
    CMASK(C0,C1,t); \
    { float a=MX3(C0[0],C0[1],C1[0]),b=MX3(C0[2],C0[3],C1[1]); a=MX3(a,C1[2],C1[3]); \
      _Pragma("unroll") for(int r=4;r<16;r+=4){a=MX3(a,C0[r],C0[r+1]);b=MX3(b,C0[r+2],C0[r+3]);a=MX3(a,C1[r],C1[r+1]);b=MX3(b,C1[r+2],C1[r+3]);} \
      float rm=__builtin_fmaxf(a,b); { auto rr=__builtin_amdgcn_permlane32_swap(__float_as_uint(rm),__float_as_uint(rm),false,false); rm=__builtin_fmaxf(__uint_as_float(rr[0]),__uint_as_float(rr[1])); } \
      resc=false; \
      if(__builtin_expect(__any(rm>(float)THRL),0)){ const float dl=__builtin_fmaxf(rm,0.f); mhat+=dl; \
        _Pragma("unroll") for(int r=0;r<16;++r){C0[r]-=dl;C1[r]-=dl;} \
        _Pragma("unroll") for(int r=0;r<16;++r)negm[r]=-mhat; asm volatile("":"+v"(negm)); \
        const float f=__builtin_amdgcn_exp2f(-dl); l_reg*=f; if(hi==0)wsf[r32]=f; resc=true; } } \
    SBAR(); \
    GAPB(o[0]=__builtin_amdgcn_mfma_f32_32x32x16_bf16(PAF(0),VFR(0),o[0],0,0,0), C0,0); \
    GAPB(o[1]=__builtin_amdgcn_mfma_f32_32x32x16_bf16(PAF(0),VFR(4),o[1],0,0,0), C0,4); \
    KRD(GL,0); GAPB(o[0]=__builtin_amdgcn_mfma_f32_32x32x16_bf16(PAF(1),VFR(1),o[0],0,0,0), C0,8); \
    KRD(GL,1); GAPB(o[1]=__builtin_amdgcn_mfma_f32_32x32x16_bf16(PAF(1),VFR(5),o[1],0,0,0), C0,12); \
    KRD(GL,2); GAPB(o[0]=__builtin_amdgcn_mfma_f32_32x32x16_bf16(PAF(2),VFR(2),o[0],0,0,0), C1,0); \
    KRD(GL,3); GAPB(o[1]=__builtin_amdgcn_mfma_f32_32x32x16_bf16(PAF(2),VFR(6),o[1],0,0,0), C1,4); \
    GAPB(o[0]=__builtin_amdgcn_mfma_f32_32x32x16_bf16(PAF(3),VFR(3),o[0],0,0,0), C1,8); \
    GAPB(o[1]=__builtin_amdgcn_mfma_f32_32x32x16_bf16(PAF(3),VFR(7),o[1],0,0,0), C1,12); \
    }while(0)
  int t=1;
  #undef CMASK
  #define CMASK(P0,P1,t) do{}while(0)
  for(;t+5<NT;t+=2){
    STEP(pB0,pB1,pA0,pA1,t,true,true,true);     WAIT_BAR(2); RESC(); ROT();
    STEP(pA0,pA1,pB0,pB1,t+1,true,true,true);   WAIT_BAR(2); RESC(); ROT();
  }
  #undef CMASK
  #define CMASK(P0,P1,t) do{int jb_=(t)-(NT-4); if(jb_>=0)cmask(P0,P1,jb_,qrel,hi);}while(0)
  #define ENDW(tt) do{ if((tt)+3<NT){WAIT_BAR(2);} else if((tt)+2<NT){WAIT_BAR(1);} else {WAIT_BAR(0);} }while(0)
  for(;t+1<NT;t+=2){
    STEP(pB0,pB1,pA0,pA1,t,(t+3<NT),(t+1<NT),(t+1<NT));       ENDW(t);   RESC(); ROT();
    STEP(pA0,pA1,pB0,pB1,t+1,(t+4<NT),(t+2<NT),(t+2<NT));     ENDW(t+1); RESC(); ROT();
  }
  STEP(pB0,pB1,pA0,pA1,NT-1,false,false,false); RESC();
  { float sacc=pB0[0]+pB0[1]; _Pragma("unroll") for(int r=2;r<16;++r)sacc+=pB0[r]; _Pragma("unroll") for(int r=0;r<16;++r)sacc+=pB1[r]; l_reg+=sacc;
    pw0=(u32x4){PKW(pB0,0),PKW(pB0,2),PKW(pB0,4),PKW(pB0,6)};pw1=(u32x4){PKW(pB0,8),PKW(pB0,10),PKW(pB0,12),PKW(pB0,14)};pw2=(u32x4){PKW(pB1,0),PKW(pB1,2),PKW(pB1,4),PKW(pB1,6)};pw3=(u32x4){PKW(pB1,8),PKW(pB1,10),PKW(pB1,12),PKW(pB1,14)};
    SBAR(); pv(o,vb0+sl_cur,PAF(0),PAF(1),PAF(2),PAF(3)); }
  #undef PKW
  #undef PAF
  #undef VFR
  #undef PIN
  #undef MX3
  #undef GAPA
  #undef GAPB
  #undef EX
  #undef VRD
  #undef KRD
  #undef STEP
  #undef ENDW
  {auto rr=__builtin_amdgcn_permlane32_swap(__float_as_uint(l_reg),__float_as_uint(l_reg),false,false);l_reg=__uint_as_float(rr[0])+__uint_as_float(rr[1]);}
  if(hi==0)wsf[32+r32]=l_reg;asm volatile("s_waitcnt lgkmcnt(0)":::"memory");
  float rli[16];
  #pragma unroll
  for(int r=0;r<16;++r)rli[r]=__builtin_amdgcn_rcpf(wsf[32+crow(r,hi)]);
  bf16*Ow=Oc+(rowbase+q0+wid*QBLK)*DM;
  { bf16*stg=(bf16*)(shm+LDS_OST)+wid*2048;
    #pragma unroll
    for(int r=0;r<16;++r){const int orow=crow(r,hi);
      #pragma unroll
      for(int d0=0;d0<2;++d0)stg[orow*64+d0*32+r32]=__float2bfloat16(o[d0][r]*rli[r]);}
    asm volatile("s_waitcnt lgkmcnt(0)":::"memory");
    #pragma unroll
    for(int i=0;i<4;++i){const int row=i*8+(lane>>3),ch=lane&7; const u32x4 v=*(const u32x4*)(stg+row*64+ch*8); ATTN_STORE16(Ow+(long)row*DM+ch*8,v);} }
  asm volatile("s_waitcnt lgkmcnt(0)\n\ts_barrier":::"memory");
  #undef DMA_K
  #undef DMA_V
  #undef CMASK
  #undef START
  #undef RESC
  #undef ROT
}
constexpr int ATTN_LDS_BYTES=LDS_BYTES;
#undef SBAR
#undef WAIT_BAR
}
namespace attn128 {
using bf16=__hip_bfloat16;
using bf16x8=__attribute__((ext_vector_type(8)))short;
using s16x4=__attribute__((ext_vector_type(4)))short;
using f32x16=__attribute__((ext_vector_type(16)))float;
using u32x4=__attribute__((ext_vector_type(4)))unsigned;
constexpr int D=64,DM=1024;
constexpr int NW=8,QBLK=32,QB=QBLK*NW,KVBLK=64;
constexpr int ATTN_PITCH=DM, ATTN_UNIT_ROWS=QB;
__device__ __forceinline__ int crow(int r,int hi){return (r&3)+8*(r>>2)+4*hi;}
#define SBAR() __builtin_amdgcn_sched_barrier(0)
__device__ __forceinline__ void cmask(f32x16&p0,f32x16&p1,int jb,int qrel,int hi){
  const float NEG=-INFINITY; int kb=64*jb+4*hi;
  #pragma unroll
  for(int r=0;r<16;++r){int kv=kb+(r&3)+8*(r>>2); if(kv>qrel)p0[r]=NEG; if(kv+32>qrel)p1[r]=NEG;}
}

constexpr int NSLOT=3, SLOTB=8192;
constexpr int LDS_K=0, LDS_V=NSLOT*SLOTB, LDS_WS=LDS_V+NSLOT*2*SLOTB, LDS_OST=LDS_WS+NW*64*4, LDS_BYTES=LDS_OST+NW*8192;
constexpr float C2=0.125f*1.4426950408889634f;
__device__ __forceinline__ void glds16(const void*gsrc,unsigned lds_dst){unsigned keep;
  asm volatile("s_mov_b32 %0, m0\n\ts_mov_b32 m0, %2\n\ts_nop 0\n\tglobal_load_lds_dwordx4 %1, off\n\ts_mov_b32 m0, %0":"=&s"(keep):"v"(gsrc),"s"(lds_dst):"memory");}
__device__ __forceinline__ void glds16s(const void*sbase,unsigned voff,unsigned lds_dst){unsigned keep;
  asm volatile("s_mov_b32 %0, m0\n\ts_mov_b32 m0, %3\n\ts_nop 4\n\tglobal_load_lds_dwordx4 %1, %2\n\ts_mov_b32 m0, %0":"=&s"(keep):"v"(voff),"s"(sbase),"s"(lds_dst):"memory");}
__device__ __forceinline__ float max3f(float a,float b,float c){float r;asm("v_max3_f32 %0, %1, %2, %3":"=v"(r):"v"(a),"v"(b),"v"(c));return r;}
__device__ __forceinline__ float max2f(float a,float b){float r;asm("v_max_f32_e32 %0, %1, %2":"=v"(r):"v"(a),"v"(b));return r;}
__device__ __forceinline__ float fadd_s(float a,float b){float r;asm("v_add_f32_e32 %0, %1, %2":"=v"(r):"v"(a),"v"(b));return r;}
__device__ __forceinline__ float fsub_s(float a,float b){float r;asm("v_sub_f32_e32 %0, %1, %2":"=v"(r):"v"(a),"v"(b));return r;}
typedef float f32x2_t __attribute__((ext_vector_type(2))); typedef __bf16 bf16x2_t __attribute__((ext_vector_type(2)));
__device__ __forceinline__ unsigned cvtpk_s(float lo,float hi){f32x2_t v={lo,hi};bf16x2_t b=__builtin_convertvector(v,bf16x2_t);return __builtin_bit_cast(unsigned,b);}
#define WAIT_BAR(N) asm volatile("s_waitcnt vmcnt(" #N ") lgkmcnt(0)\n\ts_barrier":::"memory")

__device__ __forceinline__ void qkt(f32x16&p0,f32x16&p1,const char*Kslot,const bf16x8*qr,const f32x16&negm,int r32,int hi){
  const char*kb=Kslot+hi*1024+r32*16;
  #pragma unroll
  for(int d0=0;d0<4;++d0){
    const bf16x8 b0=*reinterpret_cast<const bf16x8*>(kb+d0*2048);
    const bf16x8 b1=*reinterpret_cast<const bf16x8*>(kb+d0*2048+512);
    if(d0==0){p0=__builtin_amdgcn_mfma_f32_32x32x16_bf16(b0,qr[0],negm,0,0,0);p1=__builtin_amdgcn_mfma_f32_32x32x16_bf16(b1,qr[0],negm,0,0,0);}
    else{p0=__builtin_amdgcn_mfma_f32_32x32x16_bf16(b0,qr[d0],p0,0,0,0);p1=__builtin_amdgcn_mfma_f32_32x32x16_bf16(b1,qr[d0],p1,0,0,0);}}
}
typedef __attribute__((address_space(3))) const char* lds_cptr;
typedef short v4i16_t __attribute__((ext_vector_type(4)));
__device__ __forceinline__ void kload8(bf16x8*kf,lds_cptr kp){
  kf[0]=*(const __attribute__((address_space(3))) bf16x8*)(kp);      kf[1]=*(const __attribute__((address_space(3))) bf16x8*)(kp+512);
  kf[2]=*(const __attribute__((address_space(3))) bf16x8*)(kp+2048); kf[3]=*(const __attribute__((address_space(3))) bf16x8*)(kp+2560);
  kf[4]=*(const __attribute__((address_space(3))) bf16x8*)(kp+4096); kf[5]=*(const __attribute__((address_space(3))) bf16x8*)(kp+4608);
  kf[6]=*(const __attribute__((address_space(3))) bf16x8*)(kp+6144); kf[7]=*(const __attribute__((address_space(3))) bf16x8*)(kp+6656);
}
__device__ __forceinline__ void kload2(bf16x8*kf,lds_cptr kp,int j){ kf[2*j]=*(const __attribute__((address_space(3))) bf16x8*)(kp+j*2048); kf[2*j+1]=*(const __attribute__((address_space(3))) bf16x8*)(kp+j*2048+512); }
__device__ __forceinline__ s16x4 vtr(lds_cptr p){ return __builtin_bit_cast(s16x4,__builtin_amdgcn_ds_read_tr16_b64_v4i16((__attribute__((address_space(3))) v4i16_t*)p)); }
__device__ __forceinline__ float rowmax(const f32x16&p0,const f32x16&p1){
  float a=max3f(p0[0],p0[1],p1[0]),b=max3f(p0[2],p0[3],p1[1]);a=max3f(a,p1[2],p1[3]);
  #pragma unroll
  for(int r=4;r<16;r+=4){a=max3f(a,p0[r],p0[r+1]);b=max3f(b,p0[r+2],p0[r+3]);a=max3f(a,p1[r],p1[r+1]);b=max3f(b,p1[r+2],p1[r+3]);}
  const float m=max2f(a,b);
  auto rr=__builtin_amdgcn_permlane32_swap(__float_as_uint(m),__float_as_uint(m),false,false);
  return max2f(__uint_as_float(rr[0]),__uint_as_float(rr[1]));
}
__device__ __forceinline__ void pv(f32x16*o,int vb,bf16x8 pa0,bf16x8 pa1,bf16x8 pa2,bf16x8 pa3){
  #pragma unroll
  for(int d0=0;d0<2;++d0){s16x4 lo[4],hi[4];
    #pragma unroll
    for(int ks=0;ks<4;++ks){
      asm volatile("ds_read_b64_tr_b16 %0,%1 offset:%c2":"=&v"(lo[ks]):"v"(vb),"i"(d0*4096+ks*1024):"memory");
      asm volatile("ds_read_b64_tr_b16 %0,%1 offset:%c2":"=&v"(hi[ks]):"v"(vb),"i"(d0*4096+ks*1024+512):"memory");}
    asm volatile("s_waitcnt lgkmcnt(0)":::"memory");SBAR();
    #define PK(k) (bf16x8){lo[k][0],lo[k][1],lo[k][2],lo[k][3],hi[k][0],hi[k][1],hi[k][2],hi[k][3]}
    o[d0]=__builtin_amdgcn_mfma_f32_32x32x16_bf16(pa0,PK(0),o[d0],0,0,0);
    o[d0]=__builtin_amdgcn_mfma_f32_32x32x16_bf16(pa1,PK(1),o[d0],0,0,0);
    o[d0]=__builtin_amdgcn_mfma_f32_32x32x16_bf16(pa2,PK(2),o[d0],0,0,0);
    o[d0]=__builtin_amdgcn_mfma_f32_32x32x16_bf16(pa3,PK(3),o[d0],0,0,0);
    #undef PK
  }
}

#ifndef ATTN_STORE16
#define ATTN_STORE16(p,v) (*(u32x4*)(p)=(v))
#endif
template<int THRL> __device__ __forceinline__ void attn_unit(long rowbase,int qb,const bf16*Qc,const bf16*__restrict__ Kc,const bf16*__restrict__ Vc,bf16*Oc,char*shm){
  int tid_=threadIdx.x; asm volatile("":"+v"(tid_)); const int tid=tid_,lane=tid&63,r32=lane&31,hi=lane>>5; const int wid=__builtin_amdgcn_readfirstlane(tid>>6);
  const int q0=qb*QB;
  const bf16*Qw=Qc+(rowbase+q0+wid*QBLK)*DM;
  const bf16*Kh=Kc+rowbase*DM,*Vh=Vc+rowbase*DM;
  const unsigned lds0=(unsigned)(uintptr_t)shm;
  float*wsf=(float*)(shm+LDS_WS)+wid*64;
  const unsigned koff=(unsigned)(lane*DM+wid*8)*2u;
  const unsigned voffv=(unsigned)((16*(wid&3)+(lane>>2))*DM+(wid>>2)*32+(lane&3)*8)*2u;
  const unsigned kdst=lds0+LDS_K+wid*1024, vdst=lds0+LDS_V+wid*1024;
  #define DMA_K(t,slot) glds16s(Kh+(long)(t)*KVBLK*DM,koff,(unsigned)__builtin_amdgcn_readfirstlane(kdst+(slot)))
  #define DMA_V(t,slot) do{ glds16s(Vh+(long)(t)*KVBLK*DM,voffv,(unsigned)__builtin_amdgcn_readfirstlane(vdst+2*(slot))); glds16s(Vh+(long)(t)*KVBLK*DM+64,voffv,(unsigned)__builtin_amdgcn_readfirstlane(vdst+2*(slot)+8192)); }while(0)
  const int vb0=(int)(lds0+LDS_V)+((lane>>4)&1)*32+(lane&3)*8+(4*hi+((lane&15)>>2))*64;
  const char*Kbase=shm+LDS_K; bf16x8 kf[8];
  const lds_cptr shm3=(lds_cptr)shm; const lds_cptr kp0=shm3+LDS_K+hi*1024+r32*16; const lds_cptr vp0=shm3+LDS_V+((lane>>4)&1)*32+(lane&3)*8+(4*hi+((lane&15)>>2))*64;
  const int NT=(q0+QB)/KVBLK;
  DMA_K(0,0);DMA_V(0,0);DMA_K(1,SLOTB);
  bf16x8 qr[4];
  #pragma unroll
  for(int d0=0;d0<4;++d0)qr[d0]=*reinterpret_cast<const bf16x8*>(&Qw[(long)r32*DM+d0*16+hi*8]);
  float mhat=0.f,l_reg=0.f;f32x16 o[4];o[0]=f32x16{};o[1]=f32x16{};o[2]=f32x16{};o[3]=f32x16{};const f32x16 zf=f32x16{};
  const int qrel=wid*QBLK+r32;
  #define CMASK(P0,P1,t) do{int jb_=(t)-(NT-4); if(jb_>=0)cmask(P0,P1,jb_,qrel,hi);}while(0)
  bool resc=false;
  #define START(P0,P1) do{ const float rm=rowmax(P0,P1); resc=false; \
    { const float dl=rm; mhat=fadd_s(mhat,dl); \
      _Pragma("unroll") for(int r=0;r<16;++r){P0[r]=fsub_s(P0[r],dl);P1[r]=fsub_s(P1[r],dl);} \
      } \
    _Pragma("unroll") for(int r=0;r<16;++r)P0[r]=__builtin_amdgcn_exp2f(P0[r]); }while(0)
  #define RESC() do{ if(resc){ asm volatile("s_waitcnt lgkmcnt(0)":::"memory"); \
      _Pragma("unroll") for(int d_=0;d_<4;++d_) _Pragma("unroll") for(int r=0;r<16;++r)o[d_][r]*=wsf[crow(r,hi)]; } }while(0)
  f32x16 pA0,pA1,pB0,pB1;
  int sl_prev=0,sl_cur=0,sl_next=SLOTB;
  #define ROT() do{sl_prev=sl_cur;sl_cur=sl_next;sl_next=(sl_next==(NSLOT-1)*SLOTB)?0:sl_next+SLOTB;}while(0)
  DMA_K(2,2*SLOTB);
  WAIT_BAR(4);
  qkt(pA0,pA1,Kbase,qr,zf,r32,hi);asm volatile("s_nop 15\n\ts_nop 7":"+v"(pA0),"+v"(pA1));CMASK(pA0,pA1,0);
  START(pA0,pA1);
  _Pragma("unroll") for(int r=0;r<16;++r)pA1[r]=__builtin_amdgcn_exp2f(pA1[r]);
  WAIT_BAR(0);
  DMA_K(3,0);DMA_V(1,SLOTB);
  ROT();
  kload8(kf,kp0+sl_cur);
  WAIT_BAR(3);
  s16x4 vlo[8],vhi[8]; u32x4 pw0,pw1,pw2,pw3;
  #define PKW(P,B) cvtpk_s(P[B],P[B+1])
  #define PAF(k) __builtin_bit_cast(bf16x8,pw##k)
  #define VFR(i) (bf16x8){vlo[i][0],vlo[i][1],vlo[i][2],vlo[i][3],vhi[i][0],vhi[i][1],vhi[i][2],vhi[i][3]}
  #define PIN(x) asm volatile("":"+v"(x))
  #define MX3(a,b,c) __builtin_fmaxf(__builtin_fmaxf((a),(b)),(c))
  #define GAPA(MF,A0,A1,A2,A3,W0,W1,PW) do{ MF; sacc+=A0; sacc+=A1; sacc+=A2; sacc+=A3; PIN(sacc); W0; W1; PIN(PW); SBAR(); }while(0)
  #define EX(v) __builtin_amdgcn_exp2f(v)
  #define GAPB(MF,X,B) do{ MF; X[B]=EX(X[B]); X[B+1]=EX(X[B+1]); X[B+2]=EX(X[B+2]); X[B+3]=EX(X[B+3]); PIN(X); SBAR(); }while(0)
  #define VRD(i) do{ vlo[i]=vtr(vp_+(((i)>>2)*4096+((i)&3)*1024)); vhi[i]=vtr(vp_+(((i)>>2)*4096+((i)&3)*1024+512)); }while(0)
  #define KRD(G,j) do{ if(G){ kload2(kf,kp0+sl_next,j); SBAR(); } }while(0)
  #define VRD2(i) do{ vlo[i]=vtr(vp_+(8192+((i)>>2)*4096+((i)&3)*1024)); vhi[i]=vtr(vp_+(8192+((i)>>2)*4096+((i)&3)*1024+512)); SBAR(); }while(0)
  #define STEP(C0,C1,P0,P1,t,GK,GV,GL) do{ SBAR(); \
    const lds_cptr vp_=vp0+2*sl_prev; \
    VRD(0); SBAR(); float sacc=(P0[0]+P0[1]); \
    GAPA(C0=__builtin_amdgcn_mfma_f32_32x32x16_bf16(kf[0],qr[0],zf,0,0,0), P0[2],P0[3],P0[4],P0[5],     pw0[0]=PKW(P0,0), pw0[1]=PKW(P0,2), pw0); \
    VRD(4); SBAR(); GAPA(C1=__builtin_amdgcn_mfma_f32_32x32x16_bf16(kf[1],qr[0],zf,0,0,0), P0[6],P0[7],P0[8],P0[9],     pw0[2]=PKW(P0,4), pw0[3]=PKW(P0,6), pw0); \
    VRD(1); SBAR(); GAPA(C0=__builtin_amdgcn_mfma_f32_32x32x16_bf16(kf[2],qr[1],C0,0,0,0),   P0[10],P0[11],P0[12],P0[13], pw1[0]=PKW(P0,8), pw1[1]=PKW(P0,10), pw1); \
    VRD(5); SBAR(); GAPA(C1=__builtin_amdgcn_mfma_f32_32x32x16_bf16(kf[3],qr[1],C1,0,0,0),   P0[14],P0[15],P1[0],P1[1],   pw1[2]=PKW(P0,12),pw1[3]=PKW(P0,14), pw1); \
    VRD(2); SBAR(); GAPA(C0=__builtin_amdgcn_mfma_f32_32x32x16_bf16(kf[4],qr[2],C0,0,0,0),   P1[2],P1[3],P1[4],P1[5],     pw2[0]=PKW(P1,0), pw2[1]=PKW(P1,2), pw2); \
    VRD(6); SBAR(); GAPA(C1=__builtin_amdgcn_mfma_f32_32x32x16_bf16(kf[5],qr[2],C1,0,0,0),   P1[6],P1[7],P1[8],P1[9],     pw2[2]=PKW(P1,4), pw2[3]=PKW(P1,6), pw2); \
    VRD(3); SBAR(); GAPA(C0=__builtin_amdgcn_mfma_f32_32x32x16_bf16(kf[6],qr[3],C0,0,0,0),   P1[10],P1[11],P1[12],P1[13], pw3[0]=PKW(P1,8), pw3[1]=PKW(P1,10), pw3); \
    VRD(7); SBAR(); GAPA(C1=__builtin_amdgcn_mfma_f32_32x32x16_bf16(kf[7],qr[3],C1,0,0,0),   P1[14],P1[15],0.f,0.f,       pw3[2]=PKW(P1,12),pw3[3]=PKW(P1,14), pw3); \
    l_reg+=sacc; \
    if(GK){DMA_K((t)+3,sl_cur);} if(GV){DMA_V((t)+1,sl_next);} \
    _Pragma("unroll") for(int r=0;r<16;++r){C0[r]-=mhat;C1[r]-=mhat;} \
    CMASK(C0,C1,t); \
    { float a=MX3(C0[0],C0[1],C1[0]),b=MX3(C0[2],C0[3],C1[1]); a=MX3(a,C1[2],C1[3]); \
      _Pragma("unroll") for(int r=4;r<16;r+=4){a=MX3(a,C0[r],C0[r+1]);b=MX3(b,C0[r+2],C0[r+3]);a=MX3(a,C1[r],C1[r+1]);b=MX3(b,C1[r+2],C1[r+3]);} \
      float rm=__builtin_fmaxf(a,b); { auto rr=__builtin_amdgcn_permlane32_swap(__float_as_uint(rm),__float_as_uint(rm),false,false); rm=__builtin_fmaxf(__uint_as_float(rr[0]),__uint_as_float(rr[1])); } \
      resc=false; \
      if(__builtin_expect(__any(rm>(float)THRL),0)){ const float dl=__builtin_fmaxf(rm,0.f); mhat+=dl; \
        _Pragma("unroll") for(int r=0;r<16;++r){C0[r]-=dl;C1[r]-=dl;} \
        const float f=__builtin_amdgcn_exp2f(-dl); l_reg*=f; if(hi==0)wsf[r32]=f; resc=true; } } \
    SBAR(); \
    GAPB(o[0]=__builtin_amdgcn_mfma_f32_32x32x16_bf16(PAF(0),VFR(0),o[0],0,0,0), C0,0); VRD2(0); \
    GAPB(o[1]=__builtin_amdgcn_mfma_f32_32x32x16_bf16(PAF(0),VFR(4),o[1],0,0,0), C0,4); VRD2(4); \
    KRD(GL,0); GAPB(o[0]=__builtin_amdgcn_mfma_f32_32x32x16_bf16(PAF(1),VFR(1),o[0],0,0,0), C0,8); VRD2(1); \
    KRD(GL,1); GAPB(o[1]=__builtin_amdgcn_mfma_f32_32x32x16_bf16(PAF(1),VFR(5),o[1],0,0,0), C0,12); VRD2(5); \
    KRD(GL,2); GAPB(o[0]=__builtin_amdgcn_mfma_f32_32x32x16_bf16(PAF(2),VFR(2),o[0],0,0,0), C1,0); VRD2(2); \
    KRD(GL,3); GAPB(o[1]=__builtin_amdgcn_mfma_f32_32x32x16_bf16(PAF(2),VFR(6),o[1],0,0,0), C1,4); VRD2(6); \
    GAPB(o[0]=__builtin_amdgcn_mfma_f32_32x32x16_bf16(PAF(3),VFR(3),o[0],0,0,0), C1,8); VRD2(3); \
    GAPB(o[1]=__builtin_amdgcn_mfma_f32_32x32x16_bf16(PAF(3),VFR(7),o[1],0,0,0), C1,12); VRD2(7); \
    o[2]=__builtin_amdgcn_mfma_f32_32x32x16_bf16(PAF(0),VFR(0),o[2],0,0,0); o[3]=__builtin_amdgcn_mfma_f32_32x32x16_bf16(PAF(0),VFR(4),o[3],0,0,0); \
    o[2]=__builtin_amdgcn_mfma_f32_32x32x16_bf16(PAF(1),VFR(1),o[2],0,0,0); o[3]=__builtin_amdgcn_mfma_f32_32x32x16_bf16(PAF(1),VFR(5),o[3],0,0,0); \
    o[2]=__builtin_amdgcn_mfma_f32_32x32x16_bf16(PAF(2),VFR(2),o[2],0,0,0); o[3]=__builtin_amdgcn_mfma_f32_32x32x16_bf16(PAF(2),VFR(6),o[3],0,0,0); \
    o[2]=__builtin_amdgcn_mfma_f32_32x32x16_bf16(PAF(3),VFR(3),o[2],0,0,0); o[3]=__builtin_amdgcn_mfma_f32_32x32x16_bf16(PAF(3),VFR(7),o[3],0,0,0); SBAR(); \
    }while(0)
  int t=1;
  #undef CMASK
  #define CMASK(P0,P1,t) do{}while(0)
  for(;t+5<NT;t+=2){
    STEP(pB0,pB1,pA0,pA1,t,true,true,true);     WAIT_BAR(3); RESC(); ROT();
    STEP(pA0,pA1,pB0,pB1,t+1,true,true,true);   WAIT_BAR(3); RESC(); ROT();
  }
  #undef CMASK
  #define CMASK(P0,P1,t) do{int jb_=(t)-(NT-4); if(jb_>=0)cmask(P0,P1,jb_,qrel,hi);}while(0)
  #define ENDW(tt) do{ if((tt)+3<NT){WAIT_BAR(3);} else if((tt)+2<NT){WAIT_BAR(2);} else {WAIT_BAR(0);} }while(0)
  for(;t+1<NT;t+=2){
    STEP(pB0,pB1,pA0,pA1,t,(t+3<NT),(t+1<NT),(t+1<NT));       ENDW(t);   RESC(); ROT();
    STEP(pA0,pA1,pB0,pB1,t+1,(t+4<NT),(t+2<NT),(t+2<NT));     ENDW(t+1); RESC(); ROT();
  }
  STEP(pB0,pB1,pA0,pA1,NT-1,false,false,false); RESC();
  { float sacc=pB0[0]+pB0[1]; _Pragma("unroll") for(int r=2;r<16;++r)sacc+=pB0[r]; _Pragma("unroll") for(int r=0;r<16;++r)sacc+=pB1[r]; l_reg+=sacc;
    pw0=(u32x4){PKW(pB0,0),PKW(pB0,2),PKW(pB0,4),PKW(pB0,6)};pw1=(u32x4){PKW(pB0,8),PKW(pB0,10),PKW(pB0,12),PKW(pB0,14)};pw2=(u32x4){PKW(pB1,0),PKW(pB1,2),PKW(pB1,4),PKW(pB1,6)};pw3=(u32x4){PKW(pB1,8),PKW(pB1,10),PKW(pB1,12),PKW(pB1,14)};
    SBAR(); pv(o,vb0+2*sl_cur,PAF(0),PAF(1),PAF(2),PAF(3)); pv(o+2,vb0+2*sl_cur+8192,PAF(0),PAF(1),PAF(2),PAF(3)); }
  #undef PKW
  #undef PAF
  #undef VFR
  #undef PIN
  #undef MX3
  #undef GAPA
  #undef GAPB
  #undef EX
  #undef VRD
  #undef KRD
  #undef VRD2
  #undef STEP
  #undef ENDW
  {auto rr=__builtin_amdgcn_permlane32_swap(__float_as_uint(l_reg),__float_as_uint(l_reg),false,false);l_reg=__uint_as_float(rr[0])+__uint_as_float(rr[1]);}
  if(hi==0)wsf[32+r32]=l_reg;asm volatile("s_waitcnt lgkmcnt(0)":::"memory");
  float rli[16];
  #pragma unroll
  for(int r=0;r<16;++r)rli[r]=__builtin_amdgcn_rcpf(wsf[32+crow(r,hi)]);
  bf16*Ow=Oc+(rowbase+q0+wid*QBLK)*DM;
  { bf16*stg=(bf16*)(shm+LDS_OST)+wid*4096;
    #pragma unroll
    for(int r=0;r<16;++r){const int orow=crow(r,hi);
      #pragma unroll
      for(int d0=0;d0<4;++d0)stg[orow*128+d0*32+r32]=__float2bfloat16(o[d0][r]*rli[r]);}
    asm volatile("s_waitcnt lgkmcnt(0)":::"memory");
    #pragma unroll
    for(int i=0;i<8;++i){const int row=i*4+(lane>>4),ch=lane&15; const u32x4 v=*(const u32x4*)(stg+row*128+ch*8); ATTN_STORE16(Ow+(long)row*DM+ch*8,v);} }
  asm volatile("s_waitcnt lgkmcnt(0)\n\ts_barrier":::"memory");
  #undef DMA_K
  #undef DMA_V
  #undef CMASK
  #undef START
  #undef RESC
  #undef ROT
}
constexpr int ATTN_LDS_BYTES=LDS_BYTES;
#undef SBAR
#undef WAIT_BAR
}
namespace mk {
#define GAS __attribute__((address_space(1)))
#define LAS __attribute__((address_space(3)))
typedef unsigned short bf16;
typedef unsigned v4u __attribute__((ext_vector_type(4)));
typedef unsigned v2u __attribute__((ext_vector_type(2)));
typedef float f32x4 __attribute__((ext_vector_type(4)));
using pg8::Unit;
using pg8::cvt_pk_bf16;

constexpr int D = 1024, BATCH = 8, SEQ = 2048, T = BATCH * SEQ, NH = 8, NG = 4, EPG = 8, NE = 32, DE = 512, NRW = NG + NE;
constexpr float ALPHA = 1.4142135623730951f, LN_EPS = 1e-5f, RMS_EPS = 1e-5f;
constexpr float LAM_INIT = 0.35550906f;
constexpr float QSCALE = 0.125f * 1.4426950408889634f;
constexpr int CNT_STRIDE = 64;
constexpr int CAP = T;
constexpr int NWAVES = 8, NTHREADS = 512;
#ifndef P0B_FILL
#define P0B_FILL 1
#endif
#ifndef MOE_MERGE
#define MOE_MERGE 0
#endif
#ifndef P0B_SPLIT
#define P0B_SPLIT 8192
#endif

constexpr size_t MiB = 1u << 20;
constexpr size_t WS_CTL = 0, WS_W1T = 1 * MiB, WS_W2T = 7 * MiB, WS_WKVQ = 9 * MiB, WS_WOT = 15 * MiB, WS_RWT = 17 * MiB;
constexpr size_t WS_RWH = 17 * MiB + 512 * 1024;
constexpr size_t WS_WUT = 24 * MiB, WS_WDT = 152 * MiB, WS_XB = 216 * MiB, WS_GB = 248 * MiB, WS_U = 280 * MiB, WS_A2 = 312 * MiB, WS_Z = 344 * MiB, WS_X1B = 408 * MiB;
constexpr size_t WS_ACT = 440 * MiB, WS_YP = 480 * MiB, WS_X2B = 544 * MiB, WS_K = 576 * MiB, WS_V = 608 * MiB, WS_Q = 640 * MiB, WS_O0 = 672 * MiB, WS_O1 = 704 * MiB;
constexpr size_t WS_A3 = 736 * MiB, WS_X3B = 768 * MiB;
#ifdef MKPROBE
constexpr size_t WS_PERM = 18 * MiB;
constexpr size_t WS_Z1 = 800 * MiB, WS_ACT1 = 864 * MiB, WS_YP1 = 904 * MiB, WS_PERM1 = 968 * MiB, WS_END = 972 * MiB;
#else
constexpr size_t WS_PERM = 18 * MiB;
constexpr size_t WS_Z1 = WS_Z, WS_ACT1 = WS_ACT, WS_YP1 = WS_YP, WS_PERM1 = WS_PERM, WS_END = 800 * MiB;
#endif
#define LZ(l) ((l) ? WS_Z1 : WS_Z)
#define LACT(l) ((l) ? WS_ACT1 : WS_ACT)
#define LYP(l) ((l) ? WS_YP1 : WS_YP)
#define LPERM(l) ((l) ? WS_PERM1 : WS_PERM)
constexpr int RWH_PITCH = 2064  , RWH_BYTES = 2 * 36 * RWH_PITCH  ;
constexpr int RWH_PAD = 149504;
constexpr int RING_BYTES = 131072, RW_BYTES = RWH_PAD  , MISC_OFF = RW_BYTES, LDS_BYTES = 163840;

struct Args {
    const float *x, *a_w_in, *a_conv_w, *a_w_out, *kv_w, *b_w_q, *b_lambda, *b_subln_g, *b_w_o, *ln1_g, *ln1_b, *ln2_g, *ln2_b, *rg_w, *rg_b, *re_w, *re_b, *e_w_in, *e_w_down;
    float* out; unsigned char* ws;
};

typedef const __attribute__((address_space(4))) Args* ArgsP;
__device__ __forceinline__ ArgsP kargs() { ArgsP p = (ArgsP)__builtin_amdgcn_kernarg_segment_ptr(); asm volatile("" : "+s"(p)); return p; }
struct Ctx { int tid, lane, wave, G, bx, gw, NGW; unsigned char* ws; };
__device__ __forceinline__ Ctx mkctx(ArgsP ap) { Ctx c; int t = threadIdx.x; asm volatile("" : "+v"(t)); c.tid = t; c.lane = t & 63; c.wave = __builtin_amdgcn_readfirstlane(t >> 6);
    c.G = gridDim.x; c.bx = blockIdx.x; c.gw = c.bx * 8 + c.wave; c.NGW = c.G * 8; c.ws = ap->ws; return c; }
__device__ __forceinline__ unsigned f2bf(float f) { unsigned u = __builtin_bit_cast(unsigned, f); return (u + 0x7fffu + ((u >> 16) & 1u)) >> 16; }
__device__ __forceinline__ unsigned pk2(float lo, float hi) { return f2bf(lo) | (f2bf(hi) << 16); }
__device__ __forceinline__ float bflo(unsigned w) { return __builtin_bit_cast(float, w << 16); }
__device__ __forceinline__ float bfhi(unsigned w) { return __builtin_bit_cast(float, w & 0xffff0000u); }
__device__ __forceinline__ f32x4 ldz4(const bf16* p) { const v2u w = *(const v2u*)p; return (f32x4){bflo(w.x), bfhi(w.x), bflo(w.y), bfhi(w.y)}; }
__device__ __forceinline__ float wave_sum(float v) {
#pragma unroll
    for (int o = 1; o < 64; o <<= 1) v += __shfl_xor(v, o);
    return v;
}

__device__ __forceinline__ float dpp_add(float v, const int ctrl_sel) {
    const int iv = __builtin_bit_cast(int, v); int t;
    if (ctrl_sel == 0) t = __builtin_amdgcn_update_dpp(0, iv, 0xB1, 0xF, 0xF, true);
    else if (ctrl_sel == 1) t = __builtin_amdgcn_update_dpp(0, iv, 0x4E, 0xF, 0xF, true);
    else if (ctrl_sel == 2) t = __builtin_amdgcn_update_dpp(0, iv, 0x141, 0xF, 0xF, true);
    else if (ctrl_sel == 3) t = __builtin_amdgcn_update_dpp(0, iv, 0x140, 0xF, 0xF, true);
    else if (ctrl_sel == 4) t = __builtin_amdgcn_update_dpp(0, iv, 0x142, 0xA, 0xF, false);
    else t = __builtin_amdgcn_update_dpp(0, iv, 0x143, 0xC, 0xF, false);
    return v + __builtin_bit_cast(float, t);
}
template <int N> __device__ __forceinline__ void dpp_sum(float (&v)[N]) {
#pragma unroll
    for (int st = 0; st < 6; ++st) {
#pragma unroll
        for (int i = 0; i < N; ++i) v[i] = dpp_add(v[i], st);
    }
#pragma unroll
    for (int i = 0; i < N; ++i) v[i] = __builtin_bit_cast(float, __builtin_amdgcn_readlane(__builtin_bit_cast(int, v[i]), 63));
}
__device__ __forceinline__ float dpp_sum1(float v) { float a[1] = {v}; dpp_sum(a); return a[0]; }

__device__ __forceinline__ void p0_transpose_item(const float* W, int K, int N, bf16* WT, int row_off, LAS float* scr, int item, int lane) {
    const int nblk = N / 64, kb = item / nblk, nb = item % nblk, k0 = 64 * kb, n0 = 64 * nb;
    const float* src = W + (size_t)(k0 + (lane >> 4)) * N + n0 + (lane & 15) * 4;
    f32x4 v[16];
#pragma unroll
    for (int i = 0; i < 16; ++i) v[i] = __builtin_nontemporal_load((const f32x4*)(src + (size_t)(4 * i) * N));
#pragma unroll
    for (int i = 0; i < 16; ++i) { LAS float* d = scr + (4 * i + (lane >> 4)) * 65 + (lane & 15) * 4; d[0] = v[i].x; d[1] = v[i].y; d[2] = v[i].z; d[3] = v[i].w; }
    asm volatile("s_waitcnt lgkmcnt(0)" ::: "memory");
    const int c = lane & 7;
#pragma unroll
    for (int j = 0; j < 8; ++j) { const int n = (lane >> 3) + 8 * j; const LAS float* s = scr + (8 * c) * 65 + n;
        v4u o; o.x = pk2(s[0 * 65], s[1 * 65]); o.y = pk2(s[2 * 65], s[3 * 65]); o.z = pk2(s[4 * 65], s[5 * 65]); o.w = pk2(s[6 * 65], s[7 * 65]);
        *(GAS v4u*)(WT + (size_t)(row_off + n0 + n) * K + k0 + 8 * c) = o; }
    asm volatile("s_waitcnt lgkmcnt(0)" ::: "memory");
}

constexpr int I_IN = 16 * 48, I_SQ = 16 * 16, I_KV = 16 * 32, I_DN = 8 * 16;
constexpr int NEM = P0B_FILL ? NE : 2 * NE;
constexpr int PS1 = I_IN, PS2 = PS1 + I_SQ, PS3 = PS2 + I_KV, PS4 = PS3 + I_SQ, PS5 = PS4 + I_SQ, PS6 = PS5 + NEM * I_SQ, P0_NITEMS = PS6 + NEM * I_DN;
__device__ __forceinline__ void p0_items(LAS unsigned char* lds, int lo, int hi, int w, int nw) {
    const ArgsP a = kargs(); const Ctx cx = mkctx(a); const int lane = cx.lane; unsigned char* ws = cx.ws;
    LAS float* scr = (LAS float*)(lds + cx.wave * 16640);
    for (int it = lo + w; it < hi; it += nw) {
        if (it < PS1) p0_transpose_item(a->a_w_in, D, 3 * D, (bf16*)(ws + WS_W1T), 0, scr, it, lane);
        else if (it < PS2) p0_transpose_item(a->a_w_out, D, D, (bf16*)(ws + WS_W2T), 0, scr, it - PS1, lane);
        else if (it < PS3) p0_transpose_item(a->kv_w, D, 2 * D, (bf16*)(ws + WS_WKVQ), 0, scr, it - PS2, lane);
        else if (it < PS4) p0_transpose_item(a->b_w_q, D, D, (bf16*)(ws + WS_WKVQ), 2 * D, scr, it - PS3, lane);
        else if (it < PS5) p0_transpose_item(a->b_w_o, D, D, (bf16*)(ws + WS_WOT), 0, scr, it - PS4, lane);
        else if (it < PS6) { const int r = it - PS5, mtx = r / I_SQ; p0_transpose_item(a->e_w_in + (size_t)mtx * D * D, D, D, (bf16*)(ws + WS_WUT) + (size_t)mtx * D * D, 0, scr, r % I_SQ, lane); }
        else { const int r = it - PS6, mtx = r / I_DN; p0_transpose_item(a->e_w_down + (size_t)mtx * DE * D, DE, D, (bf16*)(ws + WS_WDT) + (size_t)mtx * D * DE, 0, scr, r % I_DN, lane); }
    }
}
#ifndef ROLE_SPLIT
#define ROLE_SPLIT 1
#endif
#ifndef P0A_EXTRA
#define P0A_EXTRA 5632
#endif
__device__ __forceinline__ void p0_prologue(LAS unsigned char* lds) {
    const ArgsP a = kargs(); const Ctx cx = mkctx(a); const int gw = cx.gw, NGW = cx.NGW, lane = cx.lane;
    unsigned char* ws = cx.ws;
    p0_items(lds, 0, ROLE_SPLIT ? PS1 + P0A_EXTRA : P0_NITEMS, gw, NGW);
    for (int m = gw; m < T; m += NGW) {
        const GAS f32x4* xr = (const GAS f32x4*)(a->x + (size_t)m * D) + lane;
        GAS v2u* o = (GAS v2u*)((bf16*)(ws + WS_XB) + (size_t)m * D) + lane;
#pragma unroll
        for (int j = 0; j < 4; ++j) { const f32x4 v = xr[64 * j]; v2u w; w.x = pk2(v.x, v.y); w.y = pk2(v.z, v.w); o[64 * j] = w; }
    }
    { float* rwt = (float*)(ws + WS_RWT);
      for (int idx = gw * 64 + lane; idx < 2 * NRW * D; idx += NGW * 64) { const int l = idx / (NRW * D), n = (idx / D) % NRW, k = idx % D;
          const float w = n < NG ? a->rg_w[((size_t)l * D + k) * NG + n] : a->re_w[((size_t)l * D + k) * NE + (n - NG)];
          rwt[idx] = w;
          const unsigned hi = f2bf(w), lo = f2bf(w - __builtin_bit_cast(float, hi << 16));
          bf16* img = (bf16*)(ws + WS_RWH) + (size_t)l * (RWH_PAD / 2);
          img[(size_t)n * (RWH_PITCH / 2) + k] = (bf16)hi; img[(size_t)(NRW + n) * (RWH_PITCH / 2) + k] = (bf16)lo; } }
}
__device__ __forceinline__ void p0b_fill(LAS unsigned char* lds, int lo, int hi, int r, int nidle) {
    const ArgsP a = kargs(); const Ctx cx = mkctx(a); unsigned char* ws = cx.ws;
    LAS float* scr = (LAS float*)(lds + cx.wave * 16640);
    for (int it = lo + r * NWAVES + cx.wave; it < hi; it += nidle * NWAVES) {
        if (it < NE * 256) { const int mtx = NE + it / 256; p0_transpose_item(a->e_w_in + (size_t)mtx * D * D, D, D, (bf16*)(ws + WS_WUT) + (size_t)mtx * D * D, 0, scr, it % 256, cx.lane); }
        else { const int r2 = it - NE * 256, mtx = NE + r2 / 128; p0_transpose_item(a->e_w_down + (size_t)mtx * DE * D, DE, D, (bf16*)(ws + WS_WDT) + (size_t)mtx * D * DE, 0, scr, r2 % 128, cx.lane); }
    }
}
constexpr int P0B_ITEMS = NE * 256 + NE * 128;
__device__ __forceinline__ void p0b_idle_fill(LAS unsigned char* lds, int lo, int hi) {
    const ArgsP a = kargs(); const Ctx cx = mkctx(a); const LAS int* misc = (const LAS int*)(lds + MISC_OFF);
    const int U = misc[2 * NE], rem = U % cx.G;
    if (rem == 0) p0b_fill(lds, lo, hi, cx.bx, cx.G);
    else if (cx.bx >= rem) p0b_fill(lds, lo, hi, cx.bx - rem, cx.G - rem);
}
struct SchedDense {
    int G, c, nN, mode, K; const char* W;
    __device__ __forceinline__ bool next(int i, Unit& u) const {
        int pm, pn; if (!pg8::static_tile(i, G, c, T / 256, nN, pm, pn)) return false;
        u.arow = pm * 256; u.p0 = pm; u.p1 = pn; u.p2 = 0; u.p3 = 0;
        const size_t rb = (size_t)K * 2;
        if (mode == 0 && pn >= 4) { const int jj = pn - 4; u.b0 = W + (size_t)(D + 128 * jj) * rb; u.b1 = W + (size_t)(2 * D + 128 * jj) * rb; }
        else { u.b0 = W + (size_t)(256 * pn) * rb; u.b1 = u.b0 + 128 * rb; }
        return true;
    }
    __device__ __forceinline__ void a_offs(const Unit& u, const int (&R)[2], const int (&C)[2], unsigned& v00, unsigned& v01, unsigned& v10, unsigned& v11) const {
        v00 = (unsigned)((u.arow + R[0]) * K + C[0]) * 2u; v01 = (unsigned)((u.arow + R[1]) * K + C[1]) * 2u;
        v10 = (unsigned)((u.arow + 128 + R[0]) * K + C[0]) * 2u; v11 = (unsigned)((u.arow + 128 + R[1]) * K + C[1]) * 2u;
    }
    __device__ __forceinline__ bool half_only(const Unit&) const { return false; }
    __device__ __forceinline__ unsigned peek(const Unit&) const { return 0u; }
    __device__ __forceinline__ void a_ready(const Unit&, unsigned) const {}
    __device__ __forceinline__ void done(const Unit&) const {}
};
struct MoeTab { const LAS int* ub; const LAS int* ps; const LAS int* cn; };
struct SchedMoe {
    int G, c, K; bool up; const char* W; const v2u* perm; MoeTab tb;
    unsigned* ready; int hook; int off, nb;
    __device__ __forceinline__ bool half_only(const Unit& u) const { return u.p2 <= 128; }
    __device__ __forceinline__ unsigned peek(const Unit& u) const {
        return hook == 2 ? __hip_atomic_load(ready + 64 * u.p3, __ATOMIC_RELAXED, __HIP_MEMORY_SCOPE_AGENT) : 0u;
    }
    __device__ __forceinline__ void a_ready(const Unit& u, unsigned pk) const {
        if (hook != 2) return;
        if ((unsigned)__builtin_amdgcn_readfirstlane(pk) >= 32u) return;
        const unsigned long long t0 = __builtin_amdgcn_s_memrealtime();
        while ((unsigned)__builtin_amdgcn_readfirstlane(__hip_atomic_load(ready + 64 * u.p3, __ATOMIC_RELAXED, __HIP_MEMORY_SCOPE_AGENT)) < 32u) {
            if (__builtin_amdgcn_s_memrealtime() - t0 > 2000000ull) break;
            __builtin_amdgcn_s_sleep(2); }
        __builtin_amdgcn_fence(__ATOMIC_ACQUIRE, "agent");
        asm volatile("s_waitcnt vmcnt(0)" ::: "memory");
    }
    __device__ __forceinline__ void done(const Unit& u) const {
        if (hook != 1) return;
        asm volatile("s_waitcnt vmcnt(0)" ::: "memory");
        if ((threadIdx.x & 63) == 0) __hip_atomic_fetch_add(ready + 64 * u.p3, 1u, __ATOMIC_RELAXED, __HIP_MEMORY_SCOPE_AGENT);
    }
    __device__ __forceinline__ bool next(int i, Unit& u) const {
        int idx = i * G + c;
        if (nb > 0) {
            const int v = c - (G - nb);
            if (v >= 0) idx = i == 0 ? v : i == 1 ? v + nb : 2 * nb + v + (i - 2) * G;
            else idx = 3 * nb + c + i * G;
        }
        if (idx >= tb.ub[2 * NE]) return false;
        const int ln = (int)__builtin_amdgcn_mbcnt_hi(~0u, __builtin_amdgcn_mbcnt_lo(~0u, 0u));
        const int k = (int)__builtin_popcountll(__ballot(idx >= tb.ub[ln])) - 1;
        const int e = k & (NE - 1), local = idx - tb.ub[k];
        int ct, rti;
        if (k < NE) { const int rtn = (tb.ub[k + 1] - tb.ub[k]) >> 2; ct = local / rtn; rti = local - ct * rtn; }
        else { ct = local; rti = (tb.cn[e] - 1) >> 8; }
        const size_t rb = (size_t)K * 2; const char* We = W + (size_t)e * D * rb;
        if (up) { u.b0 = We + (size_t)(128 * ct) * rb; u.b1 = We + (size_t)(DE + 128 * ct) * rb; u.arow = e * CAP + rti * 256; u.p0 = tb.ps[e] + rti * 256; }
        else { u.b0 = We + (size_t)(256 * ct) * rb; u.b1 = u.b0 + 128 * rb; u.arow = tb.ps[e] + rti * 256; u.p0 = e * CAP + rti * 256; }
        u.p1 = ct; u.p2 = tb.cn[e] - rti * 256; u.p3 = (tb.ps[e] >> 8) + rti;
        return true;
    }
    __device__ __forceinline__ void a_offs(const Unit& u, const int (&R)[2], const int (&C)[2], unsigned& v00, unsigned& v01, unsigned& v10, unsigned& v11) const {
        if (up) {
            const int r00 = R[0] < u.p2 ? R[0] : 0, r01 = R[1] < u.p2 ? R[1] : 0, r10 = 128 + R[0] < u.p2 ? 128 + R[0] : 0, r11 = 128 + R[1] < u.p2 ? 128 + R[1] : 0;
            const int t00 = (int)(perm[u.arow + r00].y >> 1), t01 = (int)(perm[u.arow + r01].y >> 1), t10 = (int)(perm[u.arow + r10].y >> 1), t11 = (int)(perm[u.arow + r11].y >> 1);
            v00 = (unsigned)(t00 * K + C[0]) * 2u; v01 = (unsigned)(t01 * K + C[1]) * 2u; v10 = (unsigned)(t10 * K + C[0]) * 2u; v11 = (unsigned)(t11 * K + C[1]) * 2u;
        } else {
            v00 = (unsigned)((u.arow + R[0]) * K + C[0]) * 2u; v01 = (unsigned)((u.arow + R[1]) * K + C[1]) * 2u;
            v10 = (unsigned)((u.arow + 128 + R[0]) * K + C[0]) * 2u; v11 = (unsigned)((u.arow + 128 + R[1]) * K + C[1]) * 2u;
        }
    }
};

struct EpiConvIn {
    static constexpr bool PERM = true; bf16* GB; bf16* U;
    __device__ __forceinline__ void operator()(const f32x4 (&acc)[2][2][4][2], const Unit& u, int wr, int wc, int fr, int fq) const {
        const int row0 = u.p0 * 256 + wr * 64 + fr;
        if (u.p1 < 4) {
            const int col0 = u.p1 * 256 + wc * 32 + 8 * fq;
#pragma unroll
            for (int ai = 0; ai < 2; ++ai)
#pragma unroll
                for (int m = 0; m < 4; ++m) { bf16* rowp = GB + (size_t)(row0 + ai * 128 + m * 16) * D + col0;
#pragma unroll
                    for (int bj = 0; bj < 2; ++bj) { const f32x4 v0 = acc[ai][bj][m][0], v1 = acc[ai][bj][m][1];
                        v4u w; w.x = cvt_pk_bf16(v0[0], v0[1]); w.y = cvt_pk_bf16(v0[2], v0[3]); w.z = cvt_pk_bf16(v1[0], v1[1]); w.w = cvt_pk_bf16(v1[2], v1[3]);
                        *(v4u*)(rowp + bj * 128) = w; } }
        } else {
            const int col0 = (u.p1 - 4) * 128 + wc * 32 + 8 * fq;
#pragma unroll
            for (int ai = 0; ai < 2; ++ai)
#pragma unroll
                for (int m = 0; m < 4; ++m) { const f32x4 v0 = acc[ai][0][m][0] * acc[ai][1][m][0], v1 = acc[ai][0][m][1] * acc[ai][1][m][1];
                    v4u w; w.x = cvt_pk_bf16(v0[0], v0[1]); w.y = cvt_pk_bf16(v0[2], v0[3]); w.z = cvt_pk_bf16(v1[0], v1[1]); w.w = cvt_pk_bf16(v1[2], v1[3]);
                    *(v4u*)(U + (size_t)(row0 + ai * 128 + m * 16) * D + col0) = w; }
        }
    }
};
template <bool RES_BF16> struct EpiResZ {
    static constexpr bool PERM = true; const void* res; bf16* Z;
    __device__ __forceinline__ void operator()(const f32x4 (&acc)[2][2][4][2], const Unit& u, int wr, int wc, int fr, int fq) const {
        const int row0 = u.p0 * 256 + wr * 64 + fr, col0 = u.p1 * 256 + wc * 32 + 8 * fq;
#pragma unroll
        for (int ai = 0; ai < 2; ++ai)
#pragma unroll
            for (int m = 0; m < 4; ++m) { const size_t off = (size_t)(row0 + ai * 128 + m * 16) * D + col0;
#pragma unroll
                for (int bj = 0; bj < 2; ++bj) { const size_t o = off + bj * 128; f32x4 r0, r1;
                    if (RES_BF16) { const v4u w = *(const v4u*)((const bf16*)res + o); r0 = (f32x4){bflo(w.x), bfhi(w.x), bflo(w.y), bfhi(w.y)}; r1 = (f32x4){bflo(w.z), bfhi(w.z), bflo(w.w), bfhi(w.w)}; }
                    else { r0 = *(const f32x4*)((const float*)res + o); r1 = *(const f32x4*)((const float*)res + o + 4); }
                    const f32x4 v0 = r0 * ALPHA + acc[ai][bj][m][0], v1 = r1 * ALPHA + acc[ai][bj][m][1];
                    v4u w; w.x = cvt_pk_bf16(v0[0], v0[1]); w.y = cvt_pk_bf16(v0[2], v0[3]); w.z = cvt_pk_bf16(v1[0], v1[1]); w.w = cvt_pk_bf16(v1[2], v1[3]);
                    *(v4u*)(Z + o) = w; } }
    }
};
template <bool WT> struct EpiUp {
    static constexpr bool PERM = true; bf16* ACT;
    __device__ __forceinline__ void operator()(const f32x4 (&acc)[2][2][4][2], const Unit& u, int wr, int wc, int fr, int fq) const {
        const int row0 = u.p0 + wr * 64 + fr, col0 = u.p1 * 128 + wc * 32 + 8 * fq;
#pragma unroll
        for (int ai = 0; ai < 2; ++ai)
#pragma unroll
            for (int m = 0; m < 4; ++m) { f32x4 v[2];
#pragma unroll
                for (int n = 0; n < 2; ++n) { const f32x4 g = acc[ai][0][m][n], uu = acc[ai][1][m][n];
#pragma unroll
                    for (int j = 0; j < 4; ++j) { const float e = __builtin_amdgcn_exp2f(g[j] * -1.4426950408889634f); v[n][j] = g[j] * __builtin_amdgcn_rcpf(1.0f + e) * uu[j]; } }
                v4u w; w.x = cvt_pk_bf16(v[0][0], v[0][1]); w.y = cvt_pk_bf16(v[0][2], v[0][3]); w.z = cvt_pk_bf16(v[1][0], v[1][1]); w.w = cvt_pk_bf16(v[1][2], v[1][3]);
                bf16* dst = ACT + (size_t)(row0 + ai * 128 + m * 16) * DE + col0;
                if (WT) { __hip_atomic_store((unsigned long long*)dst, ((unsigned long long)w.y << 32) | w.x, __ATOMIC_RELAXED, __HIP_MEMORY_SCOPE_AGENT);
                          __hip_atomic_store((unsigned long long*)dst + 1, ((unsigned long long)w.w << 32) | w.z, __ATOMIC_RELAXED, __HIP_MEMORY_SCOPE_AGENT); }
                else *(v4u*)dst = w; }
    }
};
struct EpiDown {
    static constexpr bool PERM = true; bf16* YP; const v2u* perm;
    __device__ __forceinline__ void operator()(const f32x4 (&acc)[2][2][4][2], const Unit& u, int wr, int wc, int fr, int fq) const {
        const int col0 = u.p1 * 256 + wc * 32 + 8 * fq;
        v2u rec[2][4];
#pragma unroll
        for (int ai = 0; ai < 2; ++ai)
#pragma unroll
            for (int m = 0; m < 4; ++m) { const int r = ai * 128 + wr * 64 + m * 16 + fr; rec[ai][m] = perm[u.p0 + (r < u.p2 ? r : 0)]; }
#pragma unroll
        for (int ai = 0; ai < 2; ++ai)
#pragma unroll
            for (int m = 0; m < 4; ++m) { const int r = ai * 128 + wr * 64 + m * 16 + fr;
                if (r < u.p2) { const int pair = (int)rec[ai][m].y; float g = __builtin_bit_cast(float, rec[ai][m].x); asm volatile("" : "+v"(g)); bf16* rowp = YP + (size_t)pair * D + col0;
#pragma unroll
                    for (int bj = 0; bj < 2; ++bj) { const f32x4 v0 = acc[ai][bj][m][0] * g, v1 = acc[ai][bj][m][1] * g;
                        v4u w; w.x = cvt_pk_bf16(v0[0], v0[1]); w.y = cvt_pk_bf16(v0[2], v0[3]); w.z = cvt_pk_bf16(v1[0], v1[1]); w.w = cvt_pk_bf16(v1[2], v1[3]);
                        *(v4u*)(rowp + bj * 128) = w; } } }
    }
};
struct EpiKVQ {
    static constexpr bool PERM = true; bf16* KB;
    __device__ __forceinline__ void operator()(const f32x4 (&acc)[2][2][4][2], const Unit& u, int wr, int wc, int fr, int fq) const {
        const int t = u.p1 >> 2; const float sc = t == 2 ? QSCALE : 1.0f;
        bf16* base = KB + (size_t)t * (32 * MiB / 2);
        const int row0 = u.p0 * 256 + wr * 64 + fr, col0 = (u.p1 & 3) * 256 + wc * 32 + 8 * fq;
#pragma unroll
        for (int ai = 0; ai < 2; ++ai)
#pragma unroll
            for (int m = 0; m < 4; ++m) { bf16* rowp = base + (size_t)(row0 + ai * 128 + m * 16) * D + col0;
#pragma unroll
                for (int bj = 0; bj < 2; ++bj) { const f32x4 v0 = acc[ai][bj][m][0] * sc, v1 = acc[ai][bj][m][1] * sc;
                    v4u w; w.x = cvt_pk_bf16(v0[0], v0[1]); w.y = cvt_pk_bf16(v0[2], v0[3]); w.z = cvt_pk_bf16(v1[0], v1[1]); w.w = cvt_pk_bf16(v1[2], v1[3]);
                    *(v4u*)(rowp + bj * 128) = w; } }
    }
};

__device__ __forceinline__ void ln_rows(f32x4 (&v)[4], const f32x4 (&gg)[4], const f32x4 (&bb)[4]) {
    float s = 0.f;
#pragma unroll
    for (int j = 0; j < 4; ++j) s += (v[j].x + v[j].y) + (v[j].z + v[j].w);
    const float mean = dpp_sum1(s) * (1.f / D); float s2 = 0.f;
#pragma unroll
    for (int j = 0; j < 4; ++j) { v[j] = v[j] - mean; s2 += (v[j].x * v[j].x + v[j].y * v[j].y) + (v[j].z * v[j].z + v[j].w * v[j].w); }
    const float rstd = 1.f / sqrtf(dpp_sum1(s2) * (1.f / D) + LN_EPS);
#pragma unroll
    for (int j = 0; j < 4; ++j) v[j] = v[j] * rstd * gg[j] + bb[j];
}
__device__ __forceinline__ float dot_lds(const f32x4 (&v)[4], const LAS f32x4* w, int lane) {
    float a = 0.f;
#pragma unroll
    for (int j = 0; j < 4; ++j) { const f32x4 ww = w[64 * j + lane]; a += (v[j].x * ww.x + v[j].y * ww.y) + (v[j].z * ww.z + v[j].w * ww.w); }
    return a;
}
typedef short bf16x8v __attribute__((ext_vector_type(8)));
__device__ __forceinline__ void ln_router_mfma(LAS unsigned char* lds, int layer, int rep) {
    const ArgsP a = kargs(); const Ctx cx = mkctx(a); const int lane = cx.lane, wave = cx.wave, tid = cx.tid;
    unsigned char* ws = cx.ws;
    const bf16* Z = (const bf16*)(ws + LZ(layer)); bf16* Xb = (bf16*)(ws + (layer == 0 ? WS_X1B : WS_X3B));
    const float* g = a->ln1_g + layer * D; const float* b = a->ln1_b + layer * D;
    const float* rgb = a->rg_b + layer * NG; const float* reb = a->re_b + layer * NE;
    int* cnt = (int*)(ws + WS_CTL) + layer * NE * CNT_STRIDE; v2u* perm = (v2u*)(ws + LPERM(layer));
    const int i = lane & 15, kq = lane >> 4, grp = wave >> 1, half = wave & 1;
    const int row = cx.bx * 64 + grp * 16 + i, col0 = 512 * half + 8 * kq;
    { const unsigned char* wg = ws + WS_RWH + (size_t)layer * RWH_PAD;
      for (int q = wave; q < RWH_PAD / 1024; q += NWAVES)
          __builtin_amdgcn_global_load_lds((const unsigned*)(wg + (size_t)q * 1024 + lane * 16), (LAS unsigned*)(lds + q * 1024), 16, 0, 0); }
    v4u xw[16];
#pragma unroll
    for (int s = 0; s < 16; ++s) xw[s] = *(const v4u*)(Z + (size_t)row * D + col0 + 32 * s);
#define XLO(s) ((f32x4){bflo(xw[s].x), bfhi(xw[s].x), bflo(xw[s].y), bfhi(xw[s].y)})
#define XHI(s) ((f32x4){bflo(xw[s].z), bfhi(xw[s].z), bflo(xw[s].w), bfhi(xw[s].w)})
    LAS float* xs = (LAS float*)(lds + MISC_OFF + 4096);
    LAS float* part = (LAS float*)lds;
    float s1 = 0.f, s2 = 0.f;
#pragma unroll
    for (int s = 0; s < 16; ++s)
#pragma unroll
        for (int h2 = 0; h2 < 2; ++h2) { const f32x4 v = h2 ? XHI(s) : XLO(s); s1 += (v.x + v.y) + (v.z + v.w); s2 += (v.x * v.x + v.y * v.y) + (v.z * v.z + v.w * v.w); }
#pragma unroll
    for (int s = 0; s < 16; ++s) asm volatile("" : "+v"(xw[s]));
    s1 += __shfl_xor(s1, 16); s2 += __shfl_xor(s2, 16); s1 += __shfl_xor(s1, 32); s2 += __shfl_xor(s2, 32);
    if (kq == 0) { xs[(wave * 16 + i) * 2] = s1; xs[(wave * 16 + i) * 2 + 1] = s2; }
    __syncthreads();
    const float t1 = xs[((wave ^ 1) * 16 + i) * 2] + s1, t2 = xs[((wave ^ 1) * 16 + i) * 2 + 1] + s2;
    const float mean = t1 * (1.f / D), rstd = 1.f / sqrtf(fmaxf(t2 * (1.f / D) - mean * mean, 0.f) + LN_EPS);
    typedef float f32x4a __attribute__((ext_vector_type(4)));
    f32x4a acc0 = {0.f, 0.f, 0.f, 0.f}, acc1 = acc0, acc2 = acc0;
    const LAS unsigned char* wb = (const LAS unsigned char*)lds + (size_t)(lane & 15) * RWH_PITCH + (size_t)col0 * 2;
    const int n2 = (32 + (lane & 15)) < NRW ? 32 + (lane & 15) : NRW - 1;
    const LAS unsigned char* wb2 = (const LAS unsigned char*)lds + (size_t)n2 * RWH_PITCH + (size_t)col0 * 2;
    constexpr int LO = NRW * RWH_PITCH;
#pragma unroll
    for (int s = 0; s < 16; ++s) {
        if ((s & 3) == 0) asm volatile("" ::: "memory");
        const float* gp = g + col0 + 32 * s; const float* bp = b + col0 + 32 * s;
        const f32x4 g0 = *(const f32x4*)gp, g1 = *(const f32x4*)(gp + 4), b0 = *(const f32x4*)bp, b1 = *(const f32x4*)(bp + 4);
        const f32x4 v0 = (XLO(s) - mean) * rstd * g0 + b0, v1 = (XHI(s) - mean) * rstd * g1 + b1;
        const float vv[8] = {v0.x, v0.y, v0.z, v0.w, v1.x, v1.y, v1.z, v1.w};
        unsigned hi[8], lo[8];
#pragma unroll
        for (int j = 0; j < 8; ++j) { hi[j] = f2bf(vv[j]); lo[j] = f2bf(vv[j] - __builtin_bit_cast(float, hi[j] << 16)); }
        v4u hw, lw;
#pragma unroll
        for (int j = 0; j < 4; ++j) { hw[j] = hi[2 * j] | (hi[2 * j + 1] << 16); lw[j] = lo[2 * j] | (lo[2 * j + 1] << 16); }
        *(v4u*)(Xb + (size_t)row * D + col0 + 32 * s) = hw;
        const bf16x8v ah = __builtin_bit_cast(bf16x8v, hw), al = __builtin_bit_cast(bf16x8v, lw);
        const bf16x8v w0h = *(const LAS bf16x8v*)(wb + 64 * s), w0l = *(const LAS bf16x8v*)(wb + LO + 64 * s);
        const bf16x8v w1h = *(const LAS bf16x8v*)(wb + 16 * RWH_PITCH + 64 * s), w1l = *(const LAS bf16x8v*)(wb + 16 * RWH_PITCH + LO + 64 * s);
        const bf16x8v w2h = *(const LAS bf16x8v*)(wb2 + 64 * s), w2l = *(const LAS bf16x8v*)(wb2 + LO + 64 * s);
        acc0 = __builtin_amdgcn_mfma_f32_16x16x32_bf16(ah, w0h, acc0, 0, 0, 0); acc0 = __builtin_amdgcn_mfma_f32_16x16x32_bf16(al, w0h, acc0, 0, 0, 0); acc0 = __builtin_amdgcn_mfma_f32_16x16x32_bf16(ah, w0l, acc0, 0, 0, 0);
        acc1 = __builtin_amdgcn_mfma_f32_16x16x32_bf16(ah, w1h, acc1, 0, 0, 0); acc1 = __builtin_amdgcn_mfma_f32_16x16x32_bf16(al, w1h, acc1, 0, 0, 0); acc1 = __builtin_amdgcn_mfma_f32_16x16x32_bf16(ah, w1l, acc1, 0, 0, 0);
        acc2 = __builtin_amdgcn_mfma_f32_16x16x32_bf16(ah, w2h, acc2, 0, 0, 0); acc2 = __builtin_amdgcn_mfma_f32_16x16x32_bf16(al, w2h, acc2, 0, 0, 0); acc2 = __builtin_amdgcn_mfma_f32_16x16x32_bf16(ah, w2l, acc2, 0, 0, 0);
    }
    __syncthreads();
#undef XLO
#undef XHI
#pragma unroll
    for (int r = 0; r < 4; ++r) { LAS float* pr = part + (size_t)(wave * 16 + 4 * kq + r) * 48 + (lane & 15); pr[0] = acc0[r]; pr[16] = acc1[r]; pr[32] = acc2[r]; }
    LAS int* rt_e = (LAS int*)(part + 8 * 16 * 48);
    LAS float* rt_g = (LAS float*)(rt_e + 128);
    LAS int* rt_base = (LAS int*)(rt_g + 128);
    __syncthreads();
    if (tid < 64) {
        const int gq = tid >> 4, ii = tid & 15; const LAS float* p0 = part + (size_t)((2 * gq) * 16 + ii) * 48; const LAS float* p1 = p0 + 16 * 48;
        int gi = 0; float gm = -INFINITY, gl[NG];
#pragma unroll
        for (int n = 0; n < NG; ++n) { gl[n] = p0[n] + p1[n] + rgb[n]; if (gl[n] > gm) { gm = gl[n]; gi = n; } }
        float gs = 0.f;
#pragma unroll
        for (int n = 0; n < NG; ++n) gs += __expf(gl[n] - gm);
        const float gtop = 1.0f / gs;
        float m0 = -INFINITY, m1 = -INFINITY; int i0 = 0, i1 = 0;
        for (int n = 0; n < EPG; ++n) { const int c = NG + gi * EPG + n; const float e = p0[c] + p1[c] + reb[gi * EPG + n];
            if (e > m0) { m1 = m0; i1 = i0; m0 = e; i0 = n; } else if (e > m1) { m1 = e; i1 = n; } }
        const float e1 = __expf(m1 - m0), w0 = 1.0f / (1.0f + e1), w1 = e1 * w0;
        rt_e[2 * tid] = gi * EPG + i0; rt_e[2 * tid + 1] = gi * EPG + i1; rt_g[2 * tid] = gtop * w0; rt_g[2 * tid + 1] = gtop * w1;
    }
    __syncthreads();
    if (rep == 0) {
        LAS int* wc = rt_base + NE;
        int my_e = 0, my_rank = 0, my_cnt = 0;
        if (tid < 128) { my_e = rt_e[tid];
            const unsigned long long lt = (1ull << lane) - 1ull;
#pragma unroll 4
            for (int e = 0; e < NE; ++e) { const unsigned long long m = __ballot(my_e == e); if (my_e == e) my_rank = (int)__builtin_popcountll(m & lt); if (lane == e) my_cnt = (int)__builtin_popcountll(m); }
            if (lane < NE) wc[wave * NE + lane] = my_cnt; }
        __syncthreads();
        if (tid < NE) { const int c = wc[tid] + wc[NE + tid]; rt_base[tid] = c ? atomicAdd(&cnt[tid * CNT_STRIDE], c) : 0; }
        __syncthreads();
        if (tid < 128) { const int pair = 2 * (cx.bx * 64 + (tid >> 1)) + (tid & 1);
            perm[my_e * CAP + rt_base[my_e] + my_rank + (wave ? wc[my_e] : 0)] = (v2u){__builtin_bit_cast(unsigned, rt_g[tid]), (unsigned)pair}; }
    }
}
__device__ __forceinline__ void ln_router_phase(LAS unsigned char* lds, int layer, int rep = 0) {
    const ArgsP a = kargs(); const Ctx cx = mkctx(a); const int gw = cx.gw, NGW = cx.NGW, lane = cx.lane;
    unsigned char* ws = cx.ws;
    const bf16* Z = (const bf16*)(ws + LZ(layer)); bf16* Xb = (bf16*)(ws + (layer == 0 ? WS_X1B : WS_X3B));
    const float* g = a->ln1_g + layer * D; const float* b = a->ln1_b + layer * D;
    const float* rgb = a->rg_b + layer * NG; const float* reb = a->re_b + layer * NE;
    int* cnt = (int*)(ws + WS_CTL) + layer * NE * CNT_STRIDE; v2u* perm = (v2u*)(ws + LPERM(layer));
    LAS f32x4* wl = (LAS f32x4*)lds;
    { const f32x4* wg = (const f32x4*)((const float*)(ws + WS_RWT) + (size_t)layer * NRW * D);
      for (int i = cx.tid; i < NRW * D / 4; i += NTHREADS) wl[i] = wg[i]; }
    f32x4 gg[4], bb[4];
#pragma unroll
    for (int j = 0; j < 4; ++j) { gg[j] = *(const f32x4*)(g + 256 * j + 4 * lane); bb[j] = *(const f32x4*)(b + 256 * j + 4 * lane); }
    constexpr int RPW = 16;
    LAS int* rt_row = (LAS int*)(lds + MISC_OFF + 2048);
    LAS int* rt_e = rt_row + NWAVES * RPW;
    LAS float* rt_g = (LAS float*)(rt_e + 2 * NWAVES * RPW);
    LAS int* rt_base = (LAS int*)(rt_g + 2 * NWAVES * RPW);
    LAS int* wave_rows = rt_base + NE;
    f32x4 nv[2][4];
#pragma unroll
    for (int r = 0; r < 2; ++r) { const int row = gw + r * NGW;
        if (row < T) {
#pragma unroll
            for (int j = 0; j < 4; ++j) nv[r][j] = ldz4(Z + (size_t)row * D + 256 * j + 4 * lane);
        } }
    __syncthreads();
    int it = 0;
#pragma unroll 1
    for (int row0 = gw; row0 < T && it < RPW; row0 += 2 * NGW, it += 2) {
        const bool two = row0 + NGW < T;
        f32x4 v[2][4];
#pragma unroll
        for (int r = 0; r < 2; ++r)
#pragma unroll
            for (int j = 0; j < 4; ++j) v[r][j] = nv[r][j];
#pragma unroll
        for (int r = 0; r < 2; ++r) { const int row = row0 + (2 + r) * NGW;
            if (row < T) {
#pragma unroll
                for (int j = 0; j < 4; ++j) nv[r][j] = ldz4(Z + (size_t)row * D + 256 * j + 4 * lane);
            } }
        if (!two) {
#pragma unroll
            for (int j = 0; j < 4; ++j) v[1][j] = v[0][j];
        }
        float s1[2];
#pragma unroll
        for (int r = 0; r < 2; ++r) { float s = 0.f;
#pragma unroll
            for (int j = 0; j < 4; ++j) s += (v[r][j].x + v[r][j].y) + (v[r][j].z + v[r][j].w);
            s1[r] = s; }
        dpp_sum(s1);
        float s2[2];
#pragma unroll
        for (int r = 0; r < 2; ++r) { const float mean = s1[r] * (1.f / D); float q = 0.f;
#pragma unroll
            for (int j = 0; j < 4; ++j) { v[r][j] = v[r][j] - mean; q += (v[r][j].x * v[r][j].x + v[r][j].y * v[r][j].y) + (v[r][j].z * v[r][j].z + v[r][j].w * v[r][j].w); }
            s2[r] = q; }
        dpp_sum(s2);
#pragma unroll
        for (int r = 0; r < 2; ++r) { const float rstd = 1.f / sqrtf(s2[r] * (1.f / D) + LN_EPS);
#pragma unroll
            for (int j = 0; j < 4; ++j) v[r][j] = v[r][j] * rstd * gg[j] + bb[j]; }
#pragma unroll
        for (int r = 0; r < 2; ++r) { const int row = row0 + r * NGW;
            if (r == 0 || two) {
#pragma unroll
                for (int j = 0; j < 4; ++j) { v2u w; w.x = pk2(v[r][j].x, v[r][j].y); w.y = pk2(v[r][j].z, v[r][j].w); *(v2u*)(Xb + (size_t)row * D + 256 * j + 4 * lane) = w; }
            } }
        float gl[2 * NG];
#pragma unroll
        for (int r = 0; r < 2; ++r)
#pragma unroll
            for (int n = 0; n < NG; ++n) gl[r * NG + n] = dot_lds(v[r], wl + n * (D / 4), lane);
        dpp_sum(gl);
        int gi[2]; float gtop[2];
#pragma unroll
        for (int r = 0; r < 2; ++r) { int g_ = 0; float gm = -INFINITY;
#pragma unroll
            for (int n = 0; n < NG; ++n) { gl[r * NG + n] += rgb[n]; if (gl[r * NG + n] > gm) { gm = gl[r * NG + n]; g_ = n; } }
            float gs = 0.f;
#pragma unroll
            for (int n = 0; n < NG; ++n) gs += __expf(gl[r * NG + n] - gm);
            gi[r] = g_; gtop[r] = 1.0f / gs; }
        float el[2 * EPG];
#pragma unroll
        for (int r = 0; r < 2; ++r)
#pragma unroll
            for (int n = 0; n < EPG; ++n) el[r * EPG + n] = dot_lds(v[r], wl + (NG + gi[r] * EPG + n) * (D / 4), lane);
        dpp_sum(el);
#pragma unroll
        for (int r = 0; r < 2; ++r) {
            float m0 = -INFINITY, m1 = -INFINITY; int i0 = 0, i1 = 0;
#pragma unroll
            for (int n = 0; n < EPG; ++n) { const float e = el[r * EPG + n] + reb[gi[r] * EPG + n];
                if (e > m0) { m1 = m0; i1 = i0; m0 = e; i0 = n; } else if (e > m1) { m1 = e; i1 = n; } }
            const float e1 = __expf(m1 - m0), w0 = 1.0f / (1.0f + e1), w1 = e1 * w0;
            if (lane == 0 && (r == 0 || two)) {
                const int li = cx.wave * RPW + it + r;
                rt_row[li] = row0 + r * NGW; rt_e[2 * li] = gi[r] * EPG + i0; rt_e[2 * li + 1] = gi[r] * EPG + i1; rt_g[2 * li] = gtop[r] * w0; rt_g[2 * li + 1] = gtop[r] * w1;
            }
        }
        if (!two) { it += 1; break; }
    }
    if (lane == 0) wave_rows[cx.wave] = it;
    __syncthreads();
    if (rep == 0) {
        if (cx.tid < NE) { int c = 0;
            for (int w = 0; w < NWAVES; ++w) { const int n = wave_rows[w]; for (int i = 0; i < 2 * n; ++i) c += (rt_e[2 * (w * RPW) + i] == cx.tid) ? 1 : 0; }
            rt_base[cx.tid] = c ? atomicAdd(&cnt[cx.tid * CNT_STRIDE], c) : 0; }
        __syncthreads();
        if (cx.tid < 2 * NWAVES * RPW) { const int w = cx.tid / (2 * RPW), i = cx.tid % (2 * RPW);
            if (i < 2 * wave_rows[w]) { const int e = rt_e[cx.tid]; int rank = 0;
                for (int w2 = 0; w2 <= w; ++w2) { const int lim = (w2 < w) ? 2 * wave_rows[w2] : i; for (int q = 0; q < lim; ++q) rank += (rt_e[2 * (w2 * RPW) + q] == e) ? 1 : 0; }
                const int pair = 2 * rt_row[cx.tid >> 1] + (cx.tid & 1);
                perm[e * CAP + rt_base[e] + rank] = (v2u){__builtin_bit_cast(unsigned, rt_g[cx.tid]), (unsigned)pair}; } }
    }
}
__device__ __forceinline__ void ln2_phase(int layer) {
    const ArgsP a = kargs(); const Ctx cx = mkctx(a); const int gw = cx.gw, NGW = cx.NGW, lane = cx.lane;
    unsigned char* ws = cx.ws;
    const bf16* Xin = (const bf16*)(ws + (layer == 0 ? WS_X1B : WS_X3B)); const bf16* YP = (const bf16*)(ws + LYP(layer));
    const float* g = a->ln2_g + layer * D; const float* b = a->ln2_b + layer * D;
    f32x4 gg[4], bb[4];
#pragma unroll
    for (int j = 0; j < 4; ++j) { gg[j] = *(const f32x4*)(g + 256 * j + 4 * lane); bb[j] = *(const f32x4*)(b + 256 * j + 4 * lane); }
    v2u nx[4], ny0[4], ny1[4];
    if (gw < T) {
#pragma unroll
        for (int j = 0; j < 4; ++j) { const size_t c = 256 * j + 4 * lane;
            nx[j] = *(const v2u*)(Xin + (size_t)gw * D + c); ny0[j] = *(const v2u*)(YP + (size_t)(2 * gw) * D + c); ny1[j] = *(const v2u*)(YP + (size_t)(2 * gw + 1) * D + c); }
    }
#pragma unroll 1
    for (int row = gw; row < T; row += NGW) {
        f32x4 v[4];
#pragma unroll
        for (int j = 0; j < 4; ++j) { const v2u xw = nx[j], y0 = ny0[j], y1 = ny1[j];
            v[j].x = ALPHA * bflo(xw.x) + (bflo(y0.x) + bflo(y1.x)); v[j].y = ALPHA * bfhi(xw.x) + (bfhi(y0.x) + bfhi(y1.x));
            v[j].z = ALPHA * bflo(xw.y) + (bflo(y0.y) + bflo(y1.y)); v[j].w = ALPHA * bfhi(xw.y) + (bfhi(y0.y) + bfhi(y1.y)); }
        if (row + NGW < T) { const int r2 = row + NGW;
#pragma unroll
            for (int j = 0; j < 4; ++j) { const size_t c = 256 * j + 4 * lane;
                nx[j] = *(const v2u*)(Xin + (size_t)r2 * D + c); ny0[j] = *(const v2u*)(YP + (size_t)(2 * r2) * D + c); ny1[j] = *(const v2u*)(YP + (size_t)(2 * r2 + 1) * D + c); }
        }
        ln_rows(v, gg, bb);
        if (layer == 0) {
#pragma unroll
            for (int j = 0; j < 4; ++j) { v2u w; w.x = pk2(v[j].x, v[j].y); w.y = pk2(v[j].z, v[j].w); *(v2u*)((bf16*)(ws + WS_X2B) + (size_t)row * D + 256 * j + 4 * lane) = w; }
        } else {
#pragma unroll
            for (int j = 0; j < 4; ++j) *(f32x4*)(a->out + (size_t)row * D + 256 * j + 4 * lane) = v[j];
        }
    }
}
__device__ __forceinline__ void conv_phase() {
    const ArgsP a = kargs(); const Ctx cx = mkctx(a); const int gtid = cx.bx * NTHREADS + cx.tid, NGT = cx.G * NTHREADS;
    unsigned char* ws = cx.ws;
    const bf16* GB = (const bf16*)(ws + WS_GB); const bf16* U = (const bf16*)(ws + WS_U); bf16* A2 = (bf16*)(ws + WS_A2);
    for (int it = gtid; it < T * (D / 8); it += NGT) {
        const int t = it >> 7, d0 = (it & 127) * 8, s = t & (SEQ - 1);
        const size_t o = (size_t)t * D + d0;
        const v4u g = *(const v4u*)(GB + o), u0 = *(const v4u*)(U + o);
        v4u u1 = (v4u){0u, 0u, 0u, 0u}, u2 = u1;
        if (s >= 1) u1 = *(const v4u*)(U + o - D);
        if (s >= 2) u2 = *(const v4u*)(U + o - 2 * D);
        const f32x4 wa0 = *(const f32x4*)(a->a_conv_w + d0), wa1 = *(const f32x4*)(a->a_conv_w + d0 + 4), wb0 = *(const f32x4*)(a->a_conv_w + D + d0), wb1 = *(const f32x4*)(a->a_conv_w + D + d0 + 4);
        const f32x4 wc0 = *(const f32x4*)(a->a_conv_w + 2 * D + d0), wc1 = *(const f32x4*)(a->a_conv_w + 2 * D + d0 + 4);
        const float w0[8] = {wa0.x, wa0.y, wa0.z, wa0.w, wa1.x, wa1.y, wa1.z, wa1.w}, w1[8] = {wb0.x, wb0.y, wb0.z, wb0.w, wb1.x, wb1.y, wb1.z, wb1.w}, w2[8] = {wc0.x, wc0.y, wc0.z, wc0.w, wc1.x, wc1.y, wc1.z, wc1.w};
        v4u r;
#pragma unroll
        for (int q = 0; q < 4; ++q) {
            const float c0 = w0[2 * q] * bflo(u2[q]) + w1[2 * q] * bflo(u1[q]) + w2[2 * q] * bflo(u0[q]);
            const float c1 = w0[2 * q + 1] * bfhi(u2[q]) + w1[2 * q + 1] * bfhi(u1[q]) + w2[2 * q + 1] * bfhi(u0[q]);
            r[q] = pk2(bflo(g[q]) * c0, bfhi(g[q]) * c1);
        }
        *(v4u*)(A2 + o) = r;
    }
}
__device__ __forceinline__ void combine_phase() {
    const ArgsP a = kargs(); const Ctx cx = mkctx(a); const int gw = cx.gw, NGW = cx.NGW, lane = cx.lane;
    unsigned char* ws = cx.ws;
    const bf16* O0 = (const bf16*)(ws + WS_O0); const bf16* O1 = (const bf16*)(ws + WS_O1); bf16* A3 = (bf16*)(ws + WS_A3);
    const float l01 = wave_sum(a->b_lambda[lane] * a->b_lambda[64 + lane]), l23 = wave_sum(a->b_lambda[128 + lane] * a->b_lambda[192 + lane]);
    const float lam = __expf(l01) - __expf(l23) + LAM_INIT;
    float gsc[16];
#pragma unroll
    for (int i = 0; i < 16; ++i) gsc[i] = a->b_subln_g[(lane & 7) * 16 + i] * (1.0f - LAM_INIT);
    for (int row = gw; row < T; row += NGW) {
        const size_t o = (size_t)row * D + lane * 16;
        const v4u p0 = *(const v4u*)(O0 + o), p1 = *(const v4u*)(O0 + o + 8), q0 = *(const v4u*)(O1 + o), q1 = *(const v4u*)(O1 + o + 8);
        float d[16]; float ss = 0.f;
#pragma unroll
        for (int i = 0; i < 4; ++i) { d[2 * i] = bflo(p0[i]) - lam * bflo(q0[i]); d[2 * i + 1] = bfhi(p0[i]) - lam * bfhi(q0[i]);
            d[8 + 2 * i] = bflo(p1[i]) - lam * bflo(q1[i]); d[8 + 2 * i + 1] = bfhi(p1[i]) - lam * bfhi(q1[i]); }
#pragma unroll
        for (int i = 0; i < 16; ++i) ss += d[i] * d[i];
        ss += __shfl_xor(ss, 1); ss += __shfl_xor(ss, 2); ss += __shfl_xor(ss, 4);
        const float r = 1.0f / sqrtf(ss * (1.0f / 128.0f) + RMS_EPS);
        v4u w0, w1;
#pragma unroll
        for (int i = 0; i < 4; ++i) { w0[i] = pk2(d[2 * i] * r * gsc[2 * i], d[2 * i + 1] * r * gsc[2 * i + 1]); w1[i] = pk2(d[8 + 2 * i] * r * gsc[8 + 2 * i], d[8 + 2 * i + 1] * r * gsc[8 + 2 * i + 1]); }
        *(v4u*)(A3 + o) = w0; *(v4u*)(A3 + o + 8) = w1;
    }
}

#ifndef MKMASK
#define MKMASK 0xffff
#endif
#ifndef MKREP
#define MKREP 0
#endif
#ifndef MKSYNC
#define MKSYNC 0
#endif
#ifndef MKMASK2
#define MKMASK2 MKMASK
#endif
#define PH(k) _Pragma("unroll 1") for (int rep_ = 0; rep_ < (int)(((pass_ ? MKMASK2 : MKMASK) >> (k)) & 1) + (int)((MKREP >> (k)) & 1); ++rep_)
#define XB_TMO      128
#define XB_XCNT(j)  (256  + 64 * (j))
#define XB_XSUB(j)  (1280 + 64 * (j))
#define XB_XGEN(j)  (2304 + 64 * (j))
#define XB_TOP      3328
#define XB_TOPGEN   3392
#define XCD_BAR_WORDS 3456
#define XB_SPIN_CAP (1u << 18)

__device__ __forceinline__ unsigned xb_ld(unsigned* p)              { return __hip_atomic_load(p, __ATOMIC_RELAXED, __HIP_MEMORY_SCOPE_AGENT); }
__device__ __forceinline__ unsigned xb_add(unsigned* p, unsigned v) { return __hip_atomic_fetch_add(p, v, __ATOMIC_RELAXED, __HIP_MEMORY_SCOPE_AGENT); }
__device__ __forceinline__ unsigned xb_xcc_id() { return (unsigned)__builtin_amdgcn_s_getreg((3 << 11) | 20) & 0xFu; }
#define XB_SPIN(cond, bar) do { unsigned _sp = 0; while (cond) { __builtin_amdgcn_s_sleep(1); \
    if ((++_sp & 255u) == 0u) { if (xb_ld(&(bar)[XB_TMO])) break; if (_sp > XB_SPIN_CAP) { atomicAdd(&(bar)[XB_TMO], 1u); break; } } } } while (0)

struct XcdBarrier {
    unsigned* bar; unsigned x;
    volatile LAS unsigned* st;
};

__device__ __forceinline__ XcdBarrier xcd_barrier_post(unsigned* bar, volatile LAS unsigned* st) {
    XcdBarrier b; b.bar = bar; b.x = xb_xcc_id(); b.st = st;
    if (threadIdx.x == 0) (void)xb_add(&bar[XB_XCNT(b.x)], 1u);
    return b;
}
__device__ __forceinline__ void xcd_barrier_complete(unsigned* bar, unsigned x, unsigned& nloc, unsigned& nx) {
    const unsigned G = gridDim.x * gridDim.y * gridDim.z;
    unsigned sum, cnt, mine, sp = 0u;
    for (;;) {
        sum = 0u; cnt = 0u; mine = 0u;
#pragma unroll
        for (unsigned j = 0; j < 16; ++j) { const unsigned c = xb_ld(&bar[XB_XCNT(j)]); sum += c; cnt += (c > 0u) ? 1u : 0u; mine = (j == x) ? c : mine; }
        if (sum == G) break;
        __builtin_amdgcn_s_sleep(1);
        if ((++sp & 255u) == 0u) { if (xb_ld(&bar[XB_TMO])) break; if (sp > XB_SPIN_CAP) { atomicAdd(&bar[XB_TMO], 1u); break; } }
    }
    nloc = mine > 0u ? mine : 1u; nx = cnt > 0u ? cnt : 1u;
}

__device__ __forceinline__ void xcd_barrier(const XcdBarrier& b) {
    asm volatile("s_waitcnt vmcnt(0)" ::: "memory");
    __syncthreads();
    if (threadIdx.x == 0) {
        unsigned* bar = b.bar;
        __builtin_amdgcn_s_waitcnt(0);
        unsigned nloc = b.st[0], nx = b.st[1];
        if (nloc == 0u) { xcd_barrier_complete(bar, b.x, nloc, nx); b.st[0] = nloc; b.st[1] = nx; }
        const unsigned old = xb_add(&bar[XB_XSUB(b.x)], 1u);
        const unsigned gen = old / nloc;
        if (old + 1u == (gen + 1u) * nloc) {
            __builtin_amdgcn_fence(__ATOMIC_RELEASE, "agent");
            asm volatile("s_waitcnt vmcnt(0)" ::: "memory");
            const unsigned og = xb_add(&bar[XB_TOP], 1u);
            const unsigned tg = og / nx;
            if (og + 1u == (tg + 1u) * nx) xb_add(&bar[XB_TOPGEN], 1u);
            else XB_SPIN(xb_ld(&bar[XB_TOPGEN]) == tg, bar);
            __builtin_amdgcn_fence(__ATOMIC_ACQUIRE, "agent");
            xb_add(&bar[XB_XGEN(b.x)], 1u);
            asm volatile("s_waitcnt vmcnt(0)" ::: "memory");
        } else {
            XB_SPIN(xb_ld(&bar[XB_XGEN(b.x)]) == gen, bar);
            __builtin_amdgcn_fence(__ATOMIC_ACQUIRE, "agent");
            asm volatile("s_waitcnt vmcnt(0)" ::: "memory");
        }
    }
    __syncthreads();
}

constexpr int CW_BAR = 16384;
constexpr int ST_OFF = MISC_OFF + 1024;
__device__ __forceinline__ void seam(LAS unsigned char* lds) { const ArgsP a = kargs(); XcdBarrier b; b.bar = (unsigned*)(a->ws + WS_CTL) + CW_BAR; b.x = xb_xcc_id(); b.st = (volatile LAS unsigned*)(lds + ST_OFF); xcd_barrier(b); }
__device__ __forceinline__ void gemm1_phase(LAS unsigned char* lds) { const ArgsP a = kargs(); const Ctx cx = mkctx(a); unsigned char* ws = cx.ws;
    const int ng = ROLE_SPLIT ? cx.G - cx.G / 4 : cx.G;
    if (cx.bx < ng) { SchedDense S{ng, cx.bx, 12, 0, D, (const char*)(ws + WS_W1T)}; EpiConvIn E{(bf16*)(ws + WS_GB), (bf16*)(ws + WS_U)};
        pg8::gemm_phase(lds, (const char*)(ws + WS_XB), D, S, E); }
    else p0_items(lds, PS1 + P0A_EXTRA, P0_NITEMS, (cx.bx - ng) * NWAVES + cx.wave, (cx.G - ng) * NWAVES); }
__device__ __forceinline__ void gemm2_phase(LAS unsigned char* lds) { const ArgsP a = kargs(); const Ctx cx = mkctx(a); unsigned char* ws = cx.ws;
    SchedDense S{cx.G, cx.bx, 4, 1, D, (const char*)(ws + WS_W2T)}; EpiResZ<true> E{(const void*)(ws + WS_XB), (bf16*)(ws + LZ(0))};
    pg8::gemm_phase(lds, (const char*)(ws + WS_A2), D, S, E); }
__device__ __forceinline__ void kvq_phase(LAS unsigned char* lds) { const ArgsP a = kargs(); const Ctx cx = mkctx(a); unsigned char* ws = cx.ws;
    SchedDense S{cx.G, cx.bx, 12, 1, D, (const char*)(ws + WS_WKVQ)}; EpiKVQ E{(bf16*)(ws + WS_K)};
    pg8::gemm_phase(lds, (const char*)(ws + WS_X2B), D, S, E); }
__device__ __forceinline__ void wo_phase(LAS unsigned char* lds) { const ArgsP a = kargs(); const Ctx cx = mkctx(a); unsigned char* ws = cx.ws;
    SchedDense S{cx.G, cx.bx, 4, 1, D, (const char*)(ws + WS_WOT)}; EpiResZ<true> E{(const void*)(ws + WS_X2B), (bf16*)(ws + LZ(1))};
    pg8::gemm_phase(lds, (const char*)(ws + WS_A3), D, S, E); }
#ifndef ATTN128
#define ATTN128 1
#endif
#if ATTN128
__device__ __forceinline__ void attn_phase(char* lds_generic) { const ArgsP a = kargs(); const Ctx cx = mkctx(a); unsigned char* ws = cx.ws;
#pragma unroll 1
    for (int uix = cx.bx; uix < BATCH * NH * 2 * (SEQ / 256); uix += cx.G) {
        const int combo = (uix & 255) >> 1, par = uix & 1, qi = uix >> 8;
        const int b = combo >> 4, h = (combo >> 1) & 7, c = combo & 1;
        const int qb = par == 0 ? (qi == 0 ? 0 : qi == 1 ? 7 : qi == 2 ? 2 : 5) : (qi == 0 ? 1 : qi == 1 ? 6 : qi == 2 ? 3 : 4);
        const attn128::bf16* QK = (const attn128::bf16*)(ws + WS_K) + h * 128 + c * 64;
        const attn128::bf16* Vc = (const attn128::bf16*)(ws + WS_V) + h * 128;
        attn128::bf16* Oc = (attn128::bf16*)(ws + (c ? WS_O1 : WS_O0)) + h * 128;
        attn128::attn_unit<8>((long)b * SEQ, qb, QK + (WS_Q - WS_K) / 2, QK, Vc, Oc, lds_generic);
    }
}
#else
__device__ __forceinline__ void attn_phase(char* lds_generic) { const ArgsP a = kargs(); const Ctx cx = mkctx(a); unsigned char* ws = cx.ws;
#pragma unroll 1
    for (int uix = cx.bx; uix < BATCH * NH * 4 * (SEQ / 256); uix += cx.G) {
        const int combo = uix & 255, qi = uix >> 8;
        const int b = combo >> 5, h = (combo >> 2) & 7, c = (combo >> 1) & 1, vh = combo & 1;
        const int qb = (qi & 1) ? (SEQ / 256 - 1 - (qi >> 1)) : (qi >> 1);
        const attn_body::bf16* QK = (const attn_body::bf16*)(ws + WS_K) + h * 128 + c * 64;
        const attn_body::bf16* Vc = (const attn_body::bf16*)(ws + WS_V) + h * 128 + vh * 64;
        attn_body::bf16* Oc = (attn_body::bf16*)(ws + (c ? WS_O1 : WS_O0)) + h * 128 + vh * 64;
        attn_body::attn_unit<8>((long)b * SEQ, qb, QK + (WS_Q - WS_K) / 2, QK, Vc, Oc, lds_generic);
    }
}
#endif
__device__ __forceinline__ int scan_excl32(int v, int lane) {
    int x = v;
#pragma unroll
    for (int o = 1; o < 32; o <<= 1) { const int y = __shfl_up(x, o); if ((lane & 31) >= o) x += y; }
    return x - v;
}
__device__ __forceinline__ void moe_tables(LAS unsigned char* lds, int layer) { const ArgsP a = kargs(); const Ctx cx = mkctx(a); LAS int* misc = (LAS int*)(lds + MISC_OFF);
    const int* cnt = (const int*)(cx.ws + WS_CTL) + layer * NE * CNT_STRIDE;
    if (cx.tid < 64) {
        const int e = cx.lane, cn = e < NE ? __hip_atomic_load(cnt + e * CNT_STRIDE, __ATOMIC_RELAXED, __HIP_MEMORY_SCOPE_AGENT) : 0;
        const int rt = (cn + 255) >> 8, half = (cn > 0 && ((cn - 1) & 255) < 128) ? 1 : 0;
        const int uf = e < NE ? 4 * (rt - half) : 0, uh = e < NE ? 4 * half : 0, pr = e < NE ? 256 * rt : 0;
        const int sf = scan_excl32(uf, e), sh = scan_excl32(uh, e), sp = scan_excl32(pr, e);
        const int totf = __shfl(sf + uf, 31), toth = __shfl(sh + uh, 31), totp = __shfl(sp + pr, 31);
        if (e < NE) { misc[e] = sf; misc[NE + e] = totf + sh; misc[128 + e] = cn; misc[192 + e] = sp; }
        if (e == 0) { misc[2 * NE] = totf + toth; misc[192 + NE] = totp; }
    }
    __syncthreads(); }
constexpr int CW_READY = 4096;
__device__ __forceinline__ void moe_up_phase(LAS unsigned char* lds, int layer, bool merged) { const ArgsP a = kargs(); const Ctx cx = mkctx(a); unsigned char* ws = cx.ws; LAS int* misc = (LAS int*)(lds + MISC_OFF);
    const MoeTab tb{misc, misc + 192, misc + 128};
    SchedMoe S{cx.G, cx.bx, D, true, (const char*)(ws + WS_WUT) + (size_t)layer * NE * D * D * 2, (const v2u*)(ws + LPERM(layer)), tb, (unsigned*)(ws + WS_CTL) + CW_READY, merged ? 1 : 0, 0, 0};
    if (merged) { EpiUp<true> E{(bf16*)(ws + LACT(layer))}; pg8::gemm_phase(lds, (const char*)(ws + (layer == 0 ? WS_X1B : WS_X3B)), D, S, E); }
    else { EpiUp<false> E{(bf16*)(ws + LACT(layer))}; pg8::gemm_phase(lds, (const char*)(ws + (layer == 0 ? WS_X1B : WS_X3B)), D, S, E); } }
__device__ __forceinline__ void moe_down_phase(LAS unsigned char* lds, int layer, bool merged) { const ArgsP a = kargs(); const Ctx cx = mkctx(a); unsigned char* ws = cx.ws; LAS int* misc = (LAS int*)(lds + MISC_OFF);
    const MoeTab tb{misc, misc + 192, misc + 128};
    int nb = 0;
    if (merged) { const int U = misc[2 * NE], rem = U % cx.G; nb = rem ? cx.G - rem : 0; }
    SchedMoe S{cx.G, cx.bx, DE, false, (const char*)(ws + WS_WDT) + (size_t)layer * NE * D * DE * 2, (const v2u*)(ws + LPERM(layer)), tb, (unsigned*)(ws + WS_CTL) + CW_READY, merged ? 2 : 0, 0, nb};
    EpiDown E{(bf16*)(ws + LYP(layer)), (const v2u*)(ws + LPERM(layer))};
    pg8::gemm_phase(lds, (const char*)(ws + LACT(layer)), DE, S, E); }

__global__ void __launch_bounds__(NTHREADS, 2) fwd_megakernel(Args args_unused) {
    extern __shared__ __attribute__((aligned(16))) unsigned char lds_raw[];
#ifdef NOSYNC
    struct { __device__ void sync() const {} } grid;
#else
    cg::grid_group grid = cg::this_grid();
#endif
#define SEAM() seam(lds)
    LAS unsigned char* lds = (LAS unsigned char*)lds_raw;
#ifndef MKPASS
#define MKPASS 1
#endif
    { const ArgsP a = kargs(); int t = threadIdx.x; asm volatile("" : "+v"(t));
      if (t < 2) ((volatile LAS unsigned*)(lds + ST_OFF))[t] = 0u;
      __syncthreads();
      (void)xcd_barrier_post((unsigned*)(a->ws + WS_CTL) + CW_BAR, (volatile LAS unsigned*)(lds + ST_OFF));
      if (a->ws == nullptr) grid.sync(); }
#pragma unroll 1
    for (int pass_ = 0; pass_ < MKPASS; ++pass_) {
    if (pass_) SEAM();
    PH(0) p0_prologue(lds);
    SEAM();
    PH(1) gemm1_phase(lds);
    SEAM();
    PH(2) conv_phase();
    SEAM();
    PH(3) gemm2_phase(lds);
    SEAM();
    PH(8) ln_router_mfma(lds, 0, rep_ + pass_);
    SEAM();
    moe_tables(lds, 0);
    PH(9) { moe_up_phase(lds, 0, false); if (P0B_FILL && pass_ == 0) p0b_idle_fill(lds, 0, P0B_SPLIT); }
    SEAM();
    PH(10) { moe_down_phase(lds, 0, false); if (P0B_FILL && pass_ == 0) p0b_idle_fill(lds, P0B_SPLIT, P0B_ITEMS); }
    SEAM();
    PH(11) ln2_phase(0);
    SEAM();
    PH(4) kvq_phase(lds);
    SEAM();
    PH(5) attn_phase((char*)lds_raw);
    SEAM();
    PH(6) combine_phase();
    SEAM();
    PH(7) wo_phase(lds);
    SEAM();
    PH(8) ln_router_mfma(lds, 1, rep_ + pass_);
    SEAM();
    moe_tables(lds, 1);
#if MOE_MERGE
    PH(9) moe_up_phase(lds, 1, pass_ == 0);
    if (pass_) SEAM();
    PH(10) moe_down_phase(lds, 1, pass_ == 0);
#else
    PH(9) moe_up_phase(lds, 1, false);
    SEAM();
    PH(10) moe_down_phase(lds, 1, false);
#endif
    SEAM();
    PH(11) ln2_phase(1);
    }
#pragma unroll 1
    for (int i = 0; i < MKSYNC; ++i) SEAM();
}
}

extern "C" void kernel_launch(void* const* d_in, const int* in_sizes, int n_in, void* d_out, int out_size, void* d_ws, size_t ws_size, hipStream_t stream) {
    using namespace mk;
    static int grid = 0;
    if (grid == 0) {
        if (n_in != 19 || out_size != T * D || ws_size < WS_END) { fprintf(stderr, "kernel_launch: unexpected shapes / workspace (n_in %d out %d ws %zu, need %zu)\n", n_in, out_size, ws_size, (size_t)WS_END); grid = -1; return; }
        int dev = 0, cus = 0, per_cu = 0;
        (void)hipGetDevice(&dev); (void)hipDeviceGetAttribute(&cus, hipDeviceAttributeMultiprocessorCount, dev);
        if (hipFuncSetAttribute((const void*)fwd_megakernel, hipFuncAttributeMaxDynamicSharedMemorySize, LDS_BYTES) != hipSuccess) { fprintf(stderr, "kernel_launch: hipFuncSetAttribute failed\n"); grid = -1; return; }
        if (hipOccupancyMaxActiveBlocksPerMultiprocessor(&per_cu, (const void*)fwd_megakernel, NTHREADS, LDS_BYTES) != hipSuccess || per_cu < 1) { fprintf(stderr, "kernel_launch: occupancy query says %d blocks per CU\n", per_cu); grid = -1; return; }
        grid = cus * 1;
        if (grid != T / 64) { fprintf(stderr, "kernel_launch: this build needs exactly %d workgroups (one per CU of a 256-CU MI355X: the LN1 + router phase gives each 64 rows); device has %d CUs\n", T / 64, cus); grid = -1; return; }
        (void)hipGetLastError();
    }
    if (grid < 0) return;
    if (hipMemsetAsync((char*)d_ws + WS_CTL, 0, (size_t)(CW_BAR + XCD_BAR_WORDS) * 4, stream) != hipSuccess) { fprintf(stderr, "kernel_launch: hipMemsetAsync of the control words failed\n"); return; }
    Args a{};
    a.x = (const float*)d_in[0]; a.a_w_in = (const float*)d_in[1]; a.a_conv_w = (const float*)d_in[2]; a.a_w_out = (const float*)d_in[3]; a.kv_w = (const float*)d_in[4];
    a.b_w_q = (const float*)d_in[5]; a.b_lambda = (const float*)d_in[6]; a.b_subln_g = (const float*)d_in[7]; a.b_w_o = (const float*)d_in[8];
    a.ln1_g = (const float*)d_in[9]; a.ln1_b = (const float*)d_in[10]; a.ln2_g = (const float*)d_in[11]; a.ln2_b = (const float*)d_in[12];
    a.rg_w = (const float*)d_in[13]; a.rg_b = (const float*)d_in[14]; a.re_w = (const float*)d_in[15]; a.re_b = (const float*)d_in[16];
    a.e_w_in = (const float*)d_in[17]; a.e_w_down = (const float*)d_in[18];
    a.out = (float*)d_out; a.ws = (unsigned char*)d_ws;
    void* kargs[] = {&a};
    const hipError_t e = hipLaunchCooperativeKernel((const void*)fwd_megakernel, dim3(grid), dim3(NTHREADS), kargs, LDS_BYTES, stream);
    if (e != hipSuccess) fprintf(stderr, "kernel_launch: cooperative launch failed: %s (grid %d)\n", hipGetErrorString(e), grid);
}
```

```cpp
#include <hip/hip_runtime.h>
#include <hip/hip_cooperative_groups.h>
#include <cstdio>
#include <cstdint>
namespace cg = cooperative_groups;

namespace pg8 {
#define PG8_LAS __attribute__((address_space(3)))
typedef unsigned short bf16_t;
typedef short bf16x8 __attribute__((ext_vector_type(8)));
typedef float f32x4 __attribute__((ext_vector_type(4)));
typedef unsigned u32x4 __attribute__((ext_vector_type(4)));
typedef unsigned u32x2 __attribute__((ext_vector_type(2)));
constexpr int BM = 256, BK = 64, HALF = 128, HTB = HALF * BK * 2  , STAGE_BYTES = 8 * HTB, NXCD = 8, WGM = 8;

__host__ __device__ __forceinline__ int lds_byte(int r, int c) { const int st = (r >> 4) * 2 + (c >> 5), rr = r & 15, cc = c & 31, ob = rr * 64 + cc * 2; return st * 1024 + (ob ^ (((ob >> 9) & 1) << 5)); }
__host__ __device__ __forceinline__ void stage_rc(int b, int& R, int& C) { const int st = b / 1024, sb = b % 1024, swz = sb ^ (((sb >> 9) & 1) << 5); R = (st >> 1) * 16 + swz / 64; C = (st & 1) * 32 + (swz % 64) / 2; }
__host__ __device__ __forceinline__ int perm32(int rho) { const int n = rho >> 4, i = rho & 15; return 8 * (i >> 2) + 4 * n + (i & 3); }

struct Unit { const char* b0; const char* b1; int arow; int p0, p1, p2, p3; };

__device__ __forceinline__ bool static_tile(int i, int G, int c, int nM, int nN, int& pm, int& pn) {
    const int nwg = nM * nN; const long L = (long)i * G + c; if (L >= nwg) return false;
    int wgid = (int)L; { const int q = nwg / NXCD, r = nwg % NXCD, xcd = wgid % NXCD, off = wgid / NXCD; wgid = (xcd < r ? xcd * (q + 1) : r * (q + 1) + (xcd - r) * q) + off; }
    const int nig = WGM * nN, gid = wgid / nig, fm = gid * WGM, gsz = (nM - fm) < WGM ? (nM - fm) : WGM;
    pm = fm + ((wgid % nig) % gsz); pn = (wgid % nig) / gsz; return true;
}

__device__ __forceinline__ unsigned cvt_pk_bf16(float lo, float hi) { unsigned r; asm volatile("v_cvt_pk_bf16_f32 %0, %1, %2" : "=v"(r) : "v"(lo), "v"(hi)); return r; }

template <class Epi, class Sched>
__device__ __forceinline__ void gemm_phase(PG8_LAS unsigned char* lds, const char* Abase, const int K, const Sched& S, const Epi& E) {
    int tid_ = threadIdx.x; asm volatile("" : "+v"(tid_));
    const int tid = tid_, wid = __builtin_amdgcn_readfirstlane(tid >> 6), lane = tid & 63, wr = wid >> 2, wc = wid & 3, fr = lane & 15, fq = lane >> 4;
    const int nt = K / BK;
    int R[2], C[2]; unsigned voffB[2];
#pragma unroll
    for (int i = 0; i < 2; ++i) { stage_rc(tid * 16 + i * 8192, R[i], C[i]); const int Rb = Epi::PERM ? ((R[i] & ~31) + perm32(R[i] & 31)) : R[i]; voffB[i] = (unsigned)(Rb * K + C[i]) * 2u; }
    const size_t kstep = (size_t)(BK * 2);
    const unsigned ldsw = (unsigned)wid * 1024u;
    const int aoff = lds_byte(wr * 64 + fr, fq * 8), boff = lds_byte(wc * 32 + fr, fq * 8);
#define PG8_SA(b, h) (((b) * 2 + (h)) * HTB)
#define PG8_SB(b, h) ((4 + (b) * 2 + (h)) * HTB)
#define PG8_STAGE(bufoff, gbase, v0, v1) do { \
        __builtin_amdgcn_global_load_lds((const unsigned*)((const char*)(gbase) + (v0)), (PG8_LAS unsigned*)(lds + (bufoff) + ldsw), 16, 0, 0); \
        __builtin_amdgcn_global_load_lds((const unsigned*)((const char*)(gbase) + (v1)), (PG8_LAS unsigned*)(lds + (bufoff) + ldsw + 8192), 16, 0, 0); } while (0)
#define PG8_STAGEB(bufoff, gbase) PG8_STAGE(bufoff, gbase, voffB[0], voffB[1])
#define PG8_LDA(dst, b, h) do { _Pragma("unroll") for (int m = 0; m < 4; ++m) _Pragma("unroll") for (int k = 0; k < 2; ++k) dst[m][k] = *(const PG8_LAS bf16x8*)(lds + PG8_SA(b, h) + aoff + m * 2048 + k * 1024); } while (0)
#define PG8_LDB(dst, b, h) do { _Pragma("unroll") for (int n = 0; n < 2; ++n) _Pragma("unroll") for (int k = 0; k < 2; ++k) dst[n][k] = *(const PG8_LAS bf16x8*)(lds + PG8_SB(b, h) + boff + n * 2048 + k * 1024); } while (0)
#define PG8_MMA(ai, bj, At, Bt) do { __builtin_amdgcn_s_setprio(1); _Pragma("unroll") for (int m = 0; m < 4; ++m) _Pragma("unroll") for (int n = 0; n < 2; ++n) _Pragma("unroll") for (int k = 0; k < 2; ++k) \
        acc[ai][bj][m][n] = __builtin_amdgcn_mfma_f32_16x16x32_bf16(Bt[n][k], At[m][k], acc[ai][bj][m][n], 0, 0, 0); __builtin_amdgcn_s_setprio(0); } while (0)
#define PG8_WAIT_V(n) asm volatile("s_waitcnt vmcnt(" #n ")" ::: "memory")
#define PG8_WAIT_L(n) asm volatile("s_waitcnt lgkmcnt(" #n ")" ::: "memory")
#define PG8_BAR __builtin_amdgcn_s_barrier()
#define PG8_SCHED __builtin_amdgcn_sched_barrier(0)
    Unit cur, nxt; int ui = 0;
    if (!S.next(0, cur)) return;
    f32x4 acc[2][2][4][2];
#pragma unroll
    for (int a = 0; a < 2; ++a)
#pragma unroll
        for (int b = 0; b < 2; ++b)
#pragma unroll
            for (int m = 0; m < 4; ++m)
#pragma unroll
                for (int n = 0; n < 2; ++n) acc[a][b][m][n] = (f32x4){0.f, 0.f, 0.f, 0.f};
    bf16x8 At[4][2], B0[2][2], B1[2][2];
    unsigned vA00, vA01, vA10, vA11, vN00, vN01, vN10, vN11;
    S.a_ready(cur, S.peek(cur));
    S.a_offs(cur, R, C, vA00, vA01, vA10, vA11);
    const char* cB0 = cur.b0; const char* cB1 = cur.b1;
    PG8_STAGEB(PG8_SB(0, 0), cB0); PG8_STAGEB(PG8_SB(0, 1), cB1); PG8_STAGE(PG8_SA(0, 0), Abase, vA00, vA01); PG8_STAGE(PG8_SA(0, 1), Abase, vA10, vA11);
    if (wr == 1) PG8_BAR;
    PG8_WAIT_V(2); PG8_BAR;
    PG8_STAGEB(PG8_SB(1, 0), cB0 + kstep); PG8_STAGE(PG8_SA(1, 0), Abase + kstep, vA00, vA01); PG8_STAGEB(PG8_SB(1, 1), cB1 + kstep);
    PG8_WAIT_V(6); PG8_BAR;
    for (;;) {
        const bool has_next = S.next(ui + 1, nxt);
        if (has_next) S.a_offs(nxt, R, C, vN00, vN01, vN10, vN11); else { vN00 = vA00; vN01 = vA01; vN10 = vA10; vN11 = vA11; }
        const char* nB0 = has_next ? nxt.b0 : cB0; const char* nB1 = has_next ? nxt.b1 : cB1;
        const unsigned pk = has_next ? S.peek(nxt) : 0u;
        const bool skip1 = S.half_only(cur);
        for (int t = 0; t < nt; t += 2) {
            const bool last = (t == nt - 2);
            if (last && has_next) S.a_ready(nxt, pk);
            const char* a1 = Abase + (size_t)(t + 1) * kstep;
            PG8_LDB(B0, 0, 0); PG8_LDB(B1, 0, 1); PG8_SCHED; PG8_LDA(At, 0, 0); PG8_STAGE(PG8_SA(1, 1), a1, vA10, vA11);
            PG8_WAIT_V(8); PG8_WAIT_L(0); PG8_BAR; PG8_MMA(0, 0, At, B0); PG8_MMA(0, 1, At, B1); PG8_BAR; PG8_SCHED;
            if (last) { vA00 = vN00; vA01 = vN01; vA10 = vN10; vA11 = vN11; }
            const char* a2 = last ? Abase : Abase + (size_t)(t + 2) * kstep;
            const char* b20 = last ? nB0 : cB0 + (size_t)(t + 2) * kstep; const char* b21 = last ? nB1 : cB1 + (size_t)(t + 2) * kstep;
            const char* a3 = a2 + kstep; const char* b30 = b20 + kstep; const char* b31 = b21 + kstep;
            PG8_LDA(At, 0, 1); PG8_STAGEB(PG8_SB(0, 0), b20); PG8_STAGEB(PG8_SB(0, 1), b21); PG8_STAGE(PG8_SA(0, 0), a2, vA00, vA01);
            PG8_WAIT_V(8); PG8_WAIT_L(0); PG8_BAR; if (!skip1) { PG8_MMA(1, 0, At, B0); PG8_MMA(1, 1, At, B1); } PG8_BAR; PG8_SCHED;
            PG8_LDB(B0, 1, 0); PG8_LDB(B1, 1, 1); PG8_SCHED; PG8_LDA(At, 1, 0); PG8_STAGE(PG8_SA(0, 1), a2, vA10, vA11);
            PG8_WAIT_V(8); PG8_WAIT_L(0); PG8_BAR; PG8_MMA(0, 0, At, B0); PG8_MMA(0, 1, At, B1); PG8_BAR; PG8_SCHED;
            PG8_LDA(At, 1, 1); PG8_STAGEB(PG8_SB(1, 0), b30); PG8_STAGEB(PG8_SB(1, 1), b31); PG8_STAGE(PG8_SA(1, 0), a3, vA00, vA01);
            PG8_WAIT_V(8); PG8_WAIT_L(0); PG8_BAR; if (!skip1) { PG8_MMA(1, 0, At, B0); PG8_MMA(1, 1, At, B1); } PG8_BAR; PG8_SCHED;
        }
        if (wr == 0) PG8_BAR;
        E(acc, cur, wr, wc, fr, fq);
        S.done(cur);
        if (!has_next) break;
#pragma unroll
        for (int a = 0; a < 2; ++a)
#pragma unroll
            for (int b = 0; b < 2; ++b)
#pragma unroll
                for (int m = 0; m < 4; ++m)
#pragma unroll
                    for (int n = 0; n < 2; ++n) acc[a][b][m][n] = (f32x4){0.f, 0.f, 0.f, 0.f};
        cur = nxt; cB0 = nB0; cB1 = nB1; ++ui;
        if (wr == 1) PG8_BAR;
    }
    PG8_WAIT_V(0);
    PG8_BAR;
#undef PG8_SA
#undef PG8_SB
#undef PG8_STAGE
#undef PG8_STAGEB
#undef PG8_LDA
#undef PG8_LDB
#undef PG8_MMA
#undef PG8_WAIT_V
#undef PG8_WAIT_L
#undef PG8_BAR
#undef PG8_SCHED
}
}
#include <hip/hip_bf16.h>
#include <cmath>
namespace attn_body {
using bf16=__hip_bfloat16;
using bf16x8=__attribute__((ext_vector_type(8)))short;
using s16x4=__attribute__((ext_vector_type(4)))short;
using f32x16=__attribute__((ext_vector_type(16)))float;
using u32x4=__attribute__((ext_vector_type(4)))unsigned;
constexpr int D=64,DM=1024;
constexpr int NW=8,QBLK=32,QB=QBLK*NW,KVBLK=64;
constexpr int ATTN_PITCH=DM, ATTN_UNIT_ROWS=QB;
__device__ __forceinline__ int crow(int r,int hi){return (r&3)+8*(r>>2)+4*hi;}
#define SBAR() __builtin_amdgcn_sched_barrier(0)
__device__ __forceinline__ void cmask(f32x16&p0,f32x16&p1,int jb,int qrel,int hi){
  const float NEG=-INFINITY; int kb=64*jb+4*hi;
  #pragma unroll
  for(int r=0;r<16;++r){int kv=kb+(r&3)+8*(r>>2); if(kv>qrel)p0[r]=NEG; if(kv+32>qrel)p1[r]=NEG;}
}

constexpr int NSLOT=3, SLOTB=8192;
constexpr int LDS_K=0, LDS_V=NSLOT*SLOTB, LDS_WS=2*NSLOT*SLOTB, LDS_OST=LDS_WS+NW*64*4, LDS_BYTES=LDS_OST+NW*4096;
constexpr float C2=0.125f*1.4426950408889634f;
__device__ __forceinline__ void glds16(const void*gsrc,unsigned lds_dst){unsigned keep;
  asm volatile("s_mov_b32 %0, m0\n\ts_mov_b32 m0, %2\n\ts_nop 0\n\tglobal_load_lds_dwordx4 %1, off\n\ts_mov_b32 m0, %0":"=&s"(keep):"v"(gsrc),"s"(lds_dst):"memory");}
__device__ __forceinline__ void glds16s(const void*sbase,unsigned voff,unsigned lds_dst){unsigned keep;
  asm volatile("s_mov_b32 %0, m0\n\ts_mov_b32 m0, %3\n\ts_nop 4\n\tglobal_load_lds_dwordx4 %1, %2\n\ts_mov_b32 m0, %0":"=&s"(keep):"v"(voff),"s"(sbase),"s"(lds_dst):"memory");}
__device__ __forceinline__ float max3f(float a,float b,float c){float r;asm("v_max3_f32 %0, %1, %2, %3":"=v"(r):"v"(a),"v"(b),"v"(c));return r;}
__device__ __forceinline__ float max2f(float a,float b){float r;asm("v_max_f32_e32 %0, %1, %2":"=v"(r):"v"(a),"v"(b));return r;}
__device__ __forceinline__ float fadd_s(float a,float b){float r;asm("v_add_f32_e32 %0, %1, %2":"=v"(r):"v"(a),"v"(b));return r;}
__device__ __forceinline__ float fsub_s(float a,float b){float r;asm("v_sub_f32_e32 %0, %1, %2":"=v"(r):"v"(a),"v"(b));return r;}
typedef float f32x2_t __attribute__((ext_vector_type(2))); typedef __bf16 bf16x2_t __attribute__((ext_vector_type(2)));
__device__ __forceinline__ unsigned cvtpk_s(float lo,float hi){f32x2_t v={lo,hi};bf16x2_t b=__builtin_convertvector(v,bf16x2_t);return __builtin_bit_cast(unsigned,b);}
#define WAIT_BAR(N) asm volatile("s_waitcnt vmcnt(" #N ") lgkmcnt(0)\n\ts_barrier":::"memory")

__device__ __forceinline__ void qkt(f32x16&p0,f32x16&p1,const char*Kslot,const bf16x8*qr,const f32x16&negm,int r32,int hi){
  const char*kb=Kslot+hi*1024+r32*16;
  #pragma unroll
  for(int d0=0;d0<4;++d0){
    const bf16x8 b0=*reinterpret_cast<const bf16x8*>(kb+d0*2048);
    const bf16x8 b1=*reinterpret_cast<const bf16x8*>(kb+d0*2048+512);
    if(d0==0){p0=__builtin_amdgcn_mfma_f32_32x32x16_bf16(b0,qr[0],negm,0,0,0);p1=__builtin_amdgcn_mfma_f32_32x32x16_bf16(b1,qr[0],negm,0,0,0);}
    else{p0=__builtin_amdgcn_mfma_f32_32x32x16_bf16(b0,qr[d0],p0,0,0,0);p1=__builtin_amdgcn_mfma_f32_32x32x16_bf16(b1,qr[d0],p1,0,0,0);}}
}
typedef __attribute__((address_space(3))) const char* lds_cptr;
typedef short v4i16_t __attribute__((ext_vector_type(4)));
__device__ __forceinline__ void kload8(bf16x8*kf,lds_cptr kp){
  kf[0]=*(const __attribute__((address_space(3))) bf16x8*)(kp);      kf[1]=*(const __attribute__((address_space(3))) bf16x8*)(kp+512);
  kf[2]=*(const __attribute__((address_space(3))) bf16x8*)(kp+2048); kf[3]=*(const __attribute__((address_space(3))) bf16x8*)(kp+2560);
  kf[4]=*(const __attribute__((address_space(3))) bf16x8*)(kp+4096); kf[5]=*(const __attribute__((address_space(3))) bf16x8*)(kp+4608);
  kf[6]=*(const __attribute__((address_space(3))) bf16x8*)(kp+6144); kf[7]=*(const __attribute__((address_space(3))) bf16x8*)(kp+6656);
}
__device__ __forceinline__ void kload2(bf16x8*kf,lds_cptr kp,int j){ kf[2*j]=*(const __attribute__((address_space(3))) bf16x8*)(kp+j*2048); kf[2*j+1]=*(const __attribute__((address_space(3))) bf16x8*)(kp+j*2048+512); }
__device__ __forceinline__ s16x4 vtr(lds_cptr p){ return __builtin_bit_cast(s16x4,__builtin_amdgcn_ds_read_tr16_b64_v4i16((__attribute__((address_space(3))) v4i16_t*)p)); }
__device__ __forceinline__ float rowmax(const f32x16&p0,const f32x16&p1){
  float a=max3f(p0[0],p0[1],p1[0]),b=max3f(p0[2],p0[3],p1[1]);a=max3f(a,p1[2],p1[3]);
  #pragma unroll
  for(int r=4;r<16;r+=4){a=max3f(a,p0[r],p0[r+1]);b=max3f(b,p0[r+2],p0[r+3]);a=max3f(a,p1[r],p1[r+1]);b=max3f(b,p1[r+2],p1[r+3]);}
  const float m=max2f(a,b);
  auto rr=__builtin_amdgcn_permlane32_swap(__float_as_uint(m),__float_as_uint(m),false,false);
  return max2f(__uint_as_float(rr[0]),__uint_as_float(rr[1]));
}
__device__ __forceinline__ void pv(f32x16*o,int vb,bf16x8 pa0,bf16x8 pa1,bf16x8 pa2,bf16x8 pa3){
  #pragma unroll
  for(int d0=0;d0<2;++d0){s16x4 lo[4],hi[4];
    #pragma unroll
    for(int ks=0;ks<4;++ks){
      asm volatile("ds_read_b64_tr_b16 %0,%1 offset:%c2":"=&v"(lo[ks]):"v"(vb),"i"(d0*4096+ks*1024):"memory");
      asm volatile("ds_read_b64_tr_b16 %0,%1 offset:%c2":"=&v"(hi[ks]):"v"(vb),"i"(d0*4096+ks*1024+512):"memory");}
    asm volatile("s_waitcnt lgkmcnt(0)":::"memory");SBAR();
    #define PK(k) (bf16x8){lo[k][0],lo[k][1],lo[k][2],lo[k][3],hi[k][0],hi[k][1],hi[k][2],hi[k][3]}
    o[d0]=__builtin_amdgcn_mfma_f32_32x32x16_bf16(pa0,PK(0),o[d0],0,0,0);
    o[d0]=__builtin_amdgcn_mfma_f32_32x32x16_bf16(pa1,PK(1),o[d0],0,0,0);
    o[d0]=__builtin_amdgcn_mfma_f32_32x32x16_bf16(pa2,PK(2),o[d0],0,0,0);
    o[d0]=__builtin_amdgcn_mfma_f32_32x32x16_bf16(pa3,PK(3),o[d0],0,0,0);
    #undef PK
  }
}

#ifndef ATTN_STORE16
#define ATTN_STORE16(p,v) (*(u32x4*)(p)=(v))
#endif
template<int THRL> __device__ __forceinline__ void attn_unit(long rowbase,int qb,const bf16*Qc,const bf16*__restrict__ Kc,const bf16*__restrict__ Vc,bf16*Oc,char*shm){
  int tid_=threadIdx.x; asm volatile("":"+v"(tid_)); const int tid=tid_,lane=tid&63,r32=lane&31,hi=lane>>5; const int wid=__builtin_amdgcn_readfirstlane(tid>>6);
  const int q0=qb*QB;
  const bf16*Qw=Qc+(rowbase+q0+wid*QBLK)*DM;
  const bf16*Kh=Kc+rowbase*DM,*Vh=Vc+rowbase*DM;
  const unsigned lds0=(unsigned)(uintptr_t)shm;
  float*wsf=(float*)(shm+LDS_WS)+wid*64;
  const unsigned koff=(unsigned)(lane*DM+wid*8)*2u;
  const unsigned voffv=(unsigned)((16*(wid&3)+(lane>>2))*DM+(wid>>2)*32+(lane&3)*8)*2u;
  const unsigned kdst=lds0+LDS_K+wid*1024, vdst=lds0+LDS_V+wid*1024;
  #define DMA_K(t,slot) glds16s(Kh+(long)(t)*KVBLK*DM,koff,(unsigned)__builtin_amdgcn_readfirstlane(kdst+(slot)))
  #define DMA_V(t,slot) glds16s(Vh+(long)(t)*KVBLK*DM,voffv,(unsigned)__builtin_amdgcn_readfirstlane(vdst+(slot)))
  const int vb0=(int)(lds0+LDS_V)+((lane>>4)&1)*32+(lane&3)*8+(4*hi+((lane&15)>>2))*64;
  const char*Kbase=shm+LDS_K; bf16x8 kf[8];
  const lds_cptr shm3=(lds_cptr)shm; const lds_cptr kp0=shm3+LDS_K+hi*1024+r32*16; const lds_cptr vp0=shm3+LDS_V+((lane>>4)&1)*32+(lane&3)*8+(4*hi+((lane&15)>>2))*64;
  const int NT=(q0+QB)/KVBLK;
  DMA_K(0,0);DMA_V(0,0);DMA_K(1,SLOTB);
  bf16x8 qr[4];
  #pragma unroll
  for(int d0=0;d0<4;++d0)qr[d0]=*reinterpret_cast<const bf16x8*>(&Qw[(long)r32*DM+d0*16+hi*8]);
  float mhat=0.f,l_reg=0.f;f32x16 o[2];o[0]=f32x16{};o[1]=f32x16{};f32x16 negm=f32x16{};asm volatile("":"+v"(negm));
  const int qrel=wid*QBLK+r32;
  #define CMASK(P0,P1,t) do{int jb_=(t)-(NT-4); if(jb_>=0)cmask(P0,P1,jb_,qrel,hi);}while(0)
  bool resc=false;
  #define START(P0,P1) do{ const float rm=rowmax(P0,P1); resc=false; \
    { const float dl=rm; mhat=fadd_s(mhat,dl); \
      _Pragma("unroll") for(int r=0;r<16;++r){P0[r]=fsub_s(P0[r],dl);P1[r]=fsub_s(P1[r],dl);} \
      _Pragma("unroll") for(int r=0;r<16;++r)negm[r]=-mhat; asm volatile("":"+v"(negm)); } \
    _Pragma("unroll") for(int r=0;r<16;++r)P0[r]=__builtin_amdgcn_exp2f(P0[r]); }while(0)
  #define RESC() do{ if(resc){ asm volatile("s_waitcnt lgkmcnt(0)":::"memory"); \
      _Pragma("unroll") for(int d_=0;d_<2;++d_) _Pragma("unroll") for(int r=0;r<16;++r)o[d_][r]*=wsf[crow(r,hi)]; } }while(0)
  f32x16 pA0,pA1,pB0,pB1;
  int sl_prev=0,sl_cur=0,sl_next=SLOTB;
  #define ROT() do{sl_prev=sl_cur;sl_cur=sl_next;sl_next=(sl_next==(NSLOT-1)*SLOTB)?0:sl_next+SLOTB;}while(0)
  DMA_K(2,2*SLOTB);
  WAIT_BAR(3);
  qkt(pA0,pA1,Kbase,qr,negm,r32,hi);asm volatile("s_nop 15\n\ts_nop 7":"+v"(pA0),"+v"(pA1));CMASK(pA0,pA1,0);
  START(pA0,pA1);
  _Pragma("unroll") for(int r=0;r<16;++r)pA1[r]=__builtin_amdgcn_exp2f(pA1[r]);
  WAIT_BAR(0);
  DMA_K(3,0);DMA_V(1,SLOTB);
  ROT();
  kload8(kf,kp0+sl_cur);
  WAIT_BAR(2);
  s16x4 vlo[8],vhi[8]; u32x4 pw0,pw1,pw2,pw3;
  #define PKW(P,B) cvtpk_s(P[B],P[B+1])
  #define PAF(k) __builtin_bit_cast(bf16x8,pw##k)
  #define VFR(i) (bf16x8){vlo[i][0],vlo[i][1],vlo[i][2],vlo[i][3],vhi[i][0],vhi[i][1],vhi[i][2],vhi[i][3]}
  #define PIN(x) asm volatile("":"+v"(x))
  #define MX3(a,b,c) __builtin_fmaxf(__builtin_fmaxf((a),(b)),(c))
  #define GAPA(MF,A0,A1,A2,A3,W0,W1,PW) do{ MF; sacc+=A0; sacc+=A1; sacc+=A2; sacc+=A3; PIN(sacc); W0; W1; PIN(PW); SBAR(); }while(0)
  #define EX(v) __builtin_amdgcn_exp2f(v)
  #define GAPB(MF,X,B) do{ MF; X[B]=EX(X[B]); X[B+1]=EX(X[B+1]); X[B+2]=EX(X[B+2]); X[B+3]=EX(X[B+3]); PIN(X); SBAR(); }while(0)
  #define VRD(i) do{ vlo[i]=vtr(vp_+(((i)>>2)*4096+((i)&3)*1024)); vhi[i]=vtr(vp_+(((i)>>2)*4096+((i)&3)*1024+512)); }while(0)
  #define KRD(G,j) do{ if(G){ kload2(kf,kp0+sl_next,j); SBAR(); } }while(0)
  #define STEP(C0,C1,P0,P1,t,GK,GV,GL) do{ SBAR(); \
    const lds_cptr vp_=vp0+sl_prev; \
    VRD(0); SBAR(); float sacc=(P0[0]+P0[1]); \
    GAPA(C0=__builtin_amdgcn_mfma_f32_32x32x16_bf16(kf[0],qr[0],negm,0,0,0), P0[2],P0[3],P0[4],P0[5],     pw0[0]=PKW(P0,0), pw0[1]=PKW(P0,2), pw0); \
    VRD(4); SBAR(); GAPA(C1=__builtin_amdgcn_mfma_f32_32x32x16_bf16(kf[1],qr[0],negm,0,0,0), P0[6],P0[7],P0[8],P0[9],     pw0[2]=PKW(P0,4), pw0[3]=PKW(P0,6), pw0); \
    VRD(1); SBAR(); GAPA(C0=__builtin_amdgcn_mfma_f32_32x32x16_bf16(kf[2],qr[1],C0,0,0,0),   P0[10],P0[11],P0[12],P0[13], pw1[0]=PKW(P0,8), pw1[1]=PKW(P0,10), pw1); \
    VRD(5); SBAR(); GAPA(C1=__builtin_amdgcn_mfma_f32_32x32x16_bf16(kf[3],qr[1],C1,0,0,0),   P0[14],P0[15],P1[0],P1[1],   pw1[2]=PKW(P0,12),pw1[3]=PKW(P0,14), pw1); \
    VRD(2); SBAR(); GAPA(C0=__builtin_amdgcn_mfma_f32_32x32x16_bf16(kf[4],qr[2],C0,0,0,0),   P1[2],P1[3],P1[4],P1[5],     pw2[0]=PKW(P1,0), pw2[1]=PKW(P1,2), pw2); \
    VRD(6); SBAR(); GAPA(C1=__builtin_amdgcn_mfma_f32_32x32x16_bf16(kf[5],qr[2],C1,0,0,0),   P1[6],P1[7],P1[8],P1[9],     pw2[2]=PKW(P1,4), pw2[3]=PKW(P1,6), pw2); \
    VRD(3); SBAR(); GAPA(C0=__builtin_amdgcn_mfma_f32_32x32x16_bf16(kf[6],qr[3],C0,0,0,0),   P1[10],P1[11],P1[12],P1[13], pw3[0]=PKW(P1,8), pw3[1]=PKW(P1,10), pw3); \
    VRD(7); SBAR(); GAPA(C1=__builtin_amdgcn_mfma_f32_32x32x16_bf16(kf[7],qr[3],C1,0,0,0),   P1[14],P1[15],0.f,0.f,       pw3[2]=PKW(P1,12),pw3[3]=PKW(P1,14), pw3); \
    l_reg+=sacc; \
    if(GK){DMA_K((t)+3,sl_cur);} if(GV){DMA_V((t)+1,sl_next);} \
    CMASK(C0,C1,t); \
    { float a=MX3(C0[0],C0[1],C1[0]),b=MX3(C0[2],C0[3],C1[1]); a=MX3(a,C1[2],C1[3]); \
      _Pragma("unroll") for(int r=4;r<16;r+=4){a=MX3(a,C0[r],C0[r+1]);b=MX3(b,C0[r+2],C0[r+3]);a=MX3(a,C1[r],C1[r+1]);b=MX3(b,C1[r+2],C1[r+3]);} \
      float rm=__builtin_fmaxf(a,b); { auto rr=__builtin_amdgcn_permlane32_swap(__float_as_uint(rm),__float_as_uint(rm),false,false); rm=__builtin_fmaxf(__uint_as_float(rr[0]),__uint_as_float(rr[1])); } \
      resc=false; \
      if(__builtin_expect(__any(rm>(float)THRL),0)){ const float dl=__builtin_fmaxf(rm,0.f); mhat+=dl; \
        _Pragma("unroll") for(int r=0;r<16;++r){C0[r]-=dl;C1[r]-=dl;} \
        _Pragma("unroll") for(int r=0;r<16;++r)negm[r]=-mhat; asm volatile("":"+v"(negm)); \
        const float f=__builtin_amdgcn_exp2f(-dl); l_reg*=f; if(hi==0)wsf[r32]=f; resc=true; } } \
    SBAR(); \
    GAPB(o[0]=__builtin_amdgcn_mfma_f32_32x32x16_bf16(PAF(0),VFR(0),o[0],0,0,0), C0,0); \
    GAPB(o[1]=__builtin_amdgcn_mfma_f32_32x32x16_bf16(PAF(0),VFR(4),o[1],0,0,0), C0,4); \
    KRD(GL,0); GAPB(o[0]=__builtin_amdgcn_mfma_f32_32x32x16_bf16(PAF(1),VFR(1),o[0],0,0,0), C0,8); \
    KRD(GL,1); GAPB(o[1]=__builtin_amdgcn_mfma_f32_32x32x16_bf16(PAF(1),VFR(5),o[1],0,0,0), C0,12); \
    KRD(GL,2); GAPB(o[0]=__builtin_amdgcn_mfma_f32_32x32x16_bf16(PAF(2),VFR(2),o[0],0,0,0), C1,0); \
    KRD(GL,3); GAPB(o[1]=__builtin_amdgcn_mfma_f32_32x32x16_bf16(PAF(2),VFR(6),o[1],0,0,0), C1,4); \
    GAPB(o[0]=__builtin_amdgcn_mfma_f32_32x32x16_bf16(PAF(3),VFR(3),o[0],0,0,0), C1,8); \
    GAPB(o[1]=__builtin_amdgcn_mfma_f32_32x32x16_bf16(PAF(3),VFR(7),o[1],0,0,0), C1,12); \
    }while(0)
  int t=1;
  #undef CMASK
  #define CMASK(P0,P1,t) do{}while(0)
  for(;t+5<NT;t+=2){
    STEP(pB0,pB1,pA0,pA1,t,true,true,true);     WAIT_BAR(2); RESC(); ROT();
    STEP(pA0,pA1,pB0,pB1,t+1,true,true,true);   WAIT_BAR(2); RESC(); ROT();
  }
  #undef CMASK
  #define CMASK(P0,P1,t) do{int jb_=(t)-(NT-4); if(jb_>=0)cmask(P0,P1,jb_,qrel,hi);}while(0)
  #define ENDW(tt) do{ if((tt)+3<NT){WAIT_BAR(2);} else if((tt)+2<NT){WAIT_BAR(1);} else {WAIT_BAR(0);} }while(0)
  for(;t+1<NT;t+=2){
    STEP(pB0,pB1,pA0,pA1,t,(t+3<NT),(t+1<NT),(t+1<NT));       ENDW(t);   RESC(); ROT();
    STEP(pA0,pA1,pB0,pB1,t+1,(t+4<NT),(t+2<NT),(t+2<NT));     ENDW(t+1); RESC(); ROT();
  }
  STEP(pB0,pB1,pA0,pA1,NT-1,false,false,false); RESC();
  { float sacc=pB0[0]+pB0[1]; _Pragma("unroll") for(int r=2;r<16;++r)sacc+=pB0[r]; _Pragma("unroll") for(int r=0;r<16;++r)sacc+=pB1[r]; l_reg+=sacc;
    pw0=(u32x4){PKW(pB0,0),PKW(pB0,2),PKW(pB0,4),PKW(pB0,6)};pw1=(u32x4){PKW(pB0,8),PKW(pB0,10),PKW(pB0,12),PKW(pB0,14)};pw2=(u32x4){PKW(pB1,0),PKW(pB1,2),PKW(pB1,4),PKW(pB1,6)};pw3=(u32x4){PKW(pB1,8),PKW(pB1,10),PKW(pB1,12),PKW(pB1,14)};
    SBAR(); pv(o,vb0+sl_cur,PAF(0),PAF(1),PAF(2),PAF(3)); }
  #undef PKW
  #undef PAF
  #undef VFR
  #undef PIN
  #undef MX3
  #undef GAPA
  #undef GAPB
  #undef EX
  #undef VRD
  #undef KRD
  #undef STEP
  #undef ENDW
  {auto rr=__builtin_amdgcn_permlane32_swap(__float_as_uint(l_reg),__float_as_uint(l_reg),false,false);l_reg=__uint_as_float(rr[0])+__uint_as_float(rr[1]);}
  if(hi==0)wsf[32+r32]=l_reg;asm volatile("s_waitcnt lgkmcnt(0)":::"memory");
  float rli[16];
  #pragma unroll
  for(int r=0;r<16;++r)rli[r]=__builtin_amdgcn_rcpf(wsf[32+crow(r,hi)]);
  bf16*Ow=Oc+(rowbase+q0+wid*QBLK)*DM;
  { bf16*stg=(bf16*)(shm+LDS_OST)+wid*2048;
    #pragma unroll
    for(int r=0;r<16;++r){const int orow=crow(r,hi);
      #pragma unroll
      for(int d0=0;d0<2;++d0)stg[orow*64+d0*32+r32]=__float2bfloat16(o[d0][r]*rli[r]);}
    asm volatile("s_waitcnt lgkmcnt(0)":::"memory");
    #pragma unroll
    for(int i=0;i<4;++i){const int row=i*8+(lane>>3),ch=lane&7; const u32x4 v=*(const u32x4*)(stg+row*64+ch*8); ATTN_STORE16(Ow+(long)row*DM+ch*8,v);} }
  asm volatile("s_waitcnt lgkmcnt(0)\n\ts_barrier":::"memory");
  #undef DMA_K
  #undef DMA_V
  #undef CMASK
  #undef START
  #undef RESC
  #undef ROT
}
constexpr int ATTN_LDS_BYTES=LDS_BYTES;
#undef SBAR
#undef WAIT_BAR
}
namespace attn128 {
using bf16=__hip_bfloat16;
using bf16x8=__attribute__((ext_vector_type(8)))short;
using s16x4=__attribute__((ext_vector_type(4)))short;
using f32x16=__attribute__((ext_vector_type(16)))float;
using u32x4=__attribute__((ext_vector_type(4)))unsigned;
constexpr int D=64,DM=1024;
constexpr int NW=8,QBLK=32,QB=QBLK*NW,KVBLK=64;
constexpr int ATTN_PITCH=DM, ATTN_UNIT_ROWS=QB;
__device__ __forceinline__ int crow(int r,int hi){return (r&3)+8*(r>>2)+4*hi;}
#define SBAR() __builtin_amdgcn_sched_barrier(0)
__device__ __forceinline__ void cmask(f32x16&p0,f32x16&p1,int jb,int qrel,int hi){
  const float NEG=-INFINITY; int kb=64*jb+4*hi;
  #pragma unroll
  for(int r=0;r<16;++r){int kv=kb+(r&3)+8*(r>>2); if(kv>qrel)p0[r]=NEG; if(kv+32>qrel)p1[r]=NEG;}
}

constexpr int NSLOT=3, SLOTB=8192;
constexpr int LDS_K=0, LDS_V=NSLOT*SLOTB, LDS_WS=LDS_V+NSLOT*2*SLOTB, LDS_OST=LDS_WS+NW*64*4, LDS_BYTES=LDS_OST+NW*8192;
constexpr float C2=0.125f*1.4426950408889634f;
__device__ __forceinline__ void glds16(const void*gsrc,unsigned lds_dst){unsigned keep;
  asm volatile("s_mov_b32 %0, m0\n\ts_mov_b32 m0, %2\n\ts_nop 0\n\tglobal_load_lds_dwordx4 %1, off\n\ts_mov_b32 m0, %0":"=&s"(keep):"v"(gsrc),"s"(lds_dst):"memory");}
__device__ __forceinline__ void glds16s(const void*sbase,unsigned voff,unsigned lds_dst){unsigned keep;
  asm volatile("s_mov_b32 %0, m0\n\ts_mov_b32 m0, %3\n\ts_nop 4\n\tglobal_load_lds_dwordx4 %1, %2\n\ts_mov_b32 m0, %0":"=&s"(keep):"v"(voff),"s"(sbase),"s"(lds_dst):"memory");}
__device__ __forceinline__ float max3f(float a,float b,float c){float r;asm("v_max3_f32 %0, %1, %2, %3":"=v"(r):"v"(a),"v"(b),"v"(c));return r;}
__device__ __forceinline__ float max2f(float a,float b){float r;asm("v_max_f32_e32 %0, %1, %2":"=v"(r):"v"(a),"v"(b));return r;}
__device__ __forceinline__ float fadd_s(float a,float b){float r;asm("v_add_f32_e32 %0, %1, %2":"=v"(r):"v"(a),"v"(b));return r;}
__device__ __forceinline__ float fsub_s(float a,float b){float r;asm("v_sub_f32_e32 %0, %1, %2":"=v"(r):"v"(a),"v"(b));return r;}
typedef float f32x2_t __attribute__((ext_vector_type(2))); typedef __bf16 bf16x2_t __attribute__((ext_vector_type(2)));
__device__ __forceinline__ unsigned cvtpk_s(float lo,float hi){f32x2_t v={lo,hi};bf16x2_t b=__builtin_convertvector(v,bf16x2_t);return __builtin_bit_cast(unsigned,b);}
#define WAIT_BAR(N) asm volatile("s_waitcnt vmcnt(" #N ") lgkmcnt(0)\n\ts_barrier":::"memory")

__device__ __forceinline__ void qkt(f32x16&p0,f32x16&p1,const char*Kslot,const bf16x8*qr,const f32x16&negm,int r32,int hi){
  const char*kb=Kslot+hi*1024+r32*16;
  #pragma unroll
  for(int d0=0;d0<4;++d0){
    const bf16x8 b0=*reinterpret_cast<const bf16x8*>(kb+d0*2048);
    const bf16x8 b1=*reinterpret_cast<const bf16x8*>(kb+d0*2048+512);
    if(d0==0){p0=__builtin_amdgcn_mfma_f32_32x32x16_bf16(b0,qr[0],negm,0,0,0);p1=__builtin_amdgcn_mfma_f32_32x32x16_bf16(b1,qr[0],negm,0,0,0);}
    else{p0=__builtin_amdgcn_mfma_f32_32x32x16_bf16(b0,qr[d0],p0,0,0,0);p1=__builtin_amdgcn_mfma_f32_32x32x16_bf16(b1,qr[d0],p1,0,0,0);}}
}
typedef __attribute__((address_space(3))) const char* lds_cptr;
typedef short v4i16_t __attribute__((ext_vector_type(4)));
__device__ __forceinline__ void kload8(bf16x8*kf,lds_cptr kp){
  kf[0]=*(const __attribute__((address_space(3))) bf16x8*)(kp);      kf[1]=*(const __attribute__((address_space(3))) bf16x8*)(kp+512);
  kf[2]=*(const __attribute__((address_space(3))) bf16x8*)(kp+2048); kf[3]=*(const __attribute__((address_space(3))) bf16x8*)(kp+2560);
  kf[4]=*(const __attribute__((address_space(3))) bf16x8*)(kp+4096); kf[5]=*(const __attribute__((address_space(3))) bf16x8*)(kp+4608);
  kf[6]=*(const __attribute__((address_space(3))) bf16x8*)(kp+6144); kf[7]=*(const __attribute__((address_space(3))) bf16x8*)(kp+6656);
}
__device__ __forceinline__ void kload2(bf16x8*kf,lds_cptr kp,int j){ kf[2*j]=*(const __attribute__((address_space(3))) bf16x8*)(kp+j*2048); kf[2*j+1]=*(const __attribute__((address_space(3))) bf16x8*)(kp+j*2048+512); }
__device__ __forceinline__ s16x4 vtr(lds_cptr p){ return __builtin_bit_cast(s16x4,__builtin_amdgcn_ds_read_tr16_b64_v4i16((__attribute__((address_space(3))) v4i16_t*)p)); }
__device__ __forceinline__ float rowmax(const f32x16&p0,const f32x16&p1){
  float a=max3f(p0[0],p0[1],p1[0]),b=max3f(p0[2],p0[3],p1[1]);a=max3f(a,p1[2],p1[3]);
  #pragma unroll
  for(int r=4;r<16;r+=4){a=max3f(a,p0[r],p0[r+1]);b=max3f(b,p0[r+2],p0[r+3]);a=max3f(a,p1[r],p1[r+1]);b=max3f(b,p1[r+2],p1[r+3]);}
  const float m=max2f(a,b);
  auto rr=__builtin_amdgcn_permlane32_swap(__float_as_uint(m),__float_as_uint(m),false,false);
  return max2f(__uint_as_float(rr[0]),__uint_as_float(rr[1]));
}
__device__ __forceinline__ void pv(f32x16*o,int vb,bf16x8 pa0,bf16x8 pa1,bf16x8 pa2,bf16x8 pa3){
  #pragma unroll
  for(int d0=0;d0<2;++d0){s16x4 lo[4],hi[4];
    #pragma unroll
    for(int ks=0;ks<4;++ks){
      asm volatile("ds_read_b64_tr_b16 %0,%1 offset:%c2":"=&v"(lo[ks]):"v"(vb),"i"(d0*4096+ks*1024):"memory");
      asm volatile("ds_read_b64_tr_b16 %0,%1 offset:%c2":"=&v"(hi[ks]):"v"(vb),"i"(d0*4096+ks*1024+512):"memory");}
    asm volatile("s_waitcnt lgkmcnt(0)":::"memory");SBAR();
    #define PK(k) (bf16x8){lo[k][0],lo[k][1],lo[k][2],lo[k][3],hi[k][0],hi[k][1],hi[k][2],hi[k][3]}
    o[d0]=__builtin_amdgcn_mfma_f32_32x32x16_bf16(pa0,PK(0),o[d0],0,0,0);
    o[d0]=__builtin_amdgcn_mfma_f32_32x32x16_bf16(pa1,PK(1),o[d0],0,0,0);
    o[d0]=__builtin_amdgcn_mfma_f32_32x32x16_bf16(pa2,PK(2),o[d0],0,0,0);
    o[d0]=__builtin_amdgcn_mfma_f32_32x32x16_bf16(pa3,PK(3),o[d0],0,0,0);
    #undef PK
  }
}

#ifndef ATTN_STORE16
#define ATTN_STORE16(p,v) (*(u32x4*)(p)=(v))
#endif
template<int THRL,int MODE> __device__ __forceinline__ void attn_unit(long rowbase,int qb,const bf16*Qc,const bf16*__restrict__ Kc,const bf16*__restrict__ Vc,bf16*Oc,char*shm,float lam,const float*gsub,float osc,float rms_eps){
  int tid_=threadIdx.x; asm volatile("":"+v"(tid_)); const int tid=tid_,lane=tid&63,r32=lane&31,hi=lane>>5; const int wid=__builtin_amdgcn_readfirstlane(tid>>6);
  const int q0=qb*QB;
  const bf16*Qw=Qc+(rowbase+q0+wid*QBLK)*DM;
  const bf16*Kh=Kc+rowbase*DM,*Vh=Vc+rowbase*DM;
  const unsigned lds0=(unsigned)(uintptr_t)shm;
  float*wsf=(float*)(shm+LDS_WS)+wid*64;
  const unsigned koff=(unsigned)(lane*DM+wid*8)*2u;
  const unsigned voffv=(unsigned)((16*(wid&3)+(lane>>2))*DM+(wid>>2)*32+(lane&3)*8)*2u;
  const unsigned kdst=lds0+LDS_K+wid*1024, vdst=lds0+LDS_V+wid*1024;
  #define DMA_K(t,slot) glds16s(Kh+(long)(t)*KVBLK*DM,koff,(unsigned)__builtin_amdgcn_readfirstlane(kdst+(slot)))
  #define DMA_V(t,slot) do{ glds16s(Vh+(long)(t)*KVBLK*DM,voffv,(unsigned)__builtin_amdgcn_readfirstlane(vdst+2*(slot))); glds16s(Vh+(long)(t)*KVBLK*DM+64,voffv,(unsigned)__builtin_amdgcn_readfirstlane(vdst+2*(slot)+8192)); }while(0)
  const int vb0=(int)(lds0+LDS_V)+((lane>>4)&1)*32+(lane&3)*8+(4*hi+((lane&15)>>2))*64;
  const char*Kbase=shm+LDS_K; bf16x8 kf[8];
  const lds_cptr shm3=(lds_cptr)shm; const lds_cptr kp0=shm3+LDS_K+hi*1024+r32*16; const lds_cptr vp0=shm3+LDS_V+((lane>>4)&1)*32+(lane&3)*8+(4*hi+((lane&15)>>2))*64;
  const int NT=(q0+QB)/KVBLK;
  DMA_K(0,0);DMA_V(0,0);DMA_K(1,SLOTB);
  bf16x8 qr[4];
  #pragma unroll
  for(int d0=0;d0<4;++d0)qr[d0]=*reinterpret_cast<const bf16x8*>(&Qw[(long)r32*DM+d0*16+hi*8]);
  float mhat=0.f,l_reg=0.f;f32x16 o[4];o[0]=f32x16{};o[1]=f32x16{};o[2]=f32x16{};o[3]=f32x16{};const f32x16 zf=f32x16{};
  const int qrel=wid*QBLK+r32;
  #define CMASK(P0,P1,t) do{int jb_=(t)-(NT-4); if(jb_>=0)cmask(P0,P1,jb_,qrel,hi);}while(0)
  bool resc=false;
  #define START(P0,P1) do{ const float rm=rowmax(P0,P1); resc=false; \
    { const float dl=rm; mhat=fadd_s(mhat,dl); \
      _Pragma("unroll") for(int r=0;r<16;++r){P0[r]=fsub_s(P0[r],dl);P1[r]=fsub_s(P1[r],dl);} \
      } \
    _Pragma("unroll") for(int r=0;r<16;++r)P0[r]=__builtin_amdgcn_exp2f(P0[r]); }while(0)
  #define RESC() do{ if(resc){ asm volatile("s_waitcnt lgkmcnt(0)":::"memory"); \
      _Pragma("unroll") for(int d_=0;d_<4;++d_) _Pragma("unroll") for(int r=0;r<16;++r)o[d_][r]*=wsf[crow(r,hi)]; } }while(0)
  f32x16 pA0,pA1,pB0,pB1;
  int sl_prev=0,sl_cur=0,sl_next=SLOTB;
  #define ROT() do{sl_prev=sl_cur;sl_cur=sl_next;sl_next=(sl_next==(NSLOT-1)*SLOTB)?0:sl_next+SLOTB;}while(0)
  DMA_K(2,2*SLOTB);
  WAIT_BAR(4);
  qkt(pA0,pA1,Kbase,qr,zf,r32,hi);asm volatile("s_nop 15\n\ts_nop 7":"+v"(pA0),"+v"(pA1));CMASK(pA0,pA1,0);
  START(pA0,pA1);
  _Pragma("unroll") for(int r=0;r<16;++r)pA1[r]=__builtin_amdgcn_exp2f(pA1[r]);
  WAIT_BAR(0);
  DMA_K(3,0);DMA_V(1,SLOTB);
  ROT();
  kload8(kf,kp0+sl_cur);
  WAIT_BAR(3);
  s16x4 vlo[8],vhi[8]; u32x4 pw0,pw1,pw2,pw3;
  #define PKW(P,B) cvtpk_s(P[B],P[B+1])
  #define PAF(k) __builtin_bit_cast(bf16x8,pw##k)
  #define VFR(i) (bf16x8){vlo[i][0],vlo[i][1],vlo[i][2],vlo[i][3],vhi[i][0],vhi[i][1],vhi[i][2],vhi[i][3]}
  #define PIN(x) asm volatile("":"+v"(x))
  #define MX3(a,b,c) __builtin_fmaxf(__builtin_fmaxf((a),(b)),(c))
  #define GAPA(MF,A0,A1,A2,A3,W0,W1,PW) do{ MF; sacc+=A0; sacc+=A1; sacc+=A2; sacc+=A3; PIN(sacc); W0; W1; PIN(PW); SBAR(); }while(0)
  #define EX(v) __builtin_amdgcn_exp2f(v)
  #define GAPB(MF,X,B) do{ MF; X[B]=EX(X[B]); X[B+1]=EX(X[B+1]); X[B+2]=EX(X[B+2]); X[B+3]=EX(X[B+3]); PIN(X); SBAR(); }while(0)
  #define VRD(i) do{ vlo[i]=vtr(vp_+(((i)>>2)*4096+((i)&3)*1024)); vhi[i]=vtr(vp_+(((i)>>2)*4096+((i)&3)*1024+512)); }while(0)
  #define KRD(G,j) do{ if(G){ kload2(kf,kp0+sl_next,j); SBAR(); } }while(0)
  #define VRD2(i) do{ vlo[i]=vtr(vp_+(8192+((i)>>2)*4096+((i)&3)*1024)); vhi[i]=vtr(vp_+(8192+((i)>>2)*4096+((i)&3)*1024+512)); SBAR(); }while(0)
  #define STEP(C0,C1,P0,P1,t,GK,GV,GL) do{ SBAR(); \
    const lds_cptr vp_=vp0+2*sl_prev; \
    VRD(0); SBAR(); float sacc=(P0[0]+P0[1]); \
    GAPA(C0=__builtin_amdgcn_mfma_f32_32x32x16_bf16(kf[0],qr[0],zf,0,0,0), P0[2],P0[3],P0[4],P0[5],     pw0[0]=PKW(P0,0), pw0[1]=PKW(P0,2), pw0); \
    VRD(4); SBAR(); GAPA(C1=__builtin_amdgcn_mfma_f32_32x32x16_bf16(kf[1],qr[0],zf,0,0,0), P0[6],P0[7],P0[8],P0[9],     pw0[2]=PKW(P0,4), pw0[3]=PKW(P0,6), pw0); \
    VRD(1); SBAR(); GAPA(C0=__builtin_amdgcn_mfma_f32_32x32x16_bf16(kf[2],qr[1],C0,0,0,0),   P0[10],P0[11],P0[12],P0[13], pw1[0]=PKW(P0,8), pw1[1]=PKW(P0,10), pw1); \
    VRD(5); SBAR(); GAPA(C1=__builtin_amdgcn_mfma_f32_32x32x16_bf16(kf[3],qr[1],C1,0,0,0),   P0[14],P0[15],P1[0],P1[1],   pw1[2]=PKW(P0,12),pw1[3]=PKW(P0,14), pw1); \
    VRD(2); SBAR(); GAPA(C0=__builtin_amdgcn_mfma_f32_32x32x16_bf16(kf[4],qr[2],C0,0,0,0),   P1[2],P1[3],P1[4],P1[5],     pw2[0]=PKW(P1,0), pw2[1]=PKW(P1,2), pw2); \
    VRD(6); SBAR(); GAPA(C1=__builtin_amdgcn_mfma_f32_32x32x16_bf16(kf[5],qr[2],C1,0,0,0),   P1[6],P1[7],P1[8],P1[9],     pw2[2]=PKW(P1,4), pw2[3]=PKW(P1,6), pw2); \
    VRD(3); SBAR(); GAPA(C0=__builtin_amdgcn_mfma_f32_32x32x16_bf16(kf[6],qr[3],C0,0,0,0),   P1[10],P1[11],P1[12],P1[13], pw3[0]=PKW(P1,8), pw3[1]=PKW(P1,10), pw3); \
    VRD(7); SBAR(); GAPA(C1=__builtin_amdgcn_mfma_f32_32x32x16_bf16(kf[7],qr[3],C1,0,0,0),   P1[14],P1[15],0.f,0.f,       pw3[2]=PKW(P1,12),pw3[3]=PKW(P1,14), pw3); \
    l_reg+=sacc; \
    if(GK){DMA_K((t)+3,sl_cur);} if(GV){DMA_V((t)+1,sl_next);} \
    _Pragma("unroll") for(int r=0;r<16;++r){C0[r]-=mhat;C1[r]-=mhat;} \
    CMASK(C0,C1,t); \
    { float a=MX3(C0[0],C0[1],C1[0]),b=MX3(C0[2],C0[3],C1[1]); a=MX3(a,C1[2],C1[3]); \
      _Pragma("unroll") for(int r=4;r<16;r+=4){a=MX3(a,C0[r],C0[r+1]);b=MX3(b,C0[r+2],C0[r+3]);a=MX3(a,C1[r],C1[r+1]);b=MX3(b,C1[r+2],C1[r+3]);} \
      float rm=__builtin_fmaxf(a,b); { auto rr=__builtin_amdgcn_permlane32_swap(__float_as_uint(rm),__float_as_uint(rm),false,false); rm=__builtin_fmaxf(__uint_as_float(rr[0]),__uint_as_float(rr[1])); } \
      resc=false; \
      if(__builtin_expect(__any(rm>(float)THRL),0)){ const float dl=__builtin_fmaxf(rm,0.f); mhat+=dl; \
        _Pragma("unroll") for(int r=0;r<16;++r){C0[r]-=dl;C1[r]-=dl;} \
        const float f=__builtin_amdgcn_exp2f(-dl); l_reg*=f; if(hi==0)wsf[r32]=f; resc=true; } } \
    SBAR(); \
    GAPB(o[0]=__builtin_amdgcn_mfma_f32_32x32x16_bf16(PAF(0),VFR(0),o[0],0,0,0), C0,0); VRD2(0); \
    GAPB(o[1]=__builtin_amdgcn_mfma_f32_32x32x16_bf16(PAF(0),VFR(4),o[1],0,0,0), C0,4); VRD2(4); \
    KRD(GL,0); GAPB(o[0]=__builtin_amdgcn_mfma_f32_32x32x16_bf16(PAF(1),VFR(1),o[0],0,0,0), C0,8); VRD2(1); \
    KRD(GL,1); GAPB(o[1]=__builtin_amdgcn_mfma_f32_32x32x16_bf16(PAF(1),VFR(5),o[1],0,0,0), C0,12); VRD2(5); \
    KRD(GL,2); GAPB(o[0]=__builtin_amdgcn_mfma_f32_32x32x16_bf16(PAF(2),VFR(2),o[0],0,0,0), C1,0); VRD2(2); \
    KRD(GL,3); GAPB(o[1]=__builtin_amdgcn_mfma_f32_32x32x16_bf16(PAF(2),VFR(6),o[1],0,0,0), C1,4); VRD2(6); \
    GAPB(o[0]=__builtin_amdgcn_mfma_f32_32x32x16_bf16(PAF(3),VFR(3),o[0],0,0,0), C1,8); VRD2(3); \
    GAPB(o[1]=__builtin_amdgcn_mfma_f32_32x32x16_bf16(PAF(3),VFR(7),o[1],0,0,0), C1,12); VRD2(7); \
    o[2]=__builtin_amdgcn_mfma_f32_32x32x16_bf16(PAF(0),VFR(0),o[2],0,0,0); o[3]=__builtin_amdgcn_mfma_f32_32x32x16_bf16(PAF(0),VFR(4),o[3],0,0,0); \
    o[2]=__builtin_amdgcn_mfma_f32_32x32x16_bf16(PAF(1),VFR(1),o[2],0,0,0); o[3]=__builtin_amdgcn_mfma_f32_32x32x16_bf16(PAF(1),VFR(5),o[3],0,0,0); \
    o[2]=__builtin_amdgcn_mfma_f32_32x32x16_bf16(PAF(2),VFR(2),o[2],0,0,0); o[3]=__builtin_amdgcn_mfma_f32_32x32x16_bf16(PAF(2),VFR(6),o[3],0,0,0); \
    o[2]=__builtin_amdgcn_mfma_f32_32x32x16_bf16(PAF(3),VFR(3),o[2],0,0,0); o[3]=__builtin_amdgcn_mfma_f32_32x32x16_bf16(PAF(3),VFR(7),o[3],0,0,0); SBAR(); \
    }while(0)
  int t=1;
  #undef CMASK
  #define CMASK(P0,P1,t) do{}while(0)
  for(;t+5<NT;t+=2){
    STEP(pB0,pB1,pA0,pA1,t,true,true,true);     WAIT_BAR(3); RESC(); ROT();
    STEP(pA0,pA1,pB0,pB1,t+1,true,true,true);   WAIT_BAR(3); RESC(); ROT();
  }
  #undef CMASK
  #define CMASK(P0,P1,t) do{int jb_=(t)-(NT-4); if(jb_>=0)cmask(P0,P1,jb_,qrel,hi);}while(0)
  #define ENDW(tt) do{ if((tt)+3<NT){WAIT_BAR(3);} else if((tt)+2<NT){WAIT_BAR(2);} else {WAIT_BAR(0);} }while(0)
  for(;t+1<NT;t+=2){
    STEP(pB0,pB1,pA0,pA1,t,(t+3<NT),(t+1<NT),(t+1<NT));       ENDW(t);   RESC(); ROT();
    STEP(pA0,pA1,pB0,pB1,t+1,(t+4<NT),(t+2<NT),(t+2<NT));     ENDW(t+1); RESC(); ROT();
  }
  STEP(pB0,pB1,pA0,pA1,NT-1,false,false,false); RESC();
  { float sacc=pB0[0]+pB0[1]; _Pragma("unroll") for(int r=2;r<16;++r)sacc+=pB0[r]; _Pragma("unroll") for(int r=0;r<16;++r)sacc+=pB1[r]; l_reg+=sacc;
    pw0=(u32x4){PKW(pB0,0),PKW(pB0,2),PKW(pB0,4),PKW(pB0,6)};pw1=(u32x4){PKW(pB0,8),PKW(pB0,10),PKW(pB0,12),PKW(pB0,14)};pw2=(u32x4){PKW(pB1,0),PKW(pB1,2),PKW(pB1,4),PKW(pB1,6)};pw3=(u32x4){PKW(pB1,8),PKW(pB1,10),PKW(pB1,12),PKW(pB1,14)};
    SBAR(); pv(o,vb0+2*sl_cur,PAF(0),PAF(1),PAF(2),PAF(3)); pv(o+2,vb0+2*sl_cur+8192,PAF(0),PAF(1),PAF(2),PAF(3)); }
  #undef PKW
  #undef PAF
  #undef VFR
  #undef PIN
  #undef MX3
  #undef GAPA
  #undef GAPB
  #undef EX
  #undef VRD
  #undef KRD
  #undef VRD2
  #undef STEP
  #undef ENDW
  {auto rr=__builtin_amdgcn_permlane32_swap(__float_as_uint(l_reg),__float_as_uint(l_reg),false,false);l_reg=__uint_as_float(rr[0])+__uint_as_float(rr[1]);}
  if(hi==0)wsf[32+r32]=l_reg;asm volatile("s_waitcnt lgkmcnt(0)":::"memory");
  float rli[16];
  #pragma unroll
  for(int r=0;r<16;++r)rli[r]=__builtin_amdgcn_rcpf(wsf[32+crow(r,hi)]);
  bf16*Ow=Oc+(rowbase+q0+wid*QBLK)*DM;
  { bf16*stg=(bf16*)(shm+LDS_OST)+wid*4096;
    #pragma unroll
    for(int r=0;r<16;++r){const int orow=crow(r,hi);
      #pragma unroll
      for(int d0=0;d0<4;++d0){ float v=o[d0][r]*rli[r];
        if(MODE==2) v=__bfloat162float(stg[orow*128+d0*32+r32])-lam*v;
        stg[orow*128+d0*32+r32]=__float2bfloat16(v);} }
    asm volatile("s_waitcnt lgkmcnt(0)":::"memory");
    if(MODE==0){
      #pragma unroll
      for(int i=0;i<8;++i){const int row=i*4+(lane>>4),ch=lane&15; const u32x4 v=*(const u32x4*)(stg+row*128+ch*8); ATTN_STORE16(Ow+(long)row*DM+ch*8,v);} }
    if(MODE==2){
      const int row=lane>>1,c0=(lane&1)*64; float ss=0.f; u32x4 w[8];
      #pragma unroll
      for(int i=0;i<8;++i){ w[i]=*(const u32x4*)(stg+row*128+c0+i*8);
        #pragma unroll
        for(int j=0;j<4;++j){ const float a=__uint_as_float(w[i][j]<<16),b=__uint_as_float(w[i][j]&0xffff0000u); ss+=a*a+b*b; } }
      ss+=__shfl_xor(ss,1);
      const float rs=osc/sqrtf(ss*(1.0f/128.0f)+rms_eps);
      #pragma unroll
      for(int i=0;i<8;++i){ u32x4 ov;
        #pragma unroll
        for(int j=0;j<4;++j){ const float a=__uint_as_float(w[i][j]<<16)*rs*gsub[c0+i*8+2*j],b=__uint_as_float(w[i][j]&0xffff0000u)*rs*gsub[c0+i*8+2*j+1]; ov[j]=cvtpk_s(a,b); }
        ATTN_STORE16(Ow+(long)row*DM+c0+i*8,ov); } }
  }
  asm volatile("s_waitcnt lgkmcnt(0)\n\ts_barrier":::"memory");
  #undef DMA_K
  #undef DMA_V
  #undef CMASK
  #undef START
  #undef RESC
  #undef ROT
}
constexpr int ATTN_LDS_BYTES=LDS_BYTES;
#undef SBAR
#undef WAIT_BAR
}
namespace mk {
#define GAS __attribute__((address_space(1)))
#define LAS __attribute__((address_space(3)))
typedef unsigned short bf16;
typedef unsigned v4u __attribute__((ext_vector_type(4)));
typedef unsigned v2u __attribute__((ext_vector_type(2)));
typedef float f32x4 __attribute__((ext_vector_type(4)));
using pg8::Unit;
using pg8::cvt_pk_bf16;

constexpr int D = 1024, BATCH = 8, SEQ = 2048, T = BATCH * SEQ, NH = 8, NG = 4, EPG = 8, NE = 32, DE = 512, NRW = NG + NE;
constexpr float ALPHA = 1.4142135623730951f, LN_EPS = 1e-5f, RMS_EPS = 1e-5f;
constexpr float LAM_INIT = 0.35550906f;
constexpr float QSCALE = 0.125f * 1.4426950408889634f;
constexpr int CNT_STRIDE = 64;
constexpr int CAP = T;
constexpr int NWAVES = 8, NTHREADS = 512;
#ifndef P0B_FILL
#define P0B_FILL 1
#endif
#ifndef MOE_MERGE
#define MOE_MERGE 0
#endif
#ifndef P0B_SPLIT
#define P0B_SPLIT 8192
#endif

constexpr size_t MiB = 1u << 20;
constexpr size_t WS_CTL = 0, WS_W1T = 1 * MiB, WS_W2T = 7 * MiB, WS_WKVQ = 9 * MiB, WS_WOT = 15 * MiB, WS_RWT = 17 * MiB;
constexpr size_t WS_RWH = 17 * MiB + 512 * 1024;
constexpr size_t WS_WUT = 24 * MiB, WS_WDT = 152 * MiB, WS_XB = 216 * MiB, WS_GB = 248 * MiB, WS_U = 280 * MiB, WS_A2 = 312 * MiB, WS_Z = 344 * MiB, WS_X1B = 408 * MiB;
constexpr size_t WS_ACT = 440 * MiB, WS_YP = 480 * MiB, WS_X2B = 544 * MiB, WS_K = 576 * MiB, WS_V = 608 * MiB, WS_Q = 640 * MiB, WS_O0 = 672 * MiB, WS_O1 = 704 * MiB;
constexpr size_t WS_A3 = 736 * MiB, WS_X3B = 768 * MiB;
#ifdef MKPROBE
constexpr size_t WS_PERM = 18 * MiB;
constexpr size_t WS_Z1 = 800 * MiB, WS_ACT1 = 864 * MiB, WS_YP1 = 904 * MiB, WS_PERM1 = 968 * MiB, WS_END = 972 * MiB;
#else
constexpr size_t WS_PERM = 18 * MiB;
constexpr size_t WS_Z1 = WS_Z, WS_ACT1 = WS_ACT, WS_YP1 = WS_YP, WS_PERM1 = WS_PERM, WS_END = 800 * MiB;
#endif
#define LZ(l) ((l) ? WS_Z1 : WS_Z)
#define LACT(l) ((l) ? WS_ACT1 : WS_ACT)
#define LYP(l) ((l) ? WS_YP1 : WS_YP)
#define LPERM(l) ((l) ? WS_PERM1 : WS_PERM)
constexpr int RWH_PITCH = 2064  , RWH_BYTES = 2 * 36 * RWH_PITCH  ;
constexpr int RWH_PAD = 149504;
constexpr int RING_BYTES = 131072, RW_BYTES = RWH_PAD  , MISC_OFF = RW_BYTES, LDS_BYTES = 163840;

struct Args {
    const float *x, *a_w_in, *a_conv_w, *a_w_out, *kv_w, *b_w_q, *b_lambda, *b_subln_g, *b_w_o, *ln1_g, *ln1_b, *ln2_g, *ln2_b, *rg_w, *rg_b, *re_w, *re_b, *e_w_in, *e_w_down;
    float* out; unsigned char* ws;
};

typedef const __attribute__((address_space(4))) Args* ArgsP;
__device__ __forceinline__ ArgsP kargs() { ArgsP p = (ArgsP)__builtin_amdgcn_kernarg_segment_ptr(); asm volatile("" : "+s"(p)); return p; }
struct Ctx { int tid, lane, wave, G, bx, gw, NGW; unsigned char* ws; };
__device__ __forceinline__ Ctx mkctx(ArgsP ap) { Ctx c; int t = threadIdx.x; asm volatile("" : "+v"(t)); c.tid = t; c.lane = t & 63; c.wave = __builtin_amdgcn_readfirstlane(t >> 6);
    c.G = gridDim.x; c.bx = blockIdx.x; c.gw = c.bx * 8 + c.wave; c.NGW = c.G * 8; c.ws = ap->ws; return c; }
__device__ __forceinline__ unsigned f2bf(float f) { unsigned u = __builtin_bit_cast(unsigned, f); return (u + 0x7fffu + ((u >> 16) & 1u)) >> 16; }
__device__ __forceinline__ unsigned pk2(float lo, float hi) { return f2bf(lo) | (f2bf(hi) << 16); }
__device__ __forceinline__ float bflo(unsigned w) { return __builtin_bit_cast(float, w << 16); }
__device__ __forceinline__ float bfhi(unsigned w) { return __builtin_bit_cast(float, w & 0xffff0000u); }
__device__ __forceinline__ f32x4 ldz4(const bf16* p) { const v2u w = *(const v2u*)p; return (f32x4){bflo(w.x), bfhi(w.x), bflo(w.y), bfhi(w.y)}; }
__device__ __forceinline__ float wave_sum(float v) {
#pragma unroll
    for (int o = 1; o < 64; o <<= 1) v += __shfl_xor(v, o);
    return v;
}

__device__ __forceinline__ float dpp_add(float v, const int ctrl_sel) {
    const int iv = __builtin_bit_cast(int, v); int t;
    if (ctrl_sel == 0) t = __builtin_amdgcn_update_dpp(0, iv, 0xB1, 0xF, 0xF, true);
    else if (ctrl_sel == 1) t = __builtin_amdgcn_update_dpp(0, iv, 0x4E, 0xF, 0xF, true);
    else if (ctrl_sel == 2) t = __builtin_amdgcn_update_dpp(0, iv, 0x141, 0xF, 0xF, true);
    else if (ctrl_sel == 3) t = __builtin_amdgcn_update_dpp(0, iv, 0x140, 0xF, 0xF, true);
    else if (ctrl_sel == 4) t = __builtin_amdgcn_update_dpp(0, iv, 0x142, 0xA, 0xF, false);
    else t = __builtin_amdgcn_update_dpp(0, iv, 0x143, 0xC, 0xF, false);
    return v + __builtin_bit_cast(float, t);
}
template <int N> __device__ __forceinline__ void dpp_sum(float (&v)[N]) {
#pragma unroll
    for (int st = 0; st < 6; ++st) {
#pragma unroll
        for (int i = 0; i < N; ++i) v[i] = dpp_add(v[i], st);
    }
#pragma unroll
    for (int i = 0; i < N; ++i) v[i] = __builtin_bit_cast(float, __builtin_amdgcn_readlane(__builtin_bit_cast(int, v[i]), 63));
}
__device__ __forceinline__ float dpp_sum1(float v) { float a[1] = {v}; dpp_sum(a); return a[0]; }

__device__ __forceinline__ void p0_transpose_item(const float* W, int K, int N, bf16* WT, int row_off, LAS float* scr, int item, int lane) {
    const int nblk = N / 64, kb = item / nblk, nb = item % nblk, k0 = 64 * kb, n0 = 64 * nb;
    const float* src = W + (size_t)(k0 + (lane >> 4)) * N + n0 + (lane & 15) * 4;
    f32x4 v[16];
#pragma unroll
    for (int i = 0; i < 16; ++i) v[i] = __builtin_nontemporal_load((const f32x4*)(src + (size_t)(4 * i) * N));
#pragma unroll
    for (int i = 0; i < 16; ++i) { LAS float* d = scr + (4 * i + (lane >> 4)) * 65 + (lane & 15) * 4; d[0] = v[i].x; d[1] = v[i].y; d[2] = v[i].z; d[3] = v[i].w; }
    asm volatile("s_waitcnt lgkmcnt(0)" ::: "memory");
    const int c = lane & 7;
#pragma unroll
    for (int j = 0; j < 8; ++j) { const int n = (lane >> 3) + 8 * j; const LAS float* s = scr + (8 * c) * 65 + n;
        v4u o; o.x = pk2(s[0 * 65], s[1 * 65]); o.y = pk2(s[2 * 65], s[3 * 65]); o.z = pk2(s[4 * 65], s[5 * 65]); o.w = pk2(s[6 * 65], s[7 * 65]);
        *(GAS v4u*)(WT + (size_t)(row_off + n0 + n) * K + k0 + 8 * c) = o; }
    asm volatile("s_waitcnt lgkmcnt(0)" ::: "memory");
}

constexpr int I_IN = 16 * 48, I_SQ = 16 * 16, I_KV = 16 * 32, I_DN = 8 * 16;
constexpr int NEM = P0B_FILL ? NE : 2 * NE;
constexpr int PS1 = I_IN, PS2 = PS1 + I_SQ, PS3 = PS2 + I_KV, PS4 = PS3 + I_SQ, PS5 = PS4 + I_SQ, PS6 = PS5 + NEM * I_SQ, P0_NITEMS = PS6 + NEM * I_DN;
__device__ __forceinline__ void p0_items(LAS unsigned char* lds, int lo, int hi, int w, int nw) {
    const ArgsP a = kargs(); const Ctx cx = mkctx(a); const int lane = cx.lane; unsigned char* ws = cx.ws;
    LAS float* scr = (LAS float*)(lds + cx.wave * 16640);
    for (int it = lo + w; it < hi; it += nw) {
        if (it < PS1) p0_transpose_item(a->a_w_in, D, 3 * D, (bf16*)(ws + WS_W1T), 0, scr, it, lane);
        else if (it < PS2) p0_transpose_item(a->a_w_out, D, D, (bf16*)(ws + WS_W2T), 0, scr, it - PS1, lane);
        else if (it < PS3) p0_transpose_item(a->kv_w, D, 2 * D, (bf16*)(ws + WS_WKVQ), 0, scr, it - PS2, lane);
        else if (it < PS4) p0_transpose_item(a->b_w_q, D, D, (bf16*)(ws + WS_WKVQ), 2 * D, scr, it - PS3, lane);
        else if (it < PS5) p0_transpose_item(a->b_w_o, D, D, (bf16*)(ws + WS_WOT), 0, scr, it - PS4, lane);
        else if (it < PS6) { const int r = it - PS5, mtx = r / I_SQ; p0_transpose_item(a->e_w_in + (size_t)mtx * D * D, D, D, (bf16*)(ws + WS_WUT) + (size_t)mtx * D * D, 0, scr, r % I_SQ, lane); }
        else { const int r = it - PS6, mtx = r / I_DN; p0_transpose_item(a->e_w_down + (size_t)mtx * DE * D, DE, D, (bf16*)(ws + WS_WDT) + (size_t)mtx * D * DE, 0, scr, r % I_DN, lane); }
    }
}
#ifndef ROLE_SPLIT
#define ROLE_SPLIT 1
#endif
#ifndef P0A_EXTRA
#define P0A_EXTRA 5632
#endif
__device__ __forceinline__ void p0_prologue(LAS unsigned char* lds) {
    const ArgsP a = kargs(); const Ctx cx = mkctx(a); const int gw = cx.gw, NGW = cx.NGW, lane = cx.lane;
    unsigned char* ws = cx.ws;
    p0_items(lds, 0, ROLE_SPLIT ? PS1 + P0A_EXTRA : P0_NITEMS, gw, NGW);
    for (int m = gw; m < T; m += NGW) {
        const GAS f32x4* xr = (const GAS f32x4*)(a->x + (size_t)m * D) + lane;
        GAS v2u* o = (GAS v2u*)((bf16*)(ws + WS_XB) + (size_t)m * D) + lane;
#pragma unroll
        for (int j = 0; j < 4; ++j) { const f32x4 v = xr[64 * j]; v2u w; w.x = pk2(v.x, v.y); w.y = pk2(v.z, v.w); o[64 * j] = w; }
    }
    { float* rwt = (float*)(ws + WS_RWT);
      for (int idx = gw * 64 + lane; idx < 2 * NRW * D; idx += NGW * 64) { const int l = idx / (NRW * D), n = (idx / D) % NRW, k = idx % D;
          const float w = n < NG ? a->rg_w[((size_t)l * D + k) * NG + n] : a->re_w[((size_t)l * D + k) * NE + (n - NG)];
          rwt[idx] = w;
          const unsigned hi = f2bf(w), lo = f2bf(w - __builtin_bit_cast(float, hi << 16));
          bf16* img = (bf16*)(ws + WS_RWH) + (size_t)l * (RWH_PAD / 2);
          img[(size_t)n * (RWH_PITCH / 2) + k] = (bf16)hi; img[(size_t)(NRW + n) * (RWH_PITCH / 2) + k] = (bf16)lo; } }
}
__device__ __forceinline__ void p0b_fill(LAS unsigned char* lds, int lo, int hi, int r, int nidle) {
    const ArgsP a = kargs(); const Ctx cx = mkctx(a); unsigned char* ws = cx.ws;
    LAS float* scr = (LAS float*)(lds + cx.wave * 16640);
    for (int it = lo + r * NWAVES + cx.wave; it < hi; it += nidle * NWAVES) {
        if (it < NE * 256) { const int mtx = NE + it / 256; p0_transpose_item(a->e_w_in + (size_t)mtx * D * D, D, D, (bf16*)(ws + WS_WUT) + (size_t)mtx * D * D, 0, scr, it % 256, cx.lane); }
        else { const int r2 = it - NE * 256, mtx = NE + r2 / 128; p0_transpose_item(a->e_w_down + (size_t)mtx * DE * D, DE, D, (bf16*)(ws + WS_WDT) + (size_t)mtx * D * DE, 0, scr, r2 % 128, cx.lane); }
    }
}
constexpr int P0B_ITEMS = NE * 256 + NE * 128;
__device__ __forceinline__ void p0b_idle_fill(LAS unsigned char* lds, int lo, int hi) {
    const ArgsP a = kargs(); const Ctx cx = mkctx(a); const LAS int* misc = (const LAS int*)(lds + MISC_OFF);
    const int U = misc[2 * NE], rem = U % cx.G;
    if (rem == 0) p0b_fill(lds, lo, hi, cx.bx, cx.G);
    else if (cx.bx >= rem) p0b_fill(lds, lo, hi, cx.bx - rem, cx.G - rem);
}
struct SchedDense {
    int G, c, nN, mode, K; const char* W;
    __device__ __forceinline__ bool next(int i, Unit& u) const {
        int pm, pn; if (!pg8::static_tile(i, G, c, T / 256, nN, pm, pn)) return false;
        u.arow = pm * 256; u.p0 = pm; u.p1 = pn; u.p2 = 0; u.p3 = 0;
        const size_t rb = (size_t)K * 2;
        if (mode == 0 && pn >= 4) { const int jj = pn - 4; u.b0 = W + (size_t)(D + 128 * jj) * rb; u.b1 = W + (size_t)(2 * D + 128 * jj) * rb; }
        else { u.b0 = W + (size_t)(256 * pn) * rb; u.b1 = u.b0 + 128 * rb; }
        return true;
    }
    __device__ __forceinline__ void a_offs(const Unit& u, const int (&R)[2], const int (&C)[2], unsigned& v00, unsigned& v01, unsigned& v10, unsigned& v11) const {
        v00 = (unsigned)((u.arow + R[0]) * K + C[0]) * 2u; v01 = (unsigned)((u.arow + R[1]) * K + C[1]) * 2u;
        v10 = (unsigned)((u.arow + 128 + R[0]) * K + C[0]) * 2u; v11 = (unsigned)((u.arow + 128 + R[1]) * K + C[1]) * 2u;
    }
    __device__ __forceinline__ bool half_only(const Unit&) const { return false; }
    __device__ __forceinline__ unsigned peek(const Unit&) const { return 0u; }
    __device__ __forceinline__ void a_ready(const Unit&, unsigned) const {}
    __device__ __forceinline__ void done(const Unit&) const {}
};
struct MoeTab { const LAS int* ub; const LAS int* ps; const LAS int* cn; };
struct SchedMoe {
    int G, c, K; bool up; const char* W; const v2u* perm; MoeTab tb;
    unsigned* ready; int hook; int off, nb;
    __device__ __forceinline__ bool half_only(const Unit& u) const { return u.p2 <= 128; }
    __device__ __forceinline__ unsigned peek(const Unit& u) const {
        return hook == 2 ? __hip_atomic_load(ready + 64 * u.p3, __ATOMIC_RELAXED, __HIP_MEMORY_SCOPE_AGENT) : 0u;
    }
    __device__ __forceinline__ void a_ready(const Unit& u, unsigned pk) const {
        if (hook != 2) return;
        if ((unsigned)__builtin_amdgcn_readfirstlane(pk) >= 32u) return;
        const unsigned long long t0 = __builtin_amdgcn_s_memrealtime();
        while ((unsigned)__builtin_amdgcn_readfirstlane(__hip_atomic_load(ready + 64 * u.p3, __ATOMIC_RELAXED, __HIP_MEMORY_SCOPE_AGENT)) < 32u) {
            if (__builtin_amdgcn_s_memrealtime() - t0 > 2000000ull) break;
            __builtin_amdgcn_s_sleep(2); }
        __builtin_amdgcn_fence(__ATOMIC_ACQUIRE, "agent");
        asm volatile("s_waitcnt vmcnt(0)" ::: "memory");
    }
    __device__ __forceinline__ void done(const Unit& u) const {
        if (hook != 1) return;
        asm volatile("s_waitcnt vmcnt(0)" ::: "memory");
        if ((threadIdx.x & 63) == 0) __hip_atomic_fetch_add(ready + 64 * u.p3, 1u, __ATOMIC_RELAXED, __HIP_MEMORY_SCOPE_AGENT);
    }
    __device__ __forceinline__ bool next(int i, Unit& u) const {
        int idx = i * G + c;
        if (nb > 0) {
            const int v = c - (G - nb);
            if (v >= 0) idx = i == 0 ? v : i == 1 ? v + nb : 2 * nb + v + (i - 2) * G;
            else idx = 3 * nb + c + i * G;
        }
        if (idx >= tb.ub[2 * NE]) return false;
        const int ln = (int)__builtin_amdgcn_mbcnt_hi(~0u, __builtin_amdgcn_mbcnt_lo(~0u, 0u));
        const int k = (int)__builtin_popcountll(__ballot(idx >= tb.ub[ln])) - 1;
        const int e = k & (NE - 1), local = idx - tb.ub[k];
        int ct, rti;
        if (k < NE) { const int rtn = (tb.ub[k + 1] - tb.ub[k]) >> 2; ct = local / rtn; rti = local - ct * rtn; }
        else { ct = local; rti = (tb.cn[e] - 1) >> 8; }
        const size_t rb = (size_t)K * 2; const char* We = W + (size_t)e * D * rb;
        if (up) { u.b0 = We + (size_t)(128 * ct) * rb; u.b1 = We + (size_t)(DE + 128 * ct) * rb; u.arow = e * CAP + rti * 256; u.p0 = tb.ps[e] + rti * 256; }
        else { u.b0 = We + (size_t)(256 * ct) * rb; u.b1 = u.b0 + 128 * rb; u.arow = tb.ps[e] + rti * 256; u.p0 = e * CAP + rti * 256; }
        u.p1 = ct; u.p2 = tb.cn[e] - rti * 256; u.p3 = (tb.ps[e] >> 8) + rti;
        return true;
    }
    __device__ __forceinline__ void a_offs(const Unit& u, const int (&R)[2], const int (&C)[2], unsigned& v00, unsigned& v01, unsigned& v10, unsigned& v11) const {
        if (up) {
            const int r00 = R[0] < u.p2 ? R[0] : 0, r01 = R[1] < u.p2 ? R[1] : 0, r10 = 128 + R[0] < u.p2 ? 128 + R[0] : 0, r11 = 128 + R[1] < u.p2 ? 128 + R[1] : 0;
            const int t00 = (int)(perm[u.arow + r00].y >> 1), t01 = (int)(perm[u.arow + r01].y >> 1), t10 = (int)(perm[u.arow + r10].y >> 1), t11 = (int)(perm[u.arow + r11].y >> 1);
            v00 = (unsigned)(t00 * K + C[0]) * 2u; v01 = (unsigned)(t01 * K + C[1]) * 2u; v10 = (unsigned)(t10 * K + C[0]) * 2u; v11 = (unsigned)(t11 * K + C[1]) * 2u;
        } else {
            v00 = (unsigned)((u.arow + R[0]) * K + C[0]) * 2u; v01 = (unsigned)((u.arow + R[1]) * K + C[1]) * 2u;
            v10 = (unsigned)((u.arow + 128 + R[0]) * K + C[0]) * 2u; v11 = (unsigned)((u.arow + 128 + R[1]) * K + C[1]) * 2u;
        }
    }
};

struct EpiConvIn {
    static constexpr bool PERM = true; bf16* GB; bf16* U;
    __device__ __forceinline__ void operator()(const f32x4 (&acc)[2][2][4][2], const Unit& u, int wr, int wc, int fr, int fq) const {
        const int row0 = u.p0 * 256 + wr * 64 + fr;
        if (u.p1 < 4) {
            const int col0 = u.p1 * 256 + wc * 32 + 8 * fq;
#pragma unroll
            for (int ai = 0; ai < 2; ++ai)
#pragma unroll
                for (int m = 0; m < 4; ++m) { bf16* rowp = GB + (size_t)(row0 + ai * 128 + m * 16) * D + col0;
#pragma unroll
                    for (int bj = 0; bj < 2; ++bj) { const f32x4 v0 = acc[ai][bj][m][0], v1 = acc[ai][bj][m][1];
                        v4u w; w.x = cvt_pk_bf16(v0[0], v0[1]); w.y = cvt_pk_bf16(v0[2], v0[3]); w.z = cvt_pk_bf16(v1[0], v1[1]); w.w = cvt_pk_bf16(v1[2], v1[3]);
                        *(v4u*)(rowp + bj * 128) = w; } }
        } else {
            const int col0 = (u.p1 - 4) * 128 + wc * 32 + 8 * fq;
#pragma unroll
            for (int ai = 0; ai < 2; ++ai)
#pragma unroll
                for (int m = 0; m < 4; ++m) { const f32x4 v0 = acc[ai][0][m][0] * acc[ai][1][m][0], v1 = acc[ai][0][m][1] * acc[ai][1][m][1];
                    v4u w; w.x = cvt_pk_bf16(v0[0], v0[1]); w.y = cvt_pk_bf16(v0[2], v0[3]); w.z = cvt_pk_bf16(v1[0], v1[1]); w.w = cvt_pk_bf16(v1[2], v1[3]);
                    *(v4u*)(U + (size_t)(row0 + ai * 128 + m * 16) * D + col0) = w; }
        }
    }
};
template <bool RES_BF16> struct EpiResZ {
    static constexpr bool PERM = true; const void* res; bf16* Z;
    __device__ __forceinline__ void operator()(const f32x4 (&acc)[2][2][4][2], const Unit& u, int wr, int wc, int fr, int fq) const {
        const int row0 = u.p0 * 256 + wr * 64 + fr, col0 = u.p1 * 256 + wc * 32 + 8 * fq;
#pragma unroll
        for (int ai = 0; ai < 2; ++ai)
#pragma unroll
            for (int m = 0; m < 4; ++m) { const size_t off = (size_t)(row0 + ai * 128 + m * 16) * D + col0;
#pragma unroll
                for (int bj = 0; bj < 2; ++bj) { const size_t o = off + bj * 128; f32x4 r0, r1;
                    if (RES_BF16) { const v4u w = *(const v4u*)((const bf16*)res + o); r0 = (f32x4){bflo(w.x), bfhi(w.x), bflo(w.y), bfhi(w.y)}; r1 = (f32x4){bflo(w.z), bfhi(w.z), bflo(w.w), bfhi(w.w)}; }
                    else { r0 = *(const f32x4*)((const float*)res + o); r1 = *(const f32x4*)((const float*)res + o + 4); }
                    const f32x4 v0 = r0 * ALPHA + acc[ai][bj][m][0], v1 = r1 * ALPHA + acc[ai][bj][m][1];
                    v4u w; w.x = cvt_pk_bf16(v0[0], v0[1]); w.y = cvt_pk_bf16(v0[2], v0[3]); w.z = cvt_pk_bf16(v1[0], v1[1]); w.w = cvt_pk_bf16(v1[2], v1[3]);
                    *(v4u*)(Z + o) = w; } }
    }
};
template <bool WT> struct EpiUp {
    static constexpr bool PERM = true; bf16* ACT;
    __device__ __forceinline__ void operator()(const f32x4 (&acc)[2][2][4][2], const Unit& u, int wr, int wc, int fr, int fq) const {
        const int row0 = u.p0 + wr * 64 + fr, col0 = u.p1 * 128 + wc * 32 + 8 * fq;
#pragma unroll
        for (int ai = 0; ai < 2; ++ai)
#pragma unroll
            for (int m = 0; m < 4; ++m) { f32x4 v[2];
#pragma unroll
                for (int n = 0; n < 2; ++n) { const f32x4 g = acc[ai][0][m][n], uu = acc[ai][1][m][n];
#pragma unroll
                    for (int j = 0; j < 4; ++j) { const float e = __builtin_amdgcn_exp2f(g[j] * -1.4426950408889634f); v[n][j] = g[j] * __builtin_amdgcn_rcpf(1.0f + e) * uu[j]; } }
                v4u w; w.x = cvt_pk_bf16(v[0][0], v[0][1]); w.y = cvt_pk_bf16(v[0][2], v[0][3]); w.z = cvt_pk_bf16(v[1][0], v[1][1]); w.w = cvt_pk_bf16(v[1][2], v[1][3]);
                bf16* dst = ACT + (size_t)(row0 + ai * 128 + m * 16) * DE + col0;
                if (WT) { __hip_atomic_store((unsigned long long*)dst, ((unsigned long long)w.y << 32) | w.x, __ATOMIC_RELAXED, __HIP_MEMORY_SCOPE_AGENT);
                          __hip_atomic_store((unsigned long long*)dst + 1, ((unsigned long long)w.w << 32) | w.z, __ATOMIC_RELAXED, __HIP_MEMORY_SCOPE_AGENT); }
                else *(v4u*)dst = w; }
    }
};
struct EpiDown {
    static constexpr bool PERM = true; bf16* YP; const v2u* perm;
    __device__ __forceinline__ void operator()(const f32x4 (&acc)[2][2][4][2], const Unit& u, int wr, int wc, int fr, int fq) const {
        const int col0 = u.p1 * 256 + wc * 32 + 8 * fq;
        v2u rec[2][4];
#pragma unroll
        for (int ai = 0; ai < 2; ++ai)
#pragma unroll
            for (int m = 0; m < 4; ++m) { const int r = ai * 128 + wr * 64 + m * 16 + fr; rec[ai][m] = perm[u.p0 + (r < u.p2 ? r : 0)]; }
#pragma unroll
        for (int ai = 0; ai < 2; ++ai)
#pragma unroll
            for (int m = 0; m < 4; ++m) { const int r = ai * 128 + wr * 64 + m * 16 + fr;
                if (r < u.p2) { const int pair = (int)rec[ai][m].y; float g = __builtin_bit_cast(float, rec[ai][m].x); asm volatile("" : "+v"(g)); bf16* rowp = YP + (size_t)pair * D + col0;
#pragma unroll
                    for (int bj = 0; bj < 2; ++bj) { const f32x4 v0 = acc[ai][bj][m][0] * g, v1 = acc[ai][bj][m][1] * g;
                        v4u w; w.x = cvt_pk_bf16(v0[0], v0[1]); w.y = cvt_pk_bf16(v0[2], v0[3]); w.z = cvt_pk_bf16(v1[0], v1[1]); w.w = cvt_pk_bf16(v1[2], v1[3]);
                        *(v4u*)(rowp + bj * 128) = w; } } }
    }
};
struct EpiKVQ {
    static constexpr bool PERM = true; bf16* KB;
    __device__ __forceinline__ void operator()(const f32x4 (&acc)[2][2][4][2], const Unit& u, int wr, int wc, int fr, int fq) const {
        const int t = u.p1 >> 2; const float sc = t == 2 ? QSCALE : 1.0f;
        bf16* base = KB + (size_t)t * (32 * MiB / 2);
        const int row0 = u.p0 * 256 + wr * 64 + fr, col0 = (u.p1 & 3) * 256 + wc * 32 + 8 * fq;
#pragma unroll
        for (int ai = 0; ai < 2; ++ai)
#pragma unroll
            for (int m = 0; m < 4; ++m) { bf16* rowp = base + (size_t)(row0 + ai * 128 + m * 16) * D + col0;
#pragma unroll
                for (int bj = 0; bj < 2; ++bj) { const f32x4 v0 = acc[ai][bj][m][0] * sc, v1 = acc[ai][bj][m][1] * sc;
                    v4u w; w.x = cvt_pk_bf16(v0[0], v0[1]); w.y = cvt_pk_bf16(v0[2], v0[3]); w.z = cvt_pk_bf16(v1[0], v1[1]); w.w = cvt_pk_bf16(v1[2], v1[3]);
                    *(v4u*)(rowp + bj * 128) = w; } }
    }
};

__device__ __forceinline__ void ln_rows(f32x4 (&v)[4], const f32x4 (&gg)[4], const f32x4 (&bb)[4]) {
    float s = 0.f;
#pragma unroll
    for (int j = 0; j < 4; ++j) s += (v[j].x + v[j].y) + (v[j].z + v[j].w);
    const float mean = dpp_sum1(s) * (1.f / D); float s2 = 0.f;
#pragma unroll
    for (int j = 0; j < 4; ++j) { v[j] = v[j] - mean; s2 += (v[j].x * v[j].x + v[j].y * v[j].y) + (v[j].z * v[j].z + v[j].w * v[j].w); }
    const float rstd = 1.f / sqrtf(dpp_sum1(s2) * (1.f / D) + LN_EPS);
#pragma unroll
    for (int j = 0; j < 4; ++j) v[j] = v[j] * rstd * gg[j] + bb[j];
}
__device__ __forceinline__ float dot_lds(const f32x4 (&v)[4], const LAS f32x4* w, int lane) {
    float a = 0.f;
#pragma unroll
    for (int j = 0; j < 4; ++j) { const f32x4 ww = w[64 * j + lane]; a += (v[j].x * ww.x + v[j].y * ww.y) + (v[j].z * ww.z + v[j].w * ww.w); }
    return a;
}
typedef short bf16x8v __attribute__((ext_vector_type(8)));
__device__ __forceinline__ void ln_router_mfma(LAS unsigned char* lds, int layer, int rep) {
    const ArgsP a = kargs(); const Ctx cx = mkctx(a); const int lane = cx.lane, wave = cx.wave, tid = cx.tid;
    unsigned char* ws = cx.ws;
    const bf16* Z = (const bf16*)(ws + LZ(layer)); bf16* Xb = (bf16*)(ws + (layer == 0 ? WS_X1B : WS_X3B));
    const float* g = a->ln1_g + layer * D; const float* b = a->ln1_b + layer * D;
    const float* rgb = a->rg_b + layer * NG; const float* reb = a->re_b + layer * NE;
    int* cnt = (int*)(ws + WS_CTL) + layer * NE * CNT_STRIDE; v2u* perm = (v2u*)(ws + LPERM(layer));
    const int i = lane & 15, kq = lane >> 4, grp = wave >> 1, half = wave & 1;
    const int row = cx.bx * 64 + grp * 16 + i, col0 = 512 * half + 8 * kq;
    { const unsigned char* wg = ws + WS_RWH + (size_t)layer * RWH_PAD;
      for (int q = wave; q < RWH_PAD / 1024; q += NWAVES)
          __builtin_amdgcn_global_load_lds((const unsigned*)(wg + (size_t)q * 1024 + lane * 16), (LAS unsigned*)(lds + q * 1024), 16, 0, 0); }
    v4u xw[16];
#pragma unroll
    for (int s = 0; s < 16; ++s) xw[s] = *(const v4u*)(Z + (size_t)row * D + col0 + 32 * s);
#define XLO(s) ((f32x4){bflo(xw[s].x), bfhi(xw[s].x), bflo(xw[s].y), bfhi(xw[s].y)})
#define XHI(s) ((f32x4){bflo(xw[s].z), bfhi(xw[s].z), bflo(xw[s].w), bfhi(xw[s].w)})
    LAS float* xs = (LAS float*)(lds + MISC_OFF + 4096);
    LAS float* part = (LAS float*)lds;
    float s1 = 0.f, s2 = 0.f;
#pragma unroll
    for (int s = 0; s < 16; ++s)
#pragma unroll
        for (int h2 = 0; h2 < 2; ++h2) { const f32x4 v = h2 ? XHI(s) : XLO(s); s1 += (v.x + v.y) + (v.z + v.w); s2 += (v.x * v.x + v.y * v.y) + (v.z * v.z + v.w * v.w); }
#pragma unroll
    for (int s = 0; s < 16; ++s) asm volatile("" : "+v"(xw[s]));
    s1 += __shfl_xor(s1, 16); s2 += __shfl_xor(s2, 16); s1 += __shfl_xor(s1, 32); s2 += __shfl_xor(s2, 32);
    if (kq == 0) { xs[(wave * 16 + i) * 2] = s1; xs[(wave * 16 + i) * 2 + 1] = s2; }
    __syncthreads();
    const float t1 = xs[((wave ^ 1) * 16 + i) * 2] + s1, t2 = xs[((wave ^ 1) * 16 + i) * 2 + 1] + s2;
    const float mean = t1 * (1.f / D), rstd = 1.f / sqrtf(fmaxf(t2 * (1.f / D) - mean * mean, 0.f) + LN_EPS);
    typedef float f32x4a __attribute__((ext_vector_type(4)));
    f32x4a acc0 = {0.f, 0.f, 0.f, 0.f}, acc1 = acc0, acc2 = acc0;
    const LAS unsigned char* wb = (const LAS unsigned char*)lds + (size_t)(lane & 15) * RWH_PITCH + (size_t)col0 * 2;
    const int n2 = (32 + (lane & 15)) < NRW ? 32 + (lane & 15) : NRW - 1;
    const LAS unsigned char* wb2 = (const LAS unsigned char*)lds + (size_t)n2 * RWH_PITCH + (size_t)col0 * 2;
    constexpr int LO = NRW * RWH_PITCH;
#pragma unroll
    for (int s = 0; s < 16; ++s) {
        if ((s & 3) == 0) asm volatile("" ::: "memory");
        const float* gp = g + col0 + 32 * s; const float* bp = b + col0 + 32 * s;
        const f32x4 g0 = *(const f32x4*)gp, g1 = *(const f32x4*)(gp + 4), b0 = *(const f32x4*)bp, b1 = *(const f32x4*)(bp + 4);
        const f32x4 v0 = (XLO(s) - mean) * rstd * g0 + b0, v1 = (XHI(s) - mean) * rstd * g1 + b1;
        const float vv[8] = {v0.x, v0.y, v0.z, v0.w, v1.x, v1.y, v1.z, v1.w};
        unsigned hi[8], lo[8];
#pragma unroll
        for (int j = 0; j < 8; ++j) { hi[j] = f2bf(vv[j]); lo[j] = f2bf(vv[j] - __builtin_bit_cast(float, hi[j] << 16)); }
        v4u hw, lw;
#pragma unroll
        for (int j = 0; j < 4; ++j) { hw[j] = hi[2 * j] | (hi[2 * j + 1] << 16); lw[j] = lo[2 * j] | (lo[2 * j + 1] << 16); }
        *(v4u*)(Xb + (size_t)row * D + col0 + 32 * s) = hw;
        const bf16x8v ah = __builtin_bit_cast(bf16x8v, hw), al = __builtin_bit_cast(bf16x8v, lw);
        const bf16x8v w0h = *(const LAS bf16x8v*)(wb + 64 * s), w0l = *(const LAS bf16x8v*)(wb + LO + 64 * s);
        const bf16x8v w1h = *(const LAS bf16x8v*)(wb + 16 * RWH_PITCH + 64 * s), w1l = *(const LAS bf16x8v*)(wb + 16 * RWH_PITCH + LO + 64 * s);
        const bf16x8v w2h = *(const LAS bf16x8v*)(wb2 + 64 * s), w2l = *(const LAS bf16x8v*)(wb2 + LO + 64 * s);
        acc0 = __builtin_amdgcn_mfma_f32_16x16x32_bf16(ah, w0h, acc0, 0, 0, 0); acc0 = __builtin_amdgcn_mfma_f32_16x16x32_bf16(al, w0h, acc0, 0, 0, 0); acc0 = __builtin_amdgcn_mfma_f32_16x16x32_bf16(ah, w0l, acc0, 0, 0, 0);
        acc1 = __builtin_amdgcn_mfma_f32_16x16x32_bf16(ah, w1h, acc1, 0, 0, 0); acc1 = __builtin_amdgcn_mfma_f32_16x16x32_bf16(al, w1h, acc1, 0, 0, 0); acc1 = __builtin_amdgcn_mfma_f32_16x16x32_bf16(ah, w1l, acc1, 0, 0, 0);
        acc2 = __builtin_amdgcn_mfma_f32_16x16x32_bf16(ah, w2h, acc2, 0, 0, 0); acc2 = __builtin_amdgcn_mfma_f32_16x16x32_bf16(al, w2h, acc2, 0, 0, 0); acc2 = __builtin_amdgcn_mfma_f32_16x16x32_bf16(ah, w2l, acc2, 0, 0, 0);
    }
    __syncthreads();
#undef XLO
#undef XHI
#pragma unroll
    for (int r = 0; r < 4; ++r) { LAS float* pr = part + (size_t)(wave * 16 + 4 * kq + r) * 48 + (lane & 15); pr[0] = acc0[r]; pr[16] = acc1[r]; pr[32] = acc2[r]; }
    LAS int* rt_e = (LAS int*)(part + 8 * 16 * 48);
    LAS float* rt_g = (LAS float*)(rt_e + 128);
    LAS int* rt_base = (LAS int*)(rt_g + 128);
    __syncthreads();
    if (tid < 64) {
        const int gq = tid >> 4, ii = tid & 15; const LAS float* p0 = part + (size_t)((2 * gq) * 16 + ii) * 48; const LAS float* p1 = p0 + 16 * 48;
        int gi = 0; float gm = -INFINITY, gl[NG];
#pragma unroll
        for (int n = 0; n < NG; ++n) { gl[n] = p0[n] + p1[n] + rgb[n]; if (gl[n] > gm) { gm = gl[n]; gi = n; } }
        float gs = 0.f;
#pragma unroll
        for (int n = 0; n < NG; ++n) gs += __expf(gl[n] - gm);
        const float gtop = 1.0f / gs;
        float m0 = -INFINITY, m1 = -INFINITY; int i0 = 0, i1 = 0;
        for (int n = 0; n < EPG; ++n) { const int c = NG + gi * EPG + n; const float e = p0[c] + p1[c] + reb[gi * EPG + n];
            if (e > m0) { m1 = m0; i1 = i0; m0 = e; i0 = n; } else if (e > m1) { m1 = e; i1 = n; } }
        const float e1 = __expf(m1 - m0), w0 = 1.0f / (1.0f + e1), w1 = e1 * w0;
        rt_e[2 * tid] = gi * EPG + i0; rt_e[2 * tid + 1] = gi * EPG + i1; rt_g[2 * tid] = gtop * w0; rt_g[2 * tid + 1] = gtop * w1;
    }
    __syncthreads();
    if (rep == 0) {
        LAS int* wc = rt_base + NE;
        int my_e = 0, my_rank = 0, my_cnt = 0;
        if (tid < 128) { my_e = rt_e[tid];
            const unsigned long long lt = (1ull << lane) - 1ull;
#pragma unroll 4
            for (int e = 0; e < NE; ++e) { const unsigned long long m = __ballot(my_e == e); if (my_e == e) my_rank = (int)__builtin_popcountll(m & lt); if (lane == e) my_cnt = (int)__builtin_popcountll(m); }
            if (lane < NE) wc[wave * NE + lane] = my_cnt; }
        __syncthreads();
        if (tid < NE) { const int c = wc[tid] + wc[NE + tid]; rt_base[tid] = c ? atomicAdd(&cnt[tid * CNT_STRIDE], c) : 0; }
        __syncthreads();
        if (tid < 128) { const int pair = 2 * (cx.bx * 64 + (tid >> 1)) + (tid & 1);
            perm[my_e * CAP + rt_base[my_e] + my_rank + (wave ? wc[my_e] : 0)] = (v2u){__builtin_bit_cast(unsigned, rt_g[tid]), (unsigned)pair}; }
    }
}
__device__ __forceinline__ void ln_router_phase(LAS unsigned char* lds, int layer, int rep = 0) {
    const ArgsP a = kargs(); const Ctx cx = mkctx(a); const int gw = cx.gw, NGW = cx.NGW, lane = cx.lane;
    unsigned char* ws = cx.ws;
    const bf16* Z = (const bf16*)(ws + LZ(layer)); bf16* Xb = (bf16*)(ws + (layer == 0 ? WS_X1B : WS_X3B));
    const float* g = a->ln1_g + layer * D; const float* b = a->ln1_b + layer * D;
    const float* rgb = a->rg_b + layer * NG; const float* reb = a->re_b + layer * NE;
    int* cnt = (int*)(ws + WS_CTL) + layer * NE * CNT_STRIDE; v2u* perm = (v2u*)(ws + LPERM(layer));
    LAS f32x4* wl = (LAS f32x4*)lds;
    { const f32x4* wg = (const f32x4*)((const float*)(ws + WS_RWT) + (size_t)layer * NRW * D);
      for (int i = cx.tid; i < NRW * D / 4; i += NTHREADS) wl[i] = wg[i]; }
    f32x4 gg[4], bb[4];
#pragma unroll
    for (int j = 0; j < 4; ++j) { gg[j] = *(const f32x4*)(g + 256 * j + 4 * lane); bb[j] = *(const f32x4*)(b + 256 * j + 4 * lane); }
    constexpr int RPW = 16;
    LAS int* rt_row = (LAS int*)(lds + MISC_OFF + 2048);
    LAS int* rt_e = rt_row + NWAVES * RPW;
    LAS float* rt_g = (LAS float*)(rt_e + 2 * NWAVES * RPW);
    LAS int* rt_base = (LAS int*)(rt_g + 2 * NWAVES * RPW);
    LAS int* wave_rows = rt_base + NE;
    f32x4 nv[2][4];
#pragma unroll
    for (int r = 0; r < 2; ++r) { const int row = gw + r * NGW;
        if (row < T) {
#pragma unroll
            for (int j = 0; j < 4; ++j) nv[r][j] = ldz4(Z + (size_t)row * D + 256 * j + 4 * lane);
        } }
    __syncthreads();
    int it = 0;
#pragma unroll 1
    for (int row0 = gw; row0 < T && it < RPW; row0 += 2 * NGW, it += 2) {
        const bool two = row0 + NGW < T;
        f32x4 v[2][4];
#pragma unroll
        for (int r = 0; r < 2; ++r)
#pragma unroll
            for (int j = 0; j < 4; ++j) v[r][j] = nv[r][j];
#pragma unroll
        for (int r = 0; r < 2; ++r) { const int row = row0 + (2 + r) * NGW;
            if (row < T) {
#pragma unroll
                for (int j = 0; j < 4; ++j) nv[r][j] = ldz4(Z + (size_t)row * D + 256 * j + 4 * lane);
            } }
        if (!two) {
#pragma unroll
            for (int j = 0; j < 4; ++j) v[1][j] = v[0][j];
        }
        float s1[2];
#pragma unroll
        for (int r = 0; r < 2; ++r) { float s = 0.f;
#pragma unroll
            for (int j = 0; j < 4; ++j) s += (v[r][j].x + v[r][j].y) + (v[r][j].z + v[r][j].w);
            s1[r] = s; }
        dpp_sum(s1);
        float s2[2];
#pragma unroll
        for (int r = 0; r < 2; ++r) { const float mean = s1[r] * (1.f / D); float q = 0.f;
#pragma unroll
            for (int j = 0; j < 4; ++j) { v[r][j] = v[r][j] - mean; q += (v[r][j].x * v[r][j].x + v[r][j].y * v[r][j].y) + (v[r][j].z * v[r][j].z + v[r][j].w * v[r][j].w); }
            s2[r] = q; }
        dpp_sum(s2);
#pragma unroll
        for (int r = 0; r < 2; ++r) { const float rstd = 1.f / sqrtf(s2[r] * (1.f / D) + LN_EPS);
#pragma unroll
            for (int j = 0; j < 4; ++j) v[r][j] = v[r][j] * rstd * gg[j] + bb[j]; }
#pragma unroll
        for (int r = 0; r < 2; ++r) { const int row = row0 + r * NGW;
            if (r == 0 || two) {
#pragma unroll
                for (int j = 0; j < 4; ++j) { v2u w; w.x = pk2(v[r][j].x, v[r][j].y); w.y = pk2(v[r][j].z, v[r][j].w); *(v2u*)(Xb + (size_t)row * D + 256 * j + 4 * lane) = w; }
            } }
        float gl[2 * NG];
#pragma unroll
        for (int r = 0; r < 2; ++r)
#pragma unroll
            for (int n = 0; n < NG; ++n) gl[r * NG + n] = dot_lds(v[r], wl + n * (D / 4), lane);
        dpp_sum(gl);
        int gi[2]; float gtop[2];
#pragma unroll
        for (int r = 0; r < 2; ++r) { int g_ = 0; float gm = -INFINITY;
#pragma unroll
            for (int n = 0; n < NG; ++n) { gl[r * NG + n] += rgb[n]; if (gl[r * NG + n] > gm) { gm = gl[r * NG + n]; g_ = n; } }
            float gs = 0.f;
#pragma unroll
            for (int n = 0; n < NG; ++n) gs += __expf(gl[r * NG + n] - gm);
            gi[r] = g_; gtop[r] = 1.0f / gs; }
        float el[2 * EPG];
#pragma unroll
        for (int r = 0; r < 2; ++r)
#pragma unroll
            for (int n = 0; n < EPG; ++n) el[r * EPG + n] = dot_lds(v[r], wl + (NG + gi[r] * EPG + n) * (D / 4), lane);
        dpp_sum(el);
#pragma unroll
        for (int r = 0; r < 2; ++r) {
            float m0 = -INFINITY, m1 = -INFINITY; int i0 = 0, i1 = 0;
#pragma unroll
            for (int n = 0; n < EPG; ++n) { const float e = el[r * EPG + n] + reb[gi[r] * EPG + n];
                if (e > m0) { m1 = m0; i1 = i0; m0 = e; i0 = n; } else if (e > m1) { m1 = e; i1 = n; } }
            const float e1 = __expf(m1 - m0), w0 = 1.0f / (1.0f + e1), w1 = e1 * w0;
            if (lane == 0 && (r == 0 || two)) {
                const int li = cx.wave * RPW + it + r;
                rt_row[li] = row0 + r * NGW; rt_e[2 * li] = gi[r] * EPG + i0; rt_e[2 * li + 1] = gi[r] * EPG + i1; rt_g[2 * li] = gtop[r] * w0; rt_g[2 * li + 1] = gtop[r] * w1;
            }
        }
        if (!two) { it += 1; break; }
    }
    if (lane == 0) wave_rows[cx.wave] = it;
    __syncthreads();
    if (rep == 0) {
        if (cx.tid < NE) { int c = 0;
            for (int w = 0; w < NWAVES; ++w) { const int n = wave_rows[w]; for (int i = 0; i < 2 * n; ++i) c += (rt_e[2 * (w * RPW) + i] == cx.tid) ? 1 : 0; }
            rt_base[cx.tid] = c ? atomicAdd(&cnt[cx.tid * CNT_STRIDE], c) : 0; }
        __syncthreads();
        if (cx.tid < 2 * NWAVES * RPW) { const int w = cx.tid / (2 * RPW), i = cx.tid % (2 * RPW);
            if (i < 2 * wave_rows[w]) { const int e = rt_e[cx.tid]; int rank = 0;
                for (int w2 = 0; w2 <= w; ++w2) { const int lim = (w2 < w) ? 2 * wave_rows[w2] : i; for (int q = 0; q < lim; ++q) rank += (rt_e[2 * (w2 * RPW) + q] == e) ? 1 : 0; }
                const int pair = 2 * rt_row[cx.tid >> 1] + (cx.tid & 1);
                perm[e * CAP + rt_base[e] + rank] = (v2u){__builtin_bit_cast(unsigned, rt_g[cx.tid]), (unsigned)pair}; } }
    }
}
__device__ __forceinline__ void ln2_phase(int layer) {
    const ArgsP a = kargs(); const Ctx cx = mkctx(a); const int gw = cx.gw, NGW = cx.NGW, lane = cx.lane;
    unsigned char* ws = cx.ws;
    const bf16* Xin = (const bf16*)(ws + (layer == 0 ? WS_X1B : WS_X3B)); const bf16* YP = (const bf16*)(ws + LYP(layer));
    const float* g = a->ln2_g + layer * D; const float* b = a->ln2_b + layer * D;
    f32x4 gg[4], bb[4];
#pragma unroll
    for (int j = 0; j < 4; ++j) { gg[j] = *(const f32x4*)(g + 256 * j + 4 * lane); bb[j] = *(const f32x4*)(b + 256 * j + 4 * lane); }
    v2u nx[4], ny0[4], ny1[4];
    if (gw < T) {
#pragma unroll
        for (int j = 0; j < 4; ++j) { const size_t c = 256 * j + 4 * lane;
            nx[j] = *(const v2u*)(Xin + (size_t)gw * D + c); ny0[j] = *(const v2u*)(YP + (size_t)(2 * gw) * D + c); ny1[j] = *(const v2u*)(YP + (size_t)(2 * gw + 1) * D + c); }
    }
#pragma unroll 1
    for (int row = gw; row < T; row += NGW) {
        f32x4 v[4];
#pragma unroll
        for (int j = 0; j < 4; ++j) { const v2u xw = nx[j], y0 = ny0[j], y1 = ny1[j];
            v[j].x = ALPHA * bflo(xw.x) + (bflo(y0.x) + bflo(y1.x)); v[j].y = ALPHA * bfhi(xw.x) + (bfhi(y0.x) + bfhi(y1.x));
            v[j].z = ALPHA * bflo(xw.y) + (bflo(y0.y) + bflo(y1.y)); v[j].w = ALPHA * bfhi(xw.y) + (bfhi(y0.y) + bfhi(y1.y)); }
        if (row + NGW < T) { const int r2 = row + NGW;
#pragma unroll
            for (int j = 0; j < 4; ++j) { const size_t c = 256 * j + 4 * lane;
                nx[j] = *(const v2u*)(Xin + (size_t)r2 * D + c); ny0[j] = *(const v2u*)(YP + (size_t)(2 * r2) * D + c); ny1[j] = *(const v2u*)(YP + (size_t)(2 * r2 + 1) * D + c); }
        }
        ln_rows(v, gg, bb);
        if (layer == 0) {
#pragma unroll
            for (int j = 0; j < 4; ++j) { v2u w; w.x = pk2(v[j].x, v[j].y); w.y = pk2(v[j].z, v[j].w); *(v2u*)((bf16*)(ws + WS_X2B) + (size_t)row * D + 256 * j + 4 * lane) = w; }
        } else {
#pragma unroll
            for (int j = 0; j < 4; ++j) *(f32x4*)(a->out + (size_t)row * D + 256 * j + 4 * lane) = v[j];
        }
    }
}
__device__ __forceinline__ void conv_phase() {
    const ArgsP a = kargs(); const Ctx cx = mkctx(a); const int gtid = cx.bx * NTHREADS + cx.tid, NGT = cx.G * NTHREADS;
    unsigned char* ws = cx.ws;
    const bf16* GB = (const bf16*)(ws + WS_GB); const bf16* U = (const bf16*)(ws + WS_U); bf16* A2 = (bf16*)(ws + WS_A2);
    for (int it = gtid; it < T * (D / 8); it += NGT) {
        const int t = it >> 7, d0 = (it & 127) * 8, s = t & (SEQ - 1);
        const size_t o = (size_t)t * D + d0;
        const v4u g = *(const v4u*)(GB + o), u0 = *(const v4u*)(U + o);
        v4u u1 = (v4u){0u, 0u, 0u, 0u}, u2 = u1;
        if (s >= 1) u1 = *(const v4u*)(U + o - D);
        if (s >= 2) u2 = *(const v4u*)(U + o - 2 * D);
        const f32x4 wa0 = *(const f32x4*)(a->a_conv_w + d0), wa1 = *(const f32x4*)(a->a_conv_w + d0 + 4), wb0 = *(const f32x4*)(a->a_conv_w + D + d0), wb1 = *(const f32x4*)(a->a_conv_w + D + d0 + 4);
        const f32x4 wc0 = *(const f32x4*)(a->a_conv_w + 2 * D + d0), wc1 = *(const f32x4*)(a->a_conv_w + 2 * D + d0 + 4);
        const float w0[8] = {wa0.x, wa0.y, wa0.z, wa0.w, wa1.x, wa1.y, wa1.z, wa1.w}, w1[8] = {wb0.x, wb0.y, wb0.z, wb0.w, wb1.x, wb1.y, wb1.z, wb1.w}, w2[8] = {wc0.x, wc0.y, wc0.z, wc0.w, wc1.x, wc1.y, wc1.z, wc1.w};
        v4u r;
#pragma unroll
        for (int q = 0; q < 4; ++q) {
            const float c0 = w0[2 * q] * bflo(u2[q]) + w1[2 * q] * bflo(u1[q]) + w2[2 * q] * bflo(u0[q]);
            const float c1 = w0[2 * q + 1] * bfhi(u2[q]) + w1[2 * q + 1] * bfhi(u1[q]) + w2[2 * q + 1] * bfhi(u0[q]);
            r[q] = pk2(bflo(g[q]) * c0, bfhi(g[q]) * c1);
        }
        *(v4u*)(A2 + o) = r;
    }
}
__device__ __forceinline__ void combine_phase() {
    const ArgsP a = kargs(); const Ctx cx = mkctx(a); const int gw = cx.gw, NGW = cx.NGW, lane = cx.lane;
    unsigned char* ws = cx.ws;
    const bf16* O0 = (const bf16*)(ws + WS_O0); const bf16* O1 = (const bf16*)(ws + WS_O1); bf16* A3 = (bf16*)(ws + WS_A3);
    const float l01 = wave_sum(a->b_lambda[lane] * a->b_lambda[64 + lane]), l23 = wave_sum(a->b_lambda[128 + lane] * a->b_lambda[192 + lane]);
    const float lam = __expf(l01) - __expf(l23) + LAM_INIT;
    float gsc[16];
#pragma unroll
    for (int i = 0; i < 16; ++i) gsc[i] = a->b_subln_g[(lane & 7) * 16 + i] * (1.0f - LAM_INIT);
    for (int row = gw; row < T; row += NGW) {
        const size_t o = (size_t)row * D + lane * 16;
        const v4u p0 = *(const v4u*)(O0 + o), p1 = *(const v4u*)(O0 + o + 8), q0 = *(const v4u*)(O1 + o), q1 = *(const v4u*)(O1 + o + 8);
        float d[16]; float ss = 0.f;
#pragma unroll
        for (int i = 0; i < 4; ++i) { d[2 * i] = bflo(p0[i]) - lam * bflo(q0[i]); d[2 * i + 1] = bfhi(p0[i]) - lam * bfhi(q0[i]);
            d[8 + 2 * i] = bflo(p1[i]) - lam * bflo(q1[i]); d[8 + 2 * i + 1] = bfhi(p1[i]) - lam * bfhi(q1[i]); }
#pragma unroll
        for (int i = 0; i < 16; ++i) ss += d[i] * d[i];
        ss += __shfl_xor(ss, 1); ss += __shfl_xor(ss, 2); ss += __shfl_xor(ss, 4);
        const float r = 1.0f / sqrtf(ss * (1.0f / 128.0f) + RMS_EPS);
        v4u w0, w1;
#pragma unroll
        for (int i = 0; i < 4; ++i) { w0[i] = pk2(d[2 * i] * r * gsc[2 * i], d[2 * i + 1] * r * gsc[2 * i + 1]); w1[i] = pk2(d[8 + 2 * i] * r * gsc[8 + 2 * i], d[8 + 2 * i + 1] * r * gsc[8 + 2 * i + 1]); }
        *(v4u*)(A3 + o) = w0; *(v4u*)(A3 + o + 8) = w1;
    }
}

#ifndef MKMASK
#define MKMASK 0xffff
#endif
#ifndef MKREP
#define MKREP 0
#endif
#ifndef MKSYNC
#define MKSYNC 0
#endif
#ifndef MKMASK2
#define MKMASK2 MKMASK
#endif
#define PH(k) _Pragma("unroll 1") for (int rep_ = 0; rep_ < (int)(((pass_ ? MKMASK2 : MKMASK) >> (k)) & 1) + (int)((MKREP >> (k)) & 1); ++rep_)
#define XB_TMO      128
#define XB_XCNT(j)  (256  + 64 * (j))
#define XB_XSUB(j)  (1280 + 64 * (j))
#define XB_XGEN(j)  (2304 + 64 * (j))
#define XB_TOP      3328
#define XB_TOPGEN   3392
#define XCD_BAR_WORDS 3456
#define XB_SPIN_CAP (1u << 18)

__device__ __forceinline__ unsigned xb_ld(unsigned* p)              { return __hip_atomic_load(p, __ATOMIC_RELAXED, __HIP_MEMORY_SCOPE_AGENT); }
__device__ __forceinline__ unsigned xb_add(unsigned* p, unsigned v) { return __hip_atomic_fetch_add(p, v, __ATOMIC_RELAXED, __HIP_MEMORY_SCOPE_AGENT); }
__device__ __forceinline__ unsigned xb_xcc_id() { return (unsigned)__builtin_amdgcn_s_getreg((3 << 11) | 20) & 0xFu; }
#define XB_SPIN(cond, bar) do { unsigned _sp = 0; while (cond) { __builtin_amdgcn_s_sleep(1); \
    if ((++_sp & 255u) == 0u) { if (xb_ld(&(bar)[XB_TMO])) break; if (_sp > XB_SPIN_CAP) { atomicAdd(&(bar)[XB_TMO], 1u); break; } } } } while (0)

struct XcdBarrier {
    unsigned* bar; unsigned x;
    volatile LAS unsigned* st;
};

__device__ __forceinline__ XcdBarrier xcd_barrier_post(unsigned* bar, volatile LAS unsigned* st) {
    XcdBarrier b; b.bar = bar; b.x = xb_xcc_id(); b.st = st;
    if (threadIdx.x == 0) (void)xb_add(&bar[XB_XCNT(b.x)], 1u);
    return b;
}
__device__ __forceinline__ void xcd_barrier_complete(unsigned* bar, unsigned x, unsigned& nloc, unsigned& nx) {
    const unsigned G = gridDim.x * gridDim.y * gridDim.z;
    unsigned sum, cnt, mine, sp = 0u;
    for (;;) {
        sum = 0u; cnt = 0u; mine = 0u;
#pragma unroll
        for (unsigned j = 0; j < 16; ++j) { const unsigned c = xb_ld(&bar[XB_XCNT(j)]); sum += c; cnt += (c > 0u) ? 1u : 0u; mine = (j == x) ? c : mine; }
        if (sum == G) break;
        __builtin_amdgcn_s_sleep(1);
        if ((++sp & 255u) == 0u) { if (xb_ld(&bar[XB_TMO])) break; if (sp > XB_SPIN_CAP) { atomicAdd(&bar[XB_TMO], 1u); break; } }
    }
    nloc = mine > 0u ? mine : 1u; nx = cnt > 0u ? cnt : 1u;
}

__device__ __forceinline__ void xcd_barrier(const XcdBarrier& b) {
    asm volatile("s_waitcnt vmcnt(0)" ::: "memory");
    __syncthreads();
    if (threadIdx.x == 0) {
        unsigned* bar = b.bar;
        __builtin_amdgcn_s_waitcnt(0);
        unsigned nloc = b.st[0], nx = b.st[1];
        if (nloc == 0u) { xcd_barrier_complete(bar, b.x, nloc, nx); b.st[0] = nloc; b.st[1] = nx; }
        const unsigned old = xb_add(&bar[XB_XSUB(b.x)], 1u);
        const unsigned gen = old / nloc;
        if (old + 1u == (gen + 1u) * nloc) {
            __builtin_amdgcn_fence(__ATOMIC_RELEASE, "agent");
            asm volatile("s_waitcnt vmcnt(0)" ::: "memory");
            const unsigned og = xb_add(&bar[XB_TOP], 1u);
            const unsigned tg = og / nx;
            if (og + 1u == (tg + 1u) * nx) xb_add(&bar[XB_TOPGEN], 1u);
            else XB_SPIN(xb_ld(&bar[XB_TOPGEN]) == tg, bar);
            __builtin_amdgcn_fence(__ATOMIC_ACQUIRE, "agent");
            xb_add(&bar[XB_XGEN(b.x)], 1u);
            asm volatile("s_waitcnt vmcnt(0)" ::: "memory");
        } else {
            XB_SPIN(xb_ld(&bar[XB_XGEN(b.x)]) == gen, bar);
            __builtin_amdgcn_fence(__ATOMIC_ACQUIRE, "agent");
            asm volatile("s_waitcnt vmcnt(0)" ::: "memory");
        }
    }
    __syncthreads();
}

constexpr int CW_BAR = 16384;
constexpr int ST_OFF = MISC_OFF + 1024;
__device__ __forceinline__ void seam(LAS unsigned char* lds) { const ArgsP a = kargs(); XcdBarrier b; b.bar = (unsigned*)(a->ws + WS_CTL) + CW_BAR; b.x = xb_xcc_id(); b.st = (volatile LAS unsigned*)(lds + ST_OFF); xcd_barrier(b); }
__device__ __forceinline__ void gemm1_phase(LAS unsigned char* lds) { const ArgsP a = kargs(); const Ctx cx = mkctx(a); unsigned char* ws = cx.ws;
    const int ng = ROLE_SPLIT ? cx.G - cx.G / 4 : cx.G;
    if (cx.bx < ng) { SchedDense S{ng, cx.bx, 12, 0, D, (const char*)(ws + WS_W1T)}; EpiConvIn E{(bf16*)(ws + WS_GB), (bf16*)(ws + WS_U)};
        pg8::gemm_phase(lds, (const char*)(ws + WS_XB), D, S, E); }
    else p0_items(lds, PS1 + P0A_EXTRA, P0_NITEMS, (cx.bx - ng) * NWAVES + cx.wave, (cx.G - ng) * NWAVES); }
__device__ __forceinline__ void gemm2_phase(LAS unsigned char* lds) { const ArgsP a = kargs(); const Ctx cx = mkctx(a); unsigned char* ws = cx.ws;
    SchedDense S{cx.G, cx.bx, 4, 1, D, (const char*)(ws + WS_W2T)}; EpiResZ<true> E{(const void*)(ws + WS_XB), (bf16*)(ws + LZ(0))};
    pg8::gemm_phase(lds, (const char*)(ws + WS_A2), D, S, E); }
__device__ __forceinline__ void kvq_phase(LAS unsigned char* lds) { const ArgsP a = kargs(); const Ctx cx = mkctx(a); unsigned char* ws = cx.ws;
    SchedDense S{cx.G, cx.bx, 12, 1, D, (const char*)(ws + WS_WKVQ)}; EpiKVQ E{(bf16*)(ws + WS_K)};
    pg8::gemm_phase(lds, (const char*)(ws + WS_X2B), D, S, E); }
__device__ __forceinline__ void wo_phase(LAS unsigned char* lds) { const ArgsP a = kargs(); const Ctx cx = mkctx(a); unsigned char* ws = cx.ws;
    SchedDense S{cx.G, cx.bx, 4, 1, D, (const char*)(ws + WS_WOT)}; EpiResZ<true> E{(const void*)(ws + WS_X2B), (bf16*)(ws + LZ(1))};
    pg8::gemm_phase(lds, (const char*)(ws + WS_A3), D, S, E); }
#ifndef ATTN128
#define ATTN128 1
#endif
#if ATTN128
__device__ __forceinline__ void attn_phase(char* lds_generic) { const ArgsP a = kargs(); const Ctx cx = mkctx(a); unsigned char* ws = cx.ws;
    const float l01 = dpp_sum1(a->b_lambda[cx.lane] * a->b_lambda[64 + cx.lane]), l23 = dpp_sum1(a->b_lambda[128 + cx.lane] * a->b_lambda[192 + cx.lane]);
    const float lam = __expf(l01) - __expf(l23) + LAM_INIT;
#pragma unroll 1
    for (int uix = cx.bx; uix < BATCH * NH * 4 * 2; uix += cx.G) {
        const int bh = (uix & 255) >> 2, j = uix & 3, qi = uix >> 8;
        const int b = bh >> 3, h = bh & 7, qb = qi == 0 ? j : 7 - j;
        const attn128::bf16* K0 = (const attn128::bf16*)(ws + WS_K) + h * 128;
        const attn128::bf16* Vc = (const attn128::bf16*)(ws + WS_V) + h * 128;
        attn128::bf16* Ac = (attn128::bf16*)(ws + WS_A3) + h * 128;
        attn128::attn_unit<8, 1>((long)b * SEQ, qb, K0 + (WS_Q - WS_K) / 2, K0, Vc, Ac, lds_generic, 0.f, nullptr, 0.f, 0.f);
        attn128::attn_unit<8, 2>((long)b * SEQ, qb, K0 + 64 + (WS_Q - WS_K) / 2, K0 + 64, Vc, Ac, lds_generic, lam, a->b_subln_g, 1.0f - LAM_INIT, RMS_EPS);
    }
}
#else
__device__ __forceinline__ void attn_phase(char* lds_generic) { const ArgsP a = kargs(); const Ctx cx = mkctx(a); unsigned char* ws = cx.ws;
#pragma unroll 1
    for (int uix = cx.bx; uix < BATCH * NH * 4 * (SEQ / 256); uix += cx.G) {
        const int combo = uix & 255, qi = uix >> 8;
        const int b = combo >> 5, h = (combo >> 2) & 7, c = (combo >> 1) & 1, vh = combo & 1;
        const int qb = (qi & 1) ? (SEQ / 256 - 1 - (qi >> 1)) : (qi >> 1);
        const attn_body::bf16* QK = (const attn_body::bf16*)(ws + WS_K) + h * 128 + c * 64;
        const attn_body::bf16* Vc = (const attn_body::bf16*)(ws + WS_V) + h * 128 + vh * 64;
        attn_body::bf16* Oc = (attn_body::bf16*)(ws + (c ? WS_O1 : WS_O0)) + h * 128 + vh * 64;
        attn_body::attn_unit<8>((long)b * SEQ, qb, QK + (WS_Q - WS_K) / 2, QK, Vc, Oc, lds_generic);
    }
}
#endif
__device__ __forceinline__ int scan_excl32(int v, int lane) {
    int x = v;
#pragma unroll
    for (int o = 1; o < 32; o <<= 1) { const int y = __shfl_up(x, o); if ((lane & 31) >= o) x += y; }
    return x - v;
}
__device__ __forceinline__ void moe_tables(LAS unsigned char* lds, int layer) { const ArgsP a = kargs(); const Ctx cx = mkctx(a); LAS int* misc = (LAS int*)(lds + MISC_OFF);
    const int* cnt = (const int*)(cx.ws + WS_CTL) + layer * NE * CNT_STRIDE;
    if (cx.tid < 64) {
        const int e = cx.lane, cn = e < NE ? __hip_atomic_load(cnt + e * CNT_STRIDE, __ATOMIC_RELAXED, __HIP_MEMORY_SCOPE_AGENT) : 0;
        const int rt = (cn + 255) >> 8, half = (cn > 0 && ((cn - 1) & 255) < 128) ? 1 : 0;
        const int uf = e < NE ? 4 * (rt - half) : 0, uh = e < NE ? 4 * half : 0, pr = e < NE ? 256 * rt : 0;
        const int sf = scan_excl32(uf, e), sh = scan_excl32(uh, e), sp = scan_excl32(pr, e);
        const int totf = __shfl(sf + uf, 31), toth = __shfl(sh + uh, 31), totp = __shfl(sp + pr, 31);
        if (e < NE) { misc[e] = sf; misc[NE + e] = totf + sh; misc[128 + e] = cn; misc[192 + e] = sp; }
        if (e == 0) { misc[2 * NE] = totf + toth; misc[192 + NE] = totp; }
    }
    __syncthreads(); }
constexpr int CW_READY = 4096;
__device__ __forceinline__ void moe_up_phase(LAS unsigned char* lds, int layer, bool merged) { const ArgsP a = kargs(); const Ctx cx = mkctx(a); unsigned char* ws = cx.ws; LAS int* misc = (LAS int*)(lds + MISC_OFF);
    const MoeTab tb{misc, misc + 192, misc + 128};
    SchedMoe S{cx.G, cx.bx, D, true, (const char*)(ws + WS_WUT) + (size_t)layer * NE * D * D * 2, (const v2u*)(ws + LPERM(layer)), tb, (unsigned*)(ws + WS_CTL) + CW_READY, merged ? 1 : 0, 0, 0};
    if (merged) { EpiUp<true> E{(bf16*)(ws + LACT(layer))}; pg8::gemm_phase(lds, (const char*)(ws + (layer == 0 ? WS_X1B : WS_X3B)), D, S, E); }
    else { EpiUp<false> E{(bf16*)(ws + LACT(layer))}; pg8::gemm_phase(lds, (const char*)(ws + (layer == 0 ? WS_X1B : WS_X3B)), D, S, E); } }
__device__ __forceinline__ void moe_down_phase(LAS unsigned char* lds, int layer, bool merged) { const ArgsP a = kargs(); const Ctx cx = mkctx(a); unsigned char* ws = cx.ws; LAS int* misc = (LAS int*)(lds + MISC_OFF);
    const MoeTab tb{misc, misc + 192, misc + 128};
    int nb = 0;
    if (merged) { const int U = misc[2 * NE], rem = U % cx.G; nb = rem ? cx.G - rem : 0; }
    SchedMoe S{cx.G, cx.bx, DE, false, (const char*)(ws + WS_WDT) + (size_t)layer * NE * D * DE * 2, (const v2u*)(ws + LPERM(layer)), tb, (unsigned*)(ws + WS_CTL) + CW_READY, merged ? 2 : 0, 0, nb};
    EpiDown E{(bf16*)(ws + LYP(layer)), (const v2u*)(ws + LPERM(layer))};
    pg8::gemm_phase(lds, (const char*)(ws + LACT(layer)), DE, S, E); }

__global__ void __launch_bounds__(NTHREADS, 2) fwd_megakernel(Args args_unused) {
    extern __shared__ __attribute__((aligned(16))) unsigned char lds_raw[];
#ifdef NOSYNC
    struct { __device__ void sync() const {} } grid;
#else
    cg::grid_group grid = cg::this_grid();
#endif
#define SEAM() seam(lds)
    LAS unsigned char* lds = (LAS unsigned char*)lds_raw;
#ifndef MKPASS
#define MKPASS 1
#endif
    { const ArgsP a = kargs(); int t = threadIdx.x; asm volatile("" : "+v"(t));
      if (t < 2) ((volatile LAS unsigned*)(lds + ST_OFF))[t] = 0u;
      __syncthreads();
      (void)xcd_barrier_post((unsigned*)(a->ws + WS_CTL) + CW_BAR, (volatile LAS unsigned*)(lds + ST_OFF));
      if (a->ws == nullptr) grid.sync(); }
#pragma unroll 1
    for (int pass_ = 0; pass_ < MKPASS; ++pass_) {
    if (pass_) SEAM();
    PH(0) p0_prologue(lds);
    SEAM();
    PH(1) gemm1_phase(lds);
    SEAM();
    PH(2) conv_phase();
    SEAM();
    PH(3) gemm2_phase(lds);
    SEAM();
    PH(8) ln_router_mfma(lds, 0, rep_ + pass_);
    SEAM();
    moe_tables(lds, 0);
    PH(9) { moe_up_phase(lds, 0, false); if (P0B_FILL && pass_ == 0) p0b_idle_fill(lds, 0, P0B_SPLIT); }
    SEAM();
    PH(10) { moe_down_phase(lds, 0, false); if (P0B_FILL && pass_ == 0) p0b_idle_fill(lds, P0B_SPLIT, P0B_ITEMS); }
    SEAM();
    PH(11) ln2_phase(0);
    SEAM();
    PH(4) kvq_phase(lds);
    SEAM();
    PH(5) attn_phase((char*)lds_raw);
    SEAM();
#if !ATTN128
    PH(6) combine_phase();
    SEAM();
#endif
    PH(7) wo_phase(lds);
    SEAM();
    PH(8) ln_router_mfma(lds, 1, rep_ + pass_);
    SEAM();
    moe_tables(lds, 1);
#if MOE_MERGE
    PH(9) moe_up_phase(lds, 1, pass_ == 0);
    if (pass_) SEAM();
    PH(10) moe_down_phase(lds, 1, pass_ == 0);
#else
    PH(9) moe_up_phase(lds, 1, false);
    SEAM();
    PH(10) moe_down_phase(lds, 1, false);
#endif
    SEAM();
    PH(11) ln2_phase(1);
    }
#pragma unroll 1
    for (int i = 0; i < MKSYNC; ++i) SEAM();
}
}

extern "C" void kernel_launch(void* const* d_in, const int* in_sizes, int n_in, void* d_out, int out_size, void* d_ws, size_t ws_size, hipStream_t stream) {
    using namespace mk;
    static int grid = 0;
    if (grid == 0) {
        if (n_in != 19 || out_size != T * D || ws_size < WS_END) { fprintf(stderr, "kernel_launch: unexpected shapes / workspace (n_in %d out %d ws %zu, need %zu)\n", n_in, out_size, ws_size, (size_t)WS_END); grid = -1; return; }
        int dev = 0, cus = 0, per_cu = 0;
        (void)hipGetDevice(&dev); (void)hipDeviceGetAttribute(&cus, hipDeviceAttributeMultiprocessorCount, dev);
        if (hipFuncSetAttribute((const void*)fwd_megakernel, hipFuncAttributeMaxDynamicSharedMemorySize, LDS_BYTES) != hipSuccess) { fprintf(stderr, "kernel_launch: hipFuncSetAttribute failed\n"); grid = -1; return; }
        if (hipOccupancyMaxActiveBlocksPerMultiprocessor(&per_cu, (const void*)fwd_megakernel, NTHREADS, LDS_BYTES) != hipSuccess || per_cu < 1) { fprintf(stderr, "kernel_launch: occupancy query says %d blocks per CU\n", per_cu); grid = -1; return; }
        grid = cus * 1;
        if (grid != T / 64) { fprintf(stderr, "kernel_launch: this build needs exactly %d workgroups (one per CU of a 256-CU MI355X: the LN1 + router phase gives each 64 rows); device has %d CUs\n", T / 64, cus); grid = -1; return; }
        (void)hipGetLastError();
    }
    if (grid < 0) return;
    if (hipMemsetAsync((char*)d_ws + WS_CTL, 0, (size_t)(CW_BAR + XCD_BAR_WORDS) * 4, stream) != hipSuccess) { fprintf(stderr, "kernel_launch: hipMemsetAsync of the control words failed\n"); return; }
    Args a{};
    a.x = (const float*)d_in[0]; a.a_w_in = (const float*)d_in[1]; a.a_conv_w = (const float*)d_in[2]; a.a_w_out = (const float*)d_in[3]; a.kv_w = (const float*)d_in[4];
    a.b_w_q = (const float*)d_in[5]; a.b_lambda = (const float*)d_in[6]; a.b_subln_g = (const float*)d_in[7]; a.b_w_o = (const float*)d_in[8];
    a.ln1_g = (const float*)d_in[9]; a.ln1_b = (const float*)d_in[10]; a.ln2_g = (const float*)d_in[11]; a.ln2_b = (const float*)d_in[12];
    a.rg_w = (const float*)d_in[13]; a.rg_b = (const float*)d_in[14]; a.re_w = (const float*)d_in[15]; a.re_b = (const float*)d_in[16];
    a.e_w_in = (const float*)d_in[17]; a.e_w_down = (const float*)d_in[18];
    a.out = (float*)d_out; a.ws = (unsigned char*)d_ws;
    void* kargs[] = {&a};
    const hipError_t e = hipLaunchCooperativeKernel((const void*)fwd_megakernel, dim3(grid), dim3(NTHREADS), kargs, LDS_BYTES, stream);
    if (e != hipSuccess) fprintf(stderr, "kernel_launch: cooperative launch failed: %s (grid %d)\n", hipGetErrorString(e), grid);
}
```

```cpp
#include <hip/hip_runtime.h>
#include <hip/hip_cooperative_groups.h>
#include <cstdio>
#include <cstdint>
namespace cg = cooperative_groups;

namespace pg8 {
#define PG8_LAS __attribute__((address_space(3)))
typedef unsigned short bf16_t;
typedef short bf16x8 __attribute__((ext_vector_type(8)));
typedef float f32x4 __attribute__((ext_vector_type(4)));
typedef unsigned u32x4 __attribute__((ext_vector_type(4)));
typedef unsigned u32x2 __attribute__((ext_vector_type(2)));
constexpr int BM = 256, BK = 64, HALF = 128, HTB = HALF * BK * 2  , STAGE_BYTES = 8 * HTB, NXCD = 8, WGM = 8;

__host__ __device__ __forceinline__ int lds_byte(int r, int c) { const int st = (r >> 4) * 2 + (c >> 5), rr = r & 15, cc = c & 31, ob = rr * 64 + cc * 2; return st * 1024 + (ob ^ (((ob >> 9) & 1) << 5)); }
__host__ __device__ __forceinline__ void stage_rc(int b, int& R, int& C) { const int st = b / 1024, sb = b % 1024, swz = sb ^ (((sb >> 9) & 1) << 5); R = (st >> 1) * 16 + swz / 64; C = (st & 1) * 32 + (swz % 64) / 2; }
__host__ __device__ __forceinline__ int perm32(int rho) { const int n = rho >> 4, i = rho & 15; return 8 * (i >> 2) + 4 * n + (i & 3); }

struct Unit { const char* b0; const char* b1; int arow; int p0, p1, p2, p3; };

__device__ __forceinline__ bool static_tile(int i, int G, int c, int nM, int nN, int& pm, int& pn) {
    const int nwg = nM * nN; const long L = (long)i * G + c; if (L >= nwg) return false;
    int wgid = (int)L; { const int q = nwg / NXCD, r = nwg % NXCD, xcd = wgid % NXCD, off = wgid / NXCD; wgid = (xcd < r ? xcd * (q + 1) : r * (q + 1) + (xcd - r) * q) + off; }
    const int nig = WGM * nN, gid = wgid / nig, fm = gid * WGM, gsz = (nM - fm) < WGM ? (nM - fm) : WGM;
    pm = fm + ((wgid % nig) % gsz); pn = (wgid % nig) / gsz; return true;
}

__device__ __forceinline__ unsigned cvt_pk_bf16(float lo, float hi) { unsigned r; asm volatile("v_cvt_pk_bf16_f32 %0, %1, %2" : "=v"(r) : "v"(lo), "v"(hi)); return r; }

template <class Epi, class Sched>
__device__ __forceinline__ void gemm_phase(PG8_LAS unsigned char* lds, const char* Abase, const int K, const Sched& S, const Epi& E) {
    int tid_ = threadIdx.x; asm volatile("" : "+v"(tid_));
    const int tid = tid_, wid = __builtin_amdgcn_readfirstlane(tid >> 6), lane = tid & 63, wr = wid >> 2, wc = wid & 3, fr = lane & 15, fq = lane >> 4;
    const int nt = K / BK;
    int R[2], C[2]; unsigned voffB[2];
#pragma unroll
    for (int i = 0; i < 2; ++i) { stage_rc(tid * 16 + i * 8192, R[i], C[i]); const int Rb = Epi::PERM ? ((R[i] & ~31) + perm32(R[i] & 31)) : R[i]; voffB[i] = (unsigned)(Rb * K + C[i]) * 2u; }
    const size_t kstep = (size_t)(BK * 2);
    const unsigned ldsw = (unsigned)wid * 1024u;
    const int aoff = lds_byte(wr * 64 + fr, fq * 8), boff = lds_byte(wc * 32 + fr, fq * 8);
#define PG8_SA(b, h) (((b) * 2 + (h)) * HTB)
#define PG8_SB(b, h) ((4 + (b) * 2 + (h)) * HTB)
#define PG8_STAGE(bufoff, gbase, v0, v1) do { \
        __builtin_amdgcn_global_load_lds((const unsigned*)((const char*)(gbase) + (v0)), (PG8_LAS unsigned*)(lds + (bufoff) + ldsw), 16, 0, 0); \
        __builtin_amdgcn_global_load_lds((const unsigned*)((const char*)(gbase) + (v1)), (PG8_LAS unsigned*)(lds + (bufoff) + ldsw + 8192), 16, 0, 0); } while (0)
#define PG8_STAGEB(bufoff, gbase) PG8_STAGE(bufoff, gbase, voffB[0], voffB[1])
#define PG8_LDA(dst, b, h) do { _Pragma("unroll") for (int m = 0; m < 4; ++m) _Pragma("unroll") for (int k = 0; k < 2; ++k) dst[m][k] = *(const PG8_LAS bf16x8*)(lds + PG8_SA(b, h) + aoff + m * 2048 + k * 1024); } while (0)
#define PG8_LDB(dst, b, h) do { _Pragma("unroll") for (int n = 0; n < 2; ++n) _Pragma("unroll") for (int k = 0; k < 2; ++k) dst[n][k] = *(const PG8_LAS bf16x8*)(lds + PG8_SB(b, h) + boff + n * 2048 + k * 1024); } while (0)
#define PG8_MMA(ai, bj, At, Bt) do { __builtin_amdgcn_s_setprio(1); _Pragma("unroll") for (int m = 0; m < 4; ++m) _Pragma("unroll") for (int n = 0; n < 2; ++n) _Pragma("unroll") for (int k = 0; k < 2; ++k) \
        acc[ai][bj][m][n] = __builtin_amdgcn_mfma_f32_16x16x32_bf16(Bt[n][k], At[m][k], acc[ai][bj][m][n], 0, 0, 0); __builtin_amdgcn_s_setprio(0); } while (0)
#define PG8_WAIT_V(n) asm volatile("s_waitcnt vmcnt(" #n ")" ::: "memory")
#define PG8_WAIT_L(n) asm volatile("s_waitcnt lgkmcnt(" #n ")" ::: "memory")
#define PG8_BAR __builtin_amdgcn_s_barrier()
#define PG8_SCHED __builtin_amdgcn_sched_barrier(0)
    Unit cur, nxt; int ui = 0;
    if (!S.next(0, cur)) return;
    f32x4 acc[2][2][4][2];
#pragma unroll
    for (int a = 0; a < 2; ++a)
#pragma unroll
        for (int b = 0; b < 2; ++b)
#pragma unroll
            for (int m = 0; m < 4; ++m)
#pragma unroll
                for (int n = 0; n < 2; ++n) acc[a][b][m][n] = (f32x4){0.f, 0.f, 0.f, 0.f};
    bf16x8 At[4][2], B0[2][2], B1[2][2];
    unsigned vA00, vA01, vA10, vA11, vN00, vN01, vN10, vN11;
    S.a_ready(cur, S.peek(cur));
    S.a_offs(cur, R, C, vA00, vA01, vA10, vA11);
    const char* cB0 = cur.b0; const char* cB1 = cur.b1;
    PG8_STAGEB(PG8_SB(0, 0), cB0); PG8_STAGEB(PG8_SB(0, 1), cB1); PG8_STAGE(PG8_SA(0, 0), Abase, vA00, vA01); PG8_STAGE(PG8_SA(0, 1), Abase, vA10, vA11);
    if (wr == 1) PG8_BAR;
    PG8_WAIT_V(2); PG8_BAR;
    PG8_STAGEB(PG8_SB(1, 0), cB0 + kstep); PG8_STAGE(PG8_SA(1, 0), Abase + kstep, vA00, vA01); PG8_STAGEB(PG8_SB(1, 1), cB1 + kstep);
    PG8_WAIT_V(6); PG8_BAR;
    for (;;) {
        const bool has_next = S.next(ui + 1, nxt);
        if (has_next) S.a_offs(nxt, R, C, vN00, vN01, vN10, vN11); else { vN00 = vA00; vN01 = vA01; vN10 = vA10; vN11 = vA11; }
        const char* nB0 = has_next ? nxt.b0 : cB0; const char* nB1 = has_next ? nxt.b1 : cB1;
        const unsigned pk = has_next ? S.peek(nxt) : 0u;
        const bool skip1 = S.half_only(cur);
        for (int t = 0; t < nt; t += 2) {
            const bool last = (t == nt - 2);
            if (last && has_next) S.a_ready(nxt, pk);
            const char* a1 = Abase + (size_t)(t + 1) * kstep;
            PG8_LDB(B0, 0, 0); PG8_LDB(B1, 0, 1); PG8_SCHED; PG8_LDA(At, 0, 0); PG8_STAGE(PG8_SA(1, 1), a1, vA10, vA11);
            PG8_WAIT_V(8); PG8_WAIT_L(0); PG8_BAR; PG8_MMA(0, 0, At, B0); PG8_MMA(0, 1, At, B1); PG8_BAR; PG8_SCHED;
            if (last) { vA00 = vN00; vA01 = vN01; vA10 = vN10; vA11 = vN11; }
            const char* a2 = last ? Abase : Abase + (size_t)(t + 2) * kstep;
            const char* b20 = last ? nB0 : cB0 + (size_t)(t + 2) * kstep; const char* b21 = last ? nB1 : cB1 + (size_t)(t + 2) * kstep;
            const char* a3 = a2 + kstep; const char* b30 = b20 + kstep; const char* b31 = b21 + kstep;
            PG8_LDA(At, 0, 1); PG8_STAGEB(PG8_SB(0, 0), b20); PG8_STAGEB(PG8_SB(0, 1), b21); PG8_STAGE(PG8_SA(0, 0), a2, vA00, vA01);
            PG8_WAIT_V(8); PG8_WAIT_L(0); PG8_BAR; if (!skip1) { PG8_MMA(1, 0, At, B0); PG8_MMA(1, 1, At, B1); } PG8_BAR; PG8_SCHED;
            PG8_LDB(B0, 1, 0); PG8_LDB(B1, 1, 1); PG8_SCHED; PG8_LDA(At, 1, 0); PG8_STAGE(PG8_SA(0, 1), a2, vA10, vA11);
            PG8_WAIT_V(8); PG8_WAIT_L(0); PG8_BAR; PG8_MMA(0, 0, At, B0); PG8_MMA(0, 1, At, B1); PG8_BAR; PG8_SCHED;
            PG8_LDA(At, 1, 1); PG8_STAGEB(PG8_SB(1, 0), b30); PG8_STAGEB(PG8_SB(1, 1), b31); PG8_STAGE(PG8_SA(1, 0), a3, vA00, vA01);
            PG8_WAIT_V(8); PG8_WAIT_L(0); PG8_BAR; if (!skip1) { PG8_MMA(1, 0, At, B0); PG8_MMA(1, 1, At, B1); } PG8_BAR; PG8_SCHED;
        }
        if (wr == 0) PG8_BAR;
        E(acc, cur, wr, wc, fr, fq);
        S.done(cur);
        if (!has_next) break;
#pragma unroll
        for (int a = 0; a < 2; ++a)
#pragma unroll
            for (int b = 0; b < 2; ++b)
#pragma unroll
                for (int m = 0; m < 4; ++m)
#pragma unroll
                    for (int n = 0; n < 2; ++n) acc[a][b][m][n] = (f32x4){0.f, 0.f, 0.f, 0.f};
        cur = nxt; cB0 = nB0; cB1 = nB1; ++ui;
        if (wr == 1) PG8_BAR;
    }
    PG8_WAIT_V(0);
    PG8_BAR;
#undef PG8_SA
#undef PG8_SB
#undef PG8_STAGE
#undef PG8_STAGEB
#undef PG8_LDA
#undef PG8_LDB
#undef PG8_MMA
#undef PG8_WAIT_V
#undef PG8_WAIT_L
#undef PG8_BAR
#undef PG8_SCHED
}
}
#include <hip/hip_bf16.h>
#include <cmath>
namespace attn_body {
using bf16=__hip_bfloat16;
using bf16x8=__attribute__((ext_vector_type(8)))short;
using s16x4=__attribute__((ext_vector_type(4)))short;
using f32x16=__attribute__((ext_vector_type(16)))float;
using u32x4=__attribute__((ext_vector_type(4)))unsigned;
constexpr int D=64,DM=1024;
constexpr int NW=8,QBLK=32,QB=QBLK*NW,KVBLK=64;
constexpr int ATTN_PITCH=DM, ATTN_UNIT_ROWS=QB;
__device__ __forceinline__ int crow(int r,int hi){return (r&3)+8*(r>>2)+4*hi;}
#define SBAR() __builtin_amdgcn_sched_barrier(0)
__device__ __forceinline__ void cmask(f32x16&p0,f32x16&p1,int jb,int qrel,int hi){
  const float NEG=-INFINITY; int kb=64*jb+4*hi;
  #pragma unroll
  for(int r=0;r<16;++r){int kv=kb+(r&3)+8*(r>>2); if(kv>qrel)p0[r]=NEG; if(kv+32>qrel)p1[r]=NEG;}
}

constexpr int NSLOT=3, SLOTB=8192;
constexpr int LDS_K=0, LDS_V=NSLOT*SLOTB, LDS_WS=2*NSLOT*SLOTB, LDS_OST=LDS_WS+NW*64*4, LDS_BYTES=LDS_OST+NW*4096;
constexpr float C2=0.125f*1.4426950408889634f;
__device__ __forceinline__ void glds16(const void*gsrc,unsigned lds_dst){unsigned keep;
  asm volatile("s_mov_b32 %0, m0\n\ts_mov_b32 m0, %2\n\ts_nop 0\n\tglobal_load_lds_dwordx4 %1, off\n\ts_mov_b32 m0, %0":"=&s"(keep):"v"(gsrc),"s"(lds_dst):"memory");}
__device__ __forceinline__ void glds16s(const void*sbase,unsigned voff,unsigned lds_dst){unsigned keep;
  asm volatile("s_mov_b32 %0, m0\n\ts_mov_b32 m0, %3\n\ts_nop 4\n\tglobal_load_lds_dwordx4 %1, %2\n\ts_mov_b32 m0, %0":"=&s"(keep):"v"(voff),"s"(sbase),"s"(lds_dst):"memory");}
__device__ __forceinline__ float max3f(float a,float b,float c){float r;asm("v_max3_f32 %0, %1, %2, %3":"=v"(r):"v"(a),"v"(b),"v"(c));return r;}
__device__ __forceinline__ float max2f(float a,float b){float r;asm("v_max_f32_e32 %0, %1, %2":"=v"(r):"v"(a),"v"(b));return r;}
__device__ __forceinline__ float fadd_s(float a,float b){float r;asm("v_add_f32_e32 %0, %1, %2":"=v"(r):"v"(a),"v"(b));return r;}
__device__ __forceinline__ float fsub_s(float a,float b){float r;asm("v_sub_f32_e32 %0, %1, %2":"=v"(r):"v"(a),"v"(b));return r;}
typedef float f32x2_t __attribute__((ext_vector_type(2))); typedef __bf16 bf16x2_t __attribute__((ext_vector_type(2)));
__device__ __forceinline__ unsigned cvtpk_s(float lo,float hi){f32x2_t v={lo,hi};bf16x2_t b=__builtin_convertvector(v,bf16x2_t);return __builtin_bit_cast(unsigned,b);}
#define WAIT_BAR(N) asm volatile("s_waitcnt vmcnt(" #N ") lgkmcnt(0)\n\ts_barrier":::"memory")

__device__ __forceinline__ void qkt(f32x16&p0,f32x16&p1,const char*Kslot,const bf16x8*qr,const f32x16&negm,int r32,int hi){
  const char*kb=Kslot+hi*1024+r32*16;
  #pragma unroll
  for(int d0=0;d0<4;++d0){
    const bf16x8 b0=*reinterpret_cast<const bf16x8*>(kb+d0*2048);
    const bf16x8 b1=*reinterpret_cast<const bf16x8*>(kb+d0*2048+512);
    if(d0==0){p0=__builtin_amdgcn_mfma_f32_32x32x16_bf16(b0,qr[0],negm,0,0,0);p1=__builtin_amdgcn_mfma_f32_32x32x16_bf16(b1,qr[0],negm,0,0,0);}
    else{p0=__builtin_amdgcn_mfma_f32_32x32x16_bf16(b0,qr[d0],p0,0,0,0);p1=__builtin_amdgcn_mfma_f32_32x32x16_bf16(b1,qr[d0],p1,0,0,0);}}
}
typedef __attribute__((address_space(3))) const char* lds_cptr;
typedef short v4i16_t __attribute__((ext_vector_type(4)));
__device__ __forceinline__ void kload8(bf16x8*kf,lds_cptr kp){
  kf[0]=*(const __attribute__((address_space(3))) bf16x8*)(kp);      kf[1]=*(const __attribute__((address_space(3))) bf16x8*)(kp+512);
  kf[2]=*(const __attribute__((address_space(3))) bf16x8*)(kp+2048); kf[3]=*(const __attribute__((address_space(3))) bf16x8*)(kp+2560);
  kf[4]=*(const __attribute__((address_space(3))) bf16x8*)(kp+4096); kf[5]=*(const __attribute__((address_space(3))) bf16x8*)(kp+4608);
  kf[6]=*(const __attribute__((address_space(3))) bf16x8*)(kp+6144); kf[7]=*(const __attribute__((address_space(3))) bf16x8*)(kp+6656);
}
__device__ __forceinline__ void kload2(bf16x8*kf,lds_cptr kp,int j){ kf[2*j]=*(const __attribute__((address_space(3))) bf16x8*)(kp+j*2048); kf[2*j+1]=*(const __attribute__((address_space(3))) bf16x8*)(kp+j*2048+512); }
__device__ __forceinline__ s16x4 vtr(lds_cptr p){ return __builtin_bit_cast(s16x4,__builtin_amdgcn_ds_read_tr16_b64_v4i16((__attribute__((address_space(3))) v4i16_t*)p)); }
__device__ __forceinline__ float rowmax(const f32x16&p0,const f32x16&p1){
  float a=max3f(p0[0],p0[1],p1[0]),b=max3f(p0[2],p0[3],p1[1]);a=max3f(a,p1[2],p1[3]);
  #pragma unroll
  for(int r=4;r<16;r+=4){a=max3f(a,p0[r],p0[r+1]);b=max3f(b,p0[r+2],p0[r+3]);a=max3f(a,p1[r],p1[r+1]);b=max3f(b,p1[r+2],p1[r+3]);}
  const float m=max2f(a,b);
  auto rr=__builtin_amdgcn_permlane32_swap(__float_as_uint(m),__float_as_uint(m),false,false);
  return max2f(__uint_as_float(rr[0]),__uint_as_float(rr[1]));
}
__device__ __forceinline__ void pv(f32x16*o,int vb,bf16x8 pa0,bf16x8 pa1,bf16x8 pa2,bf16x8 pa3){
  #pragma unroll
  for(int d0=0;d0<2;++d0){s16x4 lo[4],hi[4];
    #pragma unroll
    for(int ks=0;ks<4;++ks){
      asm volatile("ds_read_b64_tr_b16 %0,%1 offset:%c2":"=&v"(lo[ks]):"v"(vb),"i"(d0*4096+ks*1024):"memory");
      asm volatile("ds_read_b64_tr_b16 %0,%1 offset:%c2":"=&v"(hi[ks]):"v"(vb),"i"(d0*4096+ks*1024+512):"memory");}
    asm volatile("s_waitcnt lgkmcnt(0)":::"memory");SBAR();
    #define PK(k) (bf16x8){lo[k][0],lo[k][1],lo[k][2],lo[k][3],hi[k][0],hi[k][1],hi[k][2],hi[k][3]}
    o[d0]=__builtin_amdgcn_mfma_f32_32x32x16_bf16(pa0,PK(0),o[d0],0,0,0);
    o[d0]=__builtin_amdgcn_mfma_f32_32x32x16_bf16(pa1,PK(1),o[d0],0,0,0);
    o[d0]=__builtin_amdgcn_mfma_f32_32x32x16_bf16(pa2,PK(2),o[d0],0,0,0);
    o[d0]=__builtin_amdgcn_mfma_f32_32x32x16_bf16(pa3,PK(3),o[d0],0,0,0);
    #undef PK
  }
}

#ifndef ATTN_STORE16
#define ATTN_STORE16(p,v) (*(u32x4*)(p)=(v))
#endif
template<int THRL> __device__ __forceinline__ void attn_unit(long rowbase,int qb,const bf16*Qc,const bf16*__restrict__ Kc,const bf16*__restrict__ Vc,bf16*Oc,char*shm){
  int tid_=threadIdx.x; asm volatile("":"+v"(tid_)); const int tid=tid_,lane=tid&63,r32=lane&31,hi=lane>>5; const int wid=__builtin_amdgcn_readfirstlane(tid>>6);
  const int q0=qb*QB;
  const bf16*Qw=Qc+(rowbase+q0+wid*QBLK)*DM;
  const bf16*Kh=Kc+rowbase*DM,*Vh=Vc+rowbase*DM;
  const unsigned lds0=(unsigned)(uintptr_t)shm;
  float*wsf=(float*)(shm+LDS_WS)+wid*64;
  const unsigned koff=(unsigned)(lane*DM+wid*8)*2u;
  const unsigned voffv=(unsigned)((16*(wid&3)+(lane>>2))*DM+(wid>>2)*32+(lane&3)*8)*2u;
  const unsigned kdst=lds0+LDS_K+wid*1024, vdst=lds0+LDS_V+wid*1024;
  #define DMA_K(t,slot) glds16s(Kh+(long)(t)*KVBLK*DM,koff,(unsigned)__builtin_amdgcn_readfirstlane(kdst+(slot)))
  #define DMA_V(t,slot) glds16s(Vh+(long)(t)*KVBLK*DM,voffv,(unsigned)__builtin_amdgcn_readfirstlane(vdst+(slot)))
  const int vb0=(int)(lds0+LDS_V)+((lane>>4)&1)*32+(lane&3)*8+(4*hi+((lane&15)>>2))*64;
  const char*Kbase=shm+LDS_K; bf16x8 kf[8];
  const lds_cptr shm3=(lds_cptr)shm; const lds_cptr kp0=shm3+LDS_K+hi*1024+r32*16; const lds_cptr vp0=shm3+LDS_V+((lane>>4)&1)*32+(lane&3)*8+(4*hi+((lane&15)>>2))*64;
  const int NT=(q0+QB)/KVBLK;
  DMA_K(0,0);DMA_V(0,0);DMA_K(1,SLOTB);
  bf16x8 qr[4];
  #pragma unroll
  for(int d0=0;d0<4;++d0)qr[d0]=*reinterpret_cast<const bf16x8*>(&Qw[(long)r32*DM+d0*16+hi*8]);
  float mhat=0.f,l_reg=0.f;f32x16 o[2];o[0]=f32x16{};o[1]=f32x16{};f32x16 negm=f32x16{};asm volatile("":"+v"(negm));
  const int qrel=wid*QBLK+r32;
  #define CMASK(P0,P1,t) do{int jb_=(t)-(NT-4); if(jb_>=0)cmask(P0,P1,jb_,qrel,hi);}while(0)
  bool resc=false;
  #define START(P0,P1) do{ const float rm=rowmax(P0,P1); resc=false; \
    { const float dl=rm; mhat=fadd_s(mhat,dl); \
      _Pragma("unroll") for(int r=0;r<16;++r){P0[r]=fsub_s(P0[r],dl);P1[r]=fsub_s(P1[r],dl);} \
      _Pragma("unroll") for(int r=0;r<16;++r)negm[r]=-mhat; asm volatile("":"+v"(negm)); } \
    _Pragma("unroll") for(int r=0;r<16;++r)P0[r]=__builtin_amdgcn_exp2f(P0[r]); }while(0)
  #define RESC() do{ if(resc){ asm volatile("s_waitcnt lgkmcnt(0)":::"memory"); \
      _Pragma("unroll") for(int d_=0;d_<2;++d_) _Pragma("unroll") for(int r=0;r<16;++r)o[d_][r]*=wsf[crow(r,hi)]; } }while(0)
  f32x16 pA0,pA1,pB0,pB1;
  int sl_prev=0,sl_cur=0,sl_next=SLOTB;
  #define ROT() do{sl_prev=sl_cur;sl_cur=sl_next;sl_next=(sl_next==(NSLOT-1)*SLOTB)?0:sl_next+SLOTB;}while(0)
  DMA_K(2,2*SLOTB);
  WAIT_BAR(3);
  qkt(pA0,pA1,Kbase,qr,negm,r32,hi);asm volatile("s_nop 15\n\ts_nop 7":"+v"(pA0),"+v"(pA1));CMASK(pA0,pA1,0);
  START(pA0,pA1);
  _Pragma("unroll") for(int r=0;r<16;++r)pA1[r]=__builtin_amdgcn_exp2f(pA1[r]);
  WAIT_BAR(0);
  DMA_K(3,0);DMA_V(1,SLOTB);
  ROT();
  kload8(kf,kp0+sl_cur);
  WAIT_BAR(2);
  s16x4 vlo[8],vhi[8]; u32x4 pw0,pw1,pw2,pw3;
  #define PKW(P,B) cvtpk_s(P[B],P[B+1])
  #define PAF(k) __builtin_bit_cast(bf16x8,pw##k)
  #define VFR(i) (bf16x8){vlo[i][0],vlo[i][1],vlo[i][2],vlo[i][3],vhi[i][0],vhi[i][1],vhi[i][2],vhi[i][3]}
  #define PIN(x) asm volatile("":"+v"(x))
  #define MX3(a,b,c) __builtin_fmaxf(__builtin_fmaxf((a),(b)),(c))
  #define GAPA(MF,A0,A1,A2,A3,W0,W1,PW) do{ MF; sacc+=A0; sacc+=A1; sacc+=A2; sacc+=A3; PIN(sacc); W0; W1; PIN(PW); SBAR(); }while(0)
  #define EX(v) __builtin_amdgcn_exp2f(v)
  #define GAPB(MF,X,B) do{ MF; X[B]=EX(X[B]); X[B+1]=EX(X[B+1]); X[B+2]=EX(X[B+2]); X[B+3]=EX(X[B+3]); PIN(X); SBAR(); }while(0)
  #define VRD(i) do{ vlo[i]=vtr(vp_+(((i)>>2)*4096+((i)&3)*1024)); vhi[i]=vtr(vp_+(((i)>>2)*4096+((i)&3)*1024+512)); }while(0)
  #define KRD(G,j) do{ if(G){ kload2(kf,kp0+sl_next,j); SBAR(); } }while(0)
  #define STEP(C0,C1,P0,P1,t,GK,GV,GL) do{ SBAR(); \
    const lds_cptr vp_=vp0+sl_prev; \
    VRD(0); SBAR(); float sacc=(P0[0]+P0[1]); \
    GAPA(C0=__builtin_amdgcn_mfma_f32_32x32x16_bf16(kf[0],qr[0],negm,0,0,0), P0[2],P0[3],P0[4],P0[5],     pw0[0]=PKW(P0,0), pw0[1]=PKW(P0,2), pw0); \
    VRD(4); SBAR(); GAPA(C1=__builtin_amdgcn_mfma_f32_32x32x16_bf16(kf[1],qr[0],negm,0,0,0), P0[6],P0[7],P0[8],P0[9],     pw0[2]=PKW(P0,4), pw0[3]=PKW(P0,6), pw0); \
    VRD(1); SBAR(); GAPA(C0=__builtin_amdgcn_mfma_f32_32x32x16_bf16(kf[2],qr[1],C0,0,0,0),   P0[10],P0[11],P0[12],P0[13], pw1[0]=PKW(P0,8), pw1[1]=PKW(P0,10), pw1); \
    VRD(5); SBAR(); GAPA(C1=__builtin_amdgcn_mfma_f32_32x32x16_bf16(kf[3],qr[1],C1,0,0,0),   P0[14],P0[15],P1[0],P1[1],   pw1[2]=PKW(P0,12),pw1[3]=PKW(P0,14), pw1); \
    VRD(2); SBAR(); GAPA(C0=__builtin_amdgcn_mfma_f32_32x32x16_bf16(kf[4],qr[2],C0,0,0,0),   P1[2],P1[3],P1[4],P1[5],     pw2[0]=PKW(P1,0), pw2[1]=PKW(P1,2), pw2); \
    VRD(6); SBAR(); GAPA(C1=__builtin_amdgcn_mfma_f32_32x32x16_bf16(kf[5],qr[2],C1,0,0,0),   P1[6],P1[7],P1[8],P1[9],     pw2[2]=PKW(P1,4), pw2[3]=PKW(P1,6), pw2); \
    VRD(3); SBAR(); GAPA(C0=__builtin_amdgcn_mfma_f32_32x32x16_bf16(kf[6],qr[3],C0,0,0,0),   P1[10],P1[11],P1[12],P1[13], pw3[0]=PKW(P1,8), pw3[1]=PKW(P1,10), pw3); \
    VRD(7); SBAR(); GAPA(C1=__builtin_amdgcn_mfma_f32_32x32x16_bf16(kf[7],qr[3],C1,0,0,0),   P1[14],P1[15],0.f,0.f,       pw3[2]=PKW(P1,12),pw3[3]=PKW(P1,14), pw3); \
    l_reg+=sacc; \
    if(GK){DMA_K((t)+3,sl_cur);} if(GV){DMA_V((t)+1,sl_next);} \
    CMASK(C0,C1,t); \
    { float a=MX3(C0[0],C0[1],C1[0]),b=MX3(C0[2],C0[3],C1[1]); a=MX3(a,C1[2],C1[3]); \
      _Pragma("unroll") for(int r=4;r<16;r+=4){a=MX3(a,C0[r],C0[r+1]);b=MX3(b,C0[r+2],C0[r+3]);a=MX3(a,C1[r],C1[r+1]);b=MX3(b,C1[r+2],C1[r+3]);} \
      float rm=__builtin_fmaxf(a,b); { auto rr=__builtin_amdgcn_permlane32_swap(__float_as_uint(rm),__float_as_uint(rm),false,false); rm=__builtin_fmaxf(__uint_as_float(rr[0]),__uint_as_float(rr[1])); } \
      resc=false; \
      if(__builtin_expect(__any(rm>(float)THRL),0)){ const float dl=__builtin_fmaxf(rm,0.f); mhat+=dl; \
        _Pragma("unroll") for(int r=0;r<16;++r){C0[r]-=dl;C1[r]-=dl;} \
        _Pragma("unroll") for(int r=0;r<16;++r)negm[r]=-mhat; asm volatile("":"+v"(negm)); \
        const float f=__builtin_amdgcn_exp2f(-dl); l_reg*=f; if(hi==0)wsf[r32]=f; resc=true; } } \
    SBAR(); \
    GAPB(o[0]=__builtin_amdgcn_mfma_f32_32x32x16_bf16(PAF(0),VFR(0),o[0],0,0,0), C0,0); \
    GAPB(o[1]=__builtin_amdgcn_mfma_f32_32x32x16_bf16(PAF(0),VFR(4),o[1],0,0,0), C0,4); \
    KRD(GL,0); GAPB(o[0]=__builtin_amdgcn_mfma_f32_32x32x16_bf16(PAF(1),VFR(1),o[0],0,0,0), C0,8); \
    KRD(GL,1); GAPB(o[1]=__builtin_amdgcn_mfma_f32_32x32x16_bf16(PAF(1),VFR(5),o[1],0,0,0), C0,12); \
    KRD(GL,2); GAPB(o[0]=__builtin_amdgcn_mfma_f32_32x32x16_bf16(PAF(2),VFR(2),o[0],0,0,0), C1,0); \
    KRD(GL,3); GAPB(o[1]=__builtin_amdgcn_mfma_f32_32x32x16_bf16(PAF(2),VFR(6),o[1],0,0,0), C1,4); \
    GAPB(o[0]=__builtin_amdgcn_mfma_f32_32x32x16_bf16(PAF(3),VFR(3),o[0],0,0,0), C1,8); \
    GAPB(o[1]=__builtin_amdgcn_mfma_f32_32x32x16_bf16(PAF(3),VFR(7),o[1],0,0,0), C1,12); \
    }while(0)
  int t=1;
  #undef CMASK
  #define CMASK(P0,P1,t) do{}while(0)
  for(;t+5<NT;t+=2){
    STEP(pB0,pB1,pA0,pA1,t,true,true,true);     WAIT_BAR(2); RESC(); ROT();
    STEP(pA0,pA1,pB0,pB1,t+1,true,true,true);   WAIT_BAR(2); RESC(); ROT();
  }
  #undef CMASK
  #define CMASK(P0,P1,t) do{int jb_=(t)-(NT-4); if(jb_>=0)cmask(P0,P1,jb_,qrel,hi);}while(0)
  #define ENDW(tt) do{ if((tt)+3<NT){WAIT_BAR(2);} else if((tt)+2<NT){WAIT_BAR(1);} else {WAIT_BAR(0);} }while(0)
  for(;t+1<NT;t+=2){
    STEP(pB0,pB1,pA0,pA1,t,(t+3<NT),(t+1<NT),(t+1<NT));       ENDW(t);   RESC(); ROT();
    STEP(pA0,pA1,pB0,pB1,t+1,(t+4<NT),(t+2<NT),(t+2<NT));     ENDW(t+1); RESC(); ROT();
  }
  STEP(pB0,pB1,pA0,pA1,NT-1,false,false,false); RESC();
  { float sacc=pB0[0]+pB0[1]; _Pragma("unroll") for(int r=2;r<16;++r)sacc+=pB0[r]; _Pragma("unroll") for(int r=0;r<16;++r)sacc+=pB1[r]; l_reg+=sacc;
    pw0=(u32x4){PKW(pB0,0),PKW(pB0,2),PKW(pB0,4),PKW(pB0,6)};pw1=(u32x4){PKW(pB0,8),PKW(pB0,10),PKW(pB0,12),PKW(pB0,14)};pw2=(u32x4){PKW(pB1,0),PKW(pB1,2),PKW(pB1,4),PKW(pB1,6)};pw3=(u32x4){PKW(pB1,8),PKW(pB1,10),PKW(pB1,12),PKW(pB1,14)};
    SBAR(); pv(o,vb0+sl_cur,PAF(0),PAF(1),PAF(2),PAF(3)); }
  #undef PKW
  #undef PAF
  #undef VFR
  #undef PIN
  #undef MX3
  #undef GAPA
  #undef GAPB
  #undef EX
  #undef VRD
  #undef KRD
  #undef STEP
  #undef ENDW
  {auto rr=__builtin_amdgcn_permlane32_swap(__float_as_uint(l_reg),__float_as_uint(l_reg),false,false);l_reg=__uint_as_float(rr[0])+__uint_as_float(rr[1]);}
  if(hi==0)wsf[32+r32]=l_reg;asm volatile("s_waitcnt lgkmcnt(0)":::"memory");
  float rli[16];
  #pragma unroll
  for(int r=0;r<16;++r)rli[r]=__builtin_amdgcn_rcpf(wsf[32+crow(r,hi)]);
  bf16*Ow=Oc+(rowbase+q0+wid*QBLK)*DM;
  { bf16*stg=(bf16*)(shm+LDS_OST)+wid*2048;
    #pragma unroll
    for(int r=0;r<16;++r){const int orow=crow(r,hi);
      #pragma unroll
      for(int d0=0;d0<2;++d0)stg[orow*64+d0*32+r32]=__float2bfloat16(o[d0][r]*rli[r]);}
    asm volatile("s_waitcnt lgkmcnt(0)":::"memory");
    #pragma unroll
    for(int i=0;i<4;++i){const int row=i*8+(lane>>3),ch=lane&7; const u32x4 v=*(const u32x4*)(stg+row*64+ch*8); ATTN_STORE16(Ow+(long)row*DM+ch*8,v);} }
  asm volatile("s_waitcnt lgkmcnt(0)\n\ts_barrier":::"memory");
  #undef DMA_K
  #undef DMA_V
  #undef CMASK
  #undef START
  #undef RESC
  #undef ROT
}
constexpr int ATTN_LDS_BYTES=LDS_BYTES;
#undef SBAR
#undef WAIT_BAR
}
namespace attn128 {
using bf16=__hip_bfloat16;
using bf16x8=__attribute__((ext_vector_type(8)))short;
using s16x4=__attribute__((ext_vector_type(4)))short;
using f32x16=__attribute__((ext_vector_type(16)))float;
using u32x4=__attribute__((ext_vector_type(4)))unsigned;
constexpr int D=64,DM=1024;
constexpr int NW=8,QBLK=32,QB=QBLK*NW,KVBLK=64;
constexpr int ATTN_PITCH=DM, ATTN_UNIT_ROWS=QB;
__device__ __forceinline__ int crow(int r,int hi){return (r&3)+8*(r>>2)+4*hi;}
#define SBAR() __builtin_amdgcn_sched_barrier(0)
__device__ __forceinline__ void cmask(f32x16&p0,f32x16&p1,int jb,int qrel,int hi){
  const float NEG=-INFINITY; int kb=64*jb+4*hi;
  #pragma unroll
  for(int r=0;r<16;++r){int kv=kb+(r&3)+8*(r>>2); if(kv>qrel)p0[r]=NEG; if(kv+32>qrel)p1[r]=NEG;}
}

constexpr int NSLOT=3, SLOTB=8192;
constexpr int LDS_K=0, LDS_V=NSLOT*SLOTB, LDS_WS=LDS_V+NSLOT*2*SLOTB, LDS_OST=LDS_WS+NW*64*4, LDS_BYTES=LDS_OST+NW*8192;
constexpr float C2=0.125f*1.4426950408889634f;
__device__ __forceinline__ void glds16(const void*gsrc,unsigned lds_dst){unsigned keep;
  asm volatile("s_mov_b32 %0, m0\n\ts_mov_b32 m0, %2\n\ts_nop 0\n\tglobal_load_lds_dwordx4 %1, off\n\ts_mov_b32 m0, %0":"=&s"(keep):"v"(gsrc),"s"(lds_dst):"memory");}
__device__ __forceinline__ void glds16s(const void*sbase,unsigned voff,unsigned lds_dst){unsigned keep;
  asm volatile("s_mov_b32 %0, m0\n\ts_mov_b32 m0, %3\n\ts_nop 4\n\tglobal_load_lds_dwordx4 %1, %2\n\ts_mov_b32 m0, %0":"=&s"(keep):"v"(voff),"s"(sbase),"s"(lds_dst):"memory");}
__device__ __forceinline__ float max3f(float a,float b,float c){float r;asm("v_max3_f32 %0, %1, %2, %3":"=v"(r):"v"(a),"v"(b),"v"(c));return r;}
__device__ __forceinline__ float max2f(float a,float b){float r;asm("v_max_f32_e32 %0, %1, %2":"=v"(r):"v"(a),"v"(b));return r;}
__device__ __forceinline__ float fadd_s(float a,float b){float r;asm("v_add_f32_e32 %0, %1, %2":"=v"(r):"v"(a),"v"(b));return r;}
__device__ __forceinline__ float fsub_s(float a,float b){float r;asm("v_sub_f32_e32 %0, %1, %2":"=v"(r):"v"(a),"v"(b));return r;}
typedef float f32x2_t __attribute__((ext_vector_type(2))); typedef __bf16 bf16x2_t __attribute__((ext_vector_type(2)));
__device__ __forceinline__ unsigned cvtpk_s(float lo,float hi){f32x2_t v={lo,hi};bf16x2_t b=__builtin_convertvector(v,bf16x2_t);return __builtin_bit_cast(unsigned,b);}
#define WAIT_BAR(N) asm volatile("s_waitcnt vmcnt(" #N ") lgkmcnt(0)\n\ts_barrier":::"memory")

__device__ __forceinline__ void qkt(f32x16&p0,f32x16&p1,const char*Kslot,const bf16x8*qr,const f32x16&negm,int r32,int hi){
  const char*kb=Kslot+hi*1024+r32*16;
  #pragma unroll
  for(int d0=0;d0<4;++d0){
    const bf16x8 b0=*reinterpret_cast<const bf16x8*>(kb+d0*2048);
    const bf16x8 b1=*reinterpret_cast<const bf16x8*>(kb+d0*2048+512);
    if(d0==0){p0=__builtin_amdgcn_mfma_f32_32x32x16_bf16(b0,qr[0],negm,0,0,0);p1=__builtin_amdgcn_mfma_f32_32x32x16_bf16(b1,qr[0],negm,0,0,0);}
    else{p0=__builtin_amdgcn_mfma_f32_32x32x16_bf16(b0,qr[d0],p0,0,0,0);p1=__builtin_amdgcn_mfma_f32_32x32x16_bf16(b1,qr[d0],p1,0,0,0);}}
}
typedef __attribute__((address_space(3))) const char* lds_cptr;
typedef short v4i16_t __attribute__((ext_vector_type(4)));
__device__ __forceinline__ void kload8(bf16x8*kf,lds_cptr kp){
  kf[0]=*(const __attribute__((address_space(3))) bf16x8*)(kp);      kf[1]=*(const __attribute__((address_space(3))) bf16x8*)(kp+512);
  kf[2]=*(const __attribute__((address_space(3))) bf16x8*)(kp+2048); kf[3]=*(const __attribute__((address_space(3))) bf16x8*)(kp+2560);
  kf[4]=*(const __attribute__((address_space(3))) bf16x8*)(kp+4096); kf[5]=*(const __attribute__((address_space(3))) bf16x8*)(kp+4608);
  kf[6]=*(const __attribute__((address_space(3))) bf16x8*)(kp+6144); kf[7]=*(const __attribute__((address_space(3))) bf16x8*)(kp+6656);
}
__device__ __forceinline__ void kload2(bf16x8*kf,lds_cptr kp,int j){ kf[2*j]=*(const __attribute__((address_space(3))) bf16x8*)(kp+j*2048); kf[2*j+1]=*(const __attribute__((address_space(3))) bf16x8*)(kp+j*2048+512); }
__device__ __forceinline__ s16x4 vtr(lds_cptr p){ return __builtin_bit_cast(s16x4,__builtin_amdgcn_ds_read_tr16_b64_v4i16((__attribute__((address_space(3))) v4i16_t*)p)); }
__device__ __forceinline__ float rowmax(const f32x16&p0,const f32x16&p1){
  float a=max3f(p0[0],p0[1],p1[0]),b=max3f(p0[2],p0[3],p1[1]);a=max3f(a,p1[2],p1[3]);
  #pragma unroll
  for(int r=4;r<16;r+=4){a=max3f(a,p0[r],p0[r+1]);b=max3f(b,p0[r+2],p0[r+3]);a=max3f(a,p1[r],p1[r+1]);b=max3f(b,p1[r+2],p1[r+3]);}
  const float m=max2f(a,b);
  auto rr=__builtin_amdgcn_permlane32_swap(__float_as_uint(m),__float_as_uint(m),false,false);
  return max2f(__uint_as_float(rr[0]),__uint_as_float(rr[1]));
}
__device__ __forceinline__ void pv(f32x16*o,int vb,bf16x8 pa0,bf16x8 pa1,bf16x8 pa2,bf16x8 pa3){
  #pragma unroll
  for(int d0=0;d0<2;++d0){s16x4 lo[4],hi[4];
    #pragma unroll
    for(int ks=0;ks<4;++ks){
      asm volatile("ds_read_b64_tr_b16 %0,%1 offset:%c2":"=&v"(lo[ks]):"v"(vb),"i"(d0*4096+ks*1024):"memory");
      asm volatile("ds_read_b64_tr_b16 %0,%1 offset:%c2":"=&v"(hi[ks]):"v"(vb),"i"(d0*4096+ks*1024+512):"memory");}
    asm volatile("s_waitcnt lgkmcnt(0)":::"memory");SBAR();
    #define PK(k) (bf16x8){lo[k][0],lo[k][1],lo[k][2],lo[k][3],hi[k][0],hi[k][1],hi[k][2],hi[k][3]}
    o[d0]=__builtin_amdgcn_mfma_f32_32x32x16_bf16(pa0,PK(0),o[d0],0,0,0);
    o[d0]=__builtin_amdgcn_mfma_f32_32x32x16_bf16(pa1,PK(1),o[d0],0,0,0);
    o[d0]=__builtin_amdgcn_mfma_f32_32x32x16_bf16(pa2,PK(2),o[d0],0,0,0);
    o[d0]=__builtin_amdgcn_mfma_f32_32x32x16_bf16(pa3,PK(3),o[d0],0,0,0);
    #undef PK
  }
}

#ifndef ATTN_STORE16
#define ATTN_STORE16(p,v) (*(u32x4*)(p)=(v))
#endif
template<int THRL,int MODE> __device__ __forceinline__ void attn_unit(long rowbase,int qb,const bf16*Qc,const bf16*__restrict__ Kc,const bf16*__restrict__ Vc,bf16*Oc,char*shm,float lam,const float*gsub,float osc,float rms_eps){
  int tid_=threadIdx.x; asm volatile("":"+v"(tid_)); const int tid=tid_,lane=tid&63,r32=lane&31,hi=lane>>5; const int wid=__builtin_amdgcn_readfirstlane(tid>>6);
  const int q0=qb*QB;
  const bf16*Qw=Qc+(rowbase+q0+wid*QBLK)*DM;
  const bf16*Kh=Kc+rowbase*DM,*Vh=Vc+rowbase*DM;
  const unsigned lds0=(unsigned)(uintptr_t)shm;
  float*wsf=(float*)(shm+LDS_WS)+wid*64;
  const unsigned koff=(unsigned)(lane*DM+wid*8)*2u;
  const unsigned voffv=(unsigned)((16*(wid&3)+(lane>>2))*DM+(wid>>2)*32+(lane&3)*8)*2u;
  const unsigned kdst=lds0+LDS_K+wid*1024, vdst=lds0+LDS_V+wid*1024;
  #define DMA_K(t,slot) glds16s(Kh+(long)(t)*KVBLK*DM,koff,(unsigned)__builtin_amdgcn_readfirstlane(kdst+(slot)))
  #define DMA_V(t,slot) do{ glds16s(Vh+(long)(t)*KVBLK*DM,voffv,(unsigned)__builtin_amdgcn_readfirstlane(vdst+2*(slot))); glds16s(Vh+(long)(t)*KVBLK*DM+64,voffv,(unsigned)__builtin_amdgcn_readfirstlane(vdst+2*(slot)+8192)); }while(0)
  const int vb0=(int)(lds0+LDS_V)+((lane>>4)&1)*32+(lane&3)*8+(4*hi+((lane&15)>>2))*64;
  const char*Kbase=shm+LDS_K; bf16x8 kf[8];
  const lds_cptr shm3=(lds_cptr)shm; const lds_cptr kp0=shm3+LDS_K+hi*1024+r32*16; const lds_cptr vp0=shm3+LDS_V+((lane>>4)&1)*32+(lane&3)*8+(4*hi+((lane&15)>>2))*64;
  const int NT=(q0+QB)/KVBLK;
  DMA_K(0,0);DMA_V(0,0);DMA_K(1,SLOTB);
  bf16x8 qr[4];
  #pragma unroll
  for(int d0=0;d0<4;++d0)qr[d0]=*reinterpret_cast<const bf16x8*>(&Qw[(long)r32*DM+d0*16+hi*8]);
  float mhat=0.f,l_reg=0.f;f32x16 o[4];o[0]=f32x16{};o[1]=f32x16{};o[2]=f32x16{};o[3]=f32x16{};const f32x16 zf=f32x16{};
  const int qrel=wid*QBLK+r32;
  #define CMASK(P0,P1,t) do{int jb_=(t)-(NT-4); if(jb_>=0)cmask(P0,P1,jb_,qrel,hi);}while(0)
  bool resc=false;
  #define START(P0,P1) do{ const float rm=rowmax(P0,P1); resc=false; \
    { const float dl=rm; mhat=fadd_s(mhat,dl); \
      _Pragma("unroll") for(int r=0;r<16;++r){P0[r]=fsub_s(P0[r],dl);P1[r]=fsub_s(P1[r],dl);} \
      } \
    _Pragma("unroll") for(int r=0;r<16;++r)P0[r]=__builtin_amdgcn_exp2f(P0[r]); }while(0)
  #define RESC() do{ if(resc){ asm volatile("s_waitcnt lgkmcnt(0)":::"memory"); \
      _Pragma("unroll") for(int d_=0;d_<4;++d_) _Pragma("unroll") for(int r=0;r<16;++r)o[d_][r]*=wsf[crow(r,hi)]; } }while(0)
  f32x16 pA0,pA1,pB0,pB1;
  int sl_prev=0,sl_cur=0,sl_next=SLOTB;
  #define ROT() do{sl_prev=sl_cur;sl_cur=sl_next;sl_next=(sl_next==(NSLOT-1)*SLOTB)?0:sl_next+SLOTB;}while(0)
  DMA_K(2,2*SLOTB);
  WAIT_BAR(4);
  qkt(pA0,pA1,Kbase,qr,zf,r32,hi);asm volatile("s_nop 15\n\ts_nop 7":"+v"(pA0),"+v"(pA1));CMASK(pA0,pA1,0);
  START(pA0,pA1);
  _Pragma("unroll") for(int r=0;r<16;++r)pA1[r]=__builtin_amdgcn_exp2f(pA1[r]);
  WAIT_BAR(0);
  DMA_K(3,0);DMA_V(1,SLOTB);
  ROT();
  kload8(kf,kp0+sl_cur);
  WAIT_BAR(3);
  s16x4 vlo[8],vhi[8]; u32x4 pw0,pw1,pw2,pw3;
  #define PKW(P,B) cvtpk_s(P[B],P[B+1])
  #define PAF(k) __builtin_bit_cast(bf16x8,pw##k)
  #define VFR(i) (bf16x8){vlo[i][0],vlo[i][1],vlo[i][2],vlo[i][3],vhi[i][0],vhi[i][1],vhi[i][2],vhi[i][3]}
  #define PIN(x) asm volatile("":"+v"(x))
  #define MX3(a,b,c) __builtin_fmaxf(__builtin_fmaxf((a),(b)),(c))
  #define GAPA(MF,A0,A1,A2,A3,W0,W1,PW) do{ MF; sacc+=A0; sacc+=A1; sacc+=A2; sacc+=A3; PIN(sacc); W0; W1; PIN(PW); SBAR(); }while(0)
  #define EX(v) __builtin_amdgcn_exp2f(v)
  #define GAPB(MF,X,B) do{ MF; X[B]=EX(X[B]); X[B+1]=EX(X[B+1]); X[B+2]=EX(X[B+2]); X[B+3]=EX(X[B+3]); PIN(X); SBAR(); }while(0)
  #define VRD(i) do{ vlo[i]=vtr(vp_+(((i)>>2)*4096+((i)&3)*1024)); vhi[i]=vtr(vp_+(((i)>>2)*4096+((i)&3)*1024+512)); }while(0)
  #define KRD(G,j) do{ if(G){ kload2(kf,kp0+sl_next,j); SBAR(); } }while(0)
  #define VRD2(i) do{ vlo[i]=vtr(vp_+(8192+((i)>>2)*4096+((i)&3)*1024)); vhi[i]=vtr(vp_+(8192+((i)>>2)*4096+((i)&3)*1024+512)); SBAR(); }while(0)
  #define STEP(C0,C1,P0,P1,t,GK,GV,GL) do{ SBAR(); \
    const lds_cptr vp_=vp0+2*sl_prev; \
    VRD(0); SBAR(); float sacc=(P0[0]+P0[1]); \
    GAPA(C0=__builtin_amdgcn_mfma_f32_32x32x16_bf16(kf[0],qr[0],zf,0,0,0), P0[2],P0[3],P0[4],P0[5],     pw0[0]=PKW(P0,0), pw0[1]=PKW(P0,2), pw0); \
    VRD(4); SBAR(); GAPA(C1=__builtin_amdgcn_mfma_f32_32x32x16_bf16(kf[1],qr[0],zf,0,0,0), P0[6],P0[7],P0[8],P0[9],     pw0[2]=PKW(P0,4), pw0[3]=PKW(P0,6), pw0); \
    VRD(1); SBAR(); GAPA(C0=__builtin_amdgcn_mfma_f32_32x32x16_bf16(kf[2],qr[1],C0,0,0,0),   P0[10],P0[11],P0[12],P0[13], pw1[0]=PKW(P0,8), pw1[1]=PKW(P0,10), pw1); \
    VRD(5); SBAR(); GAPA(C1=__builtin_amdgcn_mfma_f32_32x32x16_bf16(kf[3],qr[1],C1,0,0,0),   P0[14],P0[15],P1[0],P1[1],   pw1[2]=PKW(P0,12),pw1[3]=PKW(P0,14), pw1); \
    VRD(2); SBAR(); GAPA(C0=__builtin_amdgcn_mfma_f32_32x32x16_bf16(kf[4],qr[2],C0,0,0,0),   P1[2],P1[3],P1[4],P1[5],     pw2[0]=PKW(P1,0), pw2[1]=PKW(P1,2), pw2); \
    VRD(6); SBAR(); GAPA(C1=__builtin_amdgcn_mfma_f32_32x32x16_bf16(kf[5],qr[2],C1,0,0,0),   P1[6],P1[7],P1[8],P1[9],     pw2[2]=PKW(P1,4), pw2[3]=PKW(P1,6), pw2); \
    VRD(3); SBAR(); GAPA(C0=__builtin_amdgcn_mfma_f32_32x32x16_bf16(kf[6],qr[3],C0,0,0,0),   P1[10],P1[11],P1[12],P1[13], pw3[0]=PKW(P1,8), pw3[1]=PKW(P1,10), pw3); \
    VRD(7); SBAR(); GAPA(C1=__builtin_amdgcn_mfma_f32_32x32x16_bf16(kf[7],qr[3],C1,0,0,0),   P1[14],P1[15],0.f,0.f,       pw3[2]=PKW(P1,12),pw3[3]=PKW(P1,14), pw3); \
    l_reg+=sacc; \
    if(GK){DMA_K((t)+3,sl_cur);} if(GV){DMA_V((t)+1,sl_next);} \
    _Pragma("unroll") for(int r=0;r<16;++r){C0[r]-=mhat;C1[r]-=mhat;} \
    CMASK(C0,C1,t); \
    { float a=MX3(C0[0],C0[1],C1[0]),b=MX3(C0[2],C0[3],C1[1]); a=MX3(a,C1[2],C1[3]); \
      _Pragma("unroll") for(int r=4;r<16;r+=4){a=MX3(a,C0[r],C0[r+1]);b=MX3(b,C0[r+2],C0[r+3]);a=MX3(a,C1[r],C1[r+1]);b=MX3(b,C1[r+2],C1[r+3]);} \
      float rm=__builtin_fmaxf(a,b); { auto rr=__builtin_amdgcn_permlane32_swap(__float_as_uint(rm),__float_as_uint(rm),false,false); rm=__builtin_fmaxf(__uint_as_float(rr[0]),__uint_as_float(rr[1])); } \
      resc=false; \
      if(__builtin_expect(__any(rm>(float)THRL),0)){ const float dl=__builtin_fmaxf(rm,0.f); mhat+=dl; \
        _Pragma("unroll") for(int r=0;r<16;++r){C0[r]-=dl;C1[r]-=dl;} \
        const float f=__builtin_amdgcn_exp2f(-dl); l_reg*=f; if(hi==0)wsf[r32]=f; resc=true; } } \
    SBAR(); \
    GAPB(o[0]=__builtin_amdgcn_mfma_f32_32x32x16_bf16(PAF(0),VFR(0),o[0],0,0,0), C0,0); VRD2(0); \
    GAPB(o[1]=__builtin_amdgcn_mfma_f32_32x32x16_bf16(PAF(0),VFR(4),o[1],0,0,0), C0,4); VRD2(4); \
    KRD(GL,0); GAPB(o[0]=__builtin_amdgcn_mfma_f32_32x32x16_bf16(PAF(1),VFR(1),o[0],0,0,0), C0,8); VRD2(1); \
    KRD(GL,1); GAPB(o[1]=__builtin_amdgcn_mfma_f32_32x32x16_bf16(PAF(1),VFR(5),o[1],0,0,0), C0,12); VRD2(5); \
    KRD(GL,2); GAPB(o[0]=__builtin_amdgcn_mfma_f32_32x32x16_bf16(PAF(2),VFR(2),o[0],0,0,0), C1,0); VRD2(2); \
    KRD(GL,3); GAPB(o[1]=__builtin_amdgcn_mfma_f32_32x32x16_bf16(PAF(2),VFR(6),o[1],0,0,0), C1,4); VRD2(6); \
    GAPB(o[0]=__builtin_amdgcn_mfma_f32_32x32x16_bf16(PAF(3),VFR(3),o[0],0,0,0), C1,8); VRD2(3); \
    GAPB(o[1]=__builtin_amdgcn_mfma_f32_32x32x16_bf16(PAF(3),VFR(7),o[1],0,0,0), C1,12); VRD2(7); \
    o[2]=__builtin_amdgcn_mfma_f32_32x32x16_bf16(PAF(0),VFR(0),o[2],0,0,0); o[3]=__builtin_amdgcn_mfma_f32_32x32x16_bf16(PAF(0),VFR(4),o[3],0,0,0); \
    o[2]=__builtin_amdgcn_mfma_f32_32x32x16_bf16(PAF(1),VFR(1),o[2],0,0,0); o[3]=__builtin_amdgcn_mfma_f32_32x32x16_bf16(PAF(1),VFR(5),o[3],0,0,0); \
    o[2]=__builtin_amdgcn_mfma_f32_32x32x16_bf16(PAF(2),VFR(2),o[2],0,0,0); o[3]=__builtin_amdgcn_mfma_f32_32x32x16_bf16(PAF(2),VFR(6),o[3],0,0,0); \
    o[2]=__builtin_amdgcn_mfma_f32_32x32x16_bf16(PAF(3),VFR(3),o[2],0,0,0); o[3]=__builtin_amdgcn_mfma_f32_32x32x16_bf16(PAF(3),VFR(7),o[3],0,0,0); SBAR(); \
    }while(0)
  int t=1;
  #undef CMASK
  #define CMASK(P0,P1,t) do{}while(0)
  for(;t+5<NT;t+=2){
    STEP(pB0,pB1,pA0,pA1,t,true,true,true);     WAIT_BAR(3); RESC(); ROT();
    STEP(pA0,pA1,pB0,pB1,t+1,true,true,true);   WAIT_BAR(3); RESC(); ROT();
  }
  #undef CMASK
  #define CMASK(P0,P1,t) do{int jb_=(t)-(NT-4); if(jb_>=0)cmask(P0,P1,jb_,qrel,hi);}while(0)
  #define ENDW(tt) do{ if((tt)+3<NT){WAIT_BAR(3);} else if((tt)+2<NT){WAIT_BAR(2);} else {WAIT_BAR(0);} }while(0)
  for(;t+1<NT;t+=2){
    STEP(pB0,pB1,pA0,pA1,t,(t+3<NT),(t+1<NT),(t+1<NT));       ENDW(t);   RESC(); ROT();
    STEP(pA0,pA1,pB0,pB1,t+1,(t+4<NT),(t+2<NT),(t+2<NT));     ENDW(t+1); RESC(); ROT();
  }
  STEP(pB0,pB1,pA0,pA1,NT-1,false,false,false); RESC();
  { float sacc=pB0[0]+pB0[1]; _Pragma("unroll") for(int r=2;r<16;++r)sacc+=pB0[r]; _Pragma("unroll") for(int r=0;r<16;++r)sacc+=pB1[r]; l_reg+=sacc;
    pw0=(u32x4){PKW(pB0,0),PKW(pB0,2),PKW(pB0,4),PKW(pB0,6)};pw1=(u32x4){PKW(pB0,8),PKW(pB0,10),PKW(pB0,12),PKW(pB0,14)};pw2=(u32x4){PKW(pB1,0),PKW(pB1,2),PKW(pB1,4),PKW(pB1,6)};pw3=(u32x4){PKW(pB1,8),PKW(pB1,10),PKW(pB1,12),PKW(pB1,14)};
    SBAR(); pv(o,vb0+2*sl_cur,PAF(0),PAF(1),PAF(2),PAF(3)); pv(o+2,vb0+2*sl_cur+8192,PAF(0),PAF(1),PAF(2),PAF(3)); }
  #undef PKW
  #undef PAF
  #undef VFR
  #undef PIN
  #undef MX3
  #undef GAPA
  #undef GAPB
  #undef EX
  #undef VRD
  #undef KRD
  #undef VRD2
  #undef STEP
  #undef ENDW
  {auto rr=__builtin_amdgcn_permlane32_swap(__float_as_uint(l_reg),__float_as_uint(l_reg),false,false);l_reg=__uint_as_float(rr[0])+__uint_as_float(rr[1]);}
  if(hi==0)wsf[32+r32]=l_reg;asm volatile("s_waitcnt lgkmcnt(0)":::"memory");
  float rli[16];
  #pragma unroll
  for(int r=0;r<16;++r)rli[r]=__builtin_amdgcn_rcpf(wsf[32+crow(r,hi)]);
  bf16*Ow=Oc+(rowbase+q0+wid*QBLK)*DM;
  { bf16*stg=(bf16*)(shm+LDS_OST)+wid*4096;
    #pragma unroll
    for(int r=0;r<16;++r){const int orow=crow(r,hi);
      #pragma unroll
      for(int d0=0;d0<4;++d0){ float v=o[d0][r]*rli[r];
        if(MODE==2) v=__bfloat162float(stg[orow*128+d0*32+r32])-lam*v;
        stg[orow*128+d0*32+r32]=__float2bfloat16(v);} }
    asm volatile("s_waitcnt lgkmcnt(0)":::"memory");
    if(MODE==0){
      #pragma unroll
      for(int i=0;i<8;++i){const int row=i*4+(lane>>4),ch=lane&15; const u32x4 v=*(const u32x4*)(stg+row*128+ch*8); ATTN_STORE16(Ow+(long)row*DM+ch*8,v);} }
    if(MODE==2){
      const int row=lane>>1,c0=(lane&1)*64; float ss=0.f; u32x4 w[8];
      #pragma unroll
      for(int i=0;i<8;++i){ w[i]=*(const u32x4*)(stg+row*128+c0+i*8);
        #pragma unroll
        for(int j=0;j<4;++j){ const float a=__uint_as_float(w[i][j]<<16),b=__uint_as_float(w[i][j]&0xffff0000u); ss+=a*a+b*b; } }
      ss+=__shfl_xor(ss,1);
      const float rs=osc/sqrtf(ss*(1.0f/128.0f)+rms_eps);
      #pragma unroll
      for(int i=0;i<8;++i){ u32x4 ov;
        #pragma unroll
        for(int j=0;j<4;++j){ const float a=__uint_as_float(w[i][j]<<16)*rs*gsub[c0+i*8+2*j],b=__uint_as_float(w[i][j]&0xffff0000u)*rs*gsub[c0+i*8+2*j+1]; ov[j]=cvtpk_s(a,b); }
        ATTN_STORE16(Ow+(long)row*DM+c0+i*8,ov); } }
  }
  asm volatile("s_waitcnt lgkmcnt(0)\n\ts_barrier":::"memory");
  #undef DMA_K
  #undef DMA_V
  #undef CMASK
  #undef START
  #undef RESC
  #undef ROT
}
constexpr int ATTN_LDS_BYTES=LDS_BYTES;
#undef SBAR
#undef WAIT_BAR
}
namespace mk {
#define GAS __attribute__((address_space(1)))
#define LAS __attribute__((address_space(3)))
typedef unsigned short bf16;
typedef unsigned v4u __attribute__((ext_vector_type(4)));
typedef unsigned v2u __attribute__((ext_vector_type(2)));
typedef float f32x4 __attribute__((ext_vector_type(4)));
using pg8::Unit;
using pg8::cvt_pk_bf16;

constexpr int D = 1024, BATCH = 8, SEQ = 2048, T = BATCH * SEQ, NH = 8, NG = 4, EPG = 8, NE = 32, DE = 512, NRW = NG + NE;
constexpr float ALPHA = 1.4142135623730951f, LN_EPS = 1e-5f, RMS_EPS = 1e-5f;
constexpr float LAM_INIT = 0.35550906f;
constexpr float QSCALE = 0.125f * 1.4426950408889634f;
constexpr int CNT_STRIDE = 64;
constexpr int CAP = T;
constexpr int NWAVES = 8, NTHREADS = 512;
#ifndef P0B_FILL
#define P0B_FILL 1
#endif
#ifndef MOE_MERGE
#define MOE_MERGE 0
#endif
#ifndef P0B_SPLIT
#define P0B_SPLIT 8192
#endif

constexpr size_t MiB = 1u << 20;
constexpr size_t WS_CTL = 0, WS_W1T = 1 * MiB, WS_W2T = 7 * MiB, WS_WKVQ = 9 * MiB, WS_WOT = 15 * MiB, WS_RWT = 17 * MiB;
constexpr size_t WS_RWH = 17 * MiB + 512 * 1024;
constexpr size_t WS_WUT = 24 * MiB, WS_WDT = 152 * MiB, WS_XB = 216 * MiB, WS_GB = 248 * MiB, WS_U = 280 * MiB, WS_A2 = 312 * MiB, WS_Z = 344 * MiB, WS_X1B = 408 * MiB;
constexpr size_t WS_ACT = 440 * MiB, WS_YP = 480 * MiB, WS_X2B = 544 * MiB, WS_K = 576 * MiB, WS_V = 608 * MiB, WS_Q = 640 * MiB, WS_O0 = 672 * MiB, WS_O1 = 704 * MiB;
constexpr size_t WS_A3 = 736 * MiB, WS_X3B = 768 * MiB;
#ifdef MKPROBE
constexpr size_t WS_PERM = 18 * MiB;
constexpr size_t WS_Z1 = 800 * MiB, WS_ACT1 = 864 * MiB, WS_YP1 = 904 * MiB, WS_PERM1 = 968 * MiB, WS_END = 972 * MiB;
#else
constexpr size_t WS_PERM = 18 * MiB;
constexpr size_t WS_Z1 = WS_Z, WS_ACT1 = WS_ACT, WS_YP1 = WS_YP, WS_PERM1 = WS_PERM, WS_END = 800 * MiB;
#endif
#define LZ(l) ((l) ? WS_Z1 : WS_Z)
#define LACT(l) ((l) ? WS_ACT1 : WS_ACT)
#define LYP(l) ((l) ? WS_YP1 : WS_YP)
#define LPERM(l) ((l) ? WS_PERM1 : WS_PERM)
constexpr int RWH_PITCH = 2064  , RWH_BYTES = 2 * 36 * RWH_PITCH  ;
constexpr int RWH_PAD = 149504;
constexpr int RING_BYTES = 131072, RW_BYTES = RWH_PAD  , MISC_OFF = RW_BYTES, LDS_BYTES = 163840;

struct Args {
    const float *x, *a_w_in, *a_conv_w, *a_w_out, *kv_w, *b_w_q, *b_lambda, *b_subln_g, *b_w_o, *ln1_g, *ln1_b, *ln2_g, *ln2_b, *rg_w, *rg_b, *re_w, *re_b, *e_w_in, *e_w_down;
    float* out; unsigned char* ws;
};

typedef const __attribute__((address_space(4))) Args* ArgsP;
__device__ __forceinline__ ArgsP kargs() { ArgsP p = (ArgsP)__builtin_amdgcn_kernarg_segment_ptr(); asm volatile("" : "+s"(p)); return p; }
struct Ctx { int tid, lane, wave, G, bx, gw, NGW; unsigned char* ws; };
__device__ __forceinline__ Ctx mkctx(ArgsP ap) { Ctx c; int t = threadIdx.x; asm volatile("" : "+v"(t)); c.tid = t; c.lane = t & 63; c.wave = __builtin_amdgcn_readfirstlane(t >> 6);
    c.G = gridDim.x; c.bx = blockIdx.x; c.gw = c.bx * 8 + c.wave; c.NGW = c.G * 8; c.ws = ap->ws; return c; }
__device__ __forceinline__ unsigned f2bf(float f) { unsigned u = __builtin_bit_cast(unsigned, f); return (u + 0x7fffu + ((u >> 16) & 1u)) >> 16; }
__device__ __forceinline__ unsigned pk2(float lo, float hi) { return f2bf(lo) | (f2bf(hi) << 16); }
__device__ __forceinline__ float bflo(unsigned w) { return __builtin_bit_cast(float, w << 16); }
__device__ __forceinline__ float bfhi(unsigned w) { return __builtin_bit_cast(float, w & 0xffff0000u); }
__device__ __forceinline__ f32x4 ldz4(const bf16* p) { const v2u w = *(const v2u*)p; return (f32x4){bflo(w.x), bfhi(w.x), bflo(w.y), bfhi(w.y)}; }
__device__ __forceinline__ float wave_sum(float v) {
#pragma unroll
    for (int o = 1; o < 64; o <<= 1) v += __shfl_xor(v, o);
    return v;
}

__device__ __forceinline__ float dpp_add(float v, const int ctrl_sel) {
    const int iv = __builtin_bit_cast(int, v); int t;
    if (ctrl_sel == 0) t = __builtin_amdgcn_update_dpp(0, iv, 0xB1, 0xF, 0xF, true);
    else if (ctrl_sel == 1) t = __builtin_amdgcn_update_dpp(0, iv, 0x4E, 0xF, 0xF, true);
    else if (ctrl_sel == 2) t = __builtin_amdgcn_update_dpp(0, iv, 0x141, 0xF, 0xF, true);
    else if (ctrl_sel == 3) t = __builtin_amdgcn_update_dpp(0, iv, 0x140, 0xF, 0xF, true);
    else if (ctrl_sel == 4) t = __builtin_amdgcn_update_dpp(0, iv, 0x142, 0xA, 0xF, false);
    else t = __builtin_amdgcn_update_dpp(0, iv, 0x143, 0xC, 0xF, false);
    return v + __builtin_bit_cast(float, t);
}
template <int N> __device__ __forceinline__ void dpp_sum(float (&v)[N]) {
#pragma unroll
    for (int st = 0; st < 6; ++st) {
#pragma unroll
        for (int i = 0; i < N; ++i) v[i] = dpp_add(v[i], st);
    }
#pragma unroll
    for (int i = 0; i < N; ++i) v[i] = __builtin_bit_cast(float, __builtin_amdgcn_readlane(__builtin_bit_cast(int, v[i]), 63));
}
__device__ __forceinline__ float dpp_sum1(float v) { float a[1] = {v}; dpp_sum(a); return a[0]; }

__device__ __forceinline__ void p0_transpose_item(const float* W, int K, int N, bf16* WT, int row_off, LAS float* scr, int item, int lane) {
    const int nblk = N / 64, kb = item / nblk, nb = item % nblk, k0 = 64 * kb, n0 = 64 * nb;
    const float* src = W + (size_t)(k0 + (lane >> 4)) * N + n0 + (lane & 15) * 4;
    f32x4 v[16];
#pragma unroll
    for (int i = 0; i < 16; ++i) v[i] = __builtin_nontemporal_load((const f32x4*)(src + (size_t)(4 * i) * N));
#pragma unroll
    for (int i = 0; i < 16; ++i) { LAS float* d = scr + (4 * i + (lane >> 4)) * 65 + (lane & 15) * 4; d[0] = v[i].x; d[1] = v[i].y; d[2] = v[i].z; d[3] = v[i].w; }
    asm volatile("s_waitcnt lgkmcnt(0)" ::: "memory");
    const int c = lane & 7;
#pragma unroll
    for (int j = 0; j < 8; ++j) { const int n = (lane >> 3) + 8 * j; const LAS float* s = scr + (8 * c) * 65 + n;
        v4u o; o.x = pk2(s[0 * 65], s[1 * 65]); o.y = pk2(s[2 * 65], s[3 * 65]); o.z = pk2(s[4 * 65], s[5 * 65]); o.w = pk2(s[6 * 65], s[7 * 65]);
        *(GAS v4u*)(WT + (size_t)(row_off + n0 + n) * K + k0 + 8 * c) = o; }
    asm volatile("s_waitcnt lgkmcnt(0)" ::: "memory");
}

constexpr int I_IN = 16 * 48, I_SQ = 16 * 16, I_KV = 16 * 32, I_DN = 8 * 16;
constexpr int NEM = P0B_FILL ? NE : 2 * NE;
constexpr int PS1 = I_IN, PS2 = PS1 + I_SQ, PS3 = PS2 + I_KV, PS4 = PS3 + I_SQ, PS5 = PS4 + I_SQ, PS6 = PS5 + NEM * I_SQ, P0_NITEMS = PS6 + NEM * I_DN;
__device__ __forceinline__ void p0_items(LAS unsigned char* lds, int lo, int hi, int w, int nw) {
    const ArgsP a = kargs(); const Ctx cx = mkctx(a); const int lane = cx.lane; unsigned char* ws = cx.ws;
    LAS float* scr = (LAS float*)(lds + cx.wave * 16640);
    for (int it = lo + w; it < hi; it += nw) {
        if (it < PS1) p0_transpose_item(a->a_w_in, D, 3 * D, (bf16*)(ws + WS_W1T), 0, scr, it, lane);
        else if (it < PS2) p0_transpose_item(a->a_w_out, D, D, (bf16*)(ws + WS_W2T), 0, scr, it - PS1, lane);
        else if (it < PS3) p0_transpose_item(a->kv_w, D, 2 * D, (bf16*)(ws + WS_WKVQ), 0, scr, it - PS2, lane);
        else if (it < PS4) p0_transpose_item(a->b_w_q, D, D, (bf16*)(ws + WS_WKVQ), 2 * D, scr, it - PS3, lane);
        else if (it < PS5) p0_transpose_item(a->b_w_o, D, D, (bf16*)(ws + WS_WOT), 0, scr, it - PS4, lane);
        else if (it < PS6) { const int r = it - PS5, mtx = r / I_SQ; p0_transpose_item(a->e_w_in + (size_t)mtx * D * D, D, D, (bf16*)(ws + WS_WUT) + (size_t)mtx * D * D, 0, scr, r % I_SQ, lane); }
        else { const int r = it - PS6, mtx = r / I_DN; p0_transpose_item(a->e_w_down + (size_t)mtx * DE * D, DE, D, (bf16*)(ws + WS_WDT) + (size_t)mtx * D * DE, 0, scr, r % I_DN, lane); }
    }
}
#ifndef ROLE_SPLIT
#define ROLE_SPLIT 1
#endif
#ifndef P0A_EXTRA
#define P0A_EXTRA 5632
#endif
__device__ __forceinline__ void p0_prologue(LAS unsigned char* lds) {
    const ArgsP a = kargs(); const Ctx cx = mkctx(a); const int gw = cx.gw, NGW = cx.NGW, lane = cx.lane;
    unsigned char* ws = cx.ws;
    p0_items(lds, 0, ROLE_SPLIT ? PS1 + P0A_EXTRA : P0_NITEMS, gw, NGW);
#pragma unroll 1
    for (int m = gw; m < T; m += 4 * NGW) {
        f32x4 v[4][4];
#pragma unroll
        for (int r = 0; r < 4; ++r) { const int row = m + r * NGW < T ? m + r * NGW : m; const GAS f32x4* xr = (const GAS f32x4*)(a->x + (size_t)row * D) + lane;
#pragma unroll
            for (int j = 0; j < 4; ++j) v[r][j] = __builtin_nontemporal_load(xr + 64 * j); }
#pragma unroll
        for (int r = 0; r < 4; ++r) { if (m + r * NGW < T) { GAS v2u* o = (GAS v2u*)((bf16*)(ws + WS_XB) + (size_t)(m + r * NGW) * D) + lane;
#pragma unroll
            for (int j = 0; j < 4; ++j) { v2u w; w.x = pk2(v[r][j].x, v[r][j].y); w.y = pk2(v[r][j].z, v[r][j].w); o[64 * j] = w; } } }
    }
    { float* rwt = (float*)(ws + WS_RWT);
      for (int idx = gw * 64 + lane; idx < 2 * NRW * D; idx += NGW * 64) { const int l = idx / (NRW * D), n = (idx / D) % NRW, k = idx % D;
          const float w = n < NG ? a->rg_w[((size_t)l * D + k) * NG + n] : a->re_w[((size_t)l * D + k) * NE + (n - NG)];
          rwt[idx] = w;
          const unsigned hi = f2bf(w), lo = f2bf(w - __builtin_bit_cast(float, hi << 16));
          bf16* img = (bf16*)(ws + WS_RWH) + (size_t)l * (RWH_PAD / 2);
          img[(size_t)n * (RWH_PITCH / 2) + k] = (bf16)hi; img[(size_t)(NRW + n) * (RWH_PITCH / 2) + k] = (bf16)lo; } }
}
__device__ __forceinline__ void p0b_fill(LAS unsigned char* lds, int lo, int hi, int r, int nidle) {
    const ArgsP a = kargs(); const Ctx cx = mkctx(a); unsigned char* ws = cx.ws;
    LAS float* scr = (LAS float*)(lds + cx.wave * 16640);
    for (int it = lo + r * NWAVES + cx.wave; it < hi; it += nidle * NWAVES) {
        if (it < NE * 256) { const int mtx = NE + it / 256; p0_transpose_item(a->e_w_in + (size_t)mtx * D * D, D, D, (bf16*)(ws + WS_WUT) + (size_t)mtx * D * D, 0, scr, it % 256, cx.lane); }
        else { const int r2 = it - NE * 256, mtx = NE + r2 / 128; p0_transpose_item(a->e_w_down + (size_t)mtx * DE * D, DE, D, (bf16*)(ws + WS_WDT) + (size_t)mtx * D * DE, 0, scr, r2 % 128, cx.lane); }
    }
}
constexpr int P0B_ITEMS = NE * 256 + NE * 128;
__device__ __forceinline__ void p0b_idle_fill(LAS unsigned char* lds, int lo, int hi) {
    const ArgsP a = kargs(); const Ctx cx = mkctx(a); const LAS int* misc = (const LAS int*)(lds + MISC_OFF);
    const int U = misc[2 * NE], rem = U % cx.G;
    if (rem == 0) p0b_fill(lds, lo, hi, cx.bx, cx.G);
    else if (cx.bx >= rem) p0b_fill(lds, lo, hi, cx.bx - rem, cx.G - rem);
}
struct SchedDense {
    int G, c, nN, mode, K; const char* W;
    __device__ __forceinline__ bool next(int i, Unit& u) const {
        int pm, pn; if (!pg8::static_tile(i, G, c, T / 256, nN, pm, pn)) return false;
        u.arow = pm * 256; u.p0 = pm; u.p1 = pn; u.p2 = 0; u.p3 = 0;
        const size_t rb = (size_t)K * 2;
        if (mode == 0 && pn >= 4) { const int jj = pn - 4; u.b0 = W + (size_t)(D + 128 * jj) * rb; u.b1 = W + (size_t)(2 * D + 128 * jj) * rb; }
        else { u.b0 = W + (size_t)(256 * pn) * rb; u.b1 = u.b0 + 128 * rb; }
        return true;
    }
    __device__ __forceinline__ void a_offs(const Unit& u, const int (&R)[2], const int (&C)[2], unsigned& v00, unsigned& v01, unsigned& v10, unsigned& v11) const {
        v00 = (unsigned)((u.arow + R[0]) * K + C[0]) * 2u; v01 = (unsigned)((u.arow + R[1]) * K + C[1]) * 2u;
        v10 = (unsigned)((u.arow + 128 + R[0]) * K + C[0]) * 2u; v11 = (unsigned)((u.arow + 128 + R[1]) * K + C[1]) * 2u;
    }
    __device__ __forceinline__ bool half_only(const Unit&) const { return false; }
    __device__ __forceinline__ unsigned peek(const Unit&) const { return 0u; }
    __device__ __forceinline__ void a_ready(const Unit&, unsigned) const {}
    __device__ __forceinline__ void done(const Unit&) const {}
};
struct MoeTab { const LAS int* ub; const LAS int* ps; const LAS int* cn; };
struct SchedMoe {
    int G, c, K; bool up; const char* W; const v2u* perm; MoeTab tb;
    unsigned* ready; int hook; int off, nb;
    __device__ __forceinline__ bool half_only(const Unit& u) const { return u.p2 <= 128; }
    __device__ __forceinline__ unsigned peek(const Unit& u) const {
        return hook == 2 ? __hip_atomic_load(ready + 64 * u.p3, __ATOMIC_RELAXED, __HIP_MEMORY_SCOPE_AGENT) : 0u;
    }
    __device__ __forceinline__ void a_ready(const Unit& u, unsigned pk) const {
        if (hook != 2) return;
        if ((unsigned)__builtin_amdgcn_readfirstlane(pk) >= 32u) return;
        const unsigned long long t0 = __builtin_amdgcn_s_memrealtime();
        while ((unsigned)__builtin_amdgcn_readfirstlane(__hip_atomic_load(ready + 64 * u.p3, __ATOMIC_RELAXED, __HIP_MEMORY_SCOPE_AGENT)) < 32u) {
            if (__builtin_amdgcn_s_memrealtime() - t0 > 2000000ull) break;
            __builtin_amdgcn_s_sleep(2); }
        __builtin_amdgcn_fence(__ATOMIC_ACQUIRE, "agent");
        asm volatile("s_waitcnt vmcnt(0)" ::: "memory");
    }
    __device__ __forceinline__ void done(const Unit& u) const {
        if (hook != 1) return;
        asm volatile("s_waitcnt vmcnt(0)" ::: "memory");
        if ((threadIdx.x & 63) == 0) __hip_atomic_fetch_add(ready + 64 * u.p3, 1u, __ATOMIC_RELAXED, __HIP_MEMORY_SCOPE_AGENT);
    }
    __device__ __forceinline__ bool next(int i, Unit& u) const {
        int idx = i * G + c;
        if (nb > 0) {
            const int v = c - (G - nb);
            if (v >= 0) idx = i == 0 ? v : i == 1 ? v + nb : 2 * nb + v + (i - 2) * G;
            else idx = 3 * nb + c + i * G;
        }
        if (idx >= tb.ub[2 * NE]) return false;
        const int ln = (int)__builtin_amdgcn_mbcnt_hi(~0u, __builtin_amdgcn_mbcnt_lo(~0u, 0u));
        const int k = (int)__builtin_popcountll(__ballot(idx >= tb.ub[ln])) - 1;
        const int e = k & (NE - 1), local = idx - tb.ub[k];
        int ct, rti;
        if (k < NE) { const int rtn = (tb.ub[k + 1] - tb.ub[k]) >> 2; ct = local / rtn; rti = local - ct * rtn; }
        else { ct = local; rti = (tb.cn[e] - 1) >> 8; }
        const size_t rb = (size_t)K * 2; const char* We = W + (size_t)e * D * rb;
        if (up) { u.b0 = We + (size_t)(128 * ct) * rb; u.b1 = We + (size_t)(DE + 128 * ct) * rb; u.arow = e * CAP + rti * 256; u.p0 = tb.ps[e] + rti * 256; }
        else { u.b0 = We + (size_t)(256 * ct) * rb; u.b1 = u.b0 + 128 * rb; u.arow = tb.ps[e] + rti * 256; u.p0 = e * CAP + rti * 256; }
        u.p1 = ct; u.p2 = tb.cn[e] - rti * 256; u.p3 = (tb.ps[e] >> 8) + rti;
        return true;
    }
    __device__ __forceinline__ void a_offs(const Unit& u, const int (&R)[2], const int (&C)[2], unsigned& v00, unsigned& v01, unsigned& v10, unsigned& v11) const {
        if (up) {
            const int r00 = R[0] < u.p2 ? R[0] : 0, r01 = R[1] < u.p2 ? R[1] : 0, r10 = 128 + R[0] < u.p2 ? 128 + R[0] : 0, r11 = 128 + R[1] < u.p2 ? 128 + R[1] : 0;
            const int t00 = (int)(perm[u.arow + r00].y >> 1), t01 = (int)(perm[u.arow + r01].y >> 1), t10 = (int)(perm[u.arow + r10].y >> 1), t11 = (int)(perm[u.arow + r11].y >> 1);
            v00 = (unsigned)(t00 * K + C[0]) * 2u; v01 = (unsigned)(t01 * K + C[1]) * 2u; v10 = (unsigned)(t10 * K + C[0]) * 2u; v11 = (unsigned)(t11 * K + C[1]) * 2u;
        } else {
            v00 = (unsigned)((u.arow + R[0]) * K + C[0]) * 2u; v01 = (unsigned)((u.arow + R[1]) * K + C[1]) * 2u;
            v10 = (unsigned)((u.arow + 128 + R[0]) * K + C[0]) * 2u; v11 = (unsigned)((u.arow + 128 + R[1]) * K + C[1]) * 2u;
        }
    }
};

struct EpiConvIn {
    static constexpr bool PERM = true; bf16* GB; bf16* U;
    __device__ __forceinline__ void operator()(const f32x4 (&acc)[2][2][4][2], const Unit& u, int wr, int wc, int fr, int fq) const {
        const int row0 = u.p0 * 256 + wr * 64 + fr;
        if (u.p1 < 4) {
            const int col0 = u.p1 * 256 + wc * 32 + 8 * fq;
#pragma unroll
            for (int ai = 0; ai < 2; ++ai)
#pragma unroll
                for (int m = 0; m < 4; ++m) { bf16* rowp = GB + (size_t)(row0 + ai * 128 + m * 16) * D + col0;
#pragma unroll
                    for (int bj = 0; bj < 2; ++bj) { const f32x4 v0 = acc[ai][bj][m][0], v1 = acc[ai][bj][m][1];
                        v4u w; w.x = cvt_pk_bf16(v0[0], v0[1]); w.y = cvt_pk_bf16(v0[2], v0[3]); w.z = cvt_pk_bf16(v1[0], v1[1]); w.w = cvt_pk_bf16(v1[2], v1[3]);
                        *(v4u*)(rowp + bj * 128) = w; } }
        } else {
            const int col0 = (u.p1 - 4) * 128 + wc * 32 + 8 * fq;
#pragma unroll
            for (int ai = 0; ai < 2; ++ai)
#pragma unroll
                for (int m = 0; m < 4; ++m) { const f32x4 v0 = acc[ai][0][m][0] * acc[ai][1][m][0], v1 = acc[ai][0][m][1] * acc[ai][1][m][1];
                    v4u w; w.x = cvt_pk_bf16(v0[0], v0[1]); w.y = cvt_pk_bf16(v0[2], v0[3]); w.z = cvt_pk_bf16(v1[0], v1[1]); w.w = cvt_pk_bf16(v1[2], v1[3]);
                    *(v4u*)(U + (size_t)(row0 + ai * 128 + m * 16) * D + col0) = w; }
        }
    }
};
template <bool RES_BF16> struct EpiResZ {
    static constexpr bool PERM = true; const void* res; bf16* Z;
    __device__ __forceinline__ void operator()(const f32x4 (&acc)[2][2][4][2], const Unit& u, int wr, int wc, int fr, int fq) const {
        const int row0 = u.p0 * 256 + wr * 64 + fr, col0 = u.p1 * 256 + wc * 32 + 8 * fq;
#pragma unroll
        for (int ai = 0; ai < 2; ++ai)
#pragma unroll
            for (int m = 0; m < 4; ++m) { const size_t off = (size_t)(row0 + ai * 128 + m * 16) * D + col0;
#pragma unroll
                for (int bj = 0; bj < 2; ++bj) { const size_t o = off + bj * 128; f32x4 r0, r1;
                    if (RES_BF16) { const v4u w = *(const v4u*)((const bf16*)res + o); r0 = (f32x4){bflo(w.x), bfhi(w.x), bflo(w.y), bfhi(w.y)}; r1 = (f32x4){bflo(w.z), bfhi(w.z), bflo(w.w), bfhi(w.w)}; }
                    else { r0 = *(const f32x4*)((const float*)res + o); r1 = *(const f32x4*)((const float*)res + o + 4); }
                    const f32x4 v0 = r0 * ALPHA + acc[ai][bj][m][0], v1 = r1 * ALPHA + acc[ai][bj][m][1];
                    v4u w; w.x = cvt_pk_bf16(v0[0], v0[1]); w.y = cvt_pk_bf16(v0[2], v0[3]); w.z = cvt_pk_bf16(v1[0], v1[1]); w.w = cvt_pk_bf16(v1[2], v1[3]);
                    *(v4u*)(Z + o) = w; } }
    }
};
template <bool WT> struct EpiUp {
    static constexpr bool PERM = true; bf16* ACT;
    __device__ __forceinline__ void operator()(const f32x4 (&acc)[2][2][4][2], const Unit& u, int wr, int wc, int fr, int fq) const {
        const int row0 = u.p0 + wr * 64 + fr, col0 = u.p1 * 128 + wc * 32 + 8 * fq;
#pragma unroll
        for (int ai = 0; ai < 2; ++ai)
#pragma unroll
            for (int m = 0; m < 4; ++m) { f32x4 v[2];
#pragma unroll
                for (int n = 0; n < 2; ++n) { const f32x4 g = acc[ai][0][m][n], uu = acc[ai][1][m][n];
#pragma unroll
                    for (int j = 0; j < 4; ++j) { const float e = __builtin_amdgcn_exp2f(g[j] * -1.4426950408889634f); v[n][j] = g[j] * __builtin_amdgcn_rcpf(1.0f + e) * uu[j]; } }
                v4u w; w.x = cvt_pk_bf16(v[0][0], v[0][1]); w.y = cvt_pk_bf16(v[0][2], v[0][3]); w.z = cvt_pk_bf16(v[1][0], v[1][1]); w.w = cvt_pk_bf16(v[1][2], v[1][3]);
                bf16* dst = ACT + (size_t)(row0 + ai * 128 + m * 16) * DE + col0;
                if (WT) { __hip_atomic_store((unsigned long long*)dst, ((unsigned long long)w.y << 32) | w.x, __ATOMIC_RELAXED, __HIP_MEMORY_SCOPE_AGENT);
                          __hip_atomic_store((unsigned long long*)dst + 1, ((unsigned long long)w.w << 32) | w.z, __ATOMIC_RELAXED, __HIP_MEMORY_SCOPE_AGENT); }
                else *(v4u*)dst = w; }
    }
};
struct EpiDown {
    static constexpr bool PERM = true; bf16* YP; const v2u* perm;
    __device__ __forceinline__ void operator()(const f32x4 (&acc)[2][2][4][2], const Unit& u, int wr, int wc, int fr, int fq) const {
        const int col0 = u.p1 * 256 + wc * 32 + 8 * fq;
        v2u rec[2][4];
#pragma unroll
        for (int ai = 0; ai < 2; ++ai)
#pragma unroll
            for (int m = 0; m < 4; ++m) { const int r = ai * 128 + wr * 64 + m * 16 + fr; rec[ai][m] = perm[u.p0 + (r < u.p2 ? r : 0)]; }
#pragma unroll
        for (int ai = 0; ai < 2; ++ai)
#pragma unroll
            for (int m = 0; m < 4; ++m) { const int r = ai * 128 + wr * 64 + m * 16 + fr;
                if (r < u.p2) { const int pair = (int)rec[ai][m].y; float g = __builtin_bit_cast(float, rec[ai][m].x); asm volatile("" : "+v"(g)); bf16* rowp = YP + (size_t)pair * D + col0;
#pragma unroll
                    for (int bj = 0; bj < 2; ++bj) { const f32x4 v0 = acc[ai][bj][m][0] * g, v1 = acc[ai][bj][m][1] * g;
                        v4u w; w.x = cvt_pk_bf16(v0[0], v0[1]); w.y = cvt_pk_bf16(v0[2], v0[3]); w.z = cvt_pk_bf16(v1[0], v1[1]); w.w = cvt_pk_bf16(v1[2], v1[3]);
                        *(v4u*)(rowp + bj * 128) = w; } } }
    }
};
struct EpiKVQ {
    static constexpr bool PERM = true; bf16* KB;
    __device__ __forceinline__ void operator()(const f32x4 (&acc)[2][2][4][2], const Unit& u, int wr, int wc, int fr, int fq) const {
        const int t = u.p1 >> 2; const float sc = t == 2 ? QSCALE : 1.0f;
        bf16* base = KB + (size_t)t * (32 * MiB / 2);
        const int row0 = u.p0 * 256 + wr * 64 + fr, col0 = (u.p1 & 3) * 256 + wc * 32 + 8 * fq;
#pragma unroll
        for (int ai = 0; ai < 2; ++ai)
#pragma unroll
            for (int m = 0; m < 4; ++m) { bf16* rowp = base + (size_t)(row0 + ai * 128 + m * 16) * D + col0;
#pragma unroll
                for (int bj = 0; bj < 2; ++bj) { const f32x4 v0 = acc[ai][bj][m][0] * sc, v1 = acc[ai][bj][m][1] * sc;
                    v4u w; w.x = cvt_pk_bf16(v0[0], v0[1]); w.y = cvt_pk_bf16(v0[2], v0[3]); w.z = cvt_pk_bf16(v1[0], v1[1]); w.w = cvt_pk_bf16(v1[2], v1[3]);
                    *(v4u*)(rowp + bj * 128) = w; } }
    }
};

__device__ __forceinline__ void ln_rows(f32x4 (&v)[4], const f32x4 (&gg)[4], const f32x4 (&bb)[4]) {
    float s = 0.f;
#pragma unroll
    for (int j = 0; j < 4; ++j) s += (v[j].x + v[j].y) + (v[j].z + v[j].w);
    const float mean = dpp_sum1(s) * (1.f / D); float s2 = 0.f;
#pragma unroll
    for (int j = 0; j < 4; ++j) { v[j] = v[j] - mean; s2 += (v[j].x * v[j].x + v[j].y * v[j].y) + (v[j].z * v[j].z + v[j].w * v[j].w); }
    const float rstd = 1.f / sqrtf(dpp_sum1(s2) * (1.f / D) + LN_EPS);
#pragma unroll
    for (int j = 0; j < 4; ++j) v[j] = v[j] * rstd * gg[j] + bb[j];
}
__device__ __forceinline__ float dot_lds(const f32x4 (&v)[4], const LAS f32x4* w, int lane) {
    float a = 0.f;
#pragma unroll
    for (int j = 0; j < 4; ++j) { const f32x4 ww = w[64 * j + lane]; a += (v[j].x * ww.x + v[j].y * ww.y) + (v[j].z * ww.z + v[j].w * ww.w); }
    return a;
}
typedef short bf16x8v __attribute__((ext_vector_type(8)));
__device__ __forceinline__ void ln_router_mfma(LAS unsigned char* lds, int layer, int rep) {
    const ArgsP a = kargs(); const Ctx cx = mkctx(a); const int lane = cx.lane, wave = cx.wave, tid = cx.tid;
    unsigned char* ws = cx.ws;
    const bf16* Z = (const bf16*)(ws + LZ(layer)); bf16* Xb = (bf16*)(ws + (layer == 0 ? WS_X1B : WS_X3B));
    const float* g = a->ln1_g + layer * D; const float* b = a->ln1_b + layer * D;
    const float* rgb = a->rg_b + layer * NG; const float* reb = a->re_b + layer * NE;
    int* cnt = (int*)(ws + WS_CTL) + layer * NE * CNT_STRIDE; v2u* perm = (v2u*)(ws + LPERM(layer));
    const int i = lane & 15, kq = lane >> 4, grp = wave >> 1, half = wave & 1;
    const int row = cx.bx * 64 + grp * 16 + i, col0 = 512 * half + 8 * kq;
    { const unsigned char* wg = ws + WS_RWH + (size_t)layer * RWH_PAD;
      for (int q = wave; q < RWH_PAD / 1024; q += NWAVES)
          __builtin_amdgcn_global_load_lds((const unsigned*)(wg + (size_t)q * 1024 + lane * 16), (LAS unsigned*)(lds + q * 1024), 16, 0, 0); }
    v4u xw[16];
#pragma unroll
    for (int s = 0; s < 16; ++s) xw[s] = *(const v4u*)(Z + (size_t)row * D + col0 + 32 * s);
#define XLO(s) ((f32x4){bflo(xw[s].x), bfhi(xw[s].x), bflo(xw[s].y), bfhi(xw[s].y)})
#define XHI(s) ((f32x4){bflo(xw[s].z), bfhi(xw[s].z), bflo(xw[s].w), bfhi(xw[s].w)})
    LAS float* xs = (LAS float*)(lds + MISC_OFF + 4096);
    LAS float* part = (LAS float*)lds;
    float s1 = 0.f, s2 = 0.f;
#pragma unroll
    for (int s = 0; s < 16; ++s)
#pragma unroll
        for (int h2 = 0; h2 < 2; ++h2) { const f32x4 v = h2 ? XHI(s) : XLO(s); s1 += (v.x + v.y) + (v.z + v.w); s2 += (v.x * v.x + v.y * v.y) + (v.z * v.z + v.w * v.w); }
#pragma unroll
    for (int s = 0; s < 16; ++s) asm volatile("" : "+v"(xw[s]));
    s1 += __shfl_xor(s1, 16); s2 += __shfl_xor(s2, 16); s1 += __shfl_xor(s1, 32); s2 += __shfl_xor(s2, 32);
    if (kq == 0) { xs[(wave * 16 + i) * 2] = s1; xs[(wave * 16 + i) * 2 + 1] = s2; }
    __syncthreads();
    const float t1 = xs[((wave ^ 1) * 16 + i) * 2] + s1, t2 = xs[((wave ^ 1) * 16 + i) * 2 + 1] + s2;
    const float mean = t1 * (1.f / D), rstd = 1.f / sqrtf(fmaxf(t2 * (1.f / D) - mean * mean, 0.f) + LN_EPS);
    typedef float f32x4a __attribute__((ext_vector_type(4)));
    f32x4a acc0 = {0.f, 0.f, 0.f, 0.f}, acc1 = acc0, acc2 = acc0;
    const LAS unsigned char* wb = (const LAS unsigned char*)lds + (size_t)(lane & 15) * RWH_PITCH + (size_t)col0 * 2;
    const int n2 = (32 + (lane & 15)) < NRW ? 32 + (lane & 15) : NRW - 1;
    const LAS unsigned char* wb2 = (const LAS unsigned char*)lds + (size_t)n2 * RWH_PITCH + (size_t)col0 * 2;
    constexpr int LO = NRW * RWH_PITCH;
#pragma unroll
    for (int s = 0; s < 16; ++s) {
        if ((s & 3) == 0) asm volatile("" ::: "memory");
        const float* gp = g + col0 + 32 * s; const float* bp = b + col0 + 32 * s;
        const f32x4 g0 = *(const f32x4*)gp, g1 = *(const f32x4*)(gp + 4), b0 = *(const f32x4*)bp, b1 = *(const f32x4*)(bp + 4);
        const f32x4 v0 = (XLO(s) - mean) * rstd * g0 + b0, v1 = (XHI(s) - mean) * rstd * g1 + b1;
        const float vv[8] = {v0.x, v0.y, v0.z, v0.w, v1.x, v1.y, v1.z, v1.w};
        unsigned hi[8], lo[8];
#pragma unroll
        for (int j = 0; j < 8; ++j) { hi[j] = f2bf(vv[j]); lo[j] = f2bf(vv[j] - __builtin_bit_cast(float, hi[j] << 16)); }
        v4u hw, lw;
#pragma unroll
        for (int j = 0; j < 4; ++j) { hw[j] = hi[2 * j] | (hi[2 * j + 1] << 16); lw[j] = lo[2 * j] | (lo[2 * j + 1] << 16); }
        *(v4u*)(Xb + (size_t)row * D + col0 + 32 * s) = hw;
        const bf16x8v ah = __builtin_bit_cast(bf16x8v, hw), al = __builtin_bit_cast(bf16x8v, lw);
        const bf16x8v w0h = *(const LAS bf16x8v*)(wb + 64 * s), w0l = *(const LAS bf16x8v*)(wb + LO + 64 * s);
        const bf16x8v w1h = *(const LAS bf16x8v*)(wb + 16 * RWH_PITCH + 64 * s), w1l = *(const LAS bf16x8v*)(wb + 16 * RWH_PITCH + LO + 64 * s);
        const bf16x8v w2h = *(const LAS bf16x8v*)(wb2 + 64 * s), w2l = *(const LAS bf16x8v*)(wb2 + LO + 64 * s);
        acc0 = __builtin_amdgcn_mfma_f32_16x16x32_bf16(ah, w0h, acc0, 0, 0, 0); acc0 = __builtin_amdgcn_mfma_f32_16x16x32_bf16(al, w0h, acc0, 0, 0, 0); acc0 = __builtin_amdgcn_mfma_f32_16x16x32_bf16(ah, w0l, acc0, 0, 0, 0);
        acc1 = __builtin_amdgcn_mfma_f32_16x16x32_bf16(ah, w1h, acc1, 0, 0, 0); acc1 = __builtin_amdgcn_mfma_f32_16x16x32_bf16(al, w1h, acc1, 0, 0, 0); acc1 = __builtin_amdgcn_mfma_f32_16x16x32_bf16(ah, w1l, acc1, 0, 0, 0);
        acc2 = __builtin_amdgcn_mfma_f32_16x16x32_bf16(ah, w2h, acc2, 0, 0, 0); acc2 = __builtin_amdgcn_mfma_f32_16x16x32_bf16(al, w2h, acc2, 0, 0, 0); acc2 = __builtin_amdgcn_mfma_f32_16x16x32_bf16(ah, w2l, acc2, 0, 0, 0);
    }
    __syncthreads();
#undef XLO
#undef XHI
#pragma unroll
    for (int r = 0; r < 4; ++r) { LAS float* pr = part + (size_t)(wave * 16 + 4 * kq + r) * 48 + (lane & 15); pr[0] = acc0[r]; pr[16] = acc1[r]; pr[32] = acc2[r]; }
    LAS int* rt_e = (LAS int*)(part + 8 * 16 * 48);
    LAS float* rt_g = (LAS float*)(rt_e + 128);
    LAS int* rt_base = (LAS int*)(rt_g + 128);
    __syncthreads();
    if (tid < 64) {
        const int gq = tid >> 4, ii = tid & 15; const LAS float* p0 = part + (size_t)((2 * gq) * 16 + ii) * 48; const LAS float* p1 = p0 + 16 * 48;
        int gi = 0; float gm = -INFINITY, gl[NG];
#pragma unroll
        for (int n = 0; n < NG; ++n) { gl[n] = p0[n] + p1[n] + rgb[n]; if (gl[n] > gm) { gm = gl[n]; gi = n; } }
        float gs = 0.f;
#pragma unroll
        for (int n = 0; n < NG; ++n) gs += __expf(gl[n] - gm);
        const float gtop = 1.0f / gs;
        float m0 = -INFINITY, m1 = -INFINITY; int i0 = 0, i1 = 0;
        for (int n = 0; n < EPG; ++n) { const int c = NG + gi * EPG + n; const float e = p0[c] + p1[c] + reb[gi * EPG + n];
            if (e > m0) { m1 = m0; i1 = i0; m0 = e; i0 = n; } else if (e > m1) { m1 = e; i1 = n; } }
        const float e1 = __expf(m1 - m0), w0 = 1.0f / (1.0f + e1), w1 = e1 * w0;
        rt_e[2 * tid] = gi * EPG + i0; rt_e[2 * tid + 1] = gi * EPG + i1; rt_g[2 * tid] = gtop * w0; rt_g[2 * tid + 1] = gtop * w1;
    }
    __syncthreads();
    if (rep == 0) {
        LAS int* wc = rt_base + NE;
        int my_e = 0, my_rank = 0, my_cnt = 0;
        if (tid < 128) { my_e = rt_e[tid];
            const unsigned long long lt = (1ull << lane) - 1ull;
#pragma unroll 4
            for (int e = 0; e < NE; ++e) { const unsigned long long m = __ballot(my_e == e); if (my_e == e) my_rank = (int)__builtin_popcountll(m & lt); if (lane == e) my_cnt = (int)__builtin_popcountll(m); }
            if (lane < NE) wc[wave * NE + lane] = my_cnt; }
        __syncthreads();
        if (tid < NE) { const int c = wc[tid] + wc[NE + tid]; rt_base[tid] = c ? atomicAdd(&cnt[tid * CNT_STRIDE], c) : 0; }
        __syncthreads();
        if (tid < 128) { const int pair = 2 * (cx.bx * 64 + (tid >> 1)) + (tid & 1);
            perm[my_e * CAP + rt_base[my_e] + my_rank + (wave ? wc[my_e] : 0)] = (v2u){__builtin_bit_cast(unsigned, rt_g[tid]), (unsigned)pair}; }
    }
}
__device__ __forceinline__ void ln_router_phase(LAS unsigned char* lds, int layer, int rep = 0) {
    const ArgsP a = kargs(); const Ctx cx = mkctx(a); const int gw = cx.gw, NGW = cx.NGW, lane = cx.lane;
    unsigned char* ws = cx.ws;
    const bf16* Z = (const bf16*)(ws + LZ(layer)); bf16* Xb = (bf16*)(ws + (layer == 0 ? WS_X1B : WS_X3B));
    const float* g = a->ln1_g + layer * D; const float* b = a->ln1_b + layer * D;
    const float* rgb = a->rg_b + layer * NG; const float* reb = a->re_b + layer * NE;
    int* cnt = (int*)(ws + WS_CTL) + layer * NE * CNT_STRIDE; v2u* perm = (v2u*)(ws + LPERM(layer));
    LAS f32x4* wl = (LAS f32x4*)lds;
    { const f32x4* wg = (const f32x4*)((const float*)(ws + WS_RWT) + (size_t)layer * NRW * D);
      for (int i = cx.tid; i < NRW * D / 4; i += NTHREADS) wl[i] = wg[i]; }
    f32x4 gg[4], bb[4];
#pragma unroll
    for (int j = 0; j < 4; ++j) { gg[j] = *(const f32x4*)(g + 256 * j + 4 * lane); bb[j] = *(const f32x4*)(b + 256 * j + 4 * lane); }
    constexpr int RPW = 16;
    LAS int* rt_row = (LAS int*)(lds + MISC_OFF + 2048);
    LAS int* rt_e = rt_row + NWAVES * RPW;
    LAS float* rt_g = (LAS float*)(rt_e + 2 * NWAVES * RPW);
    LAS int* rt_base = (LAS int*)(rt_g + 2 * NWAVES * RPW);
    LAS int* wave_rows = rt_base + NE;
    f32x4 nv[2][4];
#pragma unroll
    for (int r = 0; r < 2; ++r) { const int row = gw + r * NGW;
        if (row < T) {
#pragma unroll
            for (int j = 0; j < 4; ++j) nv[r][j] = ldz4(Z + (size_t)row * D + 256 * j + 4 * lane);
        } }
    __syncthreads();
    int it = 0;
#pragma unroll 1
    for (int row0 = gw; row0 < T && it < RPW; row0 += 2 * NGW, it += 2) {
        const bool two = row0 + NGW < T;
        f32x4 v[2][4];
#pragma unroll
        for (int r = 0; r < 2; ++r)
#pragma unroll
            for (int j = 0; j < 4; ++j) v[r][j] = nv[r][j];
#pragma unroll
        for (int r = 0; r < 2; ++r) { const int row = row0 + (2 + r) * NGW;
            if (row < T) {
#pragma unroll
                for (int j = 0; j < 4; ++j) nv[r][j] = ldz4(Z + (size_t)row * D + 256 * j + 4 * lane);
            } }
        if (!two) {
#pragma unroll
            for (int j = 0; j < 4; ++j) v[1][j] = v[0][j];
        }
        float s1[2];
#pragma unroll
        for (int r = 0; r < 2; ++r) { float s = 0.f;
#pragma unroll
            for (int j = 0; j < 4; ++j) s += (v[r][j].x + v[r][j].y) + (v[r][j].z + v[r][j].w);
            s1[r] = s; }
        dpp_sum(s1);
        float s2[2];
#pragma unroll
        for (int r = 0; r < 2; ++r) { const float mean = s1[r] * (1.f / D); float q = 0.f;
#pragma unroll
            for (int j = 0; j < 4; ++j) { v[r][j] = v[r][j] - mean; q += (v[r][j].x * v[r][j].x + v[r][j].y * v[r][j].y) + (v[r][j].z * v[r][j].z + v[r][j].w * v[r][j].w); }
            s2[r] = q; }
        dpp_sum(s2);
#pragma unroll
        for (int r = 0; r < 2; ++r) { const float rstd = 1.f / sqrtf(s2[r] * (1.f / D) + LN_EPS);
#pragma unroll
            for (int j = 0; j < 4; ++j) v[r][j] = v[r][j] * rstd * gg[j] + bb[j]; }
#pragma unroll
        for (int r = 0; r < 2; ++r) { const int row = row0 + r * NGW;
            if (r == 0 || two) {
#pragma unroll
                for (int j = 0; j < 4; ++j) { v2u w; w.x = pk2(v[r][j].x, v[r][j].y); w.y = pk2(v[r][j].z, v[r][j].w); *(v2u*)(Xb + (size_t)row * D + 256 * j + 4 * lane) = w; }
            } }
        float gl[2 * NG];
#pragma unroll
        for (int r = 0; r < 2; ++r)
#pragma unroll
            for (int n = 0; n < NG; ++n) gl[r * NG + n] = dot_lds(v[r], wl + n * (D / 4), lane);
        dpp_sum(gl);
        int gi[2]; float gtop[2];
#pragma unroll
        for (int r = 0; r < 2; ++r) { int g_ = 0; float gm = -INFINITY;
#pragma unroll
            for (int n = 0; n < NG; ++n) { gl[r * NG + n] += rgb[n]; if (gl[r * NG + n] > gm) { gm = gl[r * NG + n]; g_ = n; } }
            float gs = 0.f;
#pragma unroll
            for (int n = 0; n < NG; ++n) gs += __expf(gl[r * NG + n] - gm);
            gi[r] = g_; gtop[r] = 1.0f / gs; }
        float el[2 * EPG];
#pragma unroll
        for (int r = 0; r < 2; ++r)
#pragma unroll
            for (int n = 0; n < EPG; ++n) el[r * EPG + n] = dot_lds(v[r], wl + (NG + gi[r] * EPG + n) * (D / 4), lane);
        dpp_sum(el);
#pragma unroll
        for (int r = 0; r < 2; ++r) {
            float m0 = -INFINITY, m1 = -INFINITY; int i0 = 0, i1 = 0;
#pragma unroll
            for (int n = 0; n < EPG; ++n) { const float e = el[r * EPG + n] + reb[gi[r] * EPG + n];
                if (e > m0) { m1 = m0; i1 = i0; m0 = e; i0 = n; } else if (e > m1) { m1 = e; i1 = n; } }
            const float e1 = __expf(m1 - m0), w0 = 1.0f / (1.0f + e1), w1 = e1 * w0;
            if (lane == 0 && (r == 0 || two)) {
                const int li = cx.wave * RPW + it + r;
                rt_row[li] = row0 + r * NGW; rt_e[2 * li] = gi[r] * EPG + i0; rt_e[2 * li + 1] = gi[r] * EPG + i1; rt_g[2 * li] = gtop[r] * w0; rt_g[2 * li + 1] = gtop[r] * w1;
            }
        }
        if (!two) { it += 1; break; }
    }
    if (lane == 0) wave_rows[cx.wave] = it;
    __syncthreads();
    if (rep == 0) {
        if (cx.tid < NE) { int c = 0;
            for (int w = 0; w < NWAVES; ++w) { const int n = wave_rows[w]; for (int i = 0; i < 2 * n; ++i) c += (rt_e[2 * (w * RPW) + i] == cx.tid) ? 1 : 0; }
            rt_base[cx.tid] = c ? atomicAdd(&cnt[cx.tid * CNT_STRIDE], c) : 0; }
        __syncthreads();
        if (cx.tid < 2 * NWAVES * RPW) { const int w = cx.tid / (2 * RPW), i = cx.tid % (2 * RPW);
            if (i < 2 * wave_rows[w]) { const int e = rt_e[cx.tid]; int rank = 0;
                for (int w2 = 0; w2 <= w; ++w2) { const int lim = (w2 < w) ? 2 * wave_rows[w2] : i; for (int q = 0; q < lim; ++q) rank += (rt_e[2 * (w2 * RPW) + q] == e) ? 1 : 0; }
                const int pair = 2 * rt_row[cx.tid >> 1] + (cx.tid & 1);
                perm[e * CAP + rt_base[e] + rank] = (v2u){__builtin_bit_cast(unsigned, rt_g[cx.tid]), (unsigned)pair}; } }
    }
}
__device__ __forceinline__ void ln2_phase(int layer) {
    const ArgsP a = kargs(); const Ctx cx = mkctx(a); const int gw = cx.gw, NGW = cx.NGW, lane = cx.lane;
    unsigned char* ws = cx.ws;
    const bf16* Xin = (const bf16*)(ws + (layer == 0 ? WS_X1B : WS_X3B)); const bf16* YP = (const bf16*)(ws + LYP(layer));
    const float* g = a->ln2_g + layer * D; const float* b = a->ln2_b + layer * D;
    f32x4 gg[4], bb[4];
#pragma unroll
    for (int j = 0; j < 4; ++j) { gg[j] = *(const f32x4*)(g + 256 * j + 4 * lane); bb[j] = *(const f32x4*)(b + 256 * j + 4 * lane); }
    v2u nx[4], ny0[4], ny1[4];
    if (gw < T) {
#pragma unroll
        for (int j = 0; j < 4; ++j) { const size_t c = 256 * j + 4 * lane;
            nx[j] = *(const v2u*)(Xin + (size_t)gw * D + c); ny0[j] = *(const v2u*)(YP + (size_t)(2 * gw) * D + c); ny1[j] = *(const v2u*)(YP + (size_t)(2 * gw + 1) * D + c); }
    }
#pragma unroll 1
    for (int row = gw; row < T; row += NGW) {
        f32x4 v[4];
#pragma unroll
        for (int j = 0; j < 4; ++j) { const v2u xw = nx[j], y0 = ny0[j], y1 = ny1[j];
            v[j].x = ALPHA * bflo(xw.x) + (bflo(y0.x) + bflo(y1.x)); v[j].y = ALPHA * bfhi(xw.x) + (bfhi(y0.x) + bfhi(y1.x));
            v[j].z = ALPHA * bflo(xw.y) + (bflo(y0.y) + bflo(y1.y)); v[j].w = ALPHA * bfhi(xw.y) + (bfhi(y0.y) + bfhi(y1.y)); }
        if (row + NGW < T) { const int r2 = row + NGW;
#pragma unroll
            for (int j = 0; j < 4; ++j) { const size_t c = 256 * j + 4 * lane;
                nx[j] = *(const v2u*)(Xin + (size_t)r2 * D + c); ny0[j] = *(const v2u*)(YP + (size_t)(2 * r2) * D + c); ny1[j] = *(const v2u*)(YP + (size_t)(2 * r2 + 1) * D + c); }
        }
        ln_rows(v, gg, bb);
        if (layer == 0) {
#pragma unroll
            for (int j = 0; j < 4; ++j) { v2u w; w.x = pk2(v[j].x, v[j].y); w.y = pk2(v[j].z, v[j].w); *(v2u*)((bf16*)(ws + WS_X2B) + (size_t)row * D + 256 * j + 4 * lane) = w; }
        } else {
#pragma unroll
            for (int j = 0; j < 4; ++j) *(f32x4*)(a->out + (size_t)row * D + 256 * j + 4 * lane) = v[j];
        }
    }
}
__device__ __forceinline__ void conv_phase() {
    const ArgsP a = kargs(); const Ctx cx = mkctx(a); const int gtid = cx.bx * NTHREADS + cx.tid, NGT = cx.G * NTHREADS;
    unsigned char* ws = cx.ws;
    const bf16* GB = (const bf16*)(ws + WS_GB); const bf16* U = (const bf16*)(ws + WS_U); bf16* A2 = (bf16*)(ws + WS_A2);
    for (int it = gtid; it < T * (D / 8); it += NGT) {
        const int t = it >> 7, d0 = (it & 127) * 8, s = t & (SEQ - 1);
        const size_t o = (size_t)t * D + d0;
        const v4u g = *(const v4u*)(GB + o), u0 = *(const v4u*)(U + o);
        v4u u1 = (v4u){0u, 0u, 0u, 0u}, u2 = u1;
        if (s >= 1) u1 = *(const v4u*)(U + o - D);
        if (s >= 2) u2 = *(const v4u*)(U + o - 2 * D);
        const f32x4 wa0 = *(const f32x4*)(a->a_conv_w + d0), wa1 = *(const f32x4*)(a->a_conv_w + d0 + 4), wb0 = *(const f32x4*)(a->a_conv_w + D + d0), wb1 = *(const f32x4*)(a->a_conv_w + D + d0 + 4);
        const f32x4 wc0 = *(const f32x4*)(a->a_conv_w + 2 * D + d0), wc1 = *(const f32x4*)(a->a_conv_w + 2 * D + d0 + 4);
        const float w0[8] = {wa0.x, wa0.y, wa0.z, wa0.w, wa1.x, wa1.y, wa1.z, wa1.w}, w1[8] = {wb0.x, wb0.y, wb0.z, wb0.w, wb1.x, wb1.y, wb1.z, wb1.w}, w2[8] = {wc0.x, wc0.y, wc0.z, wc0.w, wc1.x, wc1.y, wc1.z, wc1.w};
        v4u r;
#pragma unroll
        for (int q = 0; q < 4; ++q) {
            const float c0 = w0[2 * q] * bflo(u2[q]) + w1[2 * q] * bflo(u1[q]) + w2[2 * q] * bflo(u0[q]);
            const float c1 = w0[2 * q + 1] * bfhi(u2[q]) + w1[2 * q + 1] * bfhi(u1[q]) + w2[2 * q + 1] * bfhi(u0[q]);
            r[q] = pk2(bflo(g[q]) * c0, bfhi(g[q]) * c1);
        }
        *(v4u*)(A2 + o) = r;
    }
}
__device__ __forceinline__ void combine_phase() {
    const ArgsP a = kargs(); const Ctx cx = mkctx(a); const int gw = cx.gw, NGW = cx.NGW, lane = cx.lane;
    unsigned char* ws = cx.ws;
    const bf16* O0 = (const bf16*)(ws + WS_O0); const bf16* O1 = (const bf16*)(ws + WS_O1); bf16* A3 = (bf16*)(ws + WS_A3);
    const float l01 = wave_sum(a->b_lambda[lane] * a->b_lambda[64 + lane]), l23 = wave_sum(a->b_lambda[128 + lane] * a->b_lambda[192 + lane]);
    const float lam = __expf(l01) - __expf(l23) + LAM_INIT;
    float gsc[16];
#pragma unroll
    for (int i = 0; i < 16; ++i) gsc[i] = a->b_subln_g[(lane & 7) * 16 + i] * (1.0f - LAM_INIT);
    for (int row = gw; row < T; row += NGW) {
        const size_t o = (size_t)row * D + lane * 16;
        const v4u p0 = *(const v4u*)(O0 + o), p1 = *(const v4u*)(O0 + o + 8), q0 = *(const v4u*)(O1 + o), q1 = *(const v4u*)(O1 + o + 8);
        float d[16]; float ss = 0.f;
#pragma unroll
        for (int i = 0; i < 4; ++i) { d[2 * i] = bflo(p0[i]) - lam * bflo(q0[i]); d[2 * i + 1] = bfhi(p0[i]) - lam * bfhi(q0[i]);
            d[8 + 2 * i] = bflo(p1[i]) - lam * bflo(q1[i]); d[8 + 2 * i + 1] = bfhi(p1[i]) - lam * bfhi(q1[i]); }
#pragma unroll
        for (int i = 0; i < 16; ++i) ss += d[i] * d[i];
        ss += __shfl_xor(ss, 1); ss += __shfl_xor(ss, 2); ss += __shfl_xor(ss, 4);
        const float r = 1.0f / sqrtf(ss * (1.0f / 128.0f) + RMS_EPS);
        v4u w0, w1;
#pragma unroll
        for (int i = 0; i < 4; ++i) { w0[i] = pk2(d[2 * i] * r * gsc[2 * i], d[2 * i + 1] * r * gsc[2 * i + 1]); w1[i] = pk2(d[8 + 2 * i] * r * gsc[8 + 2 * i], d[8 + 2 * i + 1] * r * gsc[8 + 2 * i + 1]); }
        *(v4u*)(A3 + o) = w0; *(v4u*)(A3 + o + 8) = w1;
    }
}

#ifndef MKMASK
#define MKMASK 0xffff
#endif
#ifndef MKREP
#define MKREP 0
#endif
#ifndef MKSYNC
#define MKSYNC 0
#endif
#ifndef MKMASK2
#define MKMASK2 MKMASK
#endif
#define PH(k) _Pragma("unroll 1") for (int rep_ = 0; rep_ < (int)(((pass_ ? MKMASK2 : MKMASK) >> (k)) & 1) + (int)((MKREP >> (k)) & 1); ++rep_)
#define XB_TMO      128
#define XB_XCNT(j)  (256  + 64 * (j))
#define XB_XSUB(j)  (1280 + 64 * (j))
#define XB_XGEN(j)  (2304 + 64 * (j))
#define XB_TOP      3328
#define XB_TOPGEN   3392
#define XCD_BAR_WORDS 3456
#define XB_SPIN_CAP (1u << 18)

__device__ __forceinline__ unsigned xb_ld(unsigned* p)              { return __hip_atomic_load(p, __ATOMIC_RELAXED, __HIP_MEMORY_SCOPE_AGENT); }
__device__ __forceinline__ unsigned xb_add(unsigned* p, unsigned v) { return __hip_atomic_fetch_add(p, v, __ATOMIC_RELAXED, __HIP_MEMORY_SCOPE_AGENT); }
__device__ __forceinline__ unsigned xb_xcc_id() { return (unsigned)__builtin_amdgcn_s_getreg((3 << 11) | 20) & 0xFu; }
#define XB_SPIN(cond, bar) do { unsigned _sp = 0; while (cond) { __builtin_amdgcn_s_sleep(1); \
    if ((++_sp & 255u) == 0u) { if (xb_ld(&(bar)[XB_TMO])) break; if (_sp > XB_SPIN_CAP) { atomicAdd(&(bar)[XB_TMO], 1u); break; } } } } while (0)

struct XcdBarrier {
    unsigned* bar; unsigned x;
    volatile LAS unsigned* st;
};

__device__ __forceinline__ XcdBarrier xcd_barrier_post(unsigned* bar, volatile LAS unsigned* st) {
    XcdBarrier b; b.bar = bar; b.x = xb_xcc_id(); b.st = st;
    if (threadIdx.x == 0) (void)xb_add(&bar[XB_XCNT(b.x)], 1u);
    return b;
}
__device__ __forceinline__ void xcd_barrier_complete(unsigned* bar, unsigned x, unsigned& nloc, unsigned& nx) {
    const unsigned G = gridDim.x * gridDim.y * gridDim.z;
    unsigned sum, cnt, mine, sp = 0u;
    for (;;) {
        sum = 0u; cnt = 0u; mine = 0u;
#pragma unroll
        for (unsigned j = 0; j < 16; ++j) { const unsigned c = xb_ld(&bar[XB_XCNT(j)]); sum += c; cnt += (c > 0u) ? 1u : 0u; mine = (j == x) ? c : mine; }
        if (sum == G) break;
        __builtin_amdgcn_s_sleep(1);
        if ((++sp & 255u) == 0u) { if (xb_ld(&bar[XB_TMO])) break; if (sp > XB_SPIN_CAP) { atomicAdd(&bar[XB_TMO], 1u); break; } }
    }
    nloc = mine > 0u ? mine : 1u; nx = cnt > 0u ? cnt : 1u;
}

__device__ __forceinline__ void xcd_barrier(const XcdBarrier& b) {
    asm volatile("s_waitcnt vmcnt(0)" ::: "memory");
    __syncthreads();
    if (threadIdx.x == 0) {
        unsigned* bar = b.bar;
        __builtin_amdgcn_s_waitcnt(0);
        unsigned nloc = b.st[0], nx = b.st[1];
        if (nloc == 0u) { xcd_barrier_complete(bar, b.x, nloc, nx); b.st[0] = nloc; b.st[1] = nx; }
        const unsigned old = xb_add(&bar[XB_XSUB(b.x)], 1u);
        const unsigned gen = old / nloc;
        if (old + 1u == (gen + 1u) * nloc) {
            __builtin_amdgcn_fence(__ATOMIC_RELEASE, "agent");
            asm volatile("s_waitcnt vmcnt(0)" ::: "memory");
            const unsigned og = xb_add(&bar[XB_TOP], 1u);
            const unsigned tg = og / nx;
            if (og + 1u == (tg + 1u) * nx) xb_add(&bar[XB_TOPGEN], 1u);
            else XB_SPIN(xb_ld(&bar[XB_TOPGEN]) == tg, bar);
            __builtin_amdgcn_fence(__ATOMIC_ACQUIRE, "agent");
            xb_add(&bar[XB_XGEN(b.x)], 1u);
            asm volatile("s_waitcnt vmcnt(0)" ::: "memory");
        } else {
            XB_SPIN(xb_ld(&bar[XB_XGEN(b.x)]) == gen, bar);
            __builtin_amdgcn_fence(__ATOMIC_ACQUIRE, "agent");
            asm volatile("s_waitcnt vmcnt(0)" ::: "memory");
        }
    }
    __syncthreads();
}

constexpr int CW_BAR = 16384;
constexpr int ST_OFF = MISC_OFF + 1024;
__device__ __forceinline__ void seam(LAS unsigned char* lds) { const ArgsP a = kargs(); XcdBarrier b; b.bar = (unsigned*)(a->ws + WS_CTL) + CW_BAR; b.x = xb_xcc_id(); b.st = (volatile LAS unsigned*)(lds + ST_OFF); xcd_barrier(b); }
__device__ __forceinline__ void gemm1_phase(LAS unsigned char* lds) { const ArgsP a = kargs(); const Ctx cx = mkctx(a); unsigned char* ws = cx.ws;
    const int ng = ROLE_SPLIT ? cx.G - cx.G / 4 : cx.G;
    if (cx.bx < ng) { SchedDense S{ng, cx.bx, 12, 0, D, (const char*)(ws + WS_W1T)}; EpiConvIn E{(bf16*)(ws + WS_GB), (bf16*)(ws + WS_U)};
        pg8::gemm_phase(lds, (const char*)(ws + WS_XB), D, S, E); }
    else p0_items(lds, PS1 + P0A_EXTRA, P0_NITEMS, (cx.bx - ng) * NWAVES + cx.wave, (cx.G - ng) * NWAVES); }
__device__ __forceinline__ void gemm2_phase(LAS unsigned char* lds) { const ArgsP a = kargs(); const Ctx cx = mkctx(a); unsigned char* ws = cx.ws;
    SchedDense S{cx.G, cx.bx, 4, 1, D, (const char*)(ws + WS_W2T)}; EpiResZ<true> E{(const void*)(ws + WS_XB), (bf16*)(ws + LZ(0))};
    pg8::gemm_phase(lds, (const char*)(ws + WS_A2), D, S, E); }
__device__ __forceinline__ void kvq_phase(LAS unsigned char* lds) { const ArgsP a = kargs(); const Ctx cx = mkctx(a); unsigned char* ws = cx.ws;
    SchedDense S{cx.G, cx.bx, 12, 1, D, (const char*)(ws + WS_WKVQ)}; EpiKVQ E{(bf16*)(ws + WS_K)};
    pg8::gemm_phase(lds, (const char*)(ws + WS_X2B), D, S, E); }
__device__ __forceinline__ void wo_phase(LAS unsigned char* lds) { const ArgsP a = kargs(); const Ctx cx = mkctx(a); unsigned char* ws = cx.ws;
    SchedDense S{cx.G, cx.bx, 4, 1, D, (const char*)(ws + WS_WOT)}; EpiResZ<true> E{(const void*)(ws + WS_X2B), (bf16*)(ws + LZ(1))};
    pg8::gemm_phase(lds, (const char*)(ws + WS_A3), D, S, E); }
#ifndef ATTN128
#define ATTN128 1
#endif
#if ATTN128
__device__ __forceinline__ void attn_phase(char* lds_generic) { const ArgsP a = kargs(); const Ctx cx = mkctx(a); unsigned char* ws = cx.ws;
    const float l01 = dpp_sum1(a->b_lambda[cx.lane] * a->b_lambda[64 + cx.lane]), l23 = dpp_sum1(a->b_lambda[128 + cx.lane] * a->b_lambda[192 + cx.lane]);
    const float lam = __expf(l01) - __expf(l23) + LAM_INIT;
#pragma unroll 1
    for (int uix = cx.bx; uix < BATCH * NH * 4 * 2; uix += cx.G) {
        const int bh = (uix & 255) >> 2, j = uix & 3, qi = uix >> 8;
        const int b = bh >> 3, h = bh & 7, qb = qi == 0 ? j : 7 - j;
        const attn128::bf16* K0 = (const attn128::bf16*)(ws + WS_K) + h * 128;
        const attn128::bf16* Vc = (const attn128::bf16*)(ws + WS_V) + h * 128;
        attn128::bf16* Ac = (attn128::bf16*)(ws + WS_A3) + h * 128;
        attn128::attn_unit<8, 1>((long)b * SEQ, qb, K0 + (WS_Q - WS_K) / 2, K0, Vc, Ac, lds_generic, 0.f, nullptr, 0.f, 0.f);
        attn128::attn_unit<8, 2>((long)b * SEQ, qb, K0 + 64 + (WS_Q - WS_K) / 2, K0 + 64, Vc, Ac, lds_generic, lam, a->b_subln_g, 1.0f - LAM_INIT, RMS_EPS);
    }
}
#else
__device__ __forceinline__ void attn_phase(char* lds_generic) { const ArgsP a = kargs(); const Ctx cx = mkctx(a); unsigned char* ws = cx.ws;
#pragma unroll 1
    for (int uix = cx.bx; uix < BATCH * NH * 4 * (SEQ / 256); uix += cx.G) {
        const int combo = uix & 255, qi = uix >> 8;
        const int b = combo >> 5, h = (combo >> 2) & 7, c = (combo >> 1) & 1, vh = combo & 1;
        const int qb = (qi & 1) ? (SEQ / 256 - 1 - (qi >> 1)) : (qi >> 1);
        const attn_body::bf16* QK = (const attn_body::bf16*)(ws + WS_K) + h * 128 + c * 64;
        const attn_body::bf16* Vc = (const attn_body::bf16*)(ws + WS_V) + h * 128 + vh * 64;
        attn_body::bf16* Oc = (attn_body::bf16*)(ws + (c ? WS_O1 : WS_O0)) + h * 128 + vh * 64;
        attn_body::attn_unit<8>((long)b * SEQ, qb, QK + (WS_Q - WS_K) / 2, QK, Vc, Oc, lds_generic);
    }
}
#endif
__device__ __forceinline__ int scan_excl32(int v, int lane) {
    int x = v;
#pragma unroll
    for (int o = 1; o < 32; o <<= 1) { const int y = __shfl_up(x, o); if ((lane & 31) >= o) x += y; }
    return x - v;
}
__device__ __forceinline__ void moe_tables(LAS unsigned char* lds, int layer) { const ArgsP a = kargs(); const Ctx cx = mkctx(a); LAS int* misc = (LAS int*)(lds + MISC_OFF);
    const int* cnt = (const int*)(cx.ws + WS_CTL) + layer * NE * CNT_STRIDE;
    if (cx.tid < 64) {
        const int e = cx.lane, cn = e < NE ? __hip_atomic_load(cnt + e * CNT_STRIDE, __ATOMIC_RELAXED, __HIP_MEMORY_SCOPE_AGENT) : 0;
        const int rt = (cn + 255) >> 8, half = (cn > 0 && ((cn - 1) & 255) < 128) ? 1 : 0;
        const int uf = e < NE ? 4 * (rt - half) : 0, uh = e < NE ? 4 * half : 0, pr = e < NE ? 256 * rt : 0;
        const int sf = scan_excl32(uf, e), sh = scan_excl32(uh, e), sp = scan_excl32(pr, e);
        const int totf = __shfl(sf + uf, 31), toth = __shfl(sh + uh, 31), totp = __shfl(sp + pr, 31);
        if (e < NE) { misc[e] = sf; misc[NE + e] = totf + sh; misc[128 + e] = cn; misc[192 + e] = sp; }
        if (e == 0) { misc[2 * NE] = totf + toth; misc[192 + NE] = totp; }
    }
    __syncthreads(); }
constexpr int CW_READY = 4096;
__device__ __forceinline__ void moe_up_phase(LAS unsigned char* lds, int layer, bool merged) { const ArgsP a = kargs(); const Ctx cx = mkctx(a); unsigned char* ws = cx.ws; LAS int* misc = (LAS int*)(lds + MISC_OFF);
    const MoeTab tb{misc, misc + 192, misc + 128};
    SchedMoe S{cx.G, cx.bx, D, true, (const char*)(ws + WS_WUT) + (size_t)layer * NE * D * D * 2, (const v2u*)(ws + LPERM(layer)), tb, (unsigned*)(ws + WS_CTL) + CW_READY, merged ? 1 : 0, 0, 0};
    if (merged) { EpiUp<true> E{(bf16*)(ws + LACT(layer))}; pg8::gemm_phase(lds, (const char*)(ws + (layer == 0 ? WS_X1B : WS_X3B)), D, S, E); }
    else { EpiUp<false> E{(bf16*)(ws + LACT(layer))}; pg8::gemm_phase(lds, (const char*)(ws + (layer == 0 ? WS_X1B : WS_X3B)), D, S, E); } }
__device__ __forceinline__ void moe_down_phase(LAS unsigned char* lds, int layer, bool merged) { const ArgsP a = kargs(); const Ctx cx = mkctx(a); unsigned char* ws = cx.ws; LAS int* misc = (LAS int*)(lds + MISC_OFF);
    const MoeTab tb{misc, misc + 192, misc + 128};
    int nb = 0;
    if (merged) { const int U = misc[2 * NE], rem = U % cx.G; nb = rem ? cx.G - rem : 0; }
    SchedMoe S{cx.G, cx.bx, DE, false, (const char*)(ws + WS_WDT) + (size_t)layer * NE * D * DE * 2, (const v2u*)(ws + LPERM(layer)), tb, (unsigned*)(ws + WS_CTL) + CW_READY, merged ? 2 : 0, 0, nb};
    EpiDown E{(bf16*)(ws + LYP(layer)), (const v2u*)(ws + LPERM(layer))};
    pg8::gemm_phase(lds, (const char*)(ws + LACT(layer)), DE, S, E); }

__global__ void __launch_bounds__(NTHREADS, 2) fwd_megakernel(Args args_unused) {
    extern __shared__ __attribute__((aligned(16))) unsigned char lds_raw[];
#ifdef NOSYNC
    struct { __device__ void sync() const {} } grid;
#else
    cg::grid_group grid = cg::this_grid();
#endif
#define SEAM() seam(lds)
    LAS unsigned char* lds = (LAS unsigned char*)lds_raw;
#ifndef MKPASS
#define MKPASS 1
#endif
    { const ArgsP a = kargs(); int t = threadIdx.x; asm volatile("" : "+v"(t));
      if (t < 2) ((volatile LAS unsigned*)(lds + ST_OFF))[t] = 0u;
      __syncthreads();
      (void)xcd_barrier_post((unsigned*)(a->ws + WS_CTL) + CW_BAR, (volatile LAS unsigned*)(lds + ST_OFF));
      if (a->ws == nullptr) grid.sync(); }
#pragma unroll 1
    for (int pass_ = 0; pass_ < MKPASS; ++pass_) {
    if (pass_) SEAM();
    PH(0) p0_prologue(lds);
    SEAM();
    PH(1) gemm1_phase(lds);
    SEAM();
    PH(2) conv_phase();
    SEAM();
    PH(3) gemm2_phase(lds);
    SEAM();
    PH(8) ln_router_mfma(lds, 0, rep_ + pass_);
    SEAM();
    moe_tables(lds, 0);
    PH(9) { moe_up_phase(lds, 0, false); if (P0B_FILL && pass_ == 0) p0b_idle_fill(lds, 0, P0B_SPLIT); }
    SEAM();
    PH(10) { moe_down_phase(lds, 0, false); if (P0B_FILL && pass_ == 0) p0b_idle_fill(lds, P0B_SPLIT, P0B_ITEMS); }
    SEAM();
    PH(11) ln2_phase(0);
    SEAM();
    PH(4) kvq_phase(lds);
    SEAM();
    PH(5) attn_phase((char*)lds_raw);
    SEAM();
#if !ATTN128
    PH(6) combine_phase();
    SEAM();
#endif
    PH(7) wo_phase(lds);
    SEAM();
    PH(8) ln_router_mfma(lds, 1, rep_ + pass_);
    SEAM();
    moe_tables(lds, 1);
#if MOE_MERGE
    PH(9) moe_up_phase(lds, 1, pass_ == 0);
    if (pass_) SEAM();
    PH(10) moe_down_phase(lds, 1, pass_ == 0);
#else
    PH(9) moe_up_phase(lds, 1, false);
    SEAM();
    PH(10) moe_down_phase(lds, 1, false);
#endif
    SEAM();
    PH(11) ln2_phase(1);
    }
#pragma unroll 1
    for (int i = 0; i < MKSYNC; ++i) SEAM();
}
}

extern "C" void kernel_launch(void* const* d_in, const int* in_sizes, int n_in, void* d_out, int out_size, void* d_ws, size_t ws_size, hipStream_t stream) {
    using namespace mk;
    static int grid = 0;
    if (grid == 0) {
        if (n_in != 19 || out_size != T * D || ws_size < WS_END) { fprintf(stderr, "kernel_launch: unexpected shapes / workspace (n_in %d out %d ws %zu, need %zu)\n", n_in, out_size, ws_size, (size_t)WS_END); grid = -1; return; }
        int dev = 0, cus = 0, per_cu = 0;
        (void)hipGetDevice(&dev); (void)hipDeviceGetAttribute(&cus, hipDeviceAttributeMultiprocessorCount, dev);
        if (hipFuncSetAttribute((const void*)fwd_megakernel, hipFuncAttributeMaxDynamicSharedMemorySize, LDS_BYTES) != hipSuccess) { fprintf(stderr, "kernel_launch: hipFuncSetAttribute failed\n"); grid = -1; return; }
        if (hipOccupancyMaxActiveBlocksPerMultiprocessor(&per_cu, (const void*)fwd_megakernel, NTHREADS, LDS_BYTES) != hipSuccess || per_cu < 1) { fprintf(stderr, "kernel_launch: occupancy query says %d blocks per CU\n", per_cu); grid = -1; return; }
        grid = cus * 1;
        if (grid != T / 64) { fprintf(stderr, "kernel_launch: this build needs exactly %d workgroups (one per CU of a 256-CU MI355X: the LN1 + router phase gives each 64 rows); device has %d CUs\n", T / 64, cus); grid = -1; return; }
        (void)hipGetLastError();
    }
    if (grid < 0) return;
    if (hipMemsetAsync((char*)d_ws + WS_CTL, 0, (size_t)(CW_BAR + XCD_BAR_WORDS) * 4, stream) != hipSuccess) { fprintf(stderr, "kernel_launch: hipMemsetAsync of the control words failed\n"); return; }
    Args a{};
    a.x = (const float*)d_in[0]; a.a_w_in = (const float*)d_in[1]; a.a_conv_w = (const float*)d_in[2]; a.a_w_out = (const float*)d_in[3]; a.kv_w = (const float*)d_in[4];
    a.b_w_q = (const float*)d_in[5]; a.b_lambda = (const float*)d_in[6]; a.b_subln_g = (const float*)d_in[7]; a.b_w_o = (const float*)d_in[8];
    a.ln1_g = (const float*)d_in[9]; a.ln1_b = (const float*)d_in[10]; a.ln2_g = (const float*)d_in[11]; a.ln2_b = (const float*)d_in[12];
    a.rg_w = (const float*)d_in[13]; a.rg_b = (const float*)d_in[14]; a.re_w = (const float*)d_in[15]; a.re_b = (const float*)d_in[16];
    a.e_w_in = (const float*)d_in[17]; a.e_w_down = (const float*)d_in[18];
    a.out = (float*)d_out; a.ws = (unsigned char*)d_ws;
    void* kargs[] = {&a};
    const hipError_t e = hipLaunchCooperativeKernel((const void*)fwd_megakernel, dim3(grid), dim3(NTHREADS), kargs, LDS_BYTES, stream);
    if (e != hipSuccess) fprintf(stderr, "kernel_launch: cooperative launch failed: %s (grid %d)\n", hipGetErrorString(e), grid);
}
```

```cpp
#include <hip/hip_runtime.h>
#include <hip/hip_cooperative_groups.h>
#include <cstdio>
#include <cstdint>
namespace cg = cooperative_groups;

namespace pg8 {
#define PG8_LAS __attribute__((address_space(3)))
typedef unsigned short bf16_t;
typedef short bf16x8 __attribute__((ext_vector_type(8)));
typedef float f32x4 __attribute__((ext_vector_type(4)));
typedef unsigned u32x4 __attribute__((ext_vector_type(4)));
typedef unsigned u32x2 __attribute__((ext_vector_type(2)));
constexpr int BM = 256, BK = 64, HALF = 128, HTB = HALF * BK * 2  , STAGE_BYTES = 8 * HTB, NXCD = 8, WGM = 8;

__host__ __device__ __forceinline__ int lds_byte(int r, int c) { const int st = (r >> 4) * 2 + (c >> 5), rr = r & 15, cc = c & 31, ob = rr * 64 + cc * 2; return st * 1024 + (ob ^ (((ob >> 9) & 1) << 5)); }
__host__ __device__ __forceinline__ void stage_rc(int b, int& R, int& C) { const int st = b / 1024, sb = b % 1024, swz = sb ^ (((sb >> 9) & 1) << 5); R = (st >> 1) * 16 + swz / 64; C = (st & 1) * 32 + (swz % 64) / 2; }
__host__ __device__ __forceinline__ int perm32(int rho) { const int n = rho >> 4, i = rho & 15; return 8 * (i >> 2) + 4 * n + (i & 3); }

struct Unit { const char* b0; const char* b1; int arow; int p0, p1, p2, p3; };

__device__ __forceinline__ bool static_tile(int i, int G, int c, int nM, int nN, int& pm, int& pn) {
    const int nwg = nM * nN; const long L = (long)i * G + c; if (L >= nwg) return false;
    int wgid = (int)L; { const int q = nwg / NXCD, r = nwg % NXCD, xcd = wgid % NXCD, off = wgid / NXCD; wgid = (xcd < r ? xcd * (q + 1) : r * (q + 1) + (xcd - r) * q) + off; }
    const int nig = WGM * nN, gid = wgid / nig, fm = gid * WGM, gsz = (nM - fm) < WGM ? (nM - fm) : WGM;
    pm = fm + ((wgid % nig) % gsz); pn = (wgid % nig) / gsz; return true;
}

__device__ __forceinline__ unsigned cvt_pk_bf16(float lo, float hi) { unsigned r; asm volatile("v_cvt_pk_bf16_f32 %0, %1, %2" : "=v"(r) : "v"(lo), "v"(hi)); return r; }

template <class Epi, class Sched>
__device__ __forceinline__ void gemm_phase(PG8_LAS unsigned char* lds, const char* Abase, const int K, const Sched& S, const Epi& E) {
    int tid_ = threadIdx.x; asm volatile("" : "+v"(tid_));
    const int tid = tid_, wid = __builtin_amdgcn_readfirstlane(tid >> 6), lane = tid & 63, wr = wid >> 2, wc = wid & 3, fr = lane & 15, fq = lane >> 4;
    const int nt = K / BK;
    int R[2], C[2]; unsigned voffB[2];
#pragma unroll
    for (int i = 0; i < 2; ++i) { stage_rc(tid * 16 + i * 8192, R[i], C[i]); const int Rb = Epi::PERM ? ((R[i] & ~31) + perm32(R[i] & 31)) : R[i]; voffB[i] = (unsigned)(Rb * K + C[i]) * 2u; }
    const size_t kstep = (size_t)(BK * 2);
    const unsigned ldsw = (unsigned)wid * 1024u;
    const int aoff = lds_byte(wr * 64 + fr, fq * 8), boff = lds_byte(wc * 32 + fr, fq * 8);
#define PG8_SA(b, h) (((b) * 2 + (h)) * HTB)
#define PG8_SB(b, h) ((4 + (b) * 2 + (h)) * HTB)
#define PG8_STAGE(bufoff, gbase, v0, v1) do { \
        __builtin_amdgcn_global_load_lds((const unsigned*)((const char*)(gbase) + (v0)), (PG8_LAS unsigned*)(lds + (bufoff) + ldsw), 16, 0, 0); \
        __builtin_amdgcn_global_load_lds((const unsigned*)((const char*)(gbase) + (v1)), (PG8_LAS unsigned*)(lds + (bufoff) + ldsw + 8192), 16, 0, 0); } while (0)
#define PG8_STAGEB(bufoff, gbase) PG8_STAGE(bufoff, gbase, voffB[0], voffB[1])
#define PG8_LDA(dst, b, h) do { _Pragma("unroll") for (int m = 0; m < 4; ++m) _Pragma("unroll") for (int k = 0; k < 2; ++k) dst[m][k] = *(const PG8_LAS bf16x8*)(lds + PG8_SA(b, h) + aoff + m * 2048 + k * 1024); } while (0)
#define PG8_LDB(dst, b, h) do { _Pragma("unroll") for (int n = 0; n < 2; ++n) _Pragma("unroll") for (int k = 0; k < 2; ++k) dst[n][k] = *(const PG8_LAS bf16x8*)(lds + PG8_SB(b, h) + boff + n * 2048 + k * 1024); } while (0)
#define PG8_MMA(ai, bj, At, Bt) do { __builtin_amdgcn_s_setprio(1); _Pragma("unroll") for (int m = 0; m < 4; ++m) _Pragma("unroll") for (int n = 0; n < 2; ++n) _Pragma("unroll") for (int k = 0; k < 2; ++k) \
        acc[ai][bj][m][n] = __builtin_amdgcn_mfma_f32_16x16x32_bf16(Bt[n][k], At[m][k], acc[ai][bj][m][n], 0, 0, 0); __builtin_amdgcn_s_setprio(0); } while (0)
#define PG8_WAIT_V(n) asm volatile("s_waitcnt vmcnt(" #n ")" ::: "memory")
#define PG8_WAIT_L(n) asm volatile("s_waitcnt lgkmcnt(" #n ")" ::: "memory")
#define PG8_BAR __builtin_amdgcn_s_barrier()
#define PG8_SCHED __builtin_amdgcn_sched_barrier(0)
    Unit cur, nxt; int ui = 0;
    if (!S.next(0, cur)) return;
    f32x4 acc[2][2][4][2];
#pragma unroll
    for (int a = 0; a < 2; ++a)
#pragma unroll
        for (int b = 0; b < 2; ++b)
#pragma unroll
            for (int m = 0; m < 4; ++m)
#pragma unroll
                for (int n = 0; n < 2; ++n) acc[a][b][m][n] = (f32x4){0.f, 0.f, 0.f, 0.f};
    bf16x8 At[4][2], B0[2][2], B1[2][2];
    unsigned vA00, vA01, vA10, vA11, vN00, vN01, vN10, vN11;
    S.a_ready(cur, S.peek(cur));
    S.a_offs(cur, R, C, vA00, vA01, vA10, vA11);
    const char* cB0 = cur.b0; const char* cB1 = cur.b1;
    PG8_STAGEB(PG8_SB(0, 0), cB0); PG8_STAGEB(PG8_SB(0, 1), cB1); PG8_STAGE(PG8_SA(0, 0), Abase, vA00, vA01); PG8_STAGE(PG8_SA(0, 1), Abase, vA10, vA11);
    if (wr == 1) PG8_BAR;
    PG8_WAIT_V(2); PG8_BAR;
    PG8_STAGEB(PG8_SB(1, 0), cB0 + kstep); PG8_STAGE(PG8_SA(1, 0), Abase + kstep, vA00, vA01); PG8_STAGEB(PG8_SB(1, 1), cB1 + kstep);
    PG8_WAIT_V(6); PG8_BAR;
    for (;;) {
        const bool has_next = S.next(ui + 1, nxt);
        if (has_next) S.a_offs(nxt, R, C, vN00, vN01, vN10, vN11); else { vN00 = vA00; vN01 = vA01; vN10 = vA10; vN11 = vA11; }
        const char* nB0 = has_next ? nxt.b0 : cB0; const char* nB1 = has_next ? nxt.b1 : cB1;
        const unsigned pk = has_next ? S.peek(nxt) : 0u;
        const bool skip1 = S.half_only(cur);
        for (int t = 0; t < nt; t += 2) {
            const bool last = (t == nt - 2);
            if (last && has_next) S.a_ready(nxt, pk);
            const char* a1 = Abase + (size_t)(t + 1) * kstep;
            PG8_LDB(B0, 0, 0); PG8_LDB(B1, 0, 1); PG8_SCHED; PG8_LDA(At, 0, 0); PG8_STAGE(PG8_SA(1, 1), a1, vA10, vA11);
            PG8_WAIT_V(8); PG8_WAIT_L(0); PG8_BAR; PG8_MMA(0, 0, At, B0); PG8_MMA(0, 1, At, B1); PG8_BAR; PG8_SCHED;
            if (last) { vA00 = vN00; vA01 = vN01; vA10 = vN10; vA11 = vN11; }
            const char* a2 = last ? Abase : Abase + (size_t)(t + 2) * kstep;
            const char* b20 = last ? nB0 : cB0 + (size_t)(t + 2) * kstep; const char* b21 = last ? nB1 : cB1 + (size_t)(t + 2) * kstep;
            const char* a3 = a2 + kstep; const char* b30 = b20 + kstep; const char* b31 = b21 + kstep;
            PG8_LDA(At, 0, 1); PG8_STAGEB(PG8_SB(0, 0), b20); PG8_STAGEB(PG8_SB(0, 1), b21); PG8_STAGE(PG8_SA(0, 0), a2, vA00, vA01);
            PG8_WAIT_V(8); PG8_WAIT_L(0); PG8_BAR; if (!skip1) { PG8_MMA(1, 0, At, B0); PG8_MMA(1, 1, At, B1); } PG8_BAR; PG8_SCHED;
            PG8_LDB(B0, 1, 0); PG8_LDB(B1, 1, 1); PG8_SCHED; PG8_LDA(At, 1, 0); PG8_STAGE(PG8_SA(0, 1), a2, vA10, vA11);
            PG8_WAIT_V(8); PG8_WAIT_L(0); PG8_BAR; PG8_MMA(0, 0, At, B0); PG8_MMA(0, 1, At, B1); PG8_BAR; PG8_SCHED;
            PG8_LDA(At, 1, 1); PG8_STAGEB(PG8_SB(1, 0), b30); PG8_STAGEB(PG8_SB(1, 1), b31); PG8_STAGE(PG8_SA(1, 0), a3, vA00, vA01);
            PG8_WAIT_V(8); PG8_WAIT_L(0); PG8_BAR; if (!skip1) { PG8_MMA(1, 0, At, B0); PG8_MMA(1, 1, At, B1); } PG8_BAR; PG8_SCHED;
        }
        if (wr == 0) PG8_BAR;
        E(acc, cur, wr, wc, fr, fq);
        S.done(cur);
        if (!has_next) break;
#pragma unroll
        for (int a = 0; a < 2; ++a)
#pragma unroll
            for (int b = 0; b < 2; ++b)
#pragma unroll
                for (int m = 0; m < 4; ++m)
#pragma unroll
                    for (int n = 0; n < 2; ++n) acc[a][b][m][n] = (f32x4){0.f, 0.f, 0.f, 0.f};
        cur = nxt; cB0 = nB0; cB1 = nB1; ++ui;
        if (wr == 1) PG8_BAR;
    }
    PG8_WAIT_V(0);
    PG8_BAR;
#undef PG8_SA
#undef PG8_SB
#undef PG8_STAGE
#undef PG8_STAGEB
#undef PG8_LDA
#undef PG8_LDB
#undef PG8_MMA
#undef PG8_WAIT_V
#undef PG8_WAIT_L
#undef PG8_BAR
#undef PG8_SCHED
}
}
#include <hip/hip_bf16.h>
#include <cmath>
namespace attn_body {
using bf16=__hip_bfloat16;
using bf16x8=__attribute__((ext_vector_type(8)))short;
using s16x4=__attribute__((ext_vector_type(4)))short;
using f32x16=__attribute__((ext_vector_type(16)))float;
using u32x4=__attribute__((ext_vector_type(4)))unsigned;
constexpr int D=64,DM=1024;
constexpr int NW=8,QBLK=32,QB=QBLK*NW,KVBLK=64;
constexpr int ATTN_PITCH=DM, ATTN_UNIT_ROWS=QB;
__device__ __forceinline__ int crow(int r,int hi){return (r&3)+8*(r>>2)+4*hi;}
#define SBAR() __builtin_amdgcn_sched_barrier(0)
__device__ __forceinline__ void cmask(f32x16&p0,f32x16&p1,int jb,int qrel,int hi){
  const float NEG=-INFINITY; int kb=64*jb+4*hi;
  #pragma unroll
  for(int r=0;r<16;++r){int kv=kb+(r&3)+8*(r>>2); if(kv>qrel)p0[r]=NEG; if(kv+32>qrel)p1[r]=NEG;}
}

constexpr int NSLOT=3, SLOTB=8192;
constexpr int LDS_K=0, LDS_V=NSLOT*SLOTB, LDS_WS=2*NSLOT*SLOTB, LDS_OST=LDS_WS+NW*64*4, LDS_BYTES=LDS_OST+NW*4096;
constexpr float C2=0.125f*1.4426950408889634f;
__device__ __forceinline__ void glds16(const void*gsrc,unsigned lds_dst){unsigned keep;
  asm volatile("s_mov_b32 %0, m0\n\ts_mov_b32 m0, %2\n\ts_nop 0\n\tglobal_load_lds_dwordx4 %1, off\n\ts_mov_b32 m0, %0":"=&s"(keep):"v"(gsrc),"s"(lds_dst):"memory");}
__device__ __forceinline__ void glds16s(const void*sbase,unsigned voff,unsigned lds_dst){unsigned keep;
  asm volatile("s_mov_b32 %0, m0\n\ts_mov_b32 m0, %3\n\ts_nop 4\n\tglobal_load_lds_dwordx4 %1, %2\n\ts_mov_b32 m0, %0":"=&s"(keep):"v"(voff),"s"(sbase),"s"(lds_dst):"memory");}
__device__ __forceinline__ float max3f(float a,float b,float c){float r;asm("v_max3_f32 %0, %1, %2, %3":"=v"(r):"v"(a),"v"(b),"v"(c));return r;}
__device__ __forceinline__ float max2f(float a,float b){float r;asm("v_max_f32_e32 %0, %1, %2":"=v"(r):"v"(a),"v"(b));return r;}
__device__ __forceinline__ float fadd_s(float a,float b){float r;asm("v_add_f32_e32 %0, %1, %2":"=v"(r):"v"(a),"v"(b));return r;}
__device__ __forceinline__ float fsub_s(float a,float b){float r;asm("v_sub_f32_e32 %0, %1, %2":"=v"(r):"v"(a),"v"(b));return r;}
typedef float f32x2_t __attribute__((ext_vector_type(2))); typedef __bf16 bf16x2_t __attribute__((ext_vector_type(2)));
__device__ __forceinline__ unsigned cvtpk_s(float lo,float hi){f32x2_t v={lo,hi};bf16x2_t b=__builtin_convertvector(v,bf16x2_t);return __builtin_bit_cast(unsigned,b);}
#define WAIT_BAR(N) asm volatile("s_waitcnt vmcnt(" #N ") lgkmcnt(0)\n\ts_barrier":::"memory")

__device__ __forceinline__ void qkt(f32x16&p0,f32x16&p1,const char*Kslot,const bf16x8*qr,const f32x16&negm,int r32,int hi){
  const char*kb=Kslot+hi*1024+r32*16;
  #pragma unroll
  for(int d0=0;d0<4;++d0){
    const bf16x8 b0=*reinterpret_cast<const bf16x8*>(kb+d0*2048);
    const bf16x8 b1=*reinterpret_cast<const bf16x8*>(kb+d0*2048+512);
    if(d0==0){p0=__builtin_amdgcn_mfma_f32_32x32x16_bf16(b0,qr[0],negm,0,0,0);p1=__builtin_amdgcn_mfma_f32_32x32x16_bf16(b1,qr[0],negm,0,0,0);}
    else{p0=__builtin_amdgcn_mfma_f32_32x32x16_bf16(b0,qr[d0],p0,0,0,0);p1=__builtin_amdgcn_mfma_f32_32x32x16_bf16(b1,qr[d0],p1,0,0,0);}}
}
typedef __attribute__((address_space(3))) const char* lds_cptr;
typedef short v4i16_t __attribute__((ext_vector_type(4)));
__device__ __forceinline__ void kload8(bf16x8*kf,lds_cptr kp){
  kf[0]=*(const __attribute__((address_space(3))) bf16x8*)(kp);      kf[1]=*(const __attribute__((address_space(3))) bf16x8*)(kp+512);
  kf[2]=*(const __attribute__((address_space(3))) bf16x8*)(kp+2048); kf[3]=*(const __attribute__((address_space(3))) bf16x8*)(kp+2560);
  kf[4]=*(const __attribute__((address_space(3))) bf16x8*)(kp+4096); kf[5]=*(const __attribute__((address_space(3))) bf16x8*)(kp+4608);
  kf[6]=*(const __attribute__((address_space(3))) bf16x8*)(kp+6144); kf[7]=*(const __attribute__((address_space(3))) bf16x8*)(kp+6656);
}
__device__ __forceinline__ void kload2(bf16x8*kf,lds_cptr kp,int j){ kf[2*j]=*(const __attribute__((address_space(3))) bf16x8*)(kp+j*2048); kf[2*j+1]=*(const __attribute__((address_space(3))) bf16x8*)(kp+j*2048+512); }
__device__ __forceinline__ s16x4 vtr(lds_cptr p){ return __builtin_bit_cast(s16x4,__builtin_amdgcn_ds_read_tr16_b64_v4i16((__attribute__((address_space(3))) v4i16_t*)p)); }
__device__ __forceinline__ float rowmax(const f32x16&p0,const f32x16&p1){
  float a=max3f(p0[0],p0[1],p1[0]),b=max3f(p0[2],p0[3],p1[1]);a=max3f(a,p1[2],p1[3]);
  #pragma unroll
  for(int r=4;r<16;r+=4){a=max3f(a,p0[r],p0[r+1]);b=max3f(b,p0[r+2],p0[r+3]);a=max3f(a,p1[r],p1[r+1]);b=max3f(b,p1[r+2],p1[r+3]);}
  const float m=max2f(a,b);
  auto rr=__builtin_amdgcn_permlane32_swap(__float_as_uint(m),__float_as_uint(m),false,false);
  return max2f(__uint_as_float(rr[0]),__uint_as_float(rr[1]));
}
__device__ __forceinline__ void pv(f32x16*o,int vb,bf16x8 pa0,bf16x8 pa1,bf16x8 pa2,bf16x8 pa3){
  #pragma unroll
  for(int d0=0;d0<2;++d0){s16x4 lo[4],hi[4];
    #pragma unroll
    for(int ks=0;ks<4;++ks){
      asm volatile("ds_read_b64_tr_b16 %0,%1 offset:%c2":"=&v"(lo[ks]):"v"(vb),"i"(d0*4096+ks*1024):"memory");
      asm volatile("ds_read_b64_tr_b16 %0,%1 offset:%c2":"=&v"(hi[ks]):"v"(vb),"i"(d0*4096+ks*1024+512):"memory");}
    asm volatile("s_waitcnt lgkmcnt(0)":::"memory");SBAR();
    #define PK(k) (bf16x8){lo[k][0],lo[k][1],lo[k][2],lo[k][3],hi[k][0],hi[k][1],hi[k][2],hi[k][3]}
    o[d0]=__builtin_amdgcn_mfma_f32_32x32x16_bf16(pa0,PK(0),o[d0],0,0,0);
    o[d0]=__builtin_amdgcn_mfma_f32_32x32x16_bf16(pa1,PK(1),o[d0],0,0,0);
    o[d0]=__builtin_amdgcn_mfma_f32_32x32x16_bf16(pa2,PK(2),o[d0],0,0,0);
    o[d0]=__builtin_amdgcn_mfma_f32_32x32x16_bf16(pa3,PK(3),o[d0],0,0,0);
    #undef PK
  }
}

#ifndef ATTN_STORE16
#define ATTN_STORE16(p,v) (*(u32x4*)(p)=(v))
#endif
template<int THRL> __device__ __forceinline__ void attn_unit(long rowbase,int qb,const bf16*Qc,const bf16*__restrict__ Kc,const bf16*__restrict__ Vc,bf16*Oc,char*shm){
  int tid_=threadIdx.x; asm volatile("":"+v"(tid_)); const int tid=tid_,lane=tid&63,r32=lane&31,hi=lane>>5; const int wid=__builtin_amdgcn_readfirstlane(tid>>6);
  const int q0=qb*QB;
  const bf16*Qw=Qc+(rowbase+q0+wid*QBLK)*DM;
  const bf16*Kh=Kc+rowbase*DM,*Vh=Vc+rowbase*DM;
  const unsigned lds0=(unsigned)(uintptr_t)shm;
  float*wsf=(float*)(shm+LDS_WS)+wid*64;
  const unsigned koff=(unsigned)(lane*DM+wid*8)*2u;
  const unsigned voffv=(unsigned)((16*(wid&3)+(lane>>2))*DM+(wid>>2)*32+(lane&3)*8)*2u;
  const unsigned kdst=lds0+LDS_K+wid*1024, vdst=lds0+LDS_V+wid*1024;
  #define DMA_K(t,slot) glds16s(Kh+(long)(t)*KVBLK*DM,koff,(unsigned)__builtin_amdgcn_readfirstlane(kdst+(slot)))
  #define DMA_V(t,slot) glds16s(Vh+(long)(t)*KVBLK*DM,voffv,(unsigned)__builtin_amdgcn_readfirstlane(vdst+(slot)))
  const int vb0=(int)(lds0+LDS_V)+((lane>>4)&1)*32+(lane&3)*8+(4*hi+((lane&15)>>2))*64;
  const char*Kbase=shm+LDS_K; bf16x8 kf[8];
  const lds_cptr shm3=(lds_cptr)shm; const lds_cptr kp0=shm3+LDS_K+hi*1024+r32*16; const lds_cptr vp0=shm3+LDS_V+((lane>>4)&1)*32+(lane&3)*8+(4*hi+((lane&15)>>2))*64;
  const int NT=(q0+QB)/KVBLK;
  DMA_K(0,0);DMA_V(0,0);DMA_K(1,SLOTB);
  bf16x8 qr[4];
  #pragma unroll
  for(int d0=0;d0<4;++d0)qr[d0]=*reinterpret_cast<const bf16x8*>(&Qw[(long)r32*DM+d0*16+hi*8]);
  float mhat=0.f,l_reg=0.f;f32x16 o[2];o[0]=f32x16{};o[1]=f32x16{};f32x16 negm=f32x16{};asm volatile("":"+v"(negm));
  const int qrel=wid*QBLK+r32;
  #define CMASK(P0,P1,t) do{int jb_=(t)-(NT-4); if(jb_>=0)cmask(P0,P1,jb_,qrel,hi);}while(0)
  bool resc=false;
  #define START(P0,P1) do{ const float rm=rowmax(P0,P1); resc=false; \
    { const float dl=rm; mhat=fadd_s(mhat,dl); \
      _Pragma("unroll") for(int r=0;r<16;++r){P0[r]=fsub_s(P0[r],dl);P1[r]=fsub_s(P1[r],dl);} \
      _Pragma("unroll") for(int r=0;r<16;++r)negm[r]=-mhat; asm volatile("":"+v"(negm)); } \
    _Pragma("unroll") for(int r=0;r<16;++r)P0[r]=__builtin_amdgcn_exp2f(P0[r]); }while(0)
  #define RESC() do{ if(resc){ asm volatile("s_waitcnt lgkmcnt(0)":::"memory"); \
      _Pragma("unroll") for(int d_=0;d_<2;++d_) _Pragma("unroll") for(int r=0;r<16;++r)o[d_][r]*=wsf[crow(r,hi)]; } }while(0)
  f32x16 pA0,pA1,pB0,pB1;
  int sl_prev=0,sl_cur=0,sl_next=SLOTB;
  #define ROT() do{sl_prev=sl_cur;sl_cur=sl_next;sl_next=(sl_next==(NSLOT-1)*SLOTB)?0:sl_next+SLOTB;}while(0)
  DMA_K(2,2*SLOTB);
  WAIT_BAR(3);
  qkt(pA0,pA1,Kbase,qr,negm,r32,hi);asm volatile("s_nop 15\n\ts_nop 7":"+v"(pA0),"+v"(pA1));CMASK(pA0,pA1,0);
  START(pA0,pA1);
  _Pragma("unroll") for(int r=0;r<16;++r)pA1[r]=__builtin_amdgcn_exp2f(pA1[r]);
  WAIT_BAR(0);
  DMA_K(3,0);DMA_V(1,SLOTB);
  ROT();
  kload8(kf,kp0+sl_cur);
  WAIT_BAR(2);
  s16x4 vlo[8],vhi[8]; u32x4 pw0,pw1,pw2,pw3;
  #define PKW(P,B) cvtpk_s(P[B],P[B+1])
  #define PAF(k) __builtin_bit_cast(bf16x8,pw##k)
  #define VFR(i) (bf16x8){vlo[i][0],vlo[i][1],vlo[i][2],vlo[i][3],vhi[i][0],vhi[i][1],vhi[i][2],vhi[i][3]}
  #define PIN(x) asm volatile("":"+v"(x))
  #define MX3(a,b,c) __builtin_fmaxf(__builtin_fmaxf((a),(b)),(c))
  #define GAPA(MF,A0,A1,A2,A3,W0,W1,PW) do{ MF; sacc+=A0; sacc+=A1; sacc+=A2; sacc+=A3; PIN(sacc); W0; W1; PIN(PW); SBAR(); }while(0)
  #define EX(v) __builtin_amdgcn_exp2f(v)
  #define GAPB(MF,X,B) do{ MF; X[B]=EX(X[B]); X[B+1]=EX(X[B+1]); X[B+2]=EX(X[B+2]); X[B+3]=EX(X[B+3]); PIN(X); SBAR(); }while(0)
  #define VRD(i) do{ vlo[i]=vtr(vp_+(((i)>>2)*4096+((i)&3)*1024)); vhi[i]=vtr(vp_+(((i)>>2)*4096+((i)&3)*1024+512)); }while(0)
  #define KRD(G,j) do{ if(G){ kload2(kf,kp0+sl_next,j); SBAR(); } }while(0)
  #define STEP(C0,C1,P0,P1,t,GK,GV,GL) do{ SBAR(); \
    const lds_cptr vp_=vp0+sl_prev; \
    VRD(0); SBAR(); float sacc=(P0[0]+P0[1]); \
    GAPA(C0=__builtin_amdgcn_mfma_f32_32x32x16_bf16(kf[0],qr[0],negm,0,0,0), P0[2],P0[3],P0[4],P0[5],     pw0[0]=PKW(P0,0), pw0[1]=PKW(P0,2), pw0); \
    VRD(4); SBAR(); GAPA(C1=__builtin_amdgcn_mfma_f32_32x32x16_bf16(kf[1],qr[0],negm,0,0,0), P0[6],P0[7],P0[8],P0[9],     pw0[2]=PKW(P0,4), pw0[3]=PKW(P0,6), pw0); \
    VRD(1); SBAR(); GAPA(C0=__builtin_amdgcn_mfma_f32_32x32x16_bf16(kf[2],qr[1],C0,0,0,0),   P0[10],P0[11],P0[12],P0[13], pw1[0]=PKW(P0,8), pw1[1]=PKW(P0,10), pw1); \
    VRD(5); SBAR(); GAPA(C1=__builtin_amdgcn_mfma_f32_32x32x16_bf16(kf[3],qr[1],C1,0,0,0),   P0[14],P0[15],P1[0],P1[1],   pw1[2]=PKW(P0,12),pw1[3]=PKW(P0,14), pw1); \
    VRD(2); SBAR(); GAPA(C0=__builtin_amdgcn_mfma_f32_32x32x16_bf16(kf[4],qr[2],C0,0,0,0),   P1[2],P1[3],P1[4],P1[5],     pw2[0]=PKW(P1,0), pw2[1]=PKW(P1,2), pw2); \
    VRD(6); SBAR(); GAPA(C1=__builtin_amdgcn_mfma_f32_32x32x16_bf16(kf[5],qr[2],C1,0,0,0),   P1[6],P1[7],P1[8],P1[9],     pw2[2]=PKW(P1,4), pw2[3]=PKW(P1,6), pw2); \
    VRD(3); SBAR(); GAPA(C0=__builtin_amdgcn_mfma_f32_32x32x16_bf16(kf[6],qr[3],C0,0,0,0),   P1[10],P1[11],P1[12],P1[13], pw3[0]=PKW(P1,8), pw3[1]=PKW(P1,10), pw3); \
    VRD(7); SBAR(); GAPA(C1=__builtin_amdgcn_mfma_f32_32x32x16_bf16(kf[7],qr[3],C1,0,0,0),   P1[14],P1[15],0.f,0.f,       pw3[2]=PKW(P1,12),pw3[3]=PKW(P1,14), pw3); \
    l_reg+=sacc; \
    if(GK){DMA_K((t)+3,sl_cur);} if(GV){DMA_V((t)+1,sl_next);} \
    CMASK(C0,C1,t); \
    { float a=MX3(C0[0],C0[1],C1[0]),b=MX3(C0[2],C0[3],C1[1]); a=MX3(a,C1[2],C1[3]); \
      _Pragma("unroll") for(int r=4;r<16;r+=4){a=MX3(a,C0[r],C0[r+1]);b=MX3(b,C0[r+2],C0[r+3]);a=MX3(a,C1[r],C1[r+1]);b=MX3(b,C1[r+2],C1[r+3]);} \
      float rm=__builtin_fmaxf(a,b); { auto rr=__builtin_amdgcn_permlane32_swap(__float_as_uint(rm),__float_as_uint(rm),false,false); rm=__builtin_fmaxf(__uint_as_float(rr[0]),__uint_as_float(rr[1])); } \
      resc=false; \
      if(__builtin_expect(__any(rm>(float)THRL),0)){ const float dl=__builtin_fmaxf(rm,0.f); mhat+=dl; \
        _Pragma("unroll") for(int r=0;r<16;++r){C0[r]-=dl;C1[r]-=dl;} \
        _Pragma("unroll") for(int r=0;r<16;++r)negm[r]=-mhat; asm volatile("":"+v"(negm)); \
        const float f=__builtin_amdgcn_exp2f(-dl); l_reg*=f; if(hi==0)wsf[r32]=f; resc=true; } } \
    SBAR(); \
    GAPB(o[0]=__builtin_amdgcn_mfma_f32_32x32x16_bf16(PAF(0),VFR(0),o[0],0,0,0), C0,0); \
    GAPB(o[1]=__builtin_amdgcn_mfma_f32_32x32x16_bf16(PAF(0),VFR(4),o[1],0,0,0), C0,4); \
    KRD(GL,0); GAPB(o[0]=__builtin_amdgcn_mfma_f32_32x32x16_bf16(PAF(1),VFR(1),o[0],0,0,0), C0,8); \
    KRD(GL,1); GAPB(o[1]=__builtin_amdgcn_mfma_f32_32x32x16_bf16(PAF(1),VFR(5),o[1],0,0,0), C0,12); \
    KRD(GL,2); GAPB(o[0]=__builtin_amdgcn_mfma_f32_32x32x16_bf16(PAF(2),VFR(2),o[0],0,0,0), C1,0); \
    KRD(GL,3); GAPB(o[1]=__builtin_amdgcn_mfma_f32_32x32x16_bf16(PAF(2),VFR(6),o[1],0,0,0), C1,4); \
    GAPB(o[0]=__builtin_amdgcn_mfma_f32_32x32x16_bf16(PAF(3),VFR(3),o[0],0,0,0), C1,8); \
    GAPB(o[1]=__builtin_amdgcn_mfma_f32_32x32x16_bf16(PAF(3),VFR(7),o[1],0,0,0), C1,12); \
    }while(0)
  int t=1;
  #undef CMASK
  #define CMASK(P0,P1,t) do{}while(0)
  for(;t+5<NT;t+=2){
    STEP(pB0,pB1,pA0,pA1,t,true,true,true);     WAIT_BAR(2); RESC(); ROT();
    STEP(pA0,pA1,pB0,pB1,t+1,true,true,true);   WAIT_BAR(2); RESC(); ROT();
  }
  #undef CMASK
  #define CMASK(P0,P1,t) do{int jb_=(t)-(NT-4); if(jb_>=0)cmask(P0,P1,jb_,qrel,hi);}while(0)
  #define ENDW(tt) do{ if((tt)+3<NT){WAIT_BAR(2);} else if((tt)+2<NT){WAIT_BAR(1);} else {WAIT_BAR(0);} }while(0)
  for(;t+1<NT;t+=2){
    STEP(pB0,pB1,pA0,pA1,t,(t+3<NT),(t+1<NT),(t+1<NT));       ENDW(t);   RESC(); ROT();
    STEP(pA0,pA1,pB0,pB1,t+1,(t+4<NT),(t+2<NT),(t+2<NT));     ENDW(t+1); RESC(); ROT();
  }
  STEP(pB0,pB1,pA0,pA1,NT-1,false,false,false); RESC();
  { float sacc=pB0[0]+pB0[1]; _Pragma("unroll") for(int r=2;r<16;++r)sacc+=pB0[r]; _Pragma("unroll") for(int r=0;r<16;++r)sacc+=pB1[r]; l_reg+=sacc;
    pw0=(u32x4){PKW(pB0,0),PKW(pB0,2),PKW(pB0,4),PKW(pB0,6)};pw1=(u32x4){PKW(pB0,8),PKW(pB0,10),PKW(pB0,12),PKW(pB0,14)};pw2=(u32x4){PKW(pB1,0),PKW(pB1,2),PKW(pB1,4),PKW(pB1,6)};pw3=(u32x4){PKW(pB1,8),PKW(pB1,10),PKW(pB1,12),PKW(pB1,14)};
    SBAR(); pv(o,vb0+sl_cur,PAF(0),PAF(1),PAF(2),PAF(3)); }
  #undef PKW
  #undef PAF
  #undef VFR
  #undef PIN
  #undef MX3
  #undef GAPA
  #undef GAPB
  #undef EX
  #undef VRD
  #undef KRD
  #undef STEP
  #undef ENDW
  {auto rr=__builtin_amdgcn_permlane32_swap(__float_as_uint(l_reg),__float_as_uint(l_reg),false,false);l_reg=__uint_as_float(rr[0])+__uint_as_float(rr[1]);}
  if(hi==0)wsf[32+r32]=l_reg;asm volatile("s_waitcnt lgkmcnt(0)":::"memory");
  float rli[16];
  #pragma unroll
  for(int r=0;r<16;++r)rli[r]=__builtin_amdgcn_rcpf(wsf[32+crow(r,hi)]);
  bf16*Ow=Oc+(rowbase+q0+wid*QBLK)*DM;
  { bf16*stg=(bf16*)(shm+LDS_OST)+wid*2048;
    #pragma unroll
    for(int r=0;r<16;++r){const int orow=crow(r,hi);
      #pragma unroll
      for(int d0=0;d0<2;++d0)stg[orow*64+d0*32+r32]=__float2bfloat16(o[d0][r]*rli[r]);}
    asm volatile("s_waitcnt lgkmcnt(0)":::"memory");
    #pragma unroll
    for(int i=0;i<4;++i){const int row=i*8+(lane>>3),ch=lane&7; const u32x4 v=*(const u32x4*)(stg+row*64+ch*8); ATTN_STORE16(Ow+(long)row*DM+ch*8,v);} }
  asm volatile("s_waitcnt lgkmcnt(0)\n\ts_barrier":::"memory");
  #undef DMA_K
  #undef DMA_V
  #undef CMASK
  #undef START
  #undef RESC
  #undef ROT
}
constexpr int ATTN_LDS_BYTES=LDS_BYTES;
#undef SBAR
#undef WAIT_BAR
}
namespace attn128 {
using bf16=__hip_bfloat16;
using bf16x8=__attribute__((ext_vector_type(8)))short;
using s16x4=__attribute__((ext_vector_type(4)))short;
using f32x16=__attribute__((ext_vector_type(16)))float;
using u32x4=__attribute__((ext_vector_type(4)))unsigned;
constexpr int D=64,DM=1024;
constexpr int NW=8,QBLK=32,QB=QBLK*NW,KVBLK=64;
constexpr int ATTN_PITCH=DM, ATTN_UNIT_ROWS=QB;
__device__ __forceinline__ int crow(int r,int hi){return (r&3)+8*(r>>2)+4*hi;}
#define SBAR() __builtin_amdgcn_sched_barrier(0)
__device__ __forceinline__ void cmask(f32x16&p0,f32x16&p1,int jb,int qrel,int hi){
  const float NEG=-INFINITY; int kb=64*jb+4*hi;
  #pragma unroll
  for(int r=0;r<16;++r){int kv=kb+(r&3)+8*(r>>2); if(kv>qrel)p0[r]=NEG; if(kv+32>qrel)p1[r]=NEG;}
}

constexpr int NSLOT=3, SLOTB=8192;
constexpr int LDS_K=0, LDS_V=NSLOT*SLOTB, LDS_WS=LDS_V+NSLOT*2*SLOTB, LDS_OST=LDS_WS+NW*64*4, LDS_BYTES=LDS_OST+NW*8192;
constexpr float C2=0.125f*1.4426950408889634f;
__device__ __forceinline__ void glds16(const void*gsrc,unsigned lds_dst){unsigned keep;
  asm volatile("s_mov_b32 %0, m0\n\ts_mov_b32 m0, %2\n\ts_nop 0\n\tglobal_load_lds_dwordx4 %1, off\n\ts_mov_b32 m0, %0":"=&s"(keep):"v"(gsrc),"s"(lds_dst):"memory");}
__device__ __forceinline__ void glds16s(const void*sbase,unsigned voff,unsigned lds_dst){unsigned keep;
  asm volatile("s_mov_b32 %0, m0\n\ts_mov_b32 m0, %3\n\ts_nop 4\n\tglobal_load_lds_dwordx4 %1, %2\n\ts_mov_b32 m0, %0":"=&s"(keep):"v"(voff),"s"(sbase),"s"(lds_dst):"memory");}
__device__ __forceinline__ float max3f(float a,float b,float c){float r;asm("v_max3_f32 %0, %1, %2, %3":"=v"(r):"v"(a),"v"(b),"v"(c));return r;}
__device__ __forceinline__ float max2f(float a,float b){float r;asm("v_max_f32_e32 %0, %1, %2":"=v"(r):"v"(a),"v"(b));return r;}
__device__ __forceinline__ float fadd_s(float a,float b){float r;asm("v_add_f32_e32 %0, %1, %2":"=v"(r):"v"(a),"v"(b));return r;}
__device__ __forceinline__ float fsub_s(float a,float b){float r;asm("v_sub_f32_e32 %0, %1, %2":"=v"(r):"v"(a),"v"(b));return r;}
typedef float f32x2_t __attribute__((ext_vector_type(2))); typedef __bf16 bf16x2_t __attribute__((ext_vector_type(2)));
__device__ __forceinline__ unsigned cvtpk_s(float lo,float hi){f32x2_t v={lo,hi};bf16x2_t b=__builtin_convertvector(v,bf16x2_t);return __builtin_bit_cast(unsigned,b);}
#define WAIT_BAR(N) asm volatile("s_waitcnt vmcnt(" #N ") lgkmcnt(0)\n\ts_barrier":::"memory")

__device__ __forceinline__ void qkt(f32x16&p0,f32x16&p1,const char*Kslot,const bf16x8*qr,const f32x16&negm,int r32,int hi){
  const char*kb=Kslot+hi*1024+r32*16;
  #pragma unroll
  for(int d0=0;d0<4;++d0){
    const bf16x8 b0=*reinterpret_cast<const bf16x8*>(kb+d0*2048);
    const bf16x8 b1=*reinterpret_cast<const bf16x8*>(kb+d0*2048+512);
    if(d0==0){p0=__builtin_amdgcn_mfma_f32_32x32x16_bf16(b0,qr[0],negm,0,0,0);p1=__builtin_amdgcn_mfma_f32_32x32x16_bf16(b1,qr[0],negm,0,0,0);}
    else{p0=__builtin_amdgcn_mfma_f32_32x32x16_bf16(b0,qr[d0],p0,0,0,0);p1=__builtin_amdgcn_mfma_f32_32x32x16_bf16(b1,qr[d0],p1,0,0,0);}}
}
typedef __attribute__((address_space(3))) const char* lds_cptr;
typedef short v4i16_t __attribute__((ext_vector_type(4)));
__device__ __forceinline__ void kload8(bf16x8*kf,lds_cptr kp){
  kf[0]=*(const __attribute__((address_space(3))) bf16x8*)(kp);      kf[1]=*(const __attribute__((address_space(3))) bf16x8*)(kp+512);
  kf[2]=*(const __attribute__((address_space(3))) bf16x8*)(kp+2048); kf[3]=*(const __attribute__((address_space(3))) bf16x8*)(kp+2560);
  kf[4]=*(const __attribute__((address_space(3))) bf16x8*)(kp+4096); kf[5]=*(const __attribute__((address_space(3))) bf16x8*)(kp+4608);
  kf[6]=*(const __attribute__((address_space(3))) bf16x8*)(kp+6144); kf[7]=*(const __attribute__((address_space(3))) bf16x8*)(kp+6656);
}
__device__ __forceinline__ void kload2(bf16x8*kf,lds_cptr kp,int j){ kf[2*j]=*(const __attribute__((address_space(3))) bf16x8*)(kp+j*2048); kf[2*j+1]=*(const __attribute__((address_space(3))) bf16x8*)(kp+j*2048+512); }
__device__ __forceinline__ s16x4 vtr(lds_cptr p){ return __builtin_bit_cast(s16x4,__builtin_amdgcn_ds_read_tr16_b64_v4i16((__attribute__((address_space(3))) v4i16_t*)p)); }
__device__ __forceinline__ float rowmax(const f32x16&p0,const f32x16&p1){
  float a=max3f(p0[0],p0[1],p1[0]),b=max3f(p0[2],p0[3],p1[1]);a=max3f(a,p1[2],p1[3]);
  #pragma unroll
  for(int r=4;r<16;r+=4){a=max3f(a,p0[r],p0[r+1]);b=max3f(b,p0[r+2],p0[r+3]);a=max3f(a,p1[r],p1[r+1]);b=max3f(b,p1[r+2],p1[r+3]);}
  const float m=max2f(a,b);
  auto rr=__builtin_amdgcn_permlane32_swap(__float_as_uint(m),__float_as_uint(m),false,false);
  return max2f(__uint_as_float(rr[0]),__uint_as_float(rr[1]));
}
__device__ __forceinline__ void pv(f32x16*o,int vb,bf16x8 pa0,bf16x8 pa1,bf16x8 pa2,bf16x8 pa3){
  #pragma unroll
  for(int d0=0;d0<2;++d0){s16x4 lo[4],hi[4];
    #pragma unroll
    for(int ks=0;ks<4;++ks){
      asm volatile("ds_read_b64_tr_b16 %0,%1 offset:%c2":"=&v"(lo[ks]):"v"(vb),"i"(d0*4096+ks*1024):"memory");
      asm volatile("ds_read_b64_tr_b16 %0,%1 offset:%c2":"=&v"(hi[ks]):"v"(vb),"i"(d0*4096+ks*1024+512):"memory");}
    asm volatile("s_waitcnt lgkmcnt(0)":::"memory");SBAR();
    #define PK(k) (bf16x8){lo[k][0],lo[k][1],lo[k][2],lo[k][3],hi[k][0],hi[k][1],hi[k][2],hi[k][3]}
    o[d0]=__builtin_amdgcn_mfma_f32_32x32x16_bf16(pa0,PK(0),o[d0],0,0,0);
    o[d0]=__builtin_amdgcn_mfma_f32_32x32x16_bf16(pa1,PK(1),o[d0],0,0,0);
    o[d0]=__builtin_amdgcn_mfma_f32_32x32x16_bf16(pa2,PK(2),o[d0],0,0,0);
    o[d0]=__builtin_amdgcn_mfma_f32_32x32x16_bf16(pa3,PK(3),o[d0],0,0,0);
    #undef PK
  }
}

#ifndef ATTN_STORE16
#define ATTN_STORE16(p,v) (*(u32x4*)(p)=(v))
#endif
template<int THRL,int MODE> __device__ __forceinline__ void attn_unit(long rowbase,int qb,const bf16*Qc,const bf16*__restrict__ Kc,const bf16*__restrict__ Vc,bf16*Oc,char*shm,float lam,const float*gsub,float osc,float rms_eps){
  int tid_=threadIdx.x; asm volatile("":"+v"(tid_)); const int tid=tid_,lane=tid&63,r32=lane&31,hi=lane>>5; const int wid=__builtin_amdgcn_readfirstlane(tid>>6);
  const int q0=qb*QB;
  const bf16*Qw=Qc+(rowbase+q0+wid*QBLK)*DM;
  const bf16*Kh=Kc+rowbase*DM,*Vh=Vc+rowbase*DM;
  const unsigned lds0=(unsigned)(uintptr_t)shm;
  float*wsf=(float*)(shm+LDS_WS)+wid*64;
  const unsigned koff=(unsigned)(lane*DM+wid*8)*2u;
  const unsigned voffv=(unsigned)((16*(wid&3)+(lane>>2))*DM+(wid>>2)*32+(lane&3)*8)*2u;
  const unsigned kdst=lds0+LDS_K+wid*1024, vdst=lds0+LDS_V+wid*1024;
  #define DMA_K(t,slot) glds16s(Kh+(long)(t)*KVBLK*DM,koff,(unsigned)__builtin_amdgcn_readfirstlane(kdst+(slot)))
  #define DMA_V(t,slot) do{ glds16s(Vh+(long)(t)*KVBLK*DM,voffv,(unsigned)__builtin_amdgcn_readfirstlane(vdst+2*(slot))); glds16s(Vh+(long)(t)*KVBLK*DM+64,voffv,(unsigned)__builtin_amdgcn_readfirstlane(vdst+2*(slot)+8192)); }while(0)
  const int vb0=(int)(lds0+LDS_V)+((lane>>4)&1)*32+(lane&3)*8+(4*hi+((lane&15)>>2))*64;
  const char*Kbase=shm+LDS_K; bf16x8 kf[8];
  const lds_cptr shm3=(lds_cptr)shm; const lds_cptr kp0=shm3+LDS_K+hi*1024+r32*16; const lds_cptr vp0=shm3+LDS_V+((lane>>4)&1)*32+(lane&3)*8+(4*hi+((lane&15)>>2))*64;
  const int NT=(q0+QB)/KVBLK;
  DMA_K(0,0);DMA_V(0,0);DMA_K(1,SLOTB);
  bf16x8 qr[4];
  #pragma unroll
  for(int d0=0;d0<4;++d0)qr[d0]=*reinterpret_cast<const bf16x8*>(&Qw[(long)r32*DM+d0*16+hi*8]);
  float mhat=0.f,l_reg=0.f;f32x16 o[4];o[0]=f32x16{};o[1]=f32x16{};o[2]=f32x16{};o[3]=f32x16{};const f32x16 zf=f32x16{};
  const int qrel=wid*QBLK+r32;
  #define CMASK(P0,P1,t) do{int jb_=(t)-(NT-4); if(jb_>=0)cmask(P0,P1,jb_,qrel,hi);}while(0)
  bool resc=false;
  #define START(P0,P1) do{ const float rm=rowmax(P0,P1); resc=false; \
    { const float dl=rm; mhat=fadd_s(mhat,dl); \
      _Pragma("unroll") for(int r=0;r<16;++r){P0[r]=fsub_s(P0[r],dl);P1[r]=fsub_s(P1[r],dl);} \
      } \
    _Pragma("unroll") for(int r=0;r<16;++r)P0[r]=__builtin_amdgcn_exp2f(P0[r]); }while(0)
  #define RESC() do{ if(resc){ asm volatile("s_waitcnt lgkmcnt(0)":::"memory"); \
      _Pragma("unroll") for(int d_=0;d_<4;++d_) _Pragma("unroll") for(int r=0;r<16;++r)o[d_][r]*=wsf[crow(r,hi)]; } }while(0)
  f32x16 pA0,pA1,pB0,pB1;
  int sl_prev=0,sl_cur=0,sl_next=SLOTB;
  #define ROT() do{sl_prev=sl_cur;sl_cur=sl_next;sl_next=(sl_next==(NSLOT-1)*SLOTB)?0:sl_next+SLOTB;}while(0)
  DMA_K(2,2*SLOTB);
  WAIT_BAR(4);
  qkt(pA0,pA1,Kbase,qr,zf,r32,hi);asm volatile("s_nop 15\n\ts_nop 7":"+v"(pA0),"+v"(pA1));CMASK(pA0,pA1,0);
  START(pA0,pA1);
  _Pragma("unroll") for(int r=0;r<16;++r)pA1[r]=__builtin_amdgcn_exp2f(pA1[r]);
  WAIT_BAR(0);
  DMA_K(3,0);DMA_V(1,SLOTB);
  ROT();
  kload8(kf,kp0+sl_cur);
  WAIT_BAR(3);
  s16x4 vlo[8],vhi[8]; u32x4 pw0,pw1,pw2,pw3;
  #define PKW(P,B) cvtpk_s(P[B],P[B+1])
  #define PAF(k) __builtin_bit_cast(bf16x8,pw##k)
  #define VFR(i) (bf16x8){vlo[i][0],vlo[i][1],vlo[i][2],vlo[i][3],vhi[i][0],vhi[i][1],vhi[i][2],vhi[i][3]}
  #define PIN(x) asm volatile("":"+v"(x))
  #define MX3(a,b,c) __builtin_fmaxf(__builtin_fmaxf((a),(b)),(c))
  #define GAPA(MF,A0,A1,A2,A3,W0,W1,PW) do{ MF; sacc+=A0; sacc+=A1; sacc+=A2; sacc+=A3; PIN(sacc); W0; W1; PIN(PW); SBAR(); }while(0)
  #define EX(v) __builtin_amdgcn_exp2f(v)
  #define GAPB(MF,X,B) do{ MF; X[B]=EX(X[B]); X[B+1]=EX(X[B+1]); X[B+2]=EX(X[B+2]); X[B+3]=EX(X[B+3]); PIN(X); SBAR(); }while(0)
  #define VRD(i) do{ vlo[i]=vtr(vp_+(((i)>>2)*4096+((i)&3)*1024)); vhi[i]=vtr(vp_+(((i)>>2)*4096+((i)&3)*1024+512)); }while(0)
  #define KRD(G,j) do{ if(G){ kload2(kf,kp0+sl_next,j); SBAR(); } }while(0)
  #define VRD2(i) do{ vlo[i]=vtr(vp_+(8192+((i)>>2)*4096+((i)&3)*1024)); vhi[i]=vtr(vp_+(8192+((i)>>2)*4096+((i)&3)*1024+512)); SBAR(); }while(0)
  #define STEP(C0,C1,P0,P1,t,GK,GV,GL) do{ SBAR(); \
    const lds_cptr vp_=vp0+2*sl_prev; \
    VRD(0); SBAR(); float sacc=(P0[0]+P0[1]); \
    GAPA(C0=__builtin_amdgcn_mfma_f32_32x32x16_bf16(kf[0],qr[0],zf,0,0,0), P0[2],P0[3],P0[4],P0[5],     pw0[0]=PKW(P0,0), pw0[1]=PKW(P0,2), pw0); \
    VRD(4); SBAR(); GAPA(C1=__builtin_amdgcn_mfma_f32_32x32x16_bf16(kf[1],qr[0],zf,0,0,0), P0[6],P0[7],P0[8],P0[9],     pw0[2]=PKW(P0,4), pw0[3]=PKW(P0,6), pw0); \
    VRD(1); SBAR(); GAPA(C0=__builtin_amdgcn_mfma_f32_32x32x16_bf16(kf[2],qr[1],C0,0,0,0),   P0[10],P0[11],P0[12],P0[13], pw1[0]=PKW(P0,8), pw1[1]=PKW(P0,10), pw1); \
    VRD(5); SBAR(); GAPA(C1=__builtin_amdgcn_mfma_f32_32x32x16_bf16(kf[3],qr[1],C1,0,0,0),   P0[14],P0[15],P1[0],P1[1],   pw1[2]=PKW(P0,12),pw1[3]=PKW(P0,14), pw1); \
    VRD(2); SBAR(); GAPA(C0=__builtin_amdgcn_mfma_f32_32x32x16_bf16(kf[4],qr[2],C0,0,0,0),   P1[2],P1[3],P1[4],P1[5],     pw2[0]=PKW(P1,0), pw2[1]=PKW(P1,2), pw2); \
    VRD(6); SBAR(); GAPA(C1=__builtin_amdgcn_mfma_f32_32x32x16_bf16(kf[5],qr[2],C1,0,0,0),   P1[6],P1[7],P1[8],P1[9],     pw2[2]=PKW(P1,4), pw2[3]=PKW(P1,6), pw2); \
    VRD(3); SBAR(); GAPA(C0=__builtin_amdgcn_mfma_f32_32x32x16_bf16(kf[6],qr[3],C0,0,0,0),   P1[10],P1[11],P1[12],P1[13], pw3[0]=PKW(P1,8), pw3[1]=PKW(P1,10), pw3); \
    VRD(7); SBAR(); GAPA(C1=__builtin_amdgcn_mfma_f32_32x32x16_bf16(kf[7],qr[3],C1,0,0,0),   P1[14],P1[15],0.f,0.f,       pw3[2]=PKW(P1,12),pw3[3]=PKW(P1,14), pw3); \
    l_reg+=sacc; \
    if(GK){DMA_K((t)+3,sl_cur);} if(GV){DMA_V((t)+1,sl_next);} \
    _Pragma("unroll") for(int r=0;r<16;++r){C0[r]-=mhat;C1[r]-=mhat;} \
    CMASK(C0,C1,t); \
    { float a=MX3(C0[0],C0[1],C1[0]),b=MX3(C0[2],C0[3],C1[1]); a=MX3(a,C1[2],C1[3]); \
      _Pragma("unroll") for(int r=4;r<16;r+=4){a=MX3(a,C0[r],C0[r+1]);b=MX3(b,C0[r+2],C0[r+3]);a=MX3(a,C1[r],C1[r+1]);b=MX3(b,C1[r+2],C1[r+3]);} \
      float rm=__builtin_fmaxf(a,b); { auto rr=__builtin_amdgcn_permlane32_swap(__float_as_uint(rm),__float_as_uint(rm),false,false); rm=__builtin_fmaxf(__uint_as_float(rr[0]),__uint_as_float(rr[1])); } \
      resc=false; \
      if(__builtin_expect(__any(rm>(float)THRL),0)){ const float dl=__builtin_fmaxf(rm,0.f); mhat+=dl; \
        _Pragma("unroll") for(int r=0;r<16;++r){C0[r]-=dl;C1[r]-=dl;} \
        const float f=__builtin_amdgcn_exp2f(-dl); l_reg*=f; if(hi==0)wsf[r32]=f; resc=true; } } \
    SBAR(); \
    GAPB(o[0]=__builtin_amdgcn_mfma_f32_32x32x16_bf16(PAF(0),VFR(0),o[0],0,0,0), C0,0); VRD2(0); \
    GAPB(o[1]=__builtin_amdgcn_mfma_f32_32x32x16_bf16(PAF(0),VFR(4),o[1],0,0,0), C0,4); VRD2(4); \
    KRD(GL,0); GAPB(o[0]=__builtin_amdgcn_mfma_f32_32x32x16_bf16(PAF(1),VFR(1),o[0],0,0,0), C0,8); VRD2(1); \
    KRD(GL,1); GAPB(o[1]=__builtin_amdgcn_mfma_f32_32x32x16_bf16(PAF(1),VFR(5),o[1],0,0,0), C0,12); VRD2(5); \
    KRD(GL,2); GAPB(o[0]=__builtin_amdgcn_mfma_f32_32x32x16_bf16(PAF(2),VFR(2),o[0],0,0,0), C1,0); VRD2(2); \
    KRD(GL,3); GAPB(o[1]=__builtin_amdgcn_mfma_f32_32x32x16_bf16(PAF(2),VFR(6),o[1],0,0,0), C1,4); VRD2(6); \
    GAPB(o[0]=__builtin_amdgcn_mfma_f32_32x32x16_bf16(PAF(3),VFR(3),o[0],0,0,0), C1,8); VRD2(3); \
    GAPB(o[1]=__builtin_amdgcn_mfma_f32_32x32x16_bf16(PAF(3),VFR(7),o[1],0,0,0), C1,12); VRD2(7); \
    o[2]=__builtin_amdgcn_mfma_f32_32x32x16_bf16(PAF(0),VFR(0),o[2],0,0,0); o[3]=__builtin_amdgcn_mfma_f32_32x32x16_bf16(PAF(0),VFR(4),o[3],0,0,0); \
    o[2]=__builtin_amdgcn_mfma_f32_32x32x16_bf16(PAF(1),VFR(1),o[2],0,0,0); o[3]=__builtin_amdgcn_mfma_f32_32x32x16_bf16(PAF(1),VFR(5),o[3],0,0,0); \
    o[2]=__builtin_amdgcn_mfma_f32_32x32x16_bf16(PAF(2),VFR(2),o[2],0,0,0); o[3]=__builtin_amdgcn_mfma_f32_32x32x16_bf16(PAF(2),VFR(6),o[3],0,0,0); \
    o[2]=__builtin_amdgcn_mfma_f32_32x32x16_bf16(PAF(3),VFR(3),o[2],0,0,0); o[3]=__builtin_amdgcn_mfma_f32_32x32x16_bf16(PAF(3),VFR(7),o[3],0,0,0); SBAR(); \
    }while(0)
  int t=1;
  #undef CMASK
  #define CMASK(P0,P1,t) do{}while(0)
  for(;t+5<NT;t+=2){
    STEP(pB0,pB1,pA0,pA1,t,true,true,true);     WAIT_BAR(3); RESC(); ROT();
    STEP(pA0,pA1,pB0,pB1,t+1,true,true,true);   WAIT_BAR(3); RESC(); ROT();
  }
  #undef CMASK
  #define CMASK(P0,P1,t) do{int jb_=(t)-(NT-4); if(jb_>=0)cmask(P0,P1,jb_,qrel,hi);}while(0)
  #define ENDW(tt) do{ if((tt)+3<NT){WAIT_BAR(3);} else if((tt)+2<NT){WAIT_BAR(2);} else {WAIT_BAR(0);} }while(0)
  for(;t+1<NT;t+=2){
    STEP(pB0,pB1,pA0,pA1,t,(t+3<NT),(t+1<NT),(t+1<NT));       ENDW(t);   RESC(); ROT();
    STEP(pA0,pA1,pB0,pB1,t+1,(t+4<NT),(t+2<NT),(t+2<NT));     ENDW(t+1); RESC(); ROT();
  }
  STEP(pB0,pB1,pA0,pA1,NT-1,false,false,false); RESC();
  { float sacc=pB0[0]+pB0[1]; _Pragma("unroll") for(int r=2;r<16;++r)sacc+=pB0[r]; _Pragma("unroll") for(int r=0;r<16;++r)sacc+=pB1[r]; l_reg+=sacc;
    pw0=(u32x4){PKW(pB0,0),PKW(pB0,2),PKW(pB0,4),PKW(pB0,6)};pw1=(u32x4){PKW(pB0,8),PKW(pB0,10),PKW(pB0,12),PKW(pB0,14)};pw2=(u32x4){PKW(pB1,0),PKW(pB1,2),PKW(pB1,4),PKW(pB1,6)};pw3=(u32x4){PKW(pB1,8),PKW(pB1,10),PKW(pB1,12),PKW(pB1,14)};
    SBAR(); pv(o,vb0+2*sl_cur,PAF(0),PAF(1),PAF(2),PAF(3)); pv(o+2,vb0+2*sl_cur+8192,PAF(0),PAF(1),PAF(2),PAF(3)); }
  #undef PKW
  #undef PAF
  #undef VFR
  #undef PIN
  #undef MX3
  #undef GAPA
  #undef GAPB
  #undef EX
  #undef VRD
  #undef KRD
  #undef VRD2
  #undef STEP
  #undef ENDW
  {auto rr=__builtin_amdgcn_permlane32_swap(__float_as_uint(l_reg),__float_as_uint(l_reg),false,false);l_reg=__uint_as_float(rr[0])+__uint_as_float(rr[1]);}
  if(hi==0)wsf[32+r32]=l_reg;asm volatile("s_waitcnt lgkmcnt(0)":::"memory");
  float rli[16];
  #pragma unroll
  for(int r=0;r<16;++r)rli[r]=__builtin_amdgcn_rcpf(wsf[32+crow(r,hi)]);
  bf16*Ow=Oc+(rowbase+q0+wid*QBLK)*DM;
  { bf16*stg=(bf16*)(shm+LDS_OST)+wid*4096;
    #pragma unroll
    for(int r=0;r<16;++r){const int orow=crow(r,hi);
      #pragma unroll
      for(int d0=0;d0<4;++d0){ float v=o[d0][r]*rli[r];
        if(MODE==2) v=__bfloat162float(stg[orow*128+d0*32+r32])-lam*v;
        stg[orow*128+d0*32+r32]=__float2bfloat16(v);} }
    asm volatile("s_waitcnt lgkmcnt(0)":::"memory");
    if(MODE==0){
      #pragma unroll
      for(int i=0;i<8;++i){const int row=i*4+(lane>>4),ch=lane&15; const u32x4 v=*(const u32x4*)(stg+row*128+ch*8); ATTN_STORE16(Ow+(long)row*DM+ch*8,v);} }
    if(MODE==2){
      const int row=lane>>1,c0=(lane&1)*64; float ss=0.f; u32x4 w[8];
      #pragma unroll
      for(int i=0;i<8;++i){ w[i]=*(const u32x4*)(stg+row*128+c0+i*8);
        #pragma unroll
        for(int j=0;j<4;++j){ const float a=__uint_as_float(w[i][j]<<16),b=__uint_as_float(w[i][j]&0xffff0000u); ss+=a*a+b*b; } }
      ss+=__shfl_xor(ss,1);
      const float rs=osc/sqrtf(ss*(1.0f/128.0f)+rms_eps);
      #pragma unroll
      for(int i=0;i<8;++i){ u32x4 ov;
        #pragma unroll
        for(int j=0;j<4;++j){ const float a=__uint_as_float(w[i][j]<<16)*rs*gsub[c0+i*8+2*j],b=__uint_as_float(w[i][j]&0xffff0000u)*rs*gsub[c0+i*8+2*j+1]; ov[j]=cvtpk_s(a,b); }
        ATTN_STORE16(Ow+(long)row*DM+c0+i*8,ov); } }
  }
  asm volatile("s_waitcnt lgkmcnt(0)\n\ts_barrier":::"memory");
  #undef DMA_K
  #undef DMA_V
  #undef CMASK
  #undef START
  #undef RESC
  #undef ROT
}
constexpr int ATTN_LDS_BYTES=LDS_BYTES;
#undef SBAR
#undef WAIT_BAR
}
namespace mk {
#define GAS __attribute__((address_space(1)))
#define LAS __attribute__((address_space(3)))
typedef unsigned short bf16;
typedef unsigned v4u __attribute__((ext_vector_type(4)));
typedef unsigned v2u __attribute__((ext_vector_type(2)));
typedef float f32x4 __attribute__((ext_vector_type(4)));
using pg8::Unit;
using pg8::cvt_pk_bf16;

constexpr int D = 1024, BATCH = 8, SEQ = 2048, T = BATCH * SEQ, NH = 8, NG = 4, EPG = 8, NE = 32, DE = 512, NRW = NG + NE;
constexpr float ALPHA = 1.4142135623730951f, LN_EPS = 1e-5f, RMS_EPS = 1e-5f;
constexpr float LAM_INIT = 0.35550906f;
constexpr float QSCALE = 0.125f * 1.4426950408889634f;
constexpr int CNT_STRIDE = 64;
constexpr int CAP = T;
constexpr int NWAVES = 8, NTHREADS = 512;
#ifndef P0B_FILL
#define P0B_FILL 1
#endif
#ifndef MOE_MERGE
#define MOE_MERGE 0
#endif
#ifndef P0B_SPLIT
#define P0B_SPLIT 8192
#endif

constexpr size_t MiB = 1u << 20;
constexpr size_t WS_CTL = 0, WS_W1T = 1 * MiB, WS_W2T = 7 * MiB, WS_WKVQ = 9 * MiB, WS_WOT = 15 * MiB, WS_RWT = 17 * MiB;
constexpr size_t WS_RWH = 17 * MiB + 512 * 1024;
constexpr size_t WS_WUT = 24 * MiB, WS_WDT = 152 * MiB, WS_XB = 216 * MiB, WS_GB = 248 * MiB, WS_U = 280 * MiB, WS_A2 = 312 * MiB, WS_Z = 344 * MiB, WS_X1B = 408 * MiB;
constexpr size_t WS_ACT = 440 * MiB, WS_YP = 480 * MiB, WS_X2B = 544 * MiB, WS_K = 576 * MiB, WS_V = 608 * MiB, WS_Q = 640 * MiB, WS_O0 = 672 * MiB, WS_O1 = 704 * MiB;
constexpr size_t WS_A3 = 736 * MiB, WS_X3B = 768 * MiB;
#ifdef MKPROBE
constexpr size_t WS_PERM = 18 * MiB;
constexpr size_t WS_Z1 = 800 * MiB, WS_ACT1 = 864 * MiB, WS_YP1 = 904 * MiB, WS_PERM1 = 968 * MiB, WS_END = 972 * MiB;
#else
constexpr size_t WS_PERM = 18 * MiB;
constexpr size_t WS_Z1 = WS_Z, WS_ACT1 = WS_ACT, WS_YP1 = WS_YP, WS_PERM1 = WS_PERM, WS_END = 800 * MiB;
#endif
#define LZ(l) ((l) ? WS_Z1 : WS_Z)
#define LACT(l) ((l) ? WS_ACT1 : WS_ACT)
#define LYP(l) ((l) ? WS_YP1 : WS_YP)
#define LPERM(l) ((l) ? WS_PERM1 : WS_PERM)
constexpr int RWH_PITCH = 2064  , RWH_BYTES = 2 * 36 * RWH_PITCH  ;
constexpr int RWH_PAD = 149504;
constexpr int RING_BYTES = 131072, RW_BYTES = RWH_PAD  , MISC_OFF = RW_BYTES, LDS_BYTES = 163840;

struct Args {
    const float *x, *a_w_in, *a_conv_w, *a_w_out, *kv_w, *b_w_q, *b_lambda, *b_subln_g, *b_w_o, *ln1_g, *ln1_b, *ln2_g, *ln2_b, *rg_w, *rg_b, *re_w, *re_b, *e_w_in, *e_w_down;
    float* out; unsigned char* ws;
};

typedef const __attribute__((address_space(4))) Args* ArgsP;
__device__ __forceinline__ ArgsP kargs() { ArgsP p = (ArgsP)__builtin_amdgcn_kernarg_segment_ptr(); asm volatile("" : "+s"(p)); return p; }
struct Ctx { int tid, lane, wave, G, bx, gw, NGW; unsigned char* ws; };
__device__ __forceinline__ Ctx mkctx(ArgsP ap) { Ctx c; int t = threadIdx.x; asm volatile("" : "+v"(t)); c.tid = t; c.lane = t & 63; c.wave = __builtin_amdgcn_readfirstlane(t >> 6);
    c.G = gridDim.x; c.bx = blockIdx.x; c.gw = c.bx * 8 + c.wave; c.NGW = c.G * 8; c.ws = ap->ws; return c; }
__device__ __forceinline__ unsigned f2bf(float f) { unsigned u = __builtin_bit_cast(unsigned, f); return (u + 0x7fffu + ((u >> 16) & 1u)) >> 16; }
__device__ __forceinline__ unsigned pk2(float lo, float hi) { return f2bf(lo) | (f2bf(hi) << 16); }
__device__ __forceinline__ float bflo(unsigned w) { return __builtin_bit_cast(float, w << 16); }
__device__ __forceinline__ float bfhi(unsigned w) { return __builtin_bit_cast(float, w & 0xffff0000u); }
__device__ __forceinline__ f32x4 ldz4(const bf16* p) { const v2u w = *(const v2u*)p; return (f32x4){bflo(w.x), bfhi(w.x), bflo(w.y), bfhi(w.y)}; }
__device__ __forceinline__ float wave_sum(float v) {
#pragma unroll
    for (int o = 1; o < 64; o <<= 1) v += __shfl_xor(v, o);
    return v;
}

__device__ __forceinline__ float dpp_add(float v, const int ctrl_sel) {
    const int iv = __builtin_bit_cast(int, v); int t;
    if (ctrl_sel == 0) t = __builtin_amdgcn_update_dpp(0, iv, 0xB1, 0xF, 0xF, true);
    else if (ctrl_sel == 1) t = __builtin_amdgcn_update_dpp(0, iv, 0x4E, 0xF, 0xF, true);
    else if (ctrl_sel == 2) t = __builtin_amdgcn_update_dpp(0, iv, 0x141, 0xF, 0xF, true);
    else if (ctrl_sel == 3) t = __builtin_amdgcn_update_dpp(0, iv, 0x140, 0xF, 0xF, true);
    else if (ctrl_sel == 4) t = __builtin_amdgcn_update_dpp(0, iv, 0x142, 0xA, 0xF, false);
    else t = __builtin_amdgcn_update_dpp(0, iv, 0x143, 0xC, 0xF, false);
    return v + __builtin_bit_cast(float, t);
}
template <int N> __device__ __forceinline__ void dpp_sum(float (&v)[N]) {
#pragma unroll
    for (int st = 0; st < 6; ++st) {
#pragma unroll
        for (int i = 0; i < N; ++i) v[i] = dpp_add(v[i], st);
    }
#pragma unroll
    for (int i = 0; i < N; ++i) v[i] = __builtin_bit_cast(float, __builtin_amdgcn_readlane(__builtin_bit_cast(int, v[i]), 63));
}
__device__ __forceinline__ float dpp_sum1(float v) { float a[1] = {v}; dpp_sum(a); return a[0]; }

__device__ __forceinline__ void p0_transpose_item(const float* W, int K, int N, bf16* WT, int row_off, LAS float* scr, int item, int lane) {
    const int nblk = N / 64, kb = item / nblk, nb = item % nblk, k0 = 64 * kb, n0 = 64 * nb;
    const float* src = W + (size_t)(k0 + (lane >> 4)) * N + n0 + (lane & 15) * 4;
    f32x4 v[16];
#pragma unroll
    for (int i = 0; i < 16; ++i) v[i] = __builtin_nontemporal_load((const f32x4*)(src + (size_t)(4 * i) * N));
#pragma unroll
    for (int i = 0; i < 16; ++i) { LAS float* d = scr + (4 * i + (lane >> 4)) * 65 + (lane & 15) * 4; d[0] = v[i].x; d[1] = v[i].y; d[2] = v[i].z; d[3] = v[i].w; }
    asm volatile("s_waitcnt lgkmcnt(0)" ::: "memory");
    const int c = lane & 7;
#pragma unroll
    for (int j = 0; j < 8; ++j) { const int n = (lane >> 3) + 8 * j; const LAS float* s = scr + (8 * c) * 65 + n;
        v4u o; o.x = pk2(s[0 * 65], s[1 * 65]); o.y = pk2(s[2 * 65], s[3 * 65]); o.z = pk2(s[4 * 65], s[5 * 65]); o.w = pk2(s[6 * 65], s[7 * 65]);
        *(GAS v4u*)(WT + (size_t)(row_off + n0 + n) * K + k0 + 8 * c) = o; }
    asm volatile("s_waitcnt lgkmcnt(0)" ::: "memory");
}

constexpr int I_IN = 16 * 48, I_SQ = 16 * 16, I_KV = 16 * 32, I_DN = 8 * 16;
constexpr int NEM = P0B_FILL ? NE : 2 * NE;
constexpr int PS1 = I_IN, PS2 = PS1 + I_SQ, PS3 = PS2 + I_KV, PS4 = PS3 + I_SQ, PS5 = PS4 + I_SQ, PS6 = PS5 + NEM * I_SQ, P0_NITEMS = PS6 + NEM * I_DN;
__device__ __forceinline__ void p0_items(LAS unsigned char* lds, int lo, int hi, int w, int nw) {
    const ArgsP a = kargs(); const Ctx cx = mkctx(a); const int lane = cx.lane; unsigned char* ws = cx.ws;
    LAS float* scr = (LAS float*)(lds + cx.wave * 16640);
    for (int it = lo + w; it < hi; it += nw) {
        if (it < PS1) p0_transpose_item(a->a_w_in, D, 3 * D, (bf16*)(ws + WS_W1T), 0, scr, it, lane);
        else if (it < PS2) p0_transpose_item(a->a_w_out, D, D, (bf16*)(ws + WS_W2T), 0, scr, it - PS1, lane);
        else if (it < PS3) p0_transpose_item(a->kv_w, D, 2 * D, (bf16*)(ws + WS_WKVQ), 0, scr, it - PS2, lane);
        else if (it < PS4) p0_transpose_item(a->b_w_q, D, D, (bf16*)(ws + WS_WKVQ), 2 * D, scr, it - PS3, lane);
        else if (it < PS5) p0_transpose_item(a->b_w_o, D, D, (bf16*)(ws + WS_WOT), 0, scr, it - PS4, lane);
        else if (it < PS6) { const int r = it - PS5, mtx = r / I_SQ; p0_transpose_item(a->e_w_in + (size_t)mtx * D * D, D, D, (bf16*)(ws + WS_WUT) + (size_t)mtx * D * D, 0, scr, r % I_SQ, lane); }
        else { const int r = it - PS6, mtx = r / I_DN; p0_transpose_item(a->e_w_down + (size_t)mtx * DE * D, DE, D, (bf16*)(ws + WS_WDT) + (size_t)mtx * D * DE, 0, scr, r % I_DN, lane); }
    }
}
#ifndef ROLE_SPLIT
#define ROLE_SPLIT 1
#endif
#ifndef P0A_EXTRA
#define P0A_EXTRA 5632
#endif
__device__ __forceinline__ void p0_prologue(LAS unsigned char* lds) {
    const ArgsP a = kargs(); const Ctx cx = mkctx(a); const int gw = cx.gw, NGW = cx.NGW, lane = cx.lane;
    unsigned char* ws = cx.ws;
    p0_items(lds, 0, ROLE_SPLIT ? PS1 + P0A_EXTRA : P0_NITEMS, gw, NGW);
#pragma unroll 1
    for (int m = gw; m < T; m += 4 * NGW) {
        f32x4 v[4][4];
#pragma unroll
        for (int r = 0; r < 4; ++r) { const int row = m + r * NGW < T ? m + r * NGW : m; const GAS f32x4* xr = (const GAS f32x4*)(a->x + (size_t)row * D) + lane;
#pragma unroll
            for (int j = 0; j < 4; ++j) v[r][j] = __builtin_nontemporal_load(xr + 64 * j); }
#pragma unroll
        for (int r = 0; r < 4; ++r) { if (m + r * NGW < T) { GAS v2u* o = (GAS v2u*)((bf16*)(ws + WS_XB) + (size_t)(m + r * NGW) * D) + lane;
#pragma unroll
            for (int j = 0; j < 4; ++j) { v2u w; w.x = pk2(v[r][j].x, v[r][j].y); w.y = pk2(v[r][j].z, v[r][j].w); o[64 * j] = w; } } }
    }
    { float* rwt = (float*)(ws + WS_RWT);
      for (int idx = gw * 64 + lane; idx < 2 * NRW * D; idx += NGW * 64) { const int l = idx / (NRW * D), n = (idx / D) % NRW, k = idx % D;
          const float w = n < NG ? a->rg_w[((size_t)l * D + k) * NG + n] : a->re_w[((size_t)l * D + k) * NE + (n - NG)];
          rwt[idx] = w;
          const unsigned hi = f2bf(w), lo = f2bf(w - __builtin_bit_cast(float, hi << 16));
          bf16* img = (bf16*)(ws + WS_RWH) + (size_t)l * (RWH_PAD / 2);
          img[(size_t)n * (RWH_PITCH / 2) + k] = (bf16)hi; img[(size_t)(NRW + n) * (RWH_PITCH / 2) + k] = (bf16)lo; } }
}
__device__ __forceinline__ void p0b_fill(LAS unsigned char* lds, int lo, int hi, int r, int nidle) {
    const ArgsP a = kargs(); const Ctx cx = mkctx(a); unsigned char* ws = cx.ws;
    LAS float* scr = (LAS float*)(lds + cx.wave * 16640);
    for (int it = lo + r * NWAVES + cx.wave; it < hi; it += nidle * NWAVES) {
        if (it < NE * 256) { const int mtx = NE + it / 256; p0_transpose_item(a->e_w_in + (size_t)mtx * D * D, D, D, (bf16*)(ws + WS_WUT) + (size_t)mtx * D * D, 0, scr, it % 256, cx.lane); }
        else { const int r2 = it - NE * 256, mtx = NE + r2 / 128; p0_transpose_item(a->e_w_down + (size_t)mtx * DE * D, DE, D, (bf16*)(ws + WS_WDT) + (size_t)mtx * D * DE, 0, scr, r2 % 128, cx.lane); }
    }
}
constexpr int P0B_ITEMS = NE * 256 + NE * 128;
__device__ __forceinline__ void p0b_idle_fill(LAS unsigned char* lds, int lo, int hi) {
    const ArgsP a = kargs(); const Ctx cx = mkctx(a); const LAS int* misc = (const LAS int*)(lds + MISC_OFF);
    const int per = cx.G >> 3, x = cx.bx & 7, r = cx.bx >> 3; int nidle = 0, before = 0;
    for (int q = 0; q < 8; ++q) { const int rem = misc[q * 9 + 8] % per, id = rem ? per - rem : 0; if (q < x) before += id; nidle += id; }
    const int remx = misc[x * 9 + 8] % per;
    if (nidle == 0) p0b_fill(lds, lo, hi, cx.bx, cx.G);
    else if (remx && r >= remx) p0b_fill(lds, lo, hi, before + r - remx, nidle);
}
struct SchedDense {
    int G, c, nN, mode, K; const char* W;
    __device__ __forceinline__ bool next(int i, Unit& u) const {
        int pm, pn; if (!pg8::static_tile(i, G, c, T / 256, nN, pm, pn)) return false;
        u.arow = pm * 256; u.p0 = pm; u.p1 = pn; u.p2 = 0; u.p3 = 0;
        const size_t rb = (size_t)K * 2;
        if (mode == 0 && pn >= 4) { const int jj = pn - 4; u.b0 = W + (size_t)(D + 128 * jj) * rb; u.b1 = W + (size_t)(2 * D + 128 * jj) * rb; }
        else { u.b0 = W + (size_t)(256 * pn) * rb; u.b1 = u.b0 + 128 * rb; }
        return true;
    }
    __device__ __forceinline__ void a_offs(const Unit& u, const int (&R)[2], const int (&C)[2], unsigned& v00, unsigned& v01, unsigned& v10, unsigned& v11) const {
        v00 = (unsigned)((u.arow + R[0]) * K + C[0]) * 2u; v01 = (unsigned)((u.arow + R[1]) * K + C[1]) * 2u;
        v10 = (unsigned)((u.arow + 128 + R[0]) * K + C[0]) * 2u; v11 = (unsigned)((u.arow + 128 + R[1]) * K + C[1]) * 2u;
    }
    __device__ __forceinline__ bool half_only(const Unit&) const { return false; }
    __device__ __forceinline__ unsigned peek(const Unit&) const { return 0u; }
    __device__ __forceinline__ void a_ready(const Unit&, unsigned) const {}
    __device__ __forceinline__ void done(const Unit&) const {}
};
struct MoeTab { const LAS int* ub; const LAS int* ps; const LAS int* cn; };
struct SchedMoe {
    int G, c, K; bool up; const char* W; const v2u* perm; MoeTab tb;
    unsigned* ready; int hook; int off, nb;
    __device__ __forceinline__ bool half_only(const Unit& u) const { return u.p2 <= 128; }
    __device__ __forceinline__ unsigned peek(const Unit& u) const {
        return hook == 2 ? __hip_atomic_load(ready + 64 * u.p3, __ATOMIC_RELAXED, __HIP_MEMORY_SCOPE_AGENT) : 0u;
    }
    __device__ __forceinline__ void a_ready(const Unit& u, unsigned pk) const {
        if (hook != 2) return;
        if ((unsigned)__builtin_amdgcn_readfirstlane(pk) >= 32u) return;
        const unsigned long long t0 = __builtin_amdgcn_s_memrealtime();
        while ((unsigned)__builtin_amdgcn_readfirstlane(__hip_atomic_load(ready + 64 * u.p3, __ATOMIC_RELAXED, __HIP_MEMORY_SCOPE_AGENT)) < 32u) {
            if (__builtin_amdgcn_s_memrealtime() - t0 > 2000000ull) break;
            __builtin_amdgcn_s_sleep(2); }
        __builtin_amdgcn_fence(__ATOMIC_ACQUIRE, "agent");
        asm volatile("s_waitcnt vmcnt(0)" ::: "memory");
    }
    __device__ __forceinline__ void done(const Unit& u) const {
        if (hook != 1) return;
        asm volatile("s_waitcnt vmcnt(0)" ::: "memory");
        if ((threadIdx.x & 63) == 0) __hip_atomic_fetch_add(ready + 64 * u.p3, 1u, __ATOMIC_RELAXED, __HIP_MEMORY_SCOPE_AGENT);
    }
    __device__ __forceinline__ bool next(int i, Unit& u) const {
        const int x = c & 7, idx = i * (G >> 3) + (c >> 3);
        const LAS int* xb = tb.ub + x * 9;
        if (idx >= xb[8]) return false;
        const int ln = (int)__builtin_amdgcn_mbcnt_hi(~0u, __builtin_amdgcn_mbcnt_lo(~0u, 0u));
        const int k = (int)__builtin_popcountll(__ballot(ln < 8 && idx >= xb[ln & 7])) - 1;
        const int e = x + 8 * (k & 3), local = idx - xb[k];
        int ct, rti;
        if (k < 4) { const int rtn = (xb[k + 1] - xb[k]) >> 2; ct = local / rtn; rti = local - ct * rtn; }
        else { ct = local; rti = (tb.cn[e] - 1) >> 8; }
        const size_t rb = (size_t)K * 2; const char* We = W + (size_t)e * D * rb;
        if (up) { u.b0 = We + (size_t)(128 * ct) * rb; u.b1 = We + (size_t)(DE + 128 * ct) * rb; u.arow = e * CAP + rti * 256; u.p0 = tb.ps[e] + rti * 256; }
        else { u.b0 = We + (size_t)(256 * ct) * rb; u.b1 = u.b0 + 128 * rb; u.arow = tb.ps[e] + rti * 256; u.p0 = e * CAP + rti * 256; }
        u.p1 = ct; u.p2 = tb.cn[e] - rti * 256; u.p3 = (tb.ps[e] >> 8) + rti;
        return true;
    }
    __device__ __forceinline__ void a_offs(const Unit& u, const int (&R)[2], const int (&C)[2], unsigned& v00, unsigned& v01, unsigned& v10, unsigned& v11) const {
        if (up) {
            const int r00 = R[0] < u.p2 ? R[0] : 0, r01 = R[1] < u.p2 ? R[1] : 0, r10 = 128 + R[0] < u.p2 ? 128 + R[0] : 0, r11 = 128 + R[1] < u.p2 ? 128 + R[1] : 0;
            const int t00 = (int)(perm[u.arow + r00].y >> 1), t01 = (int)(perm[u.arow + r01].y >> 1), t10 = (int)(perm[u.arow + r10].y >> 1), t11 = (int)(perm[u.arow + r11].y >> 1);
            v00 = (unsigned)(t00 * K + C[0]) * 2u; v01 = (unsigned)(t01 * K + C[1]) * 2u; v10 = (unsigned)(t10 * K + C[0]) * 2u; v11 = (unsigned)(t11 * K + C[1]) * 2u;
        } else {
            v00 = (unsigned)((u.arow + R[0]) * K + C[0]) * 2u; v01 = (unsigned)((u.arow + R[1]) * K + C[1]) * 2u;
            v10 = (unsigned)((u.arow + 128 + R[0]) * K + C[0]) * 2u; v11 = (unsigned)((u.arow + 128 + R[1]) * K + C[1]) * 2u;
        }
    }
};

struct EpiConvIn {
    static constexpr bool PERM = true; bf16* GB; bf16* U;
    __device__ __forceinline__ void operator()(const f32x4 (&acc)[2][2][4][2], const Unit& u, int wr, int wc, int fr, int fq) const {
        const int row0 = u.p0 * 256 + wr * 64 + fr;
        if (u.p1 < 4) {
            const int col0 = u.p1 * 256 + wc * 32 + 8 * fq;
#pragma unroll
            for (int ai = 0; ai < 2; ++ai)
#pragma unroll
                for (int m = 0; m < 4; ++m) { bf16* rowp = GB + (size_t)(row0 + ai * 128 + m * 16) * D + col0;
#pragma unroll
                    for (int bj = 0; bj < 2; ++bj) { const f32x4 v0 = acc[ai][bj][m][0], v1 = acc[ai][bj][m][1];
                        v4u w; w.x = cvt_pk_bf16(v0[0], v0[1]); w.y = cvt_pk_bf16(v0[2], v0[3]); w.z = cvt_pk_bf16(v1[0], v1[1]); w.w = cvt_pk_bf16(v1[2], v1[3]);
                        *(v4u*)(rowp + bj * 128) = w; } }
        } else {
            const int col0 = (u.p1 - 4) * 128 + wc * 32 + 8 * fq;
#pragma unroll
            for (int ai = 0; ai < 2; ++ai)
#pragma unroll
                for (int m = 0; m < 4; ++m) { const f32x4 v0 = acc[ai][0][m][0] * acc[ai][1][m][0], v1 = acc[ai][0][m][1] * acc[ai][1][m][1];
                    v4u w; w.x = cvt_pk_bf16(v0[0], v0[1]); w.y = cvt_pk_bf16(v0[2], v0[3]); w.z = cvt_pk_bf16(v1[0], v1[1]); w.w = cvt_pk_bf16(v1[2], v1[3]);
                    *(v4u*)(U + (size_t)(row0 + ai * 128 + m * 16) * D + col0) = w; }
        }
    }
};
template <bool RES_BF16> struct EpiResZ {
    static constexpr bool PERM = true; const void* res; bf16* Z;
    __device__ __forceinline__ void operator()(const f32x4 (&acc)[2][2][4][2], const Unit& u, int wr, int wc, int fr, int fq) const {
        const int row0 = u.p0 * 256 + wr * 64 + fr, col0 = u.p1 * 256 + wc * 32 + 8 * fq;
#pragma unroll
        for (int ai = 0; ai < 2; ++ai)
#pragma unroll
            for (int m = 0; m < 4; ++m) { const size_t off = (size_t)(row0 + ai * 128 + m * 16) * D + col0;
#pragma unroll
                for (int bj = 0; bj < 2; ++bj) { const size_t o = off + bj * 128; f32x4 r0, r1;
                    if (RES_BF16) { const v4u w = *(const v4u*)((const bf16*)res + o); r0 = (f32x4){bflo(w.x), bfhi(w.x), bflo(w.y), bfhi(w.y)}; r1 = (f32x4){bflo(w.z), bfhi(w.z), bflo(w.w), bfhi(w.w)}; }
                    else { r0 = *(const f32x4*)((const float*)res + o); r1 = *(const f32x4*)((const float*)res + o + 4); }
                    const f32x4 v0 = r0 * ALPHA + acc[ai][bj][m][0], v1 = r1 * ALPHA + acc[ai][bj][m][1];
                    v4u w; w.x = cvt_pk_bf16(v0[0], v0[1]); w.y = cvt_pk_bf16(v0[2], v0[3]); w.z = cvt_pk_bf16(v1[0], v1[1]); w.w = cvt_pk_bf16(v1[2], v1[3]);
                    *(v4u*)(Z + o) = w; } }
    }
};
template <bool WT> struct EpiUp {
    static constexpr bool PERM = true; bf16* ACT;
    __device__ __forceinline__ void operator()(const f32x4 (&acc)[2][2][4][2], const Unit& u, int wr, int wc, int fr, int fq) const {
        const int row0 = u.p0 + wr * 64 + fr, col0 = u.p1 * 128 + wc * 32 + 8 * fq;
#pragma unroll
        for (int ai = 0; ai < 2; ++ai)
#pragma unroll
            for (int m = 0; m < 4; ++m) { f32x4 v[2];
#pragma unroll
                for (int n = 0; n < 2; ++n) { const f32x4 g = acc[ai][0][m][n], uu = acc[ai][1][m][n];
#pragma unroll
                    for (int j = 0; j < 4; ++j) { const float e = __builtin_amdgcn_exp2f(g[j] * -1.4426950408889634f); v[n][j] = g[j] * __builtin_amdgcn_rcpf(1.0f + e) * uu[j]; } }
                v4u w; w.x = cvt_pk_bf16(v[0][0], v[0][1]); w.y = cvt_pk_bf16(v[0][2], v[0][3]); w.z = cvt_pk_bf16(v[1][0], v[1][1]); w.w = cvt_pk_bf16(v[1][2], v[1][3]);
                bf16* dst = ACT + (size_t)(row0 + ai * 128 + m * 16) * DE + col0;
                if (WT) { __hip_atomic_store((unsigned long long*)dst, ((unsigned long long)w.y << 32) | w.x, __ATOMIC_RELAXED, __HIP_MEMORY_SCOPE_AGENT);
                          __hip_atomic_store((unsigned long long*)dst + 1, ((unsigned long long)w.w << 32) | w.z, __ATOMIC_RELAXED, __HIP_MEMORY_SCOPE_AGENT); }
                else *(v4u*)dst = w; }
    }
};
struct EpiDown {
    static constexpr bool PERM = true; bf16* YP; const v2u* perm;
    __device__ __forceinline__ void operator()(const f32x4 (&acc)[2][2][4][2], const Unit& u, int wr, int wc, int fr, int fq) const {
        const int col0 = u.p1 * 256 + wc * 32 + 8 * fq;
        v2u rec[2][4];
#pragma unroll
        for (int ai = 0; ai < 2; ++ai)
#pragma unroll
            for (int m = 0; m < 4; ++m) { const int r = ai * 128 + wr * 64 + m * 16 + fr; rec[ai][m] = perm[u.p0 + (r < u.p2 ? r : 0)]; }
#pragma unroll
        for (int ai = 0; ai < 2; ++ai)
#pragma unroll
            for (int m = 0; m < 4; ++m) { const int r = ai * 128 + wr * 64 + m * 16 + fr;
                if (r < u.p2) { const int pair = (int)rec[ai][m].y; float g = __builtin_bit_cast(float, rec[ai][m].x); asm volatile("" : "+v"(g)); bf16* rowp = YP + (size_t)pair * D + col0;
#pragma unroll
                    for (int bj = 0; bj < 2; ++bj) { const f32x4 v0 = acc[ai][bj][m][0] * g, v1 = acc[ai][bj][m][1] * g;
                        v4u w; w.x = cvt_pk_bf16(v0[0], v0[1]); w.y = cvt_pk_bf16(v0[2], v0[3]); w.z = cvt_pk_bf16(v1[0], v1[1]); w.w = cvt_pk_bf16(v1[2], v1[3]);
                        *(v4u*)(rowp + bj * 128) = w; } } }
    }
};
struct EpiKVQ {
    static constexpr bool PERM = true; bf16* KB;
    __device__ __forceinline__ void operator()(const f32x4 (&acc)[2][2][4][2], const Unit& u, int wr, int wc, int fr, int fq) const {
        const int t = u.p1 >> 2; const float sc = t == 2 ? QSCALE : 1.0f;
        bf16* base = KB + (size_t)t * (32 * MiB / 2);
        const int row0 = u.p0 * 256 + wr * 64 + fr, col0 = (u.p1 & 3) * 256 + wc * 32 + 8 * fq;
#pragma unroll
        for (int ai = 0; ai < 2; ++ai)
#pragma unroll
            for (int m = 0; m < 4; ++m) { bf16* rowp = base + (size_t)(row0 + ai * 128 + m * 16) * D + col0;
#pragma unroll
                for (int bj = 0; bj < 2; ++bj) { const f32x4 v0 = acc[ai][bj][m][0] * sc, v1 = acc[ai][bj][m][1] * sc;
                    v4u w; w.x = cvt_pk_bf16(v0[0], v0[1]); w.y = cvt_pk_bf16(v0[2], v0[3]); w.z = cvt_pk_bf16(v1[0], v1[1]); w.w = cvt_pk_bf16(v1[2], v1[3]);
                    *(v4u*)(rowp + bj * 128) = w; } }
    }
};

__device__ __forceinline__ void ln_rows(f32x4 (&v)[4], const f32x4 (&gg)[4], const f32x4 (&bb)[4]) {
    float s = 0.f;
#pragma unroll
    for (int j = 0; j < 4; ++j) s += (v[j].x + v[j].y) + (v[j].z + v[j].w);
    const float mean = dpp_sum1(s) * (1.f / D); float s2 = 0.f;
#pragma unroll
    for (int j = 0; j < 4; ++j) { v[j] = v[j] - mean; s2 += (v[j].x * v[j].x + v[j].y * v[j].y) + (v[j].z * v[j].z + v[j].w * v[j].w); }
    const float rstd = 1.f / sqrtf(dpp_sum1(s2) * (1.f / D) + LN_EPS);
#pragma unroll
    for (int j = 0; j < 4; ++j) v[j] = v[j] * rstd * gg[j] + bb[j];
}
__device__ __forceinline__ float dot_lds(const f32x4 (&v)[4], const LAS f32x4* w, int lane) {
    float a = 0.f;
#pragma unroll
    for (int j = 0; j < 4; ++j) { const f32x4 ww = w[64 * j + lane]; a += (v[j].x * ww.x + v[j].y * ww.y) + (v[j].z * ww.z + v[j].w * ww.w); }
    return a;
}
typedef short bf16x8v __attribute__((ext_vector_type(8)));
__device__ __forceinline__ void ln_router_mfma(LAS unsigned char* lds, int layer, int rep) {
    const ArgsP a = kargs(); const Ctx cx = mkctx(a); const int lane = cx.lane, wave = cx.wave, tid = cx.tid;
    unsigned char* ws = cx.ws;
    const bf16* Z = (const bf16*)(ws + LZ(layer)); bf16* Xb = (bf16*)(ws + (layer == 0 ? WS_X1B : WS_X3B));
    const float* g = a->ln1_g + layer * D; const float* b = a->ln1_b + layer * D;
    const float* rgb = a->rg_b + layer * NG; const float* reb = a->re_b + layer * NE;
    int* cnt = (int*)(ws + WS_CTL) + layer * NE * CNT_STRIDE; v2u* perm = (v2u*)(ws + LPERM(layer));
    const int i = lane & 15, kq = lane >> 4, grp = wave >> 1, half = wave & 1;
    const int row = cx.bx * 64 + grp * 16 + i, col0 = 512 * half + 8 * kq;
    { const unsigned char* wg = ws + WS_RWH + (size_t)layer * RWH_PAD;
      for (int q = wave; q < RWH_PAD / 1024; q += NWAVES)
          __builtin_amdgcn_global_load_lds((const unsigned*)(wg + (size_t)q * 1024 + lane * 16), (LAS unsigned*)(lds + q * 1024), 16, 0, 0); }
    v4u xw[16];
#pragma unroll
    for (int s = 0; s < 16; ++s) xw[s] = *(const v4u*)(Z + (size_t)row * D + col0 + 32 * s);
#define XLO(s) ((f32x4){bflo(xw[s].x), bfhi(xw[s].x), bflo(xw[s].y), bfhi(xw[s].y)})
#define XHI(s) ((f32x4){bflo(xw[s].z), bfhi(xw[s].z), bflo(xw[s].w), bfhi(xw[s].w)})
    LAS float* xs = (LAS float*)(lds + MISC_OFF + 4096);
    LAS float* part = (LAS float*)lds;
    float s1 = 0.f, s2 = 0.f;
#pragma unroll
    for (int s = 0; s < 16; ++s)
#pragma unroll
        for (int h2 = 0; h2 < 2; ++h2) { const f32x4 v = h2 ? XHI(s) : XLO(s); s1 += (v.x + v.y) + (v.z + v.w); s2 += (v.x * v.x + v.y * v.y) + (v.z * v.z + v.w * v.w); }
#pragma unroll
    for (int s = 0; s < 16; ++s) asm volatile("" : "+v"(xw[s]));
    s1 += __shfl_xor(s1, 16); s2 += __shfl_xor(s2, 16); s1 += __shfl_xor(s1, 32); s2 += __shfl_xor(s2, 32);
    if (kq == 0) { xs[(wave * 16 + i) * 2] = s1; xs[(wave * 16 + i) * 2 + 1] = s2; }
    __syncthreads();
    const float t1 = xs[((wave ^ 1) * 16 + i) * 2] + s1, t2 = xs[((wave ^ 1) * 16 + i) * 2 + 1] + s2;
    const float mean = t1 * (1.f / D), rstd = 1.f / sqrtf(fmaxf(t2 * (1.f / D) - mean * mean, 0.f) + LN_EPS);
    typedef float f32x4a __attribute__((ext_vector_type(4)));
    f32x4a acc0 = {0.f, 0.f, 0.f, 0.f}, acc1 = acc0, acc2 = acc0;
    const LAS unsigned char* wb = (const LAS unsigned char*)lds + (size_t)(lane & 15) * RWH_PITCH + (size_t)col0 * 2;
    const int n2 = (32 + (lane & 15)) < NRW ? 32 + (lane & 15) : NRW - 1;
    const LAS unsigned char* wb2 = (const LAS unsigned char*)lds + (size_t)n2 * RWH_PITCH + (size_t)col0 * 2;
    constexpr int LO = NRW * RWH_PITCH;
#pragma unroll
    for (int s = 0; s < 16; ++s) {
        if ((s & 3) == 0) asm volatile("" ::: "memory");
        const float* gp = g + col0 + 32 * s; const float* bp = b + col0 + 32 * s;
        const f32x4 g0 = *(const f32x4*)gp, g1 = *(const f32x4*)(gp + 4), b0 = *(const f32x4*)bp, b1 = *(const f32x4*)(bp + 4);
        const f32x4 v0 = (XLO(s) - mean) * rstd * g0 + b0, v1 = (XHI(s) - mean) * rstd * g1 + b1;
        const float vv[8] = {v0.x, v0.y, v0.z, v0.w, v1.x, v1.y, v1.z, v1.w};
        unsigned hi[8], lo[8];
#pragma unroll
        for (int j = 0; j < 8; ++j) { hi[j] = f2bf(vv[j]); lo[j] = f2bf(vv[j] - __builtin_bit_cast(float, hi[j] << 16)); }
        v4u hw, lw;
#pragma unroll
        for (int j = 0; j < 4; ++j) { hw[j] = hi[2 * j] | (hi[2 * j + 1] << 16); lw[j] = lo[2 * j] | (lo[2 * j + 1] << 16); }
        *(v4u*)(Xb + (size_t)row * D + col0 + 32 * s) = hw;
        const bf16x8v ah = __builtin_bit_cast(bf16x8v, hw), al = __builtin_bit_cast(bf16x8v, lw);
        const bf16x8v w0h = *(const LAS bf16x8v*)(wb + 64 * s), w0l = *(const LAS bf16x8v*)(wb + LO + 64 * s);
        const bf16x8v w1h = *(const LAS bf16x8v*)(wb + 16 * RWH_PITCH + 64 * s), w1l = *(const LAS bf16x8v*)(wb + 16 * RWH_PITCH + LO + 64 * s);
        const bf16x8v w2h = *(const LAS bf16x8v*)(wb2 + 64 * s), w2l = *(const LAS bf16x8v*)(wb2 + LO + 64 * s);
        acc0 = __builtin_amdgcn_mfma_f32_16x16x32_bf16(ah, w0h, acc0, 0, 0, 0); acc0 = __builtin_amdgcn_mfma_f32_16x16x32_bf16(al, w0h, acc0, 0, 0, 0); acc0 = __builtin_amdgcn_mfma_f32_16x16x32_bf16(ah, w0l, acc0, 0, 0, 0);
        acc1 = __builtin_amdgcn_mfma_f32_16x16x32_bf16(ah, w1h, acc1, 0, 0, 0); acc1 = __builtin_amdgcn_mfma_f32_16x16x32_bf16(al, w1h, acc1, 0, 0, 0); acc1 = __builtin_amdgcn_mfma_f32_16x16x32_bf16(ah, w1l, acc1, 0, 0, 0);
        acc2 = __builtin_amdgcn_mfma_f32_16x16x32_bf16(ah, w2h, acc2, 0, 0, 0); acc2 = __builtin_amdgcn_mfma_f32_16x16x32_bf16(al, w2h, acc2, 0, 0, 0); acc2 = __builtin_amdgcn_mfma_f32_16x16x32_bf16(ah, w2l, acc2, 0, 0, 0);
    }
    __syncthreads();
#undef XLO
#undef XHI
#pragma unroll
    for (int r = 0; r < 4; ++r) { LAS float* pr = part + (size_t)(wave * 16 + 4 * kq + r) * 48 + (lane & 15); pr[0] = acc0[r]; pr[16] = acc1[r]; pr[32] = acc2[r]; }
    LAS int* rt_e = (LAS int*)(part + 8 * 16 * 48);
    LAS float* rt_g = (LAS float*)(rt_e + 128);
    LAS int* rt_base = (LAS int*)(rt_g + 128);
    __syncthreads();
    if (tid < 64) {
        const int gq = tid >> 4, ii = tid & 15; const LAS float* p0 = part + (size_t)((2 * gq) * 16 + ii) * 48; const LAS float* p1 = p0 + 16 * 48;
        int gi = 0; float gm = -INFINITY, gl[NG];
#pragma unroll
        for (int n = 0; n < NG; ++n) { gl[n] = p0[n] + p1[n] + rgb[n]; if (gl[n] > gm) { gm = gl[n]; gi = n; } }
        float gs = 0.f;
#pragma unroll
        for (int n = 0; n < NG; ++n) gs += __expf(gl[n] - gm);
        const float gtop = 1.0f / gs;
        float m0 = -INFINITY, m1 = -INFINITY; int i0 = 0, i1 = 0;
        for (int n = 0; n < EPG; ++n) { const int c = NG + gi * EPG + n; const float e = p0[c] + p1[c] + reb[gi * EPG + n];
            if (e > m0) { m1 = m0; i1 = i0; m0 = e; i0 = n; } else if (e > m1) { m1 = e; i1 = n; } }
        const float e1 = __expf(m1 - m0), w0 = 1.0f / (1.0f + e1), w1 = e1 * w0;
        rt_e[2 * tid] = gi * EPG + i0; rt_e[2 * tid + 1] = gi * EPG + i1; rt_g[2 * tid] = gtop * w0; rt_g[2 * tid + 1] = gtop * w1;
    }
    __syncthreads();
    if (rep == 0) {
        LAS int* wc = rt_base + NE;
        int my_e = 0, my_rank = 0, my_cnt = 0;
        if (tid < 128) { my_e = rt_e[tid];
            const unsigned long long lt = (1ull << lane) - 1ull;
#pragma unroll 4
            for (int e = 0; e < NE; ++e) { const unsigned long long m = __ballot(my_e == e); if (my_e == e) my_rank = (int)__builtin_popcountll(m & lt); if (lane == e) my_cnt = (int)__builtin_popcountll(m); }
            if (lane < NE) wc[wave * NE + lane] = my_cnt; }
        __syncthreads();
        if (tid < NE) { const int c = wc[tid] + wc[NE + tid]; rt_base[tid] = c ? atomicAdd(&cnt[tid * CNT_STRIDE], c) : 0; }
        __syncthreads();
        if (tid < 128) { const int pair = 2 * (cx.bx * 64 + (tid >> 1)) + (tid & 1);
            perm[my_e * CAP + rt_base[my_e] + my_rank + (wave ? wc[my_e] : 0)] = (v2u){__builtin_bit_cast(unsigned, rt_g[tid]), (unsigned)pair}; }
    }
}
__device__ __forceinline__ void ln_router_phase(LAS unsigned char* lds, int layer, int rep = 0) {
    const ArgsP a = kargs(); const Ctx cx = mkctx(a); const int gw = cx.gw, NGW = cx.NGW, lane = cx.lane;
    unsigned char* ws = cx.ws;
    const bf16* Z = (const bf16*)(ws + LZ(layer)); bf16* Xb = (bf16*)(ws + (layer == 0 ? WS_X1B : WS_X3B));
    const float* g = a->ln1_g + layer * D; const float* b = a->ln1_b + layer * D;
    const float* rgb = a->rg_b + layer * NG; const float* reb = a->re_b + layer * NE;
    int* cnt = (int*)(ws + WS_CTL) + layer * NE * CNT_STRIDE; v2u* perm = (v2u*)(ws + LPERM(layer));
    LAS f32x4* wl = (LAS f32x4*)lds;
    { const f32x4* wg = (const f32x4*)((const float*)(ws + WS_RWT) + (size_t)layer * NRW * D);
      for (int i = cx.tid; i < NRW * D / 4; i += NTHREADS) wl[i] = wg[i]; }
    f32x4 gg[4], bb[4];
#pragma unroll
    for (int j = 0; j < 4; ++j) { gg[j] = *(const f32x4*)(g + 256 * j + 4 * lane); bb[j] = *(const f32x4*)(b + 256 * j + 4 * lane); }
    constexpr int RPW = 16;
    LAS int* rt_row = (LAS int*)(lds + MISC_OFF + 2048);
    LAS int* rt_e = rt_row + NWAVES * RPW;
    LAS float* rt_g = (LAS float*)(rt_e + 2 * NWAVES * RPW);
    LAS int* rt_base = (LAS int*)(rt_g + 2 * NWAVES * RPW);
    LAS int* wave_rows = rt_base + NE;
    f32x4 nv[2][4];
#pragma unroll
    for (int r = 0; r < 2; ++r) { const int row = gw + r * NGW;
        if (row < T) {
#pragma unroll
            for (int j = 0; j < 4; ++j) nv[r][j] = ldz4(Z + (size_t)row * D + 256 * j + 4 * lane);
        } }
    __syncthreads();
    int it = 0;
#pragma unroll 1
    for (int row0 = gw; row0 < T && it < RPW; row0 += 2 * NGW, it += 2) {
        const bool two = row0 + NGW < T;
        f32x4 v[2][4];
#pragma unroll
        for (int r = 0; r < 2; ++r)
#pragma unroll
            for (int j = 0; j < 4; ++j) v[r][j] = nv[r][j];
#pragma unroll
        for (int r = 0; r < 2; ++r) { const int row = row0 + (2 + r) * NGW;
            if (row < T) {
#pragma unroll
                for (int j = 0; j < 4; ++j) nv[r][j] = ldz4(Z + (size_t)row * D + 256 * j + 4 * lane);
            } }
        if (!two) {
#pragma unroll
            for (int j = 0; j < 4; ++j) v[1][j] = v[0][j];
        }
        float s1[2];
#pragma unroll
        for (int r = 0; r < 2; ++r) { float s = 0.f;
#pragma unroll
            for (int j = 0; j < 4; ++j) s += (v[r][j].x + v[r][j].y) + (v[r][j].z + v[r][j].w);
            s1[r] = s; }
        dpp_sum(s1);
        float s2[2];
#pragma unroll
        for (int r = 0; r < 2; ++r) { const float mean = s1[r] * (1.f / D); float q = 0.f;
#pragma unroll
            for (int j = 0; j < 4; ++j) { v[r][j] = v[r][j] - mean; q += (v[r][j].x * v[r][j].x + v[r][j].y * v[r][j].y) + (v[r][j].z * v[r][j].z + v[r][j].w * v[r][j].w); }
            s2[r] = q; }
        dpp_sum(s2);
#pragma unroll
        for (int r = 0; r < 2; ++r) { const float rstd = 1.f / sqrtf(s2[r] * (1.f / D) + LN_EPS);
#pragma unroll
            for (int j = 0; j < 4; ++j) v[r][j] = v[r][j] * rstd * gg[j] + bb[j]; }
#pragma unroll
        for (int r = 0; r < 2; ++r) { const int row = row0 + r * NGW;
            if (r == 0 || two) {
#pragma unroll
                for (int j = 0; j < 4; ++j) { v2u w; w.x = pk2(v[r][j].x, v[r][j].y); w.y = pk2(v[r][j].z, v[r][j].w); *(v2u*)(Xb + (size_t)row * D + 256 * j + 4 * lane) = w; }
            } }
        float gl[2 * NG];
#pragma unroll
        for (int r = 0; r < 2; ++r)
#pragma unroll
            for (int n = 0; n < NG; ++n) gl[r * NG + n] = dot_lds(v[r], wl + n * (D / 4), lane);
        dpp_sum(gl);
        int gi[2]; float gtop[2];
#pragma unroll
        for (int r = 0; r < 2; ++r) { int g_ = 0; float gm = -INFINITY;
#pragma unroll
            for (int n = 0; n < NG; ++n) { gl[r * NG + n] += rgb[n]; if (gl[r * NG + n] > gm) { gm = gl[r * NG + n]; g_ = n; } }
            float gs = 0.f;
#pragma unroll
            for (int n = 0; n < NG; ++n) gs += __expf(gl[r * NG + n] - gm);
            gi[r] = g_; gtop[r] = 1.0f / gs; }
        float el[2 * EPG];
#pragma unroll
        for (int r = 0; r < 2; ++r)
#pragma unroll
            for (int n = 0; n < EPG; ++n) el[r * EPG + n] = dot_lds(v[r], wl + (NG + gi[r] * EPG + n) * (D / 4), lane);
        dpp_sum(el);
#pragma unroll
        for (int r = 0; r < 2; ++r) {
            float m0 = -INFINITY, m1 = -INFINITY; int i0 = 0, i1 = 0;
#pragma unroll
            for (int n = 0; n < EPG; ++n) { const float e = el[r * EPG + n] + reb[gi[r] * EPG + n];
                if (e > m0) { m1 = m0; i1 = i0; m0 = e; i0 = n; } else if (e > m1) { m1 = e; i1 = n; } }
            const float e1 = __expf(m1 - m0), w0 = 1.0f / (1.0f + e1), w1 = e1 * w0;
            if (lane == 0 && (r == 0 || two)) {
                const int li = cx.wave * RPW + it + r;
                rt_row[li] = row0 + r * NGW; rt_e[2 * li] = gi[r] * EPG + i0; rt_e[2 * li + 1] = gi[r] * EPG + i1; rt_g[2 * li] = gtop[r] * w0; rt_g[2 * li + 1] = gtop[r] * w1;
            }
        }
        if (!two) { it += 1; break; }
    }
    if (lane == 0) wave_rows[cx.wave] = it;
    __syncthreads();
    if (rep == 0) {
        if (cx.tid < NE) { int c = 0;
            for (int w = 0; w < NWAVES; ++w) { const int n = wave_rows[w]; for (int i = 0; i < 2 * n; ++i) c += (rt_e[2 * (w * RPW) + i] == cx.tid) ? 1 : 0; }
            rt_base[cx.tid] = c ? atomicAdd(&cnt[cx.tid * CNT_STRIDE], c) : 0; }
        __syncthreads();
        if (cx.tid < 2 * NWAVES * RPW) { const int w = cx.tid / (2 * RPW), i = cx.tid % (2 * RPW);
            if (i < 2 * wave_rows[w]) { const int e = rt_e[cx.tid]; int rank = 0;
                for (int w2 = 0; w2 <= w; ++w2) { const int lim = (w2 < w) ? 2 * wave_rows[w2] : i; for (int q = 0; q < lim; ++q) rank += (rt_e[2 * (w2 * RPW) + q] == e) ? 1 : 0; }
                const int pair = 2 * rt_row[cx.tid >> 1] + (cx.tid & 1);
                perm[e * CAP + rt_base[e] + rank] = (v2u){__builtin_bit_cast(unsigned, rt_g[cx.tid]), (unsigned)pair}; } }
    }
}
__device__ __forceinline__ void ln2_phase(int layer) {
    const ArgsP a = kargs(); const Ctx cx = mkctx(a); const int gw = cx.gw, NGW = cx.NGW, lane = cx.lane;
    unsigned char* ws = cx.ws;
    const bf16* Xin = (const bf16*)(ws + (layer == 0 ? WS_X1B : WS_X3B)); const bf16* YP = (const bf16*)(ws + LYP(layer));
    const float* g = a->ln2_g + layer * D; const float* b = a->ln2_b + layer * D;
    f32x4 gg[4], bb[4];
#pragma unroll
    for (int j = 0; j < 4; ++j) { gg[j] = *(const f32x4*)(g + 256 * j + 4 * lane); bb[j] = *(const f32x4*)(b + 256 * j + 4 * lane); }
    v2u nx[4], ny0[4], ny1[4];
    if (gw < T) {
#pragma unroll
        for (int j = 0; j < 4; ++j) { const size_t c = 256 * j + 4 * lane;
            nx[j] = *(const v2u*)(Xin + (size_t)gw * D + c); ny0[j] = *(const v2u*)(YP + (size_t)(2 * gw) * D + c); ny1[j] = *(const v2u*)(YP + (size_t)(2 * gw + 1) * D + c); }
    }
#pragma unroll 1
    for (int row = gw; row < T; row += NGW) {
        f32x4 v[4];
#pragma unroll
        for (int j = 0; j < 4; ++j) { const v2u xw = nx[j], y0 = ny0[j], y1 = ny1[j];
            v[j].x = ALPHA * bflo(xw.x) + (bflo(y0.x) + bflo(y1.x)); v[j].y = ALPHA * bfhi(xw.x) + (bfhi(y0.x) + bfhi(y1.x));
            v[j].z = ALPHA * bflo(xw.y) + (bflo(y0.y) + bflo(y1.y)); v[j].w = ALPHA * bfhi(xw.y) + (bfhi(y0.y) + bfhi(y1.y)); }
        if (row + NGW < T) { const int r2 = row + NGW;
#pragma unroll
            for (int j = 0; j < 4; ++j) { const size_t c = 256 * j + 4 * lane;
                nx[j] = *(const v2u*)(Xin + (size_t)r2 * D + c); ny0[j] = *(const v2u*)(YP + (size_t)(2 * r2) * D + c); ny1[j] = *(const v2u*)(YP + (size_t)(2 * r2 + 1) * D + c); }
        }
        ln_rows(v, gg, bb);
        if (layer == 0) {
#pragma unroll
            for (int j = 0; j < 4; ++j) { v2u w; w.x = pk2(v[j].x, v[j].y); w.y = pk2(v[j].z, v[j].w); *(v2u*)((bf16*)(ws + WS_X2B) + (size_t)row * D + 256 * j + 4 * lane) = w; }
        } else {
#pragma unroll
            for (int j = 0; j < 4; ++j) *(f32x4*)(a->out + (size_t)row * D + 256 * j + 4 * lane) = v[j];
        }
    }
}
__device__ __forceinline__ void conv_phase() {
    const ArgsP a = kargs(); const Ctx cx = mkctx(a); const int gtid = cx.bx * NTHREADS + cx.tid, NGT = cx.G * NTHREADS;
    unsigned char* ws = cx.ws;
    const bf16* GB = (const bf16*)(ws + WS_GB); const bf16* U = (const bf16*)(ws + WS_U); bf16* A2 = (bf16*)(ws + WS_A2);
    for (int it = gtid; it < T * (D / 8); it += NGT) {
        const int t = it >> 7, d0 = (it & 127) * 8, s = t & (SEQ - 1);
        const size_t o = (size_t)t * D + d0;
        const v4u g = *(const v4u*)(GB + o), u0 = *(const v4u*)(U + o);
        v4u u1 = (v4u){0u, 0u, 0u, 0u}, u2 = u1;
        if (s >= 1) u1 = *(const v4u*)(U + o - D);
        if (s >= 2) u2 = *(const v4u*)(U + o - 2 * D);
        const f32x4 wa0 = *(const f32x4*)(a->a_conv_w + d0), wa1 = *(const f32x4*)(a->a_conv_w + d0 + 4), wb0 = *(const f32x4*)(a->a_conv_w + D + d0), wb1 = *(const f32x4*)(a->a_conv_w + D + d0 + 4);
        const f32x4 wc0 = *(const f32x4*)(a->a_conv_w + 2 * D + d0), wc1 = *(const f32x4*)(a->a_conv_w + 2 * D + d0 + 4);
        const float w0[8] = {wa0.x, wa0.y, wa0.z, wa0.w, wa1.x, wa1.y, wa1.z, wa1.w}, w1[8] = {wb0.x, wb0.y, wb0.z, wb0.w, wb1.x, wb1.y, wb1.z, wb1.w}, w2[8] = {wc0.x, wc0.y, wc0.z, wc0.w, wc1.x, wc1.y, wc1.z, wc1.w};
        v4u r;
#pragma unroll
        for (int q = 0; q < 4; ++q) {
            const float c0 = w0[2 * q] * bflo(u2[q]) + w1[2 * q] * bflo(u1[q]) + w2[2 * q] * bflo(u0[q]);
            const float c1 = w0[2 * q + 1] * bfhi(u2[q]) + w1[2 * q + 1] * bfhi(u1[q]) + w2[2 * q + 1] * bfhi(u0[q]);
            r[q] = pk2(bflo(g[q]) * c0, bfhi(g[q]) * c1);
        }
        *(v4u*)(A2 + o) = r;
    }
}
__device__ __forceinline__ void combine_phase() {
    const ArgsP a = kargs(); const Ctx cx = mkctx(a); const int gw = cx.gw, NGW = cx.NGW, lane = cx.lane;
    unsigned char* ws = cx.ws;
    const bf16* O0 = (const bf16*)(ws + WS_O0); const bf16* O1 = (const bf16*)(ws + WS_O1); bf16* A3 = (bf16*)(ws + WS_A3);
    const float l01 = wave_sum(a->b_lambda[lane] * a->b_lambda[64 + lane]), l23 = wave_sum(a->b_lambda[128 + lane] * a->b_lambda[192 + lane]);
    const float lam = __expf(l01) - __expf(l23) + LAM_INIT;
    float gsc[16];
#pragma unroll
    for (int i = 0; i < 16; ++i) gsc[i] = a->b_subln_g[(lane & 7) * 16 + i] * (1.0f - LAM_INIT);
    for (int row = gw; row < T; row += NGW) {
        const size_t o = (size_t)row * D + lane * 16;
        const v4u p0 = *(const v4u*)(O0 + o), p1 = *(const v4u*)(O0 + o + 8), q0 = *(const v4u*)(O1 + o), q1 = *(const v4u*)(O1 + o + 8);
        float d[16]; float ss = 0.f;
#pragma unroll
        for (int i = 0; i < 4; ++i) { d[2 * i] = bflo(p0[i]) - lam * bflo(q0[i]); d[2 * i + 1] = bfhi(p0[i]) - lam * bfhi(q0[i]);
            d[8 + 2 * i] = bflo(p1[i]) - lam * bflo(q1[i]); d[8 + 2 * i + 1] = bfhi(p1[i]) - lam * bfhi(q1[i]); }
#pragma unroll
        for (int i = 0; i < 16; ++i) ss += d[i] * d[i];
        ss += __shfl_xor(ss, 1); ss += __shfl_xor(ss, 2); ss += __shfl_xor(ss, 4);
        const float r = 1.0f / sqrtf(ss * (1.0f / 128.0f) + RMS_EPS);
        v4u w0, w1;
#pragma unroll
        for (int i = 0; i < 4; ++i) { w0[i] = pk2(d[2 * i] * r * gsc[2 * i], d[2 * i + 1] * r * gsc[2 * i + 1]); w1[i] = pk2(d[8 + 2 * i] * r * gsc[8 + 2 * i], d[8 + 2 * i + 1] * r * gsc[8 + 2 * i + 1]); }
        *(v4u*)(A3 + o) = w0; *(v4u*)(A3 + o + 8) = w1;
    }
}

#ifndef MKMASK
#define MKMASK 0xffff
#endif
#ifndef MKREP
#define MKREP 0
#endif
#ifndef MKSYNC
#define MKSYNC 0
#endif
#ifndef MKMASK2
#define MKMASK2 MKMASK
#endif
#define PH(k) _Pragma("unroll 1") for (int rep_ = 0; rep_ < (int)(((pass_ ? MKMASK2 : MKMASK) >> (k)) & 1) + (int)((MKREP >> (k)) & 1); ++rep_)
#define XB_TMO      128
#define XB_XCNT(j)  (256  + 64 * (j))
#define XB_XSUB(j)  (1280 + 64 * (j))
#define XB_XGEN(j)  (2304 + 64 * (j))
#define XB_TOP      3328
#define XB_TOPGEN   3392
#define XCD_BAR_WORDS 3456
#define XB_SPIN_CAP (1u << 18)

__device__ __forceinline__ unsigned xb_ld(unsigned* p)              { return __hip_atomic_load(p, __ATOMIC_RELAXED, __HIP_MEMORY_SCOPE_AGENT); }
__device__ __forceinline__ unsigned xb_add(unsigned* p, unsigned v) { return __hip_atomic_fetch_add(p, v, __ATOMIC_RELAXED, __HIP_MEMORY_SCOPE_AGENT); }
__device__ __forceinline__ unsigned xb_xcc_id() { return (unsigned)__builtin_amdgcn_s_getreg((3 << 11) | 20) & 0xFu; }
#define XB_SPIN(cond, bar) do { unsigned _sp = 0; while (cond) { __builtin_amdgcn_s_sleep(1); \
    if ((++_sp & 255u) == 0u) { if (xb_ld(&(bar)[XB_TMO])) break; if (_sp > XB_SPIN_CAP) { atomicAdd(&(bar)[XB_TMO], 1u); break; } } } } while (0)

struct XcdBarrier {
    unsigned* bar; unsigned x;
    volatile LAS unsigned* st;
};

__device__ __forceinline__ XcdBarrier xcd_barrier_post(unsigned* bar, volatile LAS unsigned* st) {
    XcdBarrier b; b.bar = bar; b.x = xb_xcc_id(); b.st = st;
    if (threadIdx.x == 0) (void)xb_add(&bar[XB_XCNT(b.x)], 1u);
    return b;
}
__device__ __forceinline__ void xcd_barrier_complete(unsigned* bar, unsigned x, unsigned& nloc, unsigned& nx) {
    const unsigned G = gridDim.x * gridDim.y * gridDim.z;
    unsigned sum, cnt, mine, sp = 0u;
    for (;;) {
        sum = 0u; cnt = 0u; mine = 0u;
#pragma unroll
        for (unsigned j = 0; j < 16; ++j) { const unsigned c = xb_ld(&bar[XB_XCNT(j)]); sum += c; cnt += (c > 0u) ? 1u : 0u; mine = (j == x) ? c : mine; }
        if (sum == G) break;
        __builtin_amdgcn_s_sleep(1);
        if ((++sp & 255u) == 0u) { if (xb_ld(&bar[XB_TMO])) break; if (sp > XB_SPIN_CAP) { atomicAdd(&bar[XB_TMO], 1u); break; } }
    }
    nloc = mine > 0u ? mine : 1u; nx = cnt > 0u ? cnt : 1u;
}

__device__ __forceinline__ void xcd_barrier(const XcdBarrier& b) {
    asm volatile("s_waitcnt vmcnt(0)" ::: "memory");
    __syncthreads();
    if (threadIdx.x == 0) {
        unsigned* bar = b.bar;
        __builtin_amdgcn_s_waitcnt(0);
        unsigned nloc = b.st[0], nx = b.st[1];
        if (nloc == 0u) { xcd_barrier_complete(bar, b.x, nloc, nx); b.st[0] = nloc; b.st[1] = nx; }
        const unsigned old = xb_add(&bar[XB_XSUB(b.x)], 1u);
        const unsigned gen = old / nloc;
        if (old + 1u == (gen + 1u) * nloc) {
            __builtin_amdgcn_fence(__ATOMIC_RELEASE, "agent");
            asm volatile("s_waitcnt vmcnt(0)" ::: "memory");
            const unsigned og = xb_add(&bar[XB_TOP], 1u);
            const unsigned tg = og / nx;
            if (og + 1u == (tg + 1u) * nx) xb_add(&bar[XB_TOPGEN], 1u);
            else XB_SPIN(xb_ld(&bar[XB_TOPGEN]) == tg, bar);
            __builtin_amdgcn_fence(__ATOMIC_ACQUIRE, "agent");
            xb_add(&bar[XB_XGEN(b.x)], 1u);
            asm volatile("s_waitcnt vmcnt(0)" ::: "memory");
        } else {
            XB_SPIN(xb_ld(&bar[XB_XGEN(b.x)]) == gen, bar);
            __builtin_amdgcn_fence(__ATOMIC_ACQUIRE, "agent");
            asm volatile("s_waitcnt vmcnt(0)" ::: "memory");
        }
    }
    __syncthreads();
}

constexpr int CW_BAR = 16384;
constexpr int ST_OFF = MISC_OFF + 1024;
__device__ __forceinline__ void seam(LAS unsigned char* lds) { const ArgsP a = kargs(); XcdBarrier b; b.bar = (unsigned*)(a->ws + WS_CTL) + CW_BAR; b.x = xb_xcc_id(); b.st = (volatile LAS unsigned*)(lds + ST_OFF); xcd_barrier(b); }
__device__ __forceinline__ void gemm1_phase(LAS unsigned char* lds) { const ArgsP a = kargs(); const Ctx cx = mkctx(a); unsigned char* ws = cx.ws;
    const int ng = ROLE_SPLIT ? cx.G - cx.G / 4 : cx.G;
    if (cx.bx < ng) { SchedDense S{ng, cx.bx, 12, 0, D, (const char*)(ws + WS_W1T)}; EpiConvIn E{(bf16*)(ws + WS_GB), (bf16*)(ws + WS_U)};
        pg8::gemm_phase(lds, (const char*)(ws + WS_XB), D, S, E); }
    else p0_items(lds, PS1 + P0A_EXTRA, P0_NITEMS, (cx.bx - ng) * NWAVES + cx.wave, (cx.G - ng) * NWAVES); }
__device__ __forceinline__ void gemm2_phase(LAS unsigned char* lds) { const ArgsP a = kargs(); const Ctx cx = mkctx(a); unsigned char* ws = cx.ws;
    SchedDense S{cx.G, cx.bx, 4, 1, D, (const char*)(ws + WS_W2T)}; EpiResZ<true> E{(const void*)(ws + WS_XB), (bf16*)(ws + LZ(0))};
    pg8::gemm_phase(lds, (const char*)(ws + WS_A2), D, S, E); }
__device__ __forceinline__ void kvq_phase(LAS unsigned char* lds) { const ArgsP a = kargs(); const Ctx cx = mkctx(a); unsigned char* ws = cx.ws;
    SchedDense S{cx.G, cx.bx, 12, 1, D, (const char*)(ws + WS_WKVQ)}; EpiKVQ E{(bf16*)(ws + WS_K)};
    pg8::gemm_phase(lds, (const char*)(ws + WS_X2B), D, S, E); }
__device__ __forceinline__ void wo_phase(LAS unsigned char* lds) { const ArgsP a = kargs(); const Ctx cx = mkctx(a); unsigned char* ws = cx.ws;
    SchedDense S{cx.G, cx.bx, 4, 1, D, (const char*)(ws + WS_WOT)}; EpiResZ<true> E{(const void*)(ws + WS_X2B), (bf16*)(ws + LZ(1))};
    pg8::gemm_phase(lds, (const char*)(ws + WS_A3), D, S, E); }
#ifndef ATTN128
#define ATTN128 1
#endif
#if ATTN128
__device__ __forceinline__ void attn_phase(char* lds_generic) { const ArgsP a = kargs(); const Ctx cx = mkctx(a); unsigned char* ws = cx.ws;
    const float l01 = dpp_sum1(a->b_lambda[cx.lane] * a->b_lambda[64 + cx.lane]), l23 = dpp_sum1(a->b_lambda[128 + cx.lane] * a->b_lambda[192 + cx.lane]);
    const float lam = __expf(l01) - __expf(l23) + LAM_INIT;
#pragma unroll 1
    for (int uix = cx.bx; uix < BATCH * NH * 4 * 2; uix += cx.G) {
        const int bh = (uix & 255) >> 2, j = uix & 3, qi = uix >> 8;
        const int b = bh >> 3, h = bh & 7, qb = qi == 0 ? j : 7 - j;
        const attn128::bf16* K0 = (const attn128::bf16*)(ws + WS_K) + h * 128;
        const attn128::bf16* Vc = (const attn128::bf16*)(ws + WS_V) + h * 128;
        attn128::bf16* Ac = (attn128::bf16*)(ws + WS_A3) + h * 128;
        attn128::attn_unit<8, 1>((long)b * SEQ, qb, K0 + (WS_Q - WS_K) / 2, K0, Vc, Ac, lds_generic, 0.f, nullptr, 0.f, 0.f);
        attn128::attn_unit<8, 2>((long)b * SEQ, qb, K0 + 64 + (WS_Q - WS_K) / 2, K0 + 64, Vc, Ac, lds_generic, lam, a->b_subln_g, 1.0f - LAM_INIT, RMS_EPS);
    }
}
#else
__device__ __forceinline__ void attn_phase(char* lds_generic) { const ArgsP a = kargs(); const Ctx cx = mkctx(a); unsigned char* ws = cx.ws;
#pragma unroll 1
    for (int uix = cx.bx; uix < BATCH * NH * 4 * (SEQ / 256); uix += cx.G) {
        const int combo = uix & 255, qi = uix >> 8;
        const int b = combo >> 5, h = (combo >> 2) & 7, c = (combo >> 1) & 1, vh = combo & 1;
        const int qb = (qi & 1) ? (SEQ / 256 - 1 - (qi >> 1)) : (qi >> 1);
        const attn_body::bf16* QK = (const attn_body::bf16*)(ws + WS_K) + h * 128 + c * 64;
        const attn_body::bf16* Vc = (const attn_body::bf16*)(ws + WS_V) + h * 128 + vh * 64;
        attn_body::bf16* Oc = (attn_body::bf16*)(ws + (c ? WS_O1 : WS_O0)) + h * 128 + vh * 64;
        attn_body::attn_unit<8>((long)b * SEQ, qb, QK + (WS_Q - WS_K) / 2, QK, Vc, Oc, lds_generic);
    }
}
#endif
__device__ __forceinline__ int scan_excl32(int v, int lane) {
    int x = v;
#pragma unroll
    for (int o = 1; o < 32; o <<= 1) { const int y = __shfl_up(x, o); if ((lane & 31) >= o) x += y; }
    return x - v;
}
__device__ __forceinline__ void moe_tables(LAS unsigned char* lds, int layer) { const ArgsP a = kargs(); const Ctx cx = mkctx(a); LAS int* misc = (LAS int*)(lds + MISC_OFF);
    const int* cnt = (const int*)(cx.ws + WS_CTL) + layer * NE * CNT_STRIDE;
    if (cx.tid < 64) {
        const int e = cx.lane, cn = e < NE ? __hip_atomic_load(cnt + e * CNT_STRIDE, __ATOMIC_RELAXED, __HIP_MEMORY_SCOPE_AGENT) : 0;
        const int rt = (cn + 255) >> 8, half = (cn > 0 && ((cn - 1) & 255) < 128) ? 1 : 0;
        const int uf = e < NE ? 4 * (rt - half) : 0, uh = e < NE ? 4 * half : 0, pr = e < NE ? 256 * rt : 0;
        const int sp = scan_excl32(pr, e); const int totp = __shfl(sp + pr, 31);
        if (e < NE) { misc[128 + e] = cn; misc[192 + e] = sp; }
        if (e == 0) misc[192 + NE] = totp;
        const int x = e & 7, sg = e >> 3, es = x + 8 * (sg & 3);
        const int vf = __shfl(uf, es), vh = __shfl(uh, es);
        const int val = sg < 4 ? vf : vh;
        int inc = val;
#pragma unroll
        for (int o = 8; o < 64; o <<= 1) { const int y = __shfl_up(inc, o); if (e >= o) inc += y; }
        misc[x * 9 + sg] = inc - val; if (sg == 7) misc[x * 9 + 8] = inc;
    }
    __syncthreads(); }
constexpr int CW_READY = 4096;
__device__ __forceinline__ void moe_up_phase(LAS unsigned char* lds, int layer, bool merged) { const ArgsP a = kargs(); const Ctx cx = mkctx(a); unsigned char* ws = cx.ws; LAS int* misc = (LAS int*)(lds + MISC_OFF);
    const MoeTab tb{misc, misc + 192, misc + 128};
    SchedMoe S{cx.G, cx.bx, D, true, (const char*)(ws + WS_WUT) + (size_t)layer * NE * D * D * 2, (const v2u*)(ws + LPERM(layer)), tb, (unsigned*)(ws + WS_CTL) + CW_READY, merged ? 1 : 0, 0, 0};
    if (merged) { EpiUp<true> E{(bf16*)(ws + LACT(layer))}; pg8::gemm_phase(lds, (const char*)(ws + (layer == 0 ? WS_X1B : WS_X3B)), D, S, E); }
    else { EpiUp<false> E{(bf16*)(ws + LACT(layer))}; pg8::gemm_phase(lds, (const char*)(ws + (layer == 0 ? WS_X1B : WS_X3B)), D, S, E); } }
__device__ __forceinline__ void moe_down_phase(LAS unsigned char* lds, int layer, bool merged) { const ArgsP a = kargs(); const Ctx cx = mkctx(a); unsigned char* ws = cx.ws; LAS int* misc = (LAS int*)(lds + MISC_OFF);
    const MoeTab tb{misc, misc + 192, misc + 128};
    int nb = 0;
    if (merged) { const int U = misc[2 * NE], rem = U % cx.G; nb = rem ? cx.G - rem : 0; }
    SchedMoe S{cx.G, cx.bx, DE, false, (const char*)(ws + WS_WDT) + (size_t)layer * NE * D * DE * 2, (const v2u*)(ws + LPERM(layer)), tb, (unsigned*)(ws + WS_CTL) + CW_READY, merged ? 2 : 0, 0, nb};
    EpiDown E{(bf16*)(ws + LYP(layer)), (const v2u*)(ws + LPERM(layer))};
    pg8::gemm_phase(lds, (const char*)(ws + LACT(layer)), DE, S, E); }

__global__ void __launch_bounds__(NTHREADS, 2) fwd_megakernel(Args args_unused) {
    extern __shared__ __attribute__((aligned(16))) unsigned char lds_raw[];
#ifdef NOSYNC
    struct { __device__ void sync() const {} } grid;
#else
    cg::grid_group grid = cg::this_grid();
#endif
#define SEAM() seam(lds)
    LAS unsigned char* lds = (LAS unsigned char*)lds_raw;
#ifndef MKPASS
#define MKPASS 1
#endif
    { const ArgsP a = kargs(); int t = threadIdx.x; asm volatile("" : "+v"(t));
      if (t < 2) ((volatile LAS unsigned*)(lds + ST_OFF))[t] = 0u;
      __syncthreads();
      (void)xcd_barrier_post((unsigned*)(a->ws + WS_CTL) + CW_BAR, (volatile LAS unsigned*)(lds + ST_OFF));
      if (a->ws == nullptr) grid.sync(); }
#pragma unroll 1
    for (int pass_ = 0; pass_ < MKPASS; ++pass_) {
    if (pass_) SEAM();
    PH(0) p0_prologue(lds);
    SEAM();
    PH(1) gemm1_phase(lds);
    SEAM();
    PH(2) conv_phase();
    SEAM();
    PH(3) gemm2_phase(lds);
    SEAM();
    PH(8) ln_router_mfma(lds, 0, rep_ + pass_);
    SEAM();
    moe_tables(lds, 0);
    PH(9) { moe_up_phase(lds, 0, false); if (P0B_FILL && pass_ == 0) p0b_idle_fill(lds, 0, P0B_SPLIT); }
    SEAM();
    PH(10) { moe_down_phase(lds, 0, false); if (P0B_FILL && pass_ == 0) p0b_idle_fill(lds, P0B_SPLIT, P0B_ITEMS); }
    SEAM();
    PH(11) ln2_phase(0);
    SEAM();
    PH(4) kvq_phase(lds);
    SEAM();
    PH(5) attn_phase((char*)lds_raw);
    SEAM();
#if !ATTN128
    PH(6) combine_phase();
    SEAM();
#endif
    PH(7) wo_phase(lds);
    SEAM();
    PH(8) ln_router_mfma(lds, 1, rep_ + pass_);
    SEAM();
    moe_tables(lds, 1);
#if MOE_MERGE
    PH(9) moe_up_phase(lds, 1, pass_ == 0);
    if (pass_) SEAM();
    PH(10) moe_down_phase(lds, 1, pass_ == 0);
#else
    PH(9) moe_up_phase(lds, 1, false);
    SEAM();
    PH(10) moe_down_phase(lds, 1, false);
#endif
    SEAM();
    PH(11) ln2_phase(1);
    }
#pragma unroll 1
    for (int i = 0; i < MKSYNC; ++i) SEAM();
}
}

extern "C" void kernel_launch(void* const* d_in, const int* in_sizes, int n_in, void* d_out, int out_size, void* d_ws, size_t ws_size, hipStream_t stream) {
    using namespace mk;
    static int grid = 0;
    if (grid == 0) {
        if (n_in != 19 || out_size != T * D || ws_size < WS_END) { fprintf(stderr, "kernel_launch: unexpected shapes / workspace (n_in %d out %d ws %zu, need %zu)\n", n_in, out_size, ws_size, (size_t)WS_END); grid = -1; return; }
        int dev = 0, cus = 0, per_cu = 0;
        (void)hipGetDevice(&dev); (void)hipDeviceGetAttribute(&cus, hipDeviceAttributeMultiprocessorCount, dev);
        if (hipFuncSetAttribute((const void*)fwd_megakernel, hipFuncAttributeMaxDynamicSharedMemorySize, LDS_BYTES) != hipSuccess) { fprintf(stderr, "kernel_launch: hipFuncSetAttribute failed\n"); grid = -1; return; }
        if (hipOccupancyMaxActiveBlocksPerMultiprocessor(&per_cu, (const void*)fwd_megakernel, NTHREADS, LDS_BYTES) != hipSuccess || per_cu < 1) { fprintf(stderr, "kernel_launch: occupancy query says %d blocks per CU\n", per_cu); grid = -1; return; }
        grid = cus * 1;
        if (grid != T / 64) { fprintf(stderr, "kernel_launch: this build needs exactly %d workgroups (one per CU of a 256-CU MI355X: the LN1 + router phase gives each 64 rows); device has %d CUs\n", T / 64, cus); grid = -1; return; }
        (void)hipGetLastError();
    }
    if (grid < 0) return;
    if (hipMemsetAsync((char*)d_ws + WS_CTL, 0, (size_t)(CW_BAR + XCD_BAR_WORDS) * 4, stream) != hipSuccess) { fprintf(stderr, "kernel_launch: hipMemsetAsync of the control words failed\n"); return; }
    Args a{};
    a.x = (const float*)d_in[0]; a.a_w_in = (const float*)d_in[1]; a.a_conv_w = (const float*)d_in[2]; a.a_w_out = (const float*)d_in[3]; a.kv_w = (const float*)d_in[4];
    a.b_w_q = (const float*)d_in[5]; a.b_lambda = (const float*)d_in[6]; a.b_subln_g = (const float*)d_in[7]; a.b_w_o = (const float*)d_in[8];
    a.ln1_g = (const float*)d_in[9]; a.ln1_b = (const float*)d_in[10]; a.ln2_g = (const float*)d_in[11]; a.ln2_b = (const float*)d_in[12];
    a.rg_w = (const float*)d_in[13]; a.rg_b = (const float*)d_in[14]; a.re_w = (const float*)d_in[15]; a.re_b = (const float*)d_in[16];
    a.e_w_in = (const float*)d_in[17]; a.e_w_down = (const float*)d_in[18];
    a.out = (float*)d_out; a.ws = (unsigned char*)d_ws;
    void* kargs[] = {&a};
    const hipError_t e = hipLaunchCooperativeKernel((const void*)fwd_megakernel, dim3(grid), dim3(NTHREADS), kargs, LDS_BYTES, stream);
    if (e != hipSuccess) fprintf(stderr, "kernel_launch: cooperative launch failed: %s (grid %d)\n", hipGetErrorString(e), grid);
}
```

```cpp
#include <hip/hip_runtime.h>
#include <hip/hip_cooperative_groups.h>
#include <cstdio>
#include <cstdint>
namespace cg = cooperative_groups;

namespace pg8 {
#define PG8_LAS __attribute__((address_space(3)))
typedef unsigned short bf16_t;
typedef short bf16x8 __attribute__((ext_vector_type(8)));
typedef float f32x4 __attribute__((ext_vector_type(4)));
typedef unsigned u32x4 __attribute__((ext_vector_type(4)));
typedef unsigned u32x2 __attribute__((ext_vector_type(2)));
constexpr int BM = 256, BK = 64, HALF = 128, HTB = HALF * BK * 2  , STAGE_BYTES = 8 * HTB, NXCD = 8, WGM = 8;

__host__ __device__ __forceinline__ int lds_byte(int r, int c) { const int st = (r >> 4) * 2 + (c >> 5), rr = r & 15, cc = c & 31, ob = rr * 64 + cc * 2; return st * 1024 + (ob ^ (((ob >> 9) & 1) << 5)); }
__host__ __device__ __forceinline__ void stage_rc(int b, int& R, int& C) { const int st = b / 1024, sb = b % 1024, swz = sb ^ (((sb >> 9) & 1) << 5); R = (st >> 1) * 16 + swz / 64; C = (st & 1) * 32 + (swz % 64) / 2; }
__host__ __device__ __forceinline__ int perm32(int rho) { const int n = rho >> 4, i = rho & 15; return 8 * (i >> 2) + 4 * n + (i & 3); }

struct Unit { const char* b0; const char* b1; int arow; int p0, p1, p2, p3; };

__device__ __forceinline__ bool static_tile(int i, int G, int c, int nM, int nN, int& pm, int& pn) {
    const int nwg = nM * nN; const long L = (long)i * G + c; if (L >= nwg) return false;
    int wgid = (int)L; { const int q = nwg / NXCD, r = nwg % NXCD, xcd = wgid % NXCD, off = wgid / NXCD; wgid = (xcd < r ? xcd * (q + 1) : r * (q + 1) + (xcd - r) * q) + off; }
    const int nig = WGM * nN, gid = wgid / nig, fm = gid * WGM, gsz = (nM - fm) < WGM ? (nM - fm) : WGM;
    pm = fm + ((wgid % nig) % gsz); pn = (wgid % nig) / gsz; return true;
}

__device__ __forceinline__ unsigned cvt_pk_bf16(float lo, float hi) { unsigned r; asm volatile("v_cvt_pk_bf16_f32 %0, %1, %2" : "=v"(r) : "v"(lo), "v"(hi)); return r; }

template <class Epi, class Sched>
__device__ __forceinline__ void gemm_phase(PG8_LAS unsigned char* lds, const char* Abase, const int K, const Sched& S, const Epi& E) {
    int tid_ = threadIdx.x; asm volatile("" : "+v"(tid_));
    const int tid = tid_, wid = __builtin_amdgcn_readfirstlane(tid >> 6), lane = tid & 63, wr = wid >> 2, wc = wid & 3, fr = lane & 15, fq = lane >> 4;
    const int nt = K / BK;
    int R[2], C[2]; unsigned voffB[2];
#pragma unroll
    for (int i = 0; i < 2; ++i) { stage_rc(tid * 16 + i * 8192, R[i], C[i]); const int Rb = Epi::PERM ? ((R[i] & ~31) + perm32(R[i] & 31)) : R[i]; voffB[i] = (unsigned)(Rb * K + C[i]) * 2u; }
    const size_t kstep = (size_t)(BK * 2);
    const unsigned ldsw = (unsigned)wid * 1024u;
    const int aoff = lds_byte(wr * 64 + fr, fq * 8), boff = lds_byte(wc * 32 + fr, fq * 8);
#define PG8_SA(b, h) (((b) * 2 + (h)) * HTB)
#define PG8_SB(b, h) ((4 + (b) * 2 + (h)) * HTB)
#define PG8_STAGE(bufoff, gbase, v0, v1) do { \
        __builtin_amdgcn_global_load_lds((const unsigned*)((const char*)(gbase) + (v0)), (PG8_LAS unsigned*)(lds + (bufoff) + ldsw), 16, 0, 0); \
        __builtin_amdgcn_global_load_lds((const unsigned*)((const char*)(gbase) + (v1)), (PG8_LAS unsigned*)(lds + (bufoff) + ldsw + 8192), 16, 0, 0); } while (0)
#define PG8_STAGEB(bufoff, gbase) PG8_STAGE(bufoff, gbase, voffB[0], voffB[1])
#define PG8_LDA(dst, b, h) do { _Pragma("unroll") for (int m = 0; m < 4; ++m) _Pragma("unroll") for (int k = 0; k < 2; ++k) dst[m][k] = *(const PG8_LAS bf16x8*)(lds + PG8_SA(b, h) + aoff + m * 2048 + k * 1024); } while (0)
#define PG8_LDB(dst, b, h) do { _Pragma("unroll") for (int n = 0; n < 2; ++n) _Pragma("unroll") for (int k = 0; k < 2; ++k) dst[n][k] = *(const PG8_LAS bf16x8*)(lds + PG8_SB(b, h) + boff + n * 2048 + k * 1024); } while (0)
#define PG8_MMA(ai, bj, At, Bt) do { __builtin_amdgcn_s_setprio(1); _Pragma("unroll") for (int m = 0; m < 4; ++m) _Pragma("unroll") for (int n = 0; n < 2; ++n) _Pragma("unroll") for (int k = 0; k < 2; ++k) \
        acc[ai][bj][m][n] = __builtin_amdgcn_mfma_f32_16x16x32_bf16(Bt[n][k], At[m][k], acc[ai][bj][m][n], 0, 0, 0); __builtin_amdgcn_s_setprio(0); } while (0)
#define PG8_WAIT_V(n) asm volatile("s_waitcnt vmcnt(" #n ")" ::: "memory")
#define PG8_WAIT_L(n) asm volatile("s_waitcnt lgkmcnt(" #n ")" ::: "memory")
#define PG8_BAR __builtin_amdgcn_s_barrier()
#define PG8_SCHED __builtin_amdgcn_sched_barrier(0)
    Unit cur, nxt; int ui = 0;
    if (!S.next(0, cur)) return;
    f32x4 acc[2][2][4][2];
#pragma unroll
    for (int a = 0; a < 2; ++a)
#pragma unroll
        for (int b = 0; b < 2; ++b)
#pragma unroll
            for (int m = 0; m < 4; ++m)
#pragma unroll
                for (int n = 0; n < 2; ++n) acc[a][b][m][n] = (f32x4){0.f, 0.f, 0.f, 0.f};
    bf16x8 At[4][2], B0[2][2], B1[2][2];
    unsigned vA00, vA01, vA10, vA11, vN00, vN01, vN10, vN11;
    S.a_ready(cur, S.peek(cur));
    S.a_offs(cur, R, C, vA00, vA01, vA10, vA11);
    const char* cB0 = cur.b0; const char* cB1 = cur.b1;
    PG8_STAGEB(PG8_SB(0, 0), cB0); PG8_STAGEB(PG8_SB(0, 1), cB1); PG8_STAGE(PG8_SA(0, 0), Abase, vA00, vA01); PG8_STAGE(PG8_SA(0, 1), Abase, vA10, vA11);
    if (wr == 1) PG8_BAR;
    PG8_WAIT_V(2); PG8_BAR;
    PG8_STAGEB(PG8_SB(1, 0), cB0 + kstep); PG8_STAGE(PG8_SA(1, 0), Abase + kstep, vA00, vA01); PG8_STAGEB(PG8_SB(1, 1), cB1 + kstep);
    PG8_WAIT_V(6); PG8_BAR;
    for (;;) {
        const bool has_next = S.next(ui + 1, nxt);
        if (has_next) S.a_offs(nxt, R, C, vN00, vN01, vN10, vN11); else { vN00 = vA00; vN01 = vA01; vN10 = vA10; vN11 = vA11; }
        const char* nB0 = has_next ? nxt.b0 : cB0; const char* nB1 = has_next ? nxt.b1 : cB1;
        const unsigned pk = has_next ? S.peek(nxt) : 0u;
        const bool skip1 = S.half_only(cur);
        for (int t = 0; t < nt; t += 2) {
            const bool last = (t == nt - 2);
            if (last && has_next) S.a_ready(nxt, pk);
            const char* a1 = Abase + (size_t)(t + 1) * kstep;
            PG8_LDB(B0, 0, 0); PG8_LDB(B1, 0, 1); PG8_SCHED; PG8_LDA(At, 0, 0); PG8_STAGE(PG8_SA(1, 1), a1, vA10, vA11);
            PG8_WAIT_V(8); PG8_WAIT_L(0); PG8_BAR; PG8_MMA(0, 0, At, B0); PG8_MMA(0, 1, At, B1); PG8_BAR; PG8_SCHED;
            if (last) { vA00 = vN00; vA01 = vN01; vA10 = vN10; vA11 = vN11; }
            const char* a2 = last ? Abase : Abase + (size_t)(t + 2) * kstep;
            const char* b20 = last ? nB0 : cB0 + (size_t)(t + 2) * kstep; const char* b21 = last ? nB1 : cB1 + (size_t)(t + 2) * kstep;
            const char* a3 = a2 + kstep; const char* b30 = b20 + kstep; const char* b31 = b21 + kstep;
            PG8_LDA(At, 0, 1); PG8_STAGEB(PG8_SB(0, 0), b20); PG8_STAGEB(PG8_SB(0, 1), b21); PG8_STAGE(PG8_SA(0, 0), a2, vA00, vA01);
            PG8_WAIT_V(8); PG8_WAIT_L(0); PG8_BAR; if (!skip1) { PG8_MMA(1, 0, At, B0); PG8_MMA(1, 1, At, B1); } PG8_BAR; PG8_SCHED;
            PG8_LDB(B0, 1, 0); PG8_LDB(B1, 1, 1); PG8_SCHED; PG8_LDA(At, 1, 0); PG8_STAGE(PG8_SA(0, 1), a2, vA10, vA11);
            PG8_WAIT_V(8); PG8_WAIT_L(0); PG8_BAR; PG8_MMA(0, 0, At, B0); PG8_MMA(0, 1, At, B1); PG8_BAR; PG8_SCHED;
            PG8_LDA(At, 1, 1); PG8_STAGEB(PG8_SB(1, 0), b30); PG8_STAGEB(PG8_SB(1, 1), b31); PG8_STAGE(PG8_SA(1, 0), a3, vA00, vA01);
            PG8_WAIT_V(8); PG8_WAIT_L(0); PG8_BAR; if (!skip1) { PG8_MMA(1, 0, At, B0); PG8_MMA(1, 1, At, B1); } PG8_BAR; PG8_SCHED;
        }
        if (wr == 0) PG8_BAR;
        E(acc, cur, wr, wc, fr, fq);
        S.done(cur);
        if (!has_next) break;
#pragma unroll
        for (int a = 0; a < 2; ++a)
#pragma unroll
            for (int b = 0; b < 2; ++b)
#pragma unroll
                for (int m = 0; m < 4; ++m)
#pragma unroll
                    for (int n = 0; n < 2; ++n) acc[a][b][m][n] = (f32x4){0.f, 0.f, 0.f, 0.f};
        cur = nxt; cB0 = nB0; cB1 = nB1; ++ui;
        if (wr == 1) PG8_BAR;
    }
    PG8_WAIT_V(0);
    PG8_BAR;
#undef PG8_SA
#undef PG8_SB
#undef PG8_STAGE
#undef PG8_STAGEB
#undef PG8_LDA
#undef PG8_LDB
#undef PG8_MMA
#undef PG8_WAIT_V
#undef PG8_WAIT_L
#undef PG8_BAR
#undef PG8_SCHED
}
}
#include <hip/hip_bf16.h>
#include <cmath>
namespace attn_body {
using bf16=__hip_bfloat16;
using bf16x8=__attribute__((ext_vector_type(8)))short;
using s16x4=__attribute__((ext_vector_type(4)))short;
using f32x16=__attribute__((ext_vector_type(16)))float;
using u32x4=__attribute__((ext_vector_type(4)))unsigned;
constexpr int D=64,DM=1024;
constexpr int NW=8,QBLK=32,QB=QBLK*NW,KVBLK=64;
constexpr int ATTN_PITCH=DM, ATTN_UNIT_ROWS=QB;
__device__ __forceinline__ int crow(int r,int hi){return (r&3)+8*(r>>2)+4*hi;}
#define SBAR() __builtin_amdgcn_sched_barrier(0)
__device__ __forceinline__ void cmask(f32x16&p0,f32x16&p1,int jb,int qrel,int hi){
  const float NEG=-INFINITY; int kb=64*jb+4*hi;
  #pragma unroll
  for(int r=0;r<16;++r){int kv=kb+(r&3)+8*(r>>2); if(kv>qrel)p0[r]=NEG; if(kv+32>qrel)p1[r]=NEG;}
}

constexpr int NSLOT=3, SLOTB=8192;
constexpr int LDS_K=0, LDS_V=NSLOT*SLOTB, LDS_WS=2*NSLOT*SLOTB, LDS_OST=LDS_WS+NW*64*4, LDS_BYTES=LDS_OST+NW*4096;
constexpr float C2=0.125f*1.4426950408889634f;
__device__ __forceinline__ void glds16(const void*gsrc,unsigned lds_dst){unsigned keep;
  asm volatile("s_mov_b32 %0, m0\n\ts_mov_b32 m0, %2\n\ts_nop 0\n\tglobal_load_lds_dwordx4 %1, off\n\ts_mov_b32 m0, %0":"=&s"(keep):"v"(gsrc),"s"(lds_dst):"memory");}
__device__ __forceinline__ void glds16s(const void*sbase,unsigned voff,unsigned lds_dst){unsigned keep;
  asm volatile("s_mov_b32 %0, m0\n\ts_mov_b32 m0, %3\n\ts_nop 4\n\tglobal_load_lds_dwordx4 %1, %2\n\ts_mov_b32 m0, %0":"=&s"(keep):"v"(voff),"s"(sbase),"s"(lds_dst):"memory");}
__device__ __forceinline__ float max3f(float a,float b,float c){float r;asm("v_max3_f32 %0, %1, %2, %3":"=v"(r):"v"(a),"v"(b),"v"(c));return r;}
__device__ __forceinline__ float max2f(float a,float b){float r;asm("v_max_f32_e32 %0, %1, %2":"=v"(r):"v"(a),"v"(b));return r;}
__device__ __forceinline__ float fadd_s(float a,float b){float r;asm("v_add_f32_e32 %0, %1, %2":"=v"(r):"v"(a),"v"(b));return r;}
__device__ __forceinline__ float fsub_s(float a,float b){float r;asm("v_sub_f32_e32 %0, %1, %2":"=v"(r):"v"(a),"v"(b));return r;}
typedef float f32x2_t __attribute__((ext_vector_type(2))); typedef __bf16 bf16x2_t __attribute__((ext_vector_type(2)));
__device__ __forceinline__ unsigned cvtpk_s(float lo,float hi){f32x2_t v={lo,hi};bf16x2_t b=__builtin_convertvector(v,bf16x2_t);return __builtin_bit_cast(unsigned,b);}
#define WAIT_BAR(N) asm volatile("s_waitcnt vmcnt(" #N ") lgkmcnt(0)\n\ts_barrier":::"memory")

__device__ __forceinline__ void qkt(f32x16&p0,f32x16&p1,const char*Kslot,const bf16x8*qr,const f32x16&negm,int r32,int hi){
  const char*kb=Kslot+hi*1024+r32*16;
  #pragma unroll
  for(int d0=0;d0<4;++d0){
    const bf16x8 b0=*reinterpret_cast<const bf16x8*>(kb+d0*2048);
    const bf16x8 b1=*reinterpret_cast<const bf16x8*>(kb+d0*2048+512);
    if(d0==0){p0=__builtin_amdgcn_mfma_f32_32x32x16_bf16(b0,qr[0],negm,0,0,0);p1=__builtin_amdgcn_mfma_f32_32x32x16_bf16(b1,qr[0],negm,0,0,0);}
    else{p0=__builtin_amdgcn_mfma_f32_32x32x16_bf16(b0,qr[d0],p0,0,0,0);p1=__builtin_amdgcn_mfma_f32_32x32x16_bf16(b1,qr[d0],p1,0,0,0);}}
}
typedef __attribute__((address_space(3))) const char* lds_cptr;
typedef short v4i16_t __attribute__((ext_vector_type(4)));
__device__ __forceinline__ void kload8(bf16x8*kf,lds_cptr kp){
  kf[0]=*(const __attribute__((address_space(3))) bf16x8*)(kp);      kf[1]=*(const __attribute__((address_space(3))) bf16x8*)(kp+512);
  kf[2]=*(const __attribute__((address_space(3))) bf16x8*)(kp+2048); kf[3]=*(const __attribute__((address_space(3))) bf16x8*)(kp+2560);
  kf[4]=*(const __attribute__((address_space(3))) bf16x8*)(kp+4096); kf[5]=*(const __attribute__((address_space(3))) bf16x8*)(kp+4608);
  kf[6]=*(const __attribute__((address_space(3))) bf16x8*)(kp+6144); kf[7]=*(const __attribute__((address_space(3))) bf16x8*)(kp+6656);
}
__device__ __forceinline__ void kload2(bf16x8*kf,lds_cptr kp,int j){ kf[2*j]=*(const __attribute__((address_space(3))) bf16x8*)(kp+j*2048); kf[2*j+1]=*(const __attribute__((address_space(3))) bf16x8*)(kp+j*2048+512); }
__device__ __forceinline__ s16x4 vtr(lds_cptr p){ return __builtin_bit_cast(s16x4,__builtin_amdgcn_ds_read_tr16_b64_v4i16((__attribute__((address_space(3))) v4i16_t*)p)); }
__device__ __forceinline__ float rowmax(const f32x16&p0,const f32x16&p1){
  float a=max3f(p0[0],p0[1],p1[0]),b=max3f(p0[2],p0[3],p1[1]);a=max3f(a,p1[2],p1[3]);
  #pragma unroll
  for(int r=4;r<16;r+=4){a=max3f(a,p0[r],p0[r+1]);b=max3f(b,p0[r+2],p0[r+3]);a=max3f(a,p1[r],p1[r+1]);b=max3f(b,p1[r+2],p1[r+3]);}
  const float m=max2f(a,b);
  auto rr=__builtin_amdgcn_permlane32_swap(__float_as_uint(m),__float_as_uint(m),false,false);
  return max2f(__uint_as_float(rr[0]),__uint_as_float(rr[1]));
}
__device__ __forceinline__ void pv(f32x16*o,int vb,bf16x8 pa0,bf16x8 pa1,bf16x8 pa2,bf16x8 pa3){
  #pragma unroll
  for(int d0=0;d0<2;++d0){s16x4 lo[4],hi[4];
    #pragma unroll
    for(int ks=0;ks<4;++ks){
      asm volatile("ds_read_b64_tr_b16 %0,%1 offset:%c2":"=&v"(lo[ks]):"v"(vb),"i"(d0*4096+ks*1024):"memory");
      asm volatile("ds_read_b64_tr_b16 %0,%1 offset:%c2":"=&v"(hi[ks]):"v"(vb),"i"(d0*4096+ks*1024+512):"memory");}
    asm volatile("s_waitcnt lgkmcnt(0)":::"memory");SBAR();
    #define PK(k) (bf16x8){lo[k][0],lo[k][1],lo[k][2],lo[k][3],hi[k][0],hi[k][1],hi[k][2],hi[k][3]}
    o[d0]=__builtin_amdgcn_mfma_f32_32x32x16_bf16(pa0,PK(0),o[d0],0,0,0);
    o[d0]=__builtin_amdgcn_mfma_f32_32x32x16_bf16(pa1,PK(1),o[d0],0,0,0);
    o[d0]=__builtin_amdgcn_mfma_f32_32x32x16_bf16(pa2,PK(2),o[d0],0,0,0);
    o[d0]=__builtin_amdgcn_mfma_f32_32x32x16_bf16(pa3,PK(3),o[d0],0,0,0);
    #undef PK
  }
}

#ifndef ATTN_STORE16
#define ATTN_STORE16(p,v) (*(u32x4*)(p)=(v))
#endif
template<int THRL> __device__ __forceinline__ void attn_unit(long rowbase,int qb,const bf16*Qc,const bf16*__restrict__ Kc,const bf16*__restrict__ Vc,bf16*Oc,char*shm){
  int tid_=threadIdx.x; asm volatile("":"+v"(tid_)); const int tid=tid_,lane=tid&63,r32=lane&31,hi=lane>>5; const int wid=__builtin_amdgcn_readfirstlane(tid>>6);
  const int q0=qb*QB;
  const bf16*Qw=Qc+(rowbase+q0+wid*QBLK)*DM;
  const bf16*Kh=Kc+rowbase*DM,*Vh=Vc+rowbase*DM;
  const unsigned lds0=(unsigned)(uintptr_t)shm;
  float*wsf=(float*)(shm+LDS_WS)+wid*64;
  const unsigned koff=(unsigned)(lane*DM+wid*8)*2u;
  const unsigned voffv=(unsigned)((16*(wid&3)+(lane>>2))*DM+(wid>>2)*32+(lane&3)*8)*2u;
  const unsigned kdst=lds0+LDS_K+wid*1024, vdst=lds0+LDS_V+wid*1024;
  #define DMA_K(t,slot) glds16s(Kh+(long)(t)*KVBLK*DM,koff,(unsigned)__builtin_amdgcn_readfirstlane(kdst+(slot)))
  #define DMA_V(t,slot) glds16s(Vh+(long)(t)*KVBLK*DM,voffv,(unsigned)__builtin_amdgcn_readfirstlane(vdst+(slot)))
  const int vb0=(int)(lds0+LDS_V)+((lane>>4)&1)*32+(lane&3)*8+(4*hi+((lane&15)>>2))*64;
  const char*Kbase=shm+LDS_K; bf16x8 kf[8];
  const lds_cptr shm3=(lds_cptr)shm; const lds_cptr kp0=shm3+LDS_K+hi*1024+r32*16; const lds_cptr vp0=shm3+LDS_V+((lane>>4)&1)*32+(lane&3)*8+(4*hi+((lane&15)>>2))*64;
  const int NT=(q0+QB)/KVBLK;
  DMA_K(0,0);DMA_V(0,0);DMA_K(1,SLOTB);
  bf16x8 qr[4];
  #pragma unroll
  for(int d0=0;d0<4;++d0)qr[d0]=*reinterpret_cast<const bf16x8*>(&Qw[(long)r32*DM+d0*16+hi*8]);
  float mhat=0.f,l_reg=0.f;f32x16 o[2];o[0]=f32x16{};o[1]=f32x16{};f32x16 negm=f32x16{};asm volatile("":"+v"(negm));
  const int qrel=wid*QBLK+r32;
  #define CMASK(P0,P1,t) do{int jb_=(t)-(NT-4); if(jb_>=0)cmask(P0,P1,jb_,qrel,hi);}while(0)
  bool resc=false;
  #define START(P0,P1) do{ const float rm=rowmax(P0,P1); resc=false; \
    { const float dl=rm; mhat=fadd_s(mhat,dl); \
      _Pragma("unroll") for(int r=0;r<16;++r){P0[r]=fsub_s(P0[r],dl);P1[r]=fsub_s(P1[r],dl);} \
      _Pragma("unroll") for(int r=0;r<16;++r)negm[r]=-mhat; asm volatile("":"+v"(negm)); } \
    _Pragma("unroll") for(int r=0;r<16;++r)P0[r]=__builtin_amdgcn_exp2f(P0[r]); }while(0)
  #define RESC() do{ if(resc){ asm volatile("s_waitcnt lgkmcnt(0)":::"memory"); \
      _Pragma("unroll") for(int d_=0;d_<2;++d_) _Pragma("unroll") for(int r=0;r<16;++r)o[d_][r]*=wsf[crow(r,hi)]; } }while(0)
  f32x16 pA0,pA1,pB0,pB1;
  int sl_prev=0,sl_cur=0,sl_next=SLOTB;
  #define ROT() do{sl_prev=sl_cur;sl_cur=sl_next;sl_next=(sl_next==(NSLOT-1)*SLOTB)?0:sl_next+SLOTB;}while(0)
  DMA_K(2,2*SLOTB);
  WAIT_BAR(3);
  qkt(pA0,pA1,Kbase,qr,negm,r32,hi);asm volatile("s_nop 15\n\ts_nop 7":"+v"(pA0),"+v"(pA1));CMASK(pA0,pA1,0);
  START(pA0,pA1);
  _Pragma("unroll") for(int r=0;r<16;++r)pA1[r]=__builtin_amdgcn_exp2f(pA1[r]);
  WAIT_BAR(0);
  DMA_K(3,0);DMA_V(1,SLOTB);
  ROT();
  kload8(kf,kp0+sl_cur);
  WAIT_BAR(2);
  s16x4 vlo[8],vhi[8]; u32x4 pw0,pw1,pw2,pw3;
  #define PKW(P,B) cvtpk_s(P[B],P[B+1])
  #define PAF(k) __builtin_bit_cast(bf16x8,pw##k)
  #define VFR(i) (bf16x8){vlo[i][0],vlo[i][1],vlo[i][2],vlo[i][3],vhi[i][0],vhi[i][1],vhi[i][2],vhi[i][3]}
  #define PIN(x) asm volatile("":"+v"(x))
  #define MX3(a,b,c) __builtin_fmaxf(__builtin_fmaxf((a),(b)),(c))
  #define GAPA(MF,A0,A1,A2,A3,W0,W1,PW) do{ MF; sacc+=A0; sacc+=A1; sacc+=A2; sacc+=A3; PIN(sacc); W0; W1; PIN(PW); SBAR(); }while(0)
  #define EX(v) __builtin_amdgcn_exp2f(v)
  #define GAPB(MF,X,B) do{ MF; X[B]=EX(X[B]); X[B+1]=EX(X[B+1]); X[B+2]=EX(X[B+2]); X[B+3]=EX(X[B+3]); PIN(X); SBAR(); }while(0)
  #define VRD(i) do{ vlo[i]=vtr(vp_+(((i)>>2)*4096+((i)&3)*1024)); vhi[i]=vtr(vp_+(((i)>>2)*4096+((i)&3)*1024+512)); }while(0)
  #define KRD(G,j) do{ if(G){ kload2(kf,kp0+sl_next,j); SBAR(); } }while(0)
  #define STEP(C0,C1,P0,P1,t,GK,GV,GL) do{ SBAR(); \
    const lds_cptr vp_=vp0+sl_prev; \
    VRD(0); SBAR(); float sacc=(P0[0]+P0[1]); \
    GAPA(C0=__builtin_amdgcn_mfma_f32_32x32x16_bf16(kf[0],qr[0],negm,0,0,0), P0[2],P0[3],P0[4],P0[5],     pw0[0]=PKW(P0,0), pw0[1]=PKW(P0,2), pw0); \
    VRD(4); SBAR(); GAPA(C1=__builtin_amdgcn_mfma_f32_32x32x16_bf16(kf[1],qr[0],negm,0,0,0), P0[6],P0[7],P0[8],P0[9],     pw0[2]=PKW(P0,4), pw0[3]=PKW(P0,6), pw0); \
    VRD(1); SBAR(); GAPA(C0=__builtin_amdgcn_mfma_f32_32x32x16_bf16(kf[2],qr[1],C0,0,0,0),   P0[10],P0[11],P0[12],P0[13], pw1[0]=PKW(P0,8), pw1[1]=PKW(P0,10), pw1); \
    VRD(5); SBAR(); GAPA(C1=__builtin_amdgcn_mfma_f32_32x32x16_bf16(kf[3],qr[1],C1,0,0,0),   P0[14],P0[15],P1[0],P1[1],   pw1[2]=PKW(P0,12),pw1[3]=PKW(P0,14), pw1); \
    VRD(2); SBAR(); GAPA(C0=__builtin_amdgcn_mfma_f32_32x32x16_bf16(kf[4],qr[2],C0,0,0,0),   P1[2],P1[3],P1[4],P1[5],     pw2[0]=PKW(P1,0), pw2[1]=PKW(P1,2), pw2); \
    VRD(6); SBAR(); GAPA(C1=__builtin_amdgcn_mfma_f32_32x32x16_bf16(kf[5],qr[2],C1,0,0,0),   P1[6],P1[7],P1[8],P1[9],     pw2[2]=PKW(P1,4), pw2[3]=PKW(P1,6), pw2); \
    VRD(3); SBAR(); GAPA(C0=__builtin_amdgcn_mfma_f32_32x32x16_bf16(kf[6],qr[3],C0,0,0,0),   P1[10],P1[11],P1[12],P1[13], pw3[0]=PKW(P1,8), pw3[1]=PKW(P1,10), pw3); \
    VRD(7); SBAR(); GAPA(C1=__builtin_amdgcn_mfma_f32_32x32x16_bf16(kf[7],qr[3],C1,0,0,0),   P1[14],P1[15],0.f,0.f,       pw3[2]=PKW(P1,12),pw3[3]=PKW(P1,14), pw3); \
    l_reg+=sacc; \
    if(GK){DMA_K((t)+3,sl_cur);} if(GV){DMA_V((t)+1,sl_next);} \
    CMASK(C0,C1,t); \
    { float a=MX3(C0[0],C0[1],C1[0]),b=MX3(C0[2],C0[3],C1[1]); a=MX3(a,C1[2],C1[3]); \
      _Pragma("unroll") for(int r=4;r<16;r+=4){a=MX3(a,C0[r],C0[r+1]);b=MX3(b,C0[r+2],C0[r+3]);a=MX3(a,C1[r],C1[r+1]);b=MX3(b,C1[r+2],C1[r+3]);} \
      float rm=__builtin_fmaxf(a,b); { auto rr=__builtin_amdgcn_permlane32_swap(__float_as_uint(rm),__float_as_uint(rm),false,false); rm=__builtin_fmaxf(__uint_as_float(rr[0]),__uint_as_float(rr[1])); } \
      resc=false; \
      if(__builtin_expect(__any(rm>(float)THRL),0)){ const float dl=__builtin_fmaxf(rm,0.f); mhat+=dl; \
        _Pragma("unroll") for(int r=0;r<16;++r){C0[r]-=dl;C1[r]-=dl;} \
        _Pragma("unroll") for(int r=0;r<16;++r)negm[r]=-mhat; asm volatile("":"+v"(negm)); \
        const float f=__builtin_amdgcn_exp2f(-dl); l_reg*=f; if(hi==0)wsf[r32]=f; resc=true; } } \
    SBAR(); \
    GAPB(o[0]=__builtin_amdgcn_mfma_f32_32x32x16_bf16(PAF(0),VFR(0),o[0],0,0,0), C0,0); \
    GAPB(o[1]=__builtin_amdgcn_mfma_f32_32x32x16_bf16(PAF(0),VFR(4),o[1],0,0,0), C0,4); \
    KRD(GL,0); GAPB(o[0]=__builtin_amdgcn_mfma_f32_32x32x16_bf16(PAF(1),VFR(1),o[0],0,0,0), C0,8); \
    KRD(GL,1); GAPB(o[1]=__builtin_amdgcn_mfma_f32_32x32x16_bf16(PAF(1),VFR(5),o[1],0,0,0), C0,12); \
    KRD(GL,2); GAPB(o[0]=__builtin_amdgcn_mfma_f32_32x32x16_bf16(PAF(2),VFR(2),o[0],0,0,0), C1,0); \
    KRD(GL,3); GAPB(o[1]=__builtin_amdgcn_mfma_f32_32x32x16_bf16(PAF(2),VFR(6),o[1],0,0,0), C1,4); \
    GAPB(o[0]=__builtin_amdgcn_mfma_f32_32x32x16_bf16(PAF(3),VFR(3),o[0],0,0,0), C1,8); \
    GAPB(o[1]=__builtin_amdgcn_mfma_f32_32x32x16_bf16(PAF(3),VFR(7),o[1],0,0,0), C1,12); \
    }while(0)
  int t=1;
  #undef CMASK
  #define CMASK(P0,P1,t) do{}while(0)
  for(;t+5<NT;t+=2){
    STEP(pB0,pB1,pA0,pA1,t,true,true,true);     WAIT_BAR(2); RESC(); ROT();
    STEP(pA0,pA1,pB0,pB1,t+1,true,true,true);   WAIT_BAR(2); RESC(); ROT();
  }
  #undef CMASK
  #define CMASK(P0,P1,t) do{int jb_=(t)-(NT-4); if(jb_>=0)cmask(P0,P1,jb_,qrel,hi);}while(0)
  #define ENDW(tt) do{ if((tt)+3<NT){WAIT_BAR(2);} else if((tt)+2<NT){WAIT_BAR(1);} else {WAIT_BAR(0);} }while(0)
  for(;t+1<NT;t+=2){
    STEP(pB0,pB1,pA0,pA1,t,(t+3<NT),(t+1<NT),(t+1<NT));       ENDW(t);   RESC(); ROT();
    STEP(pA0,pA1,pB0,pB1,t+1,(t+4<NT),(t+2<NT),(t+2<NT));     ENDW(t+1); RESC(); ROT();
  }
  STEP(pB0,pB1,pA0,pA1,NT-1,false,false,false); RESC();
  { float sacc=pB0[0]+pB0[1]; _Pragma("unroll") for(int r=2;r<16;++r)sacc+=pB0[r]; _Pragma("unroll") for(int r=0;r<16;++r)sacc+=pB1[r]; l_reg+=sacc;
    pw0=(u32x4){PKW(pB0,0),PKW(pB0,2),PKW(pB0,4),PKW(pB0,6)};pw1=(u32x4){PKW(pB0,8),PKW(pB0,10),PKW(pB0,12),PKW(pB0,14)};pw2=(u32x4){PKW(pB1,0),PKW(pB1,2),PKW(pB1,4),PKW(pB1,6)};pw3=(u32x4){PKW(pB1,8),PKW(pB1,10),PKW(pB1,12),PKW(pB1,14)};
    SBAR(); pv(o,vb0+sl_cur,PAF(0),PAF(1),PAF(2),PAF(3)); }
  #undef PKW
  #undef PAF
  #undef VFR
  #undef PIN
  #undef MX3
  #undef GAPA
  #undef GAPB
  #undef EX
  #undef VRD
  #undef KRD
  #undef STEP
  #undef ENDW
  {auto rr=__builtin_amdgcn_permlane32_swap(__float_as_uint(l_reg),__float_as_uint(l_reg),false,false);l_reg=__uint_as_float(rr[0])+__uint_as_float(rr[1]);}
  if(hi==0)wsf[32+r32]=l_reg;asm volatile("s_waitcnt lgkmcnt(0)":::"memory");
  float rli[16];
  #pragma unroll
  for(int r=0;r<16;++r)rli[r]=__builtin_amdgcn_rcpf(wsf[32+crow(r,hi)]);
  bf16*Ow=Oc+(rowbase+q0+wid*QBLK)*DM;
  { bf16*stg=(bf16*)(shm+LDS_OST)+wid*2048;
    #pragma unroll
    for(int r=0;r<16;++r){const int orow=crow(r,hi);
      #pragma unroll
      for(int d0=0;d0<2;++d0)stg[orow*64+d0*32+r32]=__float2bfloat16(o[d0][r]*rli[r]);}
    asm volatile("s_waitcnt lgkmcnt(0)":::"memory");
    #pragma unroll
    for(int i=0;i<4;++i){const int row=i*8+(lane>>3),ch=lane&7; const u32x4 v=*(const u32x4*)(stg+row*64+ch*8); ATTN_STORE16(Ow+(long)row*DM+ch*8,v);} }
  asm volatile("s_waitcnt lgkmcnt(0)\n\ts_barrier":::"memory");
  #undef DMA_K
  #undef DMA_V
  #undef CMASK
  #undef START
  #undef RESC
  #undef ROT
}
constexpr int ATTN_LDS_BYTES=LDS_BYTES;
#undef SBAR
#undef WAIT_BAR
}
namespace attn128 {
using bf16=__hip_bfloat16;
using bf16x8=__attribute__((ext_vector_type(8)))short;
using s16x4=__attribute__((ext_vector_type(4)))short;
using f32x16=__attribute__((ext_vector_type(16)))float;
using u32x4=__attribute__((ext_vector_type(4)))unsigned;
constexpr int D=64,DM=1024;
constexpr int NW=8,QBLK=32,QB=QBLK*NW,KVBLK=64;
constexpr int ATTN_PITCH=DM, ATTN_UNIT_ROWS=QB;
__device__ __forceinline__ int crow(int r,int hi){return (r&3)+8*(r>>2)+4*hi;}
#define SBAR() __builtin_amdgcn_sched_barrier(0)
__device__ __forceinline__ void cmask(f32x16&p0,f32x16&p1,int jb,int qrel,int hi){
  const float NEG=-INFINITY; int kb=64*jb+4*hi;
  #pragma unroll
  for(int r=0;r<16;++r){int kv=kb+(r&3)+8*(r>>2); if(kv>qrel)p0[r]=NEG; if(kv+32>qrel)p1[r]=NEG;}
}

constexpr int NSLOT=3, SLOTB=8192;
constexpr int LDS_K=0, LDS_V=NSLOT*SLOTB, LDS_WS=LDS_V+NSLOT*2*SLOTB, LDS_OST=LDS_WS+NW*64*4, LDS_BYTES=LDS_OST+NW*8192;
constexpr float C2=0.125f*1.4426950408889634f;
__device__ __forceinline__ void glds16(const void*gsrc,unsigned lds_dst){unsigned keep;
  asm volatile("s_mov_b32 %0, m0\n\ts_mov_b32 m0, %2\n\ts_nop 0\n\tglobal_load_lds_dwordx4 %1, off\n\ts_mov_b32 m0, %0":"=&s"(keep):"v"(gsrc),"s"(lds_dst):"memory");}
__device__ __forceinline__ void glds16s(const void*sbase,unsigned voff,unsigned lds_dst){unsigned keep;
  asm volatile("s_mov_b32 %0, m0\n\ts_mov_b32 m0, %3\n\ts_nop 4\n\tglobal_load_lds_dwordx4 %1, %2\n\ts_mov_b32 m0, %0":"=&s"(keep):"v"(voff),"s"(sbase),"s"(lds_dst):"memory");}
__device__ __forceinline__ float max3f(float a,float b,float c){float r;asm("v_max3_f32 %0, %1, %2, %3":"=v"(r):"v"(a),"v"(b),"v"(c));return r;}
__device__ __forceinline__ float max2f(float a,float b){float r;asm("v_max_f32_e32 %0, %1, %2":"=v"(r):"v"(a),"v"(b));return r;}
__device__ __forceinline__ float fadd_s(float a,float b){float r;asm("v_add_f32_e32 %0, %1, %2":"=v"(r):"v"(a),"v"(b));return r;}
__device__ __forceinline__ float fsub_s(float a,float b){float r;asm("v_sub_f32_e32 %0, %1, %2":"=v"(r):"v"(a),"v"(b));return r;}
typedef float f32x2_t __attribute__((ext_vector_type(2))); typedef __bf16 bf16x2_t __attribute__((ext_vector_type(2)));
__device__ __forceinline__ unsigned cvtpk_s(float lo,float hi){f32x2_t v={lo,hi};bf16x2_t b=__builtin_convertvector(v,bf16x2_t);return __builtin_bit_cast(unsigned,b);}
#define WAIT_BAR(N) asm volatile("s_waitcnt vmcnt(" #N ") lgkmcnt(0)\n\ts_barrier":::"memory")

__device__ __forceinline__ void qkt(f32x16&p0,f32x16&p1,const char*Kslot,const bf16x8*qr,const f32x16&negm,int r32,int hi){
  const char*kb=Kslot+hi*1024+r32*16;
  #pragma unroll
  for(int d0=0;d0<4;++d0){
    const bf16x8 b0=*reinterpret_cast<const bf16x8*>(kb+d0*2048);
    const bf16x8 b1=*reinterpret_cast<const bf16x8*>(kb+d0*2048+512);
    if(d0==0){p0=__builtin_amdgcn_mfma_f32_32x32x16_bf16(b0,qr[0],negm,0,0,0);p1=__builtin_amdgcn_mfma_f32_32x32x16_bf16(b1,qr[0],negm,0,0,0);}
    else{p0=__builtin_amdgcn_mfma_f32_32x32x16_bf16(b0,qr[d0],p0,0,0,0);p1=__builtin_amdgcn_mfma_f32_32x32x16_bf16(b1,qr[d0],p1,0,0,0);}}
}
typedef __attribute__((address_space(3))) const char* lds_cptr;
typedef short v4i16_t __attribute__((ext_vector_type(4)));
__device__ __forceinline__ void kload8(bf16x8*kf,lds_cptr kp){
  kf[0]=*(const __attribute__((address_space(3))) bf16x8*)(kp);      kf[1]=*(const __attribute__((address_space(3))) bf16x8*)(kp+512);
  kf[2]=*(const __attribute__((address_space(3))) bf16x8*)(kp+2048); kf[3]=*(const __attribute__((address_space(3))) bf16x8*)(kp+2560);
  kf[4]=*(const __attribute__((address_space(3))) bf16x8*)(kp+4096); kf[5]=*(const __attribute__((address_space(3))) bf16x8*)(kp+4608);
  kf[6]=*(const __attribute__((address_space(3))) bf16x8*)(kp+6144); kf[7]=*(const __attribute__((address_space(3))) bf16x8*)(kp+6656);
}
__device__ __forceinline__ void kload2(bf16x8*kf,lds_cptr kp,int j){ kf[2*j]=*(const __attribute__((address_space(3))) bf16x8*)(kp+j*2048); kf[2*j+1]=*(const __attribute__((address_space(3))) bf16x8*)(kp+j*2048+512); }
__device__ __forceinline__ s16x4 vtr(lds_cptr p){ return __builtin_bit_cast(s16x4,__builtin_amdgcn_ds_read_tr16_b64_v4i16((__attribute__((address_space(3))) v4i16_t*)p)); }
__device__ __forceinline__ float rowmax(const f32x16&p0,const f32x16&p1){
  float a=max3f(p0[0],p0[1],p1[0]),b=max3f(p0[2],p0[3],p1[1]);a=max3f(a,p1[2],p1[3]);
  #pragma unroll
  for(int r=4;r<16;r+=4){a=max3f(a,p0[r],p0[r+1]);b=max3f(b,p0[r+2],p0[r+3]);a=max3f(a,p1[r],p1[r+1]);b=max3f(b,p1[r+2],p1[r+3]);}
  const float m=max2f(a,b);
  auto rr=__builtin_amdgcn_permlane32_swap(__float_as_uint(m),__float_as_uint(m),false,false);
  return max2f(__uint_as_float(rr[0]),__uint_as_float(rr[1]));
}
__device__ __forceinline__ void pv(f32x16*o,int vb,bf16x8 pa0,bf16x8 pa1,bf16x8 pa2,bf16x8 pa3){
  #pragma unroll
  for(int d0=0;d0<2;++d0){s16x4 lo[4],hi[4];
    #pragma unroll
    for(int ks=0;ks<4;++ks){
      asm volatile("ds_read_b64_tr_b16 %0,%1 offset:%c2":"=&v"(lo[ks]):"v"(vb),"i"(d0*4096+ks*1024):"memory");
      asm volatile("ds_read_b64_tr_b16 %0,%1 offset:%c2":"=&v"(hi[ks]):"v"(vb),"i"(d0*4096+ks*1024+512):"memory");}
    asm volatile("s_waitcnt lgkmcnt(0)":::"memory");SBAR();
    #define PK(k) (bf16x8){lo[k][0],lo[k][1],lo[k][2],lo[k][3],hi[k][0],hi[k][1],hi[k][2],hi[k][3]}
    o[d0]=__builtin_amdgcn_mfma_f32_32x32x16_bf16(pa0,PK(0),o[d0],0,0,0);
    o[d0]=__builtin_amdgcn_mfma_f32_32x32x16_bf16(pa1,PK(1),o[d0],0,0,0);
    o[d0]=__builtin_amdgcn_mfma_f32_32x32x16_bf16(pa2,PK(2),o[d0],0,0,0);
    o[d0]=__builtin_amdgcn_mfma_f32_32x32x16_bf16(pa3,PK(3),o[d0],0,0,0);
    #undef PK
  }
}

#ifndef ATTN_STORE16
#define ATTN_STORE16(p,v) (*(u32x4*)(p)=(v))
#endif
template<int THRL,int MODE> __device__ __forceinline__ void attn_unit(long rowbase,int qb,const bf16*Qc,const bf16*__restrict__ Kc,const bf16*__restrict__ Vc,bf16*Oc,char*shm,float lam,const float*gsub,float osc,float rms_eps){
  int tid_=threadIdx.x; asm volatile("":"+v"(tid_)); const int tid=tid_,lane=tid&63,r32=lane&31,hi=lane>>5; const int wid=__builtin_amdgcn_readfirstlane(tid>>6);
  const int q0=qb*QB;
  const bf16*Qw=Qc+(rowbase+q0+wid*QBLK)*DM;
  const bf16*Kh=Kc+rowbase*DM,*Vh=Vc+rowbase*DM;
  const unsigned lds0=(unsigned)(uintptr_t)shm;
  float*wsf=(float*)(shm+LDS_WS)+wid*64;
  const unsigned koff=(unsigned)(lane*DM+wid*8)*2u;
  const unsigned voffv=(unsigned)((16*(wid&3)+(lane>>2))*DM+(wid>>2)*32+(lane&3)*8)*2u;
  const unsigned kdst=lds0+LDS_K+wid*1024, vdst=lds0+LDS_V+wid*1024;
  #define DMA_K(t,slot) glds16s(Kh+(long)(t)*KVBLK*DM,koff,(unsigned)__builtin_amdgcn_readfirstlane(kdst+(slot)))
  #define DMA_V(t,slot) do{ glds16s(Vh+(long)(t)*KVBLK*DM,voffv,(unsigned)__builtin_amdgcn_readfirstlane(vdst+2*(slot))); glds16s(Vh+(long)(t)*KVBLK*DM+64,voffv,(unsigned)__builtin_amdgcn_readfirstlane(vdst+2*(slot)+8192)); }while(0)
  const int vb0=(int)(lds0+LDS_V)+((lane>>4)&1)*32+(lane&3)*8+(4*hi+((lane&15)>>2))*64;
  const char*Kbase=shm+LDS_K; bf16x8 kf[8];
  const lds_cptr shm3=(lds_cptr)shm; const lds_cptr kp0=shm3+LDS_K+hi*1024+r32*16; const lds_cptr vp0=shm3+LDS_V+((lane>>4)&1)*32+(lane&3)*8+(4*hi+((lane&15)>>2))*64;
  const int NT=(q0+QB)/KVBLK;
  DMA_K(0,0);DMA_V(0,0);DMA_K(1,SLOTB);
  bf16x8 qr[4];
  #pragma unroll
  for(int d0=0;d0<4;++d0)qr[d0]=*reinterpret_cast<const bf16x8*>(&Qw[(long)r32*DM+d0*16+hi*8]);
  float mhat=0.f,l_reg=0.f;f32x16 o[4];o[0]=f32x16{};o[1]=f32x16{};o[2]=f32x16{};o[3]=f32x16{};const f32x16 zf=f32x16{};
  const int qrel=wid*QBLK+r32;
  #define CMASK(P0,P1,t) do{int jb_=(t)-(NT-4); if(jb_>=0)cmask(P0,P1,jb_,qrel,hi);}while(0)
  bool resc=false;
  #define START(P0,P1) do{ const float rm=rowmax(P0,P1); resc=false; \
    { const float dl=rm; mhat=fadd_s(mhat,dl); \
      _Pragma("unroll") for(int r=0;r<16;++r){P0[r]=fsub_s(P0[r],dl);P1[r]=fsub_s(P1[r],dl);} \
      } \
    _Pragma("unroll") for(int r=0;r<16;++r)P0[r]=__builtin_amdgcn_exp2f(P0[r]); }while(0)
  #define RESC() do{ if(resc){ asm volatile("s_waitcnt lgkmcnt(0)":::"memory"); \
      _Pragma("unroll") for(int d_=0;d_<4;++d_) _Pragma("unroll") for(int r=0;r<16;++r)o[d_][r]*=wsf[crow(r,hi)]; } }while(0)
  f32x16 pA0,pA1,pB0,pB1;
  int sl_prev=0,sl_cur=0,sl_next=SLOTB;
  #define ROT() do{sl_prev=sl_cur;sl_cur=sl_next;sl_next=(sl_next==(NSLOT-1)*SLOTB)?0:sl_next+SLOTB;}while(0)
  DMA_K(2,2*SLOTB);
  WAIT_BAR(4);
  qkt(pA0,pA1,Kbase,qr,zf,r32,hi);asm volatile("s_nop 15\n\ts_nop 7":"+v"(pA0),"+v"(pA1));CMASK(pA0,pA1,0);
  START(pA0,pA1);
  _Pragma("unroll") for(int r=0;r<16;++r)pA1[r]=__builtin_amdgcn_exp2f(pA1[r]);
  WAIT_BAR(0);
  DMA_K(3,0);DMA_V(1,SLOTB);
  ROT();
  kload8(kf,kp0+sl_cur);
  WAIT_BAR(3);
  s16x4 vlo[8],vhi[8]; u32x4 pw0,pw1,pw2,pw3;
  #define PKW(P,B) cvtpk_s(P[B],P[B+1])
  #define PAF(k) __builtin_bit_cast(bf16x8,pw##k)
  #define VFR(i) (bf16x8){vlo[i][0],vlo[i][1],vlo[i][2],vlo[i][3],vhi[i][0],vhi[i][1],vhi[i][2],vhi[i][3]}
  #define PIN(x) asm volatile("":"+v"(x))
  #define MX3(a,b,c) __builtin_fmaxf(__builtin_fmaxf((a),(b)),(c))
  #define GAPA(MF,A0,A1,A2,A3,W0,W1,PW) do{ MF; sacc+=A0; sacc+=A1; sacc+=A2; sacc+=A3; PIN(sacc); W0; W1; PIN(PW); SBAR(); }while(0)
  #define EX(v) __builtin_amdgcn_exp2f(v)
  #define GAPB(MF,X,B) do{ MF; X[B]=EX(X[B]); X[B+1]=EX(X[B+1]); X[B+2]=EX(X[B+2]); X[B+3]=EX(X[B+3]); PIN(X); SBAR(); }while(0)
  #define VRD(i) do{ vlo[i]=vtr(vp_+(((i)>>2)*4096+((i)&3)*1024)); vhi[i]=vtr(vp_+(((i)>>2)*4096+((i)&3)*1024+512)); }while(0)
  #define KRD(G,j) do{ if(G){ kload2(kf,kp0+sl_next,j); SBAR(); } }while(0)
  #define VRD2(i) do{ vlo[i]=vtr(vp_+(8192+((i)>>2)*4096+((i)&3)*1024)); vhi[i]=vtr(vp_+(8192+((i)>>2)*4096+((i)&3)*1024+512)); SBAR(); }while(0)
  #define STEP(C0,C1,P0,P1,t,GK,GV,GL) do{ SBAR(); \
    const lds_cptr vp_=vp0+2*sl_prev; \
    VRD(0); SBAR(); float sacc=(P0[0]+P0[1]); \
    GAPA(C0=__builtin_amdgcn_mfma_f32_32x32x16_bf16(kf[0],qr[0],zf,0,0,0), P0[2],P0[3],P0[4],P0[5],     pw0[0]=PKW(P0,0), pw0[1]=PKW(P0,2), pw0); \
    VRD(4); SBAR(); GAPA(C1=__builtin_amdgcn_mfma_f32_32x32x16_bf16(kf[1],qr[0],zf,0,0,0), P0[6],P0[7],P0[8],P0[9],     pw0[2]=PKW(P0,4), pw0[3]=PKW(P0,6), pw0); \
    VRD(1); SBAR(); GAPA(C0=__builtin_amdgcn_mfma_f32_32x32x16_bf16(kf[2],qr[1],C0,0,0,0),   P0[10],P0[11],P0[12],P0[13], pw1[0]=PKW(P0,8), pw1[1]=PKW(P0,10), pw1); \
    VRD(5); SBAR(); GAPA(C1=__builtin_amdgcn_mfma_f32_32x32x16_bf16(kf[3],qr[1],C1,0,0,0),   P0[14],P0[15],P1[0],P1[1],   pw1[2]=PKW(P0,12),pw1[3]=PKW(P0,14), pw1); \
    VRD(2); SBAR(); GAPA(C0=__builtin_amdgcn_mfma_f32_32x32x16_bf16(kf[4],qr[2],C0,0,0,0),   P1[2],P1[3],P1[4],P1[5],     pw2[0]=PKW(P1,0), pw2[1]=PKW(P1,2), pw2); \
    VRD(6); SBAR(); GAPA(C1=__builtin_amdgcn_mfma_f32_32x32x16_bf16(kf[5],qr[2],C1,0,0,0),   P1[6],P1[7],P1[8],P1[9],     pw2[2]=PKW(P1,4), pw2[3]=PKW(P1,6), pw2); \
    VRD(3); SBAR(); GAPA(C0=__builtin_amdgcn_mfma_f32_32x32x16_bf16(kf[6],qr[3],C0,0,0,0),   P1[10],P1[11],P1[12],P1[13], pw3[0]=PKW(P1,8), pw3[1]=PKW(P1,10), pw3); \
    VRD(7); SBAR(); GAPA(C1=__builtin_amdgcn_mfma_f32_32x32x16_bf16(kf[7],qr[3],C1,0,0,0),   P1[14],P1[15],0.f,0.f,       pw3[2]=PKW(P1,12),pw3[3]=PKW(P1,14), pw3); \
    l_reg+=sacc; \
    if(GK){DMA_K((t)+3,sl_cur);} if(GV){DMA_V((t)+1,sl_next);} \
    _Pragma("unroll") for(int r=0;r<16;++r){C0[r]-=mhat;C1[r]-=mhat;} \
    CMASK(C0,C1,t); \
    { float a=MX3(C0[0],C0[1],C1[0]),b=MX3(C0[2],C0[3],C1[1]); a=MX3(a,C1[2],C1[3]); \
      _Pragma("unroll") for(int r=4;r<16;r+=4){a=MX3(a,C0[r],C0[r+1]);b=MX3(b,C0[r+2],C0[r+3]);a=MX3(a,C1[r],C1[r+1]);b=MX3(b,C1[r+2],C1[r+3]);} \
      float rm=__builtin_fmaxf(a,b); { auto rr=__builtin_amdgcn_permlane32_swap(__float_as_uint(rm),__float_as_uint(rm),false,false); rm=__builtin_fmaxf(__uint_as_float(rr[0]),__uint_as_float(rr[1])); } \
      resc=false; \
      if(__builtin_expect(__any(rm>(float)THRL),0)){ const float dl=__builtin_fmaxf(rm,0.f); mhat+=dl; \
        _Pragma("unroll") for(int r=0;r<16;++r){C0[r]-=dl;C1[r]-=dl;} \
        const float f=__builtin_amdgcn_exp2f(-dl); l_reg*=f; if(hi==0)wsf[r32]=f; resc=true; } } \
    SBAR(); \
    GAPB(o[0]=__builtin_amdgcn_mfma_f32_32x32x16_bf16(PAF(0),VFR(0),o[0],0,0,0), C0,0); VRD2(0); \
    GAPB(o[1]=__builtin_amdgcn_mfma_f32_32x32x16_bf16(PAF(0),VFR(4),o[1],0,0,0), C0,4); VRD2(4); \
    KRD(GL,0); GAPB(o[0]=__builtin_amdgcn_mfma_f32_32x32x16_bf16(PAF(1),VFR(1),o[0],0,0,0), C0,8); VRD2(1); \
    KRD(GL,1); GAPB(o[1]=__builtin_amdgcn_mfma_f32_32x32x16_bf16(PAF(1),VFR(5),o[1],0,0,0), C0,12); VRD2(5); \
    KRD(GL,2); GAPB(o[0]=__builtin_amdgcn_mfma_f32_32x32x16_bf16(PAF(2),VFR(2),o[0],0,0,0), C1,0); VRD2(2); \
    KRD(GL,3); GAPB(o[1]=__builtin_amdgcn_mfma_f32_32x32x16_bf16(PAF(2),VFR(6),o[1],0,0,0), C1,4); VRD2(6); \
    GAPB(o[0]=__builtin_amdgcn_mfma_f32_32x32x16_bf16(PAF(3),VFR(3),o[0],0,0,0), C1,8); VRD2(3); \
    GAPB(o[1]=__builtin_amdgcn_mfma_f32_32x32x16_bf16(PAF(3),VFR(7),o[1],0,0,0), C1,12); VRD2(7); \
    o[2]=__builtin_amdgcn_mfma_f32_32x32x16_bf16(PAF(0),VFR(0),o[2],0,0,0); o[3]=__builtin_amdgcn_mfma_f32_32x32x16_bf16(PAF(0),VFR(4),o[3],0,0,0); \
    o[2]=__builtin_amdgcn_mfma_f32_32x32x16_bf16(PAF(1),VFR(1),o[2],0,0,0); o[3]=__builtin_amdgcn_mfma_f32_32x32x16_bf16(PAF(1),VFR(5),o[3],0,0,0); \
    o[2]=__builtin_amdgcn_mfma_f32_32x32x16_bf16(PAF(2),VFR(2),o[2],0,0,0); o[3]=__builtin_amdgcn_mfma_f32_32x32x16_bf16(PAF(2),VFR(6),o[3],0,0,0); \
    o[2]=__builtin_amdgcn_mfma_f32_32x32x16_bf16(PAF(3),VFR(3),o[2],0,0,0); o[3]=__builtin_amdgcn_mfma_f32_32x32x16_bf16(PAF(3),VFR(7),o[3],0,0,0); SBAR(); \
    }while(0)
  int t=1;
  #undef CMASK
  #define CMASK(P0,P1,t) do{}while(0)
  for(;t+5<NT;t+=2){
    STEP(pB0,pB1,pA0,pA1,t,true,true,true);     WAIT_BAR(3); RESC(); ROT();
    STEP(pA0,pA1,pB0,pB1,t+1,true,true,true);   WAIT_BAR(3); RESC(); ROT();
  }
  #undef CMASK
  #define CMASK(P0,P1,t) do{int jb_=(t)-(NT-4); if(jb_>=0)cmask(P0,P1,jb_,qrel,hi);}while(0)
  #define ENDW(tt) do{ if((tt)+3<NT){WAIT_BAR(3);} else if((tt)+2<NT){WAIT_BAR(2);} else {WAIT_BAR(0);} }while(0)
  for(;t+1<NT;t+=2){
    STEP(pB0,pB1,pA0,pA1,t,(t+3<NT),(t+1<NT),(t+1<NT));       ENDW(t);   RESC(); ROT();
    STEP(pA0,pA1,pB0,pB1,t+1,(t+4<NT),(t+2<NT),(t+2<NT));     ENDW(t+1); RESC(); ROT();
  }
  STEP(pB0,pB1,pA0,pA1,NT-1,false,false,false); RESC();
  { float sacc=pB0[0]+pB0[1]; _Pragma("unroll") for(int r=2;r<16;++r)sacc+=pB0[r]; _Pragma("unroll") for(int r=0;r<16;++r)sacc+=pB1[r]; l_reg+=sacc;
    pw0=(u32x4){PKW(pB0,0),PKW(pB0,2),PKW(pB0,4),PKW(pB0,6)};pw1=(u32x4){PKW(pB0,8),PKW(pB0,10),PKW(pB0,12),PKW(pB0,14)};pw2=(u32x4){PKW(pB1,0),PKW(pB1,2),PKW(pB1,4),PKW(pB1,6)};pw3=(u32x4){PKW(pB1,8),PKW(pB1,10),PKW(pB1,12),PKW(pB1,14)};
    SBAR(); pv(o,vb0+2*sl_cur,PAF(0),PAF(1),PAF(2),PAF(3)); pv(o+2,vb0+2*sl_cur+8192,PAF(0),PAF(1),PAF(2),PAF(3)); }
  #undef PKW
  #undef PAF
  #undef VFR
  #undef PIN
  #undef MX3
  #undef GAPA
  #undef GAPB
  #undef EX
  #undef VRD
  #undef KRD
  #undef VRD2
  #undef STEP
  #undef ENDW
  {auto rr=__builtin_amdgcn_permlane32_swap(__float_as_uint(l_reg),__float_as_uint(l_reg),false,false);l_reg=__uint_as_float(rr[0])+__uint_as_float(rr[1]);}
  if(hi==0)wsf[32+r32]=l_reg;asm volatile("s_waitcnt lgkmcnt(0)":::"memory");
  float rli[16];
  #pragma unroll
  for(int r=0;r<16;++r)rli[r]=__builtin_amdgcn_rcpf(wsf[32+crow(r,hi)]);
  bf16*Ow=Oc+(rowbase+q0+wid*QBLK)*DM;
  { bf16*stg=(bf16*)(shm+LDS_OST)+wid*4096;
    #pragma unroll
    for(int r=0;r<16;++r){const int orow=crow(r,hi);
      #pragma unroll
      for(int d0=0;d0<4;++d0){ float v=o[d0][r]*rli[r];
        if(MODE==2) v=__bfloat162float(stg[orow*128+d0*32+r32])-lam*v;
        stg[orow*128+d0*32+r32]=__float2bfloat16(v);} }
    asm volatile("s_waitcnt lgkmcnt(0)":::"memory");
    if(MODE==0){
      #pragma unroll
      for(int i=0;i<8;++i){const int row=i*4+(lane>>4),ch=lane&15; const u32x4 v=*(const u32x4*)(stg+row*128+ch*8); ATTN_STORE16(Ow+(long)row*DM+ch*8,v);} }
    if(MODE==2){
      const int row=lane>>1,c0=(lane&1)*64; float ss=0.f; u32x4 w[8];
      #pragma unroll
      for(int i=0;i<8;++i){ w[i]=*(const u32x4*)(stg+row*128+c0+i*8);
        #pragma unroll
        for(int j=0;j<4;++j){ const float a=__uint_as_float(w[i][j]<<16),b=__uint_as_float(w[i][j]&0xffff0000u); ss+=a*a+b*b; } }
      ss+=__shfl_xor(ss,1);
      const float rs=osc/sqrtf(ss*(1.0f/128.0f)+rms_eps);
      #pragma unroll
      for(int i=0;i<8;++i){ u32x4 ov;
        #pragma unroll
        for(int j=0;j<4;++j){ const float a=__uint_as_float(w[i][j]<<16)*rs*gsub[c0+i*8+2*j],b=__uint_as_float(w[i][j]&0xffff0000u)*rs*gsub[c0+i*8+2*j+1]; ov[j]=cvtpk_s(a,b); }
        ATTN_STORE16(Ow+(long)row*DM+c0+i*8,ov); } }
  }
  asm volatile("s_waitcnt lgkmcnt(0)\n\ts_barrier":::"memory");
  #undef DMA_K
  #undef DMA_V
  #undef CMASK
  #undef START
  #undef RESC
  #undef ROT
}
constexpr int ATTN_LDS_BYTES=LDS_BYTES;
#undef SBAR
#undef WAIT_BAR
}
namespace mk {
#define GAS __attribute__((address_space(1)))
#define LAS __attribute__((address_space(3)))
typedef unsigned short bf16;
typedef unsigned v4u __attribute__((ext_vector_type(4)));
typedef unsigned v2u __attribute__((ext_vector_type(2)));
typedef float f32x4 __attribute__((ext_vector_type(4)));
using pg8::Unit;
using pg8::cvt_pk_bf16;

constexpr int D = 1024, BATCH = 8, SEQ = 2048, T = BATCH * SEQ, NH = 8, NG = 4, EPG = 8, NE = 32, DE = 512, NRW = NG + NE;
constexpr float ALPHA = 1.4142135623730951f, LN_EPS = 1e-5f, RMS_EPS = 1e-5f;
constexpr float LAM_INIT = 0.35550906f;
constexpr float QSCALE = 0.125f * 1.4426950408889634f;
constexpr int CNT_STRIDE = 64;
constexpr int CAP = T;
constexpr int NWAVES = 8, NTHREADS = 512;
#ifndef P0B_FILL
#define P0B_FILL 1
#endif
#ifndef MOE_MERGE
#define MOE_MERGE 0
#endif
#ifndef P0B_SPLIT
#define P0B_SPLIT 8192
#endif

constexpr size_t MiB = 1u << 20;
constexpr size_t WS_CTL = 0, WS_W1T = 1 * MiB, WS_W2T = 7 * MiB, WS_WKVQ = 9 * MiB, WS_WOT = 15 * MiB, WS_RWT = 17 * MiB;
constexpr size_t WS_RWH = 17 * MiB + 512 * 1024;
constexpr size_t WS_WUT = 24 * MiB, WS_WDT = 152 * MiB, WS_XB = 216 * MiB, WS_GB = 248 * MiB, WS_U = 280 * MiB, WS_A2 = 312 * MiB, WS_Z = 344 * MiB, WS_X1B = 408 * MiB;
constexpr size_t WS_ACT = 440 * MiB, WS_YP = 480 * MiB, WS_X2B = 544 * MiB, WS_K = 576 * MiB, WS_V = 608 * MiB, WS_Q = 640 * MiB, WS_O0 = 672 * MiB, WS_O1 = 704 * MiB;
constexpr size_t WS_A3 = 736 * MiB, WS_X3B = 768 * MiB;
#ifdef MKPROBE
constexpr size_t WS_PERM = 18 * MiB;
constexpr size_t WS_Z1 = 800 * MiB, WS_ACT1 = 864 * MiB, WS_YP1 = 904 * MiB, WS_PERM1 = 968 * MiB, WS_END = 972 * MiB;
#else
constexpr size_t WS_PERM = 18 * MiB;
constexpr size_t WS_Z1 = WS_Z, WS_ACT1 = WS_ACT, WS_YP1 = WS_YP, WS_PERM1 = WS_PERM, WS_END = 800 * MiB;
#endif
#define LZ(l) ((l) ? WS_Z1 : WS_Z)
#define LACT(l) ((l) ? WS_ACT1 : WS_ACT)
#define LYP(l) ((l) ? WS_YP1 : WS_YP)
#define LPERM(l) ((l) ? WS_PERM1 : WS_PERM)
constexpr int RWH_PITCH = 2064  , RWH_BYTES = 2 * 36 * RWH_PITCH  ;
constexpr int RWH_PAD = 149504;
constexpr int RING_BYTES = 131072, RW_BYTES = RWH_PAD  , MISC_OFF = RW_BYTES, LDS_BYTES = 163840;

struct Args {
    const float *x, *a_w_in, *a_conv_w, *a_w_out, *kv_w, *b_w_q, *b_lambda, *b_subln_g, *b_w_o, *ln1_g, *ln1_b, *ln2_g, *ln2_b, *rg_w, *rg_b, *re_w, *re_b, *e_w_in, *e_w_down;
    float* out; unsigned char* ws;
};

typedef const __attribute__((address_space(4))) Args* ArgsP;
__device__ __forceinline__ ArgsP kargs() { ArgsP p = (ArgsP)__builtin_amdgcn_kernarg_segment_ptr(); asm volatile("" : "+s"(p)); return p; }
struct Ctx { int tid, lane, wave, G, bx, gw, NGW; unsigned char* ws; };
__device__ __forceinline__ Ctx mkctx(ArgsP ap) { Ctx c; int t = threadIdx.x; asm volatile("" : "+v"(t)); c.tid = t; c.lane = t & 63; c.wave = __builtin_amdgcn_readfirstlane(t >> 6);
    c.G = gridDim.x; c.bx = blockIdx.x; c.gw = c.bx * 8 + c.wave; c.NGW = c.G * 8; c.ws = ap->ws; return c; }
__device__ __forceinline__ unsigned f2bf(float f) { unsigned u = __builtin_bit_cast(unsigned, f); return (u + 0x7fffu + ((u >> 16) & 1u)) >> 16; }
__device__ __forceinline__ unsigned pk2(float lo, float hi) { return f2bf(lo) | (f2bf(hi) << 16); }
__device__ __forceinline__ float bflo(unsigned w) { return __builtin_bit_cast(float, w << 16); }
__device__ __forceinline__ float bfhi(unsigned w) { return __builtin_bit_cast(float, w & 0xffff0000u); }
__device__ __forceinline__ f32x4 ldz4(const bf16* p) { const v2u w = *(const v2u*)p; return (f32x4){bflo(w.x), bfhi(w.x), bflo(w.y), bfhi(w.y)}; }
__device__ __forceinline__ float wave_sum(float v) {
#pragma unroll
    for (int o = 1; o < 64; o <<= 1) v += __shfl_xor(v, o);
    return v;
}

__device__ __forceinline__ float dpp_add(float v, const int ctrl_sel) {
    const int iv = __builtin_bit_cast(int, v); int t;
    if (ctrl_sel == 0) t = __builtin_amdgcn_update_dpp(0, iv, 0xB1, 0xF, 0xF, true);
    else if (ctrl_sel == 1) t = __builtin_amdgcn_update_dpp(0, iv, 0x4E, 0xF, 0xF, true);
    else if (ctrl_sel == 2) t = __builtin_amdgcn_update_dpp(0, iv, 0x141, 0xF, 0xF, true);
    else if (ctrl_sel == 3) t = __builtin_amdgcn_update_dpp(0, iv, 0x140, 0xF, 0xF, true);
    else if (ctrl_sel == 4) t = __builtin_amdgcn_update_dpp(0, iv, 0x142, 0xA, 0xF, false);
    else t = __builtin_amdgcn_update_dpp(0, iv, 0x143, 0xC, 0xF, false);
    return v + __builtin_bit_cast(float, t);
}
template <int N> __device__ __forceinline__ void dpp_sum(float (&v)[N]) {
#pragma unroll
    for (int st = 0; st < 6; ++st) {
#pragma unroll
        for (int i = 0; i < N; ++i) v[i] = dpp_add(v[i], st);
    }
#pragma unroll
    for (int i = 0; i < N; ++i) v[i] = __builtin_bit_cast(float, __builtin_amdgcn_readlane(__builtin_bit_cast(int, v[i]), 63));
}
__device__ __forceinline__ float dpp_sum1(float v) { float a[1] = {v}; dpp_sum(a); return a[0]; }

__device__ __forceinline__ void p0_transpose_item(const float* W, int K, int N, bf16* WT, int row_off, LAS float* scr, int item, int lane) {
    const int nblk = N / 64, kb = item / nblk, nb = item % nblk, k0 = 64 * kb, n0 = 64 * nb;
    const float* src = W + (size_t)(k0 + (lane >> 4)) * N + n0 + (lane & 15) * 4;
    f32x4 v[16];
#pragma unroll
    for (int i = 0; i < 16; ++i) v[i] = __builtin_nontemporal_load((const f32x4*)(src + (size_t)(4 * i) * N));
#pragma unroll
    for (int i = 0; i < 16; ++i) { LAS float* d = scr + (4 * i + (lane >> 4)) * 65 + (lane & 15) * 4; d[0] = v[i].x; d[1] = v[i].y; d[2] = v[i].z; d[3] = v[i].w; }
    asm volatile("s_waitcnt lgkmcnt(0)" ::: "memory");
    const int c = lane & 7;
#pragma unroll
    for (int j = 0; j < 8; ++j) { const int n = (lane >> 3) + 8 * j; const LAS float* s = scr + (8 * c) * 65 + n;
        v4u o; o.x = pk2(s[0 * 65], s[1 * 65]); o.y = pk2(s[2 * 65], s[3 * 65]); o.z = pk2(s[4 * 65], s[5 * 65]); o.w = pk2(s[6 * 65], s[7 * 65]);
        *(GAS v4u*)(WT + (size_t)(row_off + n0 + n) * K + k0 + 8 * c) = o; }
    asm volatile("s_waitcnt lgkmcnt(0)" ::: "memory");
}

constexpr int I_IN = 16 * 48, I_SQ = 16 * 16, I_KV = 16 * 32, I_DN = 8 * 16;
constexpr int NEM = P0B_FILL ? NE : 2 * NE;
constexpr int PS1 = I_IN, PS2 = PS1 + I_SQ, PS3 = PS2 + I_KV, PS4 = PS3 + I_SQ, PS5 = PS4 + I_SQ, PS6 = PS5 + NEM * I_SQ, P0_NITEMS = PS6 + NEM * I_DN;
__device__ __forceinline__ void p0_items(LAS unsigned char* lds, int lo, int hi, int w, int nw) {
    const ArgsP a = kargs(); const Ctx cx = mkctx(a); const int lane = cx.lane; unsigned char* ws = cx.ws;
    LAS float* scr = (LAS float*)(lds + cx.wave * 16640);
    for (int it = lo + w; it < hi; it += nw) {
        if (it < PS1) p0_transpose_item(a->a_w_in, D, 3 * D, (bf16*)(ws + WS_W1T), 0, scr, it, lane);
        else if (it < PS2) p0_transpose_item(a->a_w_out, D, D, (bf16*)(ws + WS_W2T), 0, scr, it - PS1, lane);
        else if (it < PS3) p0_transpose_item(a->kv_w, D, 2 * D, (bf16*)(ws + WS_WKVQ), 0, scr, it - PS2, lane);
        else if (it < PS4) p0_transpose_item(a->b_w_q, D, D, (bf16*)(ws + WS_WKVQ), 2 * D, scr, it - PS3, lane);
        else if (it < PS5) p0_transpose_item(a->b_w_o, D, D, (bf16*)(ws + WS_WOT), 0, scr, it - PS4, lane);
        else if (it < PS6) { const int r = it - PS5, mtx = r / I_SQ; p0_transpose_item(a->e_w_in + (size_t)mtx * D * D, D, D, (bf16*)(ws + WS_WUT) + (size_t)mtx * D * D, 0, scr, r % I_SQ, lane); }
        else { const int r = it - PS6, mtx = r / I_DN; p0_transpose_item(a->e_w_down + (size_t)mtx * DE * D, DE, D, (bf16*)(ws + WS_WDT) + (size_t)mtx * D * DE, 0, scr, r % I_DN, lane); }
    }
}
#ifndef ROLE_SPLIT
#define ROLE_SPLIT 1
#endif
#ifndef P0A_EXTRA
#define P0A_EXTRA 5632
#endif
__device__ __forceinline__ void p0_prologue(LAS unsigned char* lds) {
    const ArgsP a = kargs(); const Ctx cx = mkctx(a); const int gw = cx.gw, NGW = cx.NGW, lane = cx.lane;
    unsigned char* ws = cx.ws;
    p0_items(lds, 0, ROLE_SPLIT ? PS1 + P0A_EXTRA : P0_NITEMS, gw, NGW);
#pragma unroll 1
    for (int m = gw; m < T; m += 4 * NGW) {
        f32x4 v[4][4];
#pragma unroll
        for (int r = 0; r < 4; ++r) { const int row = m + r * NGW < T ? m + r * NGW : m; const GAS f32x4* xr = (const GAS f32x4*)(a->x + (size_t)row * D) + lane;
#pragma unroll
            for (int j = 0; j < 4; ++j) v[r][j] = __builtin_nontemporal_load(xr + 64 * j); }
#pragma unroll
        for (int r = 0; r < 4; ++r) { if (m + r * NGW < T) { GAS v2u* o = (GAS v2u*)((bf16*)(ws + WS_XB) + (size_t)(m + r * NGW) * D) + lane;
#pragma unroll
            for (int j = 0; j < 4; ++j) { v2u w; w.x = pk2(v[r][j].x, v[r][j].y); w.y = pk2(v[r][j].z, v[r][j].w); o[64 * j] = w; } } }
    }
    { float* rwt = (float*)(ws + WS_RWT);
      for (int idx = gw * 64 + lane; idx < 2 * NRW * D; idx += NGW * 64) { const int l = idx / (NRW * D), n = (idx / D) % NRW, k = idx % D;
          const float w = n < NG ? a->rg_w[((size_t)l * D + k) * NG + n] : a->re_w[((size_t)l * D + k) * NE + (n - NG)];
          rwt[idx] = w;
          const unsigned hi = f2bf(w), lo = f2bf(w - __builtin_bit_cast(float, hi << 16));
          bf16* img = (bf16*)(ws + WS_RWH) + (size_t)l * (RWH_PAD / 2);
          img[(size_t)n * (RWH_PITCH / 2) + k] = (bf16)hi; img[(size_t)(NRW + n) * (RWH_PITCH / 2) + k] = (bf16)lo; } }
}
__device__ __forceinline__ void p0b_fill(LAS unsigned char* lds, int lo, int hi, int r, int nidle) {
    const ArgsP a = kargs(); const Ctx cx = mkctx(a); unsigned char* ws = cx.ws;
    LAS float* scr = (LAS float*)(lds + cx.wave * 16640);
    for (int it = lo + r * NWAVES + cx.wave; it < hi; it += nidle * NWAVES) {
        if (it < NE * 256) { const int mtx = NE + it / 256; p0_transpose_item(a->e_w_in + (size_t)mtx * D * D, D, D, (bf16*)(ws + WS_WUT) + (size_t)mtx * D * D, 0, scr, it % 256, cx.lane); }
        else { const int r2 = it - NE * 256, mtx = NE + r2 / 128; p0_transpose_item(a->e_w_down + (size_t)mtx * DE * D, DE, D, (bf16*)(ws + WS_WDT) + (size_t)mtx * D * DE, 0, scr, r2 % 128, cx.lane); }
    }
}
constexpr int P0B_ITEMS = NE * 256 + NE * 128;
__device__ __forceinline__ void p0b_idle_fill(LAS unsigned char* lds, int lo, int hi) {
    const ArgsP a = kargs(); const Ctx cx = mkctx(a); const LAS int* misc = (const LAS int*)(lds + MISC_OFF);
    const int per = cx.G >> 3, x = cx.bx & 7, r = cx.bx >> 3; int nidle = 0, before = 0;
    for (int q = 0; q < 8; ++q) { const int rem = misc[q * 9 + 8] % per, id = rem ? per - rem : 0; if (q < x) before += id; nidle += id; }
    const int remx = misc[x * 9 + 8] % per;
    if (nidle == 0) p0b_fill(lds, lo, hi, cx.bx, cx.G);
    else if (remx && r >= remx) p0b_fill(lds, lo, hi, before + r - remx, nidle);
}
struct SchedDense {
    int G, c, nN, mode, K; const char* W;
    __device__ __forceinline__ bool next(int i, Unit& u) const {
        int pm, pn; if (!pg8::static_tile(i, G, c, T / 256, nN, pm, pn)) return false;
        u.arow = pm * 256; u.p0 = pm; u.p1 = pn; u.p2 = 0; u.p3 = 0;
        const size_t rb = (size_t)K * 2;
        if (mode == 0 && pn >= 4) { const int jj = pn - 4; u.b0 = W + (size_t)(D + 128 * jj) * rb; u.b1 = W + (size_t)(2 * D + 128 * jj) * rb; }
        else { u.b0 = W + (size_t)(256 * pn) * rb; u.b1 = u.b0 + 128 * rb; }
        return true;
    }
    __device__ __forceinline__ void a_offs(const Unit& u, const int (&R)[2], const int (&C)[2], unsigned& v00, unsigned& v01, unsigned& v10, unsigned& v11) const {
        v00 = (unsigned)((u.arow + R[0]) * K + C[0]) * 2u; v01 = (unsigned)((u.arow + R[1]) * K + C[1]) * 2u;
        v10 = (unsigned)((u.arow + 128 + R[0]) * K + C[0]) * 2u; v11 = (unsigned)((u.arow + 128 + R[1]) * K + C[1]) * 2u;
    }
    __device__ __forceinline__ bool half_only(const Unit&) const { return false; }
    __device__ __forceinline__ unsigned peek(const Unit&) const { return 0u; }
    __device__ __forceinline__ void a_ready(const Unit&, unsigned) const {}
    __device__ __forceinline__ void done(const Unit&) const {}
};
struct MoeTab { const LAS int* ub; const LAS int* ps; const LAS int* cn; };
struct SchedMoe {
    int G, c, K; bool up; const char* W; const v2u* perm; MoeTab tb;
    unsigned* ready; int hook; int off, nb;
    __device__ __forceinline__ bool half_only(const Unit& u) const { return u.p2 <= 128; }
    __device__ __forceinline__ unsigned peek(const Unit& u) const {
        return hook == 2 ? __hip_atomic_load(ready + 64 * u.p3, __ATOMIC_RELAXED, __HIP_MEMORY_SCOPE_AGENT) : 0u;
    }
    __device__ __forceinline__ void a_ready(const Unit& u, unsigned pk) const {
        if (hook != 2) return;
        if ((unsigned)__builtin_amdgcn_readfirstlane(pk) >= 32u) return;
        const unsigned long long t0 = __builtin_amdgcn_s_memrealtime();
        while ((unsigned)__builtin_amdgcn_readfirstlane(__hip_atomic_load(ready + 64 * u.p3, __ATOMIC_RELAXED, __HIP_MEMORY_SCOPE_AGENT)) < 32u) {
            if (__builtin_amdgcn_s_memrealtime() - t0 > 2000000ull) break;
            __builtin_amdgcn_s_sleep(2); }
        __builtin_amdgcn_fence(__ATOMIC_ACQUIRE, "agent");
        asm volatile("s_waitcnt vmcnt(0)" ::: "memory");
    }
    __device__ __forceinline__ void done(const Unit& u) const {
        if (hook != 1) return;
        asm volatile("s_waitcnt vmcnt(0)" ::: "memory");
        if ((threadIdx.x & 63) == 0) __hip_atomic_fetch_add(ready + 64 * u.p3, 1u, __ATOMIC_RELAXED, __HIP_MEMORY_SCOPE_AGENT);
    }
    __device__ __forceinline__ bool next(int i, Unit& u) const {
        const int x = c & 7, idx = i * (G >> 3) + (c >> 3);
        const LAS int* xb = tb.ub + x * 9;
        if (idx >= xb[8]) return false;
        const int ln = (int)__builtin_amdgcn_mbcnt_hi(~0u, __builtin_amdgcn_mbcnt_lo(~0u, 0u));
        const int k = (int)__builtin_popcountll(__ballot(ln < 8 && idx >= xb[ln & 7])) - 1;
        const int e = x + 8 * (k & 3), local = idx - xb[k];
        int ct, rti;
        if (k < 4) { const int rtn = (xb[k + 1] - xb[k]) >> 2; ct = local / rtn; rti = local - ct * rtn; }
        else { ct = local; rti = (tb.cn[e] - 1) >> 8; }
        const size_t rb = (size_t)K * 2; const char* We = W + (size_t)e * D * rb;
        if (up) { u.b0 = We + (size_t)(128 * ct) * rb; u.b1 = We + (size_t)(DE + 128 * ct) * rb; u.arow = e * CAP + rti * 256; u.p0 = tb.ps[e] + rti * 256; }
        else { u.b0 = We + (size_t)(256 * ct) * rb; u.b1 = u.b0 + 128 * rb; u.arow = tb.ps[e] + rti * 256; u.p0 = e * CAP + rti * 256; }
        u.p1 = ct; u.p2 = tb.cn[e] - rti * 256; u.p3 = (tb.ps[e] >> 8) + rti;
        return true;
    }
    __device__ __forceinline__ void a_offs(const Unit& u, const int (&R)[2], const int (&C)[2], unsigned& v00, unsigned& v01, unsigned& v10, unsigned& v11) const {
        if (up) {
            const int r00 = R[0] < u.p2 ? R[0] : 0, r01 = R[1] < u.p2 ? R[1] : 0, r10 = 128 + R[0] < u.p2 ? 128 + R[0] : 0, r11 = 128 + R[1] < u.p2 ? 128 + R[1] : 0;
            const int t00 = (int)(perm[u.arow + r00].y >> 1), t01 = (int)(perm[u.arow + r01].y >> 1), t10 = (int)(perm[u.arow + r10].y >> 1), t11 = (int)(perm[u.arow + r11].y >> 1);
            v00 = (unsigned)(t00 * K + C[0]) * 2u; v01 = (unsigned)(t01 * K + C[1]) * 2u; v10 = (unsigned)(t10 * K + C[0]) * 2u; v11 = (unsigned)(t11 * K + C[1]) * 2u;
        } else {
            v00 = (unsigned)((u.arow + R[0]) * K + C[0]) * 2u; v01 = (unsigned)((u.arow + R[1]) * K + C[1]) * 2u;
            v10 = (unsigned)((u.arow + 128 + R[0]) * K + C[0]) * 2u; v11 = (unsigned)((u.arow + 128 + R[1]) * K + C[1]) * 2u;
        }
    }
};

struct EpiConvIn {
    static constexpr bool PERM = true; bf16* GB; bf16* U;
    __device__ __forceinline__ void operator()(const f32x4 (&acc)[2][2][4][2], const Unit& u, int wr, int wc, int fr, int fq) const {
        const int row0 = u.p0 * 256 + wr * 64 + fr;
        if (u.p1 < 4) {
            const int col0 = u.p1 * 256 + wc * 32 + 8 * fq;
#pragma unroll
            for (int ai = 0; ai < 2; ++ai)
#pragma unroll
                for (int m = 0; m < 4; ++m) { bf16* rowp = GB + (size_t)(row0 + ai * 128 + m * 16) * D + col0;
#pragma unroll
                    for (int bj = 0; bj < 2; ++bj) { const f32x4 v0 = acc[ai][bj][m][0], v1 = acc[ai][bj][m][1];
                        v4u w; w.x = cvt_pk_bf16(v0[0], v0[1]); w.y = cvt_pk_bf16(v0[2], v0[3]); w.z = cvt_pk_bf16(v1[0], v1[1]); w.w = cvt_pk_bf16(v1[2], v1[3]);
                        *(v4u*)(rowp + bj * 128) = w; } }
        } else {
            const int col0 = (u.p1 - 4) * 128 + wc * 32 + 8 * fq;
#pragma unroll
            for (int ai = 0; ai < 2; ++ai)
#pragma unroll
                for (int m = 0; m < 4; ++m) { const f32x4 v0 = acc[ai][0][m][0] * acc[ai][1][m][0], v1 = acc[ai][0][m][1] * acc[ai][1][m][1];
                    v4u w; w.x = cvt_pk_bf16(v0[0], v0[1]); w.y = cvt_pk_bf16(v0[2], v0[3]); w.z = cvt_pk_bf16(v1[0], v1[1]); w.w = cvt_pk_bf16(v1[2], v1[3]);
                    *(v4u*)(U + (size_t)(row0 + ai * 128 + m * 16) * D + col0) = w; }
        }
    }
};
template <bool RES_BF16> struct EpiResZ {
    static constexpr bool PERM = true; const void* res; bf16* Z;
    __device__ __forceinline__ void operator()(const f32x4 (&acc)[2][2][4][2], const Unit& u, int wr, int wc, int fr, int fq) const {
        const int row0 = u.p0 * 256 + wr * 64 + fr, col0 = u.p1 * 256 + wc * 32 + 8 * fq;
#pragma unroll
        for (int ai = 0; ai < 2; ++ai)
#pragma unroll
            for (int m = 0; m < 4; ++m) { const size_t off = (size_t)(row0 + ai * 128 + m * 16) * D + col0;
#pragma unroll
                for (int bj = 0; bj < 2; ++bj) { const size_t o = off + bj * 128; f32x4 r0, r1;
                    if (RES_BF16) { const v4u w = *(const v4u*)((const bf16*)res + o); r0 = (f32x4){bflo(w.x), bfhi(w.x), bflo(w.y), bfhi(w.y)}; r1 = (f32x4){bflo(w.z), bfhi(w.z), bflo(w.w), bfhi(w.w)}; }
                    else { r0 = *(const f32x4*)((const float*)res + o); r1 = *(const f32x4*)((const float*)res + o + 4); }
                    const f32x4 v0 = r0 * ALPHA + acc[ai][bj][m][0], v1 = r1 * ALPHA + acc[ai][bj][m][1];
                    v4u w; w.x = cvt_pk_bf16(v0[0], v0[1]); w.y = cvt_pk_bf16(v0[2], v0[3]); w.z = cvt_pk_bf16(v1[0], v1[1]); w.w = cvt_pk_bf16(v1[2], v1[3]);
                    *(v4u*)(Z + o) = w; } }
    }
};
template <bool WT> struct EpiUp {
    static constexpr bool PERM = true; bf16* ACT;
    __device__ __forceinline__ void operator()(const f32x4 (&acc)[2][2][4][2], const Unit& u, int wr, int wc, int fr, int fq) const {
        const int row0 = u.p0 + wr * 64 + fr, col0 = u.p1 * 128 + wc * 32 + 8 * fq;
#pragma unroll
        for (int ai = 0; ai < 2; ++ai)
#pragma unroll
            for (int m = 0; m < 4; ++m) { f32x4 v[2];
#pragma unroll
                for (int n = 0; n < 2; ++n) { const f32x4 g = acc[ai][0][m][n], uu = acc[ai][1][m][n];
#pragma unroll
                    for (int j = 0; j < 4; ++j) { const float e = __builtin_amdgcn_exp2f(g[j] * -1.4426950408889634f); v[n][j] = g[j] * __builtin_amdgcn_rcpf(1.0f + e) * uu[j]; } }
                v4u w; w.x = cvt_pk_bf16(v[0][0], v[0][1]); w.y = cvt_pk_bf16(v[0][2], v[0][3]); w.z = cvt_pk_bf16(v[1][0], v[1][1]); w.w = cvt_pk_bf16(v[1][2], v[1][3]);
                bf16* dst = ACT + (size_t)(row0 + ai * 128 + m * 16) * DE + col0;
                if (WT) { __hip_atomic_store((unsigned long long*)dst, ((unsigned long long)w.y << 32) | w.x, __ATOMIC_RELAXED, __HIP_MEMORY_SCOPE_AGENT);
                          __hip_atomic_store((unsigned long long*)dst + 1, ((unsigned long long)w.w << 32) | w.z, __ATOMIC_RELAXED, __HIP_MEMORY_SCOPE_AGENT); }
                else *(v4u*)dst = w; }
    }
};
struct EpiDown {
    static constexpr bool PERM = true; bf16* YP; const v2u* perm;
    __device__ __forceinline__ void operator()(const f32x4 (&acc)[2][2][4][2], const Unit& u, int wr, int wc, int fr, int fq) const {
        const int col0 = u.p1 * 256 + wc * 32 + 8 * fq;
        v2u rec[2][4];
#pragma unroll
        for (int ai = 0; ai < 2; ++ai)
#pragma unroll
            for (int m = 0; m < 4; ++m) { const int r = ai * 128 + wr * 64 + m * 16 + fr; rec[ai][m] = perm[u.p0 + (r < u.p2 ? r : 0)]; }
#pragma unroll
        for (int ai = 0; ai < 2; ++ai)
#pragma unroll
            for (int m = 0; m < 4; ++m) { const int r = ai * 128 + wr * 64 + m * 16 + fr;
                if (r < u.p2) { const int pair = (int)rec[ai][m].y; float g = __builtin_bit_cast(float, rec[ai][m].x); asm volatile("" : "+v"(g)); bf16* rowp = YP + (size_t)pair * D + col0;
#pragma unroll
                    for (int bj = 0; bj < 2; ++bj) { const f32x4 v0 = acc[ai][bj][m][0] * g, v1 = acc[ai][bj][m][1] * g;
                        v4u w; w.x = cvt_pk_bf16(v0[0], v0[1]); w.y = cvt_pk_bf16(v0[2], v0[3]); w.z = cvt_pk_bf16(v1[0], v1[1]); w.w = cvt_pk_bf16(v1[2], v1[3]);
                        *(v4u*)(rowp + bj * 128) = w; } } }
    }
};
struct EpiKVQ {
    static constexpr bool PERM = true; bf16* KB;
    __device__ __forceinline__ void operator()(const f32x4 (&acc)[2][2][4][2], const Unit& u, int wr, int wc, int fr, int fq) const {
        const int t = u.p1 >> 2; const float sc = t == 2 ? QSCALE : 1.0f;
        bf16* base = KB + (size_t)t * (32 * MiB / 2);
        const int row0 = u.p0 * 256 + wr * 64 + fr, col0 = (u.p1 & 3) * 256 + wc * 32 + 8 * fq;
#pragma unroll
        for (int ai = 0; ai < 2; ++ai)
#pragma unroll
            for (int m = 0; m < 4; ++m) { bf16* rowp = base + (size_t)(row0 + ai * 128 + m * 16) * D + col0;
#pragma unroll
                for (int bj = 0; bj < 2; ++bj) { const f32x4 v0 = acc[ai][bj][m][0] * sc, v1 = acc[ai][bj][m][1] * sc;
                    v4u w; w.x = cvt_pk_bf16(v0[0], v0[1]); w.y = cvt_pk_bf16(v0[2], v0[3]); w.z = cvt_pk_bf16(v1[0], v1[1]); w.w = cvt_pk_bf16(v1[2], v1[3]);
                    *(v4u*)(rowp + bj * 128) = w; } }
    }
};

__device__ __forceinline__ void ln_rows(f32x4 (&v)[4], const f32x4 (&gg)[4], const f32x4 (&bb)[4]) {
    float s = 0.f;
#pragma unroll
    for (int j = 0; j < 4; ++j) s += (v[j].x + v[j].y) + (v[j].z + v[j].w);
    const float mean = dpp_sum1(s) * (1.f / D); float s2 = 0.f;
#pragma unroll
    for (int j = 0; j < 4; ++j) { v[j] = v[j] - mean; s2 += (v[j].x * v[j].x + v[j].y * v[j].y) + (v[j].z * v[j].z + v[j].w * v[j].w); }
    const float rstd = 1.f / sqrtf(dpp_sum1(s2) * (1.f / D) + LN_EPS);
#pragma unroll
    for (int j = 0; j < 4; ++j) v[j] = v[j] * rstd * gg[j] + bb[j];
}
__device__ __forceinline__ float dot_lds(const f32x4 (&v)[4], const LAS f32x4* w, int lane) {
    float a = 0.f;
#pragma unroll
    for (int j = 0; j < 4; ++j) { const f32x4 ww = w[64 * j + lane]; a += (v[j].x * ww.x + v[j].y * ww.y) + (v[j].z * ww.z + v[j].w * ww.w); }
    return a;
}
typedef short bf16x8v __attribute__((ext_vector_type(8)));
__device__ __forceinline__ void ln_router_mfma(LAS unsigned char* lds, int layer, int rep) {
    const ArgsP a = kargs(); const Ctx cx = mkctx(a); const int lane = cx.lane, wave = cx.wave, tid = cx.tid;
    unsigned char* ws = cx.ws;
    const bf16* Z = (const bf16*)(ws + LZ(layer)); bf16* Xb = (bf16*)(ws + (layer == 0 ? WS_X1B : WS_X3B));
    const float* g = a->ln1_g + layer * D; const float* b = a->ln1_b + layer * D;
    const float* rgb = a->rg_b + layer * NG; const float* reb = a->re_b + layer * NE;
    int* cnt = (int*)(ws + WS_CTL) + layer * NE * CNT_STRIDE; v2u* perm = (v2u*)(ws + LPERM(layer));
    const int i = lane & 15, kq = lane >> 4, grp = wave >> 1, half = wave & 1;
    const int row = cx.bx * 64 + grp * 16 + i, col0 = 512 * half + 8 * kq;
    { const unsigned char* wg = ws + WS_RWH + (size_t)layer * RWH_PAD;
      for (int q = wave; q < RWH_PAD / 1024; q += NWAVES)
          __builtin_amdgcn_global_load_lds((const unsigned*)(wg + (size_t)q * 1024 + lane * 16), (LAS unsigned*)(lds + q * 1024), 16, 0, 0); }
    v4u xw[16];
#pragma unroll
    for (int s = 0; s < 16; ++s) xw[s] = *(const v4u*)(Z + (size_t)row * D + col0 + 32 * s);
#define XLO(s) ((f32x4){bflo(xw[s].x), bfhi(xw[s].x), bflo(xw[s].y), bfhi(xw[s].y)})
#define XHI(s) ((f32x4){bflo(xw[s].z), bfhi(xw[s].z), bflo(xw[s].w), bfhi(xw[s].w)})
    LAS float* xs = (LAS float*)(lds + MISC_OFF + 4096);
    LAS float* part = (LAS float*)lds;
    float s1 = 0.f, s2 = 0.f;
#pragma unroll
    for (int s = 0; s < 16; ++s)
#pragma unroll
        for (int h2 = 0; h2 < 2; ++h2) { const f32x4 v = h2 ? XHI(s) : XLO(s); s1 += (v.x + v.y) + (v.z + v.w); s2 += (v.x * v.x + v.y * v.y) + (v.z * v.z + v.w * v.w); }
#pragma unroll
    for (int s = 0; s < 16; ++s) asm volatile("" : "+v"(xw[s]));
    s1 += __shfl_xor(s1, 16); s2 += __shfl_xor(s2, 16); s1 += __shfl_xor(s1, 32); s2 += __shfl_xor(s2, 32);
    if (kq == 0) { xs[(wave * 16 + i) * 2] = s1; xs[(wave * 16 + i) * 2 + 1] = s2; }
    __syncthreads();
    const float t1 = xs[((wave ^ 1) * 16 + i) * 2] + s1, t2 = xs[((wave ^ 1) * 16 + i) * 2 + 1] + s2;
    const float mean = t1 * (1.f / D), rstd = 1.f / sqrtf(fmaxf(t2 * (1.f / D) - mean * mean, 0.f) + LN_EPS);
    typedef float f32x4a __attribute__((ext_vector_type(4)));
    f32x4a acc0 = {0.f, 0.f, 0.f, 0.f}, acc1 = acc0, acc2 = acc0;
    const LAS unsigned char* wb = (const LAS unsigned char*)lds + (size_t)(lane & 15) * RWH_PITCH + (size_t)col0 * 2;
    const int n2 = (32 + (lane & 15)) < NRW ? 32 + (lane & 15) : NRW - 1;
    const LAS unsigned char* wb2 = (const LAS unsigned char*)lds + (size_t)n2 * RWH_PITCH + (size_t)col0 * 2;
    constexpr int LO = NRW * RWH_PITCH;
#pragma unroll
    for (int s = 0; s < 16; ++s) {
        if ((s & 3) == 0) asm volatile("" ::: "memory");
        const float* gp = g + col0 + 32 * s; const float* bp = b + col0 + 32 * s;
        const f32x4 g0 = *(const f32x4*)gp, g1 = *(const f32x4*)(gp + 4), b0 = *(const f32x4*)bp, b1 = *(const f32x4*)(bp + 4);
        const f32x4 v0 = (XLO(s) - mean) * rstd * g0 + b0, v1 = (XHI(s) - mean) * rstd * g1 + b1;
        const float vv[8] = {v0.x, v0.y, v0.z, v0.w, v1.x, v1.y, v1.z, v1.w};
        unsigned hi[8], lo[8];
#pragma unroll
        for (int j = 0; j < 8; ++j) { hi[j] = f2bf(vv[j]); lo[j] = f2bf(vv[j] - __builtin_bit_cast(float, hi[j] << 16)); }
        v4u hw, lw;
#pragma unroll
        for (int j = 0; j < 4; ++j) { hw[j] = hi[2 * j] | (hi[2 * j + 1] << 16); lw[j] = lo[2 * j] | (lo[2 * j + 1] << 16); }
        *(v4u*)(Xb + (size_t)row * D + col0 + 32 * s) = hw;
        const bf16x8v ah = __builtin_bit_cast(bf16x8v, hw), al = __builtin_bit_cast(bf16x8v, lw);
        const bf16x8v w0h = *(const LAS bf16x8v*)(wb + 64 * s), w0l = *(const LAS bf16x8v*)(wb + LO + 64 * s);
        const bf16x8v w1h = *(const LAS bf16x8v*)(wb + 16 * RWH_PITCH + 64 * s), w1l = *(const LAS bf16x8v*)(wb + 16 * RWH_PITCH + LO + 64 * s);
        const bf16x8v w2h = *(const LAS bf16x8v*)(wb2 + 64 * s), w2l = *(const LAS bf16x8v*)(wb2 + LO + 64 * s);
        acc0 = __builtin_amdgcn_mfma_f32_16x16x32_bf16(ah, w0h, acc0, 0, 0, 0); acc0 = __builtin_amdgcn_mfma_f32_16x16x32_bf16(al, w0h, acc0, 0, 0, 0); acc0 = __builtin_amdgcn_mfma_f32_16x16x32_bf16(ah, w0l, acc0, 0, 0, 0);
        acc1 = __builtin_amdgcn_mfma_f32_16x16x32_bf16(ah, w1h, acc1, 0, 0, 0); acc1 = __builtin_amdgcn_mfma_f32_16x16x32_bf16(al, w1h, acc1, 0, 0, 0); acc1 = __builtin_amdgcn_mfma_f32_16x16x32_bf16(ah, w1l, acc1, 0, 0, 0);
        acc2 = __builtin_amdgcn_mfma_f32_16x16x32_bf16(ah, w2h, acc2, 0, 0, 0); acc2 = __builtin_amdgcn_mfma_f32_16x16x32_bf16(al, w2h, acc2, 0, 0, 0); acc2 = __builtin_amdgcn_mfma_f32_16x16x32_bf16(ah, w2l, acc2, 0, 0, 0);
    }
    __syncthreads();
#undef XLO
#undef XHI
#pragma unroll
    for (int r = 0; r < 4; ++r) { LAS float* pr = part + (size_t)(wave * 16 + 4 * kq + r) * 48 + (lane & 15); pr[0] = acc0[r]; pr[16] = acc1[r]; pr[32] = acc2[r]; }
    LAS int* rt_e = (LAS int*)(part + 8 * 16 * 48);
    LAS float* rt_g = (LAS float*)(rt_e + 128);
    LAS int* rt_base = (LAS int*)(rt_g + 128);
    __syncthreads();
    if (tid < 64) {
        const int gq = tid >> 4, ii = tid & 15; const LAS float* p0 = part + (size_t)((2 * gq) * 16 + ii) * 48; const LAS float* p1 = p0 + 16 * 48;
        int gi = 0; float gm = -INFINITY, gl[NG];
#pragma unroll
        for (int n = 0; n < NG; ++n) { gl[n] = p0[n] + p1[n] + rgb[n]; if (gl[n] > gm) { gm = gl[n]; gi = n; } }
        float gs = 0.f;
#pragma unroll
        for (int n = 0; n < NG; ++n) gs += __expf(gl[n] - gm);
        const float gtop = 1.0f / gs;
        float m0 = -INFINITY, m1 = -INFINITY; int i0 = 0, i1 = 0;
        for (int n = 0; n < EPG; ++n) { const int c = NG + gi * EPG + n; const float e = p0[c] + p1[c] + reb[gi * EPG + n];
            if (e > m0) { m1 = m0; i1 = i0; m0 = e; i0 = n; } else if (e > m1) { m1 = e; i1 = n; } }
        const float e1 = __expf(m1 - m0), w0 = 1.0f / (1.0f + e1), w1 = e1 * w0;
        rt_e[2 * tid] = gi * EPG + i0; rt_e[2 * tid + 1] = gi * EPG + i1; rt_g[2 * tid] = gtop * w0; rt_g[2 * tid + 1] = gtop * w1;
    }
    __syncthreads();
    if (rep == 0) {
        LAS int* wc = rt_base + NE;
        int my_e = 0, my_rank = 0, my_cnt = 0;
        if (tid < 128) { my_e = rt_e[tid];
            const unsigned long long lt = (1ull << lane) - 1ull;
#pragma unroll 4
            for (int e = 0; e < NE; ++e) { const unsigned long long m = __ballot(my_e == e); if (my_e == e) my_rank = (int)__builtin_popcountll(m & lt); if (lane == e) my_cnt = (int)__builtin_popcountll(m); }
            if (lane < NE) wc[wave * NE + lane] = my_cnt; }
        __syncthreads();
        if (tid < NE) { const int c = wc[tid] + wc[NE + tid]; rt_base[tid] = c ? atomicAdd(&cnt[tid * CNT_STRIDE], c) : 0; }
        __syncthreads();
        if (tid < 128) { const int pair = 2 * (cx.bx * 64 + (tid >> 1)) + (tid & 1);
            perm[my_e * CAP + rt_base[my_e] + my_rank + (wave ? wc[my_e] : 0)] = (v2u){__builtin_bit_cast(unsigned, rt_g[tid]), (unsigned)pair}; }
    }
}
__device__ __forceinline__ void ln_router_phase(LAS unsigned char* lds, int layer, int rep = 0) {
    const ArgsP a = kargs(); const Ctx cx = mkctx(a); const int gw = cx.gw, NGW = cx.NGW, lane = cx.lane;
    unsigned char* ws = cx.ws;
    const bf16* Z = (const bf16*)(ws + LZ(layer)); bf16* Xb = (bf16*)(ws + (layer == 0 ? WS_X1B : WS_X3B));
    const float* g = a->ln1_g + layer * D; const float* b = a->ln1_b + layer * D;
    const float* rgb = a->rg_b + layer * NG; const float* reb = a->re_b + layer * NE;
    int* cnt = (int*)(ws + WS_CTL) + layer * NE * CNT_STRIDE; v2u* perm = (v2u*)(ws + LPERM(layer));
    LAS f32x4* wl = (LAS f32x4*)lds;
    { const f32x4* wg = (const f32x4*)((const float*)(ws + WS_RWT) + (size_t)layer * NRW * D);
      for (int i = cx.tid; i < NRW * D / 4; i += NTHREADS) wl[i] = wg[i]; }
    f32x4 gg[4], bb[4];
#pragma unroll
    for (int j = 0; j < 4; ++j) { gg[j] = *(const f32x4*)(g + 256 * j + 4 * lane); bb[j] = *(const f32x4*)(b + 256 * j + 4 * lane); }
    constexpr int RPW = 16;
    LAS int* rt_row = (LAS int*)(lds + MISC_OFF + 2048);
    LAS int* rt_e = rt_row + NWAVES * RPW;
    LAS float* rt_g = (LAS float*)(rt_e + 2 * NWAVES * RPW);
    LAS int* rt_base = (LAS int*)(rt_g + 2 * NWAVES * RPW);
    LAS int* wave_rows = rt_base + NE;
    f32x4 nv[2][4];
#pragma unroll
    for (int r = 0; r < 2; ++r) { const int row = gw + r * NGW;
        if (row < T) {
#pragma unroll
            for (int j = 0; j < 4; ++j) nv[r][j] = ldz4(Z + (size_t)row * D + 256 * j + 4 * lane);
        } }
    __syncthreads();
    int it = 0;
#pragma unroll 1
    for (int row0 = gw; row0 < T && it < RPW; row0 += 2 * NGW, it += 2) {
        const bool two = row0 + NGW < T;
        f32x4 v[2][4];
#pragma unroll
        for (int r = 0; r < 2; ++r)
#pragma unroll
            for (int j = 0; j < 4; ++j) v[r][j] = nv[r][j];
#pragma unroll
        for (int r = 0; r < 2; ++r) { const int row = row0 + (2 + r) * NGW;
            if (row < T) {
#pragma unroll
                for (int j = 0; j < 4; ++j) nv[r][j] = ldz4(Z + (size_t)row * D + 256 * j + 4 * lane);
            } }
        if (!two) {
#pragma unroll
            for (int j = 0; j < 4; ++j) v[1][j] = v[0][j];
        }
        float s1[2];
#pragma unroll
        for (int r = 0; r < 2; ++r) { float s = 0.f;
#pragma unroll
            for (int j = 0; j < 4; ++j) s += (v[r][j].x + v[r][j].y) + (v[r][j].z + v[r][j].w);
            s1[r] = s; }
        dpp_sum(s1);
        float s2[2];
#pragma unroll
        for (int r = 0; r < 2; ++r) { const float mean = s1[r] * (1.f / D); float q = 0.f;
#pragma unroll
            for (int j = 0; j < 4; ++j) { v[r][j] = v[r][j] - mean; q += (v[r][j].x * v[r][j].x + v[r][j].y * v[r][j].y) + (v[r][j].z * v[r][j].z + v[r][j].w * v[r][j].w); }
            s2[r] = q; }
        dpp_sum(s2);
#pragma unroll
        for (int r = 0; r < 2; ++r) { const float rstd = 1.f / sqrtf(s2[r] * (1.f / D) + LN_EPS);
#pragma unroll
            for (int j = 0; j < 4; ++j) v[r][j] = v[r][j] * rstd * gg[j] + bb[j]; }
#pragma unroll
        for (int r = 0; r < 2; ++r) { const int row = row0 + r * NGW;
            if (r == 0 || two) {
#pragma unroll
                for (int j = 0; j < 4; ++j) { v2u w; w.x = pk2(v[r][j].x, v[r][j].y); w.y = pk2(v[r][j].z, v[r][j].w); *(v2u*)(Xb + (size_t)row * D + 256 * j + 4 * lane) = w; }
            } }
        float gl[2 * NG];
#pragma unroll
        for (int r = 0; r < 2; ++r)
#pragma unroll
            for (int n = 0; n < NG; ++n) gl[r * NG + n] = dot_lds(v[r], wl + n * (D / 4), lane);
        dpp_sum(gl);
        int gi[2]; float gtop[2];
#pragma unroll
        for (int r = 0; r < 2; ++r) { int g_ = 0; float gm = -INFINITY;
#pragma unroll
            for (int n = 0; n < NG; ++n) { gl[r * NG + n] += rgb[n]; if (gl[r * NG + n] > gm) { gm = gl[r * NG + n]; g_ = n; } }
            float gs = 0.f;
#pragma unroll
            for (int n = 0; n < NG; ++n) gs += __expf(gl[r * NG + n] - gm);
            gi[r] = g_; gtop[r] = 1.0f / gs; }
        float el[2 * EPG];
#pragma unroll
        for (int r = 0; r < 2; ++r)
#pragma unroll
            for (int n = 0; n < EPG; ++n) el[r * EPG + n] = dot_lds(v[r], wl + (NG + gi[r] * EPG + n) * (D / 4), lane);
        dpp_sum(el);
#pragma unroll
        for (int r = 0; r < 2; ++r) {
            float m0 = -INFINITY, m1 = -INFINITY; int i0 = 0, i1 = 0;
#pragma unroll
            for (int n = 0; n < EPG; ++n) { const float e = el[r * EPG + n] + reb[gi[r] * EPG + n];
                if (e > m0) { m1 = m0; i1 = i0; m0 = e; i0 = n; } else if (e > m1) { m1 = e; i1 = n; } }
            const float e1 = __expf(m1 - m0), w0 = 1.0f / (1.0f + e1), w1 = e1 * w0;
            if (lane == 0 && (r == 0 || two)) {
                const int li = cx.wave * RPW + it + r;
                rt_row[li] = row0 + r * NGW; rt_e[2 * li] = gi[r] * EPG + i0; rt_e[2 * li + 1] = gi[r] * EPG + i1; rt_g[2 * li] = gtop[r] * w0; rt_g[2 * li + 1] = gtop[r] * w1;
            }
        }
        if (!two) { it += 1; break; }
    }
    if (lane == 0) wave_rows[cx.wave] = it;
    __syncthreads();
    if (rep == 0) {
        if (cx.tid < NE) { int c = 0;
            for (int w = 0; w < NWAVES; ++w) { const int n = wave_rows[w]; for (int i = 0; i < 2 * n; ++i) c += (rt_e[2 * (w * RPW) + i] == cx.tid) ? 1 : 0; }
            rt_base[cx.tid] = c ? atomicAdd(&cnt[cx.tid * CNT_STRIDE], c) : 0; }
        __syncthreads();
        if (cx.tid < 2 * NWAVES * RPW) { const int w = cx.tid / (2 * RPW), i = cx.tid % (2 * RPW);
            if (i < 2 * wave_rows[w]) { const int e = rt_e[cx.tid]; int rank = 0;
                for (int w2 = 0; w2 <= w; ++w2) { const int lim = (w2 < w) ? 2 * wave_rows[w2] : i; for (int q = 0; q < lim; ++q) rank += (rt_e[2 * (w2 * RPW) + q] == e) ? 1 : 0; }
                const int pair = 2 * rt_row[cx.tid >> 1] + (cx.tid & 1);
                perm[e * CAP + rt_base[e] + rank] = (v2u){__builtin_bit_cast(unsigned, rt_g[cx.tid]), (unsigned)pair}; } }
    }
}
__device__ __forceinline__ void ln2_phase(int layer) {
    const ArgsP a = kargs(); const Ctx cx = mkctx(a); const int gw = cx.gw, NGW = cx.NGW, lane = cx.lane;
    unsigned char* ws = cx.ws;
    const bf16* Xin = (const bf16*)(ws + (layer == 0 ? WS_X1B : WS_X3B)); const bf16* YP = (const bf16*)(ws + LYP(layer));
    const float* g = a->ln2_g + layer * D; const float* b = a->ln2_b + layer * D;
    f32x4 gg[4], bb[4];
#pragma unroll
    for (int j = 0; j < 4; ++j) { gg[j] = *(const f32x4*)(g + 256 * j + 4 * lane); bb[j] = *(const f32x4*)(b + 256 * j + 4 * lane); }
    v2u nx[4], ny0[4], ny1[4];
    if (gw < T) {
#pragma unroll
        for (int j = 0; j < 4; ++j) { const size_t c = 256 * j + 4 * lane;
            nx[j] = *(const v2u*)(Xin + (size_t)gw * D + c); ny0[j] = *(const v2u*)(YP + (size_t)(2 * gw) * D + c); ny1[j] = *(const v2u*)(YP + (size_t)(2 * gw + 1) * D + c); }
    }
#pragma unroll 1
    for (int row = gw; row < T; row += NGW) {
        f32x4 v[4];
#pragma unroll
        for (int j = 0; j < 4; ++j) { const v2u xw = nx[j], y0 = ny0[j], y1 = ny1[j];
            v[j].x = ALPHA * bflo(xw.x) + (bflo(y0.x) + bflo(y1.x)); v[j].y = ALPHA * bfhi(xw.x) + (bfhi(y0.x) + bfhi(y1.x));
            v[j].z = ALPHA * bflo(xw.y) + (bflo(y0.y) + bflo(y1.y)); v[j].w = ALPHA * bfhi(xw.y) + (bfhi(y0.y) + bfhi(y1.y)); }
        if (row + NGW < T) { const int r2 = row + NGW;
#pragma unroll
            for (int j = 0; j < 4; ++j) { const size_t c = 256 * j + 4 * lane;
                nx[j] = *(const v2u*)(Xin + (size_t)r2 * D + c); ny0[j] = *(const v2u*)(YP + (size_t)(2 * r2) * D + c); ny1[j] = *(const v2u*)(YP + (size_t)(2 * r2 + 1) * D + c); }
        }
        ln_rows(v, gg, bb);
        if (layer == 0) {
#pragma unroll
            for (int j = 0; j < 4; ++j) { v2u w; w.x = pk2(v[j].x, v[j].y); w.y = pk2(v[j].z, v[j].w); *(v2u*)((bf16*)(ws + WS_X2B) + (size_t)row * D + 256 * j + 4 * lane) = w; }
        } else {
#pragma unroll
            for (int j = 0; j < 4; ++j) *(f32x4*)(a->out + (size_t)row * D + 256 * j + 4 * lane) = v[j];
        }
    }
}
__device__ __forceinline__ void conv_phase() {
    const ArgsP a = kargs(); const Ctx cx = mkctx(a); const int gtid = cx.bx * NTHREADS + cx.tid, NGT = cx.G * NTHREADS;
    unsigned char* ws = cx.ws;
    const bf16* GB = (const bf16*)(ws + WS_GB); const bf16* U = (const bf16*)(ws + WS_U); bf16* A2 = (bf16*)(ws + WS_A2);
    for (int it = gtid; it < T * (D / 8); it += NGT) {
        const int t = it >> 7, d0 = (it & 127) * 8, s = t & (SEQ - 1);
        const size_t o = (size_t)t * D + d0;
        const v4u g = *(const v4u*)(GB + o), u0 = *(const v4u*)(U + o);
        v4u u1 = (v4u){0u, 0u, 0u, 0u}, u2 = u1;
        if (s >= 1) u1 = *(const v4u*)(U + o - D);
        if (s >= 2) u2 = *(const v4u*)(U + o - 2 * D);
        const f32x4 wa0 = *(const f32x4*)(a->a_conv_w + d0), wa1 = *(const f32x4*)(a->a_conv_w + d0 + 4), wb0 = *(const f32x4*)(a->a_conv_w + D + d0), wb1 = *(const f32x4*)(a->a_conv_w + D + d0 + 4);
        const f32x4 wc0 = *(const f32x4*)(a->a_conv_w + 2 * D + d0), wc1 = *(const f32x4*)(a->a_conv_w + 2 * D + d0 + 4);
        const float w0[8] = {wa0.x, wa0.y, wa0.z, wa0.w, wa1.x, wa1.y, wa1.z, wa1.w}, w1[8] = {wb0.x, wb0.y, wb0.z, wb0.w, wb1.x, wb1.y, wb1.z, wb1.w}, w2[8] = {wc0.x, wc0.y, wc0.z, wc0.w, wc1.x, wc1.y, wc1.z, wc1.w};
        v4u r;
#pragma unroll
        for (int q = 0; q < 4; ++q) {
            const float c0 = w0[2 * q] * bflo(u2[q]) + w1[2 * q] * bflo(u1[q]) + w2[2 * q] * bflo(u0[q]);
            const float c1 = w0[2 * q + 1] * bfhi(u2[q]) + w1[2 * q + 1] * bfhi(u1[q]) + w2[2 * q + 1] * bfhi(u0[q]);
            r[q] = pk2(bflo(g[q]) * c0, bfhi(g[q]) * c1);
        }
        *(v4u*)(A2 + o) = r;
    }
}
__device__ __forceinline__ void combine_phase() {
    const ArgsP a = kargs(); const Ctx cx = mkctx(a); const int gw = cx.gw, NGW = cx.NGW, lane = cx.lane;
    unsigned char* ws = cx.ws;
    const bf16* O0 = (const bf16*)(ws + WS_O0); const bf16* O1 = (const bf16*)(ws + WS_O1); bf16* A3 = (bf16*)(ws + WS_A3);
    const float l01 = wave_sum(a->b_lambda[lane] * a->b_lambda[64 + lane]), l23 = wave_sum(a->b_lambda[128 + lane] * a->b_lambda[192 + lane]);
    const float lam = __expf(l01) - __expf(l23) + LAM_INIT;
    float gsc[16];
#pragma unroll
    for (int i = 0; i < 16; ++i) gsc[i] = a->b_subln_g[(lane & 7) * 16 + i] * (1.0f - LAM_INIT);
    for (int row = gw; row < T; row += NGW) {
        const size_t o = (size_t)row * D + lane * 16;
        const v4u p0 = *(const v4u*)(O0 + o), p1 = *(const v4u*)(O0 + o + 8), q0 = *(const v4u*)(O1 + o), q1 = *(const v4u*)(O1 + o + 8);
        float d[16]; float ss = 0.f;
#pragma unroll
        for (int i = 0; i < 4; ++i) { d[2 * i] = bflo(p0[i]) - lam * bflo(q0[i]); d[2 * i + 1] = bfhi(p0[i]) - lam * bfhi(q0[i]);
            d[8 + 2 * i] = bflo(p1[i]) - lam * bflo(q1[i]); d[8 + 2 * i + 1] = bfhi(p1[i]) - lam * bfhi(q1[i]); }
#pragma unroll
        for (int i = 0; i < 16; ++i) ss += d[i] * d[i];
        ss += __shfl_xor(ss, 1); ss += __shfl_xor(ss, 2); ss += __shfl_xor(ss, 4);
        const float r = 1.0f / sqrtf(ss * (1.0f / 128.0f) + RMS_EPS);
        v4u w0, w1;
#pragma unroll
        for (int i = 0; i < 4; ++i) { w0[i] = pk2(d[2 * i] * r * gsc[2 * i], d[2 * i + 1] * r * gsc[2 * i + 1]); w1[i] = pk2(d[8 + 2 * i] * r * gsc[8 + 2 * i], d[8 + 2 * i + 1] * r * gsc[8 + 2 * i + 1]); }
        *(v4u*)(A3 + o) = w0; *(v4u*)(A3 + o + 8) = w1;
    }
}

#ifndef MKMASK
#define MKMASK 0xffff
#endif
#ifndef MKREP
#define MKREP 0
#endif
#ifndef MKSYNC
#define MKSYNC 0
#endif
#ifndef MKMASK2
#define MKMASK2 MKMASK
#endif
#define PH(k) _Pragma("unroll 1") for (int rep_ = 0; rep_ < (int)(((pass_ ? MKMASK2 : MKMASK) >> (k)) & 1) + (int)((MKREP >> (k)) & 1); ++rep_)
#define XB_TMO      128
#define XB_XCNT(j)  (256  + 64 * (j))
#define XB_XSUB(j)  (1280 + 64 * (j))
#define XB_XGEN(j)  (2304 + 64 * (j))
#define XB_TOP      3328
#define XB_TOPGEN   3392
#define XCD_BAR_WORDS 3456
#define XB_SPIN_CAP (1u << 18)

__device__ __forceinline__ unsigned xb_ld(unsigned* p)              { return __hip_atomic_load(p, __ATOMIC_RELAXED, __HIP_MEMORY_SCOPE_AGENT); }
__device__ __forceinline__ unsigned xb_add(unsigned* p, unsigned v) { return __hip_atomic_fetch_add(p, v, __ATOMIC_RELAXED, __HIP_MEMORY_SCOPE_AGENT); }
__device__ __forceinline__ unsigned xb_xcc_id() { return (unsigned)__builtin_amdgcn_s_getreg((3 << 11) | 20) & 0xFu; }
#define XB_SPIN(cond, bar) do { unsigned _sp = 0; while (cond) { __builtin_amdgcn_s_sleep(1); \
    if ((++_sp & 255u) == 0u) { if (xb_ld(&(bar)[XB_TMO])) break; if (_sp > XB_SPIN_CAP) { atomicAdd(&(bar)[XB_TMO], 1u); break; } } } } while (0)

struct XcdBarrier {
    unsigned* bar; unsigned x;
    volatile LAS unsigned* st;
};

__device__ __forceinline__ XcdBarrier xcd_barrier_post(unsigned* bar, volatile LAS unsigned* st) {
    XcdBarrier b; b.bar = bar; b.x = xb_xcc_id(); b.st = st;
    if (threadIdx.x == 0) (void)xb_add(&bar[XB_XCNT(b.x)], 1u);
    return b;
}
__device__ __forceinline__ void xcd_barrier_complete(unsigned* bar, unsigned x, unsigned& nloc, unsigned& nx) {
    const unsigned G = gridDim.x * gridDim.y * gridDim.z;
    unsigned sum, cnt, mine, sp = 0u;
    for (;;) {
        sum = 0u; cnt = 0u; mine = 0u;
#pragma unroll
        for (unsigned j = 0; j < 16; ++j) { const unsigned c = xb_ld(&bar[XB_XCNT(j)]); sum += c; cnt += (c > 0u) ? 1u : 0u; mine = (j == x) ? c : mine; }
        if (sum == G) break;
        __builtin_amdgcn_s_sleep(1);
        if ((++sp & 255u) == 0u) { if (xb_ld(&bar[XB_TMO])) break; if (sp > XB_SPIN_CAP) { atomicAdd(&bar[XB_TMO], 1u); break; } }
    }
    nloc = mine > 0u ? mine : 1u; nx = cnt > 0u ? cnt : 1u;
}

__device__ __forceinline__ void xcd_barrier(const XcdBarrier& b) {
    asm volatile("s_waitcnt vmcnt(0)" ::: "memory");
    __syncthreads();
    if (threadIdx.x == 0) {
        unsigned* bar = b.bar;
        __builtin_amdgcn_s_waitcnt(0);
        unsigned nloc = b.st[0], nx = b.st[1];
        if (nloc == 0u) { xcd_barrier_complete(bar, b.x, nloc, nx); b.st[0] = nloc; b.st[1] = nx; }
        const unsigned old = xb_add(&bar[XB_XSUB(b.x)], 1u);
        const unsigned gen = old / nloc;
        if (old + 1u == (gen + 1u) * nloc) {
            __builtin_amdgcn_fence(__ATOMIC_RELEASE, "agent");
            asm volatile("s_waitcnt vmcnt(0)" ::: "memory");
            const unsigned og = xb_add(&bar[XB_TOP], 1u);
            const unsigned tg = og / nx;
            if (og + 1u == (tg + 1u) * nx) xb_add(&bar[XB_TOPGEN], 1u);
            else XB_SPIN(xb_ld(&bar[XB_TOPGEN]) == tg, bar);
            __builtin_amdgcn_fence(__ATOMIC_ACQUIRE, "agent");
            xb_add(&bar[XB_XGEN(b.x)], 1u);
            asm volatile("s_waitcnt vmcnt(0)" ::: "memory");
        } else {
            XB_SPIN(xb_ld(&bar[XB_XGEN(b.x)]) == gen, bar);
            __builtin_amdgcn_fence(__ATOMIC_ACQUIRE, "agent");
            asm volatile("s_waitcnt vmcnt(0)" ::: "memory");
        }
    }
    __syncthreads();
}

constexpr int CW_BAR = 16384;
constexpr int ST_OFF = MISC_OFF + 1024;
__device__ __forceinline__ void seam(LAS unsigned char* lds) { const ArgsP a = kargs(); XcdBarrier b; b.bar = (unsigned*)(a->ws + WS_CTL) + CW_BAR; b.x = xb_xcc_id(); b.st = (volatile LAS unsigned*)(lds + ST_OFF); xcd_barrier(b); }
__device__ __forceinline__ void gemm1_phase(LAS unsigned char* lds) { const ArgsP a = kargs(); const Ctx cx = mkctx(a); unsigned char* ws = cx.ws;
    const int ng = ROLE_SPLIT ? cx.G - cx.G / 4 : cx.G;
    if (cx.bx < ng) { SchedDense S{ng, cx.bx, 12, 0, D, (const char*)(ws + WS_W1T)}; EpiConvIn E{(bf16*)(ws + WS_GB), (bf16*)(ws + WS_U)};
        pg8::gemm_phase(lds, (const char*)(ws + WS_XB), D, S, E); }
    else p0_items(lds, PS1 + P0A_EXTRA, P0_NITEMS, (cx.bx - ng) * NWAVES + cx.wave, (cx.G - ng) * NWAVES); }
__device__ __forceinline__ void gemm2_phase(LAS unsigned char* lds) { const ArgsP a = kargs(); const Ctx cx = mkctx(a); unsigned char* ws = cx.ws;
    SchedDense S{cx.G, cx.bx, 4, 1, D, (const char*)(ws + WS_W2T)}; EpiResZ<true> E{(const void*)(ws + WS_XB), (bf16*)(ws + LZ(0))};
    pg8::gemm_phase(lds, (const char*)(ws + WS_A2), D, S, E); }
__device__ __forceinline__ void kvq_phase(LAS unsigned char* lds) { const ArgsP a = kargs(); const Ctx cx = mkctx(a); unsigned char* ws = cx.ws;
    SchedDense S{cx.G, cx.bx, 12, 1, D, (const char*)(ws + WS_WKVQ)}; EpiKVQ E{(bf16*)(ws + WS_K)};
    pg8::gemm_phase(lds, (const char*)(ws + WS_X2B), D, S, E); }
__device__ __forceinline__ void wo_phase(LAS unsigned char* lds) { const ArgsP a = kargs(); const Ctx cx = mkctx(a); unsigned char* ws = cx.ws;
    SchedDense S{cx.G, cx.bx, 4, 1, D, (const char*)(ws + WS_WOT)}; EpiResZ<true> E{(const void*)(ws + WS_X2B), (bf16*)(ws + LZ(1))};
    pg8::gemm_phase(lds, (const char*)(ws + WS_A3), D, S, E); }
#ifndef ATTN128
#define ATTN128 1
#endif
#if ATTN128
__device__ __forceinline__ void attn_phase(char* lds_generic) { const ArgsP a = kargs(); const Ctx cx = mkctx(a); unsigned char* ws = cx.ws;
    const float l01 = dpp_sum1(a->b_lambda[cx.lane] * a->b_lambda[64 + cx.lane]), l23 = dpp_sum1(a->b_lambda[128 + cx.lane] * a->b_lambda[192 + cx.lane]);
    const float lam = __expf(l01) - __expf(l23) + LAM_INIT;
#pragma unroll 1
    for (int uix = cx.bx; uix < BATCH * NH * 4 * 2; uix += cx.G) {
        const int wgx = uix & 255, bh = ((wgx & 7) << 3) | (wgx >> 5), j = (wgx >> 3) & 3, qi = uix >> 8;
        const int b = bh >> 3, h = bh & 7, qb = qi == 0 ? j : 7 - j;
        const attn128::bf16* K0 = (const attn128::bf16*)(ws + WS_K) + h * 128;
        const attn128::bf16* Vc = (const attn128::bf16*)(ws + WS_V) + h * 128;
        attn128::bf16* Ac = (attn128::bf16*)(ws + WS_A3) + h * 128;
        attn128::attn_unit<8, 1>((long)b * SEQ, qb, K0 + (WS_Q - WS_K) / 2, K0, Vc, Ac, lds_generic, 0.f, nullptr, 0.f, 0.f);
        attn128::attn_unit<8, 2>((long)b * SEQ, qb, K0 + 64 + (WS_Q - WS_K) / 2, K0 + 64, Vc, Ac, lds_generic, lam, a->b_subln_g, 1.0f - LAM_INIT, RMS_EPS);
    }
}
#else
__device__ __forceinline__ void attn_phase(char* lds_generic) { const ArgsP a = kargs(); const Ctx cx = mkctx(a); unsigned char* ws = cx.ws;
#pragma unroll 1
    for (int uix = cx.bx; uix < BATCH * NH * 4 * (SEQ / 256); uix += cx.G) {
        const int combo = uix & 255, qi = uix >> 8;
        const int b = combo >> 5, h = (combo >> 2) & 7, c = (combo >> 1) & 1, vh = combo & 1;
        const int qb = (qi & 1) ? (SEQ / 256 - 1 - (qi >> 1)) : (qi >> 1);
        const attn_body::bf16* QK = (const attn_body::bf16*)(ws + WS_K) + h * 128 + c * 64;
        const attn_body::bf16* Vc = (const attn_body::bf16*)(ws + WS_V) + h * 128 + vh * 64;
        attn_body::bf16* Oc = (attn_body::bf16*)(ws + (c ? WS_O1 : WS_O0)) + h * 128 + vh * 64;
        attn_body::attn_unit<8>((long)b * SEQ, qb, QK + (WS_Q - WS_K) / 2, QK, Vc, Oc, lds_generic);
    }
}
#endif
__device__ __forceinline__ int scan_excl32(int v, int lane) {
    int x = v;
#pragma unroll
    for (int o = 1; o < 32; o <<= 1) { const int y = __shfl_up(x, o); if ((lane & 31) >= o) x += y; }
    return x - v;
}
__device__ __forceinline__ void moe_tables(LAS unsigned char* lds, int layer) { const ArgsP a = kargs(); const Ctx cx = mkctx(a); LAS int* misc = (LAS int*)(lds + MISC_OFF);
    const int* cnt = (const int*)(cx.ws + WS_CTL) + layer * NE * CNT_STRIDE;
    if (cx.tid < 64) {
        const int e = cx.lane, cn = e < NE ? __hip_atomic_load(cnt + e * CNT_STRIDE, __ATOMIC_RELAXED, __HIP_MEMORY_SCOPE_AGENT) : 0;
        const int rt = (cn + 255) >> 8, half = (cn > 0 && ((cn - 1) & 255) < 128) ? 1 : 0;
        const int uf = e < NE ? 4 * (rt - half) : 0, uh = e < NE ? 4 * half : 0, pr = e < NE ? 256 * rt : 0;
        const int sp = scan_excl32(pr, e); const int totp = __shfl(sp + pr, 31);
        if (e < NE) { misc[128 + e] = cn; misc[192 + e] = sp; }
        if (e == 0) misc[192 + NE] = totp;
        const int x = e & 7, sg = e >> 3, es = x + 8 * (sg & 3);
        const int vf = __shfl(uf, es), vh = __shfl(uh, es);
        const int val = sg < 4 ? vf : vh;
        int inc = val;
#pragma unroll
        for (int o = 8; o < 64; o <<= 1) { const int y = __shfl_up(inc, o); if (e >= o) inc += y; }
        misc[x * 9 + sg] = inc - val; if (sg == 7) misc[x * 9 + 8] = inc;
    }
    __syncthreads(); }
constexpr int CW_READY = 4096;
__device__ __forceinline__ void moe_up_phase(LAS unsigned char* lds, int layer, bool merged) { const ArgsP a = kargs(); const Ctx cx = mkctx(a); unsigned char* ws = cx.ws; LAS int* misc = (LAS int*)(lds + MISC_OFF);
    const MoeTab tb{misc, misc + 192, misc + 128};
    SchedMoe S{cx.G, cx.bx, D, true, (const char*)(ws + WS_WUT) + (size_t)layer * NE * D * D * 2, (const v2u*)(ws + LPERM(layer)), tb, (unsigned*)(ws + WS_CTL) + CW_READY, merged ? 1 : 0, 0, 0};
    if (merged) { EpiUp<true> E{(bf16*)(ws + LACT(layer))}; pg8::gemm_phase(lds, (const char*)(ws + (layer == 0 ? WS_X1B : WS_X3B)), D, S, E); }
    else { EpiUp<false> E{(bf16*)(ws + LACT(layer))}; pg8::gemm_phase(lds, (const char*)(ws + (layer == 0 ? WS_X1B : WS_X3B)), D, S, E); } }
__device__ __forceinline__ void moe_down_phase(LAS unsigned char* lds, int layer, bool merged) { const ArgsP a = kargs(); const Ctx cx = mkctx(a); unsigned char* ws = cx.ws; LAS int* misc = (LAS int*)(lds + MISC_OFF);
    const MoeTab tb{misc, misc + 192, misc + 128};
    int nb = 0;
    if (merged) { const int U = misc[2 * NE], rem = U % cx.G; nb = rem ? cx.G - rem : 0; }
    SchedMoe S{cx.G, cx.bx, DE, false, (const char*)(ws + WS_WDT) + (size_t)layer * NE * D * DE * 2, (const v2u*)(ws + LPERM(layer)), tb, (unsigned*)(ws + WS_CTL) + CW_READY, merged ? 2 : 0, 0, nb};
    EpiDown E{(bf16*)(ws + LYP(layer)), (const v2u*)(ws + LPERM(layer))};
    pg8::gemm_phase(lds, (const char*)(ws + LACT(layer)), DE, S, E); }

__global__ void __launch_bounds__(NTHREADS, 2) fwd_megakernel(Args args_unused) {
    extern __shared__ __attribute__((aligned(16))) unsigned char lds_raw[];
#ifdef NOSYNC
    struct { __device__ void sync() const {} } grid;
#else
    cg::grid_group grid = cg::this_grid();
#endif
#define SEAM() seam(lds)
    LAS unsigned char* lds = (LAS unsigned char*)lds_raw;
#ifndef MKPASS
#define MKPASS 1
#endif
    { const ArgsP a = kargs(); int t = threadIdx.x; asm volatile("" : "+v"(t));
      if (t < 2) ((volatile LAS unsigned*)(lds + ST_OFF))[t] = 0u;
      __syncthreads();
      (void)xcd_barrier_post((unsigned*)(a->ws + WS_CTL) + CW_BAR, (volatile LAS unsigned*)(lds + ST_OFF));
      if (a->ws == nullptr) grid.sync(); }
#pragma unroll 1
    for (int pass_ = 0; pass_ < MKPASS; ++pass_) {
    if (pass_) SEAM();
    PH(0) p0_prologue(lds);
    SEAM();
    PH(1) gemm1_phase(lds);
    SEAM();
    PH(2) conv_phase();
    SEAM();
    PH(3) gemm2_phase(lds);
    SEAM();
    PH(8) ln_router_mfma(lds, 0, rep_ + pass_);
    SEAM();
    moe_tables(lds, 0);
    PH(9) { moe_up_phase(lds, 0, false); if (P0B_FILL && pass_ == 0) p0b_idle_fill(lds, 0, P0B_SPLIT); }
    SEAM();
    PH(10) { moe_down_phase(lds, 0, false); if (P0B_FILL && pass_ == 0) p0b_idle_fill(lds, P0B_SPLIT, P0B_ITEMS); }
    SEAM();
    PH(11) ln2_phase(0);
    SEAM();
    PH(4) kvq_phase(lds);
    SEAM();
    PH(5) attn_phase((char*)lds_raw);
    SEAM();
#if !ATTN128
    PH(6) combine_phase();
    SEAM();
#endif
    PH(7) wo_phase(lds);
    SEAM();
    PH(8) ln_router_mfma(lds, 1, rep_ + pass_);
    SEAM();
    moe_tables(lds, 1);
#if MOE_MERGE
    PH(9) moe_up_phase(lds, 1, pass_ == 0);
    if (pass_) SEAM();
    PH(10) moe_down_phase(lds, 1, pass_ == 0);
#else
    PH(9) moe_up_phase(lds, 1, false);
    SEAM();
    PH(10) moe_down_phase(lds, 1, false);
#endif
    SEAM();
    PH(11) ln2_phase(1);
    }
#pragma unroll 1
    for (int i = 0; i < MKSYNC; ++i) SEAM();
}
}

extern "C" void kernel_launch(void* const* d_in, const int* in_sizes, int n_in, void* d_out, int out_size, void* d_ws, size_t ws_size, hipStream_t stream) {
    using namespace mk;
    static int grid = 0;
    if (grid == 0) {
        if (n_in != 19 || out_size != T * D || ws_size < WS_END) { fprintf(stderr, "kernel_launch: unexpected shapes / workspace (n_in %d out %d ws %zu, need %zu)\n", n_in, out_size, ws_size, (size_t)WS_END); grid = -1; return; }
        int dev = 0, cus = 0, per_cu = 0;
        (void)hipGetDevice(&dev); (void)hipDeviceGetAttribute(&cus, hipDeviceAttributeMultiprocessorCount, dev);
        if (hipFuncSetAttribute((const void*)fwd_megakernel, hipFuncAttributeMaxDynamicSharedMemorySize, LDS_BYTES) != hipSuccess) { fprintf(stderr, "kernel_launch: hipFuncSetAttribute failed\n"); grid = -1; return; }
        if (hipOccupancyMaxActiveBlocksPerMultiprocessor(&per_cu, (const void*)fwd_megakernel, NTHREADS, LDS_BYTES) != hipSuccess || per_cu < 1) { fprintf(stderr, "kernel_launch: occupancy query says %d blocks per CU\n", per_cu); grid = -1; return; }
        grid = cus * 1;
        if (grid != T / 64) { fprintf(stderr, "kernel_launch: this build needs exactly %d workgroups (one per CU of a 256-CU MI355X: the LN1 + router phase gives each 64 rows); device has %d CUs\n", T / 64, cus); grid = -1; return; }
        (void)hipGetLastError();
    }
    if (grid < 0) return;
    if (hipMemsetAsync((char*)d_ws + WS_CTL, 0, (size_t)(CW_BAR + XCD_BAR_WORDS) * 4, stream) != hipSuccess) { fprintf(stderr, "kernel_launch: hipMemsetAsync of the control words failed\n"); return; }
    Args a{};
    a.x = (const float*)d_in[0]; a.a_w_in = (const float*)d_in[1]; a.a_conv_w = (const float*)d_in[2]; a.a_w_out = (const float*)d_in[3]; a.kv_w = (const float*)d_in[4];
    a.b_w_q = (const float*)d_in[5]; a.b_lambda = (const float*)d_in[6]; a.b_subln_g = (const float*)d_in[7]; a.b_w_o = (const float*)d_in[8];
    a.ln1_g = (const float*)d_in[9]; a.ln1_b = (const float*)d_in[10]; a.ln2_g = (const float*)d_in[11]; a.ln2_b = (const float*)d_in[12];
    a.rg_w = (const float*)d_in[13]; a.rg_b = (const float*)d_in[14]; a.re_w = (const float*)d_in[15]; a.re_b = (const float*)d_in[16];
    a.e_w_in = (const float*)d_in[17]; a.e_w_down = (const float*)d_in[18];
    a.out = (float*)d_out; a.ws = (unsigned char*)d_ws;
    void* kargs[] = {&a};
    const hipError_t e = hipLaunchCooperativeKernel((const void*)fwd_megakernel, dim3(grid), dim3(NTHREADS), kargs, LDS_BYTES, stream);
    if (e != hipSuccess) fprintf(stderr, "kernel_launch: cooperative launch failed: %s (grid %d)\n", hipGetErrorString(e), grid);
}
```
